# Optimizing an MI355X kernel written in HIP

```python
import math
import jax, jax.numpy as jnp
from jax import lax
import numpy as np

D_MODEL = 2048
BATCH = 4
SEQ = 2048
DEPTH = 2

GRID_W = 64
NA_HEADS = 16
NA_HEAD_DIM = D_MODEL // NA_HEADS
NA_WIN_ROWS_MAX = 8
NA_WIN_COLS = 16
ML_PROJ_FACTOR = 2
ML_INNER = ML_PROJ_FACTOR * D_MODEL
ML_HEADS = 8
ML_HEAD_DIM = ML_INNER // ML_HEADS
ML_QKV_BLOCK = 4
ML_N_BLOCKS = ML_INNER // ML_QKV_BLOCK
ML_CONV_K = 5
ML_CHUNK = 128
FFN_DIM = 5632
N_EXPERTS = 8
TOP_K = 2
EXPERT_DIM = 7168
N_EVEN = (DEPTH + 1) // 2
N_ODD = DEPTH // 2
RMS_EPS = 1e-6
LN_EPS = 1e-5

kernel_name = "hybrid_natten_mlstm_moe_encoder"


def rms_norm(x, g):
    xf = x.astype(jnp.float32)
    y = xf * lax.rsqrt(jnp.mean(xf * xf, axis=-1, keepdims=True) + RMS_EPS)
    return (y * g.astype(jnp.float32)).astype(x.dtype)


def neighborhood_attention(h, w_in, q_g, k_g, rpb, w_out):
    B, T, D = h.shape
    rows = T // GRID_W
    kh = min(NA_WIN_ROWS_MAX, rows)
    q, k, v = jnp.split(h @ w_in, 3, axis=-1)

    def to_grid(t):
        return t.reshape(B, rows, GRID_W, NA_HEADS, NA_HEAD_DIM)

    q = rms_norm(to_grid(q), q_g) * (NA_HEAD_DIM ** -0.5)
    k = rms_norm(to_grid(k), k_g)
    v = to_grid(v)
    col = jnp.arange(GRID_W)
    col_start = jnp.clip(col - NA_WIN_COLS // 2, 0, GRID_W - NA_WIN_COLS)
    col_in = (col[None, :] >= col_start[:, None]) & (col[None, :] < col_start[:, None] + NA_WIN_COLS)
    dj_idx = jnp.clip(col[None, :] - col[:, None] + NA_WIN_COLS - 1, 0, 2 * NA_WIN_COLS - 2)
    rpb_cols = rpb[:, :, dj_idx].astype(jnp.float32)

    def row_block(r):
        r0 = jnp.clip(r - kh // 2, 0, rows - kh)
        k_band = lax.dynamic_slice_in_dim(k, r0, kh, axis=1)
        v_band = lax.dynamic_slice_in_dim(v, r0, kh, axis=1)
        q_r = lax.dynamic_index_in_dim(q, r, axis=1, keepdims=False)
        s = jnp.einsum('bqhd,bikhd->bhqik', q_r, k_band).astype(jnp.float32)
        di_idx = r0 + jnp.arange(kh) - r + NA_WIN_ROWS_MAX - 1
        bias = jnp.transpose(rpb_cols[:, di_idx], (0, 2, 1, 3))
        s = jnp.where(col_in[None, None, :, None, :], s + bias[None], -jnp.inf)
        p = jax.nn.softmax(s, axis=(-2, -1)).astype(v.dtype)
        return jnp.einsum('bhqik,bikhd->bqhd', p, v_band)

    out = lax.map(row_block, jnp.arange(rows))
    out = jnp.transpose(out, (1, 0, 2, 3, 4)).reshape(B, T, D)
    return out @ w_out


def mlstm_chunkwise(q, k, v, log_i, log_f):
    B, H, T, dq = q.shape
    dv = v.shape[-1]
    L = ML_CHUNK
    n = T // L

    def chunks(t):
        return jnp.moveaxis(t.reshape((B, H, n, L) + t.shape[3:]), 2, 0)

    causal = jnp.tril(jnp.ones((L, L), dtype=bool))

    def step(carry, inp):
        C, nv, m = carry
        qc, kc, vc, li, lf = inp
        b = jnp.cumsum(lf, axis=-1)
        g = b[..., -1]
        dlog = jnp.where(causal, b[..., :, None] - b[..., None, :] + li[..., None, :], -jnp.inf)
        m_inter = b + m[..., None]
        m_t = jnp.maximum(m_inter, jnp.max(dlog, axis=-1))
        s = jnp.einsum('bhtd,bhsd->bhts', qc, kc) * jnp.exp(dlog - m_t[..., None])
        inter = jnp.exp(m_inter - m_t)
        num = jnp.einsum('bhts,bhsv->bhtv', s, vc) + jnp.einsum('bhtd,bhvd->bhtv', qc, C) * inter[..., None]
        den = jnp.sum(s, axis=-1) + jnp.einsum('bhtd,bhd->bht', qc, nv) * inter
        hc = num / jnp.maximum(jnp.abs(den), jnp.exp(-m_t))[..., None]
        a = g[..., None] - b + li
        m_new = jnp.maximum(g + m, jnp.max(a, axis=-1))
        w = jnp.exp(a - m_new[..., None])
        decay = jnp.exp(g + m - m_new)
        C = decay[..., None, None] * C + jnp.einsum('bhsv,bhsd->bhvd', w[..., None] * vc, kc)
        nv = decay[..., None] * nv + jnp.einsum('bhs,bhsd->bhd', w, kc)
        return (C, nv, m_new), hc

    init = (jnp.zeros((B, H, dv, dq), jnp.float32), jnp.zeros((B, H, dq), jnp.float32),
            jnp.zeros((B, H), jnp.float32))
    _, hs = lax.scan(step, init, (chunks(q), chunks(k), chunks(v), chunks(log_i), chunks(log_f)))
    return jnp.moveaxis(hs, 0, 2).reshape(B, H, T, dv)


def mlstm_mixer(h, w_in, conv_w, conv_b, wq, wk, wv, w_if, b_if, skip, norm_g, w_out):
    B, T, _ = h.shape
    f32 = jnp.float32
    xm, z = jnp.split(h @ w_in, 2, axis=-1)
    pad = ML_CONV_K // 2
    xc = lax.conv_general_dilated(xm, conv_w[:, None, :], window_strides=(1,), padding=[(pad, pad)],
                                  dimension_numbers=('NWC', 'WIO', 'NWC'), feature_group_count=ML_INNER)
    xc = jax.nn.silu(xc + conv_b)

    def blockdiag(t, w):
        return jnp.einsum('btni,nio->btno', t.reshape(B, T, ML_N_BLOCKS, ML_QKV_BLOCK), w).reshape(B, T, ML_INNER)

    q = blockdiag(xc, wq)
    k = blockdiag(xc, wk)
    v = blockdiag(xm, wv)
    pre = (jnp.einsum('btc,cdgh->btdgh', jnp.concatenate([q, k, v], axis=-1), w_if) + b_if).astype(f32)
    log_i = jnp.transpose(pre[:, :, :, 0, :], (2, 0, 3, 1))
    log_f = jnp.transpose(jax.nn.log_sigmoid(pre[:, :, :, 1, :]), (2, 0, 3, 1))

    def heads(t):
        return jnp.transpose(t.reshape(B, T, ML_HEADS, ML_HEAD_DIM), (0, 2, 1, 3)).astype(f32)

    qh = heads(q)
    kh = heads(k) * (ML_HEAD_DIM ** -0.5)
    vh = heads(v)
    flip = lambda t: jnp.flip(t, axis=2)
    h_fwd = mlstm_chunkwise(qh, kh, vh, log_i[0], log_f[0])
    h_bwd = flip(mlstm_chunkwise(flip(qh), flip(kh), flip(vh), flip(log_i[1]), flip(log_f[1])))
    ht = h_fwd + h_bwd
    mu = jnp.mean(ht, axis=-1, keepdims=True)
    var = jnp.mean(jnp.square(ht - mu), axis=-1, keepdims=True)
    hn = (ht - mu) * lax.rsqrt(var + LN_EPS)
    hn = jnp.transpose(hn, (0, 2, 1, 3)).reshape(B, T, ML_INNER) * norm_g.astype(f32)
    out = (hn.astype(h.dtype) + skip * xc) * jax.nn.sigmoid(z)
    return out @ w_out


def swiglu(h, w_gate, w_up, w_down):
    return (jax.nn.silu(h @ w_gate) * (h @ w_up)) @ w_down


def moe_swiglu(h, router, w_gate, w_up, w_down):
    B, T, D = h.shape
    xt = h.reshape(B * T, D)
    logits = (xt @ router).astype(jnp.float32)
    top_v, top_i = lax.top_k(logits, TOP_K)
    top_w = jax.nn.softmax(top_v, axis=-1)
    gates = jnp.sum(jax.nn.one_hot(top_i, N_EXPERTS, dtype=jnp.float32) * top_w[..., None], axis=1)
    gates = gates.astype(xt.dtype)
    out = jnp.zeros_like(xt)
    for e in range(N_EXPERTS):
        out = out + gates[:, e:e + 1] * swiglu(xt, w_gate[e], w_up[e], w_down[e])
    return out.reshape(B, T, D)


def setup_inputs(seed: int = 0) -> dict:
    key = jax.random.key(seed)
    ks = iter(jax.random.split(key, 40))
    D = D_MODEL

    def nrm(shape, scale):
        return jax.random.normal(next(ks), shape, jnp.float32) * scale

    x = nrm((BATCH, SEQ, D), 1.0)
    c = nrm((BATCH, D), 1.0)
    mod_w = nrm((DEPTH, D, 6 * D), D ** -0.5)
    mod_b = nrm((DEPTH, 6 * D), 0.02)
    norm_mix_g = 1.0 + nrm((DEPTH, D), 0.02)
    norm_ffn_g = 1.0 + nrm((DEPTH, D), 0.02)
    na_w_in = nrm((N_EVEN, D, 3 * D), D ** -0.5)
    na_q_norm_g = 1.0 + nrm((N_EVEN, NA_HEAD_DIM), 0.02)
    na_k_norm_g = 1.0 + nrm((N_EVEN, NA_HEAD_DIM), 0.02)
    na_rpb = nrm((N_EVEN, NA_HEADS, 2 * NA_WIN_ROWS_MAX - 1, 2 * NA_WIN_COLS - 1), 0.1)
    na_w_out = nrm((N_EVEN, D, D), D ** -0.5)
    ffn_w_gate = nrm((N_EVEN, D, FFN_DIM), D ** -0.5)
    ffn_w_up = nrm((N_EVEN, D, FFN_DIM), D ** -0.5)
    ffn_w_down = nrm((N_EVEN, FFN_DIM, D), FFN_DIM ** -0.5)
    ml_w_in = nrm((N_ODD, D, 2 * ML_INNER), D ** -0.5)
    ml_conv_w = nrm((N_ODD, ML_CONV_K, ML_INNER), ML_CONV_K ** -0.5)
    ml_conv_b = nrm((N_ODD, ML_INNER), 0.02)
    ml_wq = nrm((N_ODD, ML_N_BLOCKS, ML_QKV_BLOCK, ML_QKV_BLOCK), ML_QKV_BLOCK ** -0.5)
    ml_wk = nrm((N_ODD, ML_N_BLOCKS, ML_QKV_BLOCK, ML_QKV_BLOCK), ML_QKV_BLOCK ** -0.5)
    ml_wv = nrm((N_ODD, ML_N_BLOCKS, ML_QKV_BLOCK, ML_QKV_BLOCK), ML_QKV_BLOCK ** -0.5)
    ml_w_if = nrm((N_ODD, 3 * ML_INNER, 2, 2, ML_HEADS), 0.1 * (3 * ML_INNER) ** -0.5)
    b_i = nrm((N_ODD, 2, 1, ML_HEADS), 0.1)
    b_f = 3.0 + 3.0 * jax.random.uniform(next(ks), (N_ODD, 2, 1, ML_HEADS), jnp.float32)
    ml_b_if = jnp.concatenate([b_i, b_f], axis=2)
    ml_skip = 1.0 + nrm((N_ODD, ML_INNER), 0.02)
    ml_norm_g = 1.0 + nrm((N_ODD, ML_INNER), 0.02)
    ml_w_out = nrm((N_ODD, ML_INNER, D), ML_INNER ** -0.5)
    moe_router = nrm((N_ODD, D, N_EXPERTS), D ** -0.5)
    moe_w_gate = nrm((N_ODD, N_EXPERTS, D, EXPERT_DIM), D ** -0.5)
    moe_w_up = nrm((N_ODD, N_EXPERTS, D, EXPERT_DIM), D ** -0.5)
    moe_w_down = nrm((N_ODD, N_EXPERTS, EXPERT_DIM, D), EXPERT_DIM ** -0.5)
    return {"x": x, "c": c, "mod_w": mod_w, "mod_b": mod_b, "norm_mix_g": norm_mix_g,
            "norm_ffn_g": norm_ffn_g, "na_w_in": na_w_in, "na_q_norm_g": na_q_norm_g,
            "na_k_norm_g": na_k_norm_g, "na_rpb": na_rpb, "na_w_out": na_w_out,
            "ffn_w_gate": ffn_w_gate, "ffn_w_up": ffn_w_up, "ffn_w_down": ffn_w_down,
            "ml_w_in": ml_w_in, "ml_conv_w": ml_conv_w, "ml_conv_b": ml_conv_b,
            "ml_wq": ml_wq, "ml_wk": ml_wk, "ml_wv": ml_wv, "ml_w_if": ml_w_if,
            "ml_b_if": ml_b_if, "ml_skip": ml_skip, "ml_norm_g": ml_norm_g, "ml_w_out": ml_w_out,
            "moe_router": moe_router, "moe_w_gate": moe_w_gate, "moe_w_up": moe_w_up,
            "moe_w_down": moe_w_down}


def reference(x, c, mod_w, mod_b, norm_mix_g, norm_ffn_g, na_w_in, na_q_norm_g, na_k_norm_g,
              na_rpb, na_w_out, ffn_w_gate, ffn_w_up, ffn_w_down, ml_w_in, ml_conv_w, ml_conv_b,
              ml_wq, ml_wk, ml_wv, ml_w_if, ml_b_if, ml_skip, ml_norm_g, ml_w_out,
              moe_router, moe_w_gate, moe_w_up, moe_w_down):
    c_act = jax.nn.silu(c)
    for i in range(DEPTH):
        j = i // 2
        mod = (c_act @ mod_w[i] + mod_b[i])[:, None, :]
        shift1, scale1, gate1, shift2, scale2, gate2 = jnp.split(mod, 6, axis=-1)
        h = rms_norm(x, norm_mix_g[i]) * (1 + scale1) + shift1
        if i % 2 == 0:
            y = neighborhood_attention(h, na_w_in[j], na_q_norm_g[j], na_k_norm_g[j], na_rpb[j], na_w_out[j])
        else:
            y = mlstm_mixer(h, ml_w_in[j], ml_conv_w[j], ml_conv_b[j], ml_wq[j], ml_wk[j], ml_wv[j],
                            ml_w_if[j], ml_b_if[j], ml_skip[j], ml_norm_g[j], ml_w_out[j])
        x = x + gate1 * y
        h = rms_norm(x, norm_ffn_g[i]) * (1 + scale2) + shift2
        if i % 2 == 0:
            y = swiglu(h, ffn_w_gate[j], ffn_w_up[j], ffn_w_down[j])
        else:
            y = moe_swiglu(h, moe_router[j], moe_w_gate[j], moe_w_up[j], moe_w_down[j])
        x = x + gate2 * y
    return x
```

```cpp
#include <hip/hip_runtime.h>
#include <cstdio>
#include <cstdint>

#ifndef DBG
#define DBG 0
#endif
#ifndef N_LAUNCH_SPLIT
#define N_LAUNCH_SPLIT 0
#endif

#define LAS __attribute__((address_space(3)))
#define GAS __attribute__((address_space(1)))
#define DI __device__ __forceinline__
typedef unsigned short bf16_t;
typedef short bf16x8 __attribute__((ext_vector_type(8)));
typedef short s16x4 __attribute__((ext_vector_type(4)));
typedef float f32x2 __attribute__((ext_vector_type(2)));
typedef float f32x4 __attribute__((ext_vector_type(4)));
typedef float f32x16 __attribute__((ext_vector_type(16)));
typedef unsigned u32x2 __attribute__((ext_vector_type(2)));
typedef unsigned u32x4 __attribute__((ext_vector_type(4)));
typedef int i32x4 __attribute__((ext_vector_type(4)));
typedef int i32x8 __attribute__((ext_vector_type(8)));

constexpr int BATCH = 4, SEQ = 2048, DM = 2048, MTOK = BATCH * SEQ;
constexpr int GRID_W = 64, NA_HEADS = 16, NA_HD = 128;
constexpr int ML_INNER = 4096, ML_HEADS = 8, ML_HD = 512;
constexpr int FFN = 5632, NEXP = 8, EDIM = 7168;
constexpr int MPAD = 2 * MTOK + NEXP * 256;
constexpr int NTHREADS = 512, NWAVES = 8;
constexpr int LDS_BYTES = 147456;

constexpr size_t al256(size_t x) { return (x + 255) & ~(size_t)255; }
constexpr size_t WS_CTL = 0;
constexpr size_t CTL_BYTES = 65536;
constexpr size_t WS_MOD = WS_CTL + CTL_BYTES;
constexpr size_t WS_PRE = WS_MOD + al256((size_t)2 * 4 * 12288 * 4);
constexpr size_t WS_ROUTE = WS_PRE + (size_t)8 * MTOK * 32 * 4;
constexpr size_t WS_GLF = WS_ROUTE + (size_t)4 * MTOK * 2 * 4;
constexpr size_t WS_HA = WS_GLF + (size_t)256 * 10240 * 4;
constexpr size_t WS_X1 = WS_HA + (size_t)MTOK * DM * 2;
constexpr size_t WS_X2 = WS_X1 + (size_t)MTOK * DM * 4;
constexpr size_t WS_WT_IN = WS_X2 + (size_t)MTOK * DM * 4;
constexpr size_t WS_WT_OUT = WS_WT_IN + (size_t)6144 * 2048 * 2;
constexpr size_t WS_WT_GU = WS_WT_OUT + (size_t)2048 * 2048 * 2;
constexpr size_t WS_WT_DN = WS_WT_GU + (size_t)11264 * 2048 * 2;
constexpr size_t WS_WT_MLIN = WS_WT_DN + (size_t)2048 * 5632 * 2;
constexpr size_t WS_WT_MLOUT = WS_WT_MLIN + (size_t)8192 * 2048 * 2;
constexpr size_t WS_WT_IF = WS_WT_MLOUT + (size_t)2048 * 4096 * 2;
constexpr size_t WS_WT_MGU = WS_WT_IF + (size_t)32 * 12288 * 2;
constexpr size_t WS_WT_MD = WS_WT_MGU + (size_t)8 * 14336 * 2048;
constexpr size_t WS_ARENA = WS_WT_MD + (size_t)8 * 2048 * 7168;
constexpr size_t A_QK = WS_ARENA;
constexpr size_t A_QKN = A_QK + (size_t)MTOK * 4096 * 2;
constexpr size_t A_VT = A_QKN + (size_t)MTOK * 4096 * 2;
constexpr size_t A_ATT = A_VT + (size_t)2048 * MTOK * 2;
constexpr size_t A_ACT = A_ATT + (size_t)MTOK * DM * 2;
constexpr size_t A_L0_END = A_ACT + (size_t)MTOK * FFN * 2;
constexpr size_t A_XZ = WS_ARENA;
constexpr size_t A_XC = A_XZ + (size_t)MTOK * 8192 * 2;
constexpr size_t A_Q = A_XC + (size_t)MTOK * 4096 * 2;
constexpr size_t A_K = A_Q + (size_t)MTOK * 4096 * 2;
constexpr size_t A_V = A_K + (size_t)MTOK * 4096 * 2;
constexpr size_t A_HF = A_V + (size_t)MTOK * 4096 * 2;
constexpr size_t A_HB = A_HF + (size_t)MTOK * 4096 * 2;
constexpr size_t A_MO = A_HB + (size_t)MTOK * 4096 * 2;
constexpr size_t A_L1_END = A_MO + (size_t)MTOK * 4096 * 2;
constexpr size_t A_HS = WS_ARENA;
constexpr size_t A_ACTM = A_HS + (size_t)8 * 8192 * DM;
constexpr size_t A_YS = A_ACTM + (size_t)MPAD * EDIM;
constexpr size_t A_L2_END = A_YS + (size_t)MPAD * DM * 4;
constexpr size_t cmax(size_t a, size_t b) { return a > b ? a : b; }
constexpr size_t WS_END = cmax(cmax(A_L0_END, A_L1_END), A_L2_END);

constexpr int CW_BAR = 0;
constexpr int CW_ECNT = 4096;
constexpr int CW_DBG = 8192;

typedef __bf16 bf16x2_t __attribute__((ext_vector_type(2)));
DI unsigned cvt_pk_bf16(float lo, float hi) { const f32x2 v = {lo, hi}; return __builtin_bit_cast(unsigned, __builtin_convertvector(v, bf16x2_t)); }
DI float clamp448(float x) { return __builtin_fminf(__builtin_fmaxf(x, -448.f), 448.f); }
DI unsigned pk4_fp8(float a, float b, float c, float d) {
    int p = 0; p = __builtin_amdgcn_cvt_pk_fp8_f32(clamp448(a), clamp448(b), p, false); p = __builtin_amdgcn_cvt_pk_fp8_f32(clamp448(c), clamp448(d), p, true); return (unsigned)p; }
DI float bf_lo(unsigned u) { return __uint_as_float(u << 16); }
DI float bf_hi(unsigned u) { return __uint_as_float(u & 0xffff0000u); }
DI float bf2f(bf16_t b) { return __uint_as_float(((unsigned)b) << 16); }
DI bf16_t f2bf(float f) { return (bf16_t)(cvt_pk_bf16(f, 0.f) & 0xffffu); }
DI float wave_sum(float v) {
#pragma unroll
    for (int o = 1; o < 64; o <<= 1) v += __shfl_xor(v, o);
    return v;
}
DI float wave_max(float v) {
#pragma unroll
    for (int o = 1; o < 64; o <<= 1) v = fmaxf(v, __shfl_xor(v, o));
    return v;
}
DI float silu_f(float x) { return x / (1.f + __expf(-x)); }
DI float sigmoid_f(float x) { return 1.f / (1.f + __expf(-x)); }
#define LDS_WAIT() asm volatile("s_waitcnt lgkmcnt(0)" ::: "memory")
#define VM_WAIT() asm volatile("s_waitcnt vmcnt(0)" ::: "memory")

#define XB_TMO      128
#define XB_XCNT(j)  (256  + 64 * (j))
#define XB_XSUB(j)  (1280 + 64 * (j))
#define XB_XGEN(j)  (2304 + 64 * (j))
#define XB_TOP      3328
#define XB_TOPGEN   3392
#define XCD_BAR_WORDS 3456
#define XB_SPIN_CAP (1u << 22)

__device__ __forceinline__ unsigned xb_ld(unsigned* p)              { return __hip_atomic_load(p, __ATOMIC_RELAXED, __HIP_MEMORY_SCOPE_AGENT); }
__device__ __forceinline__ unsigned xb_add(unsigned* p, unsigned v) { return __hip_atomic_fetch_add(p, v, __ATOMIC_RELAXED, __HIP_MEMORY_SCOPE_AGENT); }
__device__ __forceinline__ unsigned xb_xcc_id() { return (unsigned)__builtin_amdgcn_s_getreg((3 << 11) | 20) & 0xFu; }
#define XB_SPIN(cond, bar) do { unsigned _sp = 0; while (cond) { __builtin_amdgcn_s_sleep(1); \
    if ((++_sp & 255u) == 0u) { if (xb_ld(&(bar)[XB_TMO])) break; if (_sp > XB_SPIN_CAP) { atomicAdd(&(bar)[XB_TMO], 1u); break; } } } } while (0)

struct XcdBarrier { unsigned* bar; unsigned x; volatile LAS unsigned* st; };

__device__ __forceinline__ XcdBarrier xcd_barrier_post(unsigned* bar, volatile LAS unsigned* st) {
    XcdBarrier b; b.bar = bar; b.x = xb_xcc_id(); b.st = st;
    if (threadIdx.x == 0) (void)xb_add(&bar[XB_XCNT(b.x)], 1u);
    return b;
}
__device__ __forceinline__ void xcd_barrier_complete(unsigned* bar, unsigned x, unsigned& nloc, unsigned& nx) {
    const unsigned G = gridDim.x * gridDim.y * gridDim.z;
    unsigned sum, cnt, mine, sp = 0u;
    for (;;) {
        sum = 0u; cnt = 0u; mine = 0u;
#pragma unroll
        for (unsigned j = 0; j < 16; ++j) { const unsigned c = xb_ld(&bar[XB_XCNT(j)]); sum += c; cnt += (c > 0u) ? 1u : 0u; mine = (j == x) ? c : mine; }
        if (sum == G) break;
        __builtin_amdgcn_s_sleep(1);
        if ((++sp & 255u) == 0u) { if (xb_ld(&bar[XB_TMO])) break; if (sp > XB_SPIN_CAP) { atomicAdd(&bar[XB_TMO], 1u); break; } }
    }
    nloc = mine > 0u ? mine : 1u; nx = cnt > 0u ? cnt : 1u;
}
__device__ __forceinline__ void xcd_barrier(const XcdBarrier& b) {
    asm volatile("s_waitcnt vmcnt(0)" ::: "memory");
    __syncthreads();
    if (threadIdx.x == 0) {
        unsigned* bar = b.bar;
        __builtin_amdgcn_s_waitcnt(0);
        unsigned nloc = b.st[0], nx = b.st[1];
        if (nloc == 0u) { xcd_barrier_complete(bar, b.x, nloc, nx); b.st[0] = nloc; b.st[1] = nx; }
        const unsigned old = xb_add(&bar[XB_XSUB(b.x)], 1u);
        const unsigned gen = old / nloc;
        if (old + 1u == (gen + 1u) * nloc) {
            __builtin_amdgcn_fence(__ATOMIC_RELEASE, "agent");
            asm volatile("s_waitcnt vmcnt(0)" ::: "memory");
            const unsigned og = xb_add(&bar[XB_TOP], 1u);
            const unsigned tg = og / nx;
            if (og + 1u == (tg + 1u) * nx) xb_add(&bar[XB_TOPGEN], 1u);
            else XB_SPIN(xb_ld(&bar[XB_TOPGEN]) == tg, bar);
            __builtin_amdgcn_fence(__ATOMIC_ACQUIRE, "agent");
            xb_add(&bar[XB_XGEN(b.x)], 1u);
            asm volatile("s_waitcnt vmcnt(0)" ::: "memory");
        } else {
            XB_SPIN(xb_ld(&bar[XB_XGEN(b.x)]) == gen, bar);
            __builtin_amdgcn_fence(__ATOMIC_ACQUIRE, "agent");
            asm volatile("s_waitcnt vmcnt(0)" ::: "memory");
        }
    }
    __syncthreads();
}

namespace pg8 {
constexpr int BM = 256, BK = 64, HALF = 128, HTB = HALF * BK * 2, STAGE_BYTES = 8 * HTB, NXCD = 8, WGM = 8;
__host__ __device__ __forceinline__ int lds_byte(int r, int c) { const int st = (r >> 4) * 2 + (c >> 5), rr = r & 15, cc = c & 31, ob = rr * 64 + cc * 2; return st * 1024 + (ob ^ (((ob >> 9) & 1) << 5)); }
__host__ __device__ __forceinline__ void stage_rc(int b, int& R, int& C) { const int st = b / 1024, sb = b % 1024, swz = sb ^ (((sb >> 9) & 1) << 5); R = (st >> 1) * 16 + swz / 64; C = (st & 1) * 32 + (swz % 64) / 2; }
__host__ __device__ __forceinline__ int perm32(int rho) { const int n = rho >> 4, i = rho & 15; return 8 * (i >> 2) + 4 * n + (i & 3); }

struct Unit { int pm, pn; size_t boff; size_t aoff; int slice; };
struct Gemm { const void* A; const void* Bt; int M, N, K; int ntk; };

struct StaticOrder {
    int nM, nN, nwg, G, c;
    __device__ void init(int M, int N, int G_, int c_) { nM = M / BM; nN = N / BM; nwg = nM * nN; G = G_; c = c_; }
    __device__ bool next(int i, Unit& u) const {
        const long L = (long)i * G + c; if (L >= nwg) return false;
        int wgid = (int)L; { const int q = nwg / NXCD, r = nwg % NXCD, xcd = wgid % NXCD, off = wgid / NXCD; wgid = (xcd < r ? xcd * (q + 1) : r * (q + 1) + (xcd - r) * q) + off; }
        const int nig = WGM * nN, gid = wgid / nig, fm = gid * WGM, gsz = (nM - fm) < WGM ? (nM - fm) : WGM;
        u.pm = fm + ((wgid % nig) % gsz); u.pn = (wgid % nig) / gsz; u.boff = 0; u.aoff = 0; u.slice = 0; return true;
    }
};
struct TileMap {
    int toff[9];
    __device__ __forceinline__ void lookup(int pm, int& e, int& k) const {
        e = (pm >= toff[1]) + (pm >= toff[2]) + (pm >= toff[3]) + (pm >= toff[4]) + (pm >= toff[5]) + (pm >= toff[6]) + (pm >= toff[7]);
        int t0 = 0;
#pragma unroll
        for (int q = 1; q < 8; ++q) t0 = (e == q) ? toff[q] : t0;
        k = pm - t0;
    }
};
constexpr int ECAP = 8192;
struct MoeOrder {
    int nM, nN, nwg, G, c; TileMap tm; size_t estride; size_t arowb;
    __device__ void init(int nM_, int N, int G_, int c_, const TileMap& tm_, size_t es, size_t arowb_) { nM = nM_; nN = N / BM; nwg = nM * nN; G = G_; c = c_; tm = tm_; estride = es; arowb = arowb_; }
    __device__ bool next(int i, Unit& u) const {
        const long L = (long)i * G + c; if (L >= nwg) return false;
        int wgid = (int)L; { const int q = nwg / NXCD, r = nwg % NXCD, xcd = wgid % NXCD, off = wgid / NXCD; wgid = (xcd < r ? xcd * (q + 1) : r * (q + 1) + (xcd - r) * q) + off; }
        const int nig = WGM * nN, gid = wgid / nig, fm = gid * WGM, gsz = (nM - fm) < WGM ? (nM - fm) : WGM;
        u.pm = fm + ((wgid % nig) % gsz); u.pn = (wgid % nig) / gsz; int e, k; tm.lookup(u.pm, e, k); u.boff = (size_t)e * estride;
        u.aoff = (size_t)((long)(e * ECAP + 256 * k - 256 * u.pm) * (long)arowb); u.slice = 0; return true;
    }
};

struct MoeRowOrder {
    int nwg, G, c; TileMap tm; size_t estride;
    __device__ void init(int nMf, int G_, int c_, const TileMap& tm_, size_t es) { nwg = nMf * 8; G = G_; c = c_; tm = tm_; estride = es; }
    __device__ bool next(int i, Unit& u) const {
        const long L = (long)i * G + c; if (L >= nwg) return false;
        u.pm = (int)(L >> 3); u.pn = (int)(L & 7); int e, k; tm.lookup(u.pm, e, k); u.boff = (size_t)e * estride; u.aoff = 0; u.slice = 0; return true;
    }
};
struct MoeSplitOrder {
    int pm0, nq, S, c; size_t kslice; TileMap tm; size_t estride;
    __device__ void init(int pm0_, int nT, int S_, size_t ks, int c_, const TileMap& tm_, size_t es) { pm0 = pm0_; S = S_; nq = nT * 8 * S_; kslice = ks; c = c_; tm = tm_; estride = es; }
    __device__ bool next(int i, Unit& u) const {
        if (i != 0 || c >= nq) return false;
        const int un = c / S; u.slice = c - un * S; u.pm = pm0 + (un >> 3); u.pn = un & 7; u.aoff = (size_t)u.slice * kslice; int e, k; tm.lookup(u.pm, e, k); u.boff = (size_t)e * estride + u.aoff; return true;
    }
};
struct EpiBf16 {
    static constexpr bool PERM = true, XBAR = false;
    bf16_t* O; int ldc;
    __device__ __forceinline__ void operator()(const f32x4 (&acc)[2][2][4][2], const Unit& u, int wr, int wc, int fr, int fq) const {
        const int row0 = u.pm * BM + wr * 64 + fr, col0 = u.pn * BM + wc * 32 + 8 * fq;
#pragma unroll
        for (int ai = 0; ai < 2; ++ai)
#pragma unroll
            for (int m = 0; m < 4; ++m) { bf16_t* rowp = O + (size_t)(row0 + ai * HALF + m * 16) * ldc + col0;
#pragma unroll
                for (int bj = 0; bj < 2; ++bj) { const f32x4 v0 = acc[ai][bj][m][0], v1 = acc[ai][bj][m][1];
                    u32x4 w; w.x = cvt_pk_bf16(v0[0], v0[1]); w.y = cvt_pk_bf16(v0[2], v0[3]); w.z = cvt_pk_bf16(v1[0], v1[1]); w.w = cvt_pk_bf16(v1[2], v1[3]);
                    *(u32x4*)(rowp + bj * HALF) = w; } }
    }
};
struct EpiQKNorm {
    static constexpr bool PERM = true, XBAR = true;
    bf16_t* O; int ldc; const float* qg; const float* kg;
    __device__ __forceinline__ void pre(const f32x4 (&acc)[2][2][4][2], int wr, int wc, int fr, int fq, LAS float* P) const {
#pragma unroll
        for (int ai = 0; ai < 2; ++ai)
#pragma unroll
            for (int m = 0; m < 4; ++m)
#pragma unroll
                for (int bj = 0; bj < 2; ++bj) { const f32x4 a = acc[ai][bj][m][0], b = acc[ai][bj][m][1];
                    float ss = (a[0] * a[0] + a[1] * a[1]) + (a[2] * a[2] + a[3] * a[3]) + (b[0] * b[0] + b[1] * b[1]) + (b[2] * b[2] + b[3] * b[3]);
                    ss += __shfl_xor(ss, 16); ss += __shfl_xor(ss, 32);
                    if (fq == 0) P[((ai * HALF + wr * 64 + m * 16 + fr) * 2 + bj) * 4 + wc] = ss; }
    }
    __device__ __forceinline__ void post(const f32x4 (&acc)[2][2][4][2], const Unit& u, int wr, int wc, int fr, int fq, const LAS float* P) const {
        const int row0 = u.pm * BM + wr * 64 + fr, col0 = u.pn * BM + wc * 32 + 8 * fq;
        f32x4 g0[2], g1[2]; float hs[2];
#pragma unroll
        for (int bj = 0; bj < 2; ++bj) { const int head = 2 * u.pn + bj; const float* gp = (head < 16 ? qg : kg) + wc * 32 + 8 * fq; g0[bj] = *(const f32x4*)gp; g1[bj] = *(const f32x4*)(gp + 4); hs[bj] = head < 16 ? 0.08838834764831845f : 1.0f; }
#pragma unroll
        for (int ai = 0; ai < 2; ++ai)
#pragma unroll
            for (int m = 0; m < 4; ++m) { bf16_t* rowp = O + (size_t)(row0 + ai * HALF + m * 16) * ldc + col0;
#pragma unroll
                for (int bj = 0; bj < 2; ++bj) { const f32x4 ps = *(const LAS f32x4*)(P + ((ai * HALF + wr * 64 + m * 16 + fr) * 2 + bj) * 4);
                    const float rstd = hs[bj] / sqrtf(((ps[0] + ps[1]) + (ps[2] + ps[3])) * (1.f / 128.f) + 1e-6f);
                    const f32x4 v0 = acc[ai][bj][m][0] * g0[bj] * rstd, v1 = acc[ai][bj][m][1] * g1[bj] * rstd;
                    u32x4 w; w.x = cvt_pk_bf16(v0[0], v0[1]); w.y = cvt_pk_bf16(v0[2], v0[3]); w.z = cvt_pk_bf16(v1[0], v1[1]); w.w = cvt_pk_bf16(v1[2], v1[3]);
                    *(u32x4*)(rowp + bj * HALF) = w; } }
    }
};
struct EpiBf16S {
    static constexpr bool PERM = true, XBAR = false;
    bf16_t* O; int ldc; float sc; size_t sstride;
    __device__ __forceinline__ void operator()(const f32x4 (&acc)[2][2][4][2], const Unit& u, int wr, int wc, int fr, int fq) const {
        const int row0 = u.pm * BM + wr * 64 + fr, col0 = u.pn * BM + wc * 32 + 8 * fq;
        bf16_t* Os = O + (size_t)u.slice * sstride;
#pragma unroll
        for (int ai = 0; ai < 2; ++ai)
#pragma unroll
            for (int m = 0; m < 4; ++m) { bf16_t* rowp = Os + (size_t)(row0 + ai * HALF + m * 16) * ldc + col0;
#pragma unroll
                for (int bj = 0; bj < 2; ++bj) { const f32x4 v0 = acc[ai][bj][m][0] * sc, v1 = acc[ai][bj][m][1] * sc;
                    u32x4 w; w.x = cvt_pk_bf16(v0[0], v0[1]); w.y = cvt_pk_bf16(v0[2], v0[3]); w.z = cvt_pk_bf16(v1[0], v1[1]); w.w = cvt_pk_bf16(v1[2], v1[3]);
                    *(u32x4*)(rowp + bj * HALF) = w; } }
    }
};
struct EpiSwiGLU {
    static constexpr bool PERM = true, XBAR = false;
    bf16_t* O; int ldc;
    __device__ __forceinline__ void operator()(const f32x4 (&acc)[2][2][4][2], const Unit& u, int wr, int wc, int fr, int fq) const {
        const int row0 = u.pm * BM + wr * 64 + fr, col0 = u.pn * HALF + wc * 32 + 8 * fq;
#pragma unroll
        for (int ai = 0; ai < 2; ++ai)
#pragma unroll
            for (int m = 0; m < 4; ++m) { bf16_t* rowp = O + (size_t)(row0 + ai * HALF + m * 16) * ldc + col0;
                float o[8];
#pragma unroll
                for (int n = 0; n < 2; ++n)
#pragma unroll
                    for (int j = 0; j < 4; ++j) { const float g = acc[ai][0][m][n][j], up = acc[ai][1][m][n][j]; o[n * 4 + j] = g * __builtin_amdgcn_rcpf(1.f + __expf(-g)) * up; }
                u32x4 w; w.x = cvt_pk_bf16(o[0], o[1]); w.y = cvt_pk_bf16(o[2], o[3]); w.z = cvt_pk_bf16(o[4], o[5]); w.w = cvt_pk_bf16(o[6], o[7]);
                *(u32x4*)rowp = w; }
    }
};
struct EpiSwiGLU8 {
    static constexpr bool PERM = true, XBAR = false;
    unsigned char* O; int ldc; float isc, osc;
    __device__ __forceinline__ void operator()(const f32x4 (&acc)[2][2][4][2], const Unit& u, int wr, int wc, int fr, int fq) const {
        const int row0 = u.pm * BM + wr * 64 + fr, col0 = u.pn * HALF + wc * 32 + 8 * fq;
#pragma unroll
        for (int ai = 0; ai < 2; ++ai)
#pragma unroll
            for (int m = 0; m < 4; ++m) { unsigned char* rowp = O + (size_t)(row0 + ai * HALF + m * 16) * ldc + col0;
                float o[8];
#pragma unroll
                for (int n = 0; n < 2; ++n)
#pragma unroll
                    for (int j = 0; j < 4; ++j) { const float g = acc[ai][0][m][n][j] * isc, up = acc[ai][1][m][n][j] * isc; o[n * 4 + j] = g * __builtin_amdgcn_rcpf(1.f + __expf(-g)) * up * osc; }
                u32x2 w; w.x = pk4_fp8(o[0], o[1], o[2], o[3]); w.y = pk4_fp8(o[4], o[5], o[6], o[7]);
                *(u32x2*)rowp = w; }
    }
};
struct EpiResGate {
    static constexpr bool PERM = false, XBAR = false;
    const float* base; float* out; int ldc; const float* gate; int gstride;
    __device__ __forceinline__ void operator()(const f32x4 (&acc)[2][2][4][2], const Unit& u, int wr, int wc, int fr, int fq) const {
        const int row0 = u.pm * BM + wr * 64 + fr, col0 = u.pn * BM + wc * 32 + 4 * fq;
        const float* gp = gate + (size_t)((u.pm * BM) >> 11) * gstride + col0;
        f32x4 gv[2][2];
#pragma unroll
        for (int bj = 0; bj < 2; ++bj)
#pragma unroll
            for (int n = 0; n < 2; ++n) gv[bj][n] = *(const f32x4*)(gp + bj * HALF + n * 16);
#pragma unroll
        for (int ai = 0; ai < 2; ++ai)
#pragma unroll
            for (int m = 0; m < 4; ++m) { const size_t off = (size_t)(row0 + ai * HALF + m * 16) * ldc + col0;
#pragma unroll
                for (int bj = 0; bj < 2; ++bj)
#pragma unroll
                    for (int n = 0; n < 2; ++n) { const f32x4 bs = *(const f32x4*)(base + off + bj * HALF + n * 16);
                        *(f32x4*)(out + off + bj * HALF + n * 16) = bs + gv[bj][n] * acc[ai][bj][m][n]; }
                asm volatile("" ::: "memory"); }
    }
};
struct EpiF32 {
    static constexpr bool PERM = false, XBAR = false;
    float* C; int ldc; float sc;
    __device__ __forceinline__ void operator()(const f32x4 (&acc)[2][2][4][2], const Unit& u, int wr, int wc, int fr, int fq) const {
        const int row0 = u.pm * BM + wr * 64 + fr, col0 = u.pn * BM + wc * 32 + 4 * fq;
#pragma unroll
        for (int ai = 0; ai < 2; ++ai)
#pragma unroll
            for (int m = 0; m < 4; ++m) { float* rowp = C + (size_t)(row0 + ai * HALF + m * 16) * ldc + col0;
#pragma unroll
                for (int bj = 0; bj < 2; ++bj)
#pragma unroll
                    for (int n = 0; n < 2; ++n) *(f32x4*)(rowp + bj * HALF + n * 16) = acc[ai][bj][m][n] * sc; }
    }
};

template <class Epi, class Sched, bool F8 = false>
__device__ __forceinline__ void gemm_phase(LAS unsigned char* lds, const Gemm g, const Sched& S, const Epi& E) {
    const int tid = threadIdx.x, wid = __builtin_amdgcn_readfirstlane(tid >> 6), lane = tid & 63, wr = wid >> 2, wc = wid & 3, fr = lane & 15, fq = lane >> 4;
    const int rowb = F8 ? g.K : 2 * g.K, nt = g.ntk ? g.ntk : rowb / (BK * 2);
    unsigned voffA[2], voffB[2];
#pragma unroll
    for (int i = 0; i < 2; ++i) { int R, C; stage_rc(tid * 16 + i * 8192, R, C); const int Rb = Epi::PERM ? ((R & ~31) + perm32(R & 31)) : R;
        voffA[i] = (unsigned)(R * rowb + C * 2); voffB[i] = (unsigned)(Rb * rowb + C * 2); }
    const size_t kstep = (size_t)(BK * 2);
    const size_t hstep = (size_t)HALF * rowb;
    const size_t tstep = 2 * hstep;
    const unsigned ldsw = (unsigned)wid * 1024u;
    const int aoff = lds_byte(wr * 64 + fr, fq * 8), boff = lds_byte(wc * 32 + fr, fq * 8);
#define PG8_SA(b, h) (((b) * 2 + (h)) * HTB)
#define PG8_SB(b, h) ((4 + (b) * 2 + (h)) * HTB)
#define PG8_STAGE(bufoff, gbase, voff) do { _Pragma("unroll") for (int _i = 0; _i < 2; ++_i) \
        __builtin_amdgcn_global_load_lds((const unsigned*)((const char*)(gbase) + (voff)[_i]), (LAS unsigned*)(lds + (bufoff) + ldsw + _i * 8192), 16, 0, 0); } while (0)
#define PG8_LD8(base_) __builtin_shufflevector(*(const LAS i32x4*)(base_), *(const LAS i32x4*)((base_) + 1024), 0, 1, 2, 3, 4, 5, 6, 7)
#define PG8_LDA(dst, b, h) do { _Pragma("unroll") for (int m = 0; m < 4; ++m) { if constexpr (F8) dst##8[m] = PG8_LD8(lds + PG8_SA(b, h) + aoff + m * 2048); \
        else { _Pragma("unroll") for (int k = 0; k < 2; ++k) dst[m][k] = *(const LAS bf16x8*)(lds + PG8_SA(b, h) + aoff + m * 2048 + k * 1024); } } } while (0)
#define PG8_LDB(dst, b, h) do { _Pragma("unroll") for (int n = 0; n < 2; ++n) { if constexpr (F8) dst##8[n] = PG8_LD8(lds + PG8_SB(b, h) + boff + n * 2048); \
        else { _Pragma("unroll") for (int k = 0; k < 2; ++k) dst[n][k] = *(const LAS bf16x8*)(lds + PG8_SB(b, h) + boff + n * 2048 + k * 1024); } } } while (0)
#define PG8_MMA(ai, bj, At, Bt) do { __builtin_amdgcn_s_setprio(1); _Pragma("unroll") for (int m = 0; m < 4; ++m) _Pragma("unroll") for (int n = 0; n < 2; ++n) { \
        if constexpr (F8) { asm volatile("v_mfma_f32_16x16x128_f8f6f4 %0, %1, %2, %0" : "+v"(acc[ai][bj][m][n]) : "v"(Bt##8[n]), "v"(At##8[m])); } \
        else { _Pragma("unroll") for (int k = 0; k < 2; ++k) acc[ai][bj][m][n] = __builtin_amdgcn_mfma_f32_16x16x32_bf16(Bt[n][k], At[m][k], acc[ai][bj][m][n], 0, 0, 0); } } \
        __builtin_amdgcn_s_setprio(0); } while (0)
#define PG8_WAIT_V(n) asm volatile("s_waitcnt vmcnt(" #n ")" ::: "memory")
#define PG8_WAIT_L(n) asm volatile("s_waitcnt lgkmcnt(" #n ")" ::: "memory")
#define PG8_BAR __builtin_amdgcn_s_barrier()
#define PG8_SCHED __builtin_amdgcn_sched_barrier(0)
    Unit cur, nxt; int ui = 0;
    if (!S.next(0, cur)) return;
    f32x4 acc[2][2][4][2];
#pragma unroll
    for (int a = 0; a < 2; ++a)
#pragma unroll
        for (int b = 0; b < 2; ++b)
#pragma unroll
            for (int m = 0; m < 4; ++m)
#pragma unroll
                for (int n = 0; n < 2; ++n) acc[a][b][m][n] = (f32x4){0.f, 0.f, 0.f, 0.f};
    bf16x8 At[4][2], B0[2][2], B1[2][2]; i32x8 At8[4], B08[2], B18[2];
    const char* cA = (const char*)g.A + cur.aoff + (size_t)cur.pm * tstep; const char* cB = (const char*)g.Bt + cur.boff + (size_t)cur.pn * tstep;
    PG8_STAGE(PG8_SB(0, 0), cB, voffB); PG8_STAGE(PG8_SA(0, 0), cA, voffA); PG8_STAGE(PG8_SB(0, 1), cB + hstep, voffB); PG8_STAGE(PG8_SA(0, 1), cA + hstep, voffA);
    if (wr == 1) PG8_BAR;
    PG8_WAIT_V(4); PG8_BAR;
    PG8_STAGE(PG8_SB(1, 0), cB + kstep, voffB); PG8_STAGE(PG8_SA(1, 0), cA + kstep, voffA); PG8_STAGE(PG8_SB(1, 1), cB + hstep + kstep, voffB);
    PG8_WAIT_V(6); PG8_BAR;
    for (;;) {
        const bool has_next = S.next(ui + 1, nxt);
        const char* nA = has_next ? (const char*)g.A + nxt.aoff + (size_t)nxt.pm * tstep : cA; const char* nB = has_next ? (const char*)g.Bt + nxt.boff + (size_t)nxt.pn * tstep : cB;
        for (int t = 0; t < nt; t += 2) {
            const bool last = (t == nt - 2);
            const char* a1 = cA + (size_t)(t + 1) * kstep;
            const char* a2 = last ? nA : cA + (size_t)(t + 2) * kstep; const char* b2 = last ? nB : cB + (size_t)(t + 2) * kstep;
            const char* a3 = a2 + kstep; const char* b3 = b2 + kstep;
            PG8_LDB(B0, 0, 0); PG8_SCHED; PG8_LDA(At, 0, 0); PG8_STAGE(PG8_SA(1, 1), a1 + hstep, voffA);
            PG8_WAIT_L(8); PG8_BAR; PG8_WAIT_L(0); PG8_MMA(0, 0, At, B0); PG8_BAR; PG8_SCHED;
            PG8_LDB(B1, 0, 1); PG8_STAGE(PG8_SB(0, 0), b2, voffB);
            PG8_BAR; PG8_WAIT_L(0); PG8_MMA(0, 1, At, B1); PG8_BAR;
            PG8_LDA(At, 0, 1); PG8_STAGE(PG8_SA(0, 0), a2, voffA);
            PG8_BAR; PG8_WAIT_L(0); PG8_MMA(1, 0, At, B0); PG8_BAR; PG8_SCHED;
            PG8_STAGE(PG8_SB(0, 1), b2 + hstep, voffB);
            PG8_WAIT_V(6); PG8_BAR; PG8_MMA(1, 1, At, B1); PG8_BAR;
            PG8_LDB(B0, 1, 0); PG8_SCHED; PG8_LDA(At, 1, 0); PG8_STAGE(PG8_SA(0, 1), a2 + hstep, voffA);
            PG8_WAIT_L(8); PG8_BAR; PG8_WAIT_L(0); PG8_MMA(0, 0, At, B0); PG8_BAR; PG8_SCHED;
            PG8_LDB(B1, 1, 1); PG8_STAGE(PG8_SB(1, 0), b3, voffB);
            PG8_BAR; PG8_WAIT_L(0); PG8_MMA(0, 1, At, B1); PG8_BAR;
            PG8_LDA(At, 1, 1); PG8_STAGE(PG8_SA(1, 0), a3, voffA);
            PG8_BAR; PG8_WAIT_L(0); PG8_MMA(1, 0, At, B0); PG8_BAR; PG8_SCHED;
            PG8_STAGE(PG8_SB(1, 1), b3 + hstep, voffB);
            PG8_WAIT_V(6); PG8_BAR; PG8_MMA(1, 1, At, B1); PG8_BAR;
        }
        if constexpr (F8) asm volatile("s_nop 15\n\ts_nop 15" ::: "memory");
        if constexpr (Epi::XBAR) { LAS float* P_ = (LAS float*)(lds + STAGE_BYTES); E.pre(acc, wr, wc, fr, fq, P_); PG8_WAIT_L(0); PG8_BAR; asm volatile("" ::: "memory"); E.post(acc, cur, wr, wc, fr, fq, P_); }
        else E(acc, cur, wr, wc, fr, fq);
        if (!has_next) break;
#pragma unroll
        for (int a = 0; a < 2; ++a)
#pragma unroll
            for (int b = 0; b < 2; ++b)
#pragma unroll
                for (int m = 0; m < 4; ++m)
#pragma unroll
                    for (int n = 0; n < 2; ++n) acc[a][b][m][n] = (f32x4){0.f, 0.f, 0.f, 0.f};
        cur = nxt; cA = nA; cB = nB; ++ui;
    }
    PG8_WAIT_V(0);
    if (wr == 0) PG8_BAR;
    PG8_BAR;
#undef PG8_SA
#undef PG8_SB
#undef PG8_STAGE
#undef PG8_LDA
#undef PG8_LDB
#undef PG8_MMA
#undef PG8_WAIT_V
#undef PG8_WAIT_L
#undef PG8_BAR
#undef PG8_SCHED
}
}

DI void mod_phase(const float* c, const float* mod_w, const float* mod_b, float* mod, LAS unsigned char* lds, int G, int tid, int lane, int wave) {
    LAS f32x4* cact = (LAS f32x4*)lds;
    LAS float* red = (LAS float*)(lds + 32768);
    for (int k = tid; k < DM; k += NTHREADS) { f32x4 v; v.x = silu_f(c[k]); v.y = silu_f(c[DM + k]); v.z = silu_f(c[2 * DM + k]); v.w = silu_f(c[3 * DM + k]); cact[k] = v; }
    __syncthreads();
    for (int it = blockIdx.x; it < 256; it += G) {
        const int l = it >> 7, n0 = (it & 127) * 96;
        float a0[4] = {0.f, 0.f, 0.f, 0.f}, a1[4] = {0.f, 0.f, 0.f, 0.f};
        if (lane < 48) {
            const float* wp = mod_w + ((size_t)l * DM + wave * 256) * 12288 + n0 + 2 * lane;
#pragma unroll 8
            for (int k = 0; k < 256; ++k) { const f32x2 w = *(const f32x2*)(wp + (size_t)k * 12288); const f32x4 cv = cact[wave * 256 + k];
                a0[0] += cv.x * w.x; a1[0] += cv.x * w.y; a0[1] += cv.y * w.x; a1[1] += cv.y * w.y; a0[2] += cv.z * w.x; a1[2] += cv.z * w.y; a0[3] += cv.w * w.x; a1[3] += cv.w * w.y; }
#pragma unroll
            for (int b = 0; b < 4; ++b) { red[(wave * 4 + b) * 96 + 2 * lane] = a0[b]; red[(wave * 4 + b) * 96 + 2 * lane + 1] = a1[b]; }
        }
        __syncthreads();
        if (tid < 384) { const int b = tid / 96, col = tid % 96; float s = mod_b[l * 12288 + n0 + col];
#pragma unroll
            for (int w = 0; w < 8; ++w) s += red[(w * 4 + b) * 96 + col];
            mod[((size_t)l * 4 + b) * 12288 + n0 + col] = s; }
        __syncthreads();
    }
}

template <int MODE>
DI void cvt_item(const float* W, int K, int N, bf16_t* WT, LAS float* scr, int kb, int nb, int lane) {
    const int k0 = 64 * kb, n0 = 32 * nb;
    float v[32];
    const float* wp = W + (size_t)(k0 + (lane >> 5)) * N + n0 + (lane & 31);
#pragma unroll
    for (int i = 0; i < 32; ++i) v[i] = wp[(size_t)(2 * i) * N];
#pragma unroll
    for (int i = 0; i < 32; ++i) scr[(2 * i + (lane >> 5)) * 33 + (lane & 31)] = v[i];
    LDS_WAIT();
    const int c = lane & 7;
#pragma unroll
    for (int j = 0; j < 4; ++j) { const int n = (lane >> 3) + 8 * j; const LAS float* s = scr + (8 * c) * 33 + n;
        u32x4 o; o.x = cvt_pk_bf16(s[0 * 33], s[1 * 33]); o.y = cvt_pk_bf16(s[2 * 33], s[3 * 33]); o.z = cvt_pk_bf16(s[4 * 33], s[5 * 33]); o.w = cvt_pk_bf16(s[6 * 33], s[7 * 33]);
        const int ng = n0 + n; const int row = (MODE == 0) ? ng : ((ng >> 7) * 256 + (ng & 127) + (MODE == 2 ? 128 : 0));
        *(u32x4*)(WT + (size_t)row * K + k0 + 8 * c) = o; }
    LDS_WAIT();
}
template <int MODE>
DI void cvt_item8(const float* W, int K, int N, unsigned char* WT, LAS float* scr, int kb, int nb, int lane, float wsc) {
    const int k0 = 64 * kb, n0 = 32 * nb;
    float v[32];
    const float* wp = W + (size_t)(k0 + (lane >> 5)) * N + n0 + (lane & 31);
#pragma unroll
    for (int i = 0; i < 32; ++i) v[i] = wp[(size_t)(2 * i) * N];
#pragma unroll
    for (int i = 0; i < 32; ++i) scr[(2 * i + (lane >> 5)) * 33 + (lane & 31)] = v[i] * wsc;
    LDS_WAIT();
    const int c = lane & 3;
#pragma unroll
    for (int j = 0; j < 2; ++j) { const int n = (lane >> 2) + 16 * j; const LAS float* s = scr + (16 * c) * 33 + n;
        u32x4 o; o.x = pk4_fp8(s[0 * 33], s[1 * 33], s[2 * 33], s[3 * 33]); o.y = pk4_fp8(s[4 * 33], s[5 * 33], s[6 * 33], s[7 * 33]);
        o.z = pk4_fp8(s[8 * 33], s[9 * 33], s[10 * 33], s[11 * 33]); o.w = pk4_fp8(s[12 * 33], s[13 * 33], s[14 * 33], s[15 * 33]);
        const int ng = n0 + n; const int row = (MODE == 0) ? ng : ((ng >> 7) * 256 + (ng & 127) + (MODE == 2 ? 128 : 0));
        *(u32x4*)(WT + (size_t)row * K + k0 + 16 * c) = o; }
    LDS_WAIT();
}
template <int MODE>
DI void cvt_job8(const float* W, int K, int N, int nbatch, unsigned char* WT, size_t dst_bstride, LAS float* scr, int gw, int NGW, int lane, float wsc) {
    const int nnb = N / 32, per = (K / 64) * nnb, total = per * nbatch;
    for (int it = gw; it < total; it += NGW) {
        const int bt = it / per, r = it - bt * per, kb = r / nnb, nb = r - kb * nnb;
        cvt_item8<MODE>(W + (size_t)bt * K * N, K, N, WT + (size_t)bt * dst_bstride, scr, kb, nb, lane, wsc);
    }
}
template <int MODE>
DI void cvt_job(const float* W, int K, int N, int nbatch, bf16_t* WT, size_t dst_bstride, LAS float* scr, int gw, int NGW, int lane) {
    const int nnb = N / 32, per = (K / 64) * nnb, total = per * nbatch;
    for (int it = gw; it < total; it += NGW) {
        const int bt = it / per, r = it - bt * per, kb = r / nnb, nb = r - kb * nnb;
        cvt_item<MODE>(W + (size_t)bt * K * N, K, N, WT + (size_t)bt * dst_bstride, scr, kb, nb, lane);
    }
}

DI void cvtw_load(f32x4 (&v)[16], const float* wp, int N) {
#pragma unroll
    for (int i = 0; i < 16; ++i) v[i] = __builtin_nontemporal_load((const f32x4*)(wp + (size_t)(4 * i) * N));
}
template <int MODE, bool OUT8>
DI void cvtw_store(const f32x4 (&v)[16], int K, void* WTb, LAS float* scr, int k0, int n0, int lane, float wsc) {
    const int kr = lane >> 4, n4 = lane & 15;
#pragma unroll
    for (int i = 0; i < 16; ++i)
#pragma unroll
        for (int e = 0; e < 4; ++e) scr[(4 * n4 + e) * 65 + 4 * i + kr] = OUT8 ? v[i][e] * wsc : v[i][e];
    LDS_WAIT();
    if (OUT8) {
        unsigned char* WT = (unsigned char*)WTb; const int c = lane & 3;
#pragma unroll
        for (int j = 0; j < 4; ++j) { const int n = (lane >> 2) + 16 * j; const LAS float* s = scr + n * 65 + 16 * c;
            u32x4 o; o.x = pk4_fp8(s[0], s[1], s[2], s[3]); o.y = pk4_fp8(s[4], s[5], s[6], s[7]); o.z = pk4_fp8(s[8], s[9], s[10], s[11]); o.w = pk4_fp8(s[12], s[13], s[14], s[15]);
            const int ng = n0 + n; const int row = (MODE == 0) ? ng : ((ng >> 7) * 256 + (ng & 127) + (MODE == 2 ? 128 : 0));
            *(u32x4*)(WT + (size_t)row * K + k0 + 16 * c) = o; }
    } else {
        bf16_t* WT = (bf16_t*)WTb; const int c = lane & 7;
#pragma unroll
        for (int j = 0; j < 8; ++j) { const int n = (lane >> 3) + 8 * j; const LAS float* s = scr + n * 65 + 8 * c;
            u32x4 o; o.x = cvt_pk_bf16(s[0], s[1]); o.y = cvt_pk_bf16(s[2], s[3]); o.z = cvt_pk_bf16(s[4], s[5]); o.w = cvt_pk_bf16(s[6], s[7]);
            const int ng = n0 + n; const int row = (MODE == 0) ? ng : ((ng >> 7) * 256 + (ng & 127) + (MODE == 2 ? 128 : 0));
            *(u32x4*)(WT + (size_t)row * K + k0 + 8 * c) = o; }
    }
    LDS_WAIT();
}
DI void cvtw_pack8(const f32x4 (&v)[16], LAS float* scr, int lane, float wsc, u32x4 (&o)[4]) {
    const int kr = lane >> 4, n4 = lane & 15;
#pragma unroll
    for (int i = 0; i < 16; ++i)
#pragma unroll
        for (int e = 0; e < 4; ++e) scr[(4 * n4 + e) * 65 + 4 * i + kr] = v[i][e] * wsc;
    LDS_WAIT();
    const int c = lane & 3;
#pragma unroll
    for (int j = 0; j < 4; ++j) { const int n = (lane >> 2) + 16 * j; const LAS float* s = scr + n * 65 + 16 * c;
        o[j].x = pk4_fp8(s[0], s[1], s[2], s[3]); o[j].y = pk4_fp8(s[4], s[5], s[6], s[7]); o[j].z = pk4_fp8(s[8], s[9], s[10], s[11]); o[j].w = pk4_fp8(s[12], s[13], s[14], s[15]); }
    LDS_WAIT();
}
template <int MODE, bool OUT8>
DI void cvtw_job(const float* W, int K, int N, int nbatch, void* WT, size_t dst_bstride_bytes, LAS float* scr, int gw, int NGW, int lane, float wsc) {
    const int nnb = N / 64, per = (K / 128) * nnb, total = per * nbatch;
    for (int it = gw; it < total; it += NGW) {
        const int bt = it / per, r = it - bt * per, kb = r / nnb, nb = r - kb * nnb, k0 = 128 * kb, n0 = 64 * nb;
        const float* wp = W + (size_t)bt * K * N + (size_t)(k0 + (lane >> 4)) * N + n0 + 4 * (lane & 15);
        f32x4 v0[16], v1[16];
        cvtw_load(v0, wp, N); cvtw_load(v1, wp + (size_t)64 * N, N);
        void* WTb = (unsigned char*)WT + (size_t)bt * dst_bstride_bytes;
        if (OUT8) {
            u32x4 o0[4], o1[4]; cvtw_pack8(v0, scr, lane, wsc, o0); cvtw_pack8(v1, scr, lane, wsc, o1);
            unsigned char* WT8 = (unsigned char*)WTb; const int c = lane & 3;
#pragma unroll
            for (int j = 0; j < 4; ++j) { const int ng = n0 + (lane >> 2) + 16 * j; const int row = (MODE == 0) ? ng : ((ng >> 7) * 256 + (ng & 127) + (MODE == 2 ? 128 : 0));
                unsigned char* dp = WT8 + (size_t)row * K + k0 + 16 * c; *(u32x4*)dp = o0[j]; *(u32x4*)(dp + 64) = o1[j]; }
        } else {
            cvtw_store<MODE, OUT8>(v0, K, WTb, scr, k0, n0, lane, wsc);
            cvtw_store<MODE, OUT8>(v1, K, WTb, scr, k0 + 64, n0, lane, wsc);
        }
    }
}

constexpr float HSCALE = 8.f, WSCALE = 256.f, ASCALE = 8.f;
template <bool ROUTER>
DI void rms_mod_phase(const float* X, const float* g, const float* scale, const float* shift, bf16_t* out,
                      const float* router, int* tok_e, int* tok_pos, float* tok_w, unsigned* ecnt, unsigned char* HS2, int gw, int NGW, int lane) {
    for (int row = gw; row < MTOK; row += NGW) {
        const int b = row >> 11;
        const f32x4* xr = (const f32x4*)(X + (size_t)row * DM) + lane;
        f32x4 v[8]; float ss = 0.f;
#pragma unroll
        for (int j = 0; j < 8; ++j) { v[j] = xr[64 * j]; ss += (v[j].x * v[j].x + v[j].y * v[j].y) + (v[j].z * v[j].z + v[j].w * v[j].w); }
        const float rstd = 1.0f / sqrtf(wave_sum(ss) * (1.f / DM) + 1e-6f);
        const f32x4* gp = (const f32x4*)g + lane; const f32x4* sc = (const f32x4*)(scale + (size_t)b * 12288) + lane; const f32x4* sh = (const f32x4*)(shift + (size_t)b * 12288) + lane;
        u32x2* op = (u32x2*)(out + (size_t)row * DM) + lane;
        float lg[8] = {0.f, 0.f, 0.f, 0.f, 0.f, 0.f, 0.f, 0.f}; unsigned h8[8];
#pragma unroll
        for (int j = 0; j < 8; ++j) { const f32x4 gg = gp[64 * j], s1 = sc[64 * j], s2 = sh[64 * j];
            f32x4 h = (v[j] * rstd) * gg; h = h * (s1 + 1.0f) + s2;
            if (ROUTER) { h8[j] = pk4_fp8(h.x * HSCALE, h.y * HSCALE, h.z * HSCALE, h.w * HSCALE); }
            else { u32x2 w; w.x = cvt_pk_bf16(h.x, h.y); w.y = cvt_pk_bf16(h.z, h.w); op[64 * j] = w; }
            if (ROUTER) {
#pragma unroll
                for (int i = 0; i < 4; ++i) { const int cc = 256 * j + 4 * lane + i; const f32x4 r0 = ((const f32x4*)router)[cc * 2], r1 = ((const f32x4*)router)[cc * 2 + 1];
                    lg[0] += h[i] * r0.x; lg[1] += h[i] * r0.y; lg[2] += h[i] * r0.z; lg[3] += h[i] * r0.w; lg[4] += h[i] * r1.x; lg[5] += h[i] * r1.y; lg[6] += h[i] * r1.z; lg[7] += h[i] * r1.w; } } }
        if (ROUTER) {
#pragma unroll
            for (int e = 0; e < 8; ++e) lg[e] = wave_sum(lg[e]);
            if (lane == 0) {
                int i0 = 0; float v0 = lg[0];
#pragma unroll
                for (int e = 1; e < 8; ++e) if (lg[e] > v0) { v0 = lg[e]; i0 = e; }
                int i1 = -1; float v1 = -3.0e38f;
#pragma unroll
                for (int e = 0; e < 8; ++e) if (e != i0 && lg[e] > v1) { v1 = lg[e]; i1 = e; }
                const float w1 = 1.f / (1.f + expf(v0 - v1)), w0 = 1.f - w1;
                const int p0 = (int)__hip_atomic_fetch_add(ecnt + 64 * i0, 1u, __ATOMIC_RELAXED, __HIP_MEMORY_SCOPE_AGENT);
                const int p1 = (int)__hip_atomic_fetch_add(ecnt + 64 * i1, 1u, __ATOMIC_RELAXED, __HIP_MEMORY_SCOPE_AGENT);
                tok_e[2 * row] = i0; tok_e[2 * row + 1] = i1; tok_pos[2 * row] = p0; tok_pos[2 * row + 1] = p1; tok_w[2 * row] = w0; tok_w[2 * row + 1] = w1;
                lg[0] = __int_as_float(i0 * pg8::ECAP + p0); lg[1] = __int_as_float(i1 * pg8::ECAP + p1);
            }
            const int ra = __builtin_amdgcn_readfirstlane(__float_as_int(lg[0])), rb = __builtin_amdgcn_readfirstlane(__float_as_int(lg[1]));
            unsigned* da = (unsigned*)(HS2 + (size_t)ra * DM) + lane; unsigned* db = (unsigned*)(HS2 + (size_t)rb * DM) + lane;
#pragma unroll
            for (int j = 0; j < 8; ++j) { da[64 * j] = h8[j]; db[64 * j] = h8[j]; }
        }
    }
}

DI void qknorm_phase(const bf16_t* QK, bf16_t* QKN, const float* qg, const float* kg, int gw, int NGW, int lane) {
    const int l16 = lane & 15;
    for (int idx = gw * 4 + (lane >> 4); idx < MTOK * 32; idx += NGW * 4) {
        const int hr = idx & 31; const size_t off = (size_t)(idx >> 5) * 4096 + hr * 128 + 8 * l16;
        const u32x4 raw = *(const u32x4*)(QK + off);
        float x[8] = {bf_lo(raw.x), bf_hi(raw.x), bf_lo(raw.y), bf_hi(raw.y), bf_lo(raw.z), bf_hi(raw.z), bf_lo(raw.w), bf_hi(raw.w)};
        float ss = 0.f;
#pragma unroll
        for (int i = 0; i < 8; ++i) ss += x[i] * x[i];
        ss += __shfl_xor(ss, 1); ss += __shfl_xor(ss, 2); ss += __shfl_xor(ss, 4); ss += __shfl_xor(ss, 8);
        const float rstd = (1.0f / sqrtf(ss * (1.f / 128.f) + 1e-6f)) * (hr < 16 ? 0.08838834764831845f : 1.0f);
        const float* gp = (hr < 16 ? qg : kg) + 8 * l16;
        const f32x4 g0 = *(const f32x4*)gp, g1 = *(const f32x4*)(gp + 4);
        u32x4 o; o.x = cvt_pk_bf16(x[0] * rstd * g0.x, x[1] * rstd * g0.y); o.y = cvt_pk_bf16(x[2] * rstd * g0.z, x[3] * rstd * g0.w);
        o.z = cvt_pk_bf16(x[4] * rstd * g1.x, x[5] * rstd * g1.y); o.w = cvt_pk_bf16(x[6] * rstd * g1.z, x[7] * rstd * g1.w);
        *(u32x4*)(QKN + off) = o;
    }
}

constexpr int NA_TBL = 0, NA_BUF = 30720, NA_TILE = 18432;
DI void na_phase(const bf16_t* QKN, const bf16_t* VT, bf16_t* ATT, const float* rpb, LAS unsigned char* lds, int G, int vcu0, int tid, int lane, int wave) {
    LAS float* rpbL = (LAS float*)(lds + NA_TBL);
    for (int i = tid; i < 16 * 465; i += NTHREADS) rpbL[i] = rpb[i];
    const int c16 = lane & 15, g = lane >> 4, unit = wave >> 2, j = wave & 3;
    const int cb = (j == 0) ? 0 : (j == 1) ? 8 : (j == 2) ? 24 : 32;
    const int qc = 16 * j + c16, c0 = min(max(qc - 8, 0), 48);
    const int kcl = 8 * (c16 >> 2) + (c16 & 3);
    for (int p = vcu0; p < 1024; p += G) {
        const int rho = p & 15, hh = (p >> 4) & 15, b = p >> 8;
        const int rA = 2 * rho, r0A = min(max(rA - 4, 0), 24), r0B = min(max(rA + 1 - 4, 0), 24), delta = r0B - r0A, nrows = 8 + delta;
        const int r = rA + unit, r0 = unit ? r0B : r0A;
        const bool shiftB = (unit == 1) && (delta == 1);
        const size_t tq = (size_t)b * SEQ + r * 64 + qc;
        bf16x8 qf[4];
#pragma unroll
        for (int ks = 0; ks < 4; ++ks) qf[ks] = *(const bf16x8*)(QKN + tq * 4096 + hh * 128 + 32 * ks + 8 * g);
        f32x4 S[8][2];
        u32x4 st0, st1;
        const int kkey = tid >> 3, kch = tid & 7;
        const int vd = tid >> 2, vch = tid & 3;
        const bf16_t* kg = QKN + ((size_t)b * SEQ + (size_t)r0A * 64 + kkey) * 4096 + 2048 + hh * 128 + kch * 8;
        const bf16_t* vg = VT + (size_t)(hh * 128 + vd) * MTOK + (size_t)b * SEQ + (size_t)r0A * 64 + vch * 8;
#define NA_LDK(s_) do { st0 = *(const u32x4*)(kg + (size_t)(s_) * 64 * 4096); st1 = *(const u32x4*)(kg + (size_t)(s_) * 64 * 4096 + 64); } while (0)
#define NA_STK(s_) do { LAS unsigned char* t_ = lds + NA_BUF + ((s_) & 1) * NA_TILE + kkey * 272 + kch * 16; *(LAS u32x4*)t_ = st0; *(LAS u32x4*)(t_ + 128) = st1; } while (0)
#define NA_LDV(s_) do { st0 = *(const u32x4*)(vg + (s_) * 64); st1 = *(const u32x4*)(vg + (s_) * 64 + 32); } while (0)
#define NA_STV(s_) do { LAS unsigned char* t_ = lds + NA_BUF + ((s_) & 1) * NA_TILE + vd * 144 + vch * 16; *(LAS u32x4*)t_ = st0; *(LAS u32x4*)(t_ + 64) = st1; } while (0)
#define NA_QK(s_, i_) do { const LAS unsigned char* kb_ = lds + NA_BUF + ((s_) & 1) * NA_TILE + (cb + kcl) * 272 + 16 * g; \
            _Pragma("unroll") for (int hc = 0; hc < 2; ++hc) { f32x4 a = (f32x4){0.f, 0.f, 0.f, 0.f}; \
                _Pragma("unroll") for (int ks = 0; ks < 4; ++ks) a = __builtin_amdgcn_mfma_f32_16x16x32_bf16(*(const LAS bf16x8*)(kb_ + hc * 4 * 272 + 64 * ks), qf[ks], a, 0, 0, 0); S[i_][hc] = a; } } while (0)
#define NA_SROW(s_) do { if ((s_) < nrows) { NA_STK(s_); __syncthreads(); if ((s_) + 1 < nrows) NA_LDK((s_) + 1); \
            if (!shiftB) { if ((s_) < 8) NA_QK(s_, (s_) < 8 ? (s_) : 7); } else { if ((s_) >= 1) NA_QK(s_, (s_) >= 1 ? (s_) - 1 : 0); } } } while (0)
        __syncthreads();
        NA_LDK(0);
        NA_SROW(0); NA_SROW(1); NA_SROW(2); NA_SROW(3); NA_SROW(4); NA_SROW(5); NA_SROW(6); NA_SROW(7); NA_SROW(8);
        NA_LDV(0);
        float mx = -3.0e38f;
        const LAS float* bt = rpbL + hh * 465;
#pragma unroll
        for (int i = 0; i < 8; ++i)
#pragma unroll
            for (int hc = 0; hc < 2; ++hc)
#pragma unroll
                for (int e = 0; e < 4; ++e) {
                    const int kc = cb + 8 * g + 4 * hc + e; const bool valid = (kc >= c0) && (kc < c0 + 16);
                    const int dj = min(max(kc - qc + 15, 0), 30), di = r0 + i - r + 7;
                    const float sv = valid ? S[i][hc][e] + bt[di * 31 + dj] : -3.0e38f;
                    S[i][hc][e] = sv; mx = fmaxf(mx, sv);
                }
        mx = fmaxf(mx, __shfl_xor(mx, 16)); mx = fmaxf(mx, __shfl_xor(mx, 32));
        float sum = 0.f;
#pragma unroll
        for (int i = 0; i < 8; ++i)
#pragma unroll
            for (int hc = 0; hc < 2; ++hc)
#pragma unroll
                for (int e = 0; e < 4; ++e) { const float pv = (S[i][hc][e] > -1.0e38f) ? __expf(S[i][hc][e] - mx) : 0.f; S[i][hc][e] = pv; sum += pv; }
        sum += __shfl_xor(sum, 16); sum += __shfl_xor(sum, 32);
        const float inv = 1.0f / sum;
        f32x4 O[8];
#pragma unroll
        for (int dt = 0; dt < 8; ++dt) O[dt] = (f32x4){0.f, 0.f, 0.f, 0.f};
#define NA_PV(s_, i_) do { u32x4 pw; pw.x = cvt_pk_bf16(S[i_][0][0], S[i_][0][1]); pw.y = cvt_pk_bf16(S[i_][0][2], S[i_][0][3]); pw.z = cvt_pk_bf16(S[i_][1][0], S[i_][1][1]); pw.w = cvt_pk_bf16(S[i_][1][2], S[i_][1][3]); \
            const bf16x8 pf = __builtin_bit_cast(bf16x8, pw); const LAS unsigned char* vb_ = lds + NA_BUF + ((s_) & 1) * NA_TILE + c16 * 144 + (cb + 8 * g) * 2; \
            _Pragma("unroll") for (int dt = 0; dt < 8; ++dt) O[dt] = __builtin_amdgcn_mfma_f32_16x16x32_bf16(*(const LAS bf16x8*)(vb_ + dt * 16 * 144), pf, O[dt], 0, 0, 0); } while (0)
#define NA_VROW(s_) do { if ((s_) < nrows) { NA_STV(s_); __syncthreads(); if ((s_) + 1 < nrows) NA_LDV((s_) + 1); \
            if (!shiftB) { if ((s_) < 8) NA_PV(s_, (s_) < 8 ? (s_) : 7); } else { if ((s_) >= 1) NA_PV(s_, (s_) >= 1 ? (s_) - 1 : 0); } } } while (0)
        __syncthreads();
        NA_VROW(0); NA_VROW(1); NA_VROW(2); NA_VROW(3); NA_VROW(4); NA_VROW(5); NA_VROW(6); NA_VROW(7); NA_VROW(8);
#undef NA_LDK
#undef NA_STK
#undef NA_LDV
#undef NA_STV
#undef NA_QK
#undef NA_SROW
#undef NA_PV
#undef NA_VROW
#pragma unroll
        for (int dt = 0; dt < 8; ++dt) { u32x2 w; w.x = cvt_pk_bf16(O[dt][0] * inv, O[dt][1] * inv); w.y = cvt_pk_bf16(O[dt][2] * inv, O[dt][3] * inv);
            *(u32x2*)(ATT + tq * DM + hh * 128 + 16 * dt + 4 * g) = w; }
    }
}

constexpr int MLP_WIF = 36864, MLP_WROW = 3088;
DI void ml_pre_phase(const bf16_t* XZ, const float* conv_w, const float* conv_b, const float* wq, const float* wk, const float* wv, const bf16_t* WTif,
                     bf16_t* XC, bf16_t* Q, bf16_t* Kb, bf16_t* V, float* pre_part, LAS unsigned char* lds, int G, int tid, int lane, int wave) {
    LAS float* Lcw = (LAS float*)lds;
    LAS float* Lcb = Lcw + 2560;
    LAS float* Lwq = Lcb + 512;
    LAS float* Lwk = Lwq + 2048;
    LAS float* Lwv = Lwk + 2048;
    LAS unsigned char* Lwif = lds + MLP_WIF;
    const int g = lane >> 4, tk = lane & 15;
    for (int item = blockIdx.x; item < 256; item += G) {
        const int hd = item & 7, tr = item >> 3;
        __syncthreads();
        for (int i = tid; i < 2560; i += NTHREADS) Lcw[i] = conv_w[(i >> 9) * 4096 + hd * 512 + (i & 511)];
        Lcb[tid] = conv_b[hd * 512 + tid];
        for (int i = tid; i < 2048; i += NTHREADS) { Lwq[i] = wq[hd * 2048 + i]; Lwk[i] = wk[hd * 2048 + i]; Lwv[i] = wv[hd * 2048 + i]; }
        for (int i = tid; i < 32 * 3 * 64; i += NTHREADS) { const int n = i / 192, rem = i - n * 192, sec = rem >> 6, c16 = rem & 63;
            *(LAS u32x4*)(Lwif + n * MLP_WROW + sec * 1024 + c16 * 16) = *(const u32x4*)(WTif + (size_t)n * 12288 + sec * 4096 + hd * 512 + c16 * 8); }
        __syncthreads();
        for (int tt = wave; tt < 16; tt += 8) {
            const int tok = tr * 256 + tt * 16 + tk, tseq = tok & 2047;
            f32x4 accp[2]; accp[0] = (f32x4){0.f, 0.f, 0.f, 0.f}; accp[1] = (f32x4){0.f, 0.f, 0.f, 0.f};
            u32x4 xrA[5], xrB[5], hq, hk, hv, hc;
#define MLP_LOAD(xr_, step_) do { const int ch_ = hd * 512 + (step_) * 32 + 8 * g; \
                _Pragma("unroll") for (int jt = 0; jt < 5; ++jt) { const int dt = jt - 2; const bool ok = (unsigned)(tseq + dt) < (unsigned)SEQ; \
                    xr_[jt] = (u32x4){0u, 0u, 0u, 0u}; if (ok) xr_[jt] = *(const u32x4*)(XZ + (size_t)(tok + dt) * 8192 + ch_); } } while (0)
#define MLP_COMPUTE(xr_, step_, HOLD_) do { \
                const int cl = (step_) * 32 + 8 * g, ch = hd * 512 + cl; \
                float a[8], xm[8]; \
                { const f32x4 b0 = *(const LAS f32x4*)(Lcb + cl), b1 = *(const LAS f32x4*)(Lcb + cl + 4); \
                  a[0] = b0.x; a[1] = b0.y; a[2] = b0.z; a[3] = b0.w; a[4] = b1.x; a[5] = b1.y; a[6] = b1.z; a[7] = b1.w; } \
                _Pragma("unroll") for (int jt = 0; jt < 5; ++jt) { \
                    const u32x4 xr = xr_[jt]; \
                    const float xv[8] = {bf_lo(xr.x), bf_hi(xr.x), bf_lo(xr.y), bf_hi(xr.y), bf_lo(xr.z), bf_hi(xr.z), bf_lo(xr.w), bf_hi(xr.w)}; \
                    const f32x4 w0 = *(const LAS f32x4*)(Lcw + jt * 512 + cl), w1 = *(const LAS f32x4*)(Lcw + jt * 512 + cl + 4); \
                    a[0] += xv[0] * w0.x; a[1] += xv[1] * w0.y; a[2] += xv[2] * w0.z; a[3] += xv[3] * w0.w; a[4] += xv[4] * w1.x; a[5] += xv[5] * w1.y; a[6] += xv[6] * w1.z; a[7] += xv[7] * w1.w; \
                    if (jt == 2) { _Pragma("unroll") for (int i = 0; i < 8; ++i) xm[i] = xv[i]; } } \
                float xc[8], q[8], k[8], v[8]; \
                _Pragma("unroll") for (int i = 0; i < 8; ++i) xc[i] = silu_f(a[i]); \
                _Pragma("unroll") for (int blk = 0; blk < 2; ++blk) { const int wo = ((cl >> 2) + blk) * 16; \
                    _Pragma("unroll") for (int o = 0; o < 4; ++o) { float sq = 0.f, sk = 0.f, sv = 0.f; \
                        _Pragma("unroll") for (int i = 0; i < 4; ++i) { sq += xc[4 * blk + i] * Lwq[wo + i * 4 + o]; sk += xc[4 * blk + i] * Lwk[wo + i * 4 + o]; sv += xm[4 * blk + i] * Lwv[wo + i * 4 + o]; } \
                        q[4 * blk + o] = sq; k[4 * blk + o] = sk; v[4 * blk + o] = sv; } } \
                u32x4 qw, kw, vw, cw; \
                qw.x = cvt_pk_bf16(q[0], q[1]); qw.y = cvt_pk_bf16(q[2], q[3]); qw.z = cvt_pk_bf16(q[4], q[5]); qw.w = cvt_pk_bf16(q[6], q[7]); \
                kw.x = cvt_pk_bf16(k[0], k[1]); kw.y = cvt_pk_bf16(k[2], k[3]); kw.z = cvt_pk_bf16(k[4], k[5]); kw.w = cvt_pk_bf16(k[6], k[7]); \
                vw.x = cvt_pk_bf16(v[0], v[1]); vw.y = cvt_pk_bf16(v[2], v[3]); vw.z = cvt_pk_bf16(v[4], v[5]); vw.w = cvt_pk_bf16(v[6], v[7]); \
                cw.x = cvt_pk_bf16(xc[0], xc[1]); cw.y = cvt_pk_bf16(xc[2], xc[3]); cw.z = cvt_pk_bf16(xc[4], xc[5]); cw.w = cvt_pk_bf16(xc[6], xc[7]); \
                const size_t o4 = (size_t)tok * 4096 + ch; \
                if (HOLD_) { hq = qw; hk = kw; hv = vw; hc = cw; }     \
                else { *(u32x4*)(Q + o4 - 32) = hq; *(u32x4*)(Q + o4) = qw; *(u32x4*)(Kb + o4 - 32) = hk; *(u32x4*)(Kb + o4) = kw; *(u32x4*)(V + o4 - 32) = hv; *(u32x4*)(V + o4) = vw; *(u32x4*)(XC + o4 - 32) = hc; *(u32x4*)(XC + o4) = cw; } \
                const bf16x8 qf = __builtin_bit_cast(bf16x8, qw), kf = __builtin_bit_cast(bf16x8, kw), vf = __builtin_bit_cast(bf16x8, vw); \
                _Pragma("unroll") for (int nt = 0; nt < 2; ++nt) { const LAS unsigned char* wp = Lwif + (nt * 16 + tk) * MLP_WROW + cl * 2; \
                    accp[nt] = __builtin_amdgcn_mfma_f32_16x16x32_bf16(qf, *(const LAS bf16x8*)(wp), accp[nt], 0, 0, 0); \
                    accp[nt] = __builtin_amdgcn_mfma_f32_16x16x32_bf16(kf, *(const LAS bf16x8*)(wp + 1024), accp[nt], 0, 0, 0); \
                    accp[nt] = __builtin_amdgcn_mfma_f32_16x16x32_bf16(vf, *(const LAS bf16x8*)(wp + 2048), accp[nt], 0, 0, 0); } } while (0)
            MLP_LOAD(xrA, 0);
#pragma unroll 1
            for (int step = 0; step < 16; step += 2) {
                MLP_LOAD(xrB, step + 1);
                MLP_COMPUTE(xrA, step, true);
                { const int sn = (step + 2 < 16) ? step + 2 : 15; MLP_LOAD(xrA, sn); }
                MLP_COMPUTE(xrB, step + 1, false);
            }
#undef MLP_LOAD
#undef MLP_COMPUTE
#pragma unroll
            for (int nt = 0; nt < 2; ++nt)
#pragma unroll
                for (int e = 0; e < 4; ++e) pre_part[((size_t)hd * 32 + nt * 16 + tk) * MTOK + tr * 256 + tt * 16 + 4 * g + e] = accp[nt][e];
        }
    }
}

constexpr int ML_QS0 = 0, ML_KS0 = 16384, ML_QS1 = 32768, ML_KS1 = 49152, ML_VS0 = 65536, ML_VS1 = 81920, ML_WV = 98304, ML_SS = 114688, ML_SM = 123904;
constexpr int ML_XS = ML_QS1, ML_XN = ML_QS1;
constexpr int GB_U = 0, GB_MR = 64, GB_W = 128, GB_INT = 192, GB_BND = 256, GB_SC = 320;
constexpr int SM_DIN0 = 768, SM_DIN1 = 832, SM_NV = 896, SM_NVP = 1408, SM_DNQP = 3456, SM_GS = 3968, SM_CMX = 4000, SM_MC = 4032, SM_END = 4096;
static_assert(ML_SM + SM_END * 4 <= LDS_BYTES - 16, "mLSTM LDS");
constexpr float KSCALE = 0.04419417382415922f;

DI s16x4 tr_read(LAS unsigned char* p) { return __builtin_amdgcn_ds_read_tr16_b64_v4i16((LAS s16x4*)p); }
DI int dimg(int row, int ch) { return 2048 * (row >> 3) + 512 * (ch >> 2) + 64 * (row & 7) + 16 * ((ch & 3) ^ ((row >> 2) & 3)); }
DI bf16x8 frag_tr(LAS unsigned char* img, int k0, int c0, int lane) {
    const int h = lane >> 5, blk = (lane >> 4) & 1, q = (lane & 15) >> 2, p = lane & 3;
    const int row = k0 + 8 * h + q, ch = (c0 >> 3) + 2 * blk + (p >> 1), sub = 8 * (p & 1);
    const s16x4 lo = tr_read(img + dimg(row, ch) + sub), hi = tr_read(img + dimg(row + 4, ch) + sub);
    return __builtin_shufflevector(lo, hi, 0, 1, 2, 3, 4, 5, 6, 7);
}
#define MFMA32(a, b, c) __builtin_amdgcn_mfma_f32_32x32x16_bf16((a), (b), (c), 0, 0, 0)
DI void tr_batch4(bf16x8 (&f)[4], unsigned alo, unsigned ahi) {
    s16x4 l0, l1, l2, l3, h0, h1, h2, h3;
    asm volatile("ds_read_b64_tr_b16 %0, %8\n\tds_read_b64_tr_b16 %4, %9\n\tds_read_b64_tr_b16 %1, %8 offset:4096\n\tds_read_b64_tr_b16 %5, %9 offset:4096\n\t"
                 "ds_read_b64_tr_b16 %2, %8 offset:8192\n\tds_read_b64_tr_b16 %6, %9 offset:8192\n\tds_read_b64_tr_b16 %3, %8 offset:12288\n\tds_read_b64_tr_b16 %7, %9 offset:12288\n\t"
                 "s_waitcnt lgkmcnt(0)"
                 : "=&v"(l0), "=&v"(l1), "=&v"(l2), "=&v"(l3), "=&v"(h0), "=&v"(h1), "=&v"(h2), "=&v"(h3) : "v"(alo), "v"(ahi) : "memory");
    f[0] = __builtin_shufflevector(l0, h0, 0, 1, 2, 3, 4, 5, 6, 7); f[1] = __builtin_shufflevector(l1, h1, 0, 1, 2, 3, 4, 5, 6, 7);
    f[2] = __builtin_shufflevector(l2, h2, 0, 1, 2, 3, 4, 5, 6, 7); f[3] = __builtin_shufflevector(l3, h3, 0, 1, 2, 3, 4, 5, 6, 7);
}

DI void tr_issue4(s16x4& l0, s16x4& l1, s16x4& l2, s16x4& l3, s16x4& h0, s16x4& h1, s16x4& h2, s16x4& h3, unsigned alo, unsigned ahi) {
    asm volatile("ds_read_b64_tr_b16 %0, %8\n\tds_read_b64_tr_b16 %4, %9\n\tds_read_b64_tr_b16 %1, %8 offset:4096\n\tds_read_b64_tr_b16 %5, %9 offset:4096\n\t"
                 "ds_read_b64_tr_b16 %2, %8 offset:8192\n\tds_read_b64_tr_b16 %6, %9 offset:8192\n\tds_read_b64_tr_b16 %3, %8 offset:12288\n\tds_read_b64_tr_b16 %7, %9 offset:12288"
                 : "=&v"(l0), "=&v"(l1), "=&v"(l2), "=&v"(l3), "=&v"(h0), "=&v"(h1), "=&v"(h2), "=&v"(h3) : "v"(alo), "v"(ahi) : "memory");
}
DI void tr_wait8(s16x4& l0, s16x4& l1, s16x4& l2, s16x4& l3, s16x4& h0, s16x4& h1, s16x4& h2, s16x4& h3) {
    asm volatile("s_waitcnt lgkmcnt(0)" : "+v"(l0), "+v"(l1), "+v"(l2), "+v"(l3), "+v"(h0), "+v"(h1), "+v"(h2), "+v"(h3) :: "memory");
}
#define TR_CAT(f, l, h) do { f[0] = __builtin_shufflevector(l##0, h##0, 0, 1, 2, 3, 4, 5, 6, 7); f[1] = __builtin_shufflevector(l##1, h##1, 0, 1, 2, 3, 4, 5, 6, 7); \
        f[2] = __builtin_shufflevector(l##2, h##2, 0, 1, 2, 3, 4, 5, 6, 7); f[3] = __builtin_shufflevector(l##3, h##3, 0, 1, 2, 3, 4, 5, 6, 7); } while (0)

template <int I>
DI void ml_step(LAS unsigned char* lds, u32x4 (&Cp)[8][2], f32x16 (&num)[2], f32x16& Sacc, float& dnq, int tid, int lane, int wave, int gb) {
    asm volatile("" : "+v"(lane)); asm volatile("" : "+v"(tid));
    constexpr int QS = (I & 1) ? ML_QS1 : ML_QS0, KS = (I & 1) ? ML_KS1 : ML_KS0;
    const int r = lane & 31, h = lane >> 5, vt = wave & 3, dpar = wave >> 2;
    LAS float* SM = (LAS float*)(lds + ML_SM);
#define ML_SEC1 { const int wS = wave & 3, st = wS >> 1, tt1 = wS & 1, kh = wave >> 2; \
      if (!(st == 1 && tt1 == 0)) { \
        _Pragma("unroll") for (int ks = 0; ks < 4; ++ks) { const int kk = 4 * kh + ks; \
            const bf16x8 a = *(const LAS bf16x8*)(lds + KS + dimg(32 * st + r, 2 * kk + h)); \
            const bf16x8 b = *(const LAS bf16x8*)(lds + QS + dimg(32 * tt1 + r, 2 * kk + h)); \
            Sacc = MFMA32(a, b, Sacc); } } }
#define ML_SEC4 { _Pragma("unroll") for (int jj = 0; jj < 2; ++jj) { const int dl = dpar + 2 * jj; \
        _Pragma("unroll") for (int s2 = 0; s2 < 2; ++s2) { const bf16x8 a = __builtin_bit_cast(bf16x8, Cp[2 * I + jj][s2]); \
            _Pragma("unroll") for (int tt = 0; tt < 2; ++tt) { LAS unsigned char* qb = lds + QS + 8 * h; \
                const s16x4 lo = *(const LAS s16x4*)(qb + dimg(32 * tt + r, 4 * dl + 2 * s2)), hi = *(const LAS s16x4*)(qb + dimg(32 * tt + r, 4 * dl + 2 * s2 + 1)); \
                num[tt] = MFMA32(a, __builtin_shufflevector(lo, hi, 0, 1, 2, 3, 4, 5, 6, 7), num[tt]); } } } }
#define ML_UPD(jj_) { _Pragma("unroll") for (int s2 = 0; s2 < 2; ++s2) { const u32x4 o = Cp[2 * I + (jj_)][s2]; u32x4 n; \
            n.x = cvt_pk_bf16(bf_lo(o.x) * decay + U[8 * s2 + 0], bf_hi(o.x) * decay + U[8 * s2 + 1]); n.y = cvt_pk_bf16(bf_lo(o.y) * decay + U[8 * s2 + 2], bf_hi(o.y) * decay + U[8 * s2 + 3]); \
            n.z = cvt_pk_bf16(bf_lo(o.z) * decay + U[8 * s2 + 4], bf_hi(o.z) * decay + U[8 * s2 + 5]); n.w = cvt_pk_bf16(bf_lo(o.w) * decay + U[8 * s2 + 6], bf_hi(o.w) * decay + U[8 * s2 + 7]); \
            asm volatile("" : "+v"(n)); Cp[2 * I + (jj_)][s2] = n; } }
#define ML_SEC5 { const float decay = SM[gb + GB_SC + 0]; \
      const int blk = (lane >> 4) & 1, q = (lane & 15) >> 2, p = lane & 3, sub = 8 * (p & 1), rlo = 8 * h + q; \
      const unsigned ldsu = (unsigned)(size_t)lds; const int chB = 4 * vt + 2 * blk + (p >> 1), chA0 = 4 * dpar + 2 * blk + (p >> 1), chA1 = chA0 + 8; \
      s16x4 bl0, bl1, bl2, bl3, bh0, bh1, bh2, bh3, al0, al1, al2, al3, ah0, ah1, ah2, ah3, cl0, cl1, cl2, cl3, ch0, ch1, ch2, ch3; \
      tr_issue4(bl0, bl1, bl2, bl3, bh0, bh1, bh2, bh3, ldsu + ML_WV + dimg(rlo, chB) + sub, ldsu + ML_WV + dimg(rlo + 4, chB) + sub); \
      tr_issue4(al0, al1, al2, al3, ah0, ah1, ah2, ah3, ldsu + KS + dimg(rlo, chA0) + sub, ldsu + KS + dimg(rlo + 4, chA0) + sub); \
      tr_wait8(al0, al1, al2, al3, ah0, ah1, ah2, ah3); tr_wait8(bl0, bl1, bl2, bl3, bh0, bh1, bh2, bh3); \
      tr_issue4(cl0, cl1, cl2, cl3, ch0, ch1, ch2, ch3, ldsu + KS + dimg(rlo, chA1) + sub, ldsu + KS + dimg(rlo + 4, chA1) + sub); \
      bf16x8 Bf[4], Af[4]; TR_CAT(Bf, bl, bh); TR_CAT(Af, al, ah); \
      f32x16 U; \
      _Pragma("unroll") for (int e = 0; e < 16; ++e) U[e] = 0.f; \
      _Pragma("unroll") for (int ks = 0; ks < 4; ++ks) U = MFMA32(Af[ks], Bf[ks], U); \
      ML_UPD(0) \
      tr_wait8(cl0, cl1, cl2, cl3, ch0, ch1, ch2, ch3); TR_CAT(Af, cl, ch); \
      _Pragma("unroll") for (int e = 0; e < 16; ++e) U[e] = 0.f; \
      _Pragma("unroll") for (int ks = 0; ks < 4; ++ks) U = MFMA32(Af[ks], Bf[ks], U); \
      ML_UPD(1) }
#define ML_SECV { { const int t = tid & 63, dg = tid >> 6; \
      const u32x4 q0 = *(const LAS u32x4*)(lds + QS + dimg(t, 2 * dg)), q1 = *(const LAS u32x4*)(lds + QS + dimg(t, 2 * dg + 1)); \
      const LAS f32x4* nv = (const LAS f32x4*)(SM + SM_NV + 128 * I + 16 * dg); \
      const f32x4 n0 = nv[0], n1 = nv[1], n2 = nv[2], n3 = nv[3]; \
      dnq += bf_lo(q0.x) * n0.x + bf_hi(q0.x) * n0.y + bf_lo(q0.y) * n0.z + bf_hi(q0.y) * n0.w + bf_lo(q0.z) * n1.x + bf_hi(q0.z) * n1.y + bf_lo(q0.w) * n1.z + bf_hi(q0.w) * n1.w \
           + bf_lo(q1.x) * n2.x + bf_hi(q1.x) * n2.y + bf_lo(q1.y) * n2.z + bf_hi(q1.y) * n2.w + bf_lo(q1.z) * n3.x + bf_hi(q1.z) * n3.y + bf_lo(q1.w) * n3.z + bf_hi(q1.w) * n3.w; } \
    { const int dp = tid & 63, sg = tid >> 6; float a0 = 0.f, a1 = 0.f; \
      const f32x4 wA = *(const LAS f32x4*)(SM + gb + GB_W + 8 * sg), wB = *(const LAS f32x4*)(SM + gb + GB_W + 8 * sg + 4); const float ww[8] = {wA.x, wA.y, wA.z, wA.w, wB.x, wB.y, wB.z, wB.w}; \
      _Pragma("unroll") for (int s = 0; s < 8; ++s) { const unsigned kk2 = *(const LAS unsigned*)(lds + KS + dimg(8 * sg + s, dp >> 2) + 4 * (dp & 3)); a0 += ww[s] * bf_lo(kk2); a1 += ww[s] * bf_hi(kk2); } \
      ((LAS unsigned*)(SM + SM_NVP))[sg * 256 + 64 * I + dp] = cvt_pk_bf16(a0, a1); } }
    ML_SEC1 ML_SEC4 ML_SEC5 ML_SECV
#undef ML_SEC1
#undef ML_SEC4
#undef ML_UPD
#undef ML_SEC5
#undef ML_SECV
}

DI float lane_read(float v, int src_lane) { return __builtin_bit_cast(float, __builtin_amdgcn_ds_bpermute(src_lane << 2, __builtin_bit_cast(int, v))); }
DI void ml_scan(float li_, float lf_, float& u_, float& cm_, float& bs_, int lane) {
    bs_ = lf_;
#pragma unroll
    for (int o_ = 1; o_ < 64; o_ <<= 1) { const float t_ = lane_read(bs_, (lane - o_) & 63); if (lane >= o_) bs_ += t_; }
    u_ = li_ - bs_; cm_ = u_;
#pragma unroll
    for (int o_ = 1; o_ < 64; o_ <<= 1) { const float t_ = lane_read(cm_, (lane - o_) & 63); if (lane >= o_) cm_ = fmaxf(cm_, t_); }
}
DI void ml_gates(LAS float* SM, float u_, float cm_, float bs_, int gbn, float m_, float cmx_, int lane) {
    const float M_ = fmaxf(m_, cm_), Ml_ = fmaxf(m_, cmx_);
    SM[gbn + GB_U + lane] = u_; SM[gbn + GB_MR + lane] = M_; SM[gbn + GB_W + lane] = __expf(u_ - Ml_) * KSCALE; SM[gbn + GB_INT + lane] = __expf(m_ - M_); SM[gbn + GB_BND + lane] = __expf(-(bs_ + M_));
    if (lane == 0) SM[gbn + GB_SC + 0] = __expf(m_ - Ml_);
}

DI void ml_dma_piece(const bf16_t* colbase, int b, int dir, int tau0, LAS unsigned char* tile, int j, int lane) {
    const int pos = lane & 31, rin = pos >> 2, row = 8 * (j >> 1) + rin, ch = 4 * (2 * (j & 1) + (lane >> 5)) + ((pos & 3) ^ ((row >> 2) & 3));
    const int tau = tau0 + row; const size_t tok = (size_t)(b * SEQ + (dir ? SEQ - 1 - tau : tau));
    __builtin_amdgcn_global_load_lds((const unsigned*)(colbase + tok * 4096 + ch * 8), (LAS unsigned*)(tile + 1024 * j), 16, 0, 0);
}

DI void mlstm_phase(const bf16_t* Q, const bf16_t* Kb, const bf16_t* V, const float* pre_part, const float* b_if, float* GLF, bf16_t* HF, bf16_t* HB,
                    LAS unsigned char* lds, int G, int vcu0, int tid0, int lane0, int wave) {
    LAS float* SM = (LAS float*)(lds + ML_SM);
    const int vt = wave & 3, dpar = wave >> 2;
    for (int item = vcu0; item < 256; item += G) {
        const int vs = item & 3, stream = item >> 2, dir = stream & 1, hd = (stream >> 1) & 7, b = stream >> 4;
        bf16_t* H = dir ? HB : HF;
        float* glf = GLF + (size_t)item * 10240;
        const bf16_t* qcol = Q + hd * 512; const bf16_t* kcol = Kb + hd * 512; const bf16_t* vcol = V + hd * 512 + vs * 128;
        __syncthreads();
        int tidp = tid0, lanep = lane0; asm volatile("" : "+v"(tidp)); asm volatile("" : "+v"(lanep));
        for (int tau = tidp; tau < SEQ; tau += NTHREADS) {
            const int tok = b * SEQ + (dir ? SEQ - 1 - tau : tau);
            float li = b_if[dir * 16 + hd], lfr = b_if[dir * 16 + 8 + hd];
#pragma unroll
            for (int h8 = 0; h8 < 8; ++h8) { const float* pp = pre_part + ((size_t)h8 * 32 + dir * 16 + hd) * MTOK + tok; li += pp[0]; lfr += pp[(size_t)8 * MTOK]; }
            glf[tau] = li; glf[2048 + tau] = fminf(lfr, 0.f) - log1pf(__expf(-fabsf(lfr)));
        }
        SM[SM_NV + tidp] = 0.f;
        ml_dma_piece(qcol, b, dir, 0, lds + ML_QS0, 2 * wave, lanep); ml_dma_piece(qcol, b, dir, 0, lds + ML_QS0, 2 * wave + 1, lanep);
        ml_dma_piece(kcol, b, dir, 0, lds + ML_KS0, 2 * wave, lanep); ml_dma_piece(kcol, b, dir, 0, lds + ML_KS0, 2 * wave + 1, lanep);
        ml_dma_piece(vcol, b, dir, 0, lds + ML_VS0, 2 * wave, lanep); ml_dma_piece(vcol, b, dir, 0, lds + ML_VS0, 2 * wave + 1, lanep);
        asm volatile("s_waitcnt vmcnt(0)" ::: "memory");
        __syncthreads();
        float u0 = 0.f, cm0 = 0.f, bs0 = 0.f;
#pragma unroll 1
        for (int cc = wave; cc < 32; cc += 8) {
            const float lic = __hip_atomic_load(glf + 64 * cc + lanep, __ATOMIC_RELAXED, __HIP_MEMORY_SCOPE_AGENT), lfc = __hip_atomic_load(glf + 2048 + 64 * cc + lanep, __ATOMIC_RELAXED, __HIP_MEMORY_SCOPE_AGENT);
            float uu, cmm, bss; ml_scan(lic, lfc, uu, cmm, bss, lanep);
            glf[4096 + 64 * cc + lanep] = uu; glf[6144 + 64 * cc + lanep] = cmm; glf[8192 + 64 * cc + lanep] = bss;
            if (lanep == 63) { SM[SM_GS + cc] = bss; SM[SM_CMX + cc] = cmm; }
            if (cc == 0) { u0 = uu; cm0 = cmm; bs0 = bss; }
        }
        asm volatile("s_waitcnt vmcnt(0)" ::: "memory");
        __syncthreads();
        if (tidp == 0) { float m = 0.f;
#pragma unroll 1
            for (int cc = 0; cc < 32; ++cc) { SM[SM_MC + cc] = m; m = SM[SM_GS + cc] + fmaxf(m, SM[SM_CMX + cc]); } }
        __syncthreads();
        if (wave == 0) ml_gates(SM, u0, cm0, bs0, 0, 0.f, SM[SM_CMX + 0], lanep);
        __syncthreads();
#define ML_WRITE_WV(VS_, gbx_) do { const float w_ = SM[(gbx_) + GB_W + lrow]; \
        _Pragma("unroll") for (int hh_ = 0; hh_ < 2; ++hh_) { const int o_ = dimg(lrow, lcc + 8 * hh_); const u32x4 x_ = *(const LAS u32x4*)(lds + (VS_) + o_); u32x4 y_; \
            y_.x = cvt_pk_bf16(bf_lo(x_.x) * w_, bf_hi(x_.x) * w_); y_.y = cvt_pk_bf16(bf_lo(x_.y) * w_, bf_hi(x_.y) * w_); y_.z = cvt_pk_bf16(bf_lo(x_.z) * w_, bf_hi(x_.z) * w_); y_.w = cvt_pk_bf16(bf_lo(x_.w) * w_, bf_hi(x_.w) * w_); \
            *(LAS u32x4*)(lds + ML_WV + o_) = y_; } } while (0)
        { const int lrow = tidp >> 3, lcc = tidp & 7; ML_WRITE_WV(ML_VS0, 0); }
        u32x4 Cp[8][2];
#pragma unroll
        for (int j = 0; j < 8; ++j) { Cp[j][0] = (u32x4){0u, 0u, 0u, 0u}; Cp[j][1] = (u32x4){0u, 0u, 0u, 0u}; }
#pragma unroll 1
        for (int c = 0; c < 32; ++c) {
            int lane = lane0, tid = tid0; asm volatile("" : "+v"(lane)); asm volatile("" : "+v"(tid));
            const int r = lane & 31, h = lane >> 5, lrow = tid >> 3, lcc = tid & 7;
            const int gb = (c & 1) * 384, gbn = 384 - gb, cn = (c + 1 < 32) ? c + 1 : 31;
            const int VSc = (c & 1) ? ML_VS1 : ML_VS0, VSn = (c & 1) ? ML_VS0 : ML_VS1;
            f32x16 num[2], Sacc; float dnq = 0.f;
#pragma unroll
            for (int e = 0; e < 16; ++e) { num[0][e] = 0.f; num[1][e] = 0.f; Sacc[e] = 0.f; }
#define ML_DMA_QK(QS_, KS_, c_, i_) do { ml_dma_piece(qcol + 128 * (i_), b, dir, 64 * (c_), lds + (QS_), 2 * wave, lane); ml_dma_piece(qcol + 128 * (i_), b, dir, 64 * (c_), lds + (QS_), 2 * wave + 1, lane); \
                ml_dma_piece(kcol + 128 * (i_), b, dir, 64 * (c_), lds + (KS_), 2 * wave, lane); ml_dma_piece(kcol + 128 * (i_), b, dir, 64 * (c_), lds + (KS_), 2 * wave + 1, lane); } while (0)
            asm volatile("s_waitcnt vmcnt(0)" ::: "memory"); __syncthreads(); ML_DMA_QK(ML_QS1, ML_KS1, c, 1);  ml_step<0>(lds, Cp, num, Sacc, dnq, tid, lane, wave, gb);
            asm volatile("s_waitcnt vmcnt(0)" ::: "memory"); __syncthreads(); ML_DMA_QK(ML_QS0, ML_KS0, c, 2);  ml_step<1>(lds, Cp, num, Sacc, dnq, tid, lane, wave, gb);
            asm volatile("s_waitcnt vmcnt(0)" ::: "memory"); __syncthreads(); ML_DMA_QK(ML_QS1, ML_KS1, c, 3);  ml_step<2>(lds, Cp, num, Sacc, dnq, tid, lane, wave, gb);
            asm volatile("s_waitcnt vmcnt(0)" ::: "memory"); __syncthreads(); ML_DMA_QK(ML_QS0, ML_KS0, cn, 0);
            ml_dma_piece(vcol, b, dir, 64 * cn, lds + VSn, 2 * wave, lane); ml_dma_piece(vcol, b, dir, 64 * cn, lds + VSn, 2 * wave + 1, lane);
            ml_step<3>(lds, Cp, num, Sacc, dnq, tid, lane, wave, gb);
            asm volatile("s_waitcnt vmcnt(0)" ::: "memory");
            __syncthreads();
            float un = 0.f, cmn = 0.f, bsn = 0.f;
            if (wave == 0) { un = __hip_atomic_load(glf + 4096 + 64 * cn + lane, __ATOMIC_RELAXED, __HIP_MEMORY_SCOPE_AGENT); cmn = __hip_atomic_load(glf + 6144 + 64 * cn + lane, __ATOMIC_RELAXED, __HIP_MEMORY_SCOPE_AGENT);
                             bsn = __hip_atomic_load(glf + 8192 + 64 * cn + lane, __ATOMIC_RELAXED, __HIP_MEMORY_SCOPE_AGENT); }
            { LAS f32x4* xs = (LAS f32x4*)(lds + ML_XS) + (size_t)((wave & 3) * 4) * 64 + lane;
              if (wave >= 4) {
#pragma unroll
                for (int gq = 0; gq < 4; ++gq) xs[gq * 64] = (f32x4){Sacc[4 * gq], Sacc[4 * gq + 1], Sacc[4 * gq + 2], Sacc[4 * gq + 3]}; } }
            SM[SM_DNQP + (tid >> 6) * 64 + (tid & 63)] = dnq;
            __syncthreads();
            if (wave < 4) {
                const int st = wave >> 1, tt1 = wave & 1, t = 32 * tt1 + r;
                const LAS f32x4* xs = (const LAS f32x4*)(lds + ML_XS) + (size_t)(wave * 4) * 64 + lane;
                const float Mt = SM[gb + GB_MR + t]; float dsum = 0.f;
#pragma unroll
                for (int gq = 0; gq < 4; ++gq) {
                    const f32x4 px = xs[gq * 64]; const int s0 = 32 * st + 8 * gq + 4 * h; const f32x4 us = *(const LAS f32x4*)(SM + gb + GB_U + s0);
                    float vv[4];
#pragma unroll
                    for (int e = 0; e < 4; ++e) { const float raw = (Sacc[4 * gq + e] + px[e]) * KSCALE; vv[e] = (s0 + e <= t) ? raw * __expf(us[e] - Mt) : 0.f; dsum += vv[e]; }
                    u32x2 w; w.x = cvt_pk_bf16(vv[0], vv[1]); w.y = cvt_pk_bf16(vv[2], vv[3]);
                    *(LAS u32x2*)(lds + ML_SS + t * 144 + s0 * 2) = w;
                }
                dsum += __shfl_xor(dsum, 32);
                if (h == 0) SM[(st ? SM_DIN1 : SM_DIN0) + t] = dsum;
            }
#pragma unroll
            for (int tt = 0; tt < 2; ++tt) { const float it = SM[gb + GB_INT + 32 * tt + r]; num[tt] = num[tt] * it; }
            __syncthreads();
#pragma unroll
            for (int k2 = 0; k2 < 2; ++k2) { const int ks = 2 * dpar + k2;
                const bf16x8 a = frag_tr(lds + VSc, 16 * ks, 32 * vt, lane);
#pragma unroll
                for (int tt = 0; tt < 2; ++tt) { const bf16x8 bb = *(const LAS bf16x8*)(lds + ML_SS + (32 * tt + r) * 144 + (16 * ks + 8 * h) * 2); num[tt] = MFMA32(a, bb, num[tt]); } }
            __syncthreads();
            { LAS f32x4* xn = (LAS f32x4*)(lds + ML_XN) + (size_t)(vt * 8) * 64 + lane;
              if (dpar == 1) {
#pragma unroll
                for (int tt = 0; tt < 2; ++tt)
#pragma unroll
                    for (int gq = 0; gq < 4; ++gq) xn[(tt * 4 + gq) * 64] = (f32x4){num[tt][4 * gq], num[tt][4 * gq + 1], num[tt][4 * gq + 2], num[tt][4 * gq + 3]}; } }
            if (wave == 0) ml_gates(SM, un, cmn, bsn, gbn, SM[SM_MC + cn], SM[SM_CMX + cn], lane);
            __syncthreads();
            if (dpar == 0) {
                const LAS f32x4* xn = (const LAS f32x4*)(lds + ML_XN) + (size_t)(vt * 8) * 64 + lane;
#pragma unroll
                for (int tt = 0; tt < 2; ++tt) { const int t = 32 * tt + r; float nq = 0.f;
#pragma unroll
                    for (int gI = 0; gI < 8; ++gI) nq += SM[SM_DNQP + gI * 64 + t];
                    const float den = SM[SM_DIN0 + t] + SM[SM_DIN1 + t] + SM[gb + GB_INT + t] * nq;
                    const float inv = 1.0f / fmaxf(fabsf(den), SM[gb + GB_BND + t]);
                    const int tau = 64 * c + t; const size_t ob = (size_t)(b * SEQ + (dir ? SEQ - 1 - tau : tau)) * 4096 + hd * 512 + vs * 128 + 32 * vt + 4 * h;
#pragma unroll
                    for (int gq = 0; gq < 4; ++gq) { const f32x4 px = xn[(tt * 4 + gq) * 64];
                        u32x2 w; w.x = cvt_pk_bf16((num[tt][4 * gq] + px.x) * inv, (num[tt][4 * gq + 1] + px.y) * inv); w.y = cvt_pk_bf16((num[tt][4 * gq + 2] + px.z) * inv, (num[tt][4 * gq + 3] + px.w) * inv);
                        *(u32x2*)(H + ob + 8 * gq) = w; } }
            }
            ML_WRITE_WV(VSn, gbn);
            { const float decay = SM[gb + GB_SC + 0];
              float acc_ = 0.f; const LAS unsigned* np_ = (const LAS unsigned*)(SM + SM_NVP) + (tid >> 1);
#pragma unroll
              for (int sgx = 0; sgx < 8; ++sgx) { const unsigned pr_ = np_[sgx * 256]; acc_ += (tid & 1) ? bf_hi(pr_) : bf_lo(pr_); }
              SM[SM_NV + tid] = decay * SM[SM_NV + tid] + acc_; }
        }
#undef ML_DMA_QK
#undef ML_WRITE_WV
    }
}

DI void ml_combine_phase(const bf16_t* HF, const bf16_t* HB, const bf16_t* XC, const bf16_t* XZ, const float* norm_g, const float* skip, bf16_t* MO, int gw, int NGW, int lane) {
    for (int idx = gw; idx < MTOK * ML_HEADS; idx += NGW) {
        const int tok = idx >> 3, hd = idx & 7; const int ch = hd * 512 + 8 * lane; const size_t o4 = (size_t)tok * 4096 + ch;
        const u32x4 a = *(const u32x4*)(HF + o4), bq = *(const u32x4*)(HB + o4), xcv = *(const u32x4*)(XC + o4), zv = *(const u32x4*)(XZ + (size_t)tok * 8192 + 4096 + ch);
        float ht[8] = {bf_lo(a.x) + bf_lo(bq.x), bf_hi(a.x) + bf_hi(bq.x), bf_lo(a.y) + bf_lo(bq.y), bf_hi(a.y) + bf_hi(bq.y), bf_lo(a.z) + bf_lo(bq.z), bf_hi(a.z) + bf_hi(bq.z), bf_lo(a.w) + bf_lo(bq.w), bf_hi(a.w) + bf_hi(bq.w)};
        const float xc[8] = {bf_lo(xcv.x), bf_hi(xcv.x), bf_lo(xcv.y), bf_hi(xcv.y), bf_lo(xcv.z), bf_hi(xcv.z), bf_lo(xcv.w), bf_hi(xcv.w)};
        const float z[8] = {bf_lo(zv.x), bf_hi(zv.x), bf_lo(zv.y), bf_hi(zv.y), bf_lo(zv.z), bf_hi(zv.z), bf_lo(zv.w), bf_hi(zv.w)};
        float s = 0.f;
#pragma unroll
        for (int i = 0; i < 8; ++i) s += ht[i];
        const float mu = wave_sum(s) * (1.f / 512.f); float q = 0.f;
#pragma unroll
        for (int i = 0; i < 8; ++i) { ht[i] -= mu; q += ht[i] * ht[i]; }
        const float rstd = 1.0f / sqrtf(wave_sum(q) * (1.f / 512.f) + 1e-5f);
        const f32x4 g0 = *(const f32x4*)(norm_g + ch), g1 = *(const f32x4*)(norm_g + ch + 4), k0 = *(const f32x4*)(skip + ch), k1 = *(const f32x4*)(skip + ch + 4);
        const float gg[8] = {g0.x, g0.y, g0.z, g0.w, g1.x, g1.y, g1.z, g1.w}, sk[8] = {k0.x, k0.y, k0.z, k0.w, k1.x, k1.y, k1.z, k1.w};
        float o[8];
#pragma unroll
        for (int i = 0; i < 8; ++i) o[i] = (ht[i] * rstd * gg[i] + sk[i] * xc[i]) * sigmoid_f(z[i]);
        u32x4 w; w.x = cvt_pk_bf16(o[0], o[1]); w.y = cvt_pk_bf16(o[2], o[3]); w.z = cvt_pk_bf16(o[4], o[5]); w.w = cvt_pk_bf16(o[6], o[7]);
        *(u32x4*)(MO + o4) = w;
    }
}

DI void moe_offsets(const unsigned* ecnt, int (&cnt)[8], int (&off)[8], int& ntiles) {
    int acc = 0;
#pragma unroll
    for (int e = 0; e < 8; ++e) { cnt[e] = (int)ecnt[64 * e]; off[e] = acc * 256; acc += (cnt[e] + 255) >> 8; }
    ntiles = acc;
}
DI void moe_split_plan(int ntiles, int& nMf, int& nT, int& S) {
    nMf = (ntiles >> 5) << 5; nT = ntiles - nMf; S = 1;
    if (nT > 0) { S = (nT <= 4) ? 7 : (nT <= 8) ? 4 : (nT <= 16) ? 2 : 1; }
    if (S == 1) { nMf = ntiles; nT = 0; }
}
DI pg8::TileMap moe_tilemap(const int (&cnt)[8]) { pg8::TileMap tm; int acc = 0; tm.toff[0] = 0;
#pragma unroll
    for (int e = 0; e < 8; ++e) { acc += (cnt[e] + 255) >> 8; tm.toff[e + 1] = acc; }
    return tm; }
DI void moe_scatter_phase(const unsigned char* HA, unsigned char* HS, const int* tok_e, const int* tok_pos, int* slot_row, const unsigned* ecnt, int* tile_e, int gw, int NGW, int lane) {
    int cnt[8], off[8], ntiles; moe_offsets(ecnt, cnt, off, ntiles);
    if (gw == 0 && lane < 8) { const int e = lane; const int t0 = off[e] >> 8, nt = (cnt[e] + 255) >> 8; for (int t = 0; t < nt; ++t) tile_e[t0 + t] = e; }
    for (int id = gw; id < 2 * MTOK; id += NGW) {
        const int e = tok_e[id], pos = tok_pos[id]; int o = 0;
#pragma unroll
        for (int q = 0; q < 8; ++q) o = (e == q) ? off[q] : o;
        const int row = o + pos;
        if (lane == 0) slot_row[id] = row;
        const u32x4* src = (const u32x4*)(HA + (size_t)(id >> 1) * DM) + lane; u32x4* dst = (u32x4*)(HS + (size_t)row * DM) + lane;
#pragma unroll
        for (int j = 0; j < 2; ++j) dst[64 * j] = src[64 * j];
    }
#pragma unroll 1
    for (int e = 0; e < 8; ++e) { int c = 0, o = 0;
#pragma unroll
        for (int q = 0; q < 8; ++q) { c = (e == q) ? cnt[q] : c; o = (e == q) ? off[q] : o; }
        const int pend = ((c + 255) >> 8) << 8;
        for (int p = c + gw; p < pend; p += NGW) { u32x4* dst = (u32x4*)(HS + (size_t)(o + p) * DM) + lane;
#pragma unroll
            for (int j = 0; j < 2; ++j) dst[64 * j] = (u32x4){0u, 0u, 0u, 0u}; } }
}

DI f32x4 moe_yrow(const bf16_t* YS, const bf16_t* YSP, int r, int rsplit, int S, int nrs, int lane, int j) {
    if (r < rsplit) { const u32x2 a = ((const u32x2*)(YS + (size_t)r * DM) + lane)[64 * j]; return (f32x4){bf_lo(a.x), bf_hi(a.x), bf_lo(a.y), bf_hi(a.y)}; }
    f32x4 acc = (f32x4){0.f, 0.f, 0.f, 0.f};
    for (int s2 = 0; s2 < S; ++s2) { const u32x2 a = ((const u32x2*)(YSP + ((size_t)s2 * nrs + (r - rsplit)) * DM) + lane)[64 * j]; acc += (f32x4){bf_lo(a.x), bf_hi(a.x), bf_lo(a.y), bf_hi(a.y)}; }
    return acc;
}
DI void moe_combine_phase(const float* X3, const bf16_t* YS, const int* tok_e, const int* tok_pos, const float* tok_w, const float* gate, float* out, const unsigned* ecnt, int gw, int NGW, int lane) {
    int cnt[8], off[8], ntiles; moe_offsets(ecnt, cnt, off, ntiles);
    int nMf, nT, S; moe_split_plan(ntiles, nMf, nT, S); const int rsplit = nMf * 256; const bf16_t* YSP = YS + (size_t)MPAD * DM;
    for (int tok = gw; tok < MTOK; tok += NGW) {
        const int e0 = tok_e[2 * tok], e1 = tok_e[2 * tok + 1]; int o0 = 0, o1 = 0;
#pragma unroll
        for (int q = 0; q < 8; ++q) { o0 = (e0 == q) ? off[q] : o0; o1 = (e1 == q) ? off[q] : o1; }
        const int r0 = o0 + tok_pos[2 * tok], r1 = o1 + tok_pos[2 * tok + 1]; const float w0 = tok_w[2 * tok], w1 = tok_w[2 * tok + 1];
        const f32x4* x = (const f32x4*)(X3 + (size_t)tok * DM) + lane;
        const f32x4* gp = (const f32x4*)(gate + (size_t)(tok >> 11) * 12288) + lane; f32x4* o = (f32x4*)(out + (size_t)tok * DM) + lane;
#pragma unroll
        for (int j = 0; j < 8; ++j) { const f32x4 ya = moe_yrow(YS, YSP, r0, rsplit, S, nT * 256, lane, j), yb = moe_yrow(YS, YSP, r1, rsplit, S, nT * 256, lane, j);
            o[64 * j] = x[64 * j] + gp[64 * j] * (ya * w0 + yb * w1); }
    }
}

struct Params { const float* in[29]; float* out; unsigned char* ws; int ph_lo, ph_hi; };
static_assert(sizeof(Params) == 31 * 8 + 8, "Params has padding");
constexpr int NPHASE = 20;

#if DBG
#include "dbg_checks.inc"
#endif

__global__ void __launch_bounds__(NTHREADS, 2) mega_fwd(Params p) {
    extern __shared__ __attribute__((aligned(16))) unsigned char lds_raw[];
    LAS unsigned char* lds = (LAS unsigned char*)lds_raw;
    const int tid = threadIdx.x, lane = tid & 63, wave = __builtin_amdgcn_readfirstlane(tid >> 6);
    const int G = gridDim.x, gw = blockIdx.x * NWAVES + wave, NGW = G * NWAVES;
    const int vcu = (G % 8 == 0) ? (int)(blockIdx.x % 8) * (G / 8) + (int)(blockIdx.x / 8) : (int)blockIdx.x;
    const int gwx = vcu * NWAVES + wave;
    unsigned char* ws = p.ws;
    unsigned* ctl = (unsigned*)(ws + WS_CTL);
    volatile LAS unsigned* xbw = (volatile LAS unsigned*)(lds + LDS_BYTES - 16);
    if (tid == 0) { xbw[0] = 0u; xbw[1] = 0u; xbw[2] = 0u; xbw[3] = 0u; }
    __syncthreads();
    XcdBarrier bar = xcd_barrier_post(ctl + CW_BAR, xbw);
    const int lo = p.ph_lo, hi = p.ph_hi;
#ifndef PH_MASK
#define PH_MASK 0xFFFFFFu
#endif
#define IN(k) (((PH_MASK >> (k)) & 1u) && lo <= (k) && (k) < hi)
#define SEAM(k) do { if (IN((k) + 1)) xcd_barrier(bar); } while (0)
#ifndef REP_MASK
#define REP_MASK 0u
#endif
#define PHASE(k, ...) if (IN(k)) { { __VA_ARGS__ } if ((REP_MASK >> (k)) & 1u) { __syncthreads(); { __VA_ARGS__ } } SEAM(k); }

    float* mod = (float*)(ws + WS_MOD);
    float* pre_part = (float*)(ws + WS_PRE);
    int* tok_e = (int*)(ws + WS_ROUTE); int* tok_pos = tok_e + 2 * MTOK; float* tok_w = (float*)(tok_pos + 2 * MTOK); int* slot_row = (int*)(tok_w + 2 * MTOK);
    unsigned* ecnt = ctl + CW_ECNT; int* tile_e = (int*)(ctl + 12288);
    bf16_t* HA = (bf16_t*)(ws + WS_HA); float* X1 = (float*)(ws + WS_X1); float* X2 = (float*)(ws + WS_X2);
    bf16_t* WT_IN = (bf16_t*)(ws + WS_WT_IN); bf16_t* WT_OUT = (bf16_t*)(ws + WS_WT_OUT); bf16_t* WT_GU = (bf16_t*)(ws + WS_WT_GU); bf16_t* WT_DN = (bf16_t*)(ws + WS_WT_DN);
    bf16_t* WT_MLIN = (bf16_t*)(ws + WS_WT_MLIN); bf16_t* WT_MLOUT = (bf16_t*)(ws + WS_WT_MLOUT); bf16_t* WT_IF = (bf16_t*)(ws + WS_WT_IF);
    unsigned char* WT_MGU = ws + WS_WT_MGU; unsigned char* WT_MD = ws + WS_WT_MD;
    bf16_t* QK = (bf16_t*)(ws + A_QK); bf16_t* QKN = (bf16_t*)(ws + A_QKN); bf16_t* VT = (bf16_t*)(ws + A_VT); bf16_t* ATT = (bf16_t*)(ws + A_ATT); bf16_t* ACT = (bf16_t*)(ws + A_ACT);
    bf16_t* XZ = (bf16_t*)(ws + A_XZ); bf16_t* XC = (bf16_t*)(ws + A_XC); bf16_t* Qm = (bf16_t*)(ws + A_Q); bf16_t* Km = (bf16_t*)(ws + A_K); bf16_t* Vm = (bf16_t*)(ws + A_V);
    bf16_t* HF = (bf16_t*)(ws + A_HF); bf16_t* HB = (bf16_t*)(ws + A_HB); bf16_t* MO = (bf16_t*)(ws + A_MO);
    unsigned char* HS = ws + A_HS; unsigned char* ACTM = ws + A_ACTM; float* YS = (float*)(ws + A_YS);
    const float* x_in = p.in[0];

    PHASE(0,
        mod_phase(p.in[1], p.in[2], p.in[3], mod, lds, G, tid, lane, wave);
        LAS float* scrw = (LAS float*)lds + wave * (64 * 65);
        cvtw_job<0, false>(p.in[6], 2048, 6144, 1, WT_IN, 0, scrw, gw, NGW, lane, 1.f);
        cvtw_job<0, false>(p.in[10], 2048, 2048, 1, WT_OUT, 0, scrw, gw, NGW, lane, 1.f);
        cvtw_job<1, false>(p.in[11], 2048, FFN, 1, WT_GU, 0, scrw, gw, NGW, lane, 1.f);
        cvtw_job<2, false>(p.in[12], 2048, FFN, 1, WT_GU, 0, scrw, gw, NGW, lane, 1.f);
        cvtw_job<0, false>(p.in[13], FFN, 2048, 1, WT_DN, 0, scrw, gw, NGW, lane, 1.f);
        cvtw_job<0, false>(p.in[14], 2048, 8192, 1, WT_MLIN, 0, scrw, gw, NGW, lane, 1.f);
        cvtw_job<0, false>(p.in[24], 4096, 2048, 1, WT_MLOUT, 0, scrw, gw, NGW, lane, 1.f);
        cvt_job<0>(p.in[20], 12288, 32, 1, WT_IF, 0, scrw, gw, NGW, lane);
        cvtw_job<1, true>(p.in[26], 2048, EDIM, 8, WT_MGU, (size_t)14336 * 2048, scrw, gw, NGW, lane, WSCALE);
        cvtw_job<2, true>(p.in[27], 2048, EDIM, 8, WT_MGU, (size_t)14336 * 2048, scrw, gw, NGW, lane, WSCALE);
        cvtw_job<0, true>(p.in[28], EDIM, 2048, 8, WT_MD, (size_t)2048 * EDIM, scrw, gw, NGW, lane, WSCALE); )
    PHASE(1,  rms_mod_phase<false>(x_in, p.in[4], mod + 1 * 2048, mod + 0 * 2048, HA, nullptr, nullptr, nullptr, nullptr, nullptr, nullptr, gw, NGW, lane); )
    PHASE(2,
        { pg8::Gemm g{HA, WT_IN, MTOK, 4096, 2048, 0}; pg8::StaticOrder S; S.init(MTOK, 4096, G, (int)blockIdx.x); pg8::EpiQKNorm E{QKN, 4096, p.in[7], p.in[8]}; pg8::gemm_phase(lds, g, S, E); }
        { pg8::Gemm g{WT_IN + (size_t)4096 * 2048, HA, 2048, MTOK, 2048, 0}; pg8::StaticOrder S; S.init(2048, MTOK, G, (int)blockIdx.x); pg8::EpiBf16 E{VT, MTOK}; pg8::gemm_phase(lds, g, S, E); } )
    PHASE(4,  na_phase(QKN, VT, ATT, p.in[9], lds, G, vcu, tid, lane, wave); )
    PHASE(5,  pg8::Gemm g{ATT, WT_OUT, MTOK, 2048, 2048, 0}; pg8::StaticOrder S; S.init(MTOK, 2048, G, (int)blockIdx.x); pg8::EpiResGate E{x_in, X1, DM, mod + 2 * 2048, 12288}; pg8::gemm_phase(lds, g, S, E); )
    PHASE(6,  rms_mod_phase<false>(X1, p.in[5], mod + 4 * 2048, mod + 3 * 2048, HA, nullptr, nullptr, nullptr, nullptr, nullptr, nullptr, gw, NGW, lane); )
    PHASE(7,  pg8::Gemm g{HA, WT_GU, MTOK, 2 * FFN, 2048, 0}; pg8::StaticOrder S; S.init(MTOK, 2 * FFN, G, (int)blockIdx.x); pg8::EpiSwiGLU E{ACT, FFN}; pg8::gemm_phase(lds, g, S, E); )
    PHASE(8,  pg8::Gemm g{ACT, WT_DN, MTOK, 2048, FFN, 0}; pg8::StaticOrder S; S.init(MTOK, 2048, G, (int)blockIdx.x); pg8::EpiResGate E{X1, X2, DM, mod + 5 * 2048, 12288}; pg8::gemm_phase(lds, g, S, E); )
    PHASE(9,  rms_mod_phase<false>(X2, p.in[4] + DM, mod + 4 * 12288 + 1 * 2048, mod + 4 * 12288 + 0 * 2048, HA, nullptr, nullptr, nullptr, nullptr, nullptr, nullptr, gw, NGW, lane); )
    PHASE(10,  pg8::Gemm g{HA, WT_MLIN, MTOK, 8192, 2048, 0}; pg8::StaticOrder S; S.init(MTOK, 8192, G, (int)blockIdx.x); pg8::EpiBf16 E{XZ, 8192}; pg8::gemm_phase(lds, g, S, E); )
    PHASE(11,  ml_pre_phase(XZ, p.in[15], p.in[16], p.in[17], p.in[18], p.in[19], WT_IF, XC, Qm, Km, Vm, pre_part, lds, G, tid, lane, wave); )
    PHASE(12,  mlstm_phase(Qm, Km, Vm, pre_part, p.in[21], (float*)(ws + WS_GLF), HF, HB, lds, G, vcu, tid, lane, wave); )
    PHASE(13,  ml_combine_phase(HF, HB, XC, XZ, p.in[23], p.in[22], MO, gw, NGW, lane); )
    PHASE(14,  pg8::Gemm g{MO, WT_MLOUT, MTOK, 2048, 4096, 0}; pg8::StaticOrder S; S.init(MTOK, 2048, G, (int)blockIdx.x); pg8::EpiResGate E{X2, X1, DM, mod + 4 * 12288 + 2 * 2048, 12288}; pg8::gemm_phase(lds, g, S, E); )
    PHASE(15,  rms_mod_phase<true>(X1, p.in[5] + DM, mod + 4 * 12288 + 4 * 2048, mod + 4 * 12288 + 3 * 2048, HA, p.in[25], tok_e, tok_pos, tok_w, ecnt, HS, gw, NGW, lane); )
    PHASE(17,  int cnt[8], off[8], ntiles; moe_offsets(ecnt, cnt, off, ntiles);
        pg8::Gemm g{HS, WT_MGU, ntiles * 256, 2 * EDIM, 2048, 0}; pg8::MoeOrder S; S.init(ntiles, 2 * EDIM, G, (int)blockIdx.x, moe_tilemap(cnt), (size_t)14336 * 2048, (size_t)DM);
        pg8::EpiSwiGLU8 E{ACTM, EDIM, 1.0f / (HSCALE * WSCALE), ASCALE}; pg8::gemm_phase<pg8::EpiSwiGLU8, pg8::MoeOrder, true>(lds, g, S, E); )
    PHASE(18,  int cnt[8], off[8], ntiles; moe_offsets(ecnt, cnt, off, ntiles);
        pg8::Gemm g{ACTM, WT_MD, ntiles * 256, 2048, EDIM, 0};
        int nMf, nT, SS; moe_split_plan(ntiles, nMf, nT, SS); bf16_t* YSP = (bf16_t*)YS + (size_t)MPAD * DM;
        { pg8::MoeRowOrder S1; S1.init(nMf, G, (int)blockIdx.x, moe_tilemap(cnt), (size_t)2048 * EDIM); pg8::EpiBf16S E{(bf16_t*)YS, DM, 1.0f / (ASCALE * WSCALE), 0}; pg8::gemm_phase<pg8::EpiBf16S, pg8::MoeRowOrder, true>(lds, g, S1, E); }
        if (nT > 0) { pg8::Gemm g2 = g; g2.ntk = 56 / SS; pg8::MoeSplitOrder S2; S2.init(nMf, nT, SS, (size_t)(EDIM / SS), (int)blockIdx.x, moe_tilemap(cnt), (size_t)2048 * EDIM);
            pg8::EpiBf16S E2{YSP - (size_t)nMf * 256 * DM, DM, 1.0f / (ASCALE * WSCALE), (size_t)nT * 256 * DM}; pg8::gemm_phase<pg8::EpiBf16S, pg8::MoeSplitOrder, true>(lds, g2, S2, E2); } )
    PHASE(19,  moe_combine_phase(X1, (const bf16_t*)YS, tok_e, tok_pos, tok_w, mod + 4 * 12288 + 5 * 2048, p.out, ecnt, gw, NGW, lane); )
#undef IN
#undef SEAM
#undef PHASE
}

extern "C" void kernel_launch(void* const* d_in, const int* in_sizes, int n_in, void* d_out, int out_size, void* d_ws, size_t ws_size, hipStream_t stream) {
    static int grid = 0;
    if (grid == 0) {
        if (n_in != 29 || out_size != MTOK * DM || ws_size < WS_END) { fprintf(stderr, "kernel_launch: unexpected shapes (n_in %d out %d ws %zu need %zu)\n", n_in, out_size, ws_size, (size_t)WS_END); grid = -1; return; }
        int dev = 0, cus = 0, per_cu = 0;
        if (hipGetDevice(&dev) != hipSuccess || hipDeviceGetAttribute(&cus, hipDeviceAttributeMultiprocessorCount, dev) != hipSuccess) { grid = -1; return; }
        if (hipFuncSetAttribute((const void*)mega_fwd, hipFuncAttributeMaxDynamicSharedMemorySize, LDS_BYTES) != hipSuccess) { fprintf(stderr, "kernel_launch: hipFuncSetAttribute failed\n"); grid = -1; return; }
        if (hipOccupancyMaxActiveBlocksPerMultiprocessor(&per_cu, (const void*)mega_fwd, NTHREADS, LDS_BYTES) != hipSuccess || per_cu < 1) { fprintf(stderr, "kernel_launch: occupancy query says %d\n", per_cu); (void)hipGetLastError(); per_cu = 1; }
        grid = cus;
    }
    if (grid < 0) return;
    (void)hipMemsetAsync((char*)d_ws + WS_CTL, 0, CTL_BYTES, stream);
    Params p{};
    for (int i = 0; i < 29; ++i) p.in[i] = (const float*)d_in[i];
    p.out = (float*)d_out; p.ws = (unsigned char*)d_ws;
#if N_LAUNCH_SPLIT
    for (int k = 0; k < NPHASE; ++k) { p.ph_lo = k; p.ph_hi = k + 1; hipLaunchKernelGGL(mega_fwd, dim3(grid), dim3(NTHREADS), LDS_BYTES, stream, p); }
#else
    p.ph_lo = 0; p.ph_hi = NPHASE;
    hipLaunchKernelGGL(mega_fwd, dim3(grid), dim3(NTHREADS), LDS_BYTES, stream, p);
#endif
}
```

```cpp
#include <hip/hip_runtime.h>
#include <cstdio>
#include <cstdint>

#ifndef DBG
#define DBG 0
#endif
#ifndef N_LAUNCH_SPLIT
#define N_LAUNCH_SPLIT 0
#endif

#define LAS __attribute__((address_space(3)))
#define GAS __attribute__((address_space(1)))
#define DI __device__ __forceinline__
typedef unsigned short bf16_t;
typedef short bf16x8 __attribute__((ext_vector_type(8)));
typedef short s16x4 __attribute__((ext_vector_type(4)));
typedef float f32x2 __attribute__((ext_vector_type(2)));
typedef float f32x4 __attribute__((ext_vector_type(4)));
typedef float f32x16 __attribute__((ext_vector_type(16)));
typedef unsigned u32x2 __attribute__((ext_vector_type(2)));
typedef unsigned u32x4 __attribute__((ext_vector_type(4)));
typedef int i32x4 __attribute__((ext_vector_type(4)));
typedef int i32x8 __attribute__((ext_vector_type(8)));

constexpr int BATCH = 4, SEQ = 2048, DM = 2048, MTOK = BATCH * SEQ;
constexpr int GRID_W = 64, NA_HEADS = 16, NA_HD = 128;
constexpr int ML_INNER = 4096, ML_HEADS = 8, ML_HD = 512;
constexpr int FFN = 5632, NEXP = 8, EDIM = 7168;
constexpr int MPAD = 2 * MTOK + NEXP * 256;
constexpr int NTHREADS = 512, NWAVES = 8;
constexpr int LDS_BYTES = 147456;

constexpr size_t al256(size_t x) { return (x + 255) & ~(size_t)255; }
constexpr size_t WS_CTL = 0;
constexpr size_t CTL_BYTES = 65536;
constexpr size_t WS_MOD = WS_CTL + CTL_BYTES;
constexpr size_t WS_PRE = WS_MOD + al256((size_t)2 * 4 * 12288 * 4);
constexpr size_t WS_ROUTE = WS_PRE + (size_t)8 * MTOK * 32 * 4;
constexpr size_t WS_GLF = WS_ROUTE + (size_t)4 * MTOK * 2 * 4;
constexpr size_t WS_HA = WS_GLF + (size_t)256 * 10240 * 4;
constexpr size_t WS_X1 = WS_HA + (size_t)MTOK * DM * 2;
constexpr size_t WS_X2 = WS_X1 + (size_t)MTOK * DM * 4;
constexpr size_t WS_WT_IN = WS_X2 + (size_t)MTOK * DM * 4;
constexpr size_t WS_WT_OUT = WS_WT_IN + (size_t)6144 * 2048 * 2;
constexpr size_t WS_WT_GU = WS_WT_OUT + (size_t)2048 * 2048 * 2;
constexpr size_t WS_WT_DN = WS_WT_GU + (size_t)11264 * 2048 * 2;
constexpr size_t WS_WT_MLIN = WS_WT_DN + (size_t)2048 * 5632 * 2;
constexpr size_t WS_WT_MLOUT = WS_WT_MLIN + (size_t)8192 * 2048 * 2;
constexpr size_t WS_WT_IF = WS_WT_MLOUT + (size_t)2048 * 4096 * 2;
constexpr size_t WS_WT_MGU = WS_WT_IF + (size_t)32 * 12288 * 2;
constexpr size_t WS_WT_MD = WS_WT_MGU + (size_t)8 * 14336 * 2048;
constexpr size_t WS_ARENA = WS_WT_MD + (size_t)8 * 2048 * 7168;
constexpr size_t A_QK = WS_ARENA;
constexpr size_t A_QKN = A_QK + (size_t)MTOK * 4096 * 2;
constexpr size_t A_VT = A_QKN + (size_t)MTOK * 4096 * 2;
constexpr size_t A_ATT = A_VT + (size_t)2048 * MTOK * 2;
constexpr size_t A_ACT = A_ATT + (size_t)MTOK * DM * 2;
constexpr size_t A_L0_END = A_ACT + (size_t)MTOK * FFN * 2;
constexpr size_t A_XZ = WS_ARENA;
constexpr size_t A_XC = A_XZ + (size_t)MTOK * 8192 * 2;
constexpr size_t A_Q = A_XC + (size_t)MTOK * 4096 * 2;
constexpr size_t A_K = A_Q + (size_t)MTOK * 4096 * 2;
constexpr size_t A_V = A_K + (size_t)MTOK * 4096 * 2;
constexpr size_t A_HF = A_V + (size_t)MTOK * 4096 * 2;
constexpr size_t A_HB = A_HF + (size_t)MTOK * 4096 * 2;
constexpr size_t A_MO = A_HB + (size_t)MTOK * 4096 * 2;
constexpr size_t A_L1_END = A_MO + (size_t)MTOK * 4096 * 2;
constexpr size_t A_HS = WS_ARENA;
constexpr size_t A_ACTM = A_HS + (size_t)8 * 8192 * DM;
constexpr size_t A_YS = A_ACTM + (size_t)MPAD * EDIM;
constexpr size_t A_L2_END = A_YS + (size_t)MPAD * DM * 4;
constexpr size_t cmax(size_t a, size_t b) { return a > b ? a : b; }
constexpr size_t WS_END = cmax(cmax(A_L0_END, A_L1_END), A_L2_END);

constexpr int CW_BAR = 0;
constexpr int CW_ECNT = 4096;
constexpr int CW_DBG = 8192;

typedef __bf16 bf16x2_t __attribute__((ext_vector_type(2)));
DI unsigned cvt_pk_bf16(float lo, float hi) { const f32x2 v = {lo, hi}; return __builtin_bit_cast(unsigned, __builtin_convertvector(v, bf16x2_t)); }
DI float clamp448(float x) { return __builtin_fminf(__builtin_fmaxf(x, -448.f), 448.f); }
DI unsigned pk4_fp8(float a, float b, float c, float d) {
    int p = 0; p = __builtin_amdgcn_cvt_pk_fp8_f32(clamp448(a), clamp448(b), p, false); p = __builtin_amdgcn_cvt_pk_fp8_f32(clamp448(c), clamp448(d), p, true); return (unsigned)p; }
DI float bf_lo(unsigned u) { return __uint_as_float(u << 16); }
DI float bf_hi(unsigned u) { return __uint_as_float(u & 0xffff0000u); }
DI float bf2f(bf16_t b) { return __uint_as_float(((unsigned)b) << 16); }
DI bf16_t f2bf(float f) { return (bf16_t)(cvt_pk_bf16(f, 0.f) & 0xffffu); }
DI float wave_sum(float v) {
#pragma unroll
    for (int o = 1; o < 64; o <<= 1) v += __shfl_xor(v, o);
    return v;
}
DI float wave_max(float v) {
#pragma unroll
    for (int o = 1; o < 64; o <<= 1) v = fmaxf(v, __shfl_xor(v, o));
    return v;
}
DI float silu_f(float x) { return x / (1.f + __expf(-x)); }
DI float sigmoid_f(float x) { return 1.f / (1.f + __expf(-x)); }
#define LDS_WAIT() asm volatile("s_waitcnt lgkmcnt(0)" ::: "memory")
#define VM_WAIT() asm volatile("s_waitcnt vmcnt(0)" ::: "memory")

#define XB_TMO      128
#define XB_XCNT(j)  (256  + 64 * (j))
#define XB_XSUB(j)  (1280 + 64 * (j))
#define XB_XGEN(j)  (2304 + 64 * (j))
#define XB_TOP      3328
#define XB_TOPGEN   3392
#define XCD_BAR_WORDS 3456
#define XB_SPIN_CAP (1u << 22)

__device__ __forceinline__ unsigned xb_ld(unsigned* p)              { return __hip_atomic_load(p, __ATOMIC_RELAXED, __HIP_MEMORY_SCOPE_AGENT); }
__device__ __forceinline__ unsigned xb_add(unsigned* p, unsigned v) { return __hip_atomic_fetch_add(p, v, __ATOMIC_RELAXED, __HIP_MEMORY_SCOPE_AGENT); }
__device__ __forceinline__ unsigned xb_xcc_id() { return (unsigned)__builtin_amdgcn_s_getreg((3 << 11) | 20) & 0xFu; }
#define XB_SPIN(cond, bar) do { unsigned _sp = 0; while (cond) { __builtin_amdgcn_s_sleep(1); \
    if ((++_sp & 255u) == 0u) { if (xb_ld(&(bar)[XB_TMO])) break; if (_sp > XB_SPIN_CAP) { atomicAdd(&(bar)[XB_TMO], 1u); break; } } } } while (0)

struct XcdBarrier { unsigned* bar; unsigned x; volatile LAS unsigned* st; };

__device__ __forceinline__ XcdBarrier xcd_barrier_post(unsigned* bar, volatile LAS unsigned* st) {
    XcdBarrier b; b.bar = bar; b.x = xb_xcc_id(); b.st = st;
    if (threadIdx.x == 0) (void)xb_add(&bar[XB_XCNT(b.x)], 1u);
    return b;
}
__device__ __forceinline__ void xcd_barrier_complete(unsigned* bar, unsigned x, unsigned& nloc, unsigned& nx) {
    const unsigned G = gridDim.x * gridDim.y * gridDim.z;
    unsigned sum, cnt, mine, sp = 0u;
    for (;;) {
        sum = 0u; cnt = 0u; mine = 0u;
#pragma unroll
        for (unsigned j = 0; j < 16; ++j) { const unsigned c = xb_ld(&bar[XB_XCNT(j)]); sum += c; cnt += (c > 0u) ? 1u : 0u; mine = (j == x) ? c : mine; }
        if (sum == G) break;
        __builtin_amdgcn_s_sleep(1);
        if ((++sp & 255u) == 0u) { if (xb_ld(&bar[XB_TMO])) break; if (sp > XB_SPIN_CAP) { atomicAdd(&bar[XB_TMO], 1u); break; } }
    }
    nloc = mine > 0u ? mine : 1u; nx = cnt > 0u ? cnt : 1u;
}
__device__ __forceinline__ void xcd_barrier(const XcdBarrier& b) {
    asm volatile("s_waitcnt vmcnt(0)" ::: "memory");
    __syncthreads();
    if (threadIdx.x == 0) {
        unsigned* bar = b.bar;
        __builtin_amdgcn_s_waitcnt(0);
        unsigned nloc = b.st[0], nx = b.st[1];
        if (nloc == 0u) { xcd_barrier_complete(bar, b.x, nloc, nx); b.st[0] = nloc; b.st[1] = nx; }
        const unsigned old = xb_add(&bar[XB_XSUB(b.x)], 1u);
        const unsigned gen = old / nloc;
        if (old + 1u == (gen + 1u) * nloc) {
            __builtin_amdgcn_fence(__ATOMIC_RELEASE, "agent");
            asm volatile("s_waitcnt vmcnt(0)" ::: "memory");
            const unsigned og = xb_add(&bar[XB_TOP], 1u);
            const unsigned tg = og / nx;
            if (og + 1u == (tg + 1u) * nx) xb_add(&bar[XB_TOPGEN], 1u);
            else XB_SPIN(xb_ld(&bar[XB_TOPGEN]) == tg, bar);
            __builtin_amdgcn_fence(__ATOMIC_ACQUIRE, "agent");
            xb_add(&bar[XB_XGEN(b.x)], 1u);
            asm volatile("s_waitcnt vmcnt(0)" ::: "memory");
        } else {
            XB_SPIN(xb_ld(&bar[XB_XGEN(b.x)]) == gen, bar);
            __builtin_amdgcn_fence(__ATOMIC_ACQUIRE, "agent");
            asm volatile("s_waitcnt vmcnt(0)" ::: "memory");
        }
    }
    __syncthreads();
}

namespace pg8 {
constexpr int BM = 256, BK = 64, HALF = 128, HTB = HALF * BK * 2, STAGE_BYTES = 8 * HTB, NXCD = 8, WGM = 8;
__host__ __device__ __forceinline__ int lds_byte(int r, int c) { const int st = (r >> 4) * 2 + (c >> 5), rr = r & 15, cc = c & 31, ob = rr * 64 + cc * 2; return st * 1024 + (ob ^ (((ob >> 9) & 1) << 5)); }
__host__ __device__ __forceinline__ void stage_rc(int b, int& R, int& C) { const int st = b / 1024, sb = b % 1024, swz = sb ^ (((sb >> 9) & 1) << 5); R = (st >> 1) * 16 + swz / 64; C = (st & 1) * 32 + (swz % 64) / 2; }
__host__ __device__ __forceinline__ int perm32(int rho) { const int n = rho >> 4, i = rho & 15; return 8 * (i >> 2) + 4 * n + (i & 3); }

struct Unit { int pm, pn; size_t boff; size_t aoff; int slice; };
struct Gemm { const void* A; const void* Bt; int M, N, K; int ntk; };

struct StaticOrder {
    int nM, nN, nwg, G, c;
    __device__ void init(int M, int N, int G_, int c_) { nM = M / BM; nN = N / BM; nwg = nM * nN; G = G_; c = c_; }
    __device__ bool next(int i, Unit& u) const {
        const long L = (long)i * G + c; if (L >= nwg) return false;
        int wgid = (int)L; { const int q = nwg / NXCD, r = nwg % NXCD, xcd = wgid % NXCD, off = wgid / NXCD; wgid = (xcd < r ? xcd * (q + 1) : r * (q + 1) + (xcd - r) * q) + off; }
        const int nig = WGM * nN, gid = wgid / nig, fm = gid * WGM, gsz = (nM - fm) < WGM ? (nM - fm) : WGM;
        u.pm = fm + ((wgid % nig) % gsz); u.pn = (wgid % nig) / gsz; u.boff = 0; u.aoff = 0; u.slice = 0; return true;
    }
};
struct TileMap {
    int toff[9];
    __device__ __forceinline__ void lookup(int pm, int& e, int& k) const {
        e = (pm >= toff[1]) + (pm >= toff[2]) + (pm >= toff[3]) + (pm >= toff[4]) + (pm >= toff[5]) + (pm >= toff[6]) + (pm >= toff[7]);
        int t0 = 0;
#pragma unroll
        for (int q = 1; q < 8; ++q) t0 = (e == q) ? toff[q] : t0;
        k = pm - t0;
    }
};
constexpr int ECAP = 8192;
struct MoeOrder {
    int nM, nN, nwg, G, c; TileMap tm; size_t estride; size_t arowb;
    __device__ void init(int nM_, int N, int G_, int c_, const TileMap& tm_, size_t es, size_t arowb_) { nM = nM_; nN = N / BM; nwg = nM * nN; G = G_; c = c_; tm = tm_; estride = es; arowb = arowb_; }
    __device__ bool next(int i, Unit& u) const {
        const long L = (long)i * G + c; if (L >= nwg) return false;
        int wgid = (int)L; { const int q = nwg / NXCD, r = nwg % NXCD, xcd = wgid % NXCD, off = wgid / NXCD; wgid = (xcd < r ? xcd * (q + 1) : r * (q + 1) + (xcd - r) * q) + off; }
        const int nig = WGM * nN, gid = wgid / nig, fm = gid * WGM, gsz = (nM - fm) < WGM ? (nM - fm) : WGM;
        u.pm = fm + ((wgid % nig) % gsz); u.pn = (wgid % nig) / gsz; int e, k; tm.lookup(u.pm, e, k); u.boff = (size_t)e * estride;
        u.aoff = (size_t)((long)(e * ECAP + 256 * k - 256 * u.pm) * (long)arowb); u.slice = 0; return true;
    }
};

struct MoeRowOrder {
    int nwg, G, c; TileMap tm; size_t estride;
    __device__ void init(int nMf, int G_, int c_, const TileMap& tm_, size_t es) { nwg = nMf * 8; G = G_; c = c_; tm = tm_; estride = es; }
    __device__ bool next(int i, Unit& u) const {
        const long L = (long)i * G + c; if (L >= nwg) return false;
        u.pm = (int)(L >> 3); u.pn = (int)(L & 7); int e, k; tm.lookup(u.pm, e, k); u.boff = (size_t)e * estride; u.aoff = 0; u.slice = 0; return true;
    }
};
struct MoeSplitOrder {
    int pm0, nq, S, c; size_t kslice; TileMap tm; size_t estride;
    __device__ void init(int pm0_, int nT, int S_, size_t ks, int c_, const TileMap& tm_, size_t es) { pm0 = pm0_; S = S_; nq = nT * 8 * S_; kslice = ks; c = c_; tm = tm_; estride = es; }
    __device__ bool next(int i, Unit& u) const {
        if (i != 0 || c >= nq) return false;
        const int un = c / S; u.slice = c - un * S; u.pm = pm0 + (un >> 3); u.pn = un & 7; u.aoff = (size_t)u.slice * kslice; int e, k; tm.lookup(u.pm, e, k); u.boff = (size_t)e * estride + u.aoff; return true;
    }
};
struct EpiBf16 {
    static constexpr bool PERM = true, XBAR = false;
    bf16_t* O; int ldc;
    __device__ __forceinline__ void operator()(const f32x4 (&acc)[2][2][4][2], const Unit& u, int wr, int wc, int fr, int fq) const {
        const int row0 = u.pm * BM + wr * 64 + fr, col0 = u.pn * BM + wc * 32 + 8 * fq;
#pragma unroll
        for (int ai = 0; ai < 2; ++ai)
#pragma unroll
            for (int m = 0; m < 4; ++m) { bf16_t* rowp = O + (size_t)(row0 + ai * HALF + m * 16) * ldc + col0;
#pragma unroll
                for (int bj = 0; bj < 2; ++bj) { const f32x4 v0 = acc[ai][bj][m][0], v1 = acc[ai][bj][m][1];
                    u32x4 w; w.x = cvt_pk_bf16(v0[0], v0[1]); w.y = cvt_pk_bf16(v0[2], v0[3]); w.z = cvt_pk_bf16(v1[0], v1[1]); w.w = cvt_pk_bf16(v1[2], v1[3]);
                    *(u32x4*)(rowp + bj * HALF) = w; } }
    }
};
struct EpiQKNorm {
    static constexpr bool PERM = true, XBAR = true;
    bf16_t* O; int ldc; const float* qg; const float* kg; float sc;
    __device__ __forceinline__ void pre(const f32x4 (&acc)[2][2][4][2], int wr, int wc, int fr, int fq, LAS float* P) const {
#pragma unroll
        for (int ai = 0; ai < 2; ++ai)
#pragma unroll
            for (int m = 0; m < 4; ++m)
#pragma unroll
                for (int bj = 0; bj < 2; ++bj) { const f32x4 a = acc[ai][bj][m][0], b = acc[ai][bj][m][1];
                    float ss = (a[0] * a[0] + a[1] * a[1]) + (a[2] * a[2] + a[3] * a[3]) + (b[0] * b[0] + b[1] * b[1]) + (b[2] * b[2] + b[3] * b[3]);
                    ss += __shfl_xor(ss, 16); ss += __shfl_xor(ss, 32);
                    if (fq == 0) P[((ai * HALF + wr * 64 + m * 16 + fr) * 2 + bj) * 4 + wc] = ss * sc * sc; }
    }
    __device__ __forceinline__ void post(const f32x4 (&acc)[2][2][4][2], const Unit& u, int wr, int wc, int fr, int fq, const LAS float* P) const {
        const int row0 = u.pm * BM + wr * 64 + fr, col0 = u.pn * BM + wc * 32 + 8 * fq;
        f32x4 g0[2], g1[2]; float hs[2];
#pragma unroll
        for (int bj = 0; bj < 2; ++bj) { const int head = 2 * u.pn + bj; const float* gp = (head < 16 ? qg : kg) + wc * 32 + 8 * fq; g0[bj] = *(const f32x4*)gp; g1[bj] = *(const f32x4*)(gp + 4); hs[bj] = head < 16 ? 0.08838834764831845f : 1.0f; }
#pragma unroll
        for (int ai = 0; ai < 2; ++ai)
#pragma unroll
            for (int m = 0; m < 4; ++m) { bf16_t* rowp = O + (size_t)(row0 + ai * HALF + m * 16) * ldc + col0;
#pragma unroll
                for (int bj = 0; bj < 2; ++bj) { const f32x4 ps = *(const LAS f32x4*)(P + ((ai * HALF + wr * 64 + m * 16 + fr) * 2 + bj) * 4);
                    const float rstd = hs[bj] / sqrtf(((ps[0] + ps[1]) + (ps[2] + ps[3])) * (1.f / 128.f) + 1e-6f);
                    const f32x4 v0 = acc[ai][bj][m][0] * g0[bj] * (rstd * sc), v1 = acc[ai][bj][m][1] * g1[bj] * (rstd * sc);
                    u32x4 w; w.x = cvt_pk_bf16(v0[0], v0[1]); w.y = cvt_pk_bf16(v0[2], v0[3]); w.z = cvt_pk_bf16(v1[0], v1[1]); w.w = cvt_pk_bf16(v1[2], v1[3]);
                    *(u32x4*)(rowp + bj * HALF) = w; } }
    }
};
struct EpiBf16S {
    static constexpr bool PERM = true, XBAR = false;
    bf16_t* O; int ldc; float sc; size_t sstride;
    __device__ __forceinline__ void operator()(const f32x4 (&acc)[2][2][4][2], const Unit& u, int wr, int wc, int fr, int fq) const {
        const int row0 = u.pm * BM + wr * 64 + fr, col0 = u.pn * BM + wc * 32 + 8 * fq;
        bf16_t* Os = O + (size_t)u.slice * sstride;
#pragma unroll
        for (int ai = 0; ai < 2; ++ai)
#pragma unroll
            for (int m = 0; m < 4; ++m) { bf16_t* rowp = Os + (size_t)(row0 + ai * HALF + m * 16) * ldc + col0;
#pragma unroll
                for (int bj = 0; bj < 2; ++bj) { const f32x4 v0 = acc[ai][bj][m][0] * sc, v1 = acc[ai][bj][m][1] * sc;
                    u32x4 w; w.x = cvt_pk_bf16(v0[0], v0[1]); w.y = cvt_pk_bf16(v0[2], v0[3]); w.z = cvt_pk_bf16(v1[0], v1[1]); w.w = cvt_pk_bf16(v1[2], v1[3]);
                    *(u32x4*)(rowp + bj * HALF) = w; } }
    }
};
struct EpiSwiGLU {
    static constexpr bool PERM = true, XBAR = false;
    bf16_t* O; int ldc;
    __device__ __forceinline__ void operator()(const f32x4 (&acc)[2][2][4][2], const Unit& u, int wr, int wc, int fr, int fq) const {
        const int row0 = u.pm * BM + wr * 64 + fr, col0 = u.pn * HALF + wc * 32 + 8 * fq;
#pragma unroll
        for (int ai = 0; ai < 2; ++ai)
#pragma unroll
            for (int m = 0; m < 4; ++m) { bf16_t* rowp = O + (size_t)(row0 + ai * HALF + m * 16) * ldc + col0;
                float o[8];
#pragma unroll
                for (int n = 0; n < 2; ++n)
#pragma unroll
                    for (int j = 0; j < 4; ++j) { const float g = acc[ai][0][m][n][j], up = acc[ai][1][m][n][j]; o[n * 4 + j] = g * __builtin_amdgcn_rcpf(1.f + __expf(-g)) * up; }
                u32x4 w; w.x = cvt_pk_bf16(o[0], o[1]); w.y = cvt_pk_bf16(o[2], o[3]); w.z = cvt_pk_bf16(o[4], o[5]); w.w = cvt_pk_bf16(o[6], o[7]);
                *(u32x4*)rowp = w; }
    }
};
struct EpiSwiGLU8 {
    static constexpr bool PERM = true, XBAR = false;
    unsigned char* O; int ldc; float isc, osc;
    __device__ __forceinline__ void operator()(const f32x4 (&acc)[2][2][4][2], const Unit& u, int wr, int wc, int fr, int fq) const {
        const int row0 = u.pm * BM + wr * 64 + fr, col0 = u.pn * HALF + wc * 32 + 8 * fq;
#pragma unroll
        for (int ai = 0; ai < 2; ++ai)
#pragma unroll
            for (int m = 0; m < 4; ++m) { unsigned char* rowp = O + (size_t)(row0 + ai * HALF + m * 16) * ldc + col0;
                float o[8];
#pragma unroll
                for (int n = 0; n < 2; ++n)
#pragma unroll
                    for (int j = 0; j < 4; ++j) { const float g = acc[ai][0][m][n][j] * isc, up = acc[ai][1][m][n][j] * isc; o[n * 4 + j] = g * __builtin_amdgcn_rcpf(1.f + __expf(-g)) * up * osc; }
                u32x2 w; w.x = pk4_fp8(o[0], o[1], o[2], o[3]); w.y = pk4_fp8(o[4], o[5], o[6], o[7]);
                *(u32x2*)rowp = w; }
    }
};
struct EpiResGate {
    static constexpr bool PERM = false, XBAR = false;
    const float* base; float* out; int ldc; const float* gate; int gstride;
    __device__ __forceinline__ void operator()(const f32x4 (&acc)[2][2][4][2], const Unit& u, int wr, int wc, int fr, int fq) const {
        const int row0 = u.pm * BM + wr * 64 + fr, col0 = u.pn * BM + wc * 32 + 4 * fq;
        const float* gp = gate + (size_t)((u.pm * BM) >> 11) * gstride + col0;
        f32x4 gv[2][2];
#pragma unroll
        for (int bj = 0; bj < 2; ++bj)
#pragma unroll
            for (int n = 0; n < 2; ++n) gv[bj][n] = *(const f32x4*)(gp + bj * HALF + n * 16);
#pragma unroll
        for (int ai = 0; ai < 2; ++ai)
#pragma unroll
            for (int m = 0; m < 4; ++m) { const size_t off = (size_t)(row0 + ai * HALF + m * 16) * ldc + col0;
#pragma unroll
                for (int bj = 0; bj < 2; ++bj)
#pragma unroll
                    for (int n = 0; n < 2; ++n) { const f32x4 bs = *(const f32x4*)(base + off + bj * HALF + n * 16);
                        *(f32x4*)(out + off + bj * HALF + n * 16) = bs + gv[bj][n] * acc[ai][bj][m][n]; }
                asm volatile("" ::: "memory"); }
    }
};
struct EpiF32 {
    static constexpr bool PERM = false, XBAR = false;
    float* C; int ldc; float sc;
    __device__ __forceinline__ void operator()(const f32x4 (&acc)[2][2][4][2], const Unit& u, int wr, int wc, int fr, int fq) const {
        const int row0 = u.pm * BM + wr * 64 + fr, col0 = u.pn * BM + wc * 32 + 4 * fq;
#pragma unroll
        for (int ai = 0; ai < 2; ++ai)
#pragma unroll
            for (int m = 0; m < 4; ++m) { float* rowp = C + (size_t)(row0 + ai * HALF + m * 16) * ldc + col0;
#pragma unroll
                for (int bj = 0; bj < 2; ++bj)
#pragma unroll
                    for (int n = 0; n < 2; ++n) *(f32x4*)(rowp + bj * HALF + n * 16) = acc[ai][bj][m][n] * sc; }
    }
};

template <class Epi, class Sched, bool F8 = false>
__device__ __forceinline__ void gemm_phase(LAS unsigned char* lds, const Gemm g, const Sched& S, const Epi& E) {
    const int tid = threadIdx.x, wid = __builtin_amdgcn_readfirstlane(tid >> 6), lane = tid & 63, wr = wid >> 2, wc = wid & 3, fr = lane & 15, fq = lane >> 4;
    const int rowb = F8 ? g.K : 2 * g.K, nt = g.ntk ? g.ntk : rowb / (BK * 2);
    unsigned voffA[2], voffB[2];
#pragma unroll
    for (int i = 0; i < 2; ++i) { int R, C; stage_rc(tid * 16 + i * 8192, R, C); const int Rb = Epi::PERM ? ((R & ~31) + perm32(R & 31)) : R;
        voffA[i] = (unsigned)(R * rowb + C * 2); voffB[i] = (unsigned)(Rb * rowb + C * 2); }
    const size_t kstep = (size_t)(BK * 2);
    const size_t hstep = (size_t)HALF * rowb;
    const size_t tstep = 2 * hstep;
    const unsigned ldsw = (unsigned)wid * 1024u;
    const int aoff = lds_byte(wr * 64 + fr, fq * 8), boff = lds_byte(wc * 32 + fr, fq * 8);
#define PG8_SA(b, h) (((b) * 2 + (h)) * HTB)
#define PG8_SB(b, h) ((4 + (b) * 2 + (h)) * HTB)
#define PG8_STAGE(bufoff, gbase, voff) do { _Pragma("unroll") for (int _i = 0; _i < 2; ++_i) \
        __builtin_amdgcn_global_load_lds((const unsigned*)((const char*)(gbase) + (voff)[_i]), (LAS unsigned*)(lds + (bufoff) + ldsw + _i * 8192), 16, 0, 0); } while (0)
#define PG8_LD8(base_) __builtin_shufflevector(*(const LAS i32x4*)(base_), *(const LAS i32x4*)((base_) + 1024), 0, 1, 2, 3, 4, 5, 6, 7)
#define PG8_LDA(dst, b, h) do { _Pragma("unroll") for (int m = 0; m < 4; ++m) { if constexpr (F8) dst##8[m] = PG8_LD8(lds + PG8_SA(b, h) + aoff + m * 2048); \
        else { _Pragma("unroll") for (int k = 0; k < 2; ++k) dst[m][k] = *(const LAS bf16x8*)(lds + PG8_SA(b, h) + aoff + m * 2048 + k * 1024); } } } while (0)
#define PG8_LDB(dst, b, h) do { _Pragma("unroll") for (int n = 0; n < 2; ++n) { if constexpr (F8) dst##8[n] = PG8_LD8(lds + PG8_SB(b, h) + boff + n * 2048); \
        else { _Pragma("unroll") for (int k = 0; k < 2; ++k) dst[n][k] = *(const LAS bf16x8*)(lds + PG8_SB(b, h) + boff + n * 2048 + k * 1024); } } } while (0)
#define PG8_MMA(ai, bj, At, Bt) do { __builtin_amdgcn_s_setprio(1); _Pragma("unroll") for (int m = 0; m < 4; ++m) _Pragma("unroll") for (int n = 0; n < 2; ++n) { \
        if constexpr (F8) { asm volatile("v_mfma_f32_16x16x128_f8f6f4 %0, %1, %2, %0" : "+v"(acc[ai][bj][m][n]) : "v"(Bt##8[n]), "v"(At##8[m])); } \
        else { _Pragma("unroll") for (int k = 0; k < 2; ++k) acc[ai][bj][m][n] = __builtin_amdgcn_mfma_f32_16x16x32_bf16(Bt[n][k], At[m][k], acc[ai][bj][m][n], 0, 0, 0); } } \
        __builtin_amdgcn_s_setprio(0); } while (0)
#define PG8_WAIT_V(n) asm volatile("s_waitcnt vmcnt(" #n ")" ::: "memory")
#define PG8_WAIT_L(n) asm volatile("s_waitcnt lgkmcnt(" #n ")" ::: "memory")
#define PG8_BAR __builtin_amdgcn_s_barrier()
#define PG8_SCHED __builtin_amdgcn_sched_barrier(0)
    Unit cur, nxt; int ui = 0;
    if (!S.next(0, cur)) return;
    f32x4 acc[2][2][4][2];
#pragma unroll
    for (int a = 0; a < 2; ++a)
#pragma unroll
        for (int b = 0; b < 2; ++b)
#pragma unroll
            for (int m = 0; m < 4; ++m)
#pragma unroll
                for (int n = 0; n < 2; ++n) acc[a][b][m][n] = (f32x4){0.f, 0.f, 0.f, 0.f};
    bf16x8 At[4][2], B0[2][2], B1[2][2]; i32x8 At8[4], B08[2], B18[2];
    const char* cA = (const char*)g.A + cur.aoff + (size_t)cur.pm * tstep; const char* cB = (const char*)g.Bt + cur.boff + (size_t)cur.pn * tstep;
    PG8_STAGE(PG8_SB(0, 0), cB, voffB); PG8_STAGE(PG8_SA(0, 0), cA, voffA); PG8_STAGE(PG8_SB(0, 1), cB + hstep, voffB); PG8_STAGE(PG8_SA(0, 1), cA + hstep, voffA);
    if (wr == 1) PG8_BAR;
    PG8_WAIT_V(4); PG8_BAR;
    PG8_STAGE(PG8_SB(1, 0), cB + kstep, voffB); PG8_STAGE(PG8_SA(1, 0), cA + kstep, voffA); PG8_STAGE(PG8_SB(1, 1), cB + hstep + kstep, voffB);
    PG8_WAIT_V(6); PG8_BAR;
    for (;;) {
        const bool has_next = S.next(ui + 1, nxt);
        const char* nA = has_next ? (const char*)g.A + nxt.aoff + (size_t)nxt.pm * tstep : cA; const char* nB = has_next ? (const char*)g.Bt + nxt.boff + (size_t)nxt.pn * tstep : cB;
        for (int t = 0; t < nt; t += 2) {
            const bool last = (t == nt - 2);
            const char* a1 = cA + (size_t)(t + 1) * kstep;
            const char* a2 = last ? nA : cA + (size_t)(t + 2) * kstep; const char* b2 = last ? nB : cB + (size_t)(t + 2) * kstep;
            const char* a3 = a2 + kstep; const char* b3 = b2 + kstep;
            PG8_LDB(B0, 0, 0); PG8_SCHED; PG8_LDA(At, 0, 0); PG8_STAGE(PG8_SA(1, 1), a1 + hstep, voffA);
            PG8_WAIT_L(8); PG8_BAR; PG8_WAIT_L(0); PG8_MMA(0, 0, At, B0); PG8_BAR; PG8_SCHED;
            PG8_LDB(B1, 0, 1); PG8_STAGE(PG8_SB(0, 0), b2, voffB);
            PG8_BAR; PG8_WAIT_L(0); PG8_MMA(0, 1, At, B1); PG8_BAR;
            PG8_LDA(At, 0, 1); PG8_STAGE(PG8_SA(0, 0), a2, voffA);
            PG8_BAR; PG8_WAIT_L(0); PG8_MMA(1, 0, At, B0); PG8_BAR; PG8_SCHED;
            PG8_STAGE(PG8_SB(0, 1), b2 + hstep, voffB);
            PG8_WAIT_V(6); PG8_BAR; PG8_MMA(1, 1, At, B1); PG8_BAR;
            PG8_LDB(B0, 1, 0); PG8_SCHED; PG8_LDA(At, 1, 0); PG8_STAGE(PG8_SA(0, 1), a2 + hstep, voffA);
            PG8_WAIT_L(8); PG8_BAR; PG8_WAIT_L(0); PG8_MMA(0, 0, At, B0); PG8_BAR; PG8_SCHED;
            PG8_LDB(B1, 1, 1); PG8_STAGE(PG8_SB(1, 0), b3, voffB);
            PG8_BAR; PG8_WAIT_L(0); PG8_MMA(0, 1, At, B1); PG8_BAR;
            PG8_LDA(At, 1, 1); PG8_STAGE(PG8_SA(1, 0), a3, voffA);
            PG8_BAR; PG8_WAIT_L(0); PG8_MMA(1, 0, At, B0); PG8_BAR; PG8_SCHED;
            PG8_STAGE(PG8_SB(1, 1), b3 + hstep, voffB);
            PG8_WAIT_V(6); PG8_BAR; PG8_MMA(1, 1, At, B1); PG8_BAR;
        }
        if constexpr (F8) asm volatile("s_nop 15\n\ts_nop 15" ::: "memory");
        if constexpr (Epi::XBAR) { LAS float* P_ = (LAS float*)(lds + STAGE_BYTES); E.pre(acc, wr, wc, fr, fq, P_); PG8_WAIT_L(0); PG8_BAR; asm volatile("" ::: "memory"); E.post(acc, cur, wr, wc, fr, fq, P_); }
        else E(acc, cur, wr, wc, fr, fq);
        if (!has_next) break;
#pragma unroll
        for (int a = 0; a < 2; ++a)
#pragma unroll
            for (int b = 0; b < 2; ++b)
#pragma unroll
                for (int m = 0; m < 4; ++m)
#pragma unroll
                    for (int n = 0; n < 2; ++n) acc[a][b][m][n] = (f32x4){0.f, 0.f, 0.f, 0.f};
        cur = nxt; cA = nA; cB = nB; ++ui;
    }
    PG8_WAIT_V(0);
    if (wr == 0) PG8_BAR;
    PG8_BAR;
#undef PG8_SA
#undef PG8_SB
#undef PG8_STAGE
#undef PG8_LDA
#undef PG8_LDB
#undef PG8_MMA
#undef PG8_WAIT_V
#undef PG8_WAIT_L
#undef PG8_BAR
#undef PG8_SCHED
}
}

DI void mod_phase(const float* c, const float* mod_w, const float* mod_b, float* mod, LAS unsigned char* lds, int G, int tid, int lane, int wave) {
    LAS f32x4* cact = (LAS f32x4*)lds;
    LAS float* red = (LAS float*)(lds + 32768);
    for (int k = tid; k < DM; k += NTHREADS) { f32x4 v; v.x = silu_f(c[k]); v.y = silu_f(c[DM + k]); v.z = silu_f(c[2 * DM + k]); v.w = silu_f(c[3 * DM + k]); cact[k] = v; }
    __syncthreads();
    for (int it = blockIdx.x; it < 256; it += G) {
        const int l = it >> 7, n0 = (it & 127) * 96;
        float a0[4] = {0.f, 0.f, 0.f, 0.f}, a1[4] = {0.f, 0.f, 0.f, 0.f};
        if (lane < 48) {
            const float* wp = mod_w + ((size_t)l * DM + wave * 256) * 12288 + n0 + 2 * lane;
#pragma unroll 8
            for (int k = 0; k < 256; ++k) { const f32x2 w = *(const f32x2*)(wp + (size_t)k * 12288); const f32x4 cv = cact[wave * 256 + k];
                a0[0] += cv.x * w.x; a1[0] += cv.x * w.y; a0[1] += cv.y * w.x; a1[1] += cv.y * w.y; a0[2] += cv.z * w.x; a1[2] += cv.z * w.y; a0[3] += cv.w * w.x; a1[3] += cv.w * w.y; }
#pragma unroll
            for (int b = 0; b < 4; ++b) { red[(wave * 4 + b) * 96 + 2 * lane] = a0[b]; red[(wave * 4 + b) * 96 + 2 * lane + 1] = a1[b]; }
        }
        __syncthreads();
        if (tid < 384) { const int b = tid / 96, col = tid % 96; float s = mod_b[l * 12288 + n0 + col];
#pragma unroll
            for (int w = 0; w < 8; ++w) s += red[(w * 4 + b) * 96 + col];
            mod[((size_t)l * 4 + b) * 12288 + n0 + col] = s; }
        __syncthreads();
    }
}

template <int MODE>
DI void cvt_item(const float* W, int K, int N, bf16_t* WT, LAS float* scr, int kb, int nb, int lane) {
    const int k0 = 64 * kb, n0 = 32 * nb;
    float v[32];
    const float* wp = W + (size_t)(k0 + (lane >> 5)) * N + n0 + (lane & 31);
#pragma unroll
    for (int i = 0; i < 32; ++i) v[i] = wp[(size_t)(2 * i) * N];
#pragma unroll
    for (int i = 0; i < 32; ++i) scr[(2 * i + (lane >> 5)) * 33 + (lane & 31)] = v[i];
    LDS_WAIT();
    const int c = lane & 7;
#pragma unroll
    for (int j = 0; j < 4; ++j) { const int n = (lane >> 3) + 8 * j; const LAS float* s = scr + (8 * c) * 33 + n;
        u32x4 o; o.x = cvt_pk_bf16(s[0 * 33], s[1 * 33]); o.y = cvt_pk_bf16(s[2 * 33], s[3 * 33]); o.z = cvt_pk_bf16(s[4 * 33], s[5 * 33]); o.w = cvt_pk_bf16(s[6 * 33], s[7 * 33]);
        const int ng = n0 + n; const int row = (MODE == 0) ? ng : ((ng >> 7) * 256 + (ng & 127) + (MODE == 2 ? 128 : 0));
        *(u32x4*)(WT + (size_t)row * K + k0 + 8 * c) = o; }
    LDS_WAIT();
}
template <int MODE>
DI void cvt_item8(const float* W, int K, int N, unsigned char* WT, LAS float* scr, int kb, int nb, int lane, float wsc) {
    const int k0 = 64 * kb, n0 = 32 * nb;
    float v[32];
    const float* wp = W + (size_t)(k0 + (lane >> 5)) * N + n0 + (lane & 31);
#pragma unroll
    for (int i = 0; i < 32; ++i) v[i] = wp[(size_t)(2 * i) * N];
#pragma unroll
    for (int i = 0; i < 32; ++i) scr[(2 * i + (lane >> 5)) * 33 + (lane & 31)] = v[i] * wsc;
    LDS_WAIT();
    const int c = lane & 3;
#pragma unroll
    for (int j = 0; j < 2; ++j) { const int n = (lane >> 2) + 16 * j; const LAS float* s = scr + (16 * c) * 33 + n;
        u32x4 o; o.x = pk4_fp8(s[0 * 33], s[1 * 33], s[2 * 33], s[3 * 33]); o.y = pk4_fp8(s[4 * 33], s[5 * 33], s[6 * 33], s[7 * 33]);
        o.z = pk4_fp8(s[8 * 33], s[9 * 33], s[10 * 33], s[11 * 33]); o.w = pk4_fp8(s[12 * 33], s[13 * 33], s[14 * 33], s[15 * 33]);
        const int ng = n0 + n; const int row = (MODE == 0) ? ng : ((ng >> 7) * 256 + (ng & 127) + (MODE == 2 ? 128 : 0));
        *(u32x4*)(WT + (size_t)row * K + k0 + 16 * c) = o; }
    LDS_WAIT();
}
template <int MODE>
DI void cvt_job8(const float* W, int K, int N, int nbatch, unsigned char* WT, size_t dst_bstride, LAS float* scr, int gw, int NGW, int lane, float wsc) {
    const int nnb = N / 32, per = (K / 64) * nnb, total = per * nbatch;
    for (int it = gw; it < total; it += NGW) {
        const int bt = it / per, r = it - bt * per, kb = r / nnb, nb = r - kb * nnb;
        cvt_item8<MODE>(W + (size_t)bt * K * N, K, N, WT + (size_t)bt * dst_bstride, scr, kb, nb, lane, wsc);
    }
}
template <int MODE>
DI void cvt_job(const float* W, int K, int N, int nbatch, bf16_t* WT, size_t dst_bstride, LAS float* scr, int gw, int NGW, int lane) {
    const int nnb = N / 32, per = (K / 64) * nnb, total = per * nbatch;
    for (int it = gw; it < total; it += NGW) {
        const int bt = it / per, r = it - bt * per, kb = r / nnb, nb = r - kb * nnb;
        cvt_item<MODE>(W + (size_t)bt * K * N, K, N, WT + (size_t)bt * dst_bstride, scr, kb, nb, lane);
    }
}

DI void cvtw_load(f32x4 (&v)[16], const float* wp, int N) {
#pragma unroll
    for (int i = 0; i < 16; ++i) v[i] = __builtin_nontemporal_load((const f32x4*)(wp + (size_t)(4 * i) * N));
}
template <int MODE, bool OUT8>
DI void cvtw_store(const f32x4 (&v)[16], int K, void* WTb, LAS float* scr, int k0, int n0, int lane, float wsc) {
    const int kr = lane >> 4, n4 = lane & 15;
#pragma unroll
    for (int i = 0; i < 16; ++i)
#pragma unroll
        for (int e = 0; e < 4; ++e) scr[(4 * n4 + e) * 65 + 4 * i + kr] = OUT8 ? v[i][e] * wsc : v[i][e];
    LDS_WAIT();
    if (OUT8) {
        unsigned char* WT = (unsigned char*)WTb; const int c = lane & 3;
#pragma unroll
        for (int j = 0; j < 4; ++j) { const int n = (lane >> 2) + 16 * j; const LAS float* s = scr + n * 65 + 16 * c;
            u32x4 o; o.x = pk4_fp8(s[0], s[1], s[2], s[3]); o.y = pk4_fp8(s[4], s[5], s[6], s[7]); o.z = pk4_fp8(s[8], s[9], s[10], s[11]); o.w = pk4_fp8(s[12], s[13], s[14], s[15]);
            const int ng = n0 + n; const int row = (MODE == 0) ? ng : ((ng >> 7) * 256 + (ng & 127) + (MODE == 2 ? 128 : 0));
            *(u32x4*)(WT + (size_t)row * K + k0 + 16 * c) = o; }
    } else {
        bf16_t* WT = (bf16_t*)WTb; const int c = lane & 7;
#pragma unroll
        for (int j = 0; j < 8; ++j) { const int n = (lane >> 3) + 8 * j; const LAS float* s = scr + n * 65 + 8 * c;
            u32x4 o; o.x = cvt_pk_bf16(s[0], s[1]); o.y = cvt_pk_bf16(s[2], s[3]); o.z = cvt_pk_bf16(s[4], s[5]); o.w = cvt_pk_bf16(s[6], s[7]);
            const int ng = n0 + n; const int row = (MODE == 0) ? ng : ((ng >> 7) * 256 + (ng & 127) + (MODE == 2 ? 128 : 0));
            *(u32x4*)(WT + (size_t)row * K + k0 + 8 * c) = o; }
    }
    LDS_WAIT();
}
DI void cvtw_pack8(const f32x4 (&v)[16], LAS float* scr, int lane, float wsc, u32x4 (&o)[4]) {
    const int kr = lane >> 4, n4 = lane & 15;
#pragma unroll
    for (int i = 0; i < 16; ++i)
#pragma unroll
        for (int e = 0; e < 4; ++e) scr[(4 * n4 + e) * 65 + 4 * i + kr] = v[i][e] * wsc;
    LDS_WAIT();
    const int c = lane & 3;
#pragma unroll
    for (int j = 0; j < 4; ++j) { const int n = (lane >> 2) + 16 * j; const LAS float* s = scr + n * 65 + 16 * c;
        o[j].x = pk4_fp8(s[0], s[1], s[2], s[3]); o[j].y = pk4_fp8(s[4], s[5], s[6], s[7]); o[j].z = pk4_fp8(s[8], s[9], s[10], s[11]); o[j].w = pk4_fp8(s[12], s[13], s[14], s[15]); }
    LDS_WAIT();
}
template <int MODE, bool OUT8>
DI void cvtw_job(const float* W, int K, int N, int nbatch, void* WT, size_t dst_bstride_bytes, LAS float* scr, int gw, int NGW, int lane, float wsc, int ld = 0) {
    const int nnb = N / 64, per = (K / 128) * nnb, total = per * nbatch;
    for (int it = gw; it < total; it += NGW) {
        const int bt = it / per, r = it - bt * per, kb = r / nnb, nb = r - kb * nnb, k0 = 128 * kb, n0 = 64 * nb;
        const int pitch = ld ? ld : N;
        const float* wp = W + (size_t)bt * K * pitch + (size_t)(k0 + (lane >> 4)) * pitch + n0 + 4 * (lane & 15);
        f32x4 v0[16], v1[16];
        cvtw_load(v0, wp, pitch); cvtw_load(v1, wp + (size_t)64 * pitch, pitch);
        void* WTb = (unsigned char*)WT + (size_t)bt * dst_bstride_bytes;
        if (OUT8) {
            u32x4 o0[4], o1[4]; cvtw_pack8(v0, scr, lane, wsc, o0); cvtw_pack8(v1, scr, lane, wsc, o1);
            unsigned char* WT8 = (unsigned char*)WTb; const int c = lane & 3;
#pragma unroll
            for (int j = 0; j < 4; ++j) { const int ng = n0 + (lane >> 2) + 16 * j; const int row = (MODE == 0) ? ng : ((ng >> 7) * 256 + (ng & 127) + (MODE == 2 ? 128 : 0));
                unsigned char* dp = WT8 + (size_t)row * K + k0 + 16 * c; *(u32x4*)dp = o0[j]; *(u32x4*)(dp + 64) = o1[j]; }
        } else {
            cvtw_store<MODE, OUT8>(v0, K, WTb, scr, k0, n0, lane, wsc);
            cvtw_store<MODE, OUT8>(v1, K, WTb, scr, k0 + 64, n0, lane, wsc);
        }
    }
}

constexpr float HSCALE = 8.f, WSCALE = 256.f, ASCALE = 8.f;
template <bool ROUTER, bool OUT8 = false>
DI void rms_mod_phase(const float* X, const float* g, const float* scale, const float* shift, bf16_t* out,
                      const float* router, int* tok_e, int* tok_pos, float* tok_w, unsigned* ecnt, unsigned char* HS2, int gw, int NGW, int lane) {
    for (int row = gw; row < MTOK; row += NGW) {
        const int b = row >> 11;
        const f32x4* xr = (const f32x4*)(X + (size_t)row * DM) + lane;
        f32x4 v[8]; float ss = 0.f;
#pragma unroll
        for (int j = 0; j < 8; ++j) { v[j] = xr[64 * j]; ss += (v[j].x * v[j].x + v[j].y * v[j].y) + (v[j].z * v[j].z + v[j].w * v[j].w); }
        const float rstd = 1.0f / sqrtf(wave_sum(ss) * (1.f / DM) + 1e-6f);
        const f32x4* gp = (const f32x4*)g + lane; const f32x4* sc = (const f32x4*)(scale + (size_t)b * 12288) + lane; const f32x4* sh = (const f32x4*)(shift + (size_t)b * 12288) + lane;
        u32x2* op = (u32x2*)(out + (size_t)row * DM) + lane;
        float lg[8] = {0.f, 0.f, 0.f, 0.f, 0.f, 0.f, 0.f, 0.f}; unsigned h8[8];
#pragma unroll
        for (int j = 0; j < 8; ++j) { const f32x4 gg = gp[64 * j], s1 = sc[64 * j], s2 = sh[64 * j];
            f32x4 h = (v[j] * rstd) * gg; h = h * (s1 + 1.0f) + s2;
            if (ROUTER) { h8[j] = pk4_fp8(h.x * HSCALE, h.y * HSCALE, h.z * HSCALE, h.w * HSCALE); }
            else { u32x2 w; w.x = cvt_pk_bf16(h.x, h.y); w.y = cvt_pk_bf16(h.z, h.w); op[64 * j] = w;
                   if (OUT8) ((unsigned*)(HS2 + (size_t)row * DM) + lane)[64 * j] = pk4_fp8(h.x * HSCALE, h.y * HSCALE, h.z * HSCALE, h.w * HSCALE); }
            if (ROUTER) {
#pragma unroll
                for (int i = 0; i < 4; ++i) { const int cc = 256 * j + 4 * lane + i; const f32x4 r0 = ((const f32x4*)router)[cc * 2], r1 = ((const f32x4*)router)[cc * 2 + 1];
                    lg[0] += h[i] * r0.x; lg[1] += h[i] * r0.y; lg[2] += h[i] * r0.z; lg[3] += h[i] * r0.w; lg[4] += h[i] * r1.x; lg[5] += h[i] * r1.y; lg[6] += h[i] * r1.z; lg[7] += h[i] * r1.w; } } }
        if (ROUTER) {
#pragma unroll
            for (int e = 0; e < 8; ++e) lg[e] = wave_sum(lg[e]);
            if (lane == 0) {
                int i0 = 0; float v0 = lg[0];
#pragma unroll
                for (int e = 1; e < 8; ++e) if (lg[e] > v0) { v0 = lg[e]; i0 = e; }
                int i1 = -1; float v1 = -3.0e38f;
#pragma unroll
                for (int e = 0; e < 8; ++e) if (e != i0 && lg[e] > v1) { v1 = lg[e]; i1 = e; }
                const float w1 = 1.f / (1.f + expf(v0 - v1)), w0 = 1.f - w1;
                const int p0 = (int)__hip_atomic_fetch_add(ecnt + 64 * i0, 1u, __ATOMIC_RELAXED, __HIP_MEMORY_SCOPE_AGENT);
                const int p1 = (int)__hip_atomic_fetch_add(ecnt + 64 * i1, 1u, __ATOMIC_RELAXED, __HIP_MEMORY_SCOPE_AGENT);
                tok_e[2 * row] = i0; tok_e[2 * row + 1] = i1; tok_pos[2 * row] = p0; tok_pos[2 * row + 1] = p1; tok_w[2 * row] = w0; tok_w[2 * row + 1] = w1;
                lg[0] = __int_as_float(i0 * pg8::ECAP + p0); lg[1] = __int_as_float(i1 * pg8::ECAP + p1);
            }
            const int ra = __builtin_amdgcn_readfirstlane(__float_as_int(lg[0])), rb = __builtin_amdgcn_readfirstlane(__float_as_int(lg[1]));
            unsigned* da = (unsigned*)(HS2 + (size_t)ra * DM) + lane; unsigned* db = (unsigned*)(HS2 + (size_t)rb * DM) + lane;
#pragma unroll
            for (int j = 0; j < 8; ++j) { da[64 * j] = h8[j]; db[64 * j] = h8[j]; }
        }
    }
}

DI void qknorm_phase(const bf16_t* QK, bf16_t* QKN, const float* qg, const float* kg, int gw, int NGW, int lane) {
    const int l16 = lane & 15;
    for (int idx = gw * 4 + (lane >> 4); idx < MTOK * 32; idx += NGW * 4) {
        const int hr = idx & 31; const size_t off = (size_t)(idx >> 5) * 4096 + hr * 128 + 8 * l16;
        const u32x4 raw = *(const u32x4*)(QK + off);
        float x[8] = {bf_lo(raw.x), bf_hi(raw.x), bf_lo(raw.y), bf_hi(raw.y), bf_lo(raw.z), bf_hi(raw.z), bf_lo(raw.w), bf_hi(raw.w)};
        float ss = 0.f;
#pragma unroll
        for (int i = 0; i < 8; ++i) ss += x[i] * x[i];
        ss += __shfl_xor(ss, 1); ss += __shfl_xor(ss, 2); ss += __shfl_xor(ss, 4); ss += __shfl_xor(ss, 8);
        const float rstd = (1.0f / sqrtf(ss * (1.f / 128.f) + 1e-6f)) * (hr < 16 ? 0.08838834764831845f : 1.0f);
        const float* gp = (hr < 16 ? qg : kg) + 8 * l16;
        const f32x4 g0 = *(const f32x4*)gp, g1 = *(const f32x4*)(gp + 4);
        u32x4 o; o.x = cvt_pk_bf16(x[0] * rstd * g0.x, x[1] * rstd * g0.y); o.y = cvt_pk_bf16(x[2] * rstd * g0.z, x[3] * rstd * g0.w);
        o.z = cvt_pk_bf16(x[4] * rstd * g1.x, x[5] * rstd * g1.y); o.w = cvt_pk_bf16(x[6] * rstd * g1.z, x[7] * rstd * g1.w);
        *(u32x4*)(QKN + off) = o;
    }
}

constexpr int NA_TBL = 0, NA_BUF = 30720, NA_TILE = 18432;
DI void na_phase(const bf16_t* QKN, const bf16_t* VT, bf16_t* ATT, const float* rpb, LAS unsigned char* lds, int G, int vcu0, int tid, int lane, int wave) {
    LAS float* rpbL = (LAS float*)(lds + NA_TBL);
    for (int i = tid; i < 16 * 465; i += NTHREADS) rpbL[i] = rpb[i];
    const int c16 = lane & 15, g = lane >> 4, unit = wave >> 2, j = wave & 3;
    const int cb = (j == 0) ? 0 : (j == 1) ? 8 : (j == 2) ? 24 : 32;
    const int qc = 16 * j + c16, c0 = min(max(qc - 8, 0), 48);
    const int kcl = 8 * (c16 >> 2) + (c16 & 3);
    for (int p = vcu0; p < 1024; p += G) {
        const int rho = p & 15, hh = (p >> 4) & 15, b = p >> 8;
        const int rA = 2 * rho, r0A = min(max(rA - 4, 0), 24), r0B = min(max(rA + 1 - 4, 0), 24), delta = r0B - r0A, nrows = 8 + delta;
        const int r = rA + unit, r0 = unit ? r0B : r0A;
        const bool shiftB = (unit == 1) && (delta == 1);
        const size_t tq = (size_t)b * SEQ + r * 64 + qc;
        bf16x8 qf[4];
#pragma unroll
        for (int ks = 0; ks < 4; ++ks) qf[ks] = *(const bf16x8*)(QKN + tq * 4096 + hh * 128 + 32 * ks + 8 * g);
        f32x4 S[8][2];
        u32x4 st0, st1;
        const int kkey = tid >> 3, kch = tid & 7;
        const int vd = tid >> 2, vch = tid & 3;
        const bf16_t* kg = QKN + ((size_t)b * SEQ + (size_t)r0A * 64 + kkey) * 4096 + 2048 + hh * 128 + kch * 8;
        const bf16_t* vg = VT + (size_t)(hh * 128 + vd) * MTOK + (size_t)b * SEQ + (size_t)r0A * 64 + vch * 8;
#define NA_LDK(s_) do { st0 = *(const u32x4*)(kg + (size_t)(s_) * 64 * 4096); st1 = *(const u32x4*)(kg + (size_t)(s_) * 64 * 4096 + 64); } while (0)
#define NA_STK(s_) do { LAS unsigned char* t_ = lds + NA_BUF + ((s_) & 1) * NA_TILE + kkey * 272 + kch * 16; *(LAS u32x4*)t_ = st0; *(LAS u32x4*)(t_ + 128) = st1; } while (0)
#define NA_LDV(s_) do { st0 = *(const u32x4*)(vg + (s_) * 64); st1 = *(const u32x4*)(vg + (s_) * 64 + 32); } while (0)
#define NA_STV(s_) do { LAS unsigned char* t_ = lds + NA_BUF + ((s_) & 1) * NA_TILE + vd * 144 + vch * 16; *(LAS u32x4*)t_ = st0; *(LAS u32x4*)(t_ + 64) = st1; } while (0)
#define NA_QK(s_, i_) do { const LAS unsigned char* kb_ = lds + NA_BUF + ((s_) & 1) * NA_TILE + (cb + kcl) * 272 + 16 * g; \
            _Pragma("unroll") for (int hc = 0; hc < 2; ++hc) { f32x4 a = (f32x4){0.f, 0.f, 0.f, 0.f}; \
                _Pragma("unroll") for (int ks = 0; ks < 4; ++ks) a = __builtin_amdgcn_mfma_f32_16x16x32_bf16(*(const LAS bf16x8*)(kb_ + hc * 4 * 272 + 64 * ks), qf[ks], a, 0, 0, 0); S[i_][hc] = a; } } while (0)
#define NA_SROW(s_) do { if ((s_) < nrows) { NA_STK(s_); __syncthreads(); if ((s_) + 1 < nrows) NA_LDK((s_) + 1); \
            if (!shiftB) { if ((s_) < 8) NA_QK(s_, (s_) < 8 ? (s_) : 7); } else { if ((s_) >= 1) NA_QK(s_, (s_) >= 1 ? (s_) - 1 : 0); } } } while (0)
        __syncthreads();
        NA_LDK(0);
        NA_SROW(0); NA_SROW(1); NA_SROW(2); NA_SROW(3); NA_SROW(4); NA_SROW(5); NA_SROW(6); NA_SROW(7); NA_SROW(8);
        NA_LDV(0);
        float mx = -3.0e38f;
        const LAS float* bt = rpbL + hh * 465;
#pragma unroll
        for (int i = 0; i < 8; ++i)
#pragma unroll
            for (int hc = 0; hc < 2; ++hc)
#pragma unroll
                for (int e = 0; e < 4; ++e) {
                    const int kc = cb + 8 * g + 4 * hc + e; const bool valid = (kc >= c0) && (kc < c0 + 16);
                    const int dj = min(max(kc - qc + 15, 0), 30), di = r0 + i - r + 7;
                    const float sv = valid ? S[i][hc][e] + bt[di * 31 + dj] : -3.0e38f;
                    S[i][hc][e] = sv; mx = fmaxf(mx, sv);
                }
        mx = fmaxf(mx, __shfl_xor(mx, 16)); mx = fmaxf(mx, __shfl_xor(mx, 32));
        float sum = 0.f;
#pragma unroll
        for (int i = 0; i < 8; ++i)
#pragma unroll
            for (int hc = 0; hc < 2; ++hc)
#pragma unroll
                for (int e = 0; e < 4; ++e) { const float pv = (S[i][hc][e] > -1.0e38f) ? __expf(S[i][hc][e] - mx) : 0.f; S[i][hc][e] = pv; sum += pv; }
        sum += __shfl_xor(sum, 16); sum += __shfl_xor(sum, 32);
        const float inv = 1.0f / sum;
        f32x4 O[8];
#pragma unroll
        for (int dt = 0; dt < 8; ++dt) O[dt] = (f32x4){0.f, 0.f, 0.f, 0.f};
#define NA_PV(s_, i_) do { u32x4 pw; pw.x = cvt_pk_bf16(S[i_][0][0], S[i_][0][1]); pw.y = cvt_pk_bf16(S[i_][0][2], S[i_][0][3]); pw.z = cvt_pk_bf16(S[i_][1][0], S[i_][1][1]); pw.w = cvt_pk_bf16(S[i_][1][2], S[i_][1][3]); \
            const bf16x8 pf = __builtin_bit_cast(bf16x8, pw); const LAS unsigned char* vb_ = lds + NA_BUF + ((s_) & 1) * NA_TILE + c16 * 144 + (cb + 8 * g) * 2; \
            _Pragma("unroll") for (int dt = 0; dt < 8; ++dt) O[dt] = __builtin_amdgcn_mfma_f32_16x16x32_bf16(*(const LAS bf16x8*)(vb_ + dt * 16 * 144), pf, O[dt], 0, 0, 0); } while (0)
#define NA_VROW(s_) do { if ((s_) < nrows) { NA_STV(s_); __syncthreads(); if ((s_) + 1 < nrows) NA_LDV((s_) + 1); \
            if (!shiftB) { if ((s_) < 8) NA_PV(s_, (s_) < 8 ? (s_) : 7); } else { if ((s_) >= 1) NA_PV(s_, (s_) >= 1 ? (s_) - 1 : 0); } } } while (0)
        __syncthreads();
        NA_VROW(0); NA_VROW(1); NA_VROW(2); NA_VROW(3); NA_VROW(4); NA_VROW(5); NA_VROW(6); NA_VROW(7); NA_VROW(8);
#undef NA_LDK
#undef NA_STK
#undef NA_LDV
#undef NA_STV
#undef NA_QK
#undef NA_SROW
#undef NA_PV
#undef NA_VROW
#pragma unroll
        for (int dt = 0; dt < 8; ++dt) { u32x2 w; w.x = cvt_pk_bf16(O[dt][0] * inv, O[dt][1] * inv); w.y = cvt_pk_bf16(O[dt][2] * inv, O[dt][3] * inv);
            *(u32x2*)(ATT + tq * DM + hh * 128 + 16 * dt + 4 * g) = w; }
    }
}

constexpr int MLP_WIF = 36864, MLP_WROW = 3088;
DI void ml_pre_phase(const bf16_t* XZ, const float* conv_w, const float* conv_b, const float* wq, const float* wk, const float* wv, const bf16_t* WTif,
                     bf16_t* XC, bf16_t* Q, bf16_t* Kb, bf16_t* V, float* pre_part, LAS unsigned char* lds, int G, int tid, int lane, int wave) {
    LAS float* Lcw = (LAS float*)lds;
    LAS float* Lcb = Lcw + 2560;
    LAS float* Lwq = Lcb + 512;
    LAS float* Lwk = Lwq + 2048;
    LAS float* Lwv = Lwk + 2048;
    LAS unsigned char* Lwif = lds + MLP_WIF;
    const int g = lane >> 4, tk = lane & 15;
    for (int item = blockIdx.x; item < 256; item += G) {
        const int hd = item & 7, tr = item >> 3;
        __syncthreads();
        for (int i = tid; i < 2560; i += NTHREADS) Lcw[i] = conv_w[(i >> 9) * 4096 + hd * 512 + (i & 511)];
        Lcb[tid] = conv_b[hd * 512 + tid];
        for (int i = tid; i < 2048; i += NTHREADS) { Lwq[i] = wq[hd * 2048 + i]; Lwk[i] = wk[hd * 2048 + i]; Lwv[i] = wv[hd * 2048 + i]; }
        for (int i = tid; i < 32 * 3 * 64; i += NTHREADS) { const int n = i / 192, rem = i - n * 192, sec = rem >> 6, c16 = rem & 63;
            *(LAS u32x4*)(Lwif + n * MLP_WROW + sec * 1024 + c16 * 16) = *(const u32x4*)(WTif + (size_t)n * 12288 + sec * 4096 + hd * 512 + c16 * 8); }
        __syncthreads();
        for (int tt = wave; tt < 16; tt += 8) {
            const int tok = tr * 256 + tt * 16 + tk, tseq = tok & 2047;
            f32x4 accp[2]; accp[0] = (f32x4){0.f, 0.f, 0.f, 0.f}; accp[1] = (f32x4){0.f, 0.f, 0.f, 0.f};
            u32x4 xrA[5], xrB[5], hq, hk, hv, hc;
#define MLP_LOAD(xr_, step_) do { const int ch_ = hd * 512 + (step_) * 32 + 8 * g; \
                _Pragma("unroll") for (int jt = 0; jt < 5; ++jt) { const int dt = jt - 2; const bool ok = (unsigned)(tseq + dt) < (unsigned)SEQ; \
                    xr_[jt] = (u32x4){0u, 0u, 0u, 0u}; if (ok) xr_[jt] = *(const u32x4*)(XZ + (size_t)(tok + dt) * 8192 + ch_); } } while (0)
#define MLP_COMPUTE(xr_, step_, HOLD_) do { \
                const int cl = (step_) * 32 + 8 * g, ch = hd * 512 + cl; \
                float a[8], xm[8]; \
                { const f32x4 b0 = *(const LAS f32x4*)(Lcb + cl), b1 = *(const LAS f32x4*)(Lcb + cl + 4); \
                  a[0] = b0.x; a[1] = b0.y; a[2] = b0.z; a[3] = b0.w; a[4] = b1.x; a[5] = b1.y; a[6] = b1.z; a[7] = b1.w; } \
                _Pragma("unroll") for (int jt = 0; jt < 5; ++jt) { \
                    const u32x4 xr = xr_[jt]; \
                    const float xv[8] = {bf_lo(xr.x), bf_hi(xr.x), bf_lo(xr.y), bf_hi(xr.y), bf_lo(xr.z), bf_hi(xr.z), bf_lo(xr.w), bf_hi(xr.w)}; \
                    const f32x4 w0 = *(const LAS f32x4*)(Lcw + jt * 512 + cl), w1 = *(const LAS f32x4*)(Lcw + jt * 512 + cl + 4); \
                    a[0] += xv[0] * w0.x; a[1] += xv[1] * w0.y; a[2] += xv[2] * w0.z; a[3] += xv[3] * w0.w; a[4] += xv[4] * w1.x; a[5] += xv[5] * w1.y; a[6] += xv[6] * w1.z; a[7] += xv[7] * w1.w; \
                    if (jt == 2) { _Pragma("unroll") for (int i = 0; i < 8; ++i) xm[i] = xv[i]; } } \
                float xc[8], q[8], k[8], v[8]; \
                _Pragma("unroll") for (int i = 0; i < 8; ++i) xc[i] = silu_f(a[i]); \
                _Pragma("unroll") for (int blk = 0; blk < 2; ++blk) { const int wo = ((cl >> 2) + blk) * 16; \
                    _Pragma("unroll") for (int o = 0; o < 4; ++o) { float sq = 0.f, sk = 0.f, sv = 0.f; \
                        _Pragma("unroll") for (int i = 0; i < 4; ++i) { sq += xc[4 * blk + i] * Lwq[wo + i * 4 + o]; sk += xc[4 * blk + i] * Lwk[wo + i * 4 + o]; sv += xm[4 * blk + i] * Lwv[wo + i * 4 + o]; } \
                        q[4 * blk + o] = sq; k[4 * blk + o] = sk; v[4 * blk + o] = sv; } } \
                u32x4 qw, kw, vw, cw; \
                qw.x = cvt_pk_bf16(q[0], q[1]); qw.y = cvt_pk_bf16(q[2], q[3]); qw.z = cvt_pk_bf16(q[4], q[5]); qw.w = cvt_pk_bf16(q[6], q[7]); \
                kw.x = cvt_pk_bf16(k[0], k[1]); kw.y = cvt_pk_bf16(k[2], k[3]); kw.z = cvt_pk_bf16(k[4], k[5]); kw.w = cvt_pk_bf16(k[6], k[7]); \
                vw.x = cvt_pk_bf16(v[0], v[1]); vw.y = cvt_pk_bf16(v[2], v[3]); vw.z = cvt_pk_bf16(v[4], v[5]); vw.w = cvt_pk_bf16(v[6], v[7]); \
                cw.x = cvt_pk_bf16(xc[0], xc[1]); cw.y = cvt_pk_bf16(xc[2], xc[3]); cw.z = cvt_pk_bf16(xc[4], xc[5]); cw.w = cvt_pk_bf16(xc[6], xc[7]); \
                const size_t o4 = (size_t)tok * 4096 + ch; \
                if (HOLD_) { hq = qw; hk = kw; hv = vw; hc = cw; }     \
                else { *(u32x4*)(Q + o4 - 32) = hq; *(u32x4*)(Q + o4) = qw; *(u32x4*)(Kb + o4 - 32) = hk; *(u32x4*)(Kb + o4) = kw; *(u32x4*)(V + o4 - 32) = hv; *(u32x4*)(V + o4) = vw; *(u32x4*)(XC + o4 - 32) = hc; *(u32x4*)(XC + o4) = cw; } \
                const bf16x8 qf = __builtin_bit_cast(bf16x8, qw), kf = __builtin_bit_cast(bf16x8, kw), vf = __builtin_bit_cast(bf16x8, vw); \
                _Pragma("unroll") for (int nt = 0; nt < 2; ++nt) { const LAS unsigned char* wp = Lwif + (nt * 16 + tk) * MLP_WROW + cl * 2; \
                    accp[nt] = __builtin_amdgcn_mfma_f32_16x16x32_bf16(qf, *(const LAS bf16x8*)(wp), accp[nt], 0, 0, 0); \
                    accp[nt] = __builtin_amdgcn_mfma_f32_16x16x32_bf16(kf, *(const LAS bf16x8*)(wp + 1024), accp[nt], 0, 0, 0); \
                    accp[nt] = __builtin_amdgcn_mfma_f32_16x16x32_bf16(vf, *(const LAS bf16x8*)(wp + 2048), accp[nt], 0, 0, 0); } } while (0)
            MLP_LOAD(xrA, 0);
#pragma unroll 1
            for (int step = 0; step < 16; step += 2) {
                MLP_LOAD(xrB, step + 1);
                MLP_COMPUTE(xrA, step, true);
                { const int sn = (step + 2 < 16) ? step + 2 : 15; MLP_LOAD(xrA, sn); }
                MLP_COMPUTE(xrB, step + 1, false);
            }
#undef MLP_LOAD
#undef MLP_COMPUTE
#pragma unroll
            for (int nt = 0; nt < 2; ++nt)
#pragma unroll
                for (int e = 0; e < 4; ++e) pre_part[((size_t)hd * 32 + nt * 16 + tk) * MTOK + tr * 256 + tt * 16 + 4 * g + e] = accp[nt][e];
        }
    }
}

constexpr int ML_QS0 = 0, ML_KS0 = 16384, ML_QS1 = 32768, ML_KS1 = 49152, ML_VS0 = 65536, ML_VS1 = 81920, ML_WV = 98304, ML_SS = 114688, ML_SM = 123904;
constexpr int ML_XS = ML_QS1, ML_XN = ML_QS1;
constexpr int GB_U = 0, GB_MR = 64, GB_W = 128, GB_INT = 192, GB_BND = 256, GB_SC = 320;
constexpr int SM_DIN0 = 768, SM_DIN1 = 832, SM_NV = 896, SM_NVP = 1408, SM_DNQP = 3456, SM_GS = 3968, SM_CMX = 4000, SM_MC = 4032, SM_END = 4096;
static_assert(ML_SM + SM_END * 4 <= LDS_BYTES - 16, "mLSTM LDS");
constexpr float KSCALE = 0.04419417382415922f;

DI s16x4 tr_read(LAS unsigned char* p) { return __builtin_amdgcn_ds_read_tr16_b64_v4i16((LAS s16x4*)p); }
DI int dimg(int row, int ch) { return 2048 * (row >> 3) + 512 * (ch >> 2) + 64 * (row & 7) + 16 * ((ch & 3) ^ ((row >> 2) & 3)); }
DI bf16x8 frag_tr(LAS unsigned char* img, int k0, int c0, int lane) {
    const int h = lane >> 5, blk = (lane >> 4) & 1, q = (lane & 15) >> 2, p = lane & 3;
    const int row = k0 + 8 * h + q, ch = (c0 >> 3) + 2 * blk + (p >> 1), sub = 8 * (p & 1);
    const s16x4 lo = tr_read(img + dimg(row, ch) + sub), hi = tr_read(img + dimg(row + 4, ch) + sub);
    return __builtin_shufflevector(lo, hi, 0, 1, 2, 3, 4, 5, 6, 7);
}
#define MFMA32(a, b, c) __builtin_amdgcn_mfma_f32_32x32x16_bf16((a), (b), (c), 0, 0, 0)
DI void tr_batch4(bf16x8 (&f)[4], unsigned alo, unsigned ahi) {
    s16x4 l0, l1, l2, l3, h0, h1, h2, h3;
    asm volatile("ds_read_b64_tr_b16 %0, %8\n\tds_read_b64_tr_b16 %4, %9\n\tds_read_b64_tr_b16 %1, %8 offset:4096\n\tds_read_b64_tr_b16 %5, %9 offset:4096\n\t"
                 "ds_read_b64_tr_b16 %2, %8 offset:8192\n\tds_read_b64_tr_b16 %6, %9 offset:8192\n\tds_read_b64_tr_b16 %3, %8 offset:12288\n\tds_read_b64_tr_b16 %7, %9 offset:12288\n\t"
                 "s_waitcnt lgkmcnt(0)"
                 : "=&v"(l0), "=&v"(l1), "=&v"(l2), "=&v"(l3), "=&v"(h0), "=&v"(h1), "=&v"(h2), "=&v"(h3) : "v"(alo), "v"(ahi) : "memory");
    f[0] = __builtin_shufflevector(l0, h0, 0, 1, 2, 3, 4, 5, 6, 7); f[1] = __builtin_shufflevector(l1, h1, 0, 1, 2, 3, 4, 5, 6, 7);
    f[2] = __builtin_shufflevector(l2, h2, 0, 1, 2, 3, 4, 5, 6, 7); f[3] = __builtin_shufflevector(l3, h3, 0, 1, 2, 3, 4, 5, 6, 7);
}

DI void tr_issue4(s16x4& l0, s16x4& l1, s16x4& l2, s16x4& l3, s16x4& h0, s16x4& h1, s16x4& h2, s16x4& h3, unsigned alo, unsigned ahi) {
    asm volatile("ds_read_b64_tr_b16 %0, %8\n\tds_read_b64_tr_b16 %4, %9\n\tds_read_b64_tr_b16 %1, %8 offset:4096\n\tds_read_b64_tr_b16 %5, %9 offset:4096\n\t"
                 "ds_read_b64_tr_b16 %2, %8 offset:8192\n\tds_read_b64_tr_b16 %6, %9 offset:8192\n\tds_read_b64_tr_b16 %3, %8 offset:12288\n\tds_read_b64_tr_b16 %7, %9 offset:12288"
                 : "=&v"(l0), "=&v"(l1), "=&v"(l2), "=&v"(l3), "=&v"(h0), "=&v"(h1), "=&v"(h2), "=&v"(h3) : "v"(alo), "v"(ahi) : "memory");
}
DI void tr_wait8(s16x4& l0, s16x4& l1, s16x4& l2, s16x4& l3, s16x4& h0, s16x4& h1, s16x4& h2, s16x4& h3) {
    asm volatile("s_waitcnt lgkmcnt(0)" : "+v"(l0), "+v"(l1), "+v"(l2), "+v"(l3), "+v"(h0), "+v"(h1), "+v"(h2), "+v"(h3) :: "memory");
}
#define TR_CAT(f, l, h) do { f[0] = __builtin_shufflevector(l##0, h##0, 0, 1, 2, 3, 4, 5, 6, 7); f[1] = __builtin_shufflevector(l##1, h##1, 0, 1, 2, 3, 4, 5, 6, 7); \
        f[2] = __builtin_shufflevector(l##2, h##2, 0, 1, 2, 3, 4, 5, 6, 7); f[3] = __builtin_shufflevector(l##3, h##3, 0, 1, 2, 3, 4, 5, 6, 7); } while (0)

template <int I>
DI void ml_step(LAS unsigned char* lds, u32x4 (&Cp)[8][2], f32x16 (&num)[2], f32x16& Sacc, float& dnq, int tid, int lane, int wave, int gb) {
    asm volatile("" : "+v"(lane)); asm volatile("" : "+v"(tid));
    constexpr int QS = (I & 1) ? ML_QS1 : ML_QS0, KS = (I & 1) ? ML_KS1 : ML_KS0;
    const int r = lane & 31, h = lane >> 5, vt = wave & 3, dpar = wave >> 2;
    LAS float* SM = (LAS float*)(lds + ML_SM);
#define ML_SEC1 { const int wS = wave & 3, st = wS >> 1, tt1 = wS & 1, kh = wave >> 2; \
      if (!(st == 1 && tt1 == 0)) { \
        _Pragma("unroll") for (int ks = 0; ks < 4; ++ks) { const int kk = 4 * kh + ks; \
            const bf16x8 a = *(const LAS bf16x8*)(lds + KS + dimg(32 * st + r, 2 * kk + h)); \
            const bf16x8 b = *(const LAS bf16x8*)(lds + QS + dimg(32 * tt1 + r, 2 * kk + h)); \
            Sacc = MFMA32(a, b, Sacc); } } }
#define ML_SEC4 { _Pragma("unroll") for (int jj = 0; jj < 2; ++jj) { const int dl = dpar + 2 * jj; \
        _Pragma("unroll") for (int s2 = 0; s2 < 2; ++s2) { const bf16x8 a = __builtin_bit_cast(bf16x8, Cp[2 * I + jj][s2]); \
            _Pragma("unroll") for (int tt = 0; tt < 2; ++tt) { LAS unsigned char* qb = lds + QS + 8 * h; \
                const s16x4 lo = *(const LAS s16x4*)(qb + dimg(32 * tt + r, 4 * dl + 2 * s2)), hi = *(const LAS s16x4*)(qb + dimg(32 * tt + r, 4 * dl + 2 * s2 + 1)); \
                num[tt] = MFMA32(a, __builtin_shufflevector(lo, hi, 0, 1, 2, 3, 4, 5, 6, 7), num[tt]); } } } }
#define ML_UPD(jj_) { _Pragma("unroll") for (int s2 = 0; s2 < 2; ++s2) { const u32x4 o = Cp[2 * I + (jj_)][s2]; u32x4 n; \
            n.x = cvt_pk_bf16(bf_lo(o.x) * decay + U[8 * s2 + 0], bf_hi(o.x) * decay + U[8 * s2 + 1]); n.y = cvt_pk_bf16(bf_lo(o.y) * decay + U[8 * s2 + 2], bf_hi(o.y) * decay + U[8 * s2 + 3]); \
            n.z = cvt_pk_bf16(bf_lo(o.z) * decay + U[8 * s2 + 4], bf_hi(o.z) * decay + U[8 * s2 + 5]); n.w = cvt_pk_bf16(bf_lo(o.w) * decay + U[8 * s2 + 6], bf_hi(o.w) * decay + U[8 * s2 + 7]); \
            asm volatile("" : "+v"(n)); Cp[2 * I + (jj_)][s2] = n; } }
#define ML_SEC5 { const float decay = SM[gb + GB_SC + 0]; \
      const int blk = (lane >> 4) & 1, q = (lane & 15) >> 2, p = lane & 3, sub = 8 * (p & 1), rlo = 8 * h + q; \
      const unsigned ldsu = (unsigned)(size_t)lds; const int chB = 4 * vt + 2 * blk + (p >> 1), chA0 = 4 * dpar + 2 * blk + (p >> 1), chA1 = chA0 + 8; \
      s16x4 bl0, bl1, bl2, bl3, bh0, bh1, bh2, bh3, al0, al1, al2, al3, ah0, ah1, ah2, ah3, cl0, cl1, cl2, cl3, ch0, ch1, ch2, ch3; \
      tr_issue4(bl0, bl1, bl2, bl3, bh0, bh1, bh2, bh3, ldsu + ML_WV + dimg(rlo, chB) + sub, ldsu + ML_WV + dimg(rlo + 4, chB) + sub); \
      tr_issue4(al0, al1, al2, al3, ah0, ah1, ah2, ah3, ldsu + KS + dimg(rlo, chA0) + sub, ldsu + KS + dimg(rlo + 4, chA0) + sub); \
      tr_wait8(al0, al1, al2, al3, ah0, ah1, ah2, ah3); tr_wait8(bl0, bl1, bl2, bl3, bh0, bh1, bh2, bh3); \
      tr_issue4(cl0, cl1, cl2, cl3, ch0, ch1, ch2, ch3, ldsu + KS + dimg(rlo, chA1) + sub, ldsu + KS + dimg(rlo + 4, chA1) + sub); \
      bf16x8 Bf[4], Af[4]; TR_CAT(Bf, bl, bh); TR_CAT(Af, al, ah); \
      f32x16 U; \
      _Pragma("unroll") for (int e = 0; e < 16; ++e) U[e] = 0.f; \
      _Pragma("unroll") for (int ks = 0; ks < 4; ++ks) U = MFMA32(Af[ks], Bf[ks], U); \
      ML_UPD(0) \
      tr_wait8(cl0, cl1, cl2, cl3, ch0, ch1, ch2, ch3); TR_CAT(Af, cl, ch); \
      _Pragma("unroll") for (int e = 0; e < 16; ++e) U[e] = 0.f; \
      _Pragma("unroll") for (int ks = 0; ks < 4; ++ks) U = MFMA32(Af[ks], Bf[ks], U); \
      ML_UPD(1) }
#define ML_SECV { { const int t = tid & 63, dg = tid >> 6; \
      const u32x4 q0 = *(const LAS u32x4*)(lds + QS + dimg(t, 2 * dg)), q1 = *(const LAS u32x4*)(lds + QS + dimg(t, 2 * dg + 1)); \
      const LAS f32x4* nv = (const LAS f32x4*)(SM + SM_NV + 128 * I + 16 * dg); \
      const f32x4 n0 = nv[0], n1 = nv[1], n2 = nv[2], n3 = nv[3]; \
      dnq += bf_lo(q0.x) * n0.x + bf_hi(q0.x) * n0.y + bf_lo(q0.y) * n0.z + bf_hi(q0.y) * n0.w + bf_lo(q0.z) * n1.x + bf_hi(q0.z) * n1.y + bf_lo(q0.w) * n1.z + bf_hi(q0.w) * n1.w \
           + bf_lo(q1.x) * n2.x + bf_hi(q1.x) * n2.y + bf_lo(q1.y) * n2.z + bf_hi(q1.y) * n2.w + bf_lo(q1.z) * n3.x + bf_hi(q1.z) * n3.y + bf_lo(q1.w) * n3.z + bf_hi(q1.w) * n3.w; } \
    { const int dp = tid & 63, sg = tid >> 6; float a0 = 0.f, a1 = 0.f; \
      const f32x4 wA = *(const LAS f32x4*)(SM + gb + GB_W + 8 * sg), wB = *(const LAS f32x4*)(SM + gb + GB_W + 8 * sg + 4); const float ww[8] = {wA.x, wA.y, wA.z, wA.w, wB.x, wB.y, wB.z, wB.w}; \
      _Pragma("unroll") for (int s = 0; s < 8; ++s) { const unsigned kk2 = *(const LAS unsigned*)(lds + KS + dimg(8 * sg + s, dp >> 2) + 4 * (dp & 3)); a0 += ww[s] * bf_lo(kk2); a1 += ww[s] * bf_hi(kk2); } \
      ((LAS unsigned*)(SM + SM_NVP))[sg * 256 + 64 * I + dp] = cvt_pk_bf16(a0, a1); } }
    ML_SEC1 ML_SEC4 ML_SEC5 ML_SECV
#undef ML_SEC1
#undef ML_SEC4
#undef ML_UPD
#undef ML_SEC5
#undef ML_SECV
}

DI float lane_read(float v, int src_lane) { return __builtin_bit_cast(float, __builtin_amdgcn_ds_bpermute(src_lane << 2, __builtin_bit_cast(int, v))); }
DI void ml_scan(float li_, float lf_, float& u_, float& cm_, float& bs_, int lane) {
    bs_ = lf_;
#pragma unroll
    for (int o_ = 1; o_ < 64; o_ <<= 1) { const float t_ = lane_read(bs_, (lane - o_) & 63); if (lane >= o_) bs_ += t_; }
    u_ = li_ - bs_; cm_ = u_;
#pragma unroll
    for (int o_ = 1; o_ < 64; o_ <<= 1) { const float t_ = lane_read(cm_, (lane - o_) & 63); if (lane >= o_) cm_ = fmaxf(cm_, t_); }
}
DI void ml_gates(LAS float* SM, float u_, float cm_, float bs_, int gbn, float m_, float cmx_, int lane) {
    const float M_ = fmaxf(m_, cm_), Ml_ = fmaxf(m_, cmx_);
    SM[gbn + GB_U + lane] = u_; SM[gbn + GB_MR + lane] = M_; SM[gbn + GB_W + lane] = __expf(u_ - Ml_) * KSCALE; SM[gbn + GB_INT + lane] = __expf(m_ - M_); SM[gbn + GB_BND + lane] = __expf(-(bs_ + M_));
    if (lane == 0) SM[gbn + GB_SC + 0] = __expf(m_ - Ml_);
}

DI void ml_dma_piece(const bf16_t* colbase, int b, int dir, int tau0, LAS unsigned char* tile, int j, int lane) {
    const int pos = lane & 31, rin = pos >> 2, row = 8 * (j >> 1) + rin, ch = 4 * (2 * (j & 1) + (lane >> 5)) + ((pos & 3) ^ ((row >> 2) & 3));
    const int tau = tau0 + row; const size_t tok = (size_t)(b * SEQ + (dir ? SEQ - 1 - tau : tau));
    __builtin_amdgcn_global_load_lds((const unsigned*)(colbase + tok * 4096 + ch * 8), (LAS unsigned*)(tile + 1024 * j), 16, 0, 0);
}

DI void mlstm_phase(const bf16_t* Q, const bf16_t* Kb, const bf16_t* V, const float* pre_part, const float* b_if, float* GLF, bf16_t* HF, bf16_t* HB,
                    LAS unsigned char* lds, int G, int vcu0, int tid0, int lane0, int wave) {
    LAS float* SM = (LAS float*)(lds + ML_SM);
    const int vt = wave & 3, dpar = wave >> 2;
    for (int item = vcu0; item < 256; item += G) {
        const int vs = item & 3, stream = item >> 2, dir = stream & 1, hd = (stream >> 1) & 7, b = stream >> 4;
        bf16_t* H = dir ? HB : HF;
        float* glf = GLF + (size_t)item * 10240;
        const bf16_t* qcol = Q + hd * 512; const bf16_t* kcol = Kb + hd * 512; const bf16_t* vcol = V + hd * 512 + vs * 128;
        __syncthreads();
        int tidp = tid0, lanep = lane0; asm volatile("" : "+v"(tidp)); asm volatile("" : "+v"(lanep));
        for (int tau = tidp; tau < SEQ; tau += NTHREADS) {
            const int tok = b * SEQ + (dir ? SEQ - 1 - tau : tau);
            float li = b_if[dir * 16 + hd], lfr = b_if[dir * 16 + 8 + hd];
#pragma unroll
            for (int h8 = 0; h8 < 8; ++h8) { const float* pp = pre_part + ((size_t)h8 * 32 + dir * 16 + hd) * MTOK + tok; li += pp[0]; lfr += pp[(size_t)8 * MTOK]; }
            glf[tau] = li; glf[2048 + tau] = fminf(lfr, 0.f) - log1pf(__expf(-fabsf(lfr)));
        }
        SM[SM_NV + tidp] = 0.f;
        ml_dma_piece(qcol, b, dir, 0, lds + ML_QS0, 2 * wave, lanep); ml_dma_piece(qcol, b, dir, 0, lds + ML_QS0, 2 * wave + 1, lanep);
        ml_dma_piece(kcol, b, dir, 0, lds + ML_KS0, 2 * wave, lanep); ml_dma_piece(kcol, b, dir, 0, lds + ML_KS0, 2 * wave + 1, lanep);
        ml_dma_piece(vcol, b, dir, 0, lds + ML_VS0, 2 * wave, lanep); ml_dma_piece(vcol, b, dir, 0, lds + ML_VS0, 2 * wave + 1, lanep);
        asm volatile("s_waitcnt vmcnt(0)" ::: "memory");
        __syncthreads();
        float u0 = 0.f, cm0 = 0.f, bs0 = 0.f;
#pragma unroll 1
        for (int cc = wave; cc < 32; cc += 8) {
            const float lic = __hip_atomic_load(glf + 64 * cc + lanep, __ATOMIC_RELAXED, __HIP_MEMORY_SCOPE_AGENT), lfc = __hip_atomic_load(glf + 2048 + 64 * cc + lanep, __ATOMIC_RELAXED, __HIP_MEMORY_SCOPE_AGENT);
            float uu, cmm, bss; ml_scan(lic, lfc, uu, cmm, bss, lanep);
            glf[4096 + 64 * cc + lanep] = uu; glf[6144 + 64 * cc + lanep] = cmm; glf[8192 + 64 * cc + lanep] = bss;
            if (lanep == 63) { SM[SM_GS + cc] = bss; SM[SM_CMX + cc] = cmm; }
            if (cc == 0) { u0 = uu; cm0 = cmm; bs0 = bss; }
        }
        asm volatile("s_waitcnt vmcnt(0)" ::: "memory");
        __syncthreads();
        if (tidp == 0) { float m = 0.f;
#pragma unroll 1
            for (int cc = 0; cc < 32; ++cc) { SM[SM_MC + cc] = m; m = SM[SM_GS + cc] + fmaxf(m, SM[SM_CMX + cc]); } }
        __syncthreads();
        if (wave == 0) ml_gates(SM, u0, cm0, bs0, 0, 0.f, SM[SM_CMX + 0], lanep);
        __syncthreads();
#define ML_WRITE_WV(VS_, gbx_) do { const float w_ = SM[(gbx_) + GB_W + lrow]; \
        _Pragma("unroll") for (int hh_ = 0; hh_ < 2; ++hh_) { const int o_ = dimg(lrow, lcc + 8 * hh_); const u32x4 x_ = *(const LAS u32x4*)(lds + (VS_) + o_); u32x4 y_; \
            y_.x = cvt_pk_bf16(bf_lo(x_.x) * w_, bf_hi(x_.x) * w_); y_.y = cvt_pk_bf16(bf_lo(x_.y) * w_, bf_hi(x_.y) * w_); y_.z = cvt_pk_bf16(bf_lo(x_.z) * w_, bf_hi(x_.z) * w_); y_.w = cvt_pk_bf16(bf_lo(x_.w) * w_, bf_hi(x_.w) * w_); \
            *(LAS u32x4*)(lds + ML_WV + o_) = y_; } } while (0)
        { const int lrow = tidp >> 3, lcc = tidp & 7; ML_WRITE_WV(ML_VS0, 0); }
        u32x4 Cp[8][2];
#pragma unroll
        for (int j = 0; j < 8; ++j) { Cp[j][0] = (u32x4){0u, 0u, 0u, 0u}; Cp[j][1] = (u32x4){0u, 0u, 0u, 0u}; }
#pragma unroll 1
        for (int c = 0; c < 32; ++c) {
            int lane = lane0, tid = tid0; asm volatile("" : "+v"(lane)); asm volatile("" : "+v"(tid));
            const int r = lane & 31, h = lane >> 5, lrow = tid >> 3, lcc = tid & 7;
            const int gb = (c & 1) * 384, gbn = 384 - gb, cn = (c + 1 < 32) ? c + 1 : 31;
            const int VSc = (c & 1) ? ML_VS1 : ML_VS0, VSn = (c & 1) ? ML_VS0 : ML_VS1;
            f32x16 num[2], Sacc; float dnq = 0.f;
#pragma unroll
            for (int e = 0; e < 16; ++e) { num[0][e] = 0.f; num[1][e] = 0.f; Sacc[e] = 0.f; }
#define ML_DMA_QK(QS_, KS_, c_, i_) do { ml_dma_piece(qcol + 128 * (i_), b, dir, 64 * (c_), lds + (QS_), 2 * wave, lane); ml_dma_piece(qcol + 128 * (i_), b, dir, 64 * (c_), lds + (QS_), 2 * wave + 1, lane); \
                ml_dma_piece(kcol + 128 * (i_), b, dir, 64 * (c_), lds + (KS_), 2 * wave, lane); ml_dma_piece(kcol + 128 * (i_), b, dir, 64 * (c_), lds + (KS_), 2 * wave + 1, lane); } while (0)
            asm volatile("s_waitcnt vmcnt(0)" ::: "memory"); __syncthreads(); ML_DMA_QK(ML_QS1, ML_KS1, c, 1);  ml_step<0>(lds, Cp, num, Sacc, dnq, tid, lane, wave, gb);
            asm volatile("s_waitcnt vmcnt(0)" ::: "memory"); __syncthreads(); ML_DMA_QK(ML_QS0, ML_KS0, c, 2);  ml_step<1>(lds, Cp, num, Sacc, dnq, tid, lane, wave, gb);
            asm volatile("s_waitcnt vmcnt(0)" ::: "memory"); __syncthreads(); ML_DMA_QK(ML_QS1, ML_KS1, c, 3);  ml_step<2>(lds, Cp, num, Sacc, dnq, tid, lane, wave, gb);
            asm volatile("s_waitcnt vmcnt(0)" ::: "memory"); __syncthreads(); ML_DMA_QK(ML_QS0, ML_KS0, cn, 0);
            ml_dma_piece(vcol, b, dir, 64 * cn, lds + VSn, 2 * wave, lane); ml_dma_piece(vcol, b, dir, 64 * cn, lds + VSn, 2 * wave + 1, lane);
            ml_step<3>(lds, Cp, num, Sacc, dnq, tid, lane, wave, gb);
            asm volatile("s_waitcnt vmcnt(0)" ::: "memory");
            __syncthreads();
            float un = 0.f, cmn = 0.f, bsn = 0.f;
            if (wave == 0) { un = __hip_atomic_load(glf + 4096 + 64 * cn + lane, __ATOMIC_RELAXED, __HIP_MEMORY_SCOPE_AGENT); cmn = __hip_atomic_load(glf + 6144 + 64 * cn + lane, __ATOMIC_RELAXED, __HIP_MEMORY_SCOPE_AGENT);
                             bsn = __hip_atomic_load(glf + 8192 + 64 * cn + lane, __ATOMIC_RELAXED, __HIP_MEMORY_SCOPE_AGENT); }
            { LAS f32x4* xs = (LAS f32x4*)(lds + ML_XS) + (size_t)((wave & 3) * 4) * 64 + lane;
              if (wave >= 4) {
#pragma unroll
                for (int gq = 0; gq < 4; ++gq) xs[gq * 64] = (f32x4){Sacc[4 * gq], Sacc[4 * gq + 1], Sacc[4 * gq + 2], Sacc[4 * gq + 3]}; } }
            SM[SM_DNQP + (tid >> 6) * 64 + (tid & 63)] = dnq;
            __syncthreads();
            if (wave < 4) {
                const int st = wave >> 1, tt1 = wave & 1, t = 32 * tt1 + r;
                const LAS f32x4* xs = (const LAS f32x4*)(lds + ML_XS) + (size_t)(wave * 4) * 64 + lane;
                const float Mt = SM[gb + GB_MR + t]; float dsum = 0.f;
#pragma unroll
                for (int gq = 0; gq < 4; ++gq) {
                    const f32x4 px = xs[gq * 64]; const int s0 = 32 * st + 8 * gq + 4 * h; const f32x4 us = *(const LAS f32x4*)(SM + gb + GB_U + s0);
                    float vv[4];
#pragma unroll
                    for (int e = 0; e < 4; ++e) { const float raw = (Sacc[4 * gq + e] + px[e]) * KSCALE; vv[e] = (s0 + e <= t) ? raw * __expf(us[e] - Mt) : 0.f; dsum += vv[e]; }
                    u32x2 w; w.x = cvt_pk_bf16(vv[0], vv[1]); w.y = cvt_pk_bf16(vv[2], vv[3]);
                    *(LAS u32x2*)(lds + ML_SS + t * 144 + s0 * 2) = w;
                }
                dsum += __shfl_xor(dsum, 32);
                if (h == 0) SM[(st ? SM_DIN1 : SM_DIN0) + t] = dsum;
            }
#pragma unroll
            for (int tt = 0; tt < 2; ++tt) { const float it = SM[gb + GB_INT + 32 * tt + r]; num[tt] = num[tt] * it; }
            __syncthreads();
#pragma unroll
            for (int k2 = 0; k2 < 2; ++k2) { const int ks = 2 * dpar + k2;
                const bf16x8 a = frag_tr(lds + VSc, 16 * ks, 32 * vt, lane);
#pragma unroll
                for (int tt = 0; tt < 2; ++tt) { const bf16x8 bb = *(const LAS bf16x8*)(lds + ML_SS + (32 * tt + r) * 144 + (16 * ks + 8 * h) * 2); num[tt] = MFMA32(a, bb, num[tt]); } }
            __syncthreads();
            { LAS f32x4* xn = (LAS f32x4*)(lds + ML_XN) + (size_t)(vt * 8) * 64 + lane;
              if (dpar == 1) {
#pragma unroll
                for (int tt = 0; tt < 2; ++tt)
#pragma unroll
                    for (int gq = 0; gq < 4; ++gq) xn[(tt * 4 + gq) * 64] = (f32x4){num[tt][4 * gq], num[tt][4 * gq + 1], num[tt][4 * gq + 2], num[tt][4 * gq + 3]}; } }
            if (wave == 0) ml_gates(SM, un, cmn, bsn, gbn, SM[SM_MC + cn], SM[SM_CMX + cn], lane);
            __syncthreads();
            if (dpar == 0) {
                const LAS f32x4* xn = (const LAS f32x4*)(lds + ML_XN) + (size_t)(vt * 8) * 64 + lane;
#pragma unroll
                for (int tt = 0; tt < 2; ++tt) { const int t = 32 * tt + r; float nq = 0.f;
#pragma unroll
                    for (int gI = 0; gI < 8; ++gI) nq += SM[SM_DNQP + gI * 64 + t];
                    const float den = SM[SM_DIN0 + t] + SM[SM_DIN1 + t] + SM[gb + GB_INT + t] * nq;
                    const float inv = 1.0f / fmaxf(fabsf(den), SM[gb + GB_BND + t]);
                    const int tau = 64 * c + t; const size_t ob = (size_t)(b * SEQ + (dir ? SEQ - 1 - tau : tau)) * 4096 + hd * 512 + vs * 128 + 32 * vt + 4 * h;
#pragma unroll
                    for (int gq = 0; gq < 4; ++gq) { const f32x4 px = xn[(tt * 4 + gq) * 64];
                        u32x2 w; w.x = cvt_pk_bf16((num[tt][4 * gq] + px.x) * inv, (num[tt][4 * gq + 1] + px.y) * inv); w.y = cvt_pk_bf16((num[tt][4 * gq + 2] + px.z) * inv, (num[tt][4 * gq + 3] + px.w) * inv);
                        *(u32x2*)(H + ob + 8 * gq) = w; } }
            }
            ML_WRITE_WV(VSn, gbn);
            { const float decay = SM[gb + GB_SC + 0];
              float acc_ = 0.f; const LAS unsigned* np_ = (const LAS unsigned*)(SM + SM_NVP) + (tid >> 1);
#pragma unroll
              for (int sgx = 0; sgx < 8; ++sgx) { const unsigned pr_ = np_[sgx * 256]; acc_ += (tid & 1) ? bf_hi(pr_) : bf_lo(pr_); }
              SM[SM_NV + tid] = decay * SM[SM_NV + tid] + acc_; }
        }
#undef ML_DMA_QK
#undef ML_WRITE_WV
    }
}

DI void ml_combine_phase(const bf16_t* HF, const bf16_t* HB, const bf16_t* XC, const bf16_t* XZ, const float* norm_g, const float* skip, bf16_t* MO, int gw, int NGW, int lane) {
    for (int idx = gw; idx < MTOK * ML_HEADS; idx += NGW) {
        const int tok = idx >> 3, hd = idx & 7; const int ch = hd * 512 + 8 * lane; const size_t o4 = (size_t)tok * 4096 + ch;
        const u32x4 a = *(const u32x4*)(HF + o4), bq = *(const u32x4*)(HB + o4), xcv = *(const u32x4*)(XC + o4), zv = *(const u32x4*)(XZ + (size_t)tok * 8192 + 4096 + ch);
        float ht[8] = {bf_lo(a.x) + bf_lo(bq.x), bf_hi(a.x) + bf_hi(bq.x), bf_lo(a.y) + bf_lo(bq.y), bf_hi(a.y) + bf_hi(bq.y), bf_lo(a.z) + bf_lo(bq.z), bf_hi(a.z) + bf_hi(bq.z), bf_lo(a.w) + bf_lo(bq.w), bf_hi(a.w) + bf_hi(bq.w)};
        const float xc[8] = {bf_lo(xcv.x), bf_hi(xcv.x), bf_lo(xcv.y), bf_hi(xcv.y), bf_lo(xcv.z), bf_hi(xcv.z), bf_lo(xcv.w), bf_hi(xcv.w)};
        const float z[8] = {bf_lo(zv.x), bf_hi(zv.x), bf_lo(zv.y), bf_hi(zv.y), bf_lo(zv.z), bf_hi(zv.z), bf_lo(zv.w), bf_hi(zv.w)};
        float s = 0.f;
#pragma unroll
        for (int i = 0; i < 8; ++i) s += ht[i];
        const float mu = wave_sum(s) * (1.f / 512.f); float q = 0.f;
#pragma unroll
        for (int i = 0; i < 8; ++i) { ht[i] -= mu; q += ht[i] * ht[i]; }
        const float rstd = 1.0f / sqrtf(wave_sum(q) * (1.f / 512.f) + 1e-5f);
        const f32x4 g0 = *(const f32x4*)(norm_g + ch), g1 = *(const f32x4*)(norm_g + ch + 4), k0 = *(const f32x4*)(skip + ch), k1 = *(const f32x4*)(skip + ch + 4);
        const float gg[8] = {g0.x, g0.y, g0.z, g0.w, g1.x, g1.y, g1.z, g1.w}, sk[8] = {k0.x, k0.y, k0.z, k0.w, k1.x, k1.y, k1.z, k1.w};
        float o[8];
#pragma unroll
        for (int i = 0; i < 8; ++i) o[i] = (ht[i] * rstd * gg[i] + sk[i] * xc[i]) * sigmoid_f(z[i]);
        u32x4 w; w.x = cvt_pk_bf16(o[0], o[1]); w.y = cvt_pk_bf16(o[2], o[3]); w.z = cvt_pk_bf16(o[4], o[5]); w.w = cvt_pk_bf16(o[6], o[7]);
        *(u32x4*)(MO + o4) = w;
    }
}

DI void moe_offsets(const unsigned* ecnt, int (&cnt)[8], int (&off)[8], int& ntiles) {
    int acc = 0;
#pragma unroll
    for (int e = 0; e < 8; ++e) { cnt[e] = (int)ecnt[64 * e]; off[e] = acc * 256; acc += (cnt[e] + 255) >> 8; }
    ntiles = acc;
}
DI void moe_split_plan(int ntiles, int& nMf, int& nT, int& S) {
    nMf = (ntiles >> 5) << 5; nT = ntiles - nMf; S = 1;
    if (nT > 0) { S = (nT <= 4) ? 7 : (nT <= 8) ? 4 : (nT <= 16) ? 2 : 1; }
    if (S == 1) { nMf = ntiles; nT = 0; }
}
DI pg8::TileMap moe_tilemap(const int (&cnt)[8]) { pg8::TileMap tm; int acc = 0; tm.toff[0] = 0;
#pragma unroll
    for (int e = 0; e < 8; ++e) { acc += (cnt[e] + 255) >> 8; tm.toff[e + 1] = acc; }
    return tm; }
DI void moe_scatter_phase(const unsigned char* HA, unsigned char* HS, const int* tok_e, const int* tok_pos, int* slot_row, const unsigned* ecnt, int* tile_e, int gw, int NGW, int lane) {
    int cnt[8], off[8], ntiles; moe_offsets(ecnt, cnt, off, ntiles);
    if (gw == 0 && lane < 8) { const int e = lane; const int t0 = off[e] >> 8, nt = (cnt[e] + 255) >> 8; for (int t = 0; t < nt; ++t) tile_e[t0 + t] = e; }
    for (int id = gw; id < 2 * MTOK; id += NGW) {
        const int e = tok_e[id], pos = tok_pos[id]; int o = 0;
#pragma unroll
        for (int q = 0; q < 8; ++q) o = (e == q) ? off[q] : o;
        const int row = o + pos;
        if (lane == 0) slot_row[id] = row;
        const u32x4* src = (const u32x4*)(HA + (size_t)(id >> 1) * DM) + lane; u32x4* dst = (u32x4*)(HS + (size_t)row * DM) + lane;
#pragma unroll
        for (int j = 0; j < 2; ++j) dst[64 * j] = src[64 * j];
    }
#pragma unroll 1
    for (int e = 0; e < 8; ++e) { int c = 0, o = 0;
#pragma unroll
        for (int q = 0; q < 8; ++q) { c = (e == q) ? cnt[q] : c; o = (e == q) ? off[q] : o; }
        const int pend = ((c + 255) >> 8) << 8;
        for (int p = c + gw; p < pend; p += NGW) { u32x4* dst = (u32x4*)(HS + (size_t)(o + p) * DM) + lane;
#pragma unroll
            for (int j = 0; j < 2; ++j) dst[64 * j] = (u32x4){0u, 0u, 0u, 0u}; } }
}

DI f32x4 moe_yrow(const bf16_t* YS, const bf16_t* YSP, int r, int rsplit, int S, int nrs, int lane, int j) {
    if (r < rsplit) { const u32x2 a = ((const u32x2*)(YS + (size_t)r * DM) + lane)[64 * j]; return (f32x4){bf_lo(a.x), bf_hi(a.x), bf_lo(a.y), bf_hi(a.y)}; }
    f32x4 acc = (f32x4){0.f, 0.f, 0.f, 0.f};
    for (int s2 = 0; s2 < S; ++s2) { const u32x2 a = ((const u32x2*)(YSP + ((size_t)s2 * nrs + (r - rsplit)) * DM) + lane)[64 * j]; acc += (f32x4){bf_lo(a.x), bf_hi(a.x), bf_lo(a.y), bf_hi(a.y)}; }
    return acc;
}
DI void moe_combine_phase(const float* X3, const bf16_t* YS, const int* tok_e, const int* tok_pos, const float* tok_w, const float* gate, float* out, const unsigned* ecnt, int gw, int NGW, int lane) {
    int cnt[8], off[8], ntiles; moe_offsets(ecnt, cnt, off, ntiles);
    int nMf, nT, S; moe_split_plan(ntiles, nMf, nT, S); const int rsplit = nMf * 256; const bf16_t* YSP = YS + (size_t)MPAD * DM;
    for (int tok = gw; tok < MTOK; tok += NGW) {
        const int e0 = tok_e[2 * tok], e1 = tok_e[2 * tok + 1]; int o0 = 0, o1 = 0;
#pragma unroll
        for (int q = 0; q < 8; ++q) { o0 = (e0 == q) ? off[q] : o0; o1 = (e1 == q) ? off[q] : o1; }
        const int r0 = o0 + tok_pos[2 * tok], r1 = o1 + tok_pos[2 * tok + 1]; const float w0 = tok_w[2 * tok], w1 = tok_w[2 * tok + 1];
        const f32x4* x = (const f32x4*)(X3 + (size_t)tok * DM) + lane;
        const f32x4* gp = (const f32x4*)(gate + (size_t)(tok >> 11) * 12288) + lane; f32x4* o = (f32x4*)(out + (size_t)tok * DM) + lane;
#pragma unroll
        for (int j = 0; j < 8; ++j) { const f32x4 ya = moe_yrow(YS, YSP, r0, rsplit, S, nT * 256, lane, j), yb = moe_yrow(YS, YSP, r1, rsplit, S, nT * 256, lane, j);
            o[64 * j] = x[64 * j] + gp[64 * j] * (ya * w0 + yb * w1); }
    }
}

struct Params { const float* in[29]; float* out; unsigned char* ws; int ph_lo, ph_hi; };
static_assert(sizeof(Params) == 31 * 8 + 8, "Params has padding");
constexpr int NPHASE = 20;

#if DBG
#include "dbg_checks.inc"
#endif

__global__ void __launch_bounds__(NTHREADS, 2) mega_fwd(Params p) {
    extern __shared__ __attribute__((aligned(16))) unsigned char lds_raw[];
    LAS unsigned char* lds = (LAS unsigned char*)lds_raw;
    const int tid = threadIdx.x, lane = tid & 63, wave = __builtin_amdgcn_readfirstlane(tid >> 6);
    const int G = gridDim.x, gw = blockIdx.x * NWAVES + wave, NGW = G * NWAVES;
    const int vcu = (G % 8 == 0) ? (int)(blockIdx.x % 8) * (G / 8) + (int)(blockIdx.x / 8) : (int)blockIdx.x;
    const int gwx = vcu * NWAVES + wave;
    unsigned char* ws = p.ws;
    unsigned* ctl = (unsigned*)(ws + WS_CTL);
    volatile LAS unsigned* xbw = (volatile LAS unsigned*)(lds + LDS_BYTES - 16);
    if (tid == 0) { xbw[0] = 0u; xbw[1] = 0u; xbw[2] = 0u; xbw[3] = 0u; }
    __syncthreads();
    XcdBarrier bar = xcd_barrier_post(ctl + CW_BAR, xbw);
    const int lo = p.ph_lo, hi = p.ph_hi;
#ifndef PH_MASK
#define PH_MASK 0xFFFFFFu
#endif
#define IN(k) (((PH_MASK >> (k)) & 1u) && lo <= (k) && (k) < hi)
#define SEAM(k) do { if (IN((k) + 1)) xcd_barrier(bar); } while (0)
#ifndef REP_MASK
#define REP_MASK 0u
#endif
#define PHASE(k, ...) if (IN(k)) { { __VA_ARGS__ } if ((REP_MASK >> (k)) & 1u) { __syncthreads(); { __VA_ARGS__ } } SEAM(k); }

    float* mod = (float*)(ws + WS_MOD);
    float* pre_part = (float*)(ws + WS_PRE);
    int* tok_e = (int*)(ws + WS_ROUTE); int* tok_pos = tok_e + 2 * MTOK; float* tok_w = (float*)(tok_pos + 2 * MTOK); int* slot_row = (int*)(tok_w + 2 * MTOK);
    unsigned* ecnt = ctl + CW_ECNT; int* tile_e = (int*)(ctl + 12288);
    bf16_t* HA = (bf16_t*)(ws + WS_HA); float* X1 = (float*)(ws + WS_X1); float* X2 = (float*)(ws + WS_X2);
    bf16_t* WT_IN = (bf16_t*)(ws + WS_WT_IN); bf16_t* WT_OUT = (bf16_t*)(ws + WS_WT_OUT); bf16_t* WT_GU = (bf16_t*)(ws + WS_WT_GU); bf16_t* WT_DN = (bf16_t*)(ws + WS_WT_DN);
    bf16_t* WT_MLIN = (bf16_t*)(ws + WS_WT_MLIN); bf16_t* WT_MLOUT = (bf16_t*)(ws + WS_WT_MLOUT); bf16_t* WT_IF = (bf16_t*)(ws + WS_WT_IF);
    unsigned char* WT_MGU = ws + WS_WT_MGU; unsigned char* WT_MD = ws + WS_WT_MD;
    bf16_t* QK = (bf16_t*)(ws + A_QK); bf16_t* QKN = (bf16_t*)(ws + A_QKN); bf16_t* VT = (bf16_t*)(ws + A_VT); bf16_t* ATT = (bf16_t*)(ws + A_ATT); bf16_t* ACT = (bf16_t*)(ws + A_ACT);
    bf16_t* XZ = (bf16_t*)(ws + A_XZ); bf16_t* XC = (bf16_t*)(ws + A_XC); bf16_t* Qm = (bf16_t*)(ws + A_Q); bf16_t* Km = (bf16_t*)(ws + A_K); bf16_t* Vm = (bf16_t*)(ws + A_V);
    bf16_t* HF = (bf16_t*)(ws + A_HF); bf16_t* HB = (bf16_t*)(ws + A_HB); bf16_t* MO = (bf16_t*)(ws + A_MO);
    unsigned char* HS = ws + A_HS; unsigned char* ACTM = ws + A_ACTM; float* YS = (float*)(ws + A_YS);
    const float* x_in = p.in[0];

    PHASE(0,
        mod_phase(p.in[1], p.in[2], p.in[3], mod, lds, G, tid, lane, wave);
        LAS float* scrw = (LAS float*)lds + wave * (64 * 65);
        cvtw_job<0, false>(p.in[6] + 4096, 2048, 2048, 1, WT_IN + (size_t)4096 * 2048, 0, scrw, gw, NGW, lane, 1.f, 6144);
        cvtw_job<0, true>(p.in[6], 2048, 4096, 1, (unsigned char*)ACT + (size_t)32 * 1024 * 1024, 0, scrw, gw, NGW, lane, WSCALE, 6144);
        cvtw_job<0, false>(p.in[10], 2048, 2048, 1, WT_OUT, 0, scrw, gw, NGW, lane, 1.f);
        cvtw_job<1, false>(p.in[11], 2048, FFN, 1, WT_GU, 0, scrw, gw, NGW, lane, 1.f);
        cvtw_job<2, false>(p.in[12], 2048, FFN, 1, WT_GU, 0, scrw, gw, NGW, lane, 1.f);
        cvtw_job<0, false>(p.in[13], FFN, 2048, 1, WT_DN, 0, scrw, gw, NGW, lane, 1.f);
        cvtw_job<0, false>(p.in[14], 2048, 8192, 1, WT_MLIN, 0, scrw, gw, NGW, lane, 1.f);
        cvtw_job<0, false>(p.in[24], 4096, 2048, 1, WT_MLOUT, 0, scrw, gw, NGW, lane, 1.f);
        cvt_job<0>(p.in[20], 12288, 32, 1, WT_IF, 0, scrw, gw, NGW, lane);
        cvtw_job<1, true>(p.in[26], 2048, EDIM, 8, WT_MGU, (size_t)14336 * 2048, scrw, gw, NGW, lane, WSCALE);
        cvtw_job<2, true>(p.in[27], 2048, EDIM, 8, WT_MGU, (size_t)14336 * 2048, scrw, gw, NGW, lane, WSCALE);
        cvtw_job<0, true>(p.in[28], EDIM, 2048, 8, WT_MD, (size_t)2048 * EDIM, scrw, gw, NGW, lane, WSCALE); )
    PHASE(1,  rms_mod_phase<false, true>(x_in, p.in[4], mod + 1 * 2048, mod + 0 * 2048, HA, nullptr, nullptr, nullptr, nullptr, nullptr, (unsigned char*)ACT, gw, NGW, lane); )
    PHASE(2,
        { pg8::Gemm g{(const unsigned char*)ACT, (const unsigned char*)ACT + (size_t)32 * 1024 * 1024, MTOK, 4096, 2048, 0}; pg8::StaticOrder S; S.init(MTOK, 4096, G, (int)blockIdx.x); pg8::EpiQKNorm E{QKN, 4096, p.in[7], p.in[8], 1.0f / (HSCALE * WSCALE)}; pg8::gemm_phase<pg8::EpiQKNorm, pg8::StaticOrder, true>(lds, g, S, E); }
        { pg8::Gemm g{WT_IN + (size_t)4096 * 2048, HA, 2048, MTOK, 2048, 0}; pg8::StaticOrder S; S.init(2048, MTOK, G, (int)blockIdx.x); pg8::EpiBf16 E{VT, MTOK}; pg8::gemm_phase(lds, g, S, E); } )
    PHASE(4,  na_phase(QKN, VT, ATT, p.in[9], lds, G, vcu, tid, lane, wave); )
    PHASE(5,  pg8::Gemm g{ATT, WT_OUT, MTOK, 2048, 2048, 0}; pg8::StaticOrder S; S.init(MTOK, 2048, G, (int)blockIdx.x); pg8::EpiResGate E{x_in, X1, DM, mod + 2 * 2048, 12288}; pg8::gemm_phase(lds, g, S, E); )
    PHASE(6,  rms_mod_phase<false>(X1, p.in[5], mod + 4 * 2048, mod + 3 * 2048, HA, nullptr, nullptr, nullptr, nullptr, nullptr, nullptr, gw, NGW, lane); )
    PHASE(7,  pg8::Gemm g{HA, WT_GU, MTOK, 2 * FFN, 2048, 0}; pg8::StaticOrder S; S.init(MTOK, 2 * FFN, G, (int)blockIdx.x); pg8::EpiSwiGLU E{ACT, FFN}; pg8::gemm_phase(lds, g, S, E); )
    PHASE(8,  pg8::Gemm g{ACT, WT_DN, MTOK, 2048, FFN, 0}; pg8::StaticOrder S; S.init(MTOK, 2048, G, (int)blockIdx.x); pg8::EpiResGate E{X1, X2, DM, mod + 5 * 2048, 12288}; pg8::gemm_phase(lds, g, S, E); )
    PHASE(9,  rms_mod_phase<false>(X2, p.in[4] + DM, mod + 4 * 12288 + 1 * 2048, mod + 4 * 12288 + 0 * 2048, HA, nullptr, nullptr, nullptr, nullptr, nullptr, nullptr, gw, NGW, lane); )
    PHASE(10,  pg8::Gemm g{HA, WT_MLIN, MTOK, 8192, 2048, 0}; pg8::StaticOrder S; S.init(MTOK, 8192, G, (int)blockIdx.x); pg8::EpiBf16 E{XZ, 8192}; pg8::gemm_phase(lds, g, S, E); )
    PHASE(11,  ml_pre_phase(XZ, p.in[15], p.in[16], p.in[17], p.in[18], p.in[19], WT_IF, XC, Qm, Km, Vm, pre_part, lds, G, tid, lane, wave); )
    PHASE(12,  mlstm_phase(Qm, Km, Vm, pre_part, p.in[21], (float*)(ws + WS_GLF), HF, HB, lds, G, vcu, tid, lane, wave); )
    PHASE(13,  ml_combine_phase(HF, HB, XC, XZ, p.in[23], p.in[22], MO, gw, NGW, lane); )
    PHASE(14,  pg8::Gemm g{MO, WT_MLOUT, MTOK, 2048, 4096, 0}; pg8::StaticOrder S; S.init(MTOK, 2048, G, (int)blockIdx.x); pg8::EpiResGate E{X2, X1, DM, mod + 4 * 12288 + 2 * 2048, 12288}; pg8::gemm_phase(lds, g, S, E); )
    PHASE(15,  rms_mod_phase<true>(X1, p.in[5] + DM, mod + 4 * 12288 + 4 * 2048, mod + 4 * 12288 + 3 * 2048, HA, p.in[25], tok_e, tok_pos, tok_w, ecnt, HS, gw, NGW, lane); )
    PHASE(17,  int cnt[8], off[8], ntiles; moe_offsets(ecnt, cnt, off, ntiles);
        pg8::Gemm g{HS, WT_MGU, ntiles * 256, 2 * EDIM, 2048, 0}; pg8::MoeOrder S; S.init(ntiles, 2 * EDIM, G, (int)blockIdx.x, moe_tilemap(cnt), (size_t)14336 * 2048, (size_t)DM);
        pg8::EpiSwiGLU8 E{ACTM, EDIM, 1.0f / (HSCALE * WSCALE), ASCALE}; pg8::gemm_phase<pg8::EpiSwiGLU8, pg8::MoeOrder, true>(lds, g, S, E); )
    PHASE(18,  int cnt[8], off[8], ntiles; moe_offsets(ecnt, cnt, off, ntiles);
        pg8::Gemm g{ACTM, WT_MD, ntiles * 256, 2048, EDIM, 0};
        int nMf, nT, SS; moe_split_plan(ntiles, nMf, nT, SS); bf16_t* YSP = (bf16_t*)YS + (size_t)MPAD * DM;
        { pg8::MoeRowOrder S1; S1.init(nMf, G, (int)blockIdx.x, moe_tilemap(cnt), (size_t)2048 * EDIM); pg8::EpiBf16S E{(bf16_t*)YS, DM, 1.0f / (ASCALE * WSCALE), 0}; pg8::gemm_phase<pg8::EpiBf16S, pg8::MoeRowOrder, true>(lds, g, S1, E); }
        if (nT > 0) { pg8::Gemm g2 = g; g2.ntk = 56 / SS; pg8::MoeSplitOrder S2; S2.init(nMf, nT, SS, (size_t)(EDIM / SS), (int)blockIdx.x, moe_tilemap(cnt), (size_t)2048 * EDIM);
            pg8::EpiBf16S E2{YSP - (size_t)nMf * 256 * DM, DM, 1.0f / (ASCALE * WSCALE), (size_t)nT * 256 * DM}; pg8::gemm_phase<pg8::EpiBf16S, pg8::MoeSplitOrder, true>(lds, g2, S2, E2); } )
    PHASE(19,  moe_combine_phase(X1, (const bf16_t*)YS, tok_e, tok_pos, tok_w, mod + 4 * 12288 + 5 * 2048, p.out, ecnt, gw, NGW, lane); )
#undef IN
#undef SEAM
#undef PHASE
}

extern "C" void kernel_launch(void* const* d_in, const int* in_sizes, int n_in, void* d_out, int out_size, void* d_ws, size_t ws_size, hipStream_t stream) {
    static int grid = 0;
    if (grid == 0) {
        if (n_in != 29 || out_size != MTOK * DM || ws_size < WS_END) { fprintf(stderr, "kernel_launch: unexpected shapes (n_in %d out %d ws %zu need %zu)\n", n_in, out_size, ws_size, (size_t)WS_END); grid = -1; return; }
        int dev = 0, cus = 0, per_cu = 0;
        if (hipGetDevice(&dev) != hipSuccess || hipDeviceGetAttribute(&cus, hipDeviceAttributeMultiprocessorCount, dev) != hipSuccess) { grid = -1; return; }
        if (hipFuncSetAttribute((const void*)mega_fwd, hipFuncAttributeMaxDynamicSharedMemorySize, LDS_BYTES) != hipSuccess) { fprintf(stderr, "kernel_launch: hipFuncSetAttribute failed\n"); grid = -1; return; }
        if (hipOccupancyMaxActiveBlocksPerMultiprocessor(&per_cu, (const void*)mega_fwd, NTHREADS, LDS_BYTES) != hipSuccess || per_cu < 1) { fprintf(stderr, "kernel_launch: occupancy query says %d\n", per_cu); (void)hipGetLastError(); per_cu = 1; }
        grid = cus;
    }
    if (grid < 0) return;
    (void)hipMemsetAsync((char*)d_ws + WS_CTL, 0, CTL_BYTES, stream);
    Params p{};
    for (int i = 0; i < 29; ++i) p.in[i] = (const float*)d_in[i];
    p.out = (float*)d_out; p.ws = (unsigned char*)d_ws;
#if N_LAUNCH_SPLIT
    for (int k = 0; k < NPHASE; ++k) { p.ph_lo = k; p.ph_hi = k + 1; hipLaunchKernelGGL(mega_fwd, dim3(grid), dim3(NTHREADS), LDS_BYTES, stream, p); }
#else
    p.ph_lo = 0; p.ph_hi = NPHASE;
    hipLaunchKernelGGL(mega_fwd, dim3(grid), dim3(NTHREADS), LDS_BYTES, stream, p);
#endif
}
```

```cpp
#define PROBE_HOT 0
#ifndef GEMM_SCH
#define GEMM_SCH 1
#endif
#include <hip/hip_runtime.h>
#include <cstdio>
#include <cstdint>

#ifndef DBG
#define DBG 0
#endif
#ifndef N_LAUNCH_SPLIT
#define N_LAUNCH_SPLIT 0
#endif

#define LAS __attribute__((address_space(3)))
#define GAS __attribute__((address_space(1)))
#define DI __device__ __forceinline__
typedef unsigned short bf16_t;
typedef short bf16x8 __attribute__((ext_vector_type(8)));
typedef short s16x4 __attribute__((ext_vector_type(4)));
typedef float f32x2 __attribute__((ext_vector_type(2)));
typedef float f32x4 __attribute__((ext_vector_type(4)));
typedef float f32x16 __attribute__((ext_vector_type(16)));
typedef unsigned u32x2 __attribute__((ext_vector_type(2)));
typedef unsigned u32x4 __attribute__((ext_vector_type(4)));
typedef int i32x4 __attribute__((ext_vector_type(4)));
typedef int i32x8 __attribute__((ext_vector_type(8)));

constexpr int BATCH = 4, SEQ = 2048, DM = 2048, MTOK = BATCH * SEQ;
constexpr int GRID_W = 64, NA_HEADS = 16, NA_HD = 128;
constexpr int ML_INNER = 4096, ML_HEADS = 8, ML_HD = 512;
constexpr int FFN = 5632, NEXP = 8, EDIM = 7168;
constexpr int MPAD = 2 * MTOK + NEXP * 256;
constexpr int NTHREADS = 512, NWAVES = 8;
constexpr int LDS_BYTES = 147456;

constexpr size_t al256(size_t x) { return (x + 255) & ~(size_t)255; }
constexpr size_t WS_CTL = 0;
constexpr size_t CTL_BYTES = 65536;
constexpr size_t WS_MOD = WS_CTL + CTL_BYTES;
constexpr size_t WS_PRE = WS_MOD + al256((size_t)2 * 4 * 12288 * 4);
constexpr size_t WS_ROUTE = WS_PRE + (size_t)8 * MTOK * 32 * 4;
constexpr size_t WS_GLF = WS_ROUTE + (size_t)4 * MTOK * 2 * 4;
constexpr size_t WS_HA = WS_GLF + (size_t)256 * 10240 * 4;
constexpr size_t WS_X1 = WS_HA + (size_t)MTOK * DM * 2;
constexpr size_t WS_X2 = WS_X1 + (size_t)MTOK * DM * 4;
constexpr size_t WS_WT_IN = WS_X2 + (size_t)MTOK * DM * 4;
constexpr size_t WS_WT_OUT = WS_WT_IN + (size_t)6144 * 2048 * 2;
constexpr size_t WS_WT_GU = WS_WT_OUT + (size_t)2048 * 2048 * 2;
constexpr size_t WS_WT_DN = WS_WT_GU + (size_t)11264 * 2048 * 2;
constexpr size_t WS_WT_MLIN = WS_WT_DN + (size_t)2048 * 5632 * 2;
constexpr size_t WS_WT_MLOUT = WS_WT_MLIN + (size_t)8192 * 2048 * 2;
constexpr size_t WS_WT_IF = WS_WT_MLOUT + (size_t)2048 * 4096 * 2;
constexpr size_t WS_WT_MGU = WS_WT_IF + (size_t)32 * 12288 * 2;
constexpr size_t WS_WT_MD = WS_WT_MGU + (size_t)8 * 14336 * 2048;
constexpr size_t WS_ARENA = WS_WT_MD + (size_t)8 * 2048 * 7168;
constexpr size_t A_QK = WS_ARENA;
constexpr size_t A_QKN = A_QK + (size_t)MTOK * 4096 * 2;
constexpr size_t A_VT = A_QKN + (size_t)MTOK * 4096 * 2;
constexpr size_t A_ATT = A_VT + (size_t)2048 * MTOK * 2;
constexpr size_t A_ACT = A_ATT + (size_t)MTOK * DM * 2;
constexpr size_t A_L0_END = A_ACT + (size_t)MTOK * FFN * 2;
constexpr size_t A_XZ = WS_ARENA;
constexpr size_t A_XC = A_XZ + (size_t)MTOK * 8192 * 2;
constexpr size_t A_Q = A_XC + (size_t)MTOK * 4096 * 2;
constexpr size_t A_K = A_Q + (size_t)MTOK * 4096 * 2;
constexpr size_t A_V = A_K + (size_t)MTOK * 4096 * 2;
constexpr size_t A_HF = A_V + (size_t)MTOK * 4096 * 2;
constexpr size_t A_HB = A_HF + (size_t)MTOK * 4096 * 2;
constexpr size_t A_MO = A_HB + (size_t)MTOK * 4096 * 2;
constexpr size_t A_L1_END = A_MO + (size_t)MTOK * 4096 * 2;
constexpr size_t A_HS = WS_ARENA;
constexpr size_t A_ACTM = A_HS + (size_t)8 * 8192 * DM;
constexpr size_t A_YS = A_ACTM + (size_t)MPAD * EDIM;
constexpr size_t A_L2_END = A_YS + (size_t)MPAD * DM * 4;
constexpr size_t cmax(size_t a, size_t b) { return a > b ? a : b; }
constexpr size_t WS_END = cmax(cmax(A_L0_END, A_L1_END), A_L2_END);

constexpr int CW_BAR = 0;
constexpr int CW_ECNT = 4096;
constexpr int CW_DBG = 8192;

typedef __bf16 bf16x2_t __attribute__((ext_vector_type(2)));
DI unsigned cvt_pk_bf16(float lo, float hi) { const f32x2 v = {lo, hi}; return __builtin_bit_cast(unsigned, __builtin_convertvector(v, bf16x2_t)); }
DI float clamp448(float x) { return __builtin_fminf(__builtin_fmaxf(x, -448.f), 448.f); }
DI unsigned pk4_fp8(float a, float b, float c, float d) {
    int p = 0; p = __builtin_amdgcn_cvt_pk_fp8_f32(clamp448(a), clamp448(b), p, false); p = __builtin_amdgcn_cvt_pk_fp8_f32(clamp448(c), clamp448(d), p, true); return (unsigned)p; }
DI float bf_lo(unsigned u) { return __uint_as_float(u << 16); }
DI float bf_hi(unsigned u) { return __uint_as_float(u & 0xffff0000u); }
DI float bf2f(bf16_t b) { return __uint_as_float(((unsigned)b) << 16); }
DI bf16_t f2bf(float f) { return (bf16_t)(cvt_pk_bf16(f, 0.f) & 0xffffu); }
DI float wave_sum(float v) {
#pragma unroll
    for (int o = 1; o < 64; o <<= 1) v += __shfl_xor(v, o);
    return v;
}
DI float wave_max(float v) {
#pragma unroll
    for (int o = 1; o < 64; o <<= 1) v = fmaxf(v, __shfl_xor(v, o));
    return v;
}
DI float silu_f(float x) { return x / (1.f + __expf(-x)); }
DI float sigmoid_f(float x) { return 1.f / (1.f + __expf(-x)); }
#define LDS_WAIT() asm volatile("s_waitcnt lgkmcnt(0)" ::: "memory")
#define VM_WAIT() asm volatile("s_waitcnt vmcnt(0)" ::: "memory")

#define XB_TMO      128
#define XB_XCNT(j)  (256  + 64 * (j))
#define XB_XSUB(j)  (1280 + 64 * (j))
#define XB_XGEN(j)  (2304 + 64 * (j))
#define XB_TOP      3328
#define XB_TOPGEN   3392
#define XCD_BAR_WORDS 3456
#define XB_SPIN_CAP (1u << 22)

__device__ __forceinline__ unsigned xb_ld(unsigned* p)              { return __hip_atomic_load(p, __ATOMIC_RELAXED, __HIP_MEMORY_SCOPE_AGENT); }
__device__ __forceinline__ unsigned xb_add(unsigned* p, unsigned v) { return __hip_atomic_fetch_add(p, v, __ATOMIC_RELAXED, __HIP_MEMORY_SCOPE_AGENT); }
__device__ __forceinline__ unsigned xb_xcc_id() { return (unsigned)__builtin_amdgcn_s_getreg((3 << 11) | 20) & 0xFu; }
#define XB_SPIN(cond, bar) do { unsigned _sp = 0; while (cond) { __builtin_amdgcn_s_sleep(1); \
    if ((++_sp & 255u) == 0u) { if (xb_ld(&(bar)[XB_TMO])) break; if (_sp > XB_SPIN_CAP) { atomicAdd(&(bar)[XB_TMO], 1u); break; } } } } while (0)

struct XcdBarrier { unsigned* bar; unsigned x; volatile LAS unsigned* st; };

__device__ __forceinline__ XcdBarrier xcd_barrier_post(unsigned* bar, volatile LAS unsigned* st) {
    XcdBarrier b; b.bar = bar; b.x = xb_xcc_id(); b.st = st;
    if (threadIdx.x == 0) (void)xb_add(&bar[XB_XCNT(b.x)], 1u);
    return b;
}
__device__ __forceinline__ void xcd_barrier_complete(unsigned* bar, unsigned x, unsigned& nloc, unsigned& nx) {
    const unsigned G = gridDim.x * gridDim.y * gridDim.z;
    unsigned sum, cnt, mine, sp = 0u;
    for (;;) {
        sum = 0u; cnt = 0u; mine = 0u;
#pragma unroll
        for (unsigned j = 0; j < 16; ++j) { const unsigned c = xb_ld(&bar[XB_XCNT(j)]); sum += c; cnt += (c > 0u) ? 1u : 0u; mine = (j == x) ? c : mine; }
        if (sum == G) break;
        __builtin_amdgcn_s_sleep(1);
        if ((++sp & 255u) == 0u) { if (xb_ld(&bar[XB_TMO])) break; if (sp > XB_SPIN_CAP) { atomicAdd(&bar[XB_TMO], 1u); break; } }
    }
    nloc = mine > 0u ? mine : 1u; nx = cnt > 0u ? cnt : 1u;
}
__device__ __forceinline__ void xcd_barrier(const XcdBarrier& b) {
    asm volatile("s_waitcnt vmcnt(0)" ::: "memory");
    __syncthreads();
    if (threadIdx.x == 0) {
        unsigned* bar = b.bar;
        __builtin_amdgcn_s_waitcnt(0);
        unsigned nloc = b.st[0], nx = b.st[1];
        if (nloc == 0u) { xcd_barrier_complete(bar, b.x, nloc, nx); b.st[0] = nloc; b.st[1] = nx; }
        const unsigned old = xb_add(&bar[XB_XSUB(b.x)], 1u);
        const unsigned gen = old / nloc;
        if (old + 1u == (gen + 1u) * nloc) {
            __builtin_amdgcn_fence(__ATOMIC_RELEASE, "agent");
            asm volatile("s_waitcnt vmcnt(0)" ::: "memory");
            const unsigned og = xb_add(&bar[XB_TOP], 1u);
            const unsigned tg = og / nx;
            if (og + 1u == (tg + 1u) * nx) xb_add(&bar[XB_TOPGEN], 1u);
            else XB_SPIN(xb_ld(&bar[XB_TOPGEN]) == tg, bar);
            __builtin_amdgcn_fence(__ATOMIC_ACQUIRE, "agent");
            xb_add(&bar[XB_XGEN(b.x)], 1u);
            asm volatile("s_waitcnt vmcnt(0)" ::: "memory");
        } else {
            XB_SPIN(xb_ld(&bar[XB_XGEN(b.x)]) == gen, bar);
            __builtin_amdgcn_fence(__ATOMIC_ACQUIRE, "agent");
            asm volatile("s_waitcnt vmcnt(0)" ::: "memory");
        }
    }
    __syncthreads();
}

namespace pg8 {
constexpr int BM = 256, BK = 64, HALF = 128, HTB = HALF * BK * 2, STAGE_BYTES = 8 * HTB, NXCD = 8, WGM = 8;
__host__ __device__ __forceinline__ int lds_byte(int r, int c) { const int st = (r >> 4) * 2 + (c >> 5), rr = r & 15, cc = c & 31, ob = rr * 64 + cc * 2; return st * 1024 + (ob ^ (((ob >> 9) & 1) << 5)); }
__host__ __device__ __forceinline__ void stage_rc(int b, int& R, int& C) { const int st = b / 1024, sb = b % 1024, swz = sb ^ (((sb >> 9) & 1) << 5); R = (st >> 1) * 16 + swz / 64; C = (st & 1) * 32 + (swz % 64) / 2; }
__host__ __device__ __forceinline__ int perm32(int rho) { const int n = rho >> 4, i = rho & 15; return 8 * (i >> 2) + 4 * n + (i & 3); }

struct Unit { int pm, pn; size_t boff; size_t aoff; int slice; };
struct Gemm { const void* A; const void* Bt; int M, N, K; int ntk; };

struct StaticOrder {
    int nM, nN, nwg, G, c;
    __device__ void init(int M, int N, int G_, int c_) { nM = M / BM; nN = N / BM; nwg = nM * nN; G = G_; c = c_; }
    __device__ bool next(int i, Unit& u) const {
        const long L = (long)i * G + c; if (L >= nwg) return false;
        int wgid = (int)L; { const int q = nwg / NXCD, r = nwg % NXCD, xcd = wgid % NXCD, off = wgid / NXCD; wgid = (xcd < r ? xcd * (q + 1) : r * (q + 1) + (xcd - r) * q) + off; }
        const int nig = WGM * nN, gid = wgid / nig, fm = gid * WGM, gsz = (nM - fm) < WGM ? (nM - fm) : WGM;
        u.pm = fm + ((wgid % nig) % gsz); u.pn = (wgid % nig) / gsz; u.boff = 0; u.aoff = 0; u.slice = 0; return true;
    }
};
struct TileMap {
    int toff[9];
    __device__ __forceinline__ void lookup(int pm, int& e, int& k) const {
        e = (pm >= toff[1]) + (pm >= toff[2]) + (pm >= toff[3]) + (pm >= toff[4]) + (pm >= toff[5]) + (pm >= toff[6]) + (pm >= toff[7]);
        int t0 = 0;
#pragma unroll
        for (int q = 1; q < 8; ++q) t0 = (e == q) ? toff[q] : t0;
        k = pm - t0;
    }
};
constexpr int ECAP = 8192;
struct MoeOrder {
    int nM, nN, nwg, G, c; TileMap tm; size_t estride; size_t arowb;
    __device__ void init(int nM_, int N, int G_, int c_, const TileMap& tm_, size_t es, size_t arowb_) { nM = nM_; nN = N / BM; nwg = nM * nN; G = G_; c = c_; tm = tm_; estride = es; arowb = arowb_; }
    __device__ bool next(int i, Unit& u) const {
        const long L = (long)i * G + c; if (L >= nwg) return false;
        int wgid = (int)L; { const int q = nwg / NXCD, r = nwg % NXCD, xcd = wgid % NXCD, off = wgid / NXCD; wgid = (xcd < r ? xcd * (q + 1) : r * (q + 1) + (xcd - r) * q) + off; }
        const int nig = WGM * nN, gid = wgid / nig, fm = gid * WGM, gsz = (nM - fm) < WGM ? (nM - fm) : WGM;
        u.pm = fm + ((wgid % nig) % gsz); u.pn = (wgid % nig) / gsz; int e, k; tm.lookup(u.pm, e, k); u.boff = (size_t)e * estride;
        u.aoff = (size_t)((long)(e * ECAP + 256 * k - 256 * u.pm) * (long)arowb); u.slice = 0; return true;
    }
};

struct MoeRowOrder {
    int nwg, G, c; TileMap tm; size_t estride;
    __device__ void init(int nMf, int G_, int c_, const TileMap& tm_, size_t es) { nwg = nMf * 8; G = G_; c = c_; tm = tm_; estride = es; }
    __device__ bool next(int i, Unit& u) const {
        const long L = (long)i * G + c; if (L >= nwg) return false;
        u.pm = (int)(L >> 3); u.pn = (int)(L & 7); int e, k; tm.lookup(u.pm, e, k); u.boff = (size_t)e * estride; u.aoff = 0; u.slice = 0; return true;
    }
};
struct MoeSplitOrder {
    int pm0, nq, S, c; size_t kslice; TileMap tm; size_t estride;
    __device__ void init(int pm0_, int nT, int S_, size_t ks, int c_, const TileMap& tm_, size_t es) { pm0 = pm0_; S = S_; nq = nT * 8 * S_; kslice = ks; c = c_; tm = tm_; estride = es; }
    __device__ bool next(int i, Unit& u) const {
        if (i != 0 || c >= nq) return false;
        const int un = c / S; u.slice = c - un * S; u.pm = pm0 + (un >> 3); u.pn = un & 7; u.aoff = (size_t)u.slice * kslice; int e, k; tm.lookup(u.pm, e, k); u.boff = (size_t)e * estride + u.aoff; return true;
    }
};
struct EpiBf16 {
    static constexpr bool PERM = true, XBAR = false;
    bf16_t* O; int ldc;
    __device__ __forceinline__ void operator()(const f32x4 (&acc)[2][2][4][2], const Unit& u, int wr, int wc, int fr, int fq) const {
        const int row0 = u.pm * BM + wr * 64 + fr, col0 = u.pn * BM + wc * 32 + 8 * fq;
#pragma unroll
        for (int ai = 0; ai < 2; ++ai)
#pragma unroll
            for (int m = 0; m < 4; ++m) { bf16_t* rowp = O + (size_t)(row0 + ai * HALF + m * 16) * ldc + col0;
#pragma unroll
                for (int bj = 0; bj < 2; ++bj) { const f32x4 v0 = acc[ai][bj][m][0], v1 = acc[ai][bj][m][1];
                    u32x4 w; w.x = cvt_pk_bf16(v0[0], v0[1]); w.y = cvt_pk_bf16(v0[2], v0[3]); w.z = cvt_pk_bf16(v1[0], v1[1]); w.w = cvt_pk_bf16(v1[2], v1[3]);
                    *(u32x4*)(rowp + bj * HALF) = w; } }
    }
};
struct EpiQKNorm {
    static constexpr bool PERM = true, XBAR = true;
    bf16_t* O; int ldc; const float* qg; const float* kg; float sc;
    __device__ __forceinline__ void pre(const f32x4 (&acc)[2][2][4][2], int wr, int wc, int fr, int fq, LAS float* P) const {
#pragma unroll
        for (int ai = 0; ai < 2; ++ai)
#pragma unroll
            for (int m = 0; m < 4; ++m)
#pragma unroll
                for (int bj = 0; bj < 2; ++bj) { const f32x4 a = acc[ai][bj][m][0], b = acc[ai][bj][m][1];
                    float ss = (a[0] * a[0] + a[1] * a[1]) + (a[2] * a[2] + a[3] * a[3]) + (b[0] * b[0] + b[1] * b[1]) + (b[2] * b[2] + b[3] * b[3]);
                    ss += __shfl_xor(ss, 16); ss += __shfl_xor(ss, 32);
                    if (fq == 0) P[((ai * HALF + wr * 64 + m * 16 + fr) * 2 + bj) * 4 + wc] = ss * sc * sc; }
    }
    __device__ __forceinline__ void post(const f32x4 (&acc)[2][2][4][2], const Unit& u, int wr, int wc, int fr, int fq, const LAS float* P) const {
        const int row0 = u.pm * BM + wr * 64 + fr, col0 = u.pn * BM + wc * 32 + 8 * fq;
        f32x4 g0[2], g1[2]; float hs[2];
#pragma unroll
        for (int bj = 0; bj < 2; ++bj) { const int head = 2 * u.pn + bj; const float* gp = (head < 16 ? qg : kg) + wc * 32 + 8 * fq; g0[bj] = *(const f32x4*)gp; g1[bj] = *(const f32x4*)(gp + 4); hs[bj] = head < 16 ? 0.08838834764831845f : 1.0f; }
#pragma unroll
        for (int ai = 0; ai < 2; ++ai)
#pragma unroll
            for (int m = 0; m < 4; ++m) { bf16_t* rowp = O + (size_t)(row0 + ai * HALF + m * 16) * ldc + col0;
#pragma unroll
                for (int bj = 0; bj < 2; ++bj) { const f32x4 ps = *(const LAS f32x4*)(P + ((ai * HALF + wr * 64 + m * 16 + fr) * 2 + bj) * 4);
                    const float rstd = hs[bj] / sqrtf(((ps[0] + ps[1]) + (ps[2] + ps[3])) * (1.f / 128.f) + 1e-6f);
                    const f32x4 v0 = acc[ai][bj][m][0] * g0[bj] * (rstd * sc), v1 = acc[ai][bj][m][1] * g1[bj] * (rstd * sc);
                    u32x4 w; w.x = cvt_pk_bf16(v0[0], v0[1]); w.y = cvt_pk_bf16(v0[2], v0[3]); w.z = cvt_pk_bf16(v1[0], v1[1]); w.w = cvt_pk_bf16(v1[2], v1[3]);
                    *(u32x4*)(rowp + bj * HALF) = w; } }
    }
};
struct EpiBf16S {
    static constexpr bool PERM = true, XBAR = false;
    bf16_t* O; int ldc; float sc; size_t sstride;
    __device__ __forceinline__ void operator()(const f32x4 (&acc)[2][2][4][2], const Unit& u, int wr, int wc, int fr, int fq) const {
        const int row0 = u.pm * BM + wr * 64 + fr, col0 = u.pn * BM + wc * 32 + 8 * fq;
        bf16_t* Os = O + (size_t)u.slice * sstride;
#pragma unroll
        for (int ai = 0; ai < 2; ++ai)
#pragma unroll
            for (int m = 0; m < 4; ++m) { bf16_t* rowp = Os + (size_t)(row0 + ai * HALF + m * 16) * ldc + col0;
#pragma unroll
                for (int bj = 0; bj < 2; ++bj) { const f32x4 v0 = acc[ai][bj][m][0] * sc, v1 = acc[ai][bj][m][1] * sc;
                    u32x4 w; w.x = cvt_pk_bf16(v0[0], v0[1]); w.y = cvt_pk_bf16(v0[2], v0[3]); w.z = cvt_pk_bf16(v1[0], v1[1]); w.w = cvt_pk_bf16(v1[2], v1[3]);
                    *(u32x4*)(rowp + bj * HALF) = w; } }
    }
};
struct EpiSwiGLU {
    static constexpr bool PERM = true, XBAR = false;
    bf16_t* O; int ldc;
    __device__ __forceinline__ void operator()(const f32x4 (&acc)[2][2][4][2], const Unit& u, int wr, int wc, int fr, int fq) const {
        const int row0 = u.pm * BM + wr * 64 + fr, col0 = u.pn * HALF + wc * 32 + 8 * fq;
#pragma unroll
        for (int ai = 0; ai < 2; ++ai)
#pragma unroll
            for (int m = 0; m < 4; ++m) { bf16_t* rowp = O + (size_t)(row0 + ai * HALF + m * 16) * ldc + col0;
                float o[8];
#pragma unroll
                for (int n = 0; n < 2; ++n)
#pragma unroll
                    for (int j = 0; j < 4; ++j) { const float g = acc[ai][0][m][n][j], up = acc[ai][1][m][n][j]; o[n * 4 + j] = g * __builtin_amdgcn_rcpf(1.f + __expf(-g)) * up; }
                u32x4 w; w.x = cvt_pk_bf16(o[0], o[1]); w.y = cvt_pk_bf16(o[2], o[3]); w.z = cvt_pk_bf16(o[4], o[5]); w.w = cvt_pk_bf16(o[6], o[7]);
                *(u32x4*)rowp = w; }
    }
};
struct EpiSwiGLU8 {
    static constexpr bool PERM = true, XBAR = false;
    unsigned char* O; int ldc; float isc, osc;
    __device__ __forceinline__ void operator()(const f32x4 (&acc)[2][2][4][2], const Unit& u, int wr, int wc, int fr, int fq) const {
        const int row0 = u.pm * BM + wr * 64 + fr, col0 = u.pn * HALF + wc * 32 + 8 * fq;
#pragma unroll
        for (int ai = 0; ai < 2; ++ai)
#pragma unroll
            for (int m = 0; m < 4; ++m) { unsigned char* rowp = O + (size_t)(row0 + ai * HALF + m * 16) * ldc + col0;
                float o[8];
#pragma unroll
                for (int n = 0; n < 2; ++n)
#pragma unroll
                    for (int j = 0; j < 4; ++j) { const float g = acc[ai][0][m][n][j] * isc, up = acc[ai][1][m][n][j] * isc; o[n * 4 + j] = g * __builtin_amdgcn_rcpf(1.f + __expf(-g)) * up * osc; }
                u32x2 w; w.x = pk4_fp8(o[0], o[1], o[2], o[3]); w.y = pk4_fp8(o[4], o[5], o[6], o[7]);
                *(u32x2*)rowp = w; }
    }
};
struct EpiResGate {
    static constexpr bool PERM = false, XBAR = false;
    const float* base; float* out; int ldc; const float* gate; int gstride;
    __device__ __forceinline__ void operator()(const f32x4 (&acc)[2][2][4][2], const Unit& u, int wr, int wc, int fr, int fq) const {
        const int row0 = u.pm * BM + wr * 64 + fr, col0 = u.pn * BM + wc * 32 + 4 * fq;
        const float* gp = gate + (size_t)((u.pm * BM) >> 11) * gstride + col0;
        f32x4 gv[2][2];
#pragma unroll
        for (int bj = 0; bj < 2; ++bj)
#pragma unroll
            for (int n = 0; n < 2; ++n) gv[bj][n] = *(const f32x4*)(gp + bj * HALF + n * 16);
#pragma unroll
        for (int ai = 0; ai < 2; ++ai)
#pragma unroll
            for (int m = 0; m < 4; ++m) { const size_t off = (size_t)(row0 + ai * HALF + m * 16) * ldc + col0;
#pragma unroll
                for (int bj = 0; bj < 2; ++bj)
#pragma unroll
                    for (int n = 0; n < 2; ++n) { const f32x4 bs = *(const f32x4*)(base + off + bj * HALF + n * 16);
                        *(f32x4*)(out + off + bj * HALF + n * 16) = bs + gv[bj][n] * acc[ai][bj][m][n]; }
                asm volatile("" ::: "memory"); }
    }
};
struct EpiF32 {
    static constexpr bool PERM = false, XBAR = false;
    float* C; int ldc; float sc;
    __device__ __forceinline__ void operator()(const f32x4 (&acc)[2][2][4][2], const Unit& u, int wr, int wc, int fr, int fq) const {
        const int row0 = u.pm * BM + wr * 64 + fr, col0 = u.pn * BM + wc * 32 + 4 * fq;
#pragma unroll
        for (int ai = 0; ai < 2; ++ai)
#pragma unroll
            for (int m = 0; m < 4; ++m) { float* rowp = C + (size_t)(row0 + ai * HALF + m * 16) * ldc + col0;
#pragma unroll
                for (int bj = 0; bj < 2; ++bj)
#pragma unroll
                    for (int n = 0; n < 2; ++n) *(f32x4*)(rowp + bj * HALF + n * 16) = acc[ai][bj][m][n] * sc; }
    }
};

template <class Epi, class Sched, bool F8 = false, int HOT = 0, int SCH = GEMM_SCH>
__device__ __forceinline__ void gemm_phase(LAS unsigned char* lds, const Gemm g, const Sched& S, const Epi& E) {
    const int tid = threadIdx.x, wid = __builtin_amdgcn_readfirstlane(tid >> 6), lane = tid & 63, wr = wid >> 2, wc = wid & 3, fr = lane & 15, fq = lane >> 4;
    const int rowb = F8 ? g.K : 2 * g.K, nt = g.ntk ? g.ntk : rowb / (BK * 2);
    unsigned voffA[2], voffB[2];
#pragma unroll
    for (int i = 0; i < 2; ++i) { int R, C; stage_rc(tid * 16 + i * 8192, R, C); const int Rb = Epi::PERM ? ((R & ~31) + perm32(R & 31)) : R;
        voffA[i] = (unsigned)(R * rowb + C * 2); voffB[i] = (unsigned)(Rb * rowb + C * 2); }
    const size_t kstep = (size_t)(BK * 2);
    const size_t hstep = (size_t)HALF * rowb;
    const size_t tstep = 2 * hstep;
    const unsigned ldsw = (unsigned)wid * 1024u;
    const int aoff = lds_byte(wr * 64 + fr, fq * 8), boff = lds_byte(wc * 32 + fr, fq * 8);
#define PG8_SA(b, h) (((b) * 2 + (h)) * HTB)
#define PG8_SB(b, h) ((4 + (b) * 2 + (h)) * HTB)
#define PG8_STAGE(bufoff, gbase, voff) do { _Pragma("unroll") for (int _i = 0; _i < 2; ++_i) \
        __builtin_amdgcn_global_load_lds((const unsigned*)((const char*)(gbase) + (voff)[_i]), (LAS unsigned*)(lds + (bufoff) + ldsw + _i * 8192), 16, 0, 0); } while (0)
#define PG8_LD8(base_) __builtin_shufflevector(*(const LAS i32x4*)(base_), *(const LAS i32x4*)((base_) + 1024), 0, 1, 2, 3, 4, 5, 6, 7)
#define PG8_LDA(dst, b, h) do { _Pragma("unroll") for (int m = 0; m < 4; ++m) { if constexpr (F8) dst##8[m] = PG8_LD8(lds + PG8_SA(b, h) + aoff + m * 2048); \
        else { _Pragma("unroll") for (int k = 0; k < 2; ++k) dst[m][k] = *(const LAS bf16x8*)(lds + PG8_SA(b, h) + aoff + m * 2048 + k * 1024); } } } while (0)
#define PG8_LDB(dst, b, h) do { _Pragma("unroll") for (int n = 0; n < 2; ++n) { if constexpr (F8) dst##8[n] = PG8_LD8(lds + PG8_SB(b, h) + boff + n * 2048); \
        else { _Pragma("unroll") for (int k = 0; k < 2; ++k) dst[n][k] = *(const LAS bf16x8*)(lds + PG8_SB(b, h) + boff + n * 2048 + k * 1024); } } } while (0)
#define PG8_MMA(ai, bj, At, Bt) do { __builtin_amdgcn_s_setprio(1); _Pragma("unroll") for (int m = 0; m < 4; ++m) _Pragma("unroll") for (int n = 0; n < 2; ++n) { \
        if constexpr (F8) { asm volatile("v_mfma_f32_16x16x128_f8f6f4 %0, %1, %2, %0" : "+v"(acc[ai][bj][m][n]) : "v"(Bt##8[n]), "v"(At##8[m])); } \
        else { _Pragma("unroll") for (int k = 0; k < 2; ++k) acc[ai][bj][m][n] = __builtin_amdgcn_mfma_f32_16x16x32_bf16(Bt[n][k], At[m][k], acc[ai][bj][m][n], 0, 0, 0); } } \
        __builtin_amdgcn_s_setprio(0); } while (0)
#define PG8_WAIT_V(n) asm volatile("s_waitcnt vmcnt(" #n ")" ::: "memory")
#define PG8_WAIT_L(n) asm volatile("s_waitcnt lgkmcnt(" #n ")" ::: "memory")
#define PG8_BAR __builtin_amdgcn_s_barrier()
#define PG8_SCHED __builtin_amdgcn_sched_barrier(0)
    Unit cur, nxt; int ui = 0;
    if (!S.next(0, cur)) return;
    f32x4 acc[2][2][4][2];
#pragma unroll
    for (int a = 0; a < 2; ++a)
#pragma unroll
        for (int b = 0; b < 2; ++b)
#pragma unroll
            for (int m = 0; m < 4; ++m)
#pragma unroll
                for (int n = 0; n < 2; ++n) acc[a][b][m][n] = (f32x4){0.f, 0.f, 0.f, 0.f};
    bf16x8 At[4][2], B0[2][2], B1[2][2]; i32x8 At8[4], B08[2], B18[2];
    const char* cA = (const char*)g.A + cur.aoff + (size_t)(HOT ? 0 : cur.pm) * tstep; const char* cB = (const char*)g.Bt + cur.boff + (size_t)(HOT ? 0 : cur.pn) * tstep;
    if constexpr (SCH == 1) {
        PG8_STAGE(PG8_SB(0, 0), cB, voffB); PG8_STAGE(PG8_SB(0, 1), cB + hstep, voffB); PG8_STAGE(PG8_SA(0, 0), cA, voffA); PG8_STAGE(PG8_SA(0, 1), cA + hstep, voffA);
        if (wr == 1) PG8_BAR;
        PG8_WAIT_V(2); PG8_BAR;
        PG8_STAGE(PG8_SB(1, 0), cB + kstep, voffB); PG8_STAGE(PG8_SB(1, 1), cB + hstep + kstep, voffB); PG8_STAGE(PG8_SA(1, 0), cA + kstep, voffA);
        PG8_WAIT_V(6); PG8_BAR;
    } else {
    PG8_STAGE(PG8_SB(0, 0), cB, voffB); PG8_STAGE(PG8_SA(0, 0), cA, voffA); PG8_STAGE(PG8_SB(0, 1), cB + hstep, voffB); PG8_STAGE(PG8_SA(0, 1), cA + hstep, voffA);
    if (wr == 1) PG8_BAR;
    PG8_WAIT_V(4); PG8_BAR;
    PG8_STAGE(PG8_SB(1, 0), cB + kstep, voffB); PG8_STAGE(PG8_SA(1, 0), cA + kstep, voffA); PG8_STAGE(PG8_SB(1, 1), cB + hstep + kstep, voffB);
    PG8_WAIT_V(6); PG8_BAR;
    }
    for (;;) {
        const bool has_next = S.next(ui + 1, nxt);
        const char* nA = has_next ? (const char*)g.A + nxt.aoff + (size_t)(HOT ? 0 : nxt.pm) * tstep : cA; const char* nB = has_next ? (const char*)g.Bt + nxt.boff + (size_t)(HOT ? 0 : nxt.pn) * tstep : cB;
        for (int t = 0; t < nt; t += 2) {
            const bool last = (t == nt - 2);
            const char* a1 = cA + (size_t)(t + 1) * kstep;
            const char* a2 = last ? nA : cA + (size_t)(t + 2) * kstep; const char* b2 = last ? nB : cB + (size_t)(t + 2) * kstep;
            const char* a3 = a2 + kstep; const char* b3 = b2 + kstep;
            if constexpr (SCH == 1) {
                PG8_LDB(B0, 0, 0); PG8_LDB(B1, 0, 1); PG8_SCHED; PG8_LDA(At, 0, 0); PG8_STAGE(PG8_SA(1, 1), a1 + hstep, voffA);
                PG8_WAIT_V(8); PG8_WAIT_L(0); PG8_BAR; PG8_MMA(0, 0, At, B0); PG8_MMA(0, 1, At, B1); PG8_BAR; PG8_SCHED;
                PG8_LDA(At, 0, 1); PG8_STAGE(PG8_SB(0, 0), b2, voffB); PG8_STAGE(PG8_SB(0, 1), b2 + hstep, voffB); PG8_STAGE(PG8_SA(0, 0), a2, voffA);
                PG8_WAIT_V(8); PG8_WAIT_L(0); PG8_BAR; PG8_MMA(1, 0, At, B0); PG8_MMA(1, 1, At, B1); PG8_BAR; PG8_SCHED;
                PG8_LDB(B0, 1, 0); PG8_LDB(B1, 1, 1); PG8_SCHED; PG8_LDA(At, 1, 0); PG8_STAGE(PG8_SA(0, 1), a2 + hstep, voffA);
                PG8_WAIT_V(8); PG8_WAIT_L(0); PG8_BAR; PG8_MMA(0, 0, At, B0); PG8_MMA(0, 1, At, B1); PG8_BAR; PG8_SCHED;
                PG8_LDA(At, 1, 1); PG8_STAGE(PG8_SB(1, 0), b3, voffB); PG8_STAGE(PG8_SB(1, 1), b3 + hstep, voffB); PG8_STAGE(PG8_SA(1, 0), a3, voffA);
                PG8_WAIT_V(8); PG8_WAIT_L(0); PG8_BAR; PG8_MMA(1, 0, At, B0); PG8_MMA(1, 1, At, B1); PG8_BAR; PG8_SCHED;
                continue;
            }
            PG8_LDB(B0, 0, 0); PG8_SCHED; PG8_LDA(At, 0, 0); PG8_STAGE(PG8_SA(1, 1), a1 + hstep, voffA);
            PG8_WAIT_L(8); PG8_BAR; PG8_WAIT_L(0); PG8_MMA(0, 0, At, B0); PG8_BAR; PG8_SCHED;
            PG8_LDB(B1, 0, 1); PG8_STAGE(PG8_SB(0, 0), b2, voffB);
            PG8_BAR; PG8_WAIT_L(0); PG8_MMA(0, 1, At, B1); PG8_BAR;
            PG8_LDA(At, 0, 1); PG8_STAGE(PG8_SA(0, 0), a2, voffA);
            PG8_BAR; PG8_WAIT_L(0); PG8_MMA(1, 0, At, B0); PG8_BAR; PG8_SCHED;
            PG8_STAGE(PG8_SB(0, 1), b2 + hstep, voffB);
            PG8_WAIT_V(6); PG8_BAR; PG8_MMA(1, 1, At, B1); PG8_BAR;
            PG8_LDB(B0, 1, 0); PG8_SCHED; PG8_LDA(At, 1, 0); PG8_STAGE(PG8_SA(0, 1), a2 + hstep, voffA);
            PG8_WAIT_L(8); PG8_BAR; PG8_WAIT_L(0); PG8_MMA(0, 0, At, B0); PG8_BAR; PG8_SCHED;
            PG8_LDB(B1, 1, 1); PG8_STAGE(PG8_SB(1, 0), b3, voffB);
            PG8_BAR; PG8_WAIT_L(0); PG8_MMA(0, 1, At, B1); PG8_BAR;
            PG8_LDA(At, 1, 1); PG8_STAGE(PG8_SA(1, 0), a3, voffA);
            PG8_BAR; PG8_WAIT_L(0); PG8_MMA(1, 0, At, B0); PG8_BAR; PG8_SCHED;
            PG8_STAGE(PG8_SB(1, 1), b3 + hstep, voffB);
            PG8_WAIT_V(6); PG8_BAR; PG8_MMA(1, 1, At, B1); PG8_BAR;
        }
        if constexpr (F8) asm volatile("s_nop 15\n\ts_nop 15" ::: "memory");
        if constexpr (Epi::XBAR) { LAS float* P_ = (LAS float*)(lds + STAGE_BYTES); E.pre(acc, wr, wc, fr, fq, P_); PG8_WAIT_L(0); PG8_BAR; asm volatile("" ::: "memory"); E.post(acc, cur, wr, wc, fr, fq, P_); }
        else E(acc, cur, wr, wc, fr, fq);
        if (!has_next) break;
#pragma unroll
        for (int a = 0; a < 2; ++a)
#pragma unroll
            for (int b = 0; b < 2; ++b)
#pragma unroll
                for (int m = 0; m < 4; ++m)
#pragma unroll
                    for (int n = 0; n < 2; ++n) acc[a][b][m][n] = (f32x4){0.f, 0.f, 0.f, 0.f};
        cur = nxt; cA = nA; cB = nB; ++ui;
    }
    PG8_WAIT_V(0);
    if (wr == 0) PG8_BAR;
    PG8_BAR;
#undef PG8_SA
#undef PG8_SB
#undef PG8_STAGE
#undef PG8_LDA
#undef PG8_LDB
#undef PG8_MMA
#undef PG8_WAIT_V
#undef PG8_WAIT_L
#undef PG8_BAR
#undef PG8_SCHED
}
}

DI void mod_phase(const float* c, const float* mod_w, const float* mod_b, float* mod, LAS unsigned char* lds, int G, int tid, int lane, int wave) {
    LAS f32x4* cact = (LAS f32x4*)lds;
    LAS float* red = (LAS float*)(lds + 32768);
    for (int k = tid; k < DM; k += NTHREADS) { f32x4 v; v.x = silu_f(c[k]); v.y = silu_f(c[DM + k]); v.z = silu_f(c[2 * DM + k]); v.w = silu_f(c[3 * DM + k]); cact[k] = v; }
    __syncthreads();
    for (int it = blockIdx.x; it < 256; it += G) {
        const int l = it >> 7, n0 = (it & 127) * 96;
        float a0[4] = {0.f, 0.f, 0.f, 0.f}, a1[4] = {0.f, 0.f, 0.f, 0.f};
        if (lane < 48) {
            const float* wp = mod_w + ((size_t)l * DM + wave * 256) * 12288 + n0 + 2 * lane;
#pragma unroll 8
            for (int k = 0; k < 256; ++k) { const f32x2 w = *(const f32x2*)(wp + (size_t)k * 12288); const f32x4 cv = cact[wave * 256 + k];
                a0[0] += cv.x * w.x; a1[0] += cv.x * w.y; a0[1] += cv.y * w.x; a1[1] += cv.y * w.y; a0[2] += cv.z * w.x; a1[2] += cv.z * w.y; a0[3] += cv.w * w.x; a1[3] += cv.w * w.y; }
#pragma unroll
            for (int b = 0; b < 4; ++b) { red[(wave * 4 + b) * 96 + 2 * lane] = a0[b]; red[(wave * 4 + b) * 96 + 2 * lane + 1] = a1[b]; }
        }
        __syncthreads();
        if (tid < 384) { const int b = tid / 96, col = tid % 96; float s = mod_b[l * 12288 + n0 + col];
#pragma unroll
            for (int w = 0; w < 8; ++w) s += red[(w * 4 + b) * 96 + col];
            mod[((size_t)l * 4 + b) * 12288 + n0 + col] = s; }
        __syncthreads();
    }
}

template <int MODE>
DI void cvt_item(const float* W, int K, int N, bf16_t* WT, LAS float* scr, int kb, int nb, int lane) {
    const int k0 = 64 * kb, n0 = 32 * nb;
    float v[32];
    const float* wp = W + (size_t)(k0 + (lane >> 5)) * N + n0 + (lane & 31);
#pragma unroll
    for (int i = 0; i < 32; ++i) v[i] = wp[(size_t)(2 * i) * N];
#pragma unroll
    for (int i = 0; i < 32; ++i) scr[(2 * i + (lane >> 5)) * 33 + (lane & 31)] = v[i];
    LDS_WAIT();
    const int c = lane & 7;
#pragma unroll
    for (int j = 0; j < 4; ++j) { const int n = (lane >> 3) + 8 * j; const LAS float* s = scr + (8 * c) * 33 + n;
        u32x4 o; o.x = cvt_pk_bf16(s[0 * 33], s[1 * 33]); o.y = cvt_pk_bf16(s[2 * 33], s[3 * 33]); o.z = cvt_pk_bf16(s[4 * 33], s[5 * 33]); o.w = cvt_pk_bf16(s[6 * 33], s[7 * 33]);
        const int ng = n0 + n; const int row = (MODE == 0) ? ng : ((ng >> 7) * 256 + (ng & 127) + (MODE == 2 ? 128 : 0));
        *(u32x4*)(WT + (size_t)row * K + k0 + 8 * c) = o; }
    LDS_WAIT();
}
template <int MODE>
DI void cvt_item8(const float* W, int K, int N, unsigned char* WT, LAS float* scr, int kb, int nb, int lane, float wsc) {
    const int k0 = 64 * kb, n0 = 32 * nb;
    float v[32];
    const float* wp = W + (size_t)(k0 + (lane >> 5)) * N + n0 + (lane & 31);
#pragma unroll
    for (int i = 0; i < 32; ++i) v[i] = wp[(size_t)(2 * i) * N];
#pragma unroll
    for (int i = 0; i < 32; ++i) scr[(2 * i + (lane >> 5)) * 33 + (lane & 31)] = v[i] * wsc;
    LDS_WAIT();
    const int c = lane & 3;
#pragma unroll
    for (int j = 0; j < 2; ++j) { const int n = (lane >> 2) + 16 * j; const LAS float* s = scr + (16 * c) * 33 + n;
        u32x4 o; o.x = pk4_fp8(s[0 * 33], s[1 * 33], s[2 * 33], s[3 * 33]); o.y = pk4_fp8(s[4 * 33], s[5 * 33], s[6 * 33], s[7 * 33]);
        o.z = pk4_fp8(s[8 * 33], s[9 * 33], s[10 * 33], s[11 * 33]); o.w = pk4_fp8(s[12 * 33], s[13 * 33], s[14 * 33], s[15 * 33]);
        const int ng = n0 + n; const int row = (MODE == 0) ? ng : ((ng >> 7) * 256 + (ng & 127) + (MODE == 2 ? 128 : 0));
        *(u32x4*)(WT + (size_t)row * K + k0 + 16 * c) = o; }
    LDS_WAIT();
}
template <int MODE>
DI void cvt_job8(const float* W, int K, int N, int nbatch, unsigned char* WT, size_t dst_bstride, LAS float* scr, int gw, int NGW, int lane, float wsc) {
    const int nnb = N / 32, per = (K / 64) * nnb, total = per * nbatch;
    for (int it = gw; it < total; it += NGW) {
        const int bt = it / per, r = it - bt * per, kb = r / nnb, nb = r - kb * nnb;
        cvt_item8<MODE>(W + (size_t)bt * K * N, K, N, WT + (size_t)bt * dst_bstride, scr, kb, nb, lane, wsc);
    }
}
template <int MODE>
DI void cvt_job(const float* W, int K, int N, int nbatch, bf16_t* WT, size_t dst_bstride, LAS float* scr, int gw, int NGW, int lane) {
    const int nnb = N / 32, per = (K / 64) * nnb, total = per * nbatch;
    for (int it = gw; it < total; it += NGW) {
        const int bt = it / per, r = it - bt * per, kb = r / nnb, nb = r - kb * nnb;
        cvt_item<MODE>(W + (size_t)bt * K * N, K, N, WT + (size_t)bt * dst_bstride, scr, kb, nb, lane);
    }
}

DI void cvtw_load(f32x4 (&v)[16], const float* wp, int N) {
#pragma unroll
    for (int i = 0; i < 16; ++i) v[i] = __builtin_nontemporal_load((const f32x4*)(wp + (size_t)(4 * i) * N));
}
template <int MODE, bool OUT8>
DI void cvtw_store(const f32x4 (&v)[16], int K, void* WTb, LAS float* scr, int k0, int n0, int lane, float wsc) {
    const int kr = lane >> 4, n4 = lane & 15;
#pragma unroll
    for (int i = 0; i < 16; ++i)
#pragma unroll
        for (int e = 0; e < 4; ++e) scr[(4 * n4 + e) * 65 + 4 * i + kr] = OUT8 ? v[i][e] * wsc : v[i][e];
    LDS_WAIT();
    if (OUT8) {
        unsigned char* WT = (unsigned char*)WTb; const int c = lane & 3;
#pragma unroll
        for (int j = 0; j < 4; ++j) { const int n = (lane >> 2) + 16 * j; const LAS float* s = scr + n * 65 + 16 * c;
            u32x4 o; o.x = pk4_fp8(s[0], s[1], s[2], s[3]); o.y = pk4_fp8(s[4], s[5], s[6], s[7]); o.z = pk4_fp8(s[8], s[9], s[10], s[11]); o.w = pk4_fp8(s[12], s[13], s[14], s[15]);
            const int ng = n0 + n; const int row = (MODE == 0) ? ng : ((ng >> 7) * 256 + (ng & 127) + (MODE == 2 ? 128 : 0));
            *(u32x4*)(WT + (size_t)row * K + k0 + 16 * c) = o; }
    } else {
        bf16_t* WT = (bf16_t*)WTb; const int c = lane & 7;
#pragma unroll
        for (int j = 0; j < 8; ++j) { const int n = (lane >> 3) + 8 * j; const LAS float* s = scr + n * 65 + 8 * c;
            u32x4 o; o.x = cvt_pk_bf16(s[0], s[1]); o.y = cvt_pk_bf16(s[2], s[3]); o.z = cvt_pk_bf16(s[4], s[5]); o.w = cvt_pk_bf16(s[6], s[7]);
            const int ng = n0 + n; const int row = (MODE == 0) ? ng : ((ng >> 7) * 256 + (ng & 127) + (MODE == 2 ? 128 : 0));
            *(u32x4*)(WT + (size_t)row * K + k0 + 8 * c) = o; }
    }
    LDS_WAIT();
}
DI void cvtw_pack8(const f32x4 (&v)[16], LAS float* scr, int lane, float wsc, u32x4 (&o)[4]) {
    const int kr = lane >> 4, n4 = lane & 15;
#pragma unroll
    for (int i = 0; i < 16; ++i)
#pragma unroll
        for (int e = 0; e < 4; ++e) scr[(4 * n4 + e) * 65 + 4 * i + kr] = v[i][e] * wsc;
    LDS_WAIT();
    const int c = lane & 3;
#pragma unroll
    for (int j = 0; j < 4; ++j) { const int n = (lane >> 2) + 16 * j; const LAS float* s = scr + n * 65 + 16 * c;
        o[j].x = pk4_fp8(s[0], s[1], s[2], s[3]); o[j].y = pk4_fp8(s[4], s[5], s[6], s[7]); o[j].z = pk4_fp8(s[8], s[9], s[10], s[11]); o[j].w = pk4_fp8(s[12], s[13], s[14], s[15]); }
    LDS_WAIT();
}
template <int MODE, bool OUT8>
DI void cvtw_job(const float* W, int K, int N, int nbatch, void* WT, size_t dst_bstride_bytes, LAS float* scr, int gw, int NGW, int lane, float wsc, int ld = 0) {
    const int nnb = N / 64, per = (K / 128) * nnb, total = per * nbatch;
    for (int it = gw; it < total; it += NGW) {
        const int bt = it / per, r = it - bt * per, kb = r / nnb, nb = r - kb * nnb, k0 = 128 * kb, n0 = 64 * nb;
        const int pitch = ld ? ld : N;
        const float* wp = W + (size_t)bt * K * pitch + (size_t)(k0 + (lane >> 4)) * pitch + n0 + 4 * (lane & 15);
        f32x4 v0[16], v1[16];
        cvtw_load(v0, wp, pitch); cvtw_load(v1, wp + (size_t)64 * pitch, pitch);
        void* WTb = (unsigned char*)WT + (size_t)bt * dst_bstride_bytes;
        if (OUT8) {
            u32x4 o0[4], o1[4]; cvtw_pack8(v0, scr, lane, wsc, o0); cvtw_pack8(v1, scr, lane, wsc, o1);
            unsigned char* WT8 = (unsigned char*)WTb; const int c = lane & 3;
#pragma unroll
            for (int j = 0; j < 4; ++j) { const int ng = n0 + (lane >> 2) + 16 * j; const int row = (MODE == 0) ? ng : ((ng >> 7) * 256 + (ng & 127) + (MODE == 2 ? 128 : 0));
                unsigned char* dp = WT8 + (size_t)row * K + k0 + 16 * c; *(u32x4*)dp = o0[j]; *(u32x4*)(dp + 64) = o1[j]; }
        } else {
            cvtw_store<MODE, OUT8>(v0, K, WTb, scr, k0, n0, lane, wsc);
            cvtw_store<MODE, OUT8>(v1, K, WTb, scr, k0 + 64, n0, lane, wsc);
        }
    }
}

constexpr float HSCALE = 8.f, WSCALE = 256.f, ASCALE = 8.f;
template <bool ROUTER, bool OUT8 = false>
DI void rms_mod_phase(const float* X, const float* g, const float* scale, const float* shift, bf16_t* out,
                      const float* router, int* tok_e, int* tok_pos, float* tok_w, unsigned* ecnt, unsigned char* HS2, int gw, int NGW, int lane) {
    for (int row = gw; row < MTOK; row += NGW) {
        const int b = row >> 11;
        const f32x4* xr = (const f32x4*)(X + (size_t)row * DM) + lane;
        f32x4 v[8]; float ss = 0.f;
#pragma unroll
        for (int j = 0; j < 8; ++j) { v[j] = xr[64 * j]; ss += (v[j].x * v[j].x + v[j].y * v[j].y) + (v[j].z * v[j].z + v[j].w * v[j].w); }
        const float rstd = 1.0f / sqrtf(wave_sum(ss) * (1.f / DM) + 1e-6f);
        const f32x4* gp = (const f32x4*)g + lane; const f32x4* sc = (const f32x4*)(scale + (size_t)b * 12288) + lane; const f32x4* sh = (const f32x4*)(shift + (size_t)b * 12288) + lane;
        u32x2* op = (u32x2*)(out + (size_t)row * DM) + lane;
        float lg[8] = {0.f, 0.f, 0.f, 0.f, 0.f, 0.f, 0.f, 0.f}; unsigned h8[8];
#pragma unroll
        for (int j = 0; j < 8; ++j) { const f32x4 gg = gp[64 * j], s1 = sc[64 * j], s2 = sh[64 * j];
            f32x4 h = (v[j] * rstd) * gg; h = h * (s1 + 1.0f) + s2;
            if (ROUTER) { h8[j] = pk4_fp8(h.x * HSCALE, h.y * HSCALE, h.z * HSCALE, h.w * HSCALE); }
            else { u32x2 w; w.x = cvt_pk_bf16(h.x, h.y); w.y = cvt_pk_bf16(h.z, h.w); op[64 * j] = w;
                   if (OUT8) ((unsigned*)(HS2 + (size_t)row * DM) + lane)[64 * j] = pk4_fp8(h.x * HSCALE, h.y * HSCALE, h.z * HSCALE, h.w * HSCALE); }
            if (ROUTER) {
#pragma unroll
                for (int i = 0; i < 4; ++i) { const int cc = 256 * j + 4 * lane + i; const f32x4 r0 = ((const f32x4*)router)[cc * 2], r1 = ((const f32x4*)router)[cc * 2 + 1];
                    lg[0] += h[i] * r0.x; lg[1] += h[i] * r0.y; lg[2] += h[i] * r0.z; lg[3] += h[i] * r0.w; lg[4] += h[i] * r1.x; lg[5] += h[i] * r1.y; lg[6] += h[i] * r1.z; lg[7] += h[i] * r1.w; } } }
        if (ROUTER) {
#pragma unroll
            for (int e = 0; e < 8; ++e) lg[e] = wave_sum(lg[e]);
            if (lane == 0) {
                int i0 = 0; float v0 = lg[0];
#pragma unroll
                for (int e = 1; e < 8; ++e) if (lg[e] > v0) { v0 = lg[e]; i0 = e; }
                int i1 = -1; float v1 = -3.0e38f;
#pragma unroll
                for (int e = 0; e < 8; ++e) if (e != i0 && lg[e] > v1) { v1 = lg[e]; i1 = e; }
                const float w1 = 1.f / (1.f + expf(v0 - v1)), w0 = 1.f - w1;
                const int p0 = (int)__hip_atomic_fetch_add(ecnt + 64 * i0, 1u, __ATOMIC_RELAXED, __HIP_MEMORY_SCOPE_AGENT);
                const int p1 = (int)__hip_atomic_fetch_add(ecnt + 64 * i1, 1u, __ATOMIC_RELAXED, __HIP_MEMORY_SCOPE_AGENT);
                tok_e[2 * row] = i0; tok_e[2 * row + 1] = i1; tok_pos[2 * row] = p0; tok_pos[2 * row + 1] = p1; tok_w[2 * row] = w0; tok_w[2 * row + 1] = w1;
                lg[0] = __int_as_float(i0 * pg8::ECAP + p0); lg[1] = __int_as_float(i1 * pg8::ECAP + p1);
            }
            const int ra = __builtin_amdgcn_readfirstlane(__float_as_int(lg[0])), rb = __builtin_amdgcn_readfirstlane(__float_as_int(lg[1]));
            unsigned* da = (unsigned*)(HS2 + (size_t)ra * DM) + lane; unsigned* db = (unsigned*)(HS2 + (size_t)rb * DM) + lane;
#pragma unroll
            for (int j = 0; j < 8; ++j) { da[64 * j] = h8[j]; db[64 * j] = h8[j]; }
        }
    }
}

DI void qknorm_phase(const bf16_t* QK, bf16_t* QKN, const float* qg, const float* kg, int gw, int NGW, int lane) {
    const int l16 = lane & 15;
    for (int idx = gw * 4 + (lane >> 4); idx < MTOK * 32; idx += NGW * 4) {
        const int hr = idx & 31; const size_t off = (size_t)(idx >> 5) * 4096 + hr * 128 + 8 * l16;
        const u32x4 raw = *(const u32x4*)(QK + off);
        float x[8] = {bf_lo(raw.x), bf_hi(raw.x), bf_lo(raw.y), bf_hi(raw.y), bf_lo(raw.z), bf_hi(raw.z), bf_lo(raw.w), bf_hi(raw.w)};
        float ss = 0.f;
#pragma unroll
        for (int i = 0; i < 8; ++i) ss += x[i] * x[i];
        ss += __shfl_xor(ss, 1); ss += __shfl_xor(ss, 2); ss += __shfl_xor(ss, 4); ss += __shfl_xor(ss, 8);
        const float rstd = (1.0f / sqrtf(ss * (1.f / 128.f) + 1e-6f)) * (hr < 16 ? 0.08838834764831845f : 1.0f);
        const float* gp = (hr < 16 ? qg : kg) + 8 * l16;
        const f32x4 g0 = *(const f32x4*)gp, g1 = *(const f32x4*)(gp + 4);
        u32x4 o; o.x = cvt_pk_bf16(x[0] * rstd * g0.x, x[1] * rstd * g0.y); o.y = cvt_pk_bf16(x[2] * rstd * g0.z, x[3] * rstd * g0.w);
        o.z = cvt_pk_bf16(x[4] * rstd * g1.x, x[5] * rstd * g1.y); o.w = cvt_pk_bf16(x[6] * rstd * g1.z, x[7] * rstd * g1.w);
        *(u32x4*)(QKN + off) = o;
    }
}

constexpr int NA_TBL = 0, NA_BUF = 30720, NA_TILE = 18432;
DI void na_phase(const bf16_t* QKN, const bf16_t* VT, bf16_t* ATT, const float* rpb, LAS unsigned char* lds, int G, int vcu0, int tid, int lane, int wave) {
    LAS float* rpbL = (LAS float*)(lds + NA_TBL);
    for (int i = tid; i < 16 * 465; i += NTHREADS) rpbL[i] = rpb[i];
    const int c16 = lane & 15, g = lane >> 4, unit = wave >> 2, j = wave & 3;
    const int cb = (j == 0) ? 0 : (j == 1) ? 8 : (j == 2) ? 24 : 32;
    const int qc = 16 * j + c16, c0 = min(max(qc - 8, 0), 48);
    const int kcl = 8 * (c16 >> 2) + (c16 & 3);
    for (int p = vcu0; p < 1024; p += G) {
        const int rho = p & 15, hh = (p >> 4) & 15, b = p >> 8;
        const int rA = 2 * rho, r0A = min(max(rA - 4, 0), 24), r0B = min(max(rA + 1 - 4, 0), 24), delta = r0B - r0A, nrows = 8 + delta;
        const int r = rA + unit, r0 = unit ? r0B : r0A;
        const bool shiftB = (unit == 1) && (delta == 1);
        const size_t tq = (size_t)b * SEQ + r * 64 + qc;
        bf16x8 qf[4];
#pragma unroll
        for (int ks = 0; ks < 4; ++ks) qf[ks] = *(const bf16x8*)(QKN + tq * 4096 + hh * 128 + 32 * ks + 8 * g);
        f32x4 S[8][2];
        u32x4 st0, st1;
        const int kkey = tid >> 3, kch = tid & 7;
        const int vd = tid >> 2, vch = tid & 3;
        const bf16_t* kg = QKN + ((size_t)b * SEQ + (size_t)r0A * 64 + kkey) * 4096 + 2048 + hh * 128 + kch * 8;
        const bf16_t* vg = VT + (size_t)(hh * 128 + vd) * MTOK + (size_t)b * SEQ + (size_t)r0A * 64 + vch * 8;
#define NA_LDK(s_) do { st0 = *(const u32x4*)(kg + (size_t)(s_) * 64 * 4096); st1 = *(const u32x4*)(kg + (size_t)(s_) * 64 * 4096 + 64); } while (0)
#define NA_STK(s_) do { LAS unsigned char* t_ = lds + NA_BUF + ((s_) & 1) * NA_TILE + kkey * 272 + kch * 16; *(LAS u32x4*)t_ = st0; *(LAS u32x4*)(t_ + 128) = st1; } while (0)
#define NA_LDV(s_) do { st0 = *(const u32x4*)(vg + (s_) * 64); st1 = *(const u32x4*)(vg + (s_) * 64 + 32); } while (0)
#define NA_STV(s_) do { LAS unsigned char* t_ = lds + NA_BUF + ((s_) & 1) * NA_TILE + vd * 144 + vch * 16; *(LAS u32x4*)t_ = st0; *(LAS u32x4*)(t_ + 64) = st1; } while (0)
#define NA_QK(s_, i_) do { const LAS unsigned char* kb_ = lds + NA_BUF + ((s_) & 1) * NA_TILE + (cb + kcl) * 272 + 16 * g; \
            _Pragma("unroll") for (int hc = 0; hc < 2; ++hc) { f32x4 a = (f32x4){0.f, 0.f, 0.f, 0.f}; \
                _Pragma("unroll") for (int ks = 0; ks < 4; ++ks) a = __builtin_amdgcn_mfma_f32_16x16x32_bf16(*(const LAS bf16x8*)(kb_ + hc * 4 * 272 + 64 * ks), qf[ks], a, 0, 0, 0); S[i_][hc] = a; } } while (0)
#define NA_SROW(s_) do { if ((s_) < nrows) { NA_STK(s_); __syncthreads(); if ((s_) + 1 < nrows) NA_LDK((s_) + 1); \
            if (!shiftB) { if ((s_) < 8) NA_QK(s_, (s_) < 8 ? (s_) : 7); } else { if ((s_) >= 1) NA_QK(s_, (s_) >= 1 ? (s_) - 1 : 0); } } } while (0)
        __syncthreads();
        NA_LDK(0);
        NA_SROW(0); NA_SROW(1); NA_SROW(2); NA_SROW(3); NA_SROW(4); NA_SROW(5); NA_SROW(6); NA_SROW(7); NA_SROW(8);
        NA_LDV(0);
        float mx = -3.0e38f;
        const LAS float* bt = rpbL + hh * 465;
#pragma unroll
        for (int i = 0; i < 8; ++i)
#pragma unroll
            for (int hc = 0; hc < 2; ++hc)
#pragma unroll
                for (int e = 0; e < 4; ++e) {
                    const int kc = cb + 8 * g + 4 * hc + e; const bool valid = (kc >= c0) && (kc < c0 + 16);
                    const int dj = min(max(kc - qc + 15, 0), 30), di = r0 + i - r + 7;
                    const float sv = valid ? S[i][hc][e] + bt[di * 31 + dj] : -3.0e38f;
                    S[i][hc][e] = sv; mx = fmaxf(mx, sv);
                }
        mx = fmaxf(mx, __shfl_xor(mx, 16)); mx = fmaxf(mx, __shfl_xor(mx, 32));
        float sum = 0.f;
#pragma unroll
        for (int i = 0; i < 8; ++i)
#pragma unroll
            for (int hc = 0; hc < 2; ++hc)
#pragma unroll
                for (int e = 0; e < 4; ++e) { const float pv = (S[i][hc][e] > -1.0e38f) ? __expf(S[i][hc][e] - mx) : 0.f; S[i][hc][e] = pv; sum += pv; }
        sum += __shfl_xor(sum, 16); sum += __shfl_xor(sum, 32);
        const float inv = 1.0f / sum;
        f32x4 O[8];
#pragma unroll
        for (int dt = 0; dt < 8; ++dt) O[dt] = (f32x4){0.f, 0.f, 0.f, 0.f};
#define NA_PV(s_, i_) do { u32x4 pw; pw.x = cvt_pk_bf16(S[i_][0][0], S[i_][0][1]); pw.y = cvt_pk_bf16(S[i_][0][2], S[i_][0][3]); pw.z = cvt_pk_bf16(S[i_][1][0], S[i_][1][1]); pw.w = cvt_pk_bf16(S[i_][1][2], S[i_][1][3]); \
            const bf16x8 pf = __builtin_bit_cast(bf16x8, pw); const LAS unsigned char* vb_ = lds + NA_BUF + ((s_) & 1) * NA_TILE + c16 * 144 + (cb + 8 * g) * 2; \
            _Pragma("unroll") for (int dt = 0; dt < 8; ++dt) O[dt] = __builtin_amdgcn_mfma_f32_16x16x32_bf16(*(const LAS bf16x8*)(vb_ + dt * 16 * 144), pf, O[dt], 0, 0, 0); } while (0)
#define NA_VROW(s_) do { if ((s_) < nrows) { NA_STV(s_); __syncthreads(); if ((s_) + 1 < nrows) NA_LDV((s_) + 1); \
            if (!shiftB) { if ((s_) < 8) NA_PV(s_, (s_) < 8 ? (s_) : 7); } else { if ((s_) >= 1) NA_PV(s_, (s_) >= 1 ? (s_) - 1 : 0); } } } while (0)
        __syncthreads();
        NA_VROW(0); NA_VROW(1); NA_VROW(2); NA_VROW(3); NA_VROW(4); NA_VROW(5); NA_VROW(6); NA_VROW(7); NA_VROW(8);
#undef NA_LDK
#undef NA_STK
#undef NA_LDV
#undef NA_STV
#undef NA_QK
#undef NA_SROW
#undef NA_PV
#undef NA_VROW
#pragma unroll
        for (int dt = 0; dt < 8; ++dt) { u32x2 w; w.x = cvt_pk_bf16(O[dt][0] * inv, O[dt][1] * inv); w.y = cvt_pk_bf16(O[dt][2] * inv, O[dt][3] * inv);
            *(u32x2*)(ATT + tq * DM + hh * 128 + 16 * dt + 4 * g) = w; }
    }
}

constexpr int MLP_WIF = 36864, MLP_WROW = 3088;
DI void ml_pre_phase(const bf16_t* XZ, const float* conv_w, const float* conv_b, const float* wq, const float* wk, const float* wv, const bf16_t* WTif,
                     bf16_t* XC, bf16_t* Q, bf16_t* Kb, bf16_t* V, float* pre_part, LAS unsigned char* lds, int G, int tid, int lane, int wave) {
    LAS float* Lcw = (LAS float*)lds;
    LAS float* Lcb = Lcw + 2560;
    LAS float* Lwq = Lcb + 512;
    LAS float* Lwk = Lwq + 2048;
    LAS float* Lwv = Lwk + 2048;
    LAS unsigned char* Lwif = lds + MLP_WIF;
    const int g = lane >> 4, tk = lane & 15;
    for (int item = blockIdx.x; item < 256; item += G) {
        const int hd = item & 7, tr = item >> 3;
        __syncthreads();
        for (int i = tid; i < 2560; i += NTHREADS) Lcw[i] = conv_w[(i >> 9) * 4096 + hd * 512 + (i & 511)];
        Lcb[tid] = conv_b[hd * 512 + tid];
        for (int i = tid; i < 2048; i += NTHREADS) { Lwq[i] = wq[hd * 2048 + i]; Lwk[i] = wk[hd * 2048 + i]; Lwv[i] = wv[hd * 2048 + i]; }
        for (int i = tid; i < 32 * 3 * 64; i += NTHREADS) { const int n = i / 192, rem = i - n * 192, sec = rem >> 6, c16 = rem & 63;
            *(LAS u32x4*)(Lwif + n * MLP_WROW + sec * 1024 + c16 * 16) = *(const u32x4*)(WTif + (size_t)n * 12288 + sec * 4096 + hd * 512 + c16 * 8); }
        __syncthreads();
        for (int tt = wave; tt < 16; tt += 8) {
            const int tok = tr * 256 + tt * 16 + tk, tseq = tok & 2047;
            f32x4 accp[2]; accp[0] = (f32x4){0.f, 0.f, 0.f, 0.f}; accp[1] = (f32x4){0.f, 0.f, 0.f, 0.f};
            u32x4 xrA[5], xrB[5], hq, hk, hv, hc;
#define MLP_LOAD(xr_, step_) do { const int ch_ = hd * 512 + (step_) * 32 + 8 * g; \
                _Pragma("unroll") for (int jt = 0; jt < 5; ++jt) { const int dt = jt - 2; const bool ok = (unsigned)(tseq + dt) < (unsigned)SEQ; \
                    xr_[jt] = (u32x4){0u, 0u, 0u, 0u}; if (ok) xr_[jt] = *(const u32x4*)(XZ + (size_t)(tok + dt) * 8192 + ch_); } } while (0)
#define MLP_COMPUTE(xr_, step_, HOLD_) do { \
                const int cl = (step_) * 32 + 8 * g, ch = hd * 512 + cl; \
                float a[8], xm[8]; \
                { const f32x4 b0 = *(const LAS f32x4*)(Lcb + cl), b1 = *(const LAS f32x4*)(Lcb + cl + 4); \
                  a[0] = b0.x; a[1] = b0.y; a[2] = b0.z; a[3] = b0.w; a[4] = b1.x; a[5] = b1.y; a[6] = b1.z; a[7] = b1.w; } \
                _Pragma("unroll") for (int jt = 0; jt < 5; ++jt) { \
                    const u32x4 xr = xr_[jt]; \
                    const float xv[8] = {bf_lo(xr.x), bf_hi(xr.x), bf_lo(xr.y), bf_hi(xr.y), bf_lo(xr.z), bf_hi(xr.z), bf_lo(xr.w), bf_hi(xr.w)}; \
                    const f32x4 w0 = *(const LAS f32x4*)(Lcw + jt * 512 + cl), w1 = *(const LAS f32x4*)(Lcw + jt * 512 + cl + 4); \
                    a[0] += xv[0] * w0.x; a[1] += xv[1] * w0.y; a[2] += xv[2] * w0.z; a[3] += xv[3] * w0.w; a[4] += xv[4] * w1.x; a[5] += xv[5] * w1.y; a[6] += xv[6] * w1.z; a[7] += xv[7] * w1.w; \
                    if (jt == 2) { _Pragma("unroll") for (int i = 0; i < 8; ++i) xm[i] = xv[i]; } } \
                float xc[8], q[8], k[8], v[8]; \
                _Pragma("unroll") for (int i = 0; i < 8; ++i) xc[i] = silu_f(a[i]); \
                _Pragma("unroll") for (int blk = 0; blk < 2; ++blk) { const int wo = ((cl >> 2) + blk) * 16; \
                    _Pragma("unroll") for (int o = 0; o < 4; ++o) { float sq = 0.f, sk = 0.f, sv = 0.f; \
                        _Pragma("unroll") for (int i = 0; i < 4; ++i) { sq += xc[4 * blk + i] * Lwq[wo + i * 4 + o]; sk += xc[4 * blk + i] * Lwk[wo + i * 4 + o]; sv += xm[4 * blk + i] * Lwv[wo + i * 4 + o]; } \
                        q[4 * blk + o] = sq; k[4 * blk + o] = sk; v[4 * blk + o] = sv; } } \
                u32x4 qw, kw, vw, cw; \
                qw.x = cvt_pk_bf16(q[0], q[1]); qw.y = cvt_pk_bf16(q[2], q[3]); qw.z = cvt_pk_bf16(q[4], q[5]); qw.w = cvt_pk_bf16(q[6], q[7]); \
                kw.x = cvt_pk_bf16(k[0], k[1]); kw.y = cvt_pk_bf16(k[2], k[3]); kw.z = cvt_pk_bf16(k[4], k[5]); kw.w = cvt_pk_bf16(k[6], k[7]); \
                vw.x = cvt_pk_bf16(v[0], v[1]); vw.y = cvt_pk_bf16(v[2], v[3]); vw.z = cvt_pk_bf16(v[4], v[5]); vw.w = cvt_pk_bf16(v[6], v[7]); \
                cw.x = cvt_pk_bf16(xc[0], xc[1]); cw.y = cvt_pk_bf16(xc[2], xc[3]); cw.z = cvt_pk_bf16(xc[4], xc[5]); cw.w = cvt_pk_bf16(xc[6], xc[7]); \
                const size_t o4 = (size_t)tok * 4096 + ch; \
                if (HOLD_) { hq = qw; hk = kw; hv = vw; hc = cw; }     \
                else { *(u32x4*)(Q + o4 - 32) = hq; *(u32x4*)(Q + o4) = qw; *(u32x4*)(Kb + o4 - 32) = hk; *(u32x4*)(Kb + o4) = kw; *(u32x4*)(V + o4 - 32) = hv; *(u32x4*)(V + o4) = vw; *(u32x4*)(XC + o4 - 32) = hc; *(u32x4*)(XC + o4) = cw; } \
                const bf16x8 qf = __builtin_bit_cast(bf16x8, qw), kf = __builtin_bit_cast(bf16x8, kw), vf = __builtin_bit_cast(bf16x8, vw); \
                _Pragma("unroll") for (int nt = 0; nt < 2; ++nt) { const LAS unsigned char* wp = Lwif + (nt * 16 + tk) * MLP_WROW + cl * 2; \
                    accp[nt] = __builtin_amdgcn_mfma_f32_16x16x32_bf16(qf, *(const LAS bf16x8*)(wp), accp[nt], 0, 0, 0); \
                    accp[nt] = __builtin_amdgcn_mfma_f32_16x16x32_bf16(kf, *(const LAS bf16x8*)(wp + 1024), accp[nt], 0, 0, 0); \
                    accp[nt] = __builtin_amdgcn_mfma_f32_16x16x32_bf16(vf, *(const LAS bf16x8*)(wp + 2048), accp[nt], 0, 0, 0); } } while (0)
            MLP_LOAD(xrA, 0);
#pragma unroll 1
            for (int step = 0; step < 16; step += 2) {
                MLP_LOAD(xrB, step + 1);
                MLP_COMPUTE(xrA, step, true);
                { const int sn = (step + 2 < 16) ? step + 2 : 15; MLP_LOAD(xrA, sn); }
                MLP_COMPUTE(xrB, step + 1, false);
            }
#undef MLP_LOAD
#undef MLP_COMPUTE
#pragma unroll
            for (int nt = 0; nt < 2; ++nt)
#pragma unroll
                for (int e = 0; e < 4; ++e) pre_part[((size_t)hd * 32 + nt * 16 + tk) * MTOK + tr * 256 + tt * 16 + 4 * g + e] = accp[nt][e];
        }
    }
}

constexpr int ML_QS0 = 0, ML_KS0 = 16384, ML_QS1 = 32768, ML_KS1 = 49152, ML_VS0 = 65536, ML_VS1 = 81920, ML_WV = 98304, ML_SS = 114688, ML_SM = 123904;
constexpr int ML_XS = ML_QS1, ML_XN = ML_QS1;
constexpr int GB_U = 0, GB_MR = 64, GB_W = 128, GB_INT = 192, GB_BND = 256, GB_SC = 320;
constexpr int SM_DIN0 = 768, SM_DIN1 = 832, SM_NV = 896, SM_NVP = 1408, SM_DNQP = 3456, SM_GS = 3968, SM_CMX = 4000, SM_MC = 4032, SM_END = 4096;
static_assert(ML_SM + SM_END * 4 <= LDS_BYTES - 16, "mLSTM LDS");
constexpr float KSCALE = 0.04419417382415922f;

DI s16x4 tr_read(LAS unsigned char* p) { return __builtin_amdgcn_ds_read_tr16_b64_v4i16((LAS s16x4*)p); }
DI int dimg(int row, int ch) { return 2048 * (row >> 3) + 512 * (ch >> 2) + 64 * (row & 7) + 16 * ((ch & 3) ^ ((row >> 2) & 3)); }
DI bf16x8 frag_tr(LAS unsigned char* img, int k0, int c0, int lane) {
    const int h = lane >> 5, blk = (lane >> 4) & 1, q = (lane & 15) >> 2, p = lane & 3;
    const int row = k0 + 8 * h + q, ch = (c0 >> 3) + 2 * blk + (p >> 1), sub = 8 * (p & 1);
    const s16x4 lo = tr_read(img + dimg(row, ch) + sub), hi = tr_read(img + dimg(row + 4, ch) + sub);
    return __builtin_shufflevector(lo, hi, 0, 1, 2, 3, 4, 5, 6, 7);
}
#define MFMA32(a, b, c) __builtin_amdgcn_mfma_f32_32x32x16_bf16((a), (b), (c), 0, 0, 0)
DI void tr_batch4(bf16x8 (&f)[4], unsigned alo, unsigned ahi) {
    s16x4 l0, l1, l2, l3, h0, h1, h2, h3;
    asm volatile("ds_read_b64_tr_b16 %0, %8\n\tds_read_b64_tr_b16 %4, %9\n\tds_read_b64_tr_b16 %1, %8 offset:4096\n\tds_read_b64_tr_b16 %5, %9 offset:4096\n\t"
                 "ds_read_b64_tr_b16 %2, %8 offset:8192\n\tds_read_b64_tr_b16 %6, %9 offset:8192\n\tds_read_b64_tr_b16 %3, %8 offset:12288\n\tds_read_b64_tr_b16 %7, %9 offset:12288\n\t"
                 "s_waitcnt lgkmcnt(0)"
                 : "=&v"(l0), "=&v"(l1), "=&v"(l2), "=&v"(l3), "=&v"(h0), "=&v"(h1), "=&v"(h2), "=&v"(h3) : "v"(alo), "v"(ahi) : "memory");
    f[0] = __builtin_shufflevector(l0, h0, 0, 1, 2, 3, 4, 5, 6, 7); f[1] = __builtin_shufflevector(l1, h1, 0, 1, 2, 3, 4, 5, 6, 7);
    f[2] = __builtin_shufflevector(l2, h2, 0, 1, 2, 3, 4, 5, 6, 7); f[3] = __builtin_shufflevector(l3, h3, 0, 1, 2, 3, 4, 5, 6, 7);
}

DI void tr_issue4(s16x4& l0, s16x4& l1, s16x4& l2, s16x4& l3, s16x4& h0, s16x4& h1, s16x4& h2, s16x4& h3, unsigned alo, unsigned ahi) {
    asm volatile("ds_read_b64_tr_b16 %0, %8\n\tds_read_b64_tr_b16 %4, %9\n\tds_read_b64_tr_b16 %1, %8 offset:4096\n\tds_read_b64_tr_b16 %5, %9 offset:4096\n\t"
                 "ds_read_b64_tr_b16 %2, %8 offset:8192\n\tds_read_b64_tr_b16 %6, %9 offset:8192\n\tds_read_b64_tr_b16 %3, %8 offset:12288\n\tds_read_b64_tr_b16 %7, %9 offset:12288"
                 : "=&v"(l0), "=&v"(l1), "=&v"(l2), "=&v"(l3), "=&v"(h0), "=&v"(h1), "=&v"(h2), "=&v"(h3) : "v"(alo), "v"(ahi) : "memory");
}
DI void tr_wait8(s16x4& l0, s16x4& l1, s16x4& l2, s16x4& l3, s16x4& h0, s16x4& h1, s16x4& h2, s16x4& h3) {
    asm volatile("s_waitcnt lgkmcnt(0)" : "+v"(l0), "+v"(l1), "+v"(l2), "+v"(l3), "+v"(h0), "+v"(h1), "+v"(h2), "+v"(h3) :: "memory");
}
#define TR_CAT(f, l, h) do { f[0] = __builtin_shufflevector(l##0, h##0, 0, 1, 2, 3, 4, 5, 6, 7); f[1] = __builtin_shufflevector(l##1, h##1, 0, 1, 2, 3, 4, 5, 6, 7); \
        f[2] = __builtin_shufflevector(l##2, h##2, 0, 1, 2, 3, 4, 5, 6, 7); f[3] = __builtin_shufflevector(l##3, h##3, 0, 1, 2, 3, 4, 5, 6, 7); } while (0)

template <int I>
DI void ml_step(LAS unsigned char* lds, u32x4 (&Cp)[8][2], f32x16 (&num)[2], f32x16& Sacc, float& dnq, int tid, int lane, int wave, int gb) {
    asm volatile("" : "+v"(lane)); asm volatile("" : "+v"(tid));
    constexpr int QS = (I & 1) ? ML_QS1 : ML_QS0, KS = (I & 1) ? ML_KS1 : ML_KS0;
    const int r = lane & 31, h = lane >> 5, vt = wave & 3, dpar = wave >> 2;
    LAS float* SM = (LAS float*)(lds + ML_SM);
#define ML_SEC1 { const int wS = wave & 3, st = wS >> 1, tt1 = wS & 1, kh = wave >> 2; \
      if (!(st == 1 && tt1 == 0)) { \
        _Pragma("unroll") for (int ks = 0; ks < 4; ++ks) { const int kk = 4 * kh + ks; \
            const bf16x8 a = *(const LAS bf16x8*)(lds + KS + dimg(32 * st + r, 2 * kk + h)); \
            const bf16x8 b = *(const LAS bf16x8*)(lds + QS + dimg(32 * tt1 + r, 2 * kk + h)); \
            Sacc = MFMA32(a, b, Sacc); } } }
#define ML_SEC4 { _Pragma("unroll") for (int jj = 0; jj < 2; ++jj) { const int dl = dpar + 2 * jj; \
        _Pragma("unroll") for (int s2 = 0; s2 < 2; ++s2) { const bf16x8 a = __builtin_bit_cast(bf16x8, Cp[2 * I + jj][s2]); \
            _Pragma("unroll") for (int tt = 0; tt < 2; ++tt) { LAS unsigned char* qb = lds + QS + 8 * h; \
                const s16x4 lo = *(const LAS s16x4*)(qb + dimg(32 * tt + r, 4 * dl + 2 * s2)), hi = *(const LAS s16x4*)(qb + dimg(32 * tt + r, 4 * dl + 2 * s2 + 1)); \
                num[tt] = MFMA32(a, __builtin_shufflevector(lo, hi, 0, 1, 2, 3, 4, 5, 6, 7), num[tt]); } } } }
#define ML_UPD(jj_) { _Pragma("unroll") for (int s2 = 0; s2 < 2; ++s2) { const u32x4 o = Cp[2 * I + (jj_)][s2]; u32x4 n; \
            n.x = cvt_pk_bf16(bf_lo(o.x) * decay + U[8 * s2 + 0], bf_hi(o.x) * decay + U[8 * s2 + 1]); n.y = cvt_pk_bf16(bf_lo(o.y) * decay + U[8 * s2 + 2], bf_hi(o.y) * decay + U[8 * s2 + 3]); \
            n.z = cvt_pk_bf16(bf_lo(o.z) * decay + U[8 * s2 + 4], bf_hi(o.z) * decay + U[8 * s2 + 5]); n.w = cvt_pk_bf16(bf_lo(o.w) * decay + U[8 * s2 + 6], bf_hi(o.w) * decay + U[8 * s2 + 7]); \
            asm volatile("" : "+v"(n)); Cp[2 * I + (jj_)][s2] = n; } }
#define ML_SEC5 { const float decay = SM[gb + GB_SC + 0]; \
      const int blk = (lane >> 4) & 1, q = (lane & 15) >> 2, p = lane & 3, sub = 8 * (p & 1), rlo = 8 * h + q; \
      const unsigned ldsu = (unsigned)(size_t)lds; const int chB = 4 * vt + 2 * blk + (p >> 1), chA0 = 4 * dpar + 2 * blk + (p >> 1), chA1 = chA0 + 8; \
      s16x4 bl0, bl1, bl2, bl3, bh0, bh1, bh2, bh3, al0, al1, al2, al3, ah0, ah1, ah2, ah3, cl0, cl1, cl2, cl3, ch0, ch1, ch2, ch3; \
      tr_issue4(bl0, bl1, bl2, bl3, bh0, bh1, bh2, bh3, ldsu + ML_WV + dimg(rlo, chB) + sub, ldsu + ML_WV + dimg(rlo + 4, chB) + sub); \
      tr_issue4(al0, al1, al2, al3, ah0, ah1, ah2, ah3, ldsu + KS + dimg(rlo, chA0) + sub, ldsu + KS + dimg(rlo + 4, chA0) + sub); \
      tr_wait8(al0, al1, al2, al3, ah0, ah1, ah2, ah3); tr_wait8(bl0, bl1, bl2, bl3, bh0, bh1, bh2, bh3); \
      tr_issue4(cl0, cl1, cl2, cl3, ch0, ch1, ch2, ch3, ldsu + KS + dimg(rlo, chA1) + sub, ldsu + KS + dimg(rlo + 4, chA1) + sub); \
      bf16x8 Bf[4], Af[4]; TR_CAT(Bf, bl, bh); TR_CAT(Af, al, ah); \
      f32x16 U; \
      _Pragma("unroll") for (int e = 0; e < 16; ++e) U[e] = 0.f; \
      _Pragma("unroll") for (int ks = 0; ks < 4; ++ks) U = MFMA32(Af[ks], Bf[ks], U); \
      ML_UPD(0) \
      tr_wait8(cl0, cl1, cl2, cl3, ch0, ch1, ch2, ch3); TR_CAT(Af, cl, ch); \
      _Pragma("unroll") for (int e = 0; e < 16; ++e) U[e] = 0.f; \
      _Pragma("unroll") for (int ks = 0; ks < 4; ++ks) U = MFMA32(Af[ks], Bf[ks], U); \
      ML_UPD(1) }
#define ML_SECV { { const int t = tid & 63, dg = tid >> 6; \
      const u32x4 q0 = *(const LAS u32x4*)(lds + QS + dimg(t, 2 * dg)), q1 = *(const LAS u32x4*)(lds + QS + dimg(t, 2 * dg + 1)); \
      const LAS f32x4* nv = (const LAS f32x4*)(SM + SM_NV + 128 * I + 16 * dg); \
      const f32x4 n0 = nv[0], n1 = nv[1], n2 = nv[2], n3 = nv[3]; \
      dnq += bf_lo(q0.x) * n0.x + bf_hi(q0.x) * n0.y + bf_lo(q0.y) * n0.z + bf_hi(q0.y) * n0.w + bf_lo(q0.z) * n1.x + bf_hi(q0.z) * n1.y + bf_lo(q0.w) * n1.z + bf_hi(q0.w) * n1.w \
           + bf_lo(q1.x) * n2.x + bf_hi(q1.x) * n2.y + bf_lo(q1.y) * n2.z + bf_hi(q1.y) * n2.w + bf_lo(q1.z) * n3.x + bf_hi(q1.z) * n3.y + bf_lo(q1.w) * n3.z + bf_hi(q1.w) * n3.w; } \
    { const int dp = tid & 63, sg = tid >> 6; float a0 = 0.f, a1 = 0.f; \
      const f32x4 wA = *(const LAS f32x4*)(SM + gb + GB_W + 8 * sg), wB = *(const LAS f32x4*)(SM + gb + GB_W + 8 * sg + 4); const float ww[8] = {wA.x, wA.y, wA.z, wA.w, wB.x, wB.y, wB.z, wB.w}; \
      _Pragma("unroll") for (int s = 0; s < 8; ++s) { const unsigned kk2 = *(const LAS unsigned*)(lds + KS + dimg(8 * sg + s, dp >> 2) + 4 * (dp & 3)); a0 += ww[s] * bf_lo(kk2); a1 += ww[s] * bf_hi(kk2); } \
      ((LAS unsigned*)(SM + SM_NVP))[sg * 256 + 64 * I + dp] = cvt_pk_bf16(a0, a1); } }
    ML_SEC1 ML_SEC4 ML_SEC5 ML_SECV
#undef ML_SEC1
#undef ML_SEC4
#undef ML_UPD
#undef ML_SEC5
#undef ML_SECV
}

DI float lane_read(float v, int src_lane) { return __builtin_bit_cast(float, __builtin_amdgcn_ds_bpermute(src_lane << 2, __builtin_bit_cast(int, v))); }
DI void ml_scan(float li_, float lf_, float& u_, float& cm_, float& bs_, int lane) {
    bs_ = lf_;
#pragma unroll
    for (int o_ = 1; o_ < 64; o_ <<= 1) { const float t_ = lane_read(bs_, (lane - o_) & 63); if (lane >= o_) bs_ += t_; }
    u_ = li_ - bs_; cm_ = u_;
#pragma unroll
    for (int o_ = 1; o_ < 64; o_ <<= 1) { const float t_ = lane_read(cm_, (lane - o_) & 63); if (lane >= o_) cm_ = fmaxf(cm_, t_); }
}
DI void ml_gates(LAS float* SM, float u_, float cm_, float bs_, int gbn, float m_, float cmx_, int lane) {
    const float M_ = fmaxf(m_, cm_), Ml_ = fmaxf(m_, cmx_);
    SM[gbn + GB_U + lane] = u_; SM[gbn + GB_MR + lane] = M_; SM[gbn + GB_W + lane] = __expf(u_ - Ml_) * KSCALE; SM[gbn + GB_INT + lane] = __expf(m_ - M_); SM[gbn + GB_BND + lane] = __expf(-(bs_ + M_));
    if (lane == 0) SM[gbn + GB_SC + 0] = __expf(m_ - Ml_);
}

DI void ml_dma_piece(const bf16_t* colbase, int b, int dir, int tau0, LAS unsigned char* tile, int j, int lane) {
    const int pos = lane & 31, rin = pos >> 2, row = 8 * (j >> 1) + rin, ch = 4 * (2 * (j & 1) + (lane >> 5)) + ((pos & 3) ^ ((row >> 2) & 3));
    const int tau = tau0 + row; const size_t tok = (size_t)(b * SEQ + (dir ? SEQ - 1 - tau : tau));
    __builtin_amdgcn_global_load_lds((const unsigned*)(colbase + tok * 4096 + ch * 8), (LAS unsigned*)(tile + 1024 * j), 16, 0, 0);
}

DI void mlstm_phase(const bf16_t* Q, const bf16_t* Kb, const bf16_t* V, const float* pre_part, const float* b_if, float* GLF, bf16_t* HF, bf16_t* HB,
                    LAS unsigned char* lds, int G, int vcu0, int tid0, int lane0, int wave) {
    LAS float* SM = (LAS float*)(lds + ML_SM);
    const int vt = wave & 3, dpar = wave >> 2;
    for (int item = vcu0; item < 256; item += G) {
        const int vs = item & 3, stream = item >> 2, dir = stream & 1, hd = (stream >> 1) & 7, b = stream >> 4;
        bf16_t* H = dir ? HB : HF;
        float* glf = GLF + (size_t)item * 10240;
        const bf16_t* qcol = Q + hd * 512; const bf16_t* kcol = Kb + hd * 512; const bf16_t* vcol = V + hd * 512 + vs * 128;
        __syncthreads();
        int tidp = tid0, lanep = lane0; asm volatile("" : "+v"(tidp)); asm volatile("" : "+v"(lanep));
        for (int tau = tidp; tau < SEQ; tau += NTHREADS) {
            const int tok = b * SEQ + (dir ? SEQ - 1 - tau : tau);
            float li = b_if[dir * 16 + hd], lfr = b_if[dir * 16 + 8 + hd];
#pragma unroll
            for (int h8 = 0; h8 < 8; ++h8) { const float* pp = pre_part + ((size_t)h8 * 32 + dir * 16 + hd) * MTOK + tok; li += pp[0]; lfr += pp[(size_t)8 * MTOK]; }
            glf[tau] = li; glf[2048 + tau] = fminf(lfr, 0.f) - log1pf(__expf(-fabsf(lfr)));
        }
        SM[SM_NV + tidp] = 0.f;
        ml_dma_piece(qcol, b, dir, 0, lds + ML_QS0, 2 * wave, lanep); ml_dma_piece(qcol, b, dir, 0, lds + ML_QS0, 2 * wave + 1, lanep);
        ml_dma_piece(kcol, b, dir, 0, lds + ML_KS0, 2 * wave, lanep); ml_dma_piece(kcol, b, dir, 0, lds + ML_KS0, 2 * wave + 1, lanep);
        ml_dma_piece(vcol, b, dir, 0, lds + ML_VS0, 2 * wave, lanep); ml_dma_piece(vcol, b, dir, 0, lds + ML_VS0, 2 * wave + 1, lanep);
        asm volatile("s_waitcnt vmcnt(0)" ::: "memory");
        __syncthreads();
        float u0 = 0.f, cm0 = 0.f, bs0 = 0.f;
#pragma unroll 1
        for (int cc = wave; cc < 32; cc += 8) {
            const float lic = __hip_atomic_load(glf + 64 * cc + lanep, __ATOMIC_RELAXED, __HIP_MEMORY_SCOPE_AGENT), lfc = __hip_atomic_load(glf + 2048 + 64 * cc + lanep, __ATOMIC_RELAXED, __HIP_MEMORY_SCOPE_AGENT);
            float uu, cmm, bss; ml_scan(lic, lfc, uu, cmm, bss, lanep);
            glf[4096 + 64 * cc + lanep] = uu; glf[6144 + 64 * cc + lanep] = cmm; glf[8192 + 64 * cc + lanep] = bss;
            if (lanep == 63) { SM[SM_GS + cc] = bss; SM[SM_CMX + cc] = cmm; }
            if (cc == 0) { u0 = uu; cm0 = cmm; bs0 = bss; }
        }
        asm volatile("s_waitcnt vmcnt(0)" ::: "memory");
        __syncthreads();
        if (tidp == 0) { float m = 0.f;
#pragma unroll 1
            for (int cc = 0; cc < 32; ++cc) { SM[SM_MC + cc] = m; m = SM[SM_GS + cc] + fmaxf(m, SM[SM_CMX + cc]); } }
        __syncthreads();
        if (wave == 0) ml_gates(SM, u0, cm0, bs0, 0, 0.f, SM[SM_CMX + 0], lanep);
        __syncthreads();
#define ML_WRITE_WV(VS_, gbx_) do { const float w_ = SM[(gbx_) + GB_W + lrow]; \
        _Pragma("unroll") for (int hh_ = 0; hh_ < 2; ++hh_) { const int o_ = dimg(lrow, lcc + 8 * hh_); const u32x4 x_ = *(const LAS u32x4*)(lds + (VS_) + o_); u32x4 y_; \
            y_.x = cvt_pk_bf16(bf_lo(x_.x) * w_, bf_hi(x_.x) * w_); y_.y = cvt_pk_bf16(bf_lo(x_.y) * w_, bf_hi(x_.y) * w_); y_.z = cvt_pk_bf16(bf_lo(x_.z) * w_, bf_hi(x_.z) * w_); y_.w = cvt_pk_bf16(bf_lo(x_.w) * w_, bf_hi(x_.w) * w_); \
            *(LAS u32x4*)(lds + ML_WV + o_) = y_; } } while (0)
        { const int lrow = tidp >> 3, lcc = tidp & 7; ML_WRITE_WV(ML_VS0, 0); }
        u32x4 Cp[8][2];
#pragma unroll
        for (int j = 0; j < 8; ++j) { Cp[j][0] = (u32x4){0u, 0u, 0u, 0u}; Cp[j][1] = (u32x4){0u, 0u, 0u, 0u}; }
#pragma unroll 1
        for (int c = 0; c < 32; ++c) {
            int lane = lane0, tid = tid0; asm volatile("" : "+v"(lane)); asm volatile("" : "+v"(tid));
            const int r = lane & 31, h = lane >> 5, lrow = tid >> 3, lcc = tid & 7;
            const int gb = (c & 1) * 384, gbn = 384 - gb, cn = (c + 1 < 32) ? c + 1 : 31;
            const int VSc = (c & 1) ? ML_VS1 : ML_VS0, VSn = (c & 1) ? ML_VS0 : ML_VS1;
            f32x16 num[2], Sacc; float dnq = 0.f;
#pragma unroll
            for (int e = 0; e < 16; ++e) { num[0][e] = 0.f; num[1][e] = 0.f; Sacc[e] = 0.f; }
#define ML_DMA_QK(QS_, KS_, c_, i_) do { ml_dma_piece(qcol + 128 * (i_), b, dir, 64 * (c_), lds + (QS_), 2 * wave, lane); ml_dma_piece(qcol + 128 * (i_), b, dir, 64 * (c_), lds + (QS_), 2 * wave + 1, lane); \
                ml_dma_piece(kcol + 128 * (i_), b, dir, 64 * (c_), lds + (KS_), 2 * wave, lane); ml_dma_piece(kcol + 128 * (i_), b, dir, 64 * (c_), lds + (KS_), 2 * wave + 1, lane); } while (0)
            asm volatile("s_waitcnt vmcnt(0)" ::: "memory"); __syncthreads(); ML_DMA_QK(ML_QS1, ML_KS1, c, 1);  ml_step<0>(lds, Cp, num, Sacc, dnq, tid, lane, wave, gb);
            asm volatile("s_waitcnt vmcnt(0)" ::: "memory"); __syncthreads(); ML_DMA_QK(ML_QS0, ML_KS0, c, 2);  ml_step<1>(lds, Cp, num, Sacc, dnq, tid, lane, wave, gb);
            asm volatile("s_waitcnt vmcnt(0)" ::: "memory"); __syncthreads(); ML_DMA_QK(ML_QS1, ML_KS1, c, 3);  ml_step<2>(lds, Cp, num, Sacc, dnq, tid, lane, wave, gb);
            asm volatile("s_waitcnt vmcnt(0)" ::: "memory"); __syncthreads(); ML_DMA_QK(ML_QS0, ML_KS0, cn, 0);
            ml_dma_piece(vcol, b, dir, 64 * cn, lds + VSn, 2 * wave, lane); ml_dma_piece(vcol, b, dir, 64 * cn, lds + VSn, 2 * wave + 1, lane);
            ml_step<3>(lds, Cp, num, Sacc, dnq, tid, lane, wave, gb);
            asm volatile("s_waitcnt vmcnt(0)" ::: "memory");
            __syncthreads();
            float un = 0.f, cmn = 0.f, bsn = 0.f;
            if (wave == 0) { un = __hip_atomic_load(glf + 4096 + 64 * cn + lane, __ATOMIC_RELAXED, __HIP_MEMORY_SCOPE_AGENT); cmn = __hip_atomic_load(glf + 6144 + 64 * cn + lane, __ATOMIC_RELAXED, __HIP_MEMORY_SCOPE_AGENT);
                             bsn = __hip_atomic_load(glf + 8192 + 64 * cn + lane, __ATOMIC_RELAXED, __HIP_MEMORY_SCOPE_AGENT); }
            { LAS f32x4* xs = (LAS f32x4*)(lds + ML_XS) + (size_t)((wave & 3) * 4) * 64 + lane;
              if (wave >= 4) {
#pragma unroll
                for (int gq = 0; gq < 4; ++gq) xs[gq * 64] = (f32x4){Sacc[4 * gq], Sacc[4 * gq + 1], Sacc[4 * gq + 2], Sacc[4 * gq + 3]}; } }
            SM[SM_DNQP + (tid >> 6) * 64 + (tid & 63)] = dnq;
            __syncthreads();
            if (wave < 4) {
                const int st = wave >> 1, tt1 = wave & 1, t = 32 * tt1 + r;
                const LAS f32x4* xs = (const LAS f32x4*)(lds + ML_XS) + (size_t)(wave * 4) * 64 + lane;
                const float Mt = SM[gb + GB_MR + t]; float dsum = 0.f;
#pragma unroll
                for (int gq = 0; gq < 4; ++gq) {
                    const f32x4 px = xs[gq * 64]; const int s0 = 32 * st + 8 * gq + 4 * h; const f32x4 us = *(const LAS f32x4*)(SM + gb + GB_U + s0);
                    float vv[4];
#pragma unroll
                    for (int e = 0; e < 4; ++e) { const float raw = (Sacc[4 * gq + e] + px[e]) * KSCALE; vv[e] = (s0 + e <= t) ? raw * __expf(us[e] - Mt) : 0.f; dsum += vv[e]; }
                    u32x2 w; w.x = cvt_pk_bf16(vv[0], vv[1]); w.y = cvt_pk_bf16(vv[2], vv[3]);
                    *(LAS u32x2*)(lds + ML_SS + t * 144 + s0 * 2) = w;
                }
                dsum += __shfl_xor(dsum, 32);
                if (h == 0) SM[(st ? SM_DIN1 : SM_DIN0) + t] = dsum;
            }
#pragma unroll
            for (int tt = 0; tt < 2; ++tt) { const float it = SM[gb + GB_INT + 32 * tt + r]; num[tt] = num[tt] * it; }
            __syncthreads();
#pragma unroll
            for (int k2 = 0; k2 < 2; ++k2) { const int ks = 2 * dpar + k2;
                const bf16x8 a = frag_tr(lds + VSc, 16 * ks, 32 * vt, lane);
#pragma unroll
                for (int tt = 0; tt < 2; ++tt) { const bf16x8 bb = *(const LAS bf16x8*)(lds + ML_SS + (32 * tt + r) * 144 + (16 * ks + 8 * h) * 2); num[tt] = MFMA32(a, bb, num[tt]); } }
            __syncthreads();
            { LAS f32x4* xn = (LAS f32x4*)(lds + ML_XN) + (size_t)(vt * 8) * 64 + lane;
              if (dpar == 1) {
#pragma unroll
                for (int tt = 0; tt < 2; ++tt)
#pragma unroll
                    for (int gq = 0; gq < 4; ++gq) xn[(tt * 4 + gq) * 64] = (f32x4){num[tt][4 * gq], num[tt][4 * gq + 1], num[tt][4 * gq + 2], num[tt][4 * gq + 3]}; } }
            if (wave == 0) ml_gates(SM, un, cmn, bsn, gbn, SM[SM_MC + cn], SM[SM_CMX + cn], lane);
            __syncthreads();
            if (dpar == 0) {
                const LAS f32x4* xn = (const LAS f32x4*)(lds + ML_XN) + (size_t)(vt * 8) * 64 + lane;
#pragma unroll
                for (int tt = 0; tt < 2; ++tt) { const int t = 32 * tt + r; float nq = 0.f;
#pragma unroll
                    for (int gI = 0; gI < 8; ++gI) nq += SM[SM_DNQP + gI * 64 + t];
                    const float den = SM[SM_DIN0 + t] + SM[SM_DIN1 + t] + SM[gb + GB_INT + t] * nq;
                    const float inv = 1.0f / fmaxf(fabsf(den), SM[gb + GB_BND + t]);
                    const int tau = 64 * c + t; const size_t ob = (size_t)(b * SEQ + (dir ? SEQ - 1 - tau : tau)) * 4096 + hd * 512 + vs * 128 + 32 * vt + 4 * h;
#pragma unroll
                    for (int gq = 0; gq < 4; ++gq) { const f32x4 px = xn[(tt * 4 + gq) * 64];
                        u32x2 w; w.x = cvt_pk_bf16((num[tt][4 * gq] + px.x) * inv, (num[tt][4 * gq + 1] + px.y) * inv); w.y = cvt_pk_bf16((num[tt][4 * gq + 2] + px.z) * inv, (num[tt][4 * gq + 3] + px.w) * inv);
                        *(u32x2*)(H + ob + 8 * gq) = w; } }
            }
            ML_WRITE_WV(VSn, gbn);
            { const float decay = SM[gb + GB_SC + 0];
              float acc_ = 0.f; const LAS unsigned* np_ = (const LAS unsigned*)(SM + SM_NVP) + (tid >> 1);
#pragma unroll
              for (int sgx = 0; sgx < 8; ++sgx) { const unsigned pr_ = np_[sgx * 256]; acc_ += (tid & 1) ? bf_hi(pr_) : bf_lo(pr_); }
              SM[SM_NV + tid] = decay * SM[SM_NV + tid] + acc_; }
        }
#undef ML_DMA_QK
#undef ML_WRITE_WV
    }
}

DI void ml_combine_phase(const bf16_t* HF, const bf16_t* HB, const bf16_t* XC, const bf16_t* XZ, const float* norm_g, const float* skip, bf16_t* MO, int gw, int NGW, int lane) {
    for (int idx = gw; idx < MTOK * ML_HEADS; idx += NGW) {
        const int tok = idx >> 3, hd = idx & 7; const int ch = hd * 512 + 8 * lane; const size_t o4 = (size_t)tok * 4096 + ch;
        const u32x4 a = *(const u32x4*)(HF + o4), bq = *(const u32x4*)(HB + o4), xcv = *(const u32x4*)(XC + o4), zv = *(const u32x4*)(XZ + (size_t)tok * 8192 + 4096 + ch);
        float ht[8] = {bf_lo(a.x) + bf_lo(bq.x), bf_hi(a.x) + bf_hi(bq.x), bf_lo(a.y) + bf_lo(bq.y), bf_hi(a.y) + bf_hi(bq.y), bf_lo(a.z) + bf_lo(bq.z), bf_hi(a.z) + bf_hi(bq.z), bf_lo(a.w) + bf_lo(bq.w), bf_hi(a.w) + bf_hi(bq.w)};
        const float xc[8] = {bf_lo(xcv.x), bf_hi(xcv.x), bf_lo(xcv.y), bf_hi(xcv.y), bf_lo(xcv.z), bf_hi(xcv.z), bf_lo(xcv.w), bf_hi(xcv.w)};
        const float z[8] = {bf_lo(zv.x), bf_hi(zv.x), bf_lo(zv.y), bf_hi(zv.y), bf_lo(zv.z), bf_hi(zv.z), bf_lo(zv.w), bf_hi(zv.w)};
        float s = 0.f;
#pragma unroll
        for (int i = 0; i < 8; ++i) s += ht[i];
        const float mu = wave_sum(s) * (1.f / 512.f); float q = 0.f;
#pragma unroll
        for (int i = 0; i < 8; ++i) { ht[i] -= mu; q += ht[i] * ht[i]; }
        const float rstd = 1.0f / sqrtf(wave_sum(q) * (1.f / 512.f) + 1e-5f);
        const f32x4 g0 = *(const f32x4*)(norm_g + ch), g1 = *(const f32x4*)(norm_g + ch + 4), k0 = *(const f32x4*)(skip + ch), k1 = *(const f32x4*)(skip + ch + 4);
        const float gg[8] = {g0.x, g0.y, g0.z, g0.w, g1.x, g1.y, g1.z, g1.w}, sk[8] = {k0.x, k0.y, k0.z, k0.w, k1.x, k1.y, k1.z, k1.w};
        float o[8];
#pragma unroll
        for (int i = 0; i < 8; ++i) o[i] = (ht[i] * rstd * gg[i] + sk[i] * xc[i]) * sigmoid_f(z[i]);
        u32x4 w; w.x = cvt_pk_bf16(o[0], o[1]); w.y = cvt_pk_bf16(o[2], o[3]); w.z = cvt_pk_bf16(o[4], o[5]); w.w = cvt_pk_bf16(o[6], o[7]);
        *(u32x4*)(MO + o4) = w;
    }
}

DI void moe_offsets(const unsigned* ecnt, int (&cnt)[8], int (&off)[8], int& ntiles) {
    int acc = 0;
#pragma unroll
    for (int e = 0; e < 8; ++e) { cnt[e] = (int)ecnt[64 * e]; off[e] = acc * 256; acc += (cnt[e] + 255) >> 8; }
    ntiles = acc;
}
DI void moe_split_plan(int ntiles, int& nMf, int& nT, int& S) {
    nMf = (ntiles >> 5) << 5; nT = ntiles - nMf; S = 1;
    if (nT > 0) { S = (nT <= 4) ? 7 : (nT <= 8) ? 4 : (nT <= 16) ? 2 : 1; }
    if (S == 1) { nMf = ntiles; nT = 0; }
}
DI pg8::TileMap moe_tilemap(const int (&cnt)[8]) { pg8::TileMap tm; int acc = 0; tm.toff[0] = 0;
#pragma unroll
    for (int e = 0; e < 8; ++e) { acc += (cnt[e] + 255) >> 8; tm.toff[e + 1] = acc; }
    return tm; }
DI void moe_scatter_phase(const unsigned char* HA, unsigned char* HS, const int* tok_e, const int* tok_pos, int* slot_row, const unsigned* ecnt, int* tile_e, int gw, int NGW, int lane) {
    int cnt[8], off[8], ntiles; moe_offsets(ecnt, cnt, off, ntiles);
    if (gw == 0 && lane < 8) { const int e = lane; const int t0 = off[e] >> 8, nt = (cnt[e] + 255) >> 8; for (int t = 0; t < nt; ++t) tile_e[t0 + t] = e; }
    for (int id = gw; id < 2 * MTOK; id += NGW) {
        const int e = tok_e[id], pos = tok_pos[id]; int o = 0;
#pragma unroll
        for (int q = 0; q < 8; ++q) o = (e == q) ? off[q] : o;
        const int row = o + pos;
        if (lane == 0) slot_row[id] = row;
        const u32x4* src = (const u32x4*)(HA + (size_t)(id >> 1) * DM) + lane; u32x4* dst = (u32x4*)(HS + (size_t)row * DM) + lane;
#pragma unroll
        for (int j = 0; j < 2; ++j) dst[64 * j] = src[64 * j];
    }
#pragma unroll 1
    for (int e = 0; e < 8; ++e) { int c = 0, o = 0;
#pragma unroll
        for (int q = 0; q < 8; ++q) { c = (e == q) ? cnt[q] : c; o = (e == q) ? off[q] : o; }
        const int pend = ((c + 255) >> 8) << 8;
        for (int p = c + gw; p < pend; p += NGW) { u32x4* dst = (u32x4*)(HS + (size_t)(o + p) * DM) + lane;
#pragma unroll
            for (int j = 0; j < 2; ++j) dst[64 * j] = (u32x4){0u, 0u, 0u, 0u}; } }
}

DI f32x4 moe_yrow(const bf16_t* YS, const bf16_t* YSP, int r, int rsplit, int S, int nrs, int lane, int j) {
    if (r < rsplit) { const u32x2 a = ((const u32x2*)(YS + (size_t)r * DM) + lane)[64 * j]; return (f32x4){bf_lo(a.x), bf_hi(a.x), bf_lo(a.y), bf_hi(a.y)}; }
    f32x4 acc = (f32x4){0.f, 0.f, 0.f, 0.f};
    for (int s2 = 0; s2 < S; ++s2) { const u32x2 a = ((const u32x2*)(YSP + ((size_t)s2 * nrs + (r - rsplit)) * DM) + lane)[64 * j]; acc += (f32x4){bf_lo(a.x), bf_hi(a.x), bf_lo(a.y), bf_hi(a.y)}; }
    return acc;
}
DI void moe_combine_phase(const float* X3, const bf16_t* YS, const int* tok_e, const int* tok_pos, const float* tok_w, const float* gate, float* out, const unsigned* ecnt, int gw, int NGW, int lane) {
    int cnt[8], off[8], ntiles; moe_offsets(ecnt, cnt, off, ntiles);
    int nMf, nT, S; moe_split_plan(ntiles, nMf, nT, S); const int rsplit = nMf * 256; const bf16_t* YSP = YS + (size_t)MPAD * DM;
    for (int tok = gw; tok < MTOK; tok += NGW) {
        const int e0 = tok_e[2 * tok], e1 = tok_e[2 * tok + 1]; int o0 = 0, o1 = 0;
#pragma unroll
        for (int q = 0; q < 8; ++q) { o0 = (e0 == q) ? off[q] : o0; o1 = (e1 == q) ? off[q] : o1; }
        const int r0 = o0 + tok_pos[2 * tok], r1 = o1 + tok_pos[2 * tok + 1]; const float w0 = tok_w[2 * tok], w1 = tok_w[2 * tok + 1];
        const f32x4* x = (const f32x4*)(X3 + (size_t)tok * DM) + lane;
        const f32x4* gp = (const f32x4*)(gate + (size_t)(tok >> 11) * 12288) + lane; f32x4* o = (f32x4*)(out + (size_t)tok * DM) + lane;
#pragma unroll
        for (int j = 0; j < 8; ++j) { const f32x4 ya = moe_yrow(YS, YSP, r0, rsplit, S, nT * 256, lane, j), yb = moe_yrow(YS, YSP, r1, rsplit, S, nT * 256, lane, j);
            o[64 * j] = x[64 * j] + gp[64 * j] * (ya * w0 + yb * w1); }
    }
}

struct Params { const float* in[29]; float* out; unsigned char* ws; int ph_lo, ph_hi; };
static_assert(sizeof(Params) == 31 * 8 + 8, "Params has padding");
constexpr int NPHASE = 20;

#if DBG
#include "dbg_checks.inc"
#endif

__global__ void __launch_bounds__(NTHREADS, 2) mega_fwd(Params p) {
    extern __shared__ __attribute__((aligned(16))) unsigned char lds_raw[];
    LAS unsigned char* lds = (LAS unsigned char*)lds_raw;
    const int tid = threadIdx.x, lane = tid & 63, wave = __builtin_amdgcn_readfirstlane(tid >> 6);
    const int G = gridDim.x, gw = blockIdx.x * NWAVES + wave, NGW = G * NWAVES;
    const int vcu = (G % 8 == 0) ? (int)(blockIdx.x % 8) * (G / 8) + (int)(blockIdx.x / 8) : (int)blockIdx.x;
    const int gwx = vcu * NWAVES + wave;
    unsigned char* ws = p.ws;
    unsigned* ctl = (unsigned*)(ws + WS_CTL);
    volatile LAS unsigned* xbw = (volatile LAS unsigned*)(lds + LDS_BYTES - 16);
    if (tid == 0) { xbw[0] = 0u; xbw[1] = 0u; xbw[2] = 0u; xbw[3] = 0u; }
    __syncthreads();
    XcdBarrier bar = xcd_barrier_post(ctl + CW_BAR, xbw);
    const int lo = p.ph_lo, hi = p.ph_hi;
#ifndef PH_MASK
#define PH_MASK 0xFFFFFFu
#endif
#define IN(k) (((PH_MASK >> (k)) & 1u) && lo <= (k) && (k) < hi)
#define SEAM(k) do { if (IN((k) + 1)) xcd_barrier(bar); } while (0)
#ifndef REP_MASK
#define REP_MASK 0u
#endif
#define PHASE(k, ...) if (IN(k)) { { __VA_ARGS__ } if ((REP_MASK >> (k)) & 1u) { __syncthreads(); { __VA_ARGS__ } } SEAM(k); }

    float* mod = (float*)(ws + WS_MOD);
    float* pre_part = (float*)(ws + WS_PRE);
    int* tok_e = (int*)(ws + WS_ROUTE); int* tok_pos = tok_e + 2 * MTOK; float* tok_w = (float*)(tok_pos + 2 * MTOK); int* slot_row = (int*)(tok_w + 2 * MTOK);
    unsigned* ecnt = ctl + CW_ECNT; int* tile_e = (int*)(ctl + 12288);
    bf16_t* HA = (bf16_t*)(ws + WS_HA); float* X1 = (float*)(ws + WS_X1); float* X2 = (float*)(ws + WS_X2);
    bf16_t* WT_IN = (bf16_t*)(ws + WS_WT_IN); bf16_t* WT_OUT = (bf16_t*)(ws + WS_WT_OUT); bf16_t* WT_GU = (bf16_t*)(ws + WS_WT_GU); bf16_t* WT_DN = (bf16_t*)(ws + WS_WT_DN);
    bf16_t* WT_MLIN = (bf16_t*)(ws + WS_WT_MLIN); bf16_t* WT_MLOUT = (bf16_t*)(ws + WS_WT_MLOUT); bf16_t* WT_IF = (bf16_t*)(ws + WS_WT_IF);
    unsigned char* WT_MGU = ws + WS_WT_MGU; unsigned char* WT_MD = ws + WS_WT_MD;
    bf16_t* QK = (bf16_t*)(ws + A_QK); bf16_t* QKN = (bf16_t*)(ws + A_QKN); bf16_t* VT = (bf16_t*)(ws + A_VT); bf16_t* ATT = (bf16_t*)(ws + A_ATT); bf16_t* ACT = (bf16_t*)(ws + A_ACT);
    bf16_t* XZ = (bf16_t*)(ws + A_XZ); bf16_t* XC = (bf16_t*)(ws + A_XC); bf16_t* Qm = (bf16_t*)(ws + A_Q); bf16_t* Km = (bf16_t*)(ws + A_K); bf16_t* Vm = (bf16_t*)(ws + A_V);
    bf16_t* HF = (bf16_t*)(ws + A_HF); bf16_t* HB = (bf16_t*)(ws + A_HB); bf16_t* MO = (bf16_t*)(ws + A_MO);
    unsigned char* HS = ws + A_HS; unsigned char* ACTM = ws + A_ACTM; float* YS = (float*)(ws + A_YS);
    const float* x_in = p.in[0];

    PHASE(0,
        mod_phase(p.in[1], p.in[2], p.in[3], mod, lds, G, tid, lane, wave);
        LAS float* scrw = (LAS float*)lds + wave * (64 * 65);
        cvtw_job<0, false>(p.in[6] + 4096, 2048, 2048, 1, WT_IN + (size_t)4096 * 2048, 0, scrw, gw, NGW, lane, 1.f, 6144);
        cvtw_job<0, true>(p.in[6], 2048, 4096, 1, (unsigned char*)ACT + (size_t)32 * 1024 * 1024, 0, scrw, gw, NGW, lane, WSCALE, 6144);
        cvtw_job<0, false>(p.in[10], 2048, 2048, 1, WT_OUT, 0, scrw, gw, NGW, lane, 1.f);
        cvtw_job<1, false>(p.in[11], 2048, FFN, 1, WT_GU, 0, scrw, gw, NGW, lane, 1.f);
        cvtw_job<2, false>(p.in[12], 2048, FFN, 1, WT_GU, 0, scrw, gw, NGW, lane, 1.f);
        cvtw_job<0, false>(p.in[13], FFN, 2048, 1, WT_DN, 0, scrw, gw, NGW, lane, 1.f);
        cvtw_job<0, false>(p.in[14], 2048, 8192, 1, WT_MLIN, 0, scrw, gw, NGW, lane, 1.f);
        cvtw_job<0, false>(p.in[24], 4096, 2048, 1, WT_MLOUT, 0, scrw, gw, NGW, lane, 1.f);
        cvt_job<0>(p.in[20], 12288, 32, 1, WT_IF, 0, scrw, gw, NGW, lane);
        cvtw_job<1, true>(p.in[26], 2048, EDIM, 8, WT_MGU, (size_t)14336 * 2048, scrw, gw, NGW, lane, WSCALE);
        cvtw_job<2, true>(p.in[27], 2048, EDIM, 8, WT_MGU, (size_t)14336 * 2048, scrw, gw, NGW, lane, WSCALE);
        cvtw_job<0, true>(p.in[28], EDIM, 2048, 8, WT_MD, (size_t)2048 * EDIM, scrw, gw, NGW, lane, WSCALE); )
    PHASE(1,  rms_mod_phase<false, true>(x_in, p.in[4], mod + 1 * 2048, mod + 0 * 2048, HA, nullptr, nullptr, nullptr, nullptr, nullptr, (unsigned char*)ACT, gw, NGW, lane); )
    PHASE(2,
        { pg8::Gemm g{(const unsigned char*)ACT, (const unsigned char*)ACT + (size_t)32 * 1024 * 1024, MTOK, 4096, 2048, 0}; pg8::StaticOrder S; S.init(MTOK, 4096, G, (int)blockIdx.x); pg8::EpiQKNorm E{QKN, 4096, p.in[7], p.in[8], 1.0f / (HSCALE * WSCALE)}; pg8::gemm_phase<pg8::EpiQKNorm, pg8::StaticOrder, true>(lds, g, S, E); }
        { pg8::Gemm g{WT_IN + (size_t)4096 * 2048, HA, 2048, MTOK, 2048, 0}; pg8::StaticOrder S; S.init(2048, MTOK, G, (int)blockIdx.x); pg8::EpiBf16 E{VT, MTOK}; pg8::gemm_phase(lds, g, S, E); } )
    PHASE(4,  na_phase(QKN, VT, ATT, p.in[9], lds, G, vcu, tid, lane, wave); )
    PHASE(5,  pg8::Gemm g{ATT, WT_OUT, MTOK, 2048, 2048, 0}; pg8::StaticOrder S; S.init(MTOK, 2048, G, (int)blockIdx.x); pg8::EpiResGate E{x_in, X1, DM, mod + 2 * 2048, 12288}; pg8::gemm_phase(lds, g, S, E); )
    PHASE(6,  rms_mod_phase<false>(X1, p.in[5], mod + 4 * 2048, mod + 3 * 2048, HA, nullptr, nullptr, nullptr, nullptr, nullptr, nullptr, gw, NGW, lane); )
    PHASE(7,  pg8::Gemm g{HA, WT_GU, MTOK, 2 * FFN, 2048, 0}; pg8::StaticOrder S; S.init(MTOK, 2 * FFN, G, (int)blockIdx.x); pg8::EpiSwiGLU E{ACT, FFN}; pg8::gemm_phase(lds, g, S, E); )
    PHASE(8,  pg8::Gemm g{ACT, WT_DN, MTOK, 2048, FFN, 0}; pg8::StaticOrder S; S.init(MTOK, 2048, G, (int)blockIdx.x); pg8::EpiResGate E{X1, X2, DM, mod + 5 * 2048, 12288}; pg8::gemm_phase(lds, g, S, E); )
    PHASE(9,  rms_mod_phase<false>(X2, p.in[4] + DM, mod + 4 * 12288 + 1 * 2048, mod + 4 * 12288 + 0 * 2048, HA, nullptr, nullptr, nullptr, nullptr, nullptr, nullptr, gw, NGW, lane); )
    PHASE(10,  pg8::Gemm g{HA, WT_MLIN, MTOK, 8192, 2048, 0}; pg8::StaticOrder S; S.init(MTOK, 8192, G, (int)blockIdx.x); pg8::EpiBf16 E{XZ, 8192}; pg8::gemm_phase(lds, g, S, E); )
    PHASE(11,  ml_pre_phase(XZ, p.in[15], p.in[16], p.in[17], p.in[18], p.in[19], WT_IF, XC, Qm, Km, Vm, pre_part, lds, G, tid, lane, wave); )
    PHASE(12,  mlstm_phase(Qm, Km, Vm, pre_part, p.in[21], (float*)(ws + WS_GLF), HF, HB, lds, G, vcu, tid, lane, wave); )
    PHASE(13,  ml_combine_phase(HF, HB, XC, XZ, p.in[23], p.in[22], MO, gw, NGW, lane); )
    PHASE(14,  pg8::Gemm g{MO, WT_MLOUT, MTOK, 2048, 4096, 0}; pg8::StaticOrder S; S.init(MTOK, 2048, G, (int)blockIdx.x); pg8::EpiResGate E{X2, X1, DM, mod + 4 * 12288 + 2 * 2048, 12288}; pg8::gemm_phase(lds, g, S, E); )
    PHASE(15,  rms_mod_phase<true>(X1, p.in[5] + DM, mod + 4 * 12288 + 4 * 2048, mod + 4 * 12288 + 3 * 2048, HA, p.in[25], tok_e, tok_pos, tok_w, ecnt, HS, gw, NGW, lane); )
    PHASE(17,  int cnt[8], off[8], ntiles; moe_offsets(ecnt, cnt, off, ntiles);
        pg8::Gemm g{HS, WT_MGU, ntiles * 256, 2 * EDIM, 2048, 0}; pg8::MoeOrder S; S.init(ntiles, 2 * EDIM, G, (int)blockIdx.x, moe_tilemap(cnt), (size_t)14336 * 2048, (size_t)DM);
        pg8::EpiSwiGLU8 E{ACTM, EDIM, 1.0f / (HSCALE * WSCALE), ASCALE}; pg8::gemm_phase<pg8::EpiSwiGLU8, pg8::MoeOrder, true>(lds, g, S, E); )
    PHASE(18,  int cnt[8], off[8], ntiles; moe_offsets(ecnt, cnt, off, ntiles);
        pg8::Gemm g{ACTM, WT_MD, ntiles * 256, 2048, EDIM, 0};
        int nMf, nT, SS; moe_split_plan(ntiles, nMf, nT, SS); bf16_t* YSP = (bf16_t*)YS + (size_t)MPAD * DM;
        { pg8::MoeRowOrder S1; S1.init(nMf, G, (int)blockIdx.x, moe_tilemap(cnt), (size_t)2048 * EDIM); pg8::EpiBf16S E{(bf16_t*)YS, DM, 1.0f / (ASCALE * WSCALE), 0}; pg8::gemm_phase<pg8::EpiBf16S, pg8::MoeRowOrder, true>(lds, g, S1, E); }
        if (nT > 0) { pg8::Gemm g2 = g; g2.ntk = 56 / SS; pg8::MoeSplitOrder S2; S2.init(nMf, nT, SS, (size_t)(EDIM / SS), (int)blockIdx.x, moe_tilemap(cnt), (size_t)2048 * EDIM);
            pg8::EpiBf16S E2{YSP - (size_t)nMf * 256 * DM, DM, 1.0f / (ASCALE * WSCALE), (size_t)nT * 256 * DM}; pg8::gemm_phase<pg8::EpiBf16S, pg8::MoeSplitOrder, true>(lds, g2, S2, E2); } )
    PHASE(19,  moe_combine_phase(X1, (const bf16_t*)YS, tok_e, tok_pos, tok_w, mod + 4 * 12288 + 5 * 2048, p.out, ecnt, gw, NGW, lane); )
#undef IN
#undef SEAM
#undef PHASE
}

extern "C" void kernel_launch(void* const* d_in, const int* in_sizes, int n_in, void* d_out, int out_size, void* d_ws, size_t ws_size, hipStream_t stream) {
    static int grid = 0;
    if (grid == 0) {
        if (n_in != 29 || out_size != MTOK * DM || ws_size < WS_END) { fprintf(stderr, "kernel_launch: unexpected shapes (n_in %d out %d ws %zu need %zu)\n", n_in, out_size, ws_size, (size_t)WS_END); grid = -1; return; }
        int dev = 0, cus = 0, per_cu = 0;
        if (hipGetDevice(&dev) != hipSuccess || hipDeviceGetAttribute(&cus, hipDeviceAttributeMultiprocessorCount, dev) != hipSuccess) { grid = -1; return; }
        if (hipFuncSetAttribute((const void*)mega_fwd, hipFuncAttributeMaxDynamicSharedMemorySize, LDS_BYTES) != hipSuccess) { fprintf(stderr, "kernel_launch: hipFuncSetAttribute failed\n"); grid = -1; return; }
        if (hipOccupancyMaxActiveBlocksPerMultiprocessor(&per_cu, (const void*)mega_fwd, NTHREADS, LDS_BYTES) != hipSuccess || per_cu < 1) { fprintf(stderr, "kernel_launch: occupancy query says %d\n", per_cu); (void)hipGetLastError(); per_cu = 1; }
        grid = cus;
    }
    if (grid < 0) return;
    (void)hipMemsetAsync((char*)d_ws + WS_CTL, 0, CTL_BYTES, stream);
    Params p{};
    for (int i = 0; i < 29; ++i) p.in[i] = (const float*)d_in[i];
    p.out = (float*)d_out; p.ws = (unsigned char*)d_ws;
#if N_LAUNCH_SPLIT
    for (int k = 0; k < NPHASE; ++k) { p.ph_lo = k; p.ph_hi = k + 1; hipLaunchKernelGGL(mega_fwd, dim3(grid), dim3(NTHREADS), LDS_BYTES, stream, p); }
#else
    p.ph_lo = 0; p.ph_hi = NPHASE;
    hipLaunchKernelGGL(mega_fwd, dim3(grid), dim3(NTHREADS), LDS_BYTES, stream, p);
#endif
}
```

```cpp
#define PROBE_HOT 0
#ifndef GEMM_SCH
#define GEMM_SCH 1
#endif
#include <hip/hip_runtime.h>
#include <cstdio>
#include <cstdint>

#ifndef DBG
#define DBG 0
#endif
#ifndef N_LAUNCH_SPLIT
#define N_LAUNCH_SPLIT 0
#endif

#define LAS __attribute__((address_space(3)))
#define GAS __attribute__((address_space(1)))
#define DI __device__ __forceinline__
typedef unsigned short bf16_t;
typedef short bf16x8 __attribute__((ext_vector_type(8)));
typedef short s16x4 __attribute__((ext_vector_type(4)));
typedef float f32x2 __attribute__((ext_vector_type(2)));
typedef float f32x4 __attribute__((ext_vector_type(4)));
typedef float f32x16 __attribute__((ext_vector_type(16)));
typedef unsigned u32x2 __attribute__((ext_vector_type(2)));
typedef unsigned u32x4 __attribute__((ext_vector_type(4)));
typedef int i32x4 __attribute__((ext_vector_type(4)));
typedef int i32x8 __attribute__((ext_vector_type(8)));

constexpr int BATCH = 4, SEQ = 2048, DM = 2048, MTOK = BATCH * SEQ;
constexpr int GRID_W = 64, NA_HEADS = 16, NA_HD = 128;
constexpr int ML_INNER = 4096, ML_HEADS = 8, ML_HD = 512;
constexpr int FFN = 5632, NEXP = 8, EDIM = 7168;
constexpr int MPAD = 2 * MTOK + NEXP * 256;
constexpr int NTHREADS = 512, NWAVES = 8;
constexpr int LDS_BYTES = 147456;

constexpr size_t al256(size_t x) { return (x + 255) & ~(size_t)255; }
constexpr size_t WS_CTL = 0;
constexpr size_t CTL_BYTES = 65536;
constexpr size_t WS_MOD = WS_CTL + CTL_BYTES;
constexpr size_t WS_PRE = WS_MOD + al256((size_t)2 * 4 * 12288 * 4);
constexpr size_t WS_ROUTE = WS_PRE + (size_t)8 * MTOK * 32 * 4;
constexpr size_t WS_GLF = WS_ROUTE + (size_t)4 * MTOK * 2 * 4;
constexpr size_t WS_HA = WS_GLF + (size_t)256 * 10240 * 4;
constexpr size_t WS_X1 = WS_HA + (size_t)MTOK * DM * 2;
constexpr size_t WS_X2 = WS_X1 + (size_t)MTOK * DM * 4;
constexpr size_t WS_WT_IN = WS_X2 + (size_t)MTOK * DM * 4;
constexpr size_t WS_WT_OUT = WS_WT_IN + (size_t)6144 * 2048 * 2;
constexpr size_t WS_WT_GU = WS_WT_OUT + (size_t)2048 * 2048 * 2;
constexpr size_t WS_WT_DN = WS_WT_GU + (size_t)11264 * 2048 * 2;
constexpr size_t WS_WT_MLIN = WS_WT_DN + (size_t)2048 * 5632 * 2;
constexpr size_t WS_WT_MLOUT = WS_WT_MLIN + (size_t)8192 * 2048 * 2;
constexpr size_t WS_WT_IF = WS_WT_MLOUT + (size_t)2048 * 4096 * 2;
constexpr size_t WS_WT_MGU = WS_WT_IF + (size_t)32 * 12288 * 2;
constexpr size_t WS_WT_MD = WS_WT_MGU + (size_t)8 * 14336 * 2048;
constexpr size_t WS_ARENA = WS_WT_MD + (size_t)8 * 2048 * 7168;
constexpr size_t A_QK = WS_ARENA;
constexpr size_t A_QKN = A_QK + (size_t)MTOK * 4096 * 2;
constexpr size_t A_VT = A_QKN + (size_t)MTOK * 4096 * 2;
constexpr size_t A_ATT = A_VT + (size_t)2048 * MTOK * 2;
constexpr size_t A_ACT = A_ATT + (size_t)MTOK * DM * 2;
constexpr size_t A_L0_END = A_ACT + (size_t)MTOK * FFN * 2;
constexpr size_t A_XZ = WS_ARENA;
constexpr size_t A_XC = A_XZ + (size_t)MTOK * 8192 * 2;
constexpr size_t A_Q = A_XC + (size_t)MTOK * 4096 * 2;
constexpr size_t A_K = A_Q + (size_t)MTOK * 4096 * 2;
constexpr size_t A_V = A_K + (size_t)MTOK * 4096 * 2;
constexpr size_t A_HF = A_V + (size_t)MTOK * 4096 * 2;
constexpr size_t A_HB = A_HF + (size_t)MTOK * 4096 * 2;
constexpr size_t A_MO = A_HB + (size_t)MTOK * 4096 * 2;
constexpr size_t A_L1_END = A_MO + (size_t)MTOK * 4096 * 2;
constexpr size_t A_HS = WS_ARENA;
constexpr size_t A_ACTM = A_HS + (size_t)8 * 8192 * DM;
constexpr size_t A_YS = A_ACTM + (size_t)MPAD * EDIM;
constexpr size_t A_L2_END = A_YS + (size_t)MPAD * DM * 4;
constexpr size_t cmax(size_t a, size_t b) { return a > b ? a : b; }
constexpr size_t WS_END = cmax(cmax(A_L0_END, A_L1_END), A_L2_END);

constexpr int CW_BAR = 0;
constexpr int CW_ECNT = 4096;
constexpr int CW_DBG = 8192;

typedef __bf16 bf16x2_t __attribute__((ext_vector_type(2)));
DI unsigned cvt_pk_bf16(float lo, float hi) { const f32x2 v = {lo, hi}; return __builtin_bit_cast(unsigned, __builtin_convertvector(v, bf16x2_t)); }
DI float clamp448(float x) { return __builtin_fminf(__builtin_fmaxf(x, -448.f), 448.f); }
DI unsigned pk4_fp8(float a, float b, float c, float d) {
    int p = 0; p = __builtin_amdgcn_cvt_pk_fp8_f32(clamp448(a), clamp448(b), p, false); p = __builtin_amdgcn_cvt_pk_fp8_f32(clamp448(c), clamp448(d), p, true); return (unsigned)p; }
DI float bf_lo(unsigned u) { return __uint_as_float(u << 16); }
DI float bf_hi(unsigned u) { return __uint_as_float(u & 0xffff0000u); }
DI float bf2f(bf16_t b) { return __uint_as_float(((unsigned)b) << 16); }
DI bf16_t f2bf(float f) { return (bf16_t)(cvt_pk_bf16(f, 0.f) & 0xffffu); }
DI float wave_sum(float v) {
#pragma unroll
    for (int o = 1; o < 64; o <<= 1) v += __shfl_xor(v, o);
    return v;
}
DI float wave_max(float v) {
#pragma unroll
    for (int o = 1; o < 64; o <<= 1) v = fmaxf(v, __shfl_xor(v, o));
    return v;
}
DI float silu_f(float x) { return x / (1.f + __expf(-x)); }
DI float sigmoid_f(float x) { return 1.f / (1.f + __expf(-x)); }
#define LDS_WAIT() asm volatile("s_waitcnt lgkmcnt(0)" ::: "memory")
#define VM_WAIT() asm volatile("s_waitcnt vmcnt(0)" ::: "memory")

#define XB_TMO      128
#define XB_XCNT(j)  (256  + 64 * (j))
#define XB_XSUB(j)  (1280 + 64 * (j))
#define XB_XGEN(j)  (2304 + 64 * (j))
#define XB_TOP      3328
#define XB_TOPGEN   3392
#define XCD_BAR_WORDS 3456
#define XB_SPIN_CAP (1u << 22)

__device__ __forceinline__ unsigned xb_ld(unsigned* p)              { return __hip_atomic_load(p, __ATOMIC_RELAXED, __HIP_MEMORY_SCOPE_AGENT); }
__device__ __forceinline__ unsigned xb_add(unsigned* p, unsigned v) { return __hip_atomic_fetch_add(p, v, __ATOMIC_RELAXED, __HIP_MEMORY_SCOPE_AGENT); }
__device__ __forceinline__ unsigned xb_xcc_id() { return (unsigned)__builtin_amdgcn_s_getreg((3 << 11) | 20) & 0xFu; }
#define XB_SPIN(cond, bar) do { unsigned _sp = 0; while (cond) { __builtin_amdgcn_s_sleep(1); \
    if ((++_sp & 255u) == 0u) { if (xb_ld(&(bar)[XB_TMO])) break; if (_sp > XB_SPIN_CAP) { atomicAdd(&(bar)[XB_TMO], 1u); break; } } } } while (0)

struct XcdBarrier { unsigned* bar; unsigned x; volatile LAS unsigned* st; };

__device__ __forceinline__ XcdBarrier xcd_barrier_post(unsigned* bar, volatile LAS unsigned* st) {
    XcdBarrier b; b.bar = bar; b.x = xb_xcc_id(); b.st = st;
    if (threadIdx.x == 0) (void)xb_add(&bar[XB_XCNT(b.x)], 1u);
    return b;
}
__device__ __forceinline__ void xcd_barrier_complete(unsigned* bar, unsigned x, unsigned& nloc, unsigned& nx) {
    const unsigned G = gridDim.x * gridDim.y * gridDim.z;
    unsigned sum, cnt, mine, sp = 0u;
    for (;;) {
        sum = 0u; cnt = 0u; mine = 0u;
#pragma unroll
        for (unsigned j = 0; j < 16; ++j) { const unsigned c = xb_ld(&bar[XB_XCNT(j)]); sum += c; cnt += (c > 0u) ? 1u : 0u; mine = (j == x) ? c : mine; }
        if (sum == G) break;
        __builtin_amdgcn_s_sleep(1);
        if ((++sp & 255u) == 0u) { if (xb_ld(&bar[XB_TMO])) break; if (sp > XB_SPIN_CAP) { atomicAdd(&bar[XB_TMO], 1u); break; } }
    }
    nloc = mine > 0u ? mine : 1u; nx = cnt > 0u ? cnt : 1u;
}
__device__ __forceinline__ void xcd_barrier(const XcdBarrier& b) {
    asm volatile("s_waitcnt vmcnt(0)" ::: "memory");
    __syncthreads();
    if (threadIdx.x == 0) {
        unsigned* bar = b.bar;
        __builtin_amdgcn_s_waitcnt(0);
        unsigned nloc = b.st[0], nx = b.st[1];
        if (nloc == 0u) { xcd_barrier_complete(bar, b.x, nloc, nx); b.st[0] = nloc; b.st[1] = nx; }
        const unsigned old = xb_add(&bar[XB_XSUB(b.x)], 1u);
        const unsigned gen = old / nloc;
        if (old + 1u == (gen + 1u) * nloc) {
            __builtin_amdgcn_fence(__ATOMIC_RELEASE, "agent");
            asm volatile("s_waitcnt vmcnt(0)" ::: "memory");
            const unsigned og = xb_add(&bar[XB_TOP], 1u);
            const unsigned tg = og / nx;
            if (og + 1u == (tg + 1u) * nx) xb_add(&bar[XB_TOPGEN], 1u);
            else XB_SPIN(xb_ld(&bar[XB_TOPGEN]) == tg, bar);
            __builtin_amdgcn_fence(__ATOMIC_ACQUIRE, "agent");
            xb_add(&bar[XB_XGEN(b.x)], 1u);
            asm volatile("s_waitcnt vmcnt(0)" ::: "memory");
        } else {
            XB_SPIN(xb_ld(&bar[XB_XGEN(b.x)]) == gen, bar);
            __builtin_amdgcn_fence(__ATOMIC_ACQUIRE, "agent");
            asm volatile("s_waitcnt vmcnt(0)" ::: "memory");
        }
    }
    __syncthreads();
}

namespace pg8 {
constexpr int BM = 256, BK = 64, HALF = 128, HTB = HALF * BK * 2, STAGE_BYTES = 8 * HTB, NXCD = 8, WGM = 8;
__host__ __device__ __forceinline__ int lds_byte(int r, int c) { const int st = (r >> 4) * 2 + (c >> 5), rr = r & 15, cc = c & 31, ob = rr * 64 + cc * 2; return st * 1024 + (ob ^ (((ob >> 9) & 1) << 5)); }
__host__ __device__ __forceinline__ void stage_rc(int b, int& R, int& C) { const int st = b / 1024, sb = b % 1024, swz = sb ^ (((sb >> 9) & 1) << 5); R = (st >> 1) * 16 + swz / 64; C = (st & 1) * 32 + (swz % 64) / 2; }
__host__ __device__ __forceinline__ int perm32(int rho) { const int n = rho >> 4, i = rho & 15; return 8 * (i >> 2) + 4 * n + (i & 3); }

struct Unit { int pm, pn; size_t boff; size_t aoff; int slice; };
struct Gemm { const void* A; const void* Bt; int M, N, K; int ntk; };

struct StaticOrder {
    int nM, nN, nwg, G, c;
    __device__ void init(int M, int N, int G_, int c_) { nM = M / BM; nN = N / BM; nwg = nM * nN; G = G_; c = c_; }
    __device__ bool next(int i, Unit& u) const {
        const long L = (long)i * G + c; if (L >= nwg) return false;
        int wgid = (int)L; { const int q = nwg / NXCD, r = nwg % NXCD, xcd = wgid % NXCD, off = wgid / NXCD; wgid = (xcd < r ? xcd * (q + 1) : r * (q + 1) + (xcd - r) * q) + off; }
        const int nig = WGM * nN, gid = wgid / nig, fm = gid * WGM, gsz = (nM - fm) < WGM ? (nM - fm) : WGM;
        u.pm = fm + ((wgid % nig) % gsz); u.pn = (wgid % nig) / gsz; u.boff = 0; u.aoff = 0; u.slice = 0; return true;
    }
};
struct TileMap {
    int toff[9];
    __device__ __forceinline__ void lookup(int pm, int& e, int& k) const {
        e = (pm >= toff[1]) + (pm >= toff[2]) + (pm >= toff[3]) + (pm >= toff[4]) + (pm >= toff[5]) + (pm >= toff[6]) + (pm >= toff[7]);
        int t0 = 0;
#pragma unroll
        for (int q = 1; q < 8; ++q) t0 = (e == q) ? toff[q] : t0;
        k = pm - t0;
    }
};
constexpr int ECAP = 8192;
struct MoeOrder {
    int nM, nN, nwg, G, c; TileMap tm; size_t estride; size_t arowb;
    __device__ void init(int nM_, int N, int G_, int c_, const TileMap& tm_, size_t es, size_t arowb_) { nM = nM_; nN = N / BM; nwg = nM * nN; G = G_; c = c_; tm = tm_; estride = es; arowb = arowb_; }
    __device__ bool next(int i, Unit& u) const {
        const long L = (long)i * G + c; if (L >= nwg) return false;
        int wgid = (int)L; { const int q = nwg / NXCD, r = nwg % NXCD, xcd = wgid % NXCD, off = wgid / NXCD; wgid = (xcd < r ? xcd * (q + 1) : r * (q + 1) + (xcd - r) * q) + off; }
        const int nig = WGM * nN, gid = wgid / nig, fm = gid * WGM, gsz = (nM - fm) < WGM ? (nM - fm) : WGM;
        u.pm = fm + ((wgid % nig) % gsz); u.pn = (wgid % nig) / gsz; int e, k; tm.lookup(u.pm, e, k); u.boff = (size_t)e * estride;
        u.aoff = (size_t)((long)(e * ECAP + 256 * k - 256 * u.pm) * (long)arowb); u.slice = 0; return true;
    }
};

struct MoeRowOrder {
    int nwg, G, c; TileMap tm; size_t estride;
    __device__ void init(int nMf, int G_, int c_, const TileMap& tm_, size_t es) { nwg = nMf * 8; G = G_; c = c_; tm = tm_; estride = es; }
    __device__ bool next(int i, Unit& u) const {
        const long L = (long)i * G + c; if (L >= nwg) return false;
        u.pm = (int)(L >> 3); u.pn = (int)(L & 7); int e, k; tm.lookup(u.pm, e, k); u.boff = (size_t)e * estride; u.aoff = 0; u.slice = 0; return true;
    }
};
struct MoeSplitOrder {
    int pm0, nq, S, c; size_t kslice; TileMap tm; size_t estride;
    __device__ void init(int pm0_, int nT, int S_, size_t ks, int c_, const TileMap& tm_, size_t es) { pm0 = pm0_; S = S_; nq = nT * 8 * S_; kslice = ks; c = c_; tm = tm_; estride = es; }
    __device__ bool next(int i, Unit& u) const {
        if (i != 0 || c >= nq) return false;
        const int un = c / S; u.slice = c - un * S; u.pm = pm0 + (un >> 3); u.pn = un & 7; u.aoff = (size_t)u.slice * kslice; int e, k; tm.lookup(u.pm, e, k); u.boff = (size_t)e * estride + u.aoff; return true;
    }
};
struct EpiBf16 {
    static constexpr bool PERM = true, XBAR = false;
    bf16_t* O; int ldc;
    __device__ __forceinline__ void operator()(const f32x4 (&acc)[2][2][4][2], const Unit& u, int wr, int wc, int fr, int fq) const {
        const int row0 = u.pm * BM + wr * 64 + fr, col0 = u.pn * BM + wc * 32 + 8 * fq;
#pragma unroll
        for (int ai = 0; ai < 2; ++ai)
#pragma unroll
            for (int m = 0; m < 4; ++m) { bf16_t* rowp = O + (size_t)(row0 + ai * HALF + m * 16) * ldc + col0;
#pragma unroll
                for (int bj = 0; bj < 2; ++bj) { const f32x4 v0 = acc[ai][bj][m][0], v1 = acc[ai][bj][m][1];
                    u32x4 w; w.x = cvt_pk_bf16(v0[0], v0[1]); w.y = cvt_pk_bf16(v0[2], v0[3]); w.z = cvt_pk_bf16(v1[0], v1[1]); w.w = cvt_pk_bf16(v1[2], v1[3]);
                    *(u32x4*)(rowp + bj * HALF) = w; } }
    }
};
struct EpiQKNorm {
    static constexpr bool PERM = true, XBAR = true;
    bf16_t* O; int ldc; const float* qg; const float* kg; float sc;
    __device__ __forceinline__ void pre(const f32x4 (&acc)[2][2][4][2], int wr, int wc, int fr, int fq, LAS float* P) const {
#pragma unroll
        for (int ai = 0; ai < 2; ++ai)
#pragma unroll
            for (int m = 0; m < 4; ++m)
#pragma unroll
                for (int bj = 0; bj < 2; ++bj) { const f32x4 a = acc[ai][bj][m][0], b = acc[ai][bj][m][1];
                    float ss = (a[0] * a[0] + a[1] * a[1]) + (a[2] * a[2] + a[3] * a[3]) + (b[0] * b[0] + b[1] * b[1]) + (b[2] * b[2] + b[3] * b[3]);
                    ss += __shfl_xor(ss, 16); ss += __shfl_xor(ss, 32);
                    if (fq == 0) P[((ai * HALF + wr * 64 + m * 16 + fr) * 2 + bj) * 4 + wc] = ss * sc * sc; }
    }
    __device__ __forceinline__ void post(const f32x4 (&acc)[2][2][4][2], const Unit& u, int wr, int wc, int fr, int fq, const LAS float* P) const {
        const int row0 = u.pm * BM + wr * 64 + fr, col0 = u.pn * BM + wc * 32 + 8 * fq;
        f32x4 g0[2], g1[2]; float hs[2];
#pragma unroll
        for (int bj = 0; bj < 2; ++bj) { const int head = 2 * u.pn + bj; const float* gp = (head < 16 ? qg : kg) + wc * 32 + 8 * fq; g0[bj] = *(const f32x4*)gp; g1[bj] = *(const f32x4*)(gp + 4); hs[bj] = head < 16 ? 0.08838834764831845f : 1.0f; }
#pragma unroll
        for (int ai = 0; ai < 2; ++ai)
#pragma unroll
            for (int m = 0; m < 4; ++m) { bf16_t* rowp = O + (size_t)(row0 + ai * HALF + m * 16) * ldc + col0;
#pragma unroll
                for (int bj = 0; bj < 2; ++bj) { const f32x4 ps = *(const LAS f32x4*)(P + ((ai * HALF + wr * 64 + m * 16 + fr) * 2 + bj) * 4);
                    const float rstd = hs[bj] / sqrtf(((ps[0] + ps[1]) + (ps[2] + ps[3])) * (1.f / 128.f) + 1e-6f);
                    const f32x4 v0 = acc[ai][bj][m][0] * g0[bj] * (rstd * sc), v1 = acc[ai][bj][m][1] * g1[bj] * (rstd * sc);
                    u32x4 w; w.x = cvt_pk_bf16(v0[0], v0[1]); w.y = cvt_pk_bf16(v0[2], v0[3]); w.z = cvt_pk_bf16(v1[0], v1[1]); w.w = cvt_pk_bf16(v1[2], v1[3]);
                    *(u32x4*)(rowp + bj * HALF) = w; } }
    }
};
struct EpiBf16S {
    static constexpr bool PERM = true, XBAR = false;
    bf16_t* O; int ldc; float sc; size_t sstride;
    __device__ __forceinline__ void operator()(const f32x4 (&acc)[2][2][4][2], const Unit& u, int wr, int wc, int fr, int fq) const {
        const int row0 = u.pm * BM + wr * 64 + fr, col0 = u.pn * BM + wc * 32 + 8 * fq;
        bf16_t* Os = O + (size_t)u.slice * sstride;
#pragma unroll
        for (int ai = 0; ai < 2; ++ai)
#pragma unroll
            for (int m = 0; m < 4; ++m) { bf16_t* rowp = Os + (size_t)(row0 + ai * HALF + m * 16) * ldc + col0;
#pragma unroll
                for (int bj = 0; bj < 2; ++bj) { const f32x4 v0 = acc[ai][bj][m][0] * sc, v1 = acc[ai][bj][m][1] * sc;
                    u32x4 w; w.x = cvt_pk_bf16(v0[0], v0[1]); w.y = cvt_pk_bf16(v0[2], v0[3]); w.z = cvt_pk_bf16(v1[0], v1[1]); w.w = cvt_pk_bf16(v1[2], v1[3]);
                    *(u32x4*)(rowp + bj * HALF) = w; } }
    }
};
struct EpiSwiGLU {
    static constexpr bool PERM = true, XBAR = false;
    bf16_t* O; int ldc;
    __device__ __forceinline__ void operator()(const f32x4 (&acc)[2][2][4][2], const Unit& u, int wr, int wc, int fr, int fq) const {
        const int row0 = u.pm * BM + wr * 64 + fr, col0 = u.pn * HALF + wc * 32 + 8 * fq;
#pragma unroll
        for (int ai = 0; ai < 2; ++ai)
#pragma unroll
            for (int m = 0; m < 4; ++m) { bf16_t* rowp = O + (size_t)(row0 + ai * HALF + m * 16) * ldc + col0;
                float o[8];
#pragma unroll
                for (int n = 0; n < 2; ++n)
#pragma unroll
                    for (int j = 0; j < 4; ++j) { const float g = acc[ai][0][m][n][j], up = acc[ai][1][m][n][j]; o[n * 4 + j] = g * __builtin_amdgcn_rcpf(1.f + __expf(-g)) * up; }
                u32x4 w; w.x = cvt_pk_bf16(o[0], o[1]); w.y = cvt_pk_bf16(o[2], o[3]); w.z = cvt_pk_bf16(o[4], o[5]); w.w = cvt_pk_bf16(o[6], o[7]);
                *(u32x4*)rowp = w; }
    }
};
struct EpiSwiGLU8 {
    static constexpr bool PERM = true, XBAR = false;
    unsigned char* O; int ldc; float isc, osc;
    __device__ __forceinline__ void operator()(const f32x4 (&acc)[2][2][4][2], const Unit& u, int wr, int wc, int fr, int fq) const {
        const int row0 = u.pm * BM + wr * 64 + fr, col0 = u.pn * HALF + wc * 32 + 8 * fq;
#pragma unroll
        for (int ai = 0; ai < 2; ++ai)
#pragma unroll
            for (int m = 0; m < 4; ++m) { unsigned char* rowp = O + (size_t)(row0 + ai * HALF + m * 16) * ldc + col0;
                float o[8];
#pragma unroll
                for (int n = 0; n < 2; ++n)
#pragma unroll
                    for (int j = 0; j < 4; ++j) { const float g = acc[ai][0][m][n][j] * isc, up = acc[ai][1][m][n][j] * isc; o[n * 4 + j] = g * __builtin_amdgcn_rcpf(1.f + __expf(-g)) * up * osc; }
                u32x2 w; w.x = pk4_fp8(o[0], o[1], o[2], o[3]); w.y = pk4_fp8(o[4], o[5], o[6], o[7]);
                *(u32x2*)rowp = w; }
    }
};
struct EpiResGate {
    static constexpr bool PERM = false, XBAR = false;
    const float* base; float* out; int ldc; const float* gate; int gstride;
    __device__ __forceinline__ void operator()(const f32x4 (&acc)[2][2][4][2], const Unit& u, int wr, int wc, int fr, int fq) const {
        const int row0 = u.pm * BM + wr * 64 + fr, col0 = u.pn * BM + wc * 32 + 4 * fq;
        const float* gp = gate + (size_t)((u.pm * BM) >> 11) * gstride + col0;
        f32x4 gv[2][2];
#pragma unroll
        for (int bj = 0; bj < 2; ++bj)
#pragma unroll
            for (int n = 0; n < 2; ++n) gv[bj][n] = *(const f32x4*)(gp + bj * HALF + n * 16);
#pragma unroll
        for (int ai = 0; ai < 2; ++ai)
#pragma unroll
            for (int m = 0; m < 4; ++m) { const size_t off = (size_t)(row0 + ai * HALF + m * 16) * ldc + col0;
#pragma unroll
                for (int bj = 0; bj < 2; ++bj)
#pragma unroll
                    for (int n = 0; n < 2; ++n) { const f32x4 bs = *(const f32x4*)(base + off + bj * HALF + n * 16);
                        *(f32x4*)(out + off + bj * HALF + n * 16) = bs + gv[bj][n] * acc[ai][bj][m][n]; }
                asm volatile("" ::: "memory"); }
    }
};
template <bool BASE16>
struct EpiResGate16 {
    static constexpr bool PERM = true, XBAR = false;
    const void* base; bf16_t* out; int ldc; const float* gate; int gstride;
    __device__ __forceinline__ void operator()(const f32x4 (&acc)[2][2][4][2], const Unit& u, int wr, int wc, int fr, int fq) const {
        const int row0 = u.pm * BM + wr * 64 + fr, col0 = u.pn * BM + wc * 32 + 8 * fq;
        const float* gp = gate + (size_t)((u.pm * BM) >> 11) * gstride + col0;
        f32x4 gv[2][2];
#pragma unroll
        for (int bj = 0; bj < 2; ++bj)
#pragma unroll
            for (int n = 0; n < 2; ++n) gv[bj][n] = *(const f32x4*)(gp + bj * HALF + 4 * n);
#pragma unroll
        for (int ai = 0; ai < 2; ++ai)
#pragma unroll
            for (int m = 0; m < 4; ++m) { const size_t off = (size_t)(row0 + ai * HALF + m * 16) * ldc + col0;
#pragma unroll
                for (int bj = 0; bj < 2; ++bj) { f32x4 b0, b1;
                    if (BASE16) { const u32x4 r = *(const u32x4*)((const bf16_t*)base + off + bj * HALF);
                        b0 = (f32x4){__uint_as_float(r.x << 16), __uint_as_float(r.x & 0xffff0000u), __uint_as_float(r.y << 16), __uint_as_float(r.y & 0xffff0000u)};
                        b1 = (f32x4){__uint_as_float(r.z << 16), __uint_as_float(r.z & 0xffff0000u), __uint_as_float(r.w << 16), __uint_as_float(r.w & 0xffff0000u)}; }
                    else { b0 = *(const f32x4*)((const float*)base + off + bj * HALF); b1 = *(const f32x4*)((const float*)base + off + bj * HALF + 4); }
                    const f32x4 v0 = b0 + gv[bj][0] * acc[ai][bj][m][0], v1 = b1 + gv[bj][1] * acc[ai][bj][m][1];
                    u32x4 w; w.x = cvt_pk_bf16(v0[0], v0[1]); w.y = cvt_pk_bf16(v0[2], v0[3]); w.z = cvt_pk_bf16(v1[0], v1[1]); w.w = cvt_pk_bf16(v1[2], v1[3]);
                    *(u32x4*)(out + off + bj * HALF) = w; }
                asm volatile("" ::: "memory"); }
    }
};
struct EpiF32 {
    static constexpr bool PERM = false, XBAR = false;
    float* C; int ldc; float sc;
    __device__ __forceinline__ void operator()(const f32x4 (&acc)[2][2][4][2], const Unit& u, int wr, int wc, int fr, int fq) const {
        const int row0 = u.pm * BM + wr * 64 + fr, col0 = u.pn * BM + wc * 32 + 4 * fq;
#pragma unroll
        for (int ai = 0; ai < 2; ++ai)
#pragma unroll
            for (int m = 0; m < 4; ++m) { float* rowp = C + (size_t)(row0 + ai * HALF + m * 16) * ldc + col0;
#pragma unroll
                for (int bj = 0; bj < 2; ++bj)
#pragma unroll
                    for (int n = 0; n < 2; ++n) *(f32x4*)(rowp + bj * HALF + n * 16) = acc[ai][bj][m][n] * sc; }
    }
};

template <class Epi, class Sched, bool F8 = false, int HOT = 0, int SCH = GEMM_SCH>
__device__ __forceinline__ void gemm_phase(LAS unsigned char* lds, const Gemm g, const Sched& S, const Epi& E) {
    const int tid = threadIdx.x, wid = __builtin_amdgcn_readfirstlane(tid >> 6), lane = tid & 63, wr = wid >> 2, wc = wid & 3, fr = lane & 15, fq = lane >> 4;
    const int rowb = F8 ? g.K : 2 * g.K, nt = g.ntk ? g.ntk : rowb / (BK * 2);
    unsigned voffA[2], voffB[2];
#pragma unroll
    for (int i = 0; i < 2; ++i) { int R, C; stage_rc(tid * 16 + i * 8192, R, C); const int Rb = Epi::PERM ? ((R & ~31) + perm32(R & 31)) : R;
        voffA[i] = (unsigned)(R * rowb + C * 2); voffB[i] = (unsigned)(Rb * rowb + C * 2); }
    const size_t kstep = (size_t)(BK * 2);
    const size_t hstep = (size_t)HALF * rowb;
    const size_t tstep = 2 * hstep;
    const unsigned ldsw = (unsigned)wid * 1024u;
    const int aoff = lds_byte(wr * 64 + fr, fq * 8), boff = lds_byte(wc * 32 + fr, fq * 8);
#define PG8_SA(b, h) (((b) * 2 + (h)) * HTB)
#define PG8_SB(b, h) ((4 + (b) * 2 + (h)) * HTB)
#define PG8_STAGE(bufoff, gbase, voff) do { _Pragma("unroll") for (int _i = 0; _i < 2; ++_i) \
        __builtin_amdgcn_global_load_lds((const unsigned*)((const char*)(gbase) + (voff)[_i]), (LAS unsigned*)(lds + (bufoff) + ldsw + _i * 8192), 16, 0, 0); } while (0)
#define PG8_LD8(base_) __builtin_shufflevector(*(const LAS i32x4*)(base_), *(const LAS i32x4*)((base_) + 1024), 0, 1, 2, 3, 4, 5, 6, 7)
#define PG8_LDA(dst, b, h) do { _Pragma("unroll") for (int m = 0; m < 4; ++m) { if constexpr (F8) dst##8[m] = PG8_LD8(lds + PG8_SA(b, h) + aoff + m * 2048); \
        else { _Pragma("unroll") for (int k = 0; k < 2; ++k) dst[m][k] = *(const LAS bf16x8*)(lds + PG8_SA(b, h) + aoff + m * 2048 + k * 1024); } } } while (0)
#define PG8_LDB(dst, b, h) do { _Pragma("unroll") for (int n = 0; n < 2; ++n) { if constexpr (F8) dst##8[n] = PG8_LD8(lds + PG8_SB(b, h) + boff + n * 2048); \
        else { _Pragma("unroll") for (int k = 0; k < 2; ++k) dst[n][k] = *(const LAS bf16x8*)(lds + PG8_SB(b, h) + boff + n * 2048 + k * 1024); } } } while (0)
#define PG8_MMA(ai, bj, At, Bt) do { __builtin_amdgcn_s_setprio(1); _Pragma("unroll") for (int m = 0; m < 4; ++m) _Pragma("unroll") for (int n = 0; n < 2; ++n) { \
        if constexpr (F8) { asm volatile("v_mfma_f32_16x16x128_f8f6f4 %0, %1, %2, %0" : "+v"(acc[ai][bj][m][n]) : "v"(Bt##8[n]), "v"(At##8[m])); } \
        else { _Pragma("unroll") for (int k = 0; k < 2; ++k) acc[ai][bj][m][n] = __builtin_amdgcn_mfma_f32_16x16x32_bf16(Bt[n][k], At[m][k], acc[ai][bj][m][n], 0, 0, 0); } } \
        __builtin_amdgcn_s_setprio(0); } while (0)
#define PG8_WAIT_V(n) asm volatile("s_waitcnt vmcnt(" #n ")" ::: "memory")
#define PG8_WAIT_L(n) asm volatile("s_waitcnt lgkmcnt(" #n ")" ::: "memory")
#define PG8_BAR __builtin_amdgcn_s_barrier()
#define PG8_SCHED __builtin_amdgcn_sched_barrier(0)
    Unit cur, nxt; int ui = 0;
    if (!S.next(0, cur)) return;
    f32x4 acc[2][2][4][2];
#pragma unroll
    for (int a = 0; a < 2; ++a)
#pragma unroll
        for (int b = 0; b < 2; ++b)
#pragma unroll
            for (int m = 0; m < 4; ++m)
#pragma unroll
                for (int n = 0; n < 2; ++n) acc[a][b][m][n] = (f32x4){0.f, 0.f, 0.f, 0.f};
    bf16x8 At[4][2], B0[2][2], B1[2][2]; i32x8 At8[4], B08[2], B18[2];
    const char* cA = (const char*)g.A + cur.aoff + (size_t)(HOT ? 0 : cur.pm) * tstep; const char* cB = (const char*)g.Bt + cur.boff + (size_t)(HOT ? 0 : cur.pn) * tstep;
    if constexpr (SCH == 1) {
        PG8_STAGE(PG8_SB(0, 0), cB, voffB); PG8_STAGE(PG8_SB(0, 1), cB + hstep, voffB); PG8_STAGE(PG8_SA(0, 0), cA, voffA); PG8_STAGE(PG8_SA(0, 1), cA + hstep, voffA);
        if (wr == 1) PG8_BAR;
        PG8_WAIT_V(2); PG8_BAR;
        PG8_STAGE(PG8_SB(1, 0), cB + kstep, voffB); PG8_STAGE(PG8_SB(1, 1), cB + hstep + kstep, voffB); PG8_STAGE(PG8_SA(1, 0), cA + kstep, voffA);
        PG8_WAIT_V(6); PG8_BAR;
    } else {
    PG8_STAGE(PG8_SB(0, 0), cB, voffB); PG8_STAGE(PG8_SA(0, 0), cA, voffA); PG8_STAGE(PG8_SB(0, 1), cB + hstep, voffB); PG8_STAGE(PG8_SA(0, 1), cA + hstep, voffA);
    if (wr == 1) PG8_BAR;
    PG8_WAIT_V(4); PG8_BAR;
    PG8_STAGE(PG8_SB(1, 0), cB + kstep, voffB); PG8_STAGE(PG8_SA(1, 0), cA + kstep, voffA); PG8_STAGE(PG8_SB(1, 1), cB + hstep + kstep, voffB);
    PG8_WAIT_V(6); PG8_BAR;
    }
    for (;;) {
        const bool has_next = S.next(ui + 1, nxt);
        const char* nA = has_next ? (const char*)g.A + nxt.aoff + (size_t)(HOT ? 0 : nxt.pm) * tstep : cA; const char* nB = has_next ? (const char*)g.Bt + nxt.boff + (size_t)(HOT ? 0 : nxt.pn) * tstep : cB;
        for (int t = 0; t < nt; t += 2) {
            const bool last = (t == nt - 2);
            const char* a1 = cA + (size_t)(t + 1) * kstep;
            const char* a2 = last ? nA : cA + (size_t)(t + 2) * kstep; const char* b2 = last ? nB : cB + (size_t)(t + 2) * kstep;
            const char* a3 = a2 + kstep; const char* b3 = b2 + kstep;
            if constexpr (SCH == 1) {
                PG8_LDB(B0, 0, 0); PG8_LDB(B1, 0, 1); PG8_SCHED; PG8_LDA(At, 0, 0); PG8_STAGE(PG8_SA(1, 1), a1 + hstep, voffA);
                PG8_WAIT_V(8); PG8_WAIT_L(0); PG8_BAR; PG8_MMA(0, 0, At, B0); PG8_MMA(0, 1, At, B1); PG8_BAR; PG8_SCHED;
                PG8_LDA(At, 0, 1); PG8_STAGE(PG8_SB(0, 0), b2, voffB); PG8_STAGE(PG8_SB(0, 1), b2 + hstep, voffB); PG8_STAGE(PG8_SA(0, 0), a2, voffA);
                PG8_WAIT_V(8); PG8_WAIT_L(0); PG8_BAR; PG8_MMA(1, 0, At, B0); PG8_MMA(1, 1, At, B1); PG8_BAR; PG8_SCHED;
                PG8_LDB(B0, 1, 0); PG8_LDB(B1, 1, 1); PG8_SCHED; PG8_LDA(At, 1, 0); PG8_STAGE(PG8_SA(0, 1), a2 + hstep, voffA);
                PG8_WAIT_V(8); PG8_WAIT_L(0); PG8_BAR; PG8_MMA(0, 0, At, B0); PG8_MMA(0, 1, At, B1); PG8_BAR; PG8_SCHED;
                PG8_LDA(At, 1, 1); PG8_STAGE(PG8_SB(1, 0), b3, voffB); PG8_STAGE(PG8_SB(1, 1), b3 + hstep, voffB); PG8_STAGE(PG8_SA(1, 0), a3, voffA);
                PG8_WAIT_V(8); PG8_WAIT_L(0); PG8_BAR; PG8_MMA(1, 0, At, B0); PG8_MMA(1, 1, At, B1); PG8_BAR; PG8_SCHED;
                continue;
            }
            PG8_LDB(B0, 0, 0); PG8_SCHED; PG8_LDA(At, 0, 0); PG8_STAGE(PG8_SA(1, 1), a1 + hstep, voffA);
            PG8_WAIT_L(8); PG8_BAR; PG8_WAIT_L(0); PG8_MMA(0, 0, At, B0); PG8_BAR; PG8_SCHED;
            PG8_LDB(B1, 0, 1); PG8_STAGE(PG8_SB(0, 0), b2, voffB);
            PG8_BAR; PG8_WAIT_L(0); PG8_MMA(0, 1, At, B1); PG8_BAR;
            PG8_LDA(At, 0, 1); PG8_STAGE(PG8_SA(0, 0), a2, voffA);
            PG8_BAR; PG8_WAIT_L(0); PG8_MMA(1, 0, At, B0); PG8_BAR; PG8_SCHED;
            PG8_STAGE(PG8_SB(0, 1), b2 + hstep, voffB);
            PG8_WAIT_V(6); PG8_BAR; PG8_MMA(1, 1, At, B1); PG8_BAR;
            PG8_LDB(B0, 1, 0); PG8_SCHED; PG8_LDA(At, 1, 0); PG8_STAGE(PG8_SA(0, 1), a2 + hstep, voffA);
            PG8_WAIT_L(8); PG8_BAR; PG8_WAIT_L(0); PG8_MMA(0, 0, At, B0); PG8_BAR; PG8_SCHED;
            PG8_LDB(B1, 1, 1); PG8_STAGE(PG8_SB(1, 0), b3, voffB);
            PG8_BAR; PG8_WAIT_L(0); PG8_MMA(0, 1, At, B1); PG8_BAR;
            PG8_LDA(At, 1, 1); PG8_STAGE(PG8_SA(1, 0), a3, voffA);
            PG8_BAR; PG8_WAIT_L(0); PG8_MMA(1, 0, At, B0); PG8_BAR; PG8_SCHED;
            PG8_STAGE(PG8_SB(1, 1), b3 + hstep, voffB);
            PG8_WAIT_V(6); PG8_BAR; PG8_MMA(1, 1, At, B1); PG8_BAR;
        }
        if constexpr (F8) asm volatile("s_nop 15\n\ts_nop 15" ::: "memory");
        if constexpr (Epi::XBAR) { LAS float* P_ = (LAS float*)(lds + STAGE_BYTES); E.pre(acc, wr, wc, fr, fq, P_); PG8_WAIT_L(0); PG8_BAR; asm volatile("" ::: "memory"); E.post(acc, cur, wr, wc, fr, fq, P_); }
        else E(acc, cur, wr, wc, fr, fq);
        if (!has_next) break;
#pragma unroll
        for (int a = 0; a < 2; ++a)
#pragma unroll
            for (int b = 0; b < 2; ++b)
#pragma unroll
                for (int m = 0; m < 4; ++m)
#pragma unroll
                    for (int n = 0; n < 2; ++n) acc[a][b][m][n] = (f32x4){0.f, 0.f, 0.f, 0.f};
        cur = nxt; cA = nA; cB = nB; ++ui;
    }
    PG8_WAIT_V(0);
    if (wr == 0) PG8_BAR;
    PG8_BAR;
#undef PG8_SA
#undef PG8_SB
#undef PG8_STAGE
#undef PG8_LDA
#undef PG8_LDB
#undef PG8_MMA
#undef PG8_WAIT_V
#undef PG8_WAIT_L
#undef PG8_BAR
#undef PG8_SCHED
}
}

DI void mod_phase(const float* c, const float* mod_w, const float* mod_b, float* mod, LAS unsigned char* lds, int G, int tid, int lane, int wave) {
    LAS f32x4* cact = (LAS f32x4*)lds;
    LAS float* red = (LAS float*)(lds + 32768);
    for (int k = tid; k < DM; k += NTHREADS) { f32x4 v; v.x = silu_f(c[k]); v.y = silu_f(c[DM + k]); v.z = silu_f(c[2 * DM + k]); v.w = silu_f(c[3 * DM + k]); cact[k] = v; }
    __syncthreads();
    for (int it = blockIdx.x; it < 256; it += G) {
        const int l = it >> 7, n0 = (it & 127) * 96;
        float a0[4] = {0.f, 0.f, 0.f, 0.f}, a1[4] = {0.f, 0.f, 0.f, 0.f};
        if (lane < 48) {
            const float* wp = mod_w + ((size_t)l * DM + wave * 256) * 12288 + n0 + 2 * lane;
#pragma unroll 8
            for (int k = 0; k < 256; ++k) { const f32x2 w = *(const f32x2*)(wp + (size_t)k * 12288); const f32x4 cv = cact[wave * 256 + k];
                a0[0] += cv.x * w.x; a1[0] += cv.x * w.y; a0[1] += cv.y * w.x; a1[1] += cv.y * w.y; a0[2] += cv.z * w.x; a1[2] += cv.z * w.y; a0[3] += cv.w * w.x; a1[3] += cv.w * w.y; }
#pragma unroll
            for (int b = 0; b < 4; ++b) { red[(wave * 4 + b) * 96 + 2 * lane] = a0[b]; red[(wave * 4 + b) * 96 + 2 * lane + 1] = a1[b]; }
        }
        __syncthreads();
        if (tid < 384) { const int b = tid / 96, col = tid % 96; float s = mod_b[l * 12288 + n0 + col];
#pragma unroll
            for (int w = 0; w < 8; ++w) s += red[(w * 4 + b) * 96 + col];
            mod[((size_t)l * 4 + b) * 12288 + n0 + col] = s; }
        __syncthreads();
    }
}

template <int MODE>
DI void cvt_item(const float* W, int K, int N, bf16_t* WT, LAS float* scr, int kb, int nb, int lane) {
    const int k0 = 64 * kb, n0 = 32 * nb;
    float v[32];
    const float* wp = W + (size_t)(k0 + (lane >> 5)) * N + n0 + (lane & 31);
#pragma unroll
    for (int i = 0; i < 32; ++i) v[i] = wp[(size_t)(2 * i) * N];
#pragma unroll
    for (int i = 0; i < 32; ++i) scr[(2 * i + (lane >> 5)) * 33 + (lane & 31)] = v[i];
    LDS_WAIT();
    const int c = lane & 7;
#pragma unroll
    for (int j = 0; j < 4; ++j) { const int n = (lane >> 3) + 8 * j; const LAS float* s = scr + (8 * c) * 33 + n;
        u32x4 o; o.x = cvt_pk_bf16(s[0 * 33], s[1 * 33]); o.y = cvt_pk_bf16(s[2 * 33], s[3 * 33]); o.z = cvt_pk_bf16(s[4 * 33], s[5 * 33]); o.w = cvt_pk_bf16(s[6 * 33], s[7 * 33]);
        const int ng = n0 + n; const int row = (MODE == 0) ? ng : ((ng >> 7) * 256 + (ng & 127) + (MODE == 2 ? 128 : 0));
        *(u32x4*)(WT + (size_t)row * K + k0 + 8 * c) = o; }
    LDS_WAIT();
}
template <int MODE>
DI void cvt_item8(const float* W, int K, int N, unsigned char* WT, LAS float* scr, int kb, int nb, int lane, float wsc) {
    const int k0 = 64 * kb, n0 = 32 * nb;
    float v[32];
    const float* wp = W + (size_t)(k0 + (lane >> 5)) * N + n0 + (lane & 31);
#pragma unroll
    for (int i = 0; i < 32; ++i) v[i] = wp[(size_t)(2 * i) * N];
#pragma unroll
    for (int i = 0; i < 32; ++i) scr[(2 * i + (lane >> 5)) * 33 + (lane & 31)] = v[i] * wsc;
    LDS_WAIT();
    const int c = lane & 3;
#pragma unroll
    for (int j = 0; j < 2; ++j) { const int n = (lane >> 2) + 16 * j; const LAS float* s = scr + (16 * c) * 33 + n;
        u32x4 o; o.x = pk4_fp8(s[0 * 33], s[1 * 33], s[2 * 33], s[3 * 33]); o.y = pk4_fp8(s[4 * 33], s[5 * 33], s[6 * 33], s[7 * 33]);
        o.z = pk4_fp8(s[8 * 33], s[9 * 33], s[10 * 33], s[11 * 33]); o.w = pk4_fp8(s[12 * 33], s[13 * 33], s[14 * 33], s[15 * 33]);
        const int ng = n0 + n; const int row = (MODE == 0) ? ng : ((ng >> 7) * 256 + (ng & 127) + (MODE == 2 ? 128 : 0));
        *(u32x4*)(WT + (size_t)row * K + k0 + 16 * c) = o; }
    LDS_WAIT();
}
template <int MODE>
DI void cvt_job8(const float* W, int K, int N, int nbatch, unsigned char* WT, size_t dst_bstride, LAS float* scr, int gw, int NGW, int lane, float wsc) {
    const int nnb = N / 32, per = (K / 64) * nnb, total = per * nbatch;
    for (int it = gw; it < total; it += NGW) {
        const int bt = it / per, r = it - bt * per, kb = r / nnb, nb = r - kb * nnb;
        cvt_item8<MODE>(W + (size_t)bt * K * N, K, N, WT + (size_t)bt * dst_bstride, scr, kb, nb, lane, wsc);
    }
}
template <int MODE>
DI void cvt_job(const float* W, int K, int N, int nbatch, bf16_t* WT, size_t dst_bstride, LAS float* scr, int gw, int NGW, int lane) {
    const int nnb = N / 32, per = (K / 64) * nnb, total = per * nbatch;
    for (int it = gw; it < total; it += NGW) {
        const int bt = it / per, r = it - bt * per, kb = r / nnb, nb = r - kb * nnb;
        cvt_item<MODE>(W + (size_t)bt * K * N, K, N, WT + (size_t)bt * dst_bstride, scr, kb, nb, lane);
    }
}

DI void cvtw_load(f32x4 (&v)[16], const float* wp, int N) {
#pragma unroll
    for (int i = 0; i < 16; ++i) v[i] = __builtin_nontemporal_load((const f32x4*)(wp + (size_t)(4 * i) * N));
}
template <int MODE, bool OUT8>
DI void cvtw_store(const f32x4 (&v)[16], int K, void* WTb, LAS float* scr, int k0, int n0, int lane, float wsc) {
    const int kr = lane >> 4, n4 = lane & 15;
#pragma unroll
    for (int i = 0; i < 16; ++i)
#pragma unroll
        for (int e = 0; e < 4; ++e) scr[(4 * n4 + e) * 65 + 4 * i + kr] = OUT8 ? v[i][e] * wsc : v[i][e];
    LDS_WAIT();
    if (OUT8) {
        unsigned char* WT = (unsigned char*)WTb; const int c = lane & 3;
#pragma unroll
        for (int j = 0; j < 4; ++j) { const int n = (lane >> 2) + 16 * j; const LAS float* s = scr + n * 65 + 16 * c;
            u32x4 o; o.x = pk4_fp8(s[0], s[1], s[2], s[3]); o.y = pk4_fp8(s[4], s[5], s[6], s[7]); o.z = pk4_fp8(s[8], s[9], s[10], s[11]); o.w = pk4_fp8(s[12], s[13], s[14], s[15]);
            const int ng = n0 + n; const int row = (MODE == 0) ? ng : ((ng >> 7) * 256 + (ng & 127) + (MODE == 2 ? 128 : 0));
            *(u32x4*)(WT + (size_t)row * K + k0 + 16 * c) = o; }
    } else {
        bf16_t* WT = (bf16_t*)WTb; const int c = lane & 7;
#pragma unroll
        for (int j = 0; j < 8; ++j) { const int n = (lane >> 3) + 8 * j; const LAS float* s = scr + n * 65 + 8 * c;
            u32x4 o; o.x = cvt_pk_bf16(s[0], s[1]); o.y = cvt_pk_bf16(s[2], s[3]); o.z = cvt_pk_bf16(s[4], s[5]); o.w = cvt_pk_bf16(s[6], s[7]);
            const int ng = n0 + n; const int row = (MODE == 0) ? ng : ((ng >> 7) * 256 + (ng & 127) + (MODE == 2 ? 128 : 0));
            *(u32x4*)(WT + (size_t)row * K + k0 + 8 * c) = o; }
    }
    LDS_WAIT();
}
DI void cvtw_pack8(const f32x4 (&v)[16], LAS float* scr, int lane, float wsc, u32x4 (&o)[4]) {
    const int kr = lane >> 4, n4 = lane & 15;
#pragma unroll
    for (int i = 0; i < 16; ++i)
#pragma unroll
        for (int e = 0; e < 4; ++e) scr[(4 * n4 + e) * 65 + 4 * i + kr] = v[i][e] * wsc;
    LDS_WAIT();
    const int c = lane & 3;
#pragma unroll
    for (int j = 0; j < 4; ++j) { const int n = (lane >> 2) + 16 * j; const LAS float* s = scr + n * 65 + 16 * c;
        o[j].x = pk4_fp8(s[0], s[1], s[2], s[3]); o[j].y = pk4_fp8(s[4], s[5], s[6], s[7]); o[j].z = pk4_fp8(s[8], s[9], s[10], s[11]); o[j].w = pk4_fp8(s[12], s[13], s[14], s[15]); }
    LDS_WAIT();
}
template <int MODE, bool OUT8>
DI void cvtw_job(const float* W, int K, int N, int nbatch, void* WT, size_t dst_bstride_bytes, LAS float* scr, int gw, int NGW, int lane, float wsc, int ld = 0) {
    const int nnb = N / 64, per = (K / 128) * nnb, total = per * nbatch;
    for (int it = gw; it < total; it += NGW) {
        const int bt = it / per, r = it - bt * per, kb = r / nnb, nb = r - kb * nnb, k0 = 128 * kb, n0 = 64 * nb;
        const int pitch = ld ? ld : N;
        const float* wp = W + (size_t)bt * K * pitch + (size_t)(k0 + (lane >> 4)) * pitch + n0 + 4 * (lane & 15);
        f32x4 v0[16], v1[16];
        cvtw_load(v0, wp, pitch); cvtw_load(v1, wp + (size_t)64 * pitch, pitch);
        void* WTb = (unsigned char*)WT + (size_t)bt * dst_bstride_bytes;
        if (OUT8) {
            u32x4 o0[4], o1[4]; cvtw_pack8(v0, scr, lane, wsc, o0); cvtw_pack8(v1, scr, lane, wsc, o1);
            unsigned char* WT8 = (unsigned char*)WTb; const int c = lane & 3;
#pragma unroll
            for (int j = 0; j < 4; ++j) { const int ng = n0 + (lane >> 2) + 16 * j; const int row = (MODE == 0) ? ng : ((ng >> 7) * 256 + (ng & 127) + (MODE == 2 ? 128 : 0));
                unsigned char* dp = WT8 + (size_t)row * K + k0 + 16 * c; *(u32x4*)dp = o0[j]; *(u32x4*)(dp + 64) = o1[j]; }
        } else {
            cvtw_store<MODE, OUT8>(v0, K, WTb, scr, k0, n0, lane, wsc);
            cvtw_store<MODE, OUT8>(v1, K, WTb, scr, k0 + 64, n0, lane, wsc);
        }
    }
}

constexpr float HSCALE = 8.f, WSCALE = 256.f, ASCALE = 8.f;
template <bool ROUTER, bool OUT8 = false, bool X16 = false>
DI void rms_mod_phase(const void* X, const float* g, const float* scale, const float* shift, bf16_t* out,
                      const float* router, int* tok_e, int* tok_pos, float* tok_w, unsigned* ecnt, unsigned char* HS2, int gw, int NGW, int lane) {
    for (int row = gw; row < MTOK; row += NGW) {
        const int b = row >> 11;
        f32x4 v[8]; float ss = 0.f;
        if (X16) { const u32x2* xr = (const u32x2*)((const bf16_t*)X + (size_t)row * DM) + lane; u32x2 raw[8];
#pragma unroll
            for (int j = 0; j < 8; ++j) raw[j] = xr[64 * j];
#pragma unroll
            for (int j = 0; j < 8; ++j) v[j] = (f32x4){bf_lo(raw[j].x), bf_hi(raw[j].x), bf_lo(raw[j].y), bf_hi(raw[j].y)}; }
        else { const f32x4* xr = (const f32x4*)((const float*)X + (size_t)row * DM) + lane;
#pragma unroll
            for (int j = 0; j < 8; ++j) v[j] = xr[64 * j]; }
#pragma unroll
        for (int j = 0; j < 8; ++j) ss += (v[j].x * v[j].x + v[j].y * v[j].y) + (v[j].z * v[j].z + v[j].w * v[j].w);
        const float rstd = 1.0f / sqrtf(wave_sum(ss) * (1.f / DM) + 1e-6f);
        const f32x4* gp = (const f32x4*)g + lane; const f32x4* sc = (const f32x4*)(scale + (size_t)b * 12288) + lane; const f32x4* sh = (const f32x4*)(shift + (size_t)b * 12288) + lane;
        u32x2* op = (u32x2*)(out + (size_t)row * DM) + lane;
        float lg[8] = {0.f, 0.f, 0.f, 0.f, 0.f, 0.f, 0.f, 0.f}; unsigned h8[8];
#pragma unroll
        for (int j = 0; j < 8; ++j) { const f32x4 gg = gp[64 * j], s1 = sc[64 * j], s2 = sh[64 * j];
            f32x4 h = (v[j] * rstd) * gg; h = h * (s1 + 1.0f) + s2;
            if (ROUTER) { h8[j] = pk4_fp8(h.x * HSCALE, h.y * HSCALE, h.z * HSCALE, h.w * HSCALE); }
            else { u32x2 w; w.x = cvt_pk_bf16(h.x, h.y); w.y = cvt_pk_bf16(h.z, h.w); op[64 * j] = w;
                   if (OUT8) ((unsigned*)(HS2 + (size_t)row * DM) + lane)[64 * j] = pk4_fp8(h.x * HSCALE, h.y * HSCALE, h.z * HSCALE, h.w * HSCALE); }
            if (ROUTER) {
#pragma unroll
                for (int i = 0; i < 4; ++i) { const int cc = 256 * j + 4 * lane + i; const f32x4 r0 = ((const f32x4*)router)[cc * 2], r1 = ((const f32x4*)router)[cc * 2 + 1];
                    lg[0] += h[i] * r0.x; lg[1] += h[i] * r0.y; lg[2] += h[i] * r0.z; lg[3] += h[i] * r0.w; lg[4] += h[i] * r1.x; lg[5] += h[i] * r1.y; lg[6] += h[i] * r1.z; lg[7] += h[i] * r1.w; } } }
        if (ROUTER) {
#pragma unroll
            for (int e = 0; e < 8; ++e) lg[e] = wave_sum(lg[e]);
            if (lane == 0) {
                int i0 = 0; float v0 = lg[0];
#pragma unroll
                for (int e = 1; e < 8; ++e) if (lg[e] > v0) { v0 = lg[e]; i0 = e; }
                int i1 = -1; float v1 = -3.0e38f;
#pragma unroll
                for (int e = 0; e < 8; ++e) if (e != i0 && lg[e] > v1) { v1 = lg[e]; i1 = e; }
                const float w1 = 1.f / (1.f + expf(v0 - v1)), w0 = 1.f - w1;
                const int p0 = (int)__hip_atomic_fetch_add(ecnt + 64 * i0, 1u, __ATOMIC_RELAXED, __HIP_MEMORY_SCOPE_AGENT);
                const int p1 = (int)__hip_atomic_fetch_add(ecnt + 64 * i1, 1u, __ATOMIC_RELAXED, __HIP_MEMORY_SCOPE_AGENT);
                tok_e[2 * row] = i0; tok_e[2 * row + 1] = i1; tok_pos[2 * row] = p0; tok_pos[2 * row + 1] = p1; tok_w[2 * row] = w0; tok_w[2 * row + 1] = w1;
                lg[0] = __int_as_float(i0 * pg8::ECAP + p0); lg[1] = __int_as_float(i1 * pg8::ECAP + p1);
            }
            const int ra = __builtin_amdgcn_readfirstlane(__float_as_int(lg[0])), rb = __builtin_amdgcn_readfirstlane(__float_as_int(lg[1]));
            unsigned* da = (unsigned*)(HS2 + (size_t)ra * DM) + lane; unsigned* db = (unsigned*)(HS2 + (size_t)rb * DM) + lane;
#pragma unroll
            for (int j = 0; j < 8; ++j) { da[64 * j] = h8[j]; db[64 * j] = h8[j]; }
        }
    }
}

DI void qknorm_phase(const bf16_t* QK, bf16_t* QKN, const float* qg, const float* kg, int gw, int NGW, int lane) {
    const int l16 = lane & 15;
    for (int idx = gw * 4 + (lane >> 4); idx < MTOK * 32; idx += NGW * 4) {
        const int hr = idx & 31; const size_t off = (size_t)(idx >> 5) * 4096 + hr * 128 + 8 * l16;
        const u32x4 raw = *(const u32x4*)(QK + off);
        float x[8] = {bf_lo(raw.x), bf_hi(raw.x), bf_lo(raw.y), bf_hi(raw.y), bf_lo(raw.z), bf_hi(raw.z), bf_lo(raw.w), bf_hi(raw.w)};
        float ss = 0.f;
#pragma unroll
        for (int i = 0; i < 8; ++i) ss += x[i] * x[i];
        ss += __shfl_xor(ss, 1); ss += __shfl_xor(ss, 2); ss += __shfl_xor(ss, 4); ss += __shfl_xor(ss, 8);
        const float rstd = (1.0f / sqrtf(ss * (1.f / 128.f) + 1e-6f)) * (hr < 16 ? 0.08838834764831845f : 1.0f);
        const float* gp = (hr < 16 ? qg : kg) + 8 * l16;
        const f32x4 g0 = *(const f32x4*)gp, g1 = *(const f32x4*)(gp + 4);
        u32x4 o; o.x = cvt_pk_bf16(x[0] * rstd * g0.x, x[1] * rstd * g0.y); o.y = cvt_pk_bf16(x[2] * rstd * g0.z, x[3] * rstd * g0.w);
        o.z = cvt_pk_bf16(x[4] * rstd * g1.x, x[5] * rstd * g1.y); o.w = cvt_pk_bf16(x[6] * rstd * g1.z, x[7] * rstd * g1.w);
        *(u32x4*)(QKN + off) = o;
    }
}

constexpr int NA_TBL = 0, NA_BUF = 30720, NA_TILE = 18432;
DI void na_phase(const bf16_t* QKN, const bf16_t* VT, bf16_t* ATT, const float* rpb, LAS unsigned char* lds, int G, int vcu0, int tid, int lane, int wave) {
    LAS float* rpbL = (LAS float*)(lds + NA_TBL);
    for (int i = tid; i < 16 * 465; i += NTHREADS) rpbL[i] = rpb[i];
    const int c16 = lane & 15, g = lane >> 4, unit = wave >> 2, j = wave & 3;
    const int cb = (j == 0) ? 0 : (j == 1) ? 8 : (j == 2) ? 24 : 32;
    const int qc = 16 * j + c16, c0 = min(max(qc - 8, 0), 48);
    const int kcl = 8 * (c16 >> 2) + (c16 & 3);
    for (int p = vcu0; p < 1024; p += G) {
        const int rho = p & 15, hh = (p >> 4) & 15, b = p >> 8;
        const int rA = 2 * rho, r0A = min(max(rA - 4, 0), 24), r0B = min(max(rA + 1 - 4, 0), 24), delta = r0B - r0A, nrows = 8 + delta;
        const int r = rA + unit, r0 = unit ? r0B : r0A;
        const bool shiftB = (unit == 1) && (delta == 1);
        const size_t tq = (size_t)b * SEQ + r * 64 + qc;
        bf16x8 qf[4];
#pragma unroll
        for (int ks = 0; ks < 4; ++ks) qf[ks] = *(const bf16x8*)(QKN + tq * 4096 + hh * 128 + 32 * ks + 8 * g);
        f32x4 S[8][2];
        u32x4 st0, st1;
        const int kkey = tid >> 3, kch = tid & 7;
        const int vd = tid >> 2, vch = tid & 3;
        const bf16_t* kg = QKN + ((size_t)b * SEQ + (size_t)r0A * 64 + kkey) * 4096 + 2048 + hh * 128 + kch * 8;
        const bf16_t* vg = VT + (size_t)(hh * 128 + vd) * MTOK + (size_t)b * SEQ + (size_t)r0A * 64 + vch * 8;
#define NA_LDK(s_) do { st0 = *(const u32x4*)(kg + (size_t)(s_) * 64 * 4096); st1 = *(const u32x4*)(kg + (size_t)(s_) * 64 * 4096 + 64); } while (0)
#define NA_STK(s_) do { LAS unsigned char* t_ = lds + NA_BUF + ((s_) & 1) * NA_TILE + kkey * 272 + kch * 16; *(LAS u32x4*)t_ = st0; *(LAS u32x4*)(t_ + 128) = st1; } while (0)
#define NA_LDV(s_) do { st0 = *(const u32x4*)(vg + (s_) * 64); st1 = *(const u32x4*)(vg + (s_) * 64 + 32); } while (0)
#define NA_STV(s_) do { LAS unsigned char* t_ = lds + NA_BUF + ((s_) & 1) * NA_TILE + vd * 144 + vch * 16; *(LAS u32x4*)t_ = st0; *(LAS u32x4*)(t_ + 64) = st1; } while (0)
#define NA_QK(s_, i_) do { const LAS unsigned char* kb_ = lds + NA_BUF + ((s_) & 1) * NA_TILE + (cb + kcl) * 272 + 16 * g; \
            _Pragma("unroll") for (int hc = 0; hc < 2; ++hc) { f32x4 a = (f32x4){0.f, 0.f, 0.f, 0.f}; \
                _Pragma("unroll") for (int ks = 0; ks < 4; ++ks) a = __builtin_amdgcn_mfma_f32_16x16x32_bf16(*(const LAS bf16x8*)(kb_ + hc * 4 * 272 + 64 * ks), qf[ks], a, 0, 0, 0); S[i_][hc] = a; } } while (0)
#define NA_SROW(s_) do { if ((s_) < nrows) { NA_STK(s_); __syncthreads(); if ((s_) + 1 < nrows) NA_LDK((s_) + 1); \
            if (!shiftB) { if ((s_) < 8) NA_QK(s_, (s_) < 8 ? (s_) : 7); } else { if ((s_) >= 1) NA_QK(s_, (s_) >= 1 ? (s_) - 1 : 0); } } } while (0)
        __syncthreads();
        NA_LDK(0);
        NA_SROW(0); NA_SROW(1); NA_SROW(2); NA_SROW(3); NA_SROW(4); NA_SROW(5); NA_SROW(6); NA_SROW(7); NA_SROW(8);
        NA_LDV(0);
        float mx = -3.0e38f;
        const LAS float* bt = rpbL + hh * 465;
#pragma unroll
        for (int i = 0; i < 8; ++i)
#pragma unroll
            for (int hc = 0; hc < 2; ++hc)
#pragma unroll
                for (int e = 0; e < 4; ++e) {
                    const int kc = cb + 8 * g + 4 * hc + e; const bool valid = (kc >= c0) && (kc < c0 + 16);
                    const int dj = min(max(kc - qc + 15, 0), 30), di = r0 + i - r + 7;
                    const float sv = valid ? S[i][hc][e] + bt[di * 31 + dj] : -3.0e38f;
                    S[i][hc][e] = sv; mx = fmaxf(mx, sv);
                }
        mx = fmaxf(mx, __shfl_xor(mx, 16)); mx = fmaxf(mx, __shfl_xor(mx, 32));
        float sum = 0.f;
#pragma unroll
        for (int i = 0; i < 8; ++i)
#pragma unroll
            for (int hc = 0; hc < 2; ++hc)
#pragma unroll
                for (int e = 0; e < 4; ++e) { const float pv = (S[i][hc][e] > -1.0e38f) ? __expf(S[i][hc][e] - mx) : 0.f; S[i][hc][e] = pv; sum += pv; }
        sum += __shfl_xor(sum, 16); sum += __shfl_xor(sum, 32);
        const float inv = 1.0f / sum;
        f32x4 O[8];
#pragma unroll
        for (int dt = 0; dt < 8; ++dt) O[dt] = (f32x4){0.f, 0.f, 0.f, 0.f};
#define NA_PV(s_, i_) do { u32x4 pw; pw.x = cvt_pk_bf16(S[i_][0][0], S[i_][0][1]); pw.y = cvt_pk_bf16(S[i_][0][2], S[i_][0][3]); pw.z = cvt_pk_bf16(S[i_][1][0], S[i_][1][1]); pw.w = cvt_pk_bf16(S[i_][1][2], S[i_][1][3]); \
            const bf16x8 pf = __builtin_bit_cast(bf16x8, pw); const LAS unsigned char* vb_ = lds + NA_BUF + ((s_) & 1) * NA_TILE + c16 * 144 + (cb + 8 * g) * 2; \
            _Pragma("unroll") for (int dt = 0; dt < 8; ++dt) O[dt] = __builtin_amdgcn_mfma_f32_16x16x32_bf16(*(const LAS bf16x8*)(vb_ + dt * 16 * 144), pf, O[dt], 0, 0, 0); } while (0)
#define NA_VROW(s_) do { if ((s_) < nrows) { NA_STV(s_); __syncthreads(); if ((s_) + 1 < nrows) NA_LDV((s_) + 1); \
            if (!shiftB) { if ((s_) < 8) NA_PV(s_, (s_) < 8 ? (s_) : 7); } else { if ((s_) >= 1) NA_PV(s_, (s_) >= 1 ? (s_) - 1 : 0); } } } while (0)
        __syncthreads();
        NA_VROW(0); NA_VROW(1); NA_VROW(2); NA_VROW(3); NA_VROW(4); NA_VROW(5); NA_VROW(6); NA_VROW(7); NA_VROW(8);
#undef NA_LDK
#undef NA_STK
#undef NA_LDV
#undef NA_STV
#undef NA_QK
#undef NA_SROW
#undef NA_PV
#undef NA_VROW
#pragma unroll
        for (int dt = 0; dt < 8; ++dt) { u32x2 w; w.x = cvt_pk_bf16(O[dt][0] * inv, O[dt][1] * inv); w.y = cvt_pk_bf16(O[dt][2] * inv, O[dt][3] * inv);
            *(u32x2*)(ATT + tq * DM + hh * 128 + 16 * dt + 4 * g) = w; }
    }
}

constexpr int MLP_WIF = 36864, MLP_WROW = 3088;
DI void ml_pre_phase(const bf16_t* XZ, const float* conv_w, const float* conv_b, const float* wq, const float* wk, const float* wv, const bf16_t* WTif,
                     bf16_t* XC, bf16_t* Q, bf16_t* Kb, bf16_t* V, float* pre_part, LAS unsigned char* lds, int G, int tid, int lane, int wave) {
    LAS float* Lcw = (LAS float*)lds;
    LAS float* Lcb = Lcw + 2560;
    LAS float* Lwq = Lcb + 512;
    LAS float* Lwk = Lwq + 2048;
    LAS float* Lwv = Lwk + 2048;
    LAS unsigned char* Lwif = lds + MLP_WIF;
    const int g = lane >> 4, tk = lane & 15;
    for (int item = blockIdx.x; item < 256; item += G) {
        const int hd = item & 7, tr = item >> 3;
        __syncthreads();
        for (int i = tid; i < 2560; i += NTHREADS) Lcw[i] = conv_w[(i >> 9) * 4096 + hd * 512 + (i & 511)];
        Lcb[tid] = conv_b[hd * 512 + tid];
        for (int i = tid; i < 2048; i += NTHREADS) { Lwq[i] = wq[hd * 2048 + i]; Lwk[i] = wk[hd * 2048 + i]; Lwv[i] = wv[hd * 2048 + i]; }
        for (int i = tid; i < 32 * 3 * 64; i += NTHREADS) { const int n = i / 192, rem = i - n * 192, sec = rem >> 6, c16 = rem & 63;
            *(LAS u32x4*)(Lwif + n * MLP_WROW + sec * 1024 + c16 * 16) = *(const u32x4*)(WTif + (size_t)n * 12288 + sec * 4096 + hd * 512 + c16 * 8); }
        __syncthreads();
        for (int tt = wave; tt < 16; tt += 8) {
            const int tok = tr * 256 + tt * 16 + tk, tseq = tok & 2047;
            f32x4 accp[2]; accp[0] = (f32x4){0.f, 0.f, 0.f, 0.f}; accp[1] = (f32x4){0.f, 0.f, 0.f, 0.f};
            u32x4 xrA[5], xrB[5], hq, hk, hv, hc;
#define MLP_LOAD(xr_, step_) do { const int ch_ = hd * 512 + (step_) * 32 + 8 * g; \
                _Pragma("unroll") for (int jt = 0; jt < 5; ++jt) { const int dt = jt - 2; const bool ok = (unsigned)(tseq + dt) < (unsigned)SEQ; \
                    xr_[jt] = (u32x4){0u, 0u, 0u, 0u}; if (ok) xr_[jt] = *(const u32x4*)(XZ + (size_t)(tok + dt) * 8192 + ch_); } } while (0)
#define MLP_COMPUTE(xr_, step_, HOLD_) do { \
                const int cl = (step_) * 32 + 8 * g, ch = hd * 512 + cl; \
                float a[8], xm[8]; \
                { const f32x4 b0 = *(const LAS f32x4*)(Lcb + cl), b1 = *(const LAS f32x4*)(Lcb + cl + 4); \
                  a[0] = b0.x; a[1] = b0.y; a[2] = b0.z; a[3] = b0.w; a[4] = b1.x; a[5] = b1.y; a[6] = b1.z; a[7] = b1.w; } \
                _Pragma("unroll") for (int jt = 0; jt < 5; ++jt) { \
                    const u32x4 xr = xr_[jt]; \
                    const float xv[8] = {bf_lo(xr.x), bf_hi(xr.x), bf_lo(xr.y), bf_hi(xr.y), bf_lo(xr.z), bf_hi(xr.z), bf_lo(xr.w), bf_hi(xr.w)}; \
                    const f32x4 w0 = *(const LAS f32x4*)(Lcw + jt * 512 + cl), w1 = *(const LAS f32x4*)(Lcw + jt * 512 + cl + 4); \
                    a[0] += xv[0] * w0.x; a[1] += xv[1] * w0.y; a[2] += xv[2] * w0.z; a[3] += xv[3] * w0.w; a[4] += xv[4] * w1.x; a[5] += xv[5] * w1.y; a[6] += xv[6] * w1.z; a[7] += xv[7] * w1.w; \
                    if (jt == 2) { _Pragma("unroll") for (int i = 0; i < 8; ++i) xm[i] = xv[i]; } } \
                float xc[8], q[8], k[8], v[8]; \
                _Pragma("unroll") for (int i = 0; i < 8; ++i) xc[i] = silu_f(a[i]); \
                _Pragma("unroll") for (int blk = 0; blk < 2; ++blk) { const int wo = ((cl >> 2) + blk) * 16; \
                    _Pragma("unroll") for (int o = 0; o < 4; ++o) { float sq = 0.f, sk = 0.f, sv = 0.f; \
                        _Pragma("unroll") for (int i = 0; i < 4; ++i) { sq += xc[4 * blk + i] * Lwq[wo + i * 4 + o]; sk += xc[4 * blk + i] * Lwk[wo + i * 4 + o]; sv += xm[4 * blk + i] * Lwv[wo + i * 4 + o]; } \
                        q[4 * blk + o] = sq; k[4 * blk + o] = sk; v[4 * blk + o] = sv; } } \
                u32x4 qw, kw, vw, cw; \
                qw.x = cvt_pk_bf16(q[0], q[1]); qw.y = cvt_pk_bf16(q[2], q[3]); qw.z = cvt_pk_bf16(q[4], q[5]); qw.w = cvt_pk_bf16(q[6], q[7]); \
                kw.x = cvt_pk_bf16(k[0], k[1]); kw.y = cvt_pk_bf16(k[2], k[3]); kw.z = cvt_pk_bf16(k[4], k[5]); kw.w = cvt_pk_bf16(k[6], k[7]); \
                vw.x = cvt_pk_bf16(v[0], v[1]); vw.y = cvt_pk_bf16(v[2], v[3]); vw.z = cvt_pk_bf16(v[4], v[5]); vw.w = cvt_pk_bf16(v[6], v[7]); \
                cw.x = cvt_pk_bf16(xc[0], xc[1]); cw.y = cvt_pk_bf16(xc[2], xc[3]); cw.z = cvt_pk_bf16(xc[4], xc[5]); cw.w = cvt_pk_bf16(xc[6], xc[7]); \
                const size_t o4 = (size_t)tok * 4096 + ch; \
                if (HOLD_) { hq = qw; hk = kw; hv = vw; hc = cw; }     \
                else { *(u32x4*)(Q + o4 - 32) = hq; *(u32x4*)(Q + o4) = qw; *(u32x4*)(Kb + o4 - 32) = hk; *(u32x4*)(Kb + o4) = kw; *(u32x4*)(V + o4 - 32) = hv; *(u32x4*)(V + o4) = vw; *(u32x4*)(XC + o4 - 32) = hc; *(u32x4*)(XC + o4) = cw; } \
                const bf16x8 qf = __builtin_bit_cast(bf16x8, qw), kf = __builtin_bit_cast(bf16x8, kw), vf = __builtin_bit_cast(bf16x8, vw); \
                _Pragma("unroll") for (int nt = 0; nt < 2; ++nt) { const LAS unsigned char* wp = Lwif + (nt * 16 + tk) * MLP_WROW + cl * 2; \
                    accp[nt] = __builtin_amdgcn_mfma_f32_16x16x32_bf16(qf, *(const LAS bf16x8*)(wp), accp[nt], 0, 0, 0); \
                    accp[nt] = __builtin_amdgcn_mfma_f32_16x16x32_bf16(kf, *(const LAS bf16x8*)(wp + 1024), accp[nt], 0, 0, 0); \
                    accp[nt] = __builtin_amdgcn_mfma_f32_16x16x32_bf16(vf, *(const LAS bf16x8*)(wp + 2048), accp[nt], 0, 0, 0); } } while (0)
            MLP_LOAD(xrA, 0);
#pragma unroll 1
            for (int step = 0; step < 16; step += 2) {
                MLP_LOAD(xrB, step + 1);
                MLP_COMPUTE(xrA, step, true);
                { const int sn = (step + 2 < 16) ? step + 2 : 15; MLP_LOAD(xrA, sn); }
                MLP_COMPUTE(xrB, step + 1, false);
            }
#undef MLP_LOAD
#undef MLP_COMPUTE
#pragma unroll
            for (int nt = 0; nt < 2; ++nt)
#pragma unroll
                for (int e = 0; e < 4; ++e) pre_part[((size_t)hd * 32 + nt * 16 + tk) * MTOK + tr * 256 + tt * 16 + 4 * g + e] = accp[nt][e];
        }
    }
}

constexpr int ML_QS0 = 0, ML_KS0 = 16384, ML_QS1 = 32768, ML_KS1 = 49152, ML_VS0 = 65536, ML_VS1 = 81920, ML_WV = 98304, ML_SS = 114688, ML_SM = 123904;
constexpr int ML_XS = ML_QS1, ML_XN = ML_QS1;
constexpr int GB_U = 0, GB_MR = 64, GB_W = 128, GB_INT = 192, GB_BND = 256, GB_SC = 320;
constexpr int SM_DIN0 = 768, SM_DIN1 = 832, SM_NV = 896, SM_NVP = 1408, SM_DNQP = 3456, SM_GS = 3968, SM_CMX = 4000, SM_MC = 4032, SM_END = 4096;
static_assert(ML_SM + SM_END * 4 <= LDS_BYTES - 16, "mLSTM LDS");
constexpr float KSCALE = 0.04419417382415922f;

DI s16x4 tr_read(LAS unsigned char* p) { return __builtin_amdgcn_ds_read_tr16_b64_v4i16((LAS s16x4*)p); }
DI int dimg(int row, int ch) { return 2048 * (row >> 3) + 512 * (ch >> 2) + 64 * (row & 7) + 16 * ((ch & 3) ^ ((row >> 2) & 3)); }
DI bf16x8 frag_tr(LAS unsigned char* img, int k0, int c0, int lane) {
    const int h = lane >> 5, blk = (lane >> 4) & 1, q = (lane & 15) >> 2, p = lane & 3;
    const int row = k0 + 8 * h + q, ch = (c0 >> 3) + 2 * blk + (p >> 1), sub = 8 * (p & 1);
    const s16x4 lo = tr_read(img + dimg(row, ch) + sub), hi = tr_read(img + dimg(row + 4, ch) + sub);
    return __builtin_shufflevector(lo, hi, 0, 1, 2, 3, 4, 5, 6, 7);
}
#define MFMA32(a, b, c) __builtin_amdgcn_mfma_f32_32x32x16_bf16((a), (b), (c), 0, 0, 0)
DI void tr_batch4(bf16x8 (&f)[4], unsigned alo, unsigned ahi) {
    s16x4 l0, l1, l2, l3, h0, h1, h2, h3;
    asm volatile("ds_read_b64_tr_b16 %0, %8\n\tds_read_b64_tr_b16 %4, %9\n\tds_read_b64_tr_b16 %1, %8 offset:4096\n\tds_read_b64_tr_b16 %5, %9 offset:4096\n\t"
                 "ds_read_b64_tr_b16 %2, %8 offset:8192\n\tds_read_b64_tr_b16 %6, %9 offset:8192\n\tds_read_b64_tr_b16 %3, %8 offset:12288\n\tds_read_b64_tr_b16 %7, %9 offset:12288\n\t"
                 "s_waitcnt lgkmcnt(0)"
                 : "=&v"(l0), "=&v"(l1), "=&v"(l2), "=&v"(l3), "=&v"(h0), "=&v"(h1), "=&v"(h2), "=&v"(h3) : "v"(alo), "v"(ahi) : "memory");
    f[0] = __builtin_shufflevector(l0, h0, 0, 1, 2, 3, 4, 5, 6, 7); f[1] = __builtin_shufflevector(l1, h1, 0, 1, 2, 3, 4, 5, 6, 7);
    f[2] = __builtin_shufflevector(l2, h2, 0, 1, 2, 3, 4, 5, 6, 7); f[3] = __builtin_shufflevector(l3, h3, 0, 1, 2, 3, 4, 5, 6, 7);
}

DI void tr_issue4(s16x4& l0, s16x4& l1, s16x4& l2, s16x4& l3, s16x4& h0, s16x4& h1, s16x4& h2, s16x4& h3, unsigned alo, unsigned ahi) {
    asm volatile("ds_read_b64_tr_b16 %0, %8\n\tds_read_b64_tr_b16 %4, %9\n\tds_read_b64_tr_b16 %1, %8 offset:4096\n\tds_read_b64_tr_b16 %5, %9 offset:4096\n\t"
                 "ds_read_b64_tr_b16 %2, %8 offset:8192\n\tds_read_b64_tr_b16 %6, %9 offset:8192\n\tds_read_b64_tr_b16 %3, %8 offset:12288\n\tds_read_b64_tr_b16 %7, %9 offset:12288"
                 : "=&v"(l0), "=&v"(l1), "=&v"(l2), "=&v"(l3), "=&v"(h0), "=&v"(h1), "=&v"(h2), "=&v"(h3) : "v"(alo), "v"(ahi) : "memory");
}
DI void tr_wait8(s16x4& l0, s16x4& l1, s16x4& l2, s16x4& l3, s16x4& h0, s16x4& h1, s16x4& h2, s16x4& h3) {
    asm volatile("s_waitcnt lgkmcnt(0)" : "+v"(l0), "+v"(l1), "+v"(l2), "+v"(l3), "+v"(h0), "+v"(h1), "+v"(h2), "+v"(h3) :: "memory");
}
#define TR_CAT(f, l, h) do { f[0] = __builtin_shufflevector(l##0, h##0, 0, 1, 2, 3, 4, 5, 6, 7); f[1] = __builtin_shufflevector(l##1, h##1, 0, 1, 2, 3, 4, 5, 6, 7); \
        f[2] = __builtin_shufflevector(l##2, h##2, 0, 1, 2, 3, 4, 5, 6, 7); f[3] = __builtin_shufflevector(l##3, h##3, 0, 1, 2, 3, 4, 5, 6, 7); } while (0)

template <int I>
DI void ml_step(LAS unsigned char* lds, u32x4 (&Cp)[8][2], f32x16 (&num)[2], f32x16& Sacc, float& dnq, int tid, int lane, int wave, int gb) {
    asm volatile("" : "+v"(lane)); asm volatile("" : "+v"(tid));
    constexpr int QS = (I & 1) ? ML_QS1 : ML_QS0, KS = (I & 1) ? ML_KS1 : ML_KS0;
    const int r = lane & 31, h = lane >> 5, vt = wave & 3, dpar = wave >> 2;
    LAS float* SM = (LAS float*)(lds + ML_SM);
#define ML_SEC1 { const int wS = wave & 3, st = wS >> 1, tt1 = wS & 1, kh = wave >> 2; \
      if (!(st == 1 && tt1 == 0)) { \
        _Pragma("unroll") for (int ks = 0; ks < 4; ++ks) { const int kk = 4 * kh + ks; \
            const bf16x8 a = *(const LAS bf16x8*)(lds + KS + dimg(32 * st + r, 2 * kk + h)); \
            const bf16x8 b = *(const LAS bf16x8*)(lds + QS + dimg(32 * tt1 + r, 2 * kk + h)); \
            Sacc = MFMA32(a, b, Sacc); } } }
#define ML_SEC4 { _Pragma("unroll") for (int jj = 0; jj < 2; ++jj) { const int dl = dpar + 2 * jj; \
        _Pragma("unroll") for (int s2 = 0; s2 < 2; ++s2) { const bf16x8 a = __builtin_bit_cast(bf16x8, Cp[2 * I + jj][s2]); \
            _Pragma("unroll") for (int tt = 0; tt < 2; ++tt) { LAS unsigned char* qb = lds + QS + 8 * h; \
                const s16x4 lo = *(const LAS s16x4*)(qb + dimg(32 * tt + r, 4 * dl + 2 * s2)), hi = *(const LAS s16x4*)(qb + dimg(32 * tt + r, 4 * dl + 2 * s2 + 1)); \
                num[tt] = MFMA32(a, __builtin_shufflevector(lo, hi, 0, 1, 2, 3, 4, 5, 6, 7), num[tt]); } } } }
#define ML_UPD(jj_) { _Pragma("unroll") for (int s2 = 0; s2 < 2; ++s2) { const u32x4 o = Cp[2 * I + (jj_)][s2]; u32x4 n; \
            n.x = cvt_pk_bf16(bf_lo(o.x) * decay + U[8 * s2 + 0], bf_hi(o.x) * decay + U[8 * s2 + 1]); n.y = cvt_pk_bf16(bf_lo(o.y) * decay + U[8 * s2 + 2], bf_hi(o.y) * decay + U[8 * s2 + 3]); \
            n.z = cvt_pk_bf16(bf_lo(o.z) * decay + U[8 * s2 + 4], bf_hi(o.z) * decay + U[8 * s2 + 5]); n.w = cvt_pk_bf16(bf_lo(o.w) * decay + U[8 * s2 + 6], bf_hi(o.w) * decay + U[8 * s2 + 7]); \
            asm volatile("" : "+v"(n)); Cp[2 * I + (jj_)][s2] = n; } }
#define ML_SEC5 { const float decay = SM[gb + GB_SC + 0]; \
      const int blk = (lane >> 4) & 1, q = (lane & 15) >> 2, p = lane & 3, sub = 8 * (p & 1), rlo = 8 * h + q; \
      const unsigned ldsu = (unsigned)(size_t)lds; const int chB = 4 * vt + 2 * blk + (p >> 1), chA0 = 4 * dpar + 2 * blk + (p >> 1), chA1 = chA0 + 8; \
      s16x4 bl0, bl1, bl2, bl3, bh0, bh1, bh2, bh3, al0, al1, al2, al3, ah0, ah1, ah2, ah3, cl0, cl1, cl2, cl3, ch0, ch1, ch2, ch3; \
      tr_issue4(bl0, bl1, bl2, bl3, bh0, bh1, bh2, bh3, ldsu + ML_WV + dimg(rlo, chB) + sub, ldsu + ML_WV + dimg(rlo + 4, chB) + sub); \
      tr_issue4(al0, al1, al2, al3, ah0, ah1, ah2, ah3, ldsu + KS + dimg(rlo, chA0) + sub, ldsu + KS + dimg(rlo + 4, chA0) + sub); \
      tr_wait8(al0, al1, al2, al3, ah0, ah1, ah2, ah3); tr_wait8(bl0, bl1, bl2, bl3, bh0, bh1, bh2, bh3); \
      tr_issue4(cl0, cl1, cl2, cl3, ch0, ch1, ch2, ch3, ldsu + KS + dimg(rlo, chA1) + sub, ldsu + KS + dimg(rlo + 4, chA1) + sub); \
      bf16x8 Bf[4], Af[4]; TR_CAT(Bf, bl, bh); TR_CAT(Af, al, ah); \
      f32x16 U; \
      _Pragma("unroll") for (int e = 0; e < 16; ++e) U[e] = 0.f; \
      _Pragma("unroll") for (int ks = 0; ks < 4; ++ks) U = MFMA32(Af[ks], Bf[ks], U); \
      ML_UPD(0) \
      tr_wait8(cl0, cl1, cl2, cl3, ch0, ch1, ch2, ch3); TR_CAT(Af, cl, ch); \
      _Pragma("unroll") for (int e = 0; e < 16; ++e) U[e] = 0.f; \
      _Pragma("unroll") for (int ks = 0; ks < 4; ++ks) U = MFMA32(Af[ks], Bf[ks], U); \
      ML_UPD(1) }
#define ML_SECV { { const int t = tid & 63, dg = tid >> 6; \
      const u32x4 q0 = *(const LAS u32x4*)(lds + QS + dimg(t, 2 * dg)), q1 = *(const LAS u32x4*)(lds + QS + dimg(t, 2 * dg + 1)); \
      const LAS f32x4* nv = (const LAS f32x4*)(SM + SM_NV + 128 * I + 16 * dg); \
      const f32x4 n0 = nv[0], n1 = nv[1], n2 = nv[2], n3 = nv[3]; \
      dnq += bf_lo(q0.x) * n0.x + bf_hi(q0.x) * n0.y + bf_lo(q0.y) * n0.z + bf_hi(q0.y) * n0.w + bf_lo(q0.z) * n1.x + bf_hi(q0.z) * n1.y + bf_lo(q0.w) * n1.z + bf_hi(q0.w) * n1.w \
           + bf_lo(q1.x) * n2.x + bf_hi(q1.x) * n2.y + bf_lo(q1.y) * n2.z + bf_hi(q1.y) * n2.w + bf_lo(q1.z) * n3.x + bf_hi(q1.z) * n3.y + bf_lo(q1.w) * n3.z + bf_hi(q1.w) * n3.w; } \
    { const int dp = tid & 63, sg = tid >> 6; float a0 = 0.f, a1 = 0.f; \
      const f32x4 wA = *(const LAS f32x4*)(SM + gb + GB_W + 8 * sg), wB = *(const LAS f32x4*)(SM + gb + GB_W + 8 * sg + 4); const float ww[8] = {wA.x, wA.y, wA.z, wA.w, wB.x, wB.y, wB.z, wB.w}; \
      _Pragma("unroll") for (int s = 0; s < 8; ++s) { const unsigned kk2 = *(const LAS unsigned*)(lds + KS + dimg(8 * sg + s, dp >> 2) + 4 * (dp & 3)); a0 += ww[s] * bf_lo(kk2); a1 += ww[s] * bf_hi(kk2); } \
      ((LAS unsigned*)(SM + SM_NVP))[sg * 256 + 64 * I + dp] = cvt_pk_bf16(a0, a1); } }
    ML_SEC1 ML_SEC4 ML_SEC5 ML_SECV
#undef ML_SEC1
#undef ML_SEC4
#undef ML_UPD
#undef ML_SEC5
#undef ML_SECV
}

DI float lane_read(float v, int src_lane) { return __builtin_bit_cast(float, __builtin_amdgcn_ds_bpermute(src_lane << 2, __builtin_bit_cast(int, v))); }
DI void ml_scan(float li_, float lf_, float& u_, float& cm_, float& bs_, int lane) {
    bs_ = lf_;
#pragma unroll
    for (int o_ = 1; o_ < 64; o_ <<= 1) { const float t_ = lane_read(bs_, (lane - o_) & 63); if (lane >= o_) bs_ += t_; }
    u_ = li_ - bs_; cm_ = u_;
#pragma unroll
    for (int o_ = 1; o_ < 64; o_ <<= 1) { const float t_ = lane_read(cm_, (lane - o_) & 63); if (lane >= o_) cm_ = fmaxf(cm_, t_); }
}
DI void ml_gates(LAS float* SM, float u_, float cm_, float bs_, int gbn, float m_, float cmx_, int lane) {
    const float M_ = fmaxf(m_, cm_), Ml_ = fmaxf(m_, cmx_);
    SM[gbn + GB_U + lane] = u_; SM[gbn + GB_MR + lane] = M_; SM[gbn + GB_W + lane] = __expf(u_ - Ml_) * KSCALE; SM[gbn + GB_INT + lane] = __expf(m_ - M_); SM[gbn + GB_BND + lane] = __expf(-(bs_ + M_));
    if (lane == 0) SM[gbn + GB_SC + 0] = __expf(m_ - Ml_);
}

DI void ml_dma_piece(const bf16_t* colbase, int b, int dir, int tau0, LAS unsigned char* tile, int j, int lane) {
    const int pos = lane & 31, rin = pos >> 2, row = 8 * (j >> 1) + rin, ch = 4 * (2 * (j & 1) + (lane >> 5)) + ((pos & 3) ^ ((row >> 2) & 3));
    const int tau = tau0 + row; const size_t tok = (size_t)(b * SEQ + (dir ? SEQ - 1 - tau : tau));
    __builtin_amdgcn_global_load_lds((const unsigned*)(colbase + tok * 4096 + ch * 8), (LAS unsigned*)(tile + 1024 * j), 16, 0, 0);
}

DI void mlstm_phase(const bf16_t* Q, const bf16_t* Kb, const bf16_t* V, const float* pre_part, const float* b_if, float* GLF, bf16_t* HF, bf16_t* HB,
                    LAS unsigned char* lds, int G, int vcu0, int tid0, int lane0, int wave) {
    LAS float* SM = (LAS float*)(lds + ML_SM);
    const int vt = wave & 3, dpar = wave >> 2;
    for (int item = vcu0; item < 256; item += G) {
        const int vs = item & 3, stream = item >> 2, dir = stream & 1, hd = (stream >> 1) & 7, b = stream >> 4;
        bf16_t* H = dir ? HB : HF;
        float* glf = GLF + (size_t)item * 10240;
        const bf16_t* qcol = Q + hd * 512; const bf16_t* kcol = Kb + hd * 512; const bf16_t* vcol = V + hd * 512 + vs * 128;
        __syncthreads();
        int tidp = tid0, lanep = lane0; asm volatile("" : "+v"(tidp)); asm volatile("" : "+v"(lanep));
        for (int tau = tidp; tau < SEQ; tau += NTHREADS) {
            const int tok = b * SEQ + (dir ? SEQ - 1 - tau : tau);
            float li = b_if[dir * 16 + hd], lfr = b_if[dir * 16 + 8 + hd];
#pragma unroll
            for (int h8 = 0; h8 < 8; ++h8) { const float* pp = pre_part + ((size_t)h8 * 32 + dir * 16 + hd) * MTOK + tok; li += pp[0]; lfr += pp[(size_t)8 * MTOK]; }
            glf[tau] = li; glf[2048 + tau] = fminf(lfr, 0.f) - log1pf(__expf(-fabsf(lfr)));
        }
        SM[SM_NV + tidp] = 0.f;
        ml_dma_piece(qcol, b, dir, 0, lds + ML_QS0, 2 * wave, lanep); ml_dma_piece(qcol, b, dir, 0, lds + ML_QS0, 2 * wave + 1, lanep);
        ml_dma_piece(kcol, b, dir, 0, lds + ML_KS0, 2 * wave, lanep); ml_dma_piece(kcol, b, dir, 0, lds + ML_KS0, 2 * wave + 1, lanep);
        ml_dma_piece(vcol, b, dir, 0, lds + ML_VS0, 2 * wave, lanep); ml_dma_piece(vcol, b, dir, 0, lds + ML_VS0, 2 * wave + 1, lanep);
        asm volatile("s_waitcnt vmcnt(0)" ::: "memory");
        __syncthreads();
        float u0 = 0.f, cm0 = 0.f, bs0 = 0.f;
#pragma unroll 1
        for (int cc = wave; cc < 32; cc += 8) {
            const float lic = __hip_atomic_load(glf + 64 * cc + lanep, __ATOMIC_RELAXED, __HIP_MEMORY_SCOPE_AGENT), lfc = __hip_atomic_load(glf + 2048 + 64 * cc + lanep, __ATOMIC_RELAXED, __HIP_MEMORY_SCOPE_AGENT);
            float uu, cmm, bss; ml_scan(lic, lfc, uu, cmm, bss, lanep);
            glf[4096 + 64 * cc + lanep] = uu; glf[6144 + 64 * cc + lanep] = cmm; glf[8192 + 64 * cc + lanep] = bss;
            if (lanep == 63) { SM[SM_GS + cc] = bss; SM[SM_CMX + cc] = cmm; }
            if (cc == 0) { u0 = uu; cm0 = cmm; bs0 = bss; }
        }
        asm volatile("s_waitcnt vmcnt(0)" ::: "memory");
        __syncthreads();
        if (tidp == 0) { float m = 0.f;
#pragma unroll 1
            for (int cc = 0; cc < 32; ++cc) { SM[SM_MC + cc] = m; m = SM[SM_GS + cc] + fmaxf(m, SM[SM_CMX + cc]); } }
        __syncthreads();
        if (wave == 0) ml_gates(SM, u0, cm0, bs0, 0, 0.f, SM[SM_CMX + 0], lanep);
        __syncthreads();
#define ML_WRITE_WV(VS_, gbx_) do { const float w_ = SM[(gbx_) + GB_W + lrow]; \
        _Pragma("unroll") for (int hh_ = 0; hh_ < 2; ++hh_) { const int o_ = dimg(lrow, lcc + 8 * hh_); const u32x4 x_ = *(const LAS u32x4*)(lds + (VS_) + o_); u32x4 y_; \
            y_.x = cvt_pk_bf16(bf_lo(x_.x) * w_, bf_hi(x_.x) * w_); y_.y = cvt_pk_bf16(bf_lo(x_.y) * w_, bf_hi(x_.y) * w_); y_.z = cvt_pk_bf16(bf_lo(x_.z) * w_, bf_hi(x_.z) * w_); y_.w = cvt_pk_bf16(bf_lo(x_.w) * w_, bf_hi(x_.w) * w_); \
            *(LAS u32x4*)(lds + ML_WV + o_) = y_; } } while (0)
        { const int lrow = tidp >> 3, lcc = tidp & 7; ML_WRITE_WV(ML_VS0, 0); }
        u32x4 Cp[8][2];
#pragma unroll
        for (int j = 0; j < 8; ++j) { Cp[j][0] = (u32x4){0u, 0u, 0u, 0u}; Cp[j][1] = (u32x4){0u, 0u, 0u, 0u}; }
#pragma unroll 1
        for (int c = 0; c < 32; ++c) {
            int lane = lane0, tid = tid0; asm volatile("" : "+v"(lane)); asm volatile("" : "+v"(tid));
            const int r = lane & 31, h = lane >> 5, lrow = tid >> 3, lcc = tid & 7;
            const int gb = (c & 1) * 384, gbn = 384 - gb, cn = (c + 1 < 32) ? c + 1 : 31;
            const int VSc = (c & 1) ? ML_VS1 : ML_VS0, VSn = (c & 1) ? ML_VS0 : ML_VS1;
            f32x16 num[2], Sacc; float dnq = 0.f;
#pragma unroll
            for (int e = 0; e < 16; ++e) { num[0][e] = 0.f; num[1][e] = 0.f; Sacc[e] = 0.f; }
#define ML_DMA_QK(QS_, KS_, c_, i_) do { ml_dma_piece(qcol + 128 * (i_), b, dir, 64 * (c_), lds + (QS_), 2 * wave, lane); ml_dma_piece(qcol + 128 * (i_), b, dir, 64 * (c_), lds + (QS_), 2 * wave + 1, lane); \
                ml_dma_piece(kcol + 128 * (i_), b, dir, 64 * (c_), lds + (KS_), 2 * wave, lane); ml_dma_piece(kcol + 128 * (i_), b, dir, 64 * (c_), lds + (KS_), 2 * wave + 1, lane); } while (0)
            asm volatile("s_waitcnt vmcnt(0)" ::: "memory"); __syncthreads(); ML_DMA_QK(ML_QS1, ML_KS1, c, 1);  ml_step<0>(lds, Cp, num, Sacc, dnq, tid, lane, wave, gb);
            asm volatile("s_waitcnt vmcnt(0)" ::: "memory"); __syncthreads(); ML_DMA_QK(ML_QS0, ML_KS0, c, 2);  ml_step<1>(lds, Cp, num, Sacc, dnq, tid, lane, wave, gb);
            asm volatile("s_waitcnt vmcnt(0)" ::: "memory"); __syncthreads(); ML_DMA_QK(ML_QS1, ML_KS1, c, 3);  ml_step<2>(lds, Cp, num, Sacc, dnq, tid, lane, wave, gb);
            asm volatile("s_waitcnt vmcnt(0)" ::: "memory"); __syncthreads(); ML_DMA_QK(ML_QS0, ML_KS0, cn, 0);
            ml_dma_piece(vcol, b, dir, 64 * cn, lds + VSn, 2 * wave, lane); ml_dma_piece(vcol, b, dir, 64 * cn, lds + VSn, 2 * wave + 1, lane);
            ml_step<3>(lds, Cp, num, Sacc, dnq, tid, lane, wave, gb);
            asm volatile("s_waitcnt vmcnt(0)" ::: "memory");
            __syncthreads();
            float un = 0.f, cmn = 0.f, bsn = 0.f;
            if (wave == 0) { un = __hip_atomic_load(glf + 4096 + 64 * cn + lane, __ATOMIC_RELAXED, __HIP_MEMORY_SCOPE_AGENT); cmn = __hip_atomic_load(glf + 6144 + 64 * cn + lane, __ATOMIC_RELAXED, __HIP_MEMORY_SCOPE_AGENT);
                             bsn = __hip_atomic_load(glf + 8192 + 64 * cn + lane, __ATOMIC_RELAXED, __HIP_MEMORY_SCOPE_AGENT); }
            { LAS f32x4* xs = (LAS f32x4*)(lds + ML_XS) + (size_t)((wave & 3) * 4) * 64 + lane;
              if (wave >= 4) {
#pragma unroll
                for (int gq = 0; gq < 4; ++gq) xs[gq * 64] = (f32x4){Sacc[4 * gq], Sacc[4 * gq + 1], Sacc[4 * gq + 2], Sacc[4 * gq + 3]}; } }
            SM[SM_DNQP + (tid >> 6) * 64 + (tid & 63)] = dnq;
            __syncthreads();
            if (wave < 4) {
                const int st = wave >> 1, tt1 = wave & 1, t = 32 * tt1 + r;
                const LAS f32x4* xs = (const LAS f32x4*)(lds + ML_XS) + (size_t)(wave * 4) * 64 + lane;
                const float Mt = SM[gb + GB_MR + t]; float dsum = 0.f;
#pragma unroll
                for (int gq = 0; gq < 4; ++gq) {
                    const f32x4 px = xs[gq * 64]; const int s0 = 32 * st + 8 * gq + 4 * h; const f32x4 us = *(const LAS f32x4*)(SM + gb + GB_U + s0);
                    float vv[4];
#pragma unroll
                    for (int e = 0; e < 4; ++e) { const float raw = (Sacc[4 * gq + e] + px[e]) * KSCALE; vv[e] = (s0 + e <= t) ? raw * __expf(us[e] - Mt) : 0.f; dsum += vv[e]; }
                    u32x2 w; w.x = cvt_pk_bf16(vv[0], vv[1]); w.y = cvt_pk_bf16(vv[2], vv[3]);
                    *(LAS u32x2*)(lds + ML_SS + t * 144 + s0 * 2) = w;
                }
                dsum += __shfl_xor(dsum, 32);
                if (h == 0) SM[(st ? SM_DIN1 : SM_DIN0) + t] = dsum;
            }
#pragma unroll
            for (int tt = 0; tt < 2; ++tt) { const float it = SM[gb + GB_INT + 32 * tt + r]; num[tt] = num[tt] * it; }
            __syncthreads();
#pragma unroll
            for (int k2 = 0; k2 < 2; ++k2) { const int ks = 2 * dpar + k2;
                const bf16x8 a = frag_tr(lds + VSc, 16 * ks, 32 * vt, lane);
#pragma unroll
                for (int tt = 0; tt < 2; ++tt) { const bf16x8 bb = *(const LAS bf16x8*)(lds + ML_SS + (32 * tt + r) * 144 + (16 * ks + 8 * h) * 2); num[tt] = MFMA32(a, bb, num[tt]); } }
            __syncthreads();
            { LAS f32x4* xn = (LAS f32x4*)(lds + ML_XN) + (size_t)(vt * 8) * 64 + lane;
              if (dpar == 1) {
#pragma unroll
                for (int tt = 0; tt < 2; ++tt)
#pragma unroll
                    for (int gq = 0; gq < 4; ++gq) xn[(tt * 4 + gq) * 64] = (f32x4){num[tt][4 * gq], num[tt][4 * gq + 1], num[tt][4 * gq + 2], num[tt][4 * gq + 3]}; } }
            if (wave == 0) ml_gates(SM, un, cmn, bsn, gbn, SM[SM_MC + cn], SM[SM_CMX + cn], lane);
            __syncthreads();
            if (dpar == 0) {
                const LAS f32x4* xn = (const LAS f32x4*)(lds + ML_XN) + (size_t)(vt * 8) * 64 + lane;
#pragma unroll
                for (int tt = 0; tt < 2; ++tt) { const int t = 32 * tt + r; float nq = 0.f;
#pragma unroll
                    for (int gI = 0; gI < 8; ++gI) nq += SM[SM_DNQP + gI * 64 + t];
                    const float den = SM[SM_DIN0 + t] + SM[SM_DIN1 + t] + SM[gb + GB_INT + t] * nq;
                    const float inv = 1.0f / fmaxf(fabsf(den), SM[gb + GB_BND + t]);
                    const int tau = 64 * c + t; const size_t ob = (size_t)(b * SEQ + (dir ? SEQ - 1 - tau : tau)) * 4096 + hd * 512 + vs * 128 + 32 * vt + 4 * h;
#pragma unroll
                    for (int gq = 0; gq < 4; ++gq) { const f32x4 px = xn[(tt * 4 + gq) * 64];
                        u32x2 w; w.x = cvt_pk_bf16((num[tt][4 * gq] + px.x) * inv, (num[tt][4 * gq + 1] + px.y) * inv); w.y = cvt_pk_bf16((num[tt][4 * gq + 2] + px.z) * inv, (num[tt][4 * gq + 3] + px.w) * inv);
                        *(u32x2*)(H + ob + 8 * gq) = w; } }
            }
            ML_WRITE_WV(VSn, gbn);
            { const float decay = SM[gb + GB_SC + 0];
              float acc_ = 0.f; const LAS unsigned* np_ = (const LAS unsigned*)(SM + SM_NVP) + (tid >> 1);
#pragma unroll
              for (int sgx = 0; sgx < 8; ++sgx) { const unsigned pr_ = np_[sgx * 256]; acc_ += (tid & 1) ? bf_hi(pr_) : bf_lo(pr_); }
              SM[SM_NV + tid] = decay * SM[SM_NV + tid] + acc_; }
        }
#undef ML_DMA_QK
#undef ML_WRITE_WV
    }
}

DI void ml_combine_phase(const bf16_t* HF, const bf16_t* HB, const bf16_t* XC, const bf16_t* XZ, const float* norm_g, const float* skip, bf16_t* MO, int gw, int NGW, int lane) {
    for (int idx = gw; idx < MTOK * ML_HEADS; idx += NGW) {
        const int tok = idx >> 3, hd = idx & 7; const int ch = hd * 512 + 8 * lane; const size_t o4 = (size_t)tok * 4096 + ch;
        const u32x4 a = *(const u32x4*)(HF + o4), bq = *(const u32x4*)(HB + o4), xcv = *(const u32x4*)(XC + o4), zv = *(const u32x4*)(XZ + (size_t)tok * 8192 + 4096 + ch);
        float ht[8] = {bf_lo(a.x) + bf_lo(bq.x), bf_hi(a.x) + bf_hi(bq.x), bf_lo(a.y) + bf_lo(bq.y), bf_hi(a.y) + bf_hi(bq.y), bf_lo(a.z) + bf_lo(bq.z), bf_hi(a.z) + bf_hi(bq.z), bf_lo(a.w) + bf_lo(bq.w), bf_hi(a.w) + bf_hi(bq.w)};
        const float xc[8] = {bf_lo(xcv.x), bf_hi(xcv.x), bf_lo(xcv.y), bf_hi(xcv.y), bf_lo(xcv.z), bf_hi(xcv.z), bf_lo(xcv.w), bf_hi(xcv.w)};
        const float z[8] = {bf_lo(zv.x), bf_hi(zv.x), bf_lo(zv.y), bf_hi(zv.y), bf_lo(zv.z), bf_hi(zv.z), bf_lo(zv.w), bf_hi(zv.w)};
        float s = 0.f;
#pragma unroll
        for (int i = 0; i < 8; ++i) s += ht[i];
        const float mu = wave_sum(s) * (1.f / 512.f); float q = 0.f;
#pragma unroll
        for (int i = 0; i < 8; ++i) { ht[i] -= mu; q += ht[i] * ht[i]; }
        const float rstd = 1.0f / sqrtf(wave_sum(q) * (1.f / 512.f) + 1e-5f);
        const f32x4 g0 = *(const f32x4*)(norm_g + ch), g1 = *(const f32x4*)(norm_g + ch + 4), k0 = *(const f32x4*)(skip + ch), k1 = *(const f32x4*)(skip + ch + 4);
        const float gg[8] = {g0.x, g0.y, g0.z, g0.w, g1.x, g1.y, g1.z, g1.w}, sk[8] = {k0.x, k0.y, k0.z, k0.w, k1.x, k1.y, k1.z, k1.w};
        float o[8];
#pragma unroll
        for (int i = 0; i < 8; ++i) o[i] = (ht[i] * rstd * gg[i] + sk[i] * xc[i]) * sigmoid_f(z[i]);
        u32x4 w; w.x = cvt_pk_bf16(o[0], o[1]); w.y = cvt_pk_bf16(o[2], o[3]); w.z = cvt_pk_bf16(o[4], o[5]); w.w = cvt_pk_bf16(o[6], o[7]);
        *(u32x4*)(MO + o4) = w;
    }
}

DI void moe_offsets(const unsigned* ecnt, int (&cnt)[8], int (&off)[8], int& ntiles) {
    int acc = 0;
#pragma unroll
    for (int e = 0; e < 8; ++e) { cnt[e] = (int)ecnt[64 * e]; off[e] = acc * 256; acc += (cnt[e] + 255) >> 8; }
    ntiles = acc;
}
DI void moe_split_plan(int ntiles, int& nMf, int& nT, int& S) {
    nMf = (ntiles >> 5) << 5; nT = ntiles - nMf; S = 1;
    if (nT > 0) { S = (nT <= 4) ? 7 : (nT <= 8) ? 4 : (nT <= 16) ? 2 : 1; }
    if (S == 1) { nMf = ntiles; nT = 0; }
}
DI pg8::TileMap moe_tilemap(const int (&cnt)[8]) { pg8::TileMap tm; int acc = 0; tm.toff[0] = 0;
#pragma unroll
    for (int e = 0; e < 8; ++e) { acc += (cnt[e] + 255) >> 8; tm.toff[e + 1] = acc; }
    return tm; }
DI void moe_scatter_phase(const unsigned char* HA, unsigned char* HS, const int* tok_e, const int* tok_pos, int* slot_row, const unsigned* ecnt, int* tile_e, int gw, int NGW, int lane) {
    int cnt[8], off[8], ntiles; moe_offsets(ecnt, cnt, off, ntiles);
    if (gw == 0 && lane < 8) { const int e = lane; const int t0 = off[e] >> 8, nt = (cnt[e] + 255) >> 8; for (int t = 0; t < nt; ++t) tile_e[t0 + t] = e; }
    for (int id = gw; id < 2 * MTOK; id += NGW) {
        const int e = tok_e[id], pos = tok_pos[id]; int o = 0;
#pragma unroll
        for (int q = 0; q < 8; ++q) o = (e == q) ? off[q] : o;
        const int row = o + pos;
        if (lane == 0) slot_row[id] = row;
        const u32x4* src = (const u32x4*)(HA + (size_t)(id >> 1) * DM) + lane; u32x4* dst = (u32x4*)(HS + (size_t)row * DM) + lane;
#pragma unroll
        for (int j = 0; j < 2; ++j) dst[64 * j] = src[64 * j];
    }
#pragma unroll 1
    for (int e = 0; e < 8; ++e) { int c = 0, o = 0;
#pragma unroll
        for (int q = 0; q < 8; ++q) { c = (e == q) ? cnt[q] : c; o = (e == q) ? off[q] : o; }
        const int pend = ((c + 255) >> 8) << 8;
        for (int p = c + gw; p < pend; p += NGW) { u32x4* dst = (u32x4*)(HS + (size_t)(o + p) * DM) + lane;
#pragma unroll
            for (int j = 0; j < 2; ++j) dst[64 * j] = (u32x4){0u, 0u, 0u, 0u}; } }
}

DI f32x4 moe_yrow(const bf16_t* YS, const bf16_t* YSP, int r, int rsplit, int S, int nrs, int lane, int j) {
    if (r < rsplit) { const u32x2 a = ((const u32x2*)(YS + (size_t)r * DM) + lane)[64 * j]; return (f32x4){bf_lo(a.x), bf_hi(a.x), bf_lo(a.y), bf_hi(a.y)}; }
    f32x4 acc = (f32x4){0.f, 0.f, 0.f, 0.f};
    for (int s2 = 0; s2 < S; ++s2) { const u32x2 a = ((const u32x2*)(YSP + ((size_t)s2 * nrs + (r - rsplit)) * DM) + lane)[64 * j]; acc += (f32x4){bf_lo(a.x), bf_hi(a.x), bf_lo(a.y), bf_hi(a.y)}; }
    return acc;
}
DI void moe_combine_phase(const bf16_t* X3, const bf16_t* YS, const int* tok_e, const int* tok_pos, const float* tok_w, const float* gate, float* out, const unsigned* ecnt, int gw, int NGW, int lane) {
    int cnt[8], off[8], ntiles; moe_offsets(ecnt, cnt, off, ntiles);
    int nMf, nT, S; moe_split_plan(ntiles, nMf, nT, S); const int rsplit = nMf * 256; const bf16_t* YSP = YS + (size_t)MPAD * DM;
    for (int tok = gw; tok < MTOK; tok += NGW) {
        const int e0 = tok_e[2 * tok], e1 = tok_e[2 * tok + 1]; int o0 = 0, o1 = 0;
#pragma unroll
        for (int q = 0; q < 8; ++q) { o0 = (e0 == q) ? off[q] : o0; o1 = (e1 == q) ? off[q] : o1; }
        const int r0 = o0 + tok_pos[2 * tok], r1 = o1 + tok_pos[2 * tok + 1]; const float w0 = tok_w[2 * tok], w1 = tok_w[2 * tok + 1];
        const u32x2* x = (const u32x2*)(X3 + (size_t)tok * DM) + lane;
        const f32x4* gp = (const f32x4*)(gate + (size_t)(tok >> 11) * 12288) + lane; f32x4* o = (f32x4*)(out + (size_t)tok * DM) + lane;
#pragma unroll
        for (int j = 0; j < 8; ++j) { const f32x4 ya = moe_yrow(YS, YSP, r0, rsplit, S, nT * 256, lane, j), yb = moe_yrow(YS, YSP, r1, rsplit, S, nT * 256, lane, j);
            const u32x2 xr = x[64 * j]; o[64 * j] = (f32x4){bf_lo(xr.x), bf_hi(xr.x), bf_lo(xr.y), bf_hi(xr.y)} + gp[64 * j] * (ya * w0 + yb * w1); }
    }
}

struct Params { const float* in[29]; float* out; unsigned char* ws; int ph_lo, ph_hi; };
static_assert(sizeof(Params) == 31 * 8 + 8, "Params has padding");
constexpr int NPHASE = 20;

#if DBG
#include "dbg_checks.inc"
#endif

__global__ void __launch_bounds__(NTHREADS, 2) mega_fwd(Params p) {
    extern __shared__ __attribute__((aligned(16))) unsigned char lds_raw[];
    LAS unsigned char* lds = (LAS unsigned char*)lds_raw;
    const int tid = threadIdx.x, lane = tid & 63, wave = __builtin_amdgcn_readfirstlane(tid >> 6);
    const int G = gridDim.x, gw = blockIdx.x * NWAVES + wave, NGW = G * NWAVES;
    const int vcu = (G % 8 == 0) ? (int)(blockIdx.x % 8) * (G / 8) + (int)(blockIdx.x / 8) : (int)blockIdx.x;
    const int gwx = vcu * NWAVES + wave;
    unsigned char* ws = p.ws;
    unsigned* ctl = (unsigned*)(ws + WS_CTL);
    volatile LAS unsigned* xbw = (volatile LAS unsigned*)(lds + LDS_BYTES - 16);
    if (tid == 0) { xbw[0] = 0u; xbw[1] = 0u; xbw[2] = 0u; xbw[3] = 0u; }
    __syncthreads();
    XcdBarrier bar = xcd_barrier_post(ctl + CW_BAR, xbw);
    const int lo = p.ph_lo, hi = p.ph_hi;
#ifndef PH_MASK
#define PH_MASK 0xFFFFFFu
#endif
#define IN(k) (((PH_MASK >> (k)) & 1u) && lo <= (k) && (k) < hi)
#define SEAM(k) do { if (IN((k) + 1)) xcd_barrier(bar); } while (0)
#ifndef REP_MASK
#define REP_MASK 0u
#endif
#define PHASE(k, ...) if (IN(k)) { { __VA_ARGS__ } if ((REP_MASK >> (k)) & 1u) { __syncthreads(); { __VA_ARGS__ } } SEAM(k); }

    float* mod = (float*)(ws + WS_MOD);
    float* pre_part = (float*)(ws + WS_PRE);
    int* tok_e = (int*)(ws + WS_ROUTE); int* tok_pos = tok_e + 2 * MTOK; float* tok_w = (float*)(tok_pos + 2 * MTOK); int* slot_row = (int*)(tok_w + 2 * MTOK);
    unsigned* ecnt = ctl + CW_ECNT; int* tile_e = (int*)(ctl + 12288);
    bf16_t* HA = (bf16_t*)(ws + WS_HA); bf16_t* X1 = (bf16_t*)(ws + WS_X1); bf16_t* X2 = (bf16_t*)(ws + WS_X2);
    bf16_t* WT_IN = (bf16_t*)(ws + WS_WT_IN); bf16_t* WT_OUT = (bf16_t*)(ws + WS_WT_OUT); bf16_t* WT_GU = (bf16_t*)(ws + WS_WT_GU); bf16_t* WT_DN = (bf16_t*)(ws + WS_WT_DN);
    bf16_t* WT_MLIN = (bf16_t*)(ws + WS_WT_MLIN); bf16_t* WT_MLOUT = (bf16_t*)(ws + WS_WT_MLOUT); bf16_t* WT_IF = (bf16_t*)(ws + WS_WT_IF);
    unsigned char* WT_MGU = ws + WS_WT_MGU; unsigned char* WT_MD = ws + WS_WT_MD;
    bf16_t* QK = (bf16_t*)(ws + A_QK); bf16_t* QKN = (bf16_t*)(ws + A_QKN); bf16_t* VT = (bf16_t*)(ws + A_VT); bf16_t* ATT = (bf16_t*)(ws + A_ATT); bf16_t* ACT = (bf16_t*)(ws + A_ACT);
    bf16_t* XZ = (bf16_t*)(ws + A_XZ); bf16_t* XC = (bf16_t*)(ws + A_XC); bf16_t* Qm = (bf16_t*)(ws + A_Q); bf16_t* Km = (bf16_t*)(ws + A_K); bf16_t* Vm = (bf16_t*)(ws + A_V);
    bf16_t* HF = (bf16_t*)(ws + A_HF); bf16_t* HB = (bf16_t*)(ws + A_HB); bf16_t* MO = (bf16_t*)(ws + A_MO);
    unsigned char* HS = ws + A_HS; unsigned char* ACTM = ws + A_ACTM; float* YS = (float*)(ws + A_YS);
    const float* x_in = p.in[0];

    PHASE(0,
        mod_phase(p.in[1], p.in[2], p.in[3], mod, lds, G, tid, lane, wave);
        LAS float* scrw = (LAS float*)lds + wave * (64 * 65);
        cvtw_job<0, false>(p.in[6] + 4096, 2048, 2048, 1, WT_IN + (size_t)4096 * 2048, 0, scrw, gw, NGW, lane, 1.f, 6144);
        cvtw_job<0, true>(p.in[6], 2048, 4096, 1, (unsigned char*)ACT + (size_t)32 * 1024 * 1024, 0, scrw, gw, NGW, lane, WSCALE, 6144);
        cvtw_job<0, false>(p.in[10], 2048, 2048, 1, WT_OUT, 0, scrw, gw, NGW, lane, 1.f);
        cvtw_job<1, false>(p.in[11], 2048, FFN, 1, WT_GU, 0, scrw, gw, NGW, lane, 1.f);
        cvtw_job<2, false>(p.in[12], 2048, FFN, 1, WT_GU, 0, scrw, gw, NGW, lane, 1.f);
        cvtw_job<0, false>(p.in[13], FFN, 2048, 1, WT_DN, 0, scrw, gw, NGW, lane, 1.f);
        cvtw_job<0, false>(p.in[14], 2048, 8192, 1, WT_MLIN, 0, scrw, gw, NGW, lane, 1.f);
        cvtw_job<0, false>(p.in[24], 4096, 2048, 1, WT_MLOUT, 0, scrw, gw, NGW, lane, 1.f);
        cvt_job<0>(p.in[20], 12288, 32, 1, WT_IF, 0, scrw, gw, NGW, lane);
        cvtw_job<1, true>(p.in[26], 2048, EDIM, 8, WT_MGU, (size_t)14336 * 2048, scrw, gw, NGW, lane, WSCALE);
        cvtw_job<2, true>(p.in[27], 2048, EDIM, 8, WT_MGU, (size_t)14336 * 2048, scrw, gw, NGW, lane, WSCALE);
        cvtw_job<0, true>(p.in[28], EDIM, 2048, 8, WT_MD, (size_t)2048 * EDIM, scrw, gw, NGW, lane, WSCALE); )
    PHASE(1,  rms_mod_phase<false, true>(x_in, p.in[4], mod + 1 * 2048, mod + 0 * 2048, HA, nullptr, nullptr, nullptr, nullptr, nullptr, (unsigned char*)ACT, gw, NGW, lane); )
    PHASE(2,
        { pg8::Gemm g{(const unsigned char*)ACT, (const unsigned char*)ACT + (size_t)32 * 1024 * 1024, MTOK, 4096, 2048, 0}; pg8::StaticOrder S; S.init(MTOK, 4096, G, (int)blockIdx.x); pg8::EpiQKNorm E{QKN, 4096, p.in[7], p.in[8], 1.0f / (HSCALE * WSCALE)}; pg8::gemm_phase<pg8::EpiQKNorm, pg8::StaticOrder, true>(lds, g, S, E); }
        { pg8::Gemm g{WT_IN + (size_t)4096 * 2048, HA, 2048, MTOK, 2048, 0}; pg8::StaticOrder S; S.init(2048, MTOK, G, (int)blockIdx.x); pg8::EpiBf16 E{VT, MTOK}; pg8::gemm_phase(lds, g, S, E); } )
    PHASE(4,  na_phase(QKN, VT, ATT, p.in[9], lds, G, vcu, tid, lane, wave); )
    PHASE(5,  pg8::Gemm g{ATT, WT_OUT, MTOK, 2048, 2048, 0}; pg8::StaticOrder S; S.init(MTOK, 2048, G, (int)blockIdx.x); pg8::EpiResGate16<false> E{x_in, X1, DM, mod + 2 * 2048, 12288}; pg8::gemm_phase(lds, g, S, E); )
    PHASE(6,  rms_mod_phase<false, false, true>(X1, p.in[5], mod + 4 * 2048, mod + 3 * 2048, HA, nullptr, nullptr, nullptr, nullptr, nullptr, nullptr, gw, NGW, lane); )
    PHASE(7,  pg8::Gemm g{HA, WT_GU, MTOK, 2 * FFN, 2048, 0}; pg8::StaticOrder S; S.init(MTOK, 2 * FFN, G, (int)blockIdx.x); pg8::EpiSwiGLU E{ACT, FFN}; pg8::gemm_phase(lds, g, S, E); )
    PHASE(8,  pg8::Gemm g{ACT, WT_DN, MTOK, 2048, FFN, 0}; pg8::StaticOrder S; S.init(MTOK, 2048, G, (int)blockIdx.x); pg8::EpiResGate16<true> E{X1, X2, DM, mod + 5 * 2048, 12288}; pg8::gemm_phase(lds, g, S, E); )
    PHASE(9,  rms_mod_phase<false, false, true>(X2, p.in[4] + DM, mod + 4 * 12288 + 1 * 2048, mod + 4 * 12288 + 0 * 2048, HA, nullptr, nullptr, nullptr, nullptr, nullptr, nullptr, gw, NGW, lane); )
    PHASE(10,  pg8::Gemm g{HA, WT_MLIN, MTOK, 8192, 2048, 0}; pg8::StaticOrder S; S.init(MTOK, 8192, G, (int)blockIdx.x); pg8::EpiBf16 E{XZ, 8192}; pg8::gemm_phase(lds, g, S, E); )
    PHASE(11,  ml_pre_phase(XZ, p.in[15], p.in[16], p.in[17], p.in[18], p.in[19], WT_IF, XC, Qm, Km, Vm, pre_part, lds, G, tid, lane, wave); )
    PHASE(12,  mlstm_phase(Qm, Km, Vm, pre_part, p.in[21], (float*)(ws + WS_GLF), HF, HB, lds, G, vcu, tid, lane, wave); )
    PHASE(13,  ml_combine_phase(HF, HB, XC, XZ, p.in[23], p.in[22], MO, gw, NGW, lane); )
    PHASE(14,  pg8::Gemm g{MO, WT_MLOUT, MTOK, 2048, 4096, 0}; pg8::StaticOrder S; S.init(MTOK, 2048, G, (int)blockIdx.x); pg8::EpiResGate16<true> E{X2, X1, DM, mod + 4 * 12288 + 2 * 2048, 12288}; pg8::gemm_phase(lds, g, S, E); )
    PHASE(15,  rms_mod_phase<true, false, true>(X1, p.in[5] + DM, mod + 4 * 12288 + 4 * 2048, mod + 4 * 12288 + 3 * 2048, HA, p.in[25], tok_e, tok_pos, tok_w, ecnt, HS, gw, NGW, lane); )
    PHASE(17,  int cnt[8], off[8], ntiles; moe_offsets(ecnt, cnt, off, ntiles);
        pg8::Gemm g{HS, WT_MGU, ntiles * 256, 2 * EDIM, 2048, 0}; pg8::MoeOrder S; S.init(ntiles, 2 * EDIM, G, (int)blockIdx.x, moe_tilemap(cnt), (size_t)14336 * 2048, (size_t)DM);
        pg8::EpiSwiGLU8 E{ACTM, EDIM, 1.0f / (HSCALE * WSCALE), ASCALE}; pg8::gemm_phase<pg8::EpiSwiGLU8, pg8::MoeOrder, true>(lds, g, S, E); )
    PHASE(18,  int cnt[8], off[8], ntiles; moe_offsets(ecnt, cnt, off, ntiles);
        pg8::Gemm g{ACTM, WT_MD, ntiles * 256, 2048, EDIM, 0};
        int nMf, nT, SS; moe_split_plan(ntiles, nMf, nT, SS); bf16_t* YSP = (bf16_t*)YS + (size_t)MPAD * DM;
        { pg8::MoeRowOrder S1; S1.init(nMf, G, (int)blockIdx.x, moe_tilemap(cnt), (size_t)2048 * EDIM); pg8::EpiBf16S E{(bf16_t*)YS, DM, 1.0f / (ASCALE * WSCALE), 0}; pg8::gemm_phase<pg8::EpiBf16S, pg8::MoeRowOrder, true>(lds, g, S1, E); }
        if (nT > 0) { pg8::Gemm g2 = g; g2.ntk = 56 / SS; pg8::MoeSplitOrder S2; S2.init(nMf, nT, SS, (size_t)(EDIM / SS), (int)blockIdx.x, moe_tilemap(cnt), (size_t)2048 * EDIM);
            pg8::EpiBf16S E2{YSP - (size_t)nMf * 256 * DM, DM, 1.0f / (ASCALE * WSCALE), (size_t)nT * 256 * DM}; pg8::gemm_phase<pg8::EpiBf16S, pg8::MoeSplitOrder, true>(lds, g2, S2, E2); } )
    PHASE(19,  moe_combine_phase(X1, (const bf16_t*)YS, tok_e, tok_pos, tok_w, mod + 4 * 12288 + 5 * 2048, p.out, ecnt, gw, NGW, lane); )
#undef IN
#undef SEAM
#undef PHASE
}

extern "C" void kernel_launch(void* const* d_in, const int* in_sizes, int n_in, void* d_out, int out_size, void* d_ws, size_t ws_size, hipStream_t stream) {
    static int grid = 0;
    if (grid == 0) {
        if (n_in != 29 || out_size != MTOK * DM || ws_size < WS_END) { fprintf(stderr, "kernel_launch: unexpected shapes (n_in %d out %d ws %zu need %zu)\n", n_in, out_size, ws_size, (size_t)WS_END); grid = -1; return; }
        int dev = 0, cus = 0, per_cu = 0;
        if (hipGetDevice(&dev) != hipSuccess || hipDeviceGetAttribute(&cus, hipDeviceAttributeMultiprocessorCount, dev) != hipSuccess) { grid = -1; return; }
        if (hipFuncSetAttribute((const void*)mega_fwd, hipFuncAttributeMaxDynamicSharedMemorySize, LDS_BYTES) != hipSuccess) { fprintf(stderr, "kernel_launch: hipFuncSetAttribute failed\n"); grid = -1; return; }
        if (hipOccupancyMaxActiveBlocksPerMultiprocessor(&per_cu, (const void*)mega_fwd, NTHREADS, LDS_BYTES) != hipSuccess || per_cu < 1) { fprintf(stderr, "kernel_launch: occupancy query says %d\n", per_cu); (void)hipGetLastError(); per_cu = 1; }
        grid = cus;
    }
    if (grid < 0) return;
    (void)hipMemsetAsync((char*)d_ws + WS_CTL, 0, CTL_BYTES, stream);
    Params p{};
    for (int i = 0; i < 29; ++i) p.in[i] = (const float*)d_in[i];
    p.out = (float*)d_out; p.ws = (unsigned char*)d_ws;
#if N_LAUNCH_SPLIT
    for (int k = 0; k < NPHASE; ++k) { p.ph_lo = k; p.ph_hi = k + 1; hipLaunchKernelGGL(mega_fwd, dim3(grid), dim3(NTHREADS), LDS_BYTES, stream, p); }
#else
    p.ph_lo = 0; p.ph_hi = NPHASE;
    hipLaunchKernelGGL(mega_fwd, dim3(grid), dim3(NTHREADS), LDS_BYTES, stream, p);
#endif
}
```

```cpp
#define PROBE_HOT 0
#ifndef GEMM_SCH
#define GEMM_SCH 1
#endif
#include <hip/hip_runtime.h>
#include <cstdio>
#include <cstdint>

#ifndef DBG
#define DBG 0
#endif
#ifndef N_LAUNCH_SPLIT
#define N_LAUNCH_SPLIT 0
#endif

#define LAS __attribute__((address_space(3)))
#define GAS __attribute__((address_space(1)))
#define DI __device__ __forceinline__
typedef unsigned short bf16_t;
typedef short bf16x8 __attribute__((ext_vector_type(8)));
typedef short s16x4 __attribute__((ext_vector_type(4)));
typedef float f32x2 __attribute__((ext_vector_type(2)));
typedef float f32x4 __attribute__((ext_vector_type(4)));
typedef float f32x16 __attribute__((ext_vector_type(16)));
typedef unsigned u32x2 __attribute__((ext_vector_type(2)));
typedef unsigned u32x4 __attribute__((ext_vector_type(4)));
typedef int i32x4 __attribute__((ext_vector_type(4)));
typedef int i32x8 __attribute__((ext_vector_type(8)));

constexpr int BATCH = 4, SEQ = 2048, DM = 2048, MTOK = BATCH * SEQ;
constexpr int GRID_W = 64, NA_HEADS = 16, NA_HD = 128;
constexpr int ML_INNER = 4096, ML_HEADS = 8, ML_HD = 512;
constexpr int FFN = 5632, NEXP = 8, EDIM = 7168;
constexpr int MPAD = 2 * MTOK + NEXP * 256;
constexpr int NTHREADS = 512, NWAVES = 8;
constexpr int LDS_BYTES = 147456;

constexpr size_t al256(size_t x) { return (x + 255) & ~(size_t)255; }
constexpr size_t WS_CTL = 0;
constexpr size_t CTL_BYTES = 65536;
constexpr size_t WS_MOD = WS_CTL + CTL_BYTES;
constexpr size_t WS_PRE = WS_MOD + al256((size_t)2 * 4 * 12288 * 4);
constexpr size_t WS_ROUTE = WS_PRE + (size_t)8 * MTOK * 32 * 4;
constexpr size_t WS_GLF = WS_ROUTE + (size_t)4 * MTOK * 2 * 4;
constexpr size_t WS_HA = WS_GLF + (size_t)256 * 10240 * 4;
constexpr size_t WS_X1 = WS_HA + (size_t)MTOK * DM * 2;
constexpr size_t WS_X2 = WS_X1 + (size_t)MTOK * DM * 4;
constexpr size_t WS_WT_IN = WS_X2 + (size_t)MTOK * DM * 4;
constexpr size_t WS_WT_OUT = WS_WT_IN + (size_t)6144 * 2048 * 2;
constexpr size_t WS_WT_GU = WS_WT_OUT + (size_t)2048 * 2048 * 2;
constexpr size_t WS_WT_DN = WS_WT_GU + (size_t)11264 * 2048 * 2;
constexpr size_t WS_WT_MLIN = WS_WT_DN + (size_t)2048 * 5632 * 2;
constexpr size_t WS_WT_MLOUT = WS_WT_MLIN + (size_t)8192 * 2048 * 2;
constexpr size_t WS_WT_IF = WS_WT_MLOUT + (size_t)2048 * 4096 * 2;
constexpr size_t WS_WT_MGU = WS_WT_IF + (size_t)32 * 12288 * 2;
constexpr size_t WS_WT_MD = WS_WT_MGU + (size_t)8 * 14336 * 2048;
constexpr size_t WS_ARENA = WS_WT_MD + (size_t)8 * 2048 * 7168;
constexpr size_t A_QK = WS_ARENA;
constexpr size_t A_QKN = A_QK + (size_t)MTOK * 4096 * 2;
constexpr size_t A_VT = A_QKN + (size_t)MTOK * 4096 * 2;
constexpr size_t A_ATT = A_VT + (size_t)2048 * MTOK * 2;
constexpr size_t A_ACT = A_ATT + (size_t)MTOK * DM * 2;
constexpr size_t A_L0_END = A_ACT + (size_t)MTOK * FFN * 2;
constexpr size_t A_XZ = WS_ARENA;
constexpr size_t A_XC = A_XZ + (size_t)MTOK * 8192 * 2;
constexpr size_t A_Q = A_XC + (size_t)MTOK * 4096 * 2;
constexpr size_t A_K = A_Q + (size_t)MTOK * 4096 * 2;
constexpr size_t A_V = A_K + (size_t)MTOK * 4096 * 2;
constexpr size_t A_HF = A_V + (size_t)MTOK * 4096 * 2;
constexpr size_t A_HB = A_HF + (size_t)MTOK * 4096 * 2;
constexpr size_t A_MO = A_HB + (size_t)MTOK * 4096 * 2;
constexpr size_t A_L1_END = A_MO + (size_t)MTOK * 4096 * 2;
constexpr size_t A_HS = WS_ARENA;
constexpr size_t A_ACTM = A_HS + (size_t)8 * 8192 * DM;
constexpr size_t A_YS = A_ACTM + (size_t)MPAD * EDIM;
constexpr size_t A_L2_END = A_YS + (size_t)MPAD * DM * 4;
constexpr size_t cmax(size_t a, size_t b) { return a > b ? a : b; }
constexpr size_t WS_END = cmax(cmax(A_L0_END, A_L1_END), A_L2_END);

constexpr int CW_BAR = 0;
constexpr int CW_ECNT = 4096;
constexpr int CW_DBG = 8192;

typedef __bf16 bf16x2_t __attribute__((ext_vector_type(2)));
DI unsigned cvt_pk_bf16(float lo, float hi) { const f32x2 v = {lo, hi}; return __builtin_bit_cast(unsigned, __builtin_convertvector(v, bf16x2_t)); }
DI float clamp448(float x) { return __builtin_fminf(__builtin_fmaxf(x, -448.f), 448.f); }
DI unsigned pk4_fp8(float a, float b, float c, float d) {
    int p = 0; p = __builtin_amdgcn_cvt_pk_fp8_f32(clamp448(a), clamp448(b), p, false); p = __builtin_amdgcn_cvt_pk_fp8_f32(clamp448(c), clamp448(d), p, true); return (unsigned)p; }
DI float bf_lo(unsigned u) { return __uint_as_float(u << 16); }
DI float bf_hi(unsigned u) { return __uint_as_float(u & 0xffff0000u); }
DI float bf2f(bf16_t b) { return __uint_as_float(((unsigned)b) << 16); }
DI bf16_t f2bf(float f) { return (bf16_t)(cvt_pk_bf16(f, 0.f) & 0xffffu); }
DI float wave_sum(float v) {
#pragma unroll
    for (int o = 1; o < 64; o <<= 1) v += __shfl_xor(v, o);
    return v;
}
DI float wave_max(float v) {
#pragma unroll
    for (int o = 1; o < 64; o <<= 1) v = fmaxf(v, __shfl_xor(v, o));
    return v;
}
DI float silu_f(float x) { return x / (1.f + __expf(-x)); }
DI float sigmoid_f(float x) { return 1.f / (1.f + __expf(-x)); }
#define LDS_WAIT() asm volatile("s_waitcnt lgkmcnt(0)" ::: "memory")
#define VM_WAIT() asm volatile("s_waitcnt vmcnt(0)" ::: "memory")

#define XB_TMO      128
#define XB_XCNT(j)  (256  + 64 * (j))
#define XB_XSUB(j)  (1280 + 64 * (j))
#define XB_XGEN(j)  (2304 + 64 * (j))
#define XB_TOP      3328
#define XB_TOPGEN   3392
#define XCD_BAR_WORDS 3456
#define XB_SPIN_CAP (1u << 22)

__device__ __forceinline__ unsigned xb_ld(unsigned* p)              { return __hip_atomic_load(p, __ATOMIC_RELAXED, __HIP_MEMORY_SCOPE_AGENT); }
__device__ __forceinline__ unsigned xb_add(unsigned* p, unsigned v) { return __hip_atomic_fetch_add(p, v, __ATOMIC_RELAXED, __HIP_MEMORY_SCOPE_AGENT); }
__device__ __forceinline__ unsigned xb_xcc_id() { return (unsigned)__builtin_amdgcn_s_getreg((3 << 11) | 20) & 0xFu; }
#define XB_SPIN(cond, bar) do { unsigned _sp = 0; while (cond) { __builtin_amdgcn_s_sleep(1); \
    if ((++_sp & 255u) == 0u) { if (xb_ld(&(bar)[XB_TMO])) break; if (_sp > XB_SPIN_CAP) { atomicAdd(&(bar)[XB_TMO], 1u); break; } } } } while (0)

struct XcdBarrier { unsigned* bar; unsigned x; volatile LAS unsigned* st; };

__device__ __forceinline__ XcdBarrier xcd_barrier_post(unsigned* bar, volatile LAS unsigned* st) {
    XcdBarrier b; b.bar = bar; b.x = xb_xcc_id(); b.st = st;
    if (threadIdx.x == 0) (void)xb_add(&bar[XB_XCNT(b.x)], 1u);
    return b;
}
__device__ __forceinline__ void xcd_barrier_complete(unsigned* bar, unsigned x, unsigned& nloc, unsigned& nx) {
    const unsigned G = gridDim.x * gridDim.y * gridDim.z;
    unsigned sum, cnt, mine, sp = 0u;
    for (;;) {
        sum = 0u; cnt = 0u; mine = 0u;
#pragma unroll
        for (unsigned j = 0; j < 16; ++j) { const unsigned c = xb_ld(&bar[XB_XCNT(j)]); sum += c; cnt += (c > 0u) ? 1u : 0u; mine = (j == x) ? c : mine; }
        if (sum == G) break;
        __builtin_amdgcn_s_sleep(1);
        if ((++sp & 255u) == 0u) { if (xb_ld(&bar[XB_TMO])) break; if (sp > XB_SPIN_CAP) { atomicAdd(&bar[XB_TMO], 1u); break; } }
    }
    nloc = mine > 0u ? mine : 1u; nx = cnt > 0u ? cnt : 1u;
}
__device__ __forceinline__ void xcd_barrier(const XcdBarrier& b) {
    asm volatile("s_waitcnt vmcnt(0)" ::: "memory");
    __syncthreads();
    if (threadIdx.x == 0) {
        unsigned* bar = b.bar;
        __builtin_amdgcn_s_waitcnt(0);
        unsigned nloc = b.st[0], nx = b.st[1];
        if (nloc == 0u) { xcd_barrier_complete(bar, b.x, nloc, nx); b.st[0] = nloc; b.st[1] = nx; }
        const unsigned old = xb_add(&bar[XB_XSUB(b.x)], 1u);
        const unsigned gen = old / nloc;
        if (old + 1u == (gen + 1u) * nloc) {
            __builtin_amdgcn_fence(__ATOMIC_RELEASE, "agent");
            asm volatile("s_waitcnt vmcnt(0)" ::: "memory");
            const unsigned og = xb_add(&bar[XB_TOP], 1u);
            const unsigned tg = og / nx;
            if (og + 1u == (tg + 1u) * nx) xb_add(&bar[XB_TOPGEN], 1u);
            else XB_SPIN(xb_ld(&bar[XB_TOPGEN]) == tg, bar);
            __builtin_amdgcn_fence(__ATOMIC_ACQUIRE, "agent");
            xb_add(&bar[XB_XGEN(b.x)], 1u);
            asm volatile("s_waitcnt vmcnt(0)" ::: "memory");
        } else {
            XB_SPIN(xb_ld(&bar[XB_XGEN(b.x)]) == gen, bar);
            __builtin_amdgcn_fence(__ATOMIC_ACQUIRE, "agent");
            asm volatile("s_waitcnt vmcnt(0)" ::: "memory");
        }
    }
    __syncthreads();
}

namespace pg8 {
constexpr int BM = 256, BK = 64, HALF = 128, HTB = HALF * BK * 2, STAGE_BYTES = 8 * HTB, NXCD = 8, WGM = 8;
__host__ __device__ __forceinline__ int lds_byte(int r, int c) { const int st = (r >> 4) * 2 + (c >> 5), rr = r & 15, cc = c & 31, ob = rr * 64 + cc * 2; return st * 1024 + (ob ^ (((ob >> 9) & 1) << 5)); }
__host__ __device__ __forceinline__ void stage_rc(int b, int& R, int& C) { const int st = b / 1024, sb = b % 1024, swz = sb ^ (((sb >> 9) & 1) << 5); R = (st >> 1) * 16 + swz / 64; C = (st & 1) * 32 + (swz % 64) / 2; }
__host__ __device__ __forceinline__ int perm32(int rho) { const int n = rho >> 4, i = rho & 15; return 8 * (i >> 2) + 4 * n + (i & 3); }

struct Unit { int pm, pn; size_t boff; size_t aoff; int slice; };
struct Gemm { const void* A; const void* Bt; int M, N, K; int ntk; };

struct StaticOrder {
    int nM, nN, nwg, G, c;
    __device__ void init(int M, int N, int G_, int c_) { nM = M / BM; nN = N / BM; nwg = nM * nN; G = G_; c = c_; }
    __device__ bool next(int i, Unit& u) const {
        const long L = (long)i * G + c; if (L >= nwg) return false;
        int wgid = (int)L; { const int q = nwg / NXCD, r = nwg % NXCD, xcd = wgid % NXCD, off = wgid / NXCD; wgid = (xcd < r ? xcd * (q + 1) : r * (q + 1) + (xcd - r) * q) + off; }
        const int nig = WGM * nN, gid = wgid / nig, fm = gid * WGM, gsz = (nM - fm) < WGM ? (nM - fm) : WGM;
        u.pm = fm + ((wgid % nig) % gsz); u.pn = (wgid % nig) / gsz; u.boff = 0; u.aoff = 0; u.slice = 0; return true;
    }
};
struct TileMap {
    int toff[9];
    __device__ __forceinline__ void lookup(int pm, int& e, int& k) const {
        e = (pm >= toff[1]) + (pm >= toff[2]) + (pm >= toff[3]) + (pm >= toff[4]) + (pm >= toff[5]) + (pm >= toff[6]) + (pm >= toff[7]);
        int t0 = 0;
#pragma unroll
        for (int q = 1; q < 8; ++q) t0 = (e == q) ? toff[q] : t0;
        k = pm - t0;
    }
};
constexpr int ECAP = 8192;
struct MoeOrder {
    int nM, nN, nwg, G, c; TileMap tm; size_t estride; size_t arowb;
    __device__ void init(int nM_, int N, int G_, int c_, const TileMap& tm_, size_t es, size_t arowb_) { nM = nM_; nN = N / BM; nwg = nM * nN; G = G_; c = c_; tm = tm_; estride = es; arowb = arowb_; }
    __device__ bool next(int i, Unit& u) const {
        const long L = (long)i * G + c; if (L >= nwg) return false;
        int wgid = (int)L; { const int q = nwg / NXCD, r = nwg % NXCD, xcd = wgid % NXCD, off = wgid / NXCD; wgid = (xcd < r ? xcd * (q + 1) : r * (q + 1) + (xcd - r) * q) + off; }
        const int nig = WGM * nN, gid = wgid / nig, fm = gid * WGM, gsz = (nM - fm) < WGM ? (nM - fm) : WGM;
        u.pm = fm + ((wgid % nig) % gsz); u.pn = (wgid % nig) / gsz; int e, k; tm.lookup(u.pm, e, k); u.boff = (size_t)e * estride;
        u.aoff = (size_t)((long)(e * ECAP + 256 * k - 256 * u.pm) * (long)arowb); u.slice = 0; return true;
    }
};

struct MoeRowOrder {
    int nwg, G, c; TileMap tm; size_t estride;
    __device__ void init(int nMf, int G_, int c_, const TileMap& tm_, size_t es) { nwg = nMf * 8; G = G_; c = c_; tm = tm_; estride = es; }
    __device__ bool next(int i, Unit& u) const {
        const long L = (long)i * G + c; if (L >= nwg) return false;
        u.pm = (int)(L >> 3); u.pn = (int)(L & 7); int e, k; tm.lookup(u.pm, e, k); u.boff = (size_t)e * estride; u.aoff = 0; u.slice = 0; return true;
    }
};
struct MoeSplitOrder {
    int pm0, nq, S, c; size_t kslice; TileMap tm; size_t estride;
    __device__ void init(int pm0_, int nT, int S_, size_t ks, int c_, const TileMap& tm_, size_t es) { pm0 = pm0_; S = S_; nq = nT * 8 * S_; kslice = ks; c = c_; tm = tm_; estride = es; }
    __device__ bool next(int i, Unit& u) const {
        if (i != 0 || c >= nq) return false;
        const int un = c / S; u.slice = c - un * S; u.pm = pm0 + (un >> 3); u.pn = un & 7; u.aoff = (size_t)u.slice * kslice; int e, k; tm.lookup(u.pm, e, k); u.boff = (size_t)e * estride + u.aoff; return true;
    }
};
struct EpiBf16 {
    static constexpr bool PERM = true, XBAR = false;
    bf16_t* O; int ldc;
    __device__ __forceinline__ void operator()(const f32x4 (&acc)[2][2][4][2], const Unit& u, int wr, int wc, int fr, int fq) const {
        const int row0 = u.pm * BM + wr * 64 + fr, col0 = u.pn * BM + wc * 32 + 8 * fq;
#pragma unroll
        for (int ai = 0; ai < 2; ++ai)
#pragma unroll
            for (int m = 0; m < 4; ++m) { bf16_t* rowp = O + (size_t)(row0 + ai * HALF + m * 16) * ldc + col0;
#pragma unroll
                for (int bj = 0; bj < 2; ++bj) { const f32x4 v0 = acc[ai][bj][m][0], v1 = acc[ai][bj][m][1];
                    u32x4 w; w.x = cvt_pk_bf16(v0[0], v0[1]); w.y = cvt_pk_bf16(v0[2], v0[3]); w.z = cvt_pk_bf16(v1[0], v1[1]); w.w = cvt_pk_bf16(v1[2], v1[3]);
                    *(u32x4*)(rowp + bj * HALF) = w; } }
    }
};
struct EpiQKNorm {
    static constexpr bool PERM = true, XBAR = true;
    bf16_t* O; int ldc; const float* qg; const float* kg; float sc;
    __device__ __forceinline__ void pre(const f32x4 (&acc)[2][2][4][2], int wr, int wc, int fr, int fq, LAS float* P) const {
#pragma unroll
        for (int ai = 0; ai < 2; ++ai)
#pragma unroll
            for (int m = 0; m < 4; ++m)
#pragma unroll
                for (int bj = 0; bj < 2; ++bj) { const f32x4 a = acc[ai][bj][m][0], b = acc[ai][bj][m][1];
                    float ss = (a[0] * a[0] + a[1] * a[1]) + (a[2] * a[2] + a[3] * a[3]) + (b[0] * b[0] + b[1] * b[1]) + (b[2] * b[2] + b[3] * b[3]);
                    ss += __shfl_xor(ss, 16); ss += __shfl_xor(ss, 32);
                    if (fq == 0) P[((ai * HALF + wr * 64 + m * 16 + fr) * 2 + bj) * 4 + wc] = ss * sc * sc; }
    }
    __device__ __forceinline__ void post(const f32x4 (&acc)[2][2][4][2], const Unit& u, int wr, int wc, int fr, int fq, const LAS float* P) const {
        const int row0 = u.pm * BM + wr * 64 + fr, col0 = u.pn * BM + wc * 32 + 8 * fq;
        f32x4 g0[2], g1[2]; float hs[2];
#pragma unroll
        for (int bj = 0; bj < 2; ++bj) { const int head = 2 * u.pn + bj; const float* gp = (head < 16 ? qg : kg) + wc * 32 + 8 * fq; g0[bj] = *(const f32x4*)gp; g1[bj] = *(const f32x4*)(gp + 4); hs[bj] = head < 16 ? 0.08838834764831845f : 1.0f; }
#pragma unroll
        for (int ai = 0; ai < 2; ++ai)
#pragma unroll
            for (int m = 0; m < 4; ++m) { bf16_t* rowp = O + (size_t)(row0 + ai * HALF + m * 16) * ldc + col0;
#pragma unroll
                for (int bj = 0; bj < 2; ++bj) { const f32x4 ps = *(const LAS f32x4*)(P + ((ai * HALF + wr * 64 + m * 16 + fr) * 2 + bj) * 4);
                    const float rstd = hs[bj] / sqrtf(((ps[0] + ps[1]) + (ps[2] + ps[3])) * (1.f / 128.f) + 1e-6f);
                    const f32x4 v0 = acc[ai][bj][m][0] * g0[bj] * (rstd * sc), v1 = acc[ai][bj][m][1] * g1[bj] * (rstd * sc);
                    u32x4 w; w.x = cvt_pk_bf16(v0[0], v0[1]); w.y = cvt_pk_bf16(v0[2], v0[3]); w.z = cvt_pk_bf16(v1[0], v1[1]); w.w = cvt_pk_bf16(v1[2], v1[3]);
                    *(u32x4*)(rowp + bj * HALF) = w; } }
    }
};
struct EpiBf16S {
    static constexpr bool PERM = true, XBAR = false;
    bf16_t* O; int ldc; float sc; size_t sstride;
    __device__ __forceinline__ void operator()(const f32x4 (&acc)[2][2][4][2], const Unit& u, int wr, int wc, int fr, int fq) const {
        const int row0 = u.pm * BM + wr * 64 + fr, col0 = u.pn * BM + wc * 32 + 8 * fq;
        bf16_t* Os = O + (size_t)u.slice * sstride;
#pragma unroll
        for (int ai = 0; ai < 2; ++ai)
#pragma unroll
            for (int m = 0; m < 4; ++m) { bf16_t* rowp = Os + (size_t)(row0 + ai * HALF + m * 16) * ldc + col0;
#pragma unroll
                for (int bj = 0; bj < 2; ++bj) { const f32x4 v0 = acc[ai][bj][m][0] * sc, v1 = acc[ai][bj][m][1] * sc;
                    u32x4 w; w.x = cvt_pk_bf16(v0[0], v0[1]); w.y = cvt_pk_bf16(v0[2], v0[3]); w.z = cvt_pk_bf16(v1[0], v1[1]); w.w = cvt_pk_bf16(v1[2], v1[3]);
                    *(u32x4*)(rowp + bj * HALF) = w; } }
    }
};
struct EpiSwiGLU {
    static constexpr bool PERM = true, XBAR = false;
    bf16_t* O; int ldc;
    __device__ __forceinline__ void operator()(const f32x4 (&acc)[2][2][4][2], const Unit& u, int wr, int wc, int fr, int fq) const {
        const int row0 = u.pm * BM + wr * 64 + fr, col0 = u.pn * HALF + wc * 32 + 8 * fq;
#pragma unroll
        for (int ai = 0; ai < 2; ++ai)
#pragma unroll
            for (int m = 0; m < 4; ++m) { bf16_t* rowp = O + (size_t)(row0 + ai * HALF + m * 16) * ldc + col0;
                float o[8];
#pragma unroll
                for (int n = 0; n < 2; ++n)
#pragma unroll
                    for (int j = 0; j < 4; ++j) { const float g = acc[ai][0][m][n][j], up = acc[ai][1][m][n][j]; o[n * 4 + j] = g * __builtin_amdgcn_rcpf(1.f + __expf(-g)) * up; }
                u32x4 w; w.x = cvt_pk_bf16(o[0], o[1]); w.y = cvt_pk_bf16(o[2], o[3]); w.z = cvt_pk_bf16(o[4], o[5]); w.w = cvt_pk_bf16(o[6], o[7]);
                *(u32x4*)rowp = w; }
    }
};
struct EpiSwiGLU8 {
    static constexpr bool PERM = true, XBAR = false;
    unsigned char* O; int ldc; float isc, osc;
    __device__ __forceinline__ void operator()(const f32x4 (&acc)[2][2][4][2], const Unit& u, int wr, int wc, int fr, int fq) const {
        const int row0 = u.pm * BM + wr * 64 + fr, col0 = u.pn * HALF + wc * 32 + 8 * fq;
#pragma unroll
        for (int ai = 0; ai < 2; ++ai)
#pragma unroll
            for (int m = 0; m < 4; ++m) { unsigned char* rowp = O + (size_t)(row0 + ai * HALF + m * 16) * ldc + col0;
                float o[8];
#pragma unroll
                for (int n = 0; n < 2; ++n)
#pragma unroll
                    for (int j = 0; j < 4; ++j) { const float g = acc[ai][0][m][n][j] * isc, up = acc[ai][1][m][n][j] * isc; o[n * 4 + j] = g * __builtin_amdgcn_rcpf(1.f + __expf(-g)) * up * osc; }
                u32x2 w; w.x = pk4_fp8(o[0], o[1], o[2], o[3]); w.y = pk4_fp8(o[4], o[5], o[6], o[7]);
                *(u32x2*)rowp = w; }
    }
};
struct EpiResGate {
    static constexpr bool PERM = false, XBAR = false;
    const float* base; float* out; int ldc; const float* gate; int gstride;
    __device__ __forceinline__ void operator()(const f32x4 (&acc)[2][2][4][2], const Unit& u, int wr, int wc, int fr, int fq) const {
        const int row0 = u.pm * BM + wr * 64 + fr, col0 = u.pn * BM + wc * 32 + 4 * fq;
        const float* gp = gate + (size_t)((u.pm * BM) >> 11) * gstride + col0;
        f32x4 gv[2][2];
#pragma unroll
        for (int bj = 0; bj < 2; ++bj)
#pragma unroll
            for (int n = 0; n < 2; ++n) gv[bj][n] = *(const f32x4*)(gp + bj * HALF + n * 16);
#pragma unroll
        for (int ai = 0; ai < 2; ++ai)
#pragma unroll
            for (int m = 0; m < 4; ++m) { const size_t off = (size_t)(row0 + ai * HALF + m * 16) * ldc + col0;
#pragma unroll
                for (int bj = 0; bj < 2; ++bj)
#pragma unroll
                    for (int n = 0; n < 2; ++n) { const f32x4 bs = *(const f32x4*)(base + off + bj * HALF + n * 16);
                        *(f32x4*)(out + off + bj * HALF + n * 16) = bs + gv[bj][n] * acc[ai][bj][m][n]; }
                asm volatile("" ::: "memory"); }
    }
};
template <bool BASE16>
struct EpiResGate16 {
    static constexpr bool PERM = true, XBAR = false;
    const void* base; bf16_t* out; int ldc; const float* gate; int gstride; float sc = 1.0f;
    __device__ __forceinline__ void operator()(const f32x4 (&acc)[2][2][4][2], const Unit& u, int wr, int wc, int fr, int fq) const {
        const int row0 = u.pm * BM + wr * 64 + fr, col0 = u.pn * BM + wc * 32 + 8 * fq;
        const float* gp = gate + (size_t)((u.pm * BM) >> 11) * gstride + col0;
        f32x4 gv[2][2];
#pragma unroll
        for (int bj = 0; bj < 2; ++bj)
#pragma unroll
            for (int n = 0; n < 2; ++n) gv[bj][n] = *(const f32x4*)(gp + bj * HALF + 4 * n) * sc;
#pragma unroll
        for (int ai = 0; ai < 2; ++ai)
#pragma unroll
            for (int m = 0; m < 4; ++m) { const size_t off = (size_t)(row0 + ai * HALF + m * 16) * ldc + col0;
#pragma unroll
                for (int bj = 0; bj < 2; ++bj) { f32x4 b0, b1;
                    if (BASE16) { const u32x4 r = *(const u32x4*)((const bf16_t*)base + off + bj * HALF);
                        b0 = (f32x4){__uint_as_float(r.x << 16), __uint_as_float(r.x & 0xffff0000u), __uint_as_float(r.y << 16), __uint_as_float(r.y & 0xffff0000u)};
                        b1 = (f32x4){__uint_as_float(r.z << 16), __uint_as_float(r.z & 0xffff0000u), __uint_as_float(r.w << 16), __uint_as_float(r.w & 0xffff0000u)}; }
                    else { b0 = *(const f32x4*)((const float*)base + off + bj * HALF); b1 = *(const f32x4*)((const float*)base + off + bj * HALF + 4); }
                    const f32x4 v0 = b0 + gv[bj][0] * acc[ai][bj][m][0], v1 = b1 + gv[bj][1] * acc[ai][bj][m][1];
                    u32x4 w; w.x = cvt_pk_bf16(v0[0], v0[1]); w.y = cvt_pk_bf16(v0[2], v0[3]); w.z = cvt_pk_bf16(v1[0], v1[1]); w.w = cvt_pk_bf16(v1[2], v1[3]);
                    *(u32x4*)(out + off + bj * HALF) = w; }
                asm volatile("" ::: "memory"); }
    }
};
struct EpiF32 {
    static constexpr bool PERM = false, XBAR = false;
    float* C; int ldc; float sc;
    __device__ __forceinline__ void operator()(const f32x4 (&acc)[2][2][4][2], const Unit& u, int wr, int wc, int fr, int fq) const {
        const int row0 = u.pm * BM + wr * 64 + fr, col0 = u.pn * BM + wc * 32 + 4 * fq;
#pragma unroll
        for (int ai = 0; ai < 2; ++ai)
#pragma unroll
            for (int m = 0; m < 4; ++m) { float* rowp = C + (size_t)(row0 + ai * HALF + m * 16) * ldc + col0;
#pragma unroll
                for (int bj = 0; bj < 2; ++bj)
#pragma unroll
                    for (int n = 0; n < 2; ++n) *(f32x4*)(rowp + bj * HALF + n * 16) = acc[ai][bj][m][n] * sc; }
    }
};

template <class Epi, class Sched, bool F8 = false, int HOT = 0, int SCH = GEMM_SCH>
__device__ __forceinline__ void gemm_phase(LAS unsigned char* lds, const Gemm g, const Sched& S, const Epi& E) {
    const int tid = threadIdx.x, wid = __builtin_amdgcn_readfirstlane(tid >> 6), lane = tid & 63, wr = wid >> 2, wc = wid & 3, fr = lane & 15, fq = lane >> 4;
    const int rowb = F8 ? g.K : 2 * g.K, nt = g.ntk ? g.ntk : rowb / (BK * 2);
    unsigned voffA[2], voffB[2];
#pragma unroll
    for (int i = 0; i < 2; ++i) { int R, C; stage_rc(tid * 16 + i * 8192, R, C); const int Rb = Epi::PERM ? ((R & ~31) + perm32(R & 31)) : R;
        voffA[i] = (unsigned)(R * rowb + C * 2); voffB[i] = (unsigned)(Rb * rowb + C * 2); }
    const size_t kstep = (size_t)(BK * 2);
    const size_t hstep = (size_t)HALF * rowb;
    const size_t tstep = 2 * hstep;
    const unsigned ldsw = (unsigned)wid * 1024u;
    const int aoff = lds_byte(wr * 64 + fr, fq * 8), boff = lds_byte(wc * 32 + fr, fq * 8);
#define PG8_SA(b, h) (((b) * 2 + (h)) * HTB)
#define PG8_SB(b, h) ((4 + (b) * 2 + (h)) * HTB)
#define PG8_STAGE(bufoff, gbase, voff) do { _Pragma("unroll") for (int _i = 0; _i < 2; ++_i) \
        __builtin_amdgcn_global_load_lds((const unsigned*)((const char*)(gbase) + (voff)[_i]), (LAS unsigned*)(lds + (bufoff) + ldsw + _i * 8192), 16, 0, 0); } while (0)
#define PG8_LD8(base_) __builtin_shufflevector(*(const LAS i32x4*)(base_), *(const LAS i32x4*)((base_) + 1024), 0, 1, 2, 3, 4, 5, 6, 7)
#define PG8_LDA(dst, b, h) do { _Pragma("unroll") for (int m = 0; m < 4; ++m) { if constexpr (F8) dst##8[m] = PG8_LD8(lds + PG8_SA(b, h) + aoff + m * 2048); \
        else { _Pragma("unroll") for (int k = 0; k < 2; ++k) dst[m][k] = *(const LAS bf16x8*)(lds + PG8_SA(b, h) + aoff + m * 2048 + k * 1024); } } } while (0)
#define PG8_LDB(dst, b, h) do { _Pragma("unroll") for (int n = 0; n < 2; ++n) { if constexpr (F8) dst##8[n] = PG8_LD8(lds + PG8_SB(b, h) + boff + n * 2048); \
        else { _Pragma("unroll") for (int k = 0; k < 2; ++k) dst[n][k] = *(const LAS bf16x8*)(lds + PG8_SB(b, h) + boff + n * 2048 + k * 1024); } } } while (0)
#define PG8_MMA(ai, bj, At, Bt) do { __builtin_amdgcn_s_setprio(1); _Pragma("unroll") for (int m = 0; m < 4; ++m) _Pragma("unroll") for (int n = 0; n < 2; ++n) { \
        if constexpr (F8) { asm volatile("v_mfma_f32_16x16x128_f8f6f4 %0, %1, %2, %0" : "+v"(acc[ai][bj][m][n]) : "v"(Bt##8[n]), "v"(At##8[m])); } \
        else { _Pragma("unroll") for (int k = 0; k < 2; ++k) acc[ai][bj][m][n] = __builtin_amdgcn_mfma_f32_16x16x32_bf16(Bt[n][k], At[m][k], acc[ai][bj][m][n], 0, 0, 0); } } \
        __builtin_amdgcn_s_setprio(0); } while (0)
#define PG8_WAIT_V(n) asm volatile("s_waitcnt vmcnt(" #n ")" ::: "memory")
#define PG8_WAIT_L(n) asm volatile("s_waitcnt lgkmcnt(" #n ")" ::: "memory")
#define PG8_BAR __builtin_amdgcn_s_barrier()
#define PG8_SCHED __builtin_amdgcn_sched_barrier(0)
    Unit cur, nxt; int ui = 0;
    if (!S.next(0, cur)) return;
    f32x4 acc[2][2][4][2];
#pragma unroll
    for (int a = 0; a < 2; ++a)
#pragma unroll
        for (int b = 0; b < 2; ++b)
#pragma unroll
            for (int m = 0; m < 4; ++m)
#pragma unroll
                for (int n = 0; n < 2; ++n) acc[a][b][m][n] = (f32x4){0.f, 0.f, 0.f, 0.f};
    bf16x8 At[4][2], B0[2][2], B1[2][2]; i32x8 At8[4], B08[2], B18[2];
    const char* cA = (const char*)g.A + cur.aoff + (size_t)(HOT ? 0 : cur.pm) * tstep; const char* cB = (const char*)g.Bt + cur.boff + (size_t)(HOT ? 0 : cur.pn) * tstep;
    if constexpr (SCH == 1) {
        PG8_STAGE(PG8_SB(0, 0), cB, voffB); PG8_STAGE(PG8_SB(0, 1), cB + hstep, voffB); PG8_STAGE(PG8_SA(0, 0), cA, voffA); PG8_STAGE(PG8_SA(0, 1), cA + hstep, voffA);
        if (wr == 1) PG8_BAR;
        PG8_WAIT_V(2); PG8_BAR;
        PG8_STAGE(PG8_SB(1, 0), cB + kstep, voffB); PG8_STAGE(PG8_SB(1, 1), cB + hstep + kstep, voffB); PG8_STAGE(PG8_SA(1, 0), cA + kstep, voffA);
        PG8_WAIT_V(6); PG8_BAR;
    } else {
    PG8_STAGE(PG8_SB(0, 0), cB, voffB); PG8_STAGE(PG8_SA(0, 0), cA, voffA); PG8_STAGE(PG8_SB(0, 1), cB + hstep, voffB); PG8_STAGE(PG8_SA(0, 1), cA + hstep, voffA);
    if (wr == 1) PG8_BAR;
    PG8_WAIT_V(4); PG8_BAR;
    PG8_STAGE(PG8_SB(1, 0), cB + kstep, voffB); PG8_STAGE(PG8_SA(1, 0), cA + kstep, voffA); PG8_STAGE(PG8_SB(1, 1), cB + hstep + kstep, voffB);
    PG8_WAIT_V(6); PG8_BAR;
    }
    for (;;) {
        const bool has_next = S.next(ui + 1, nxt);
        const char* nA = has_next ? (const char*)g.A + nxt.aoff + (size_t)(HOT ? 0 : nxt.pm) * tstep : cA; const char* nB = has_next ? (const char*)g.Bt + nxt.boff + (size_t)(HOT ? 0 : nxt.pn) * tstep : cB;
        for (int t = 0; t < nt; t += 2) {
            const bool last = (t == nt - 2);
            const char* a1 = cA + (size_t)(t + 1) * kstep;
            const char* a2 = last ? nA : cA + (size_t)(t + 2) * kstep; const char* b2 = last ? nB : cB + (size_t)(t + 2) * kstep;
            const char* a3 = a2 + kstep; const char* b3 = b2 + kstep;
            if constexpr (SCH == 1) {
                PG8_LDB(B0, 0, 0); PG8_LDB(B1, 0, 1); PG8_SCHED; PG8_LDA(At, 0, 0); PG8_STAGE(PG8_SA(1, 1), a1 + hstep, voffA);
                PG8_WAIT_V(8); PG8_WAIT_L(0); PG8_BAR; PG8_MMA(0, 0, At, B0); PG8_MMA(0, 1, At, B1); PG8_BAR; PG8_SCHED;
                PG8_LDA(At, 0, 1); PG8_STAGE(PG8_SB(0, 0), b2, voffB); PG8_STAGE(PG8_SB(0, 1), b2 + hstep, voffB); PG8_STAGE(PG8_SA(0, 0), a2, voffA);
                PG8_WAIT_V(8); PG8_WAIT_L(0); PG8_BAR; PG8_MMA(1, 0, At, B0); PG8_MMA(1, 1, At, B1); PG8_BAR; PG8_SCHED;
                PG8_LDB(B0, 1, 0); PG8_LDB(B1, 1, 1); PG8_SCHED; PG8_LDA(At, 1, 0); PG8_STAGE(PG8_SA(0, 1), a2 + hstep, voffA);
                PG8_WAIT_V(8); PG8_WAIT_L(0); PG8_BAR; PG8_MMA(0, 0, At, B0); PG8_MMA(0, 1, At, B1); PG8_BAR; PG8_SCHED;
                PG8_LDA(At, 1, 1); PG8_STAGE(PG8_SB(1, 0), b3, voffB); PG8_STAGE(PG8_SB(1, 1), b3 + hstep, voffB); PG8_STAGE(PG8_SA(1, 0), a3, voffA);
                PG8_WAIT_V(8); PG8_WAIT_L(0); PG8_BAR; PG8_MMA(1, 0, At, B0); PG8_MMA(1, 1, At, B1); PG8_BAR; PG8_SCHED;
                continue;
            }
            PG8_LDB(B0, 0, 0); PG8_SCHED; PG8_LDA(At, 0, 0); PG8_STAGE(PG8_SA(1, 1), a1 + hstep, voffA);
            PG8_WAIT_L(8); PG8_BAR; PG8_WAIT_L(0); PG8_MMA(0, 0, At, B0); PG8_BAR; PG8_SCHED;
            PG8_LDB(B1, 0, 1); PG8_STAGE(PG8_SB(0, 0), b2, voffB);
            PG8_BAR; PG8_WAIT_L(0); PG8_MMA(0, 1, At, B1); PG8_BAR;
            PG8_LDA(At, 0, 1); PG8_STAGE(PG8_SA(0, 0), a2, voffA);
            PG8_BAR; PG8_WAIT_L(0); PG8_MMA(1, 0, At, B0); PG8_BAR; PG8_SCHED;
            PG8_STAGE(PG8_SB(0, 1), b2 + hstep, voffB);
            PG8_WAIT_V(6); PG8_BAR; PG8_MMA(1, 1, At, B1); PG8_BAR;
            PG8_LDB(B0, 1, 0); PG8_SCHED; PG8_LDA(At, 1, 0); PG8_STAGE(PG8_SA(0, 1), a2 + hstep, voffA);
            PG8_WAIT_L(8); PG8_BAR; PG8_WAIT_L(0); PG8_MMA(0, 0, At, B0); PG8_BAR; PG8_SCHED;
            PG8_LDB(B1, 1, 1); PG8_STAGE(PG8_SB(1, 0), b3, voffB);
            PG8_BAR; PG8_WAIT_L(0); PG8_MMA(0, 1, At, B1); PG8_BAR;
            PG8_LDA(At, 1, 1); PG8_STAGE(PG8_SA(1, 0), a3, voffA);
            PG8_BAR; PG8_WAIT_L(0); PG8_MMA(1, 0, At, B0); PG8_BAR; PG8_SCHED;
            PG8_STAGE(PG8_SB(1, 1), b3 + hstep, voffB);
            PG8_WAIT_V(6); PG8_BAR; PG8_MMA(1, 1, At, B1); PG8_BAR;
        }
        if constexpr (F8) asm volatile("s_nop 15\n\ts_nop 15" ::: "memory");
        if constexpr (Epi::XBAR) { LAS float* P_ = (LAS float*)(lds + STAGE_BYTES); E.pre(acc, wr, wc, fr, fq, P_); PG8_WAIT_L(0); PG8_BAR; asm volatile("" ::: "memory"); E.post(acc, cur, wr, wc, fr, fq, P_); }
        else E(acc, cur, wr, wc, fr, fq);
        if (!has_next) break;
#pragma unroll
        for (int a = 0; a < 2; ++a)
#pragma unroll
            for (int b = 0; b < 2; ++b)
#pragma unroll
                for (int m = 0; m < 4; ++m)
#pragma unroll
                    for (int n = 0; n < 2; ++n) acc[a][b][m][n] = (f32x4){0.f, 0.f, 0.f, 0.f};
        cur = nxt; cA = nA; cB = nB; ++ui;
    }
    PG8_WAIT_V(0);
    if (wr == 0) PG8_BAR;
    PG8_BAR;
#undef PG8_SA
#undef PG8_SB
#undef PG8_STAGE
#undef PG8_LDA
#undef PG8_LDB
#undef PG8_MMA
#undef PG8_WAIT_V
#undef PG8_WAIT_L
#undef PG8_BAR
#undef PG8_SCHED
}
}

DI void mod_phase(const float* c, const float* mod_w, const float* mod_b, float* mod, LAS unsigned char* lds, int G, int tid, int lane, int wave) {
    LAS f32x4* cact = (LAS f32x4*)lds;
    LAS float* red = (LAS float*)(lds + 32768);
    for (int k = tid; k < DM; k += NTHREADS) { f32x4 v; v.x = silu_f(c[k]); v.y = silu_f(c[DM + k]); v.z = silu_f(c[2 * DM + k]); v.w = silu_f(c[3 * DM + k]); cact[k] = v; }
    __syncthreads();
    for (int it = blockIdx.x; it < 256; it += G) {
        const int l = it >> 7, n0 = (it & 127) * 96;
        float a0[4] = {0.f, 0.f, 0.f, 0.f}, a1[4] = {0.f, 0.f, 0.f, 0.f};
        if (lane < 48) {
            const float* wp = mod_w + ((size_t)l * DM + wave * 256) * 12288 + n0 + 2 * lane;
#pragma unroll 8
            for (int k = 0; k < 256; ++k) { const f32x2 w = *(const f32x2*)(wp + (size_t)k * 12288); const f32x4 cv = cact[wave * 256 + k];
                a0[0] += cv.x * w.x; a1[0] += cv.x * w.y; a0[1] += cv.y * w.x; a1[1] += cv.y * w.y; a0[2] += cv.z * w.x; a1[2] += cv.z * w.y; a0[3] += cv.w * w.x; a1[3] += cv.w * w.y; }
#pragma unroll
            for (int b = 0; b < 4; ++b) { red[(wave * 4 + b) * 96 + 2 * lane] = a0[b]; red[(wave * 4 + b) * 96 + 2 * lane + 1] = a1[b]; }
        }
        __syncthreads();
        if (tid < 384) { const int b = tid / 96, col = tid % 96; float s = mod_b[l * 12288 + n0 + col];
#pragma unroll
            for (int w = 0; w < 8; ++w) s += red[(w * 4 + b) * 96 + col];
            mod[((size_t)l * 4 + b) * 12288 + n0 + col] = s; }
        __syncthreads();
    }
}

template <int MODE>
DI void cvt_item(const float* W, int K, int N, bf16_t* WT, LAS float* scr, int kb, int nb, int lane) {
    const int k0 = 64 * kb, n0 = 32 * nb;
    float v[32];
    const float* wp = W + (size_t)(k0 + (lane >> 5)) * N + n0 + (lane & 31);
#pragma unroll
    for (int i = 0; i < 32; ++i) v[i] = wp[(size_t)(2 * i) * N];
#pragma unroll
    for (int i = 0; i < 32; ++i) scr[(2 * i + (lane >> 5)) * 33 + (lane & 31)] = v[i];
    LDS_WAIT();
    const int c = lane & 7;
#pragma unroll
    for (int j = 0; j < 4; ++j) { const int n = (lane >> 3) + 8 * j; const LAS float* s = scr + (8 * c) * 33 + n;
        u32x4 o; o.x = cvt_pk_bf16(s[0 * 33], s[1 * 33]); o.y = cvt_pk_bf16(s[2 * 33], s[3 * 33]); o.z = cvt_pk_bf16(s[4 * 33], s[5 * 33]); o.w = cvt_pk_bf16(s[6 * 33], s[7 * 33]);
        const int ng = n0 + n; const int row = (MODE == 0) ? ng : ((ng >> 7) * 256 + (ng & 127) + (MODE == 2 ? 128 : 0));
        *(u32x4*)(WT + (size_t)row * K + k0 + 8 * c) = o; }
    LDS_WAIT();
}
template <int MODE>
DI void cvt_item8(const float* W, int K, int N, unsigned char* WT, LAS float* scr, int kb, int nb, int lane, float wsc) {
    const int k0 = 64 * kb, n0 = 32 * nb;
    float v[32];
    const float* wp = W + (size_t)(k0 + (lane >> 5)) * N + n0 + (lane & 31);
#pragma unroll
    for (int i = 0; i < 32; ++i) v[i] = wp[(size_t)(2 * i) * N];
#pragma unroll
    for (int i = 0; i < 32; ++i) scr[(2 * i + (lane >> 5)) * 33 + (lane & 31)] = v[i] * wsc;
    LDS_WAIT();
    const int c = lane & 3;
#pragma unroll
    for (int j = 0; j < 2; ++j) { const int n = (lane >> 2) + 16 * j; const LAS float* s = scr + (16 * c) * 33 + n;
        u32x4 o; o.x = pk4_fp8(s[0 * 33], s[1 * 33], s[2 * 33], s[3 * 33]); o.y = pk4_fp8(s[4 * 33], s[5 * 33], s[6 * 33], s[7 * 33]);
        o.z = pk4_fp8(s[8 * 33], s[9 * 33], s[10 * 33], s[11 * 33]); o.w = pk4_fp8(s[12 * 33], s[13 * 33], s[14 * 33], s[15 * 33]);
        const int ng = n0 + n; const int row = (MODE == 0) ? ng : ((ng >> 7) * 256 + (ng & 127) + (MODE == 2 ? 128 : 0));
        *(u32x4*)(WT + (size_t)row * K + k0 + 16 * c) = o; }
    LDS_WAIT();
}
template <int MODE>
DI void cvt_job8(const float* W, int K, int N, int nbatch, unsigned char* WT, size_t dst_bstride, LAS float* scr, int gw, int NGW, int lane, float wsc) {
    const int nnb = N / 32, per = (K / 64) * nnb, total = per * nbatch;
    for (int it = gw; it < total; it += NGW) {
        const int bt = it / per, r = it - bt * per, kb = r / nnb, nb = r - kb * nnb;
        cvt_item8<MODE>(W + (size_t)bt * K * N, K, N, WT + (size_t)bt * dst_bstride, scr, kb, nb, lane, wsc);
    }
}
template <int MODE>
DI void cvt_job(const float* W, int K, int N, int nbatch, bf16_t* WT, size_t dst_bstride, LAS float* scr, int gw, int NGW, int lane) {
    const int nnb = N / 32, per = (K / 64) * nnb, total = per * nbatch;
    for (int it = gw; it < total; it += NGW) {
        const int bt = it / per, r = it - bt * per, kb = r / nnb, nb = r - kb * nnb;
        cvt_item<MODE>(W + (size_t)bt * K * N, K, N, WT + (size_t)bt * dst_bstride, scr, kb, nb, lane);
    }
}

DI void cvtw_load(f32x4 (&v)[16], const float* wp, int N) {
#pragma unroll
    for (int i = 0; i < 16; ++i) v[i] = __builtin_nontemporal_load((const f32x4*)(wp + (size_t)(4 * i) * N));
}
template <int MODE, bool OUT8>
DI void cvtw_store(const f32x4 (&v)[16], int K, void* WTb, LAS float* scr, int k0, int n0, int lane, float wsc) {
    const int kr = lane >> 4, n4 = lane & 15;
#pragma unroll
    for (int i = 0; i < 16; ++i)
#pragma unroll
        for (int e = 0; e < 4; ++e) scr[(4 * n4 + e) * 65 + 4 * i + kr] = OUT8 ? v[i][e] * wsc : v[i][e];
    LDS_WAIT();
    if (OUT8) {
        unsigned char* WT = (unsigned char*)WTb; const int c = lane & 3;
#pragma unroll
        for (int j = 0; j < 4; ++j) { const int n = (lane >> 2) + 16 * j; const LAS float* s = scr + n * 65 + 16 * c;
            u32x4 o; o.x = pk4_fp8(s[0], s[1], s[2], s[3]); o.y = pk4_fp8(s[4], s[5], s[6], s[7]); o.z = pk4_fp8(s[8], s[9], s[10], s[11]); o.w = pk4_fp8(s[12], s[13], s[14], s[15]);
            const int ng = n0 + n; const int row = (MODE == 0) ? ng : ((ng >> 7) * 256 + (ng & 127) + (MODE == 2 ? 128 : 0));
            *(u32x4*)(WT + (size_t)row * K + k0 + 16 * c) = o; }
    } else {
        bf16_t* WT = (bf16_t*)WTb; const int c = lane & 7;
#pragma unroll
        for (int j = 0; j < 8; ++j) { const int n = (lane >> 3) + 8 * j; const LAS float* s = scr + n * 65 + 8 * c;
            u32x4 o; o.x = cvt_pk_bf16(s[0], s[1]); o.y = cvt_pk_bf16(s[2], s[3]); o.z = cvt_pk_bf16(s[4], s[5]); o.w = cvt_pk_bf16(s[6], s[7]);
            const int ng = n0 + n; const int row = (MODE == 0) ? ng : ((ng >> 7) * 256 + (ng & 127) + (MODE == 2 ? 128 : 0));
            *(u32x4*)(WT + (size_t)row * K + k0 + 8 * c) = o; }
    }
    LDS_WAIT();
}
DI void cvtw_pack8(const f32x4 (&v)[16], LAS float* scr, int lane, float wsc, u32x4 (&o)[4]) {
    const int kr = lane >> 4, n4 = lane & 15;
#pragma unroll
    for (int i = 0; i < 16; ++i)
#pragma unroll
        for (int e = 0; e < 4; ++e) scr[(4 * n4 + e) * 65 + 4 * i + kr] = v[i][e] * wsc;
    LDS_WAIT();
    const int c = lane & 3;
#pragma unroll
    for (int j = 0; j < 4; ++j) { const int n = (lane >> 2) + 16 * j; const LAS float* s = scr + n * 65 + 16 * c;
        o[j].x = pk4_fp8(s[0], s[1], s[2], s[3]); o[j].y = pk4_fp8(s[4], s[5], s[6], s[7]); o[j].z = pk4_fp8(s[8], s[9], s[10], s[11]); o[j].w = pk4_fp8(s[12], s[13], s[14], s[15]); }
    LDS_WAIT();
}
template <int MODE, bool OUT8>
DI void cvtw_job(const float* W, int K, int N, int nbatch, void* WT, size_t dst_bstride_bytes, LAS float* scr, int gw, int NGW, int lane, float wsc, int ld = 0) {
    const int nnb = N / 64, per = (K / 128) * nnb, total = per * nbatch;
    for (int it = gw; it < total; it += NGW) {
        const int bt = it / per, r = it - bt * per, kb = r / nnb, nb = r - kb * nnb, k0 = 128 * kb, n0 = 64 * nb;
        const int pitch = ld ? ld : N;
        const float* wp = W + (size_t)bt * K * pitch + (size_t)(k0 + (lane >> 4)) * pitch + n0 + 4 * (lane & 15);
        f32x4 v0[16], v1[16];
        cvtw_load(v0, wp, pitch); cvtw_load(v1, wp + (size_t)64 * pitch, pitch);
        void* WTb = (unsigned char*)WT + (size_t)bt * dst_bstride_bytes;
        if (OUT8) {
            u32x4 o0[4], o1[4]; cvtw_pack8(v0, scr, lane, wsc, o0); cvtw_pack8(v1, scr, lane, wsc, o1);
            unsigned char* WT8 = (unsigned char*)WTb; const int c = lane & 3;
#pragma unroll
            for (int j = 0; j < 4; ++j) { const int ng = n0 + (lane >> 2) + 16 * j; const int row = (MODE == 0) ? ng : ((ng >> 7) * 256 + (ng & 127) + (MODE == 2 ? 128 : 0));
                unsigned char* dp = WT8 + (size_t)row * K + k0 + 16 * c; *(u32x4*)dp = o0[j]; *(u32x4*)(dp + 64) = o1[j]; }
        } else {
            cvtw_store<MODE, OUT8>(v0, K, WTb, scr, k0, n0, lane, wsc);
            cvtw_store<MODE, OUT8>(v1, K, WTb, scr, k0 + 64, n0, lane, wsc);
        }
    }
}

constexpr float HSCALE = 8.f, WSCALE = 256.f, ASCALE = 8.f;
template <bool ROUTER, bool OUT8 = false, bool X16 = false>
DI void rms_mod_phase(const void* X, const float* g, const float* scale, const float* shift, bf16_t* out,
                      const float* router, int* tok_e, int* tok_pos, float* tok_w, unsigned* ecnt, unsigned char* HS2, int gw, int NGW, int lane) {
    for (int row = gw; row < MTOK; row += NGW) {
        const int b = row >> 11;
        f32x4 v[8]; float ss = 0.f;
        if (X16) { const u32x2* xr = (const u32x2*)((const bf16_t*)X + (size_t)row * DM) + lane; u32x2 raw[8];
#pragma unroll
            for (int j = 0; j < 8; ++j) raw[j] = xr[64 * j];
#pragma unroll
            for (int j = 0; j < 8; ++j) v[j] = (f32x4){bf_lo(raw[j].x), bf_hi(raw[j].x), bf_lo(raw[j].y), bf_hi(raw[j].y)}; }
        else { const f32x4* xr = (const f32x4*)((const float*)X + (size_t)row * DM) + lane;
#pragma unroll
            for (int j = 0; j < 8; ++j) v[j] = xr[64 * j]; }
#pragma unroll
        for (int j = 0; j < 8; ++j) ss += (v[j].x * v[j].x + v[j].y * v[j].y) + (v[j].z * v[j].z + v[j].w * v[j].w);
        const float rstd = 1.0f / sqrtf(wave_sum(ss) * (1.f / DM) + 1e-6f);
        const f32x4* gp = (const f32x4*)g + lane; const f32x4* sc = (const f32x4*)(scale + (size_t)b * 12288) + lane; const f32x4* sh = (const f32x4*)(shift + (size_t)b * 12288) + lane;
        u32x2* op = (u32x2*)(out + (size_t)row * DM) + lane;
        float lg[8] = {0.f, 0.f, 0.f, 0.f, 0.f, 0.f, 0.f, 0.f}; unsigned h8[8];
#pragma unroll
        for (int j = 0; j < 8; ++j) { const f32x4 gg = gp[64 * j], s1 = sc[64 * j], s2 = sh[64 * j];
            f32x4 h = (v[j] * rstd) * gg; h = h * (s1 + 1.0f) + s2;
            if (ROUTER) { h8[j] = pk4_fp8(h.x * HSCALE, h.y * HSCALE, h.z * HSCALE, h.w * HSCALE); }
            else { u32x2 w; w.x = cvt_pk_bf16(h.x, h.y); w.y = cvt_pk_bf16(h.z, h.w); op[64 * j] = w;
                   if (OUT8) ((unsigned*)(HS2 + (size_t)row * DM) + lane)[64 * j] = pk4_fp8(h.x * HSCALE, h.y * HSCALE, h.z * HSCALE, h.w * HSCALE); }
            if (ROUTER) {
#pragma unroll
                for (int i = 0; i < 4; ++i) { const int cc = 256 * j + 4 * lane + i; const f32x4 r0 = ((const f32x4*)router)[cc * 2], r1 = ((const f32x4*)router)[cc * 2 + 1];
                    lg[0] += h[i] * r0.x; lg[1] += h[i] * r0.y; lg[2] += h[i] * r0.z; lg[3] += h[i] * r0.w; lg[4] += h[i] * r1.x; lg[5] += h[i] * r1.y; lg[6] += h[i] * r1.z; lg[7] += h[i] * r1.w; } } }
        if (ROUTER) {
#pragma unroll
            for (int e = 0; e < 8; ++e) lg[e] = wave_sum(lg[e]);
            if (lane == 0) {
                int i0 = 0; float v0 = lg[0];
#pragma unroll
                for (int e = 1; e < 8; ++e) if (lg[e] > v0) { v0 = lg[e]; i0 = e; }
                int i1 = -1; float v1 = -3.0e38f;
#pragma unroll
                for (int e = 0; e < 8; ++e) if (e != i0 && lg[e] > v1) { v1 = lg[e]; i1 = e; }
                const float w1 = 1.f / (1.f + expf(v0 - v1)), w0 = 1.f - w1;
                const int p0 = (int)__hip_atomic_fetch_add(ecnt + 64 * i0, 1u, __ATOMIC_RELAXED, __HIP_MEMORY_SCOPE_AGENT);
                const int p1 = (int)__hip_atomic_fetch_add(ecnt + 64 * i1, 1u, __ATOMIC_RELAXED, __HIP_MEMORY_SCOPE_AGENT);
                tok_e[2 * row] = i0; tok_e[2 * row + 1] = i1; tok_pos[2 * row] = p0; tok_pos[2 * row + 1] = p1; tok_w[2 * row] = w0; tok_w[2 * row + 1] = w1;
                lg[0] = __int_as_float(i0 * pg8::ECAP + p0); lg[1] = __int_as_float(i1 * pg8::ECAP + p1);
            }
            const int ra = __builtin_amdgcn_readfirstlane(__float_as_int(lg[0])), rb = __builtin_amdgcn_readfirstlane(__float_as_int(lg[1]));
            unsigned* da = (unsigned*)(HS2 + (size_t)ra * DM) + lane; unsigned* db = (unsigned*)(HS2 + (size_t)rb * DM) + lane;
#pragma unroll
            for (int j = 0; j < 8; ++j) { da[64 * j] = h8[j]; db[64 * j] = h8[j]; }
        }
    }
}

DI void qknorm_phase(const bf16_t* QK, bf16_t* QKN, const float* qg, const float* kg, int gw, int NGW, int lane) {
    const int l16 = lane & 15;
    for (int idx = gw * 4 + (lane >> 4); idx < MTOK * 32; idx += NGW * 4) {
        const int hr = idx & 31; const size_t off = (size_t)(idx >> 5) * 4096 + hr * 128 + 8 * l16;
        const u32x4 raw = *(const u32x4*)(QK + off);
        float x[8] = {bf_lo(raw.x), bf_hi(raw.x), bf_lo(raw.y), bf_hi(raw.y), bf_lo(raw.z), bf_hi(raw.z), bf_lo(raw.w), bf_hi(raw.w)};
        float ss = 0.f;
#pragma unroll
        for (int i = 0; i < 8; ++i) ss += x[i] * x[i];
        ss += __shfl_xor(ss, 1); ss += __shfl_xor(ss, 2); ss += __shfl_xor(ss, 4); ss += __shfl_xor(ss, 8);
        const float rstd = (1.0f / sqrtf(ss * (1.f / 128.f) + 1e-6f)) * (hr < 16 ? 0.08838834764831845f : 1.0f);
        const float* gp = (hr < 16 ? qg : kg) + 8 * l16;
        const f32x4 g0 = *(const f32x4*)gp, g1 = *(const f32x4*)(gp + 4);
        u32x4 o; o.x = cvt_pk_bf16(x[0] * rstd * g0.x, x[1] * rstd * g0.y); o.y = cvt_pk_bf16(x[2] * rstd * g0.z, x[3] * rstd * g0.w);
        o.z = cvt_pk_bf16(x[4] * rstd * g1.x, x[5] * rstd * g1.y); o.w = cvt_pk_bf16(x[6] * rstd * g1.z, x[7] * rstd * g1.w);
        *(u32x4*)(QKN + off) = o;
    }
}

constexpr int NA_TBL = 0, NA_BUF = 30720, NA_TILE = 18432;
DI void na_phase(const bf16_t* QKN, const bf16_t* VT, bf16_t* ATT, const float* rpb, LAS unsigned char* lds, int G, int vcu0, int tid, int lane, int wave) {
    LAS float* rpbL = (LAS float*)(lds + NA_TBL);
    for (int i = tid; i < 16 * 465; i += NTHREADS) rpbL[i] = rpb[i];
    const int c16 = lane & 15, g = lane >> 4, unit = wave >> 2, j = wave & 3;
    const int cb = (j == 0) ? 0 : (j == 1) ? 8 : (j == 2) ? 24 : 32;
    const int qc = 16 * j + c16, c0 = min(max(qc - 8, 0), 48);
    const int kcl = 8 * (c16 >> 2) + (c16 & 3);
    for (int p = vcu0; p < 1024; p += G) {
        const int rho = p & 15, hh = (p >> 4) & 15, b = p >> 8;
        const int rA = 2 * rho, r0A = min(max(rA - 4, 0), 24), r0B = min(max(rA + 1 - 4, 0), 24), delta = r0B - r0A, nrows = 8 + delta;
        const int r = rA + unit, r0 = unit ? r0B : r0A;
        const bool shiftB = (unit == 1) && (delta == 1);
        const size_t tq = (size_t)b * SEQ + r * 64 + qc;
        bf16x8 qf[4];
#pragma unroll
        for (int ks = 0; ks < 4; ++ks) qf[ks] = *(const bf16x8*)(QKN + tq * 4096 + hh * 128 + 32 * ks + 8 * g);
        f32x4 S[8][2];
        u32x4 st0, st1;
        const int kkey = tid >> 3, kch = tid & 7;
        const int vd = tid >> 2, vch = tid & 3;
        const bf16_t* kg = QKN + ((size_t)b * SEQ + (size_t)r0A * 64 + kkey) * 4096 + 2048 + hh * 128 + kch * 8;
        const bf16_t* vg = VT + (size_t)(hh * 128 + vd) * MTOK + (size_t)b * SEQ + (size_t)r0A * 64 + vch * 8;
#define NA_LDK(s_) do { st0 = *(const u32x4*)(kg + (size_t)(s_) * 64 * 4096); st1 = *(const u32x4*)(kg + (size_t)(s_) * 64 * 4096 + 64); } while (0)
#define NA_STK(s_) do { LAS unsigned char* t_ = lds + NA_BUF + ((s_) & 1) * NA_TILE + kkey * 272 + kch * 16; *(LAS u32x4*)t_ = st0; *(LAS u32x4*)(t_ + 128) = st1; } while (0)
#define NA_LDV(s_) do { st0 = *(const u32x4*)(vg + (s_) * 64); st1 = *(const u32x4*)(vg + (s_) * 64 + 32); } while (0)
#define NA_STV(s_) do { LAS unsigned char* t_ = lds + NA_BUF + ((s_) & 1) * NA_TILE + vd * 144 + vch * 16; *(LAS u32x4*)t_ = st0; *(LAS u32x4*)(t_ + 64) = st1; } while (0)
#define NA_QK(s_, i_) do { const LAS unsigned char* kb_ = lds + NA_BUF + ((s_) & 1) * NA_TILE + (cb + kcl) * 272 + 16 * g; \
            _Pragma("unroll") for (int hc = 0; hc < 2; ++hc) { f32x4 a = (f32x4){0.f, 0.f, 0.f, 0.f}; \
                _Pragma("unroll") for (int ks = 0; ks < 4; ++ks) a = __builtin_amdgcn_mfma_f32_16x16x32_bf16(*(const LAS bf16x8*)(kb_ + hc * 4 * 272 + 64 * ks), qf[ks], a, 0, 0, 0); S[i_][hc] = a; } } while (0)
#define NA_SROW(s_) do { if ((s_) < nrows) { NA_STK(s_); __syncthreads(); if ((s_) + 1 < nrows) NA_LDK((s_) + 1); \
            if (!shiftB) { if ((s_) < 8) NA_QK(s_, (s_) < 8 ? (s_) : 7); } else { if ((s_) >= 1) NA_QK(s_, (s_) >= 1 ? (s_) - 1 : 0); } } } while (0)
        __syncthreads();
        NA_LDK(0);
        NA_SROW(0); NA_SROW(1); NA_SROW(2); NA_SROW(3); NA_SROW(4); NA_SROW(5); NA_SROW(6); NA_SROW(7); NA_SROW(8);
        NA_LDV(0);
        float mx = -3.0e38f;
        const LAS float* bt = rpbL + hh * 465;
#pragma unroll
        for (int i = 0; i < 8; ++i)
#pragma unroll
            for (int hc = 0; hc < 2; ++hc)
#pragma unroll
                for (int e = 0; e < 4; ++e) {
                    const int kc = cb + 8 * g + 4 * hc + e; const bool valid = (kc >= c0) && (kc < c0 + 16);
                    const int dj = min(max(kc - qc + 15, 0), 30), di = r0 + i - r + 7;
                    const float sv = valid ? S[i][hc][e] + bt[di * 31 + dj] : -3.0e38f;
                    S[i][hc][e] = sv; mx = fmaxf(mx, sv);
                }
        mx = fmaxf(mx, __shfl_xor(mx, 16)); mx = fmaxf(mx, __shfl_xor(mx, 32));
        float sum = 0.f;
#pragma unroll
        for (int i = 0; i < 8; ++i)
#pragma unroll
            for (int hc = 0; hc < 2; ++hc)
#pragma unroll
                for (int e = 0; e < 4; ++e) { const float pv = (S[i][hc][e] > -1.0e38f) ? __expf(S[i][hc][e] - mx) : 0.f; S[i][hc][e] = pv; sum += pv; }
        sum += __shfl_xor(sum, 16); sum += __shfl_xor(sum, 32);
        const float inv = 1.0f / sum;
        f32x4 O[8];
#pragma unroll
        for (int dt = 0; dt < 8; ++dt) O[dt] = (f32x4){0.f, 0.f, 0.f, 0.f};
#define NA_PV(s_, i_) do { u32x4 pw; pw.x = cvt_pk_bf16(S[i_][0][0], S[i_][0][1]); pw.y = cvt_pk_bf16(S[i_][0][2], S[i_][0][3]); pw.z = cvt_pk_bf16(S[i_][1][0], S[i_][1][1]); pw.w = cvt_pk_bf16(S[i_][1][2], S[i_][1][3]); \
            const bf16x8 pf = __builtin_bit_cast(bf16x8, pw); const LAS unsigned char* vb_ = lds + NA_BUF + ((s_) & 1) * NA_TILE + c16 * 144 + (cb + 8 * g) * 2; \
            _Pragma("unroll") for (int dt = 0; dt < 8; ++dt) O[dt] = __builtin_amdgcn_mfma_f32_16x16x32_bf16(*(const LAS bf16x8*)(vb_ + dt * 16 * 144), pf, O[dt], 0, 0, 0); } while (0)
#define NA_VROW(s_) do { if ((s_) < nrows) { NA_STV(s_); __syncthreads(); if ((s_) + 1 < nrows) NA_LDV((s_) + 1); \
            if (!shiftB) { if ((s_) < 8) NA_PV(s_, (s_) < 8 ? (s_) : 7); } else { if ((s_) >= 1) NA_PV(s_, (s_) >= 1 ? (s_) - 1 : 0); } } } while (0)
        __syncthreads();
        NA_VROW(0); NA_VROW(1); NA_VROW(2); NA_VROW(3); NA_VROW(4); NA_VROW(5); NA_VROW(6); NA_VROW(7); NA_VROW(8);
#undef NA_LDK
#undef NA_STK
#undef NA_LDV
#undef NA_STV
#undef NA_QK
#undef NA_SROW
#undef NA_PV
#undef NA_VROW
#pragma unroll
        for (int dt = 0; dt < 8; ++dt) { u32x2 w; w.x = cvt_pk_bf16(O[dt][0] * inv, O[dt][1] * inv); w.y = cvt_pk_bf16(O[dt][2] * inv, O[dt][3] * inv);
            *(u32x2*)(ATT + tq * DM + hh * 128 + 16 * dt + 4 * g) = w; }
    }
}

constexpr int MLP_WIF = 36864, MLP_WROW = 3088;
DI void ml_pre_phase(const bf16_t* XZ, const float* conv_w, const float* conv_b, const float* wq, const float* wk, const float* wv, const bf16_t* WTif,
                     bf16_t* XC, bf16_t* Q, bf16_t* Kb, bf16_t* V, float* pre_part, LAS unsigned char* lds, int G, int tid, int lane, int wave) {
    LAS float* Lcw = (LAS float*)lds;
    LAS float* Lcb = Lcw + 2560;
    LAS float* Lwq = Lcb + 512;
    LAS float* Lwk = Lwq + 2048;
    LAS float* Lwv = Lwk + 2048;
    LAS unsigned char* Lwif = lds + MLP_WIF;
    const int g = lane >> 4, tk = lane & 15;
    for (int item = blockIdx.x; item < 256; item += G) {
        const int hd = item & 7, tr = item >> 3;
        __syncthreads();
        for (int i = tid; i < 2560; i += NTHREADS) Lcw[i] = conv_w[(i >> 9) * 4096 + hd * 512 + (i & 511)];
        Lcb[tid] = conv_b[hd * 512 + tid];
        for (int i = tid; i < 2048; i += NTHREADS) { Lwq[i] = wq[hd * 2048 + i]; Lwk[i] = wk[hd * 2048 + i]; Lwv[i] = wv[hd * 2048 + i]; }
        for (int i = tid; i < 32 * 3 * 64; i += NTHREADS) { const int n = i / 192, rem = i - n * 192, sec = rem >> 6, c16 = rem & 63;
            *(LAS u32x4*)(Lwif + n * MLP_WROW + sec * 1024 + c16 * 16) = *(const u32x4*)(WTif + (size_t)n * 12288 + sec * 4096 + hd * 512 + c16 * 8); }
        __syncthreads();
        for (int tt = wave; tt < 16; tt += 8) {
            const int tok = tr * 256 + tt * 16 + tk, tseq = tok & 2047;
            f32x4 accp[2]; accp[0] = (f32x4){0.f, 0.f, 0.f, 0.f}; accp[1] = (f32x4){0.f, 0.f, 0.f, 0.f};
            u32x4 xrA[5], xrB[5], hq, hk, hv, hc;
#define MLP_LOAD(xr_, step_) do { const int ch_ = hd * 512 + (step_) * 32 + 8 * g; \
                _Pragma("unroll") for (int jt = 0; jt < 5; ++jt) { const int dt = jt - 2; const bool ok = (unsigned)(tseq + dt) < (unsigned)SEQ; \
                    xr_[jt] = (u32x4){0u, 0u, 0u, 0u}; if (ok) xr_[jt] = *(const u32x4*)(XZ + (size_t)(tok + dt) * 8192 + ch_); } } while (0)
#define MLP_COMPUTE(xr_, step_, HOLD_) do { \
                const int cl = (step_) * 32 + 8 * g, ch = hd * 512 + cl; \
                float a[8], xm[8]; \
                { const f32x4 b0 = *(const LAS f32x4*)(Lcb + cl), b1 = *(const LAS f32x4*)(Lcb + cl + 4); \
                  a[0] = b0.x; a[1] = b0.y; a[2] = b0.z; a[3] = b0.w; a[4] = b1.x; a[5] = b1.y; a[6] = b1.z; a[7] = b1.w; } \
                _Pragma("unroll") for (int jt = 0; jt < 5; ++jt) { \
                    const u32x4 xr = xr_[jt]; \
                    const float xv[8] = {bf_lo(xr.x), bf_hi(xr.x), bf_lo(xr.y), bf_hi(xr.y), bf_lo(xr.z), bf_hi(xr.z), bf_lo(xr.w), bf_hi(xr.w)}; \
                    const f32x4 w0 = *(const LAS f32x4*)(Lcw + jt * 512 + cl), w1 = *(const LAS f32x4*)(Lcw + jt * 512 + cl + 4); \
                    a[0] += xv[0] * w0.x; a[1] += xv[1] * w0.y; a[2] += xv[2] * w0.z; a[3] += xv[3] * w0.w; a[4] += xv[4] * w1.x; a[5] += xv[5] * w1.y; a[6] += xv[6] * w1.z; a[7] += xv[7] * w1.w; \
                    if (jt == 2) { _Pragma("unroll") for (int i = 0; i < 8; ++i) xm[i] = xv[i]; } } \
                float xc[8], q[8], k[8], v[8]; \
                _Pragma("unroll") for (int i = 0; i < 8; ++i) xc[i] = silu_f(a[i]); \
                _Pragma("unroll") for (int blk = 0; blk < 2; ++blk) { const int wo = ((cl >> 2) + blk) * 16; \
                    _Pragma("unroll") for (int o = 0; o < 4; ++o) { float sq = 0.f, sk = 0.f, sv = 0.f; \
                        _Pragma("unroll") for (int i = 0; i < 4; ++i) { sq += xc[4 * blk + i] * Lwq[wo + i * 4 + o]; sk += xc[4 * blk + i] * Lwk[wo + i * 4 + o]; sv += xm[4 * blk + i] * Lwv[wo + i * 4 + o]; } \
                        q[4 * blk + o] = sq; k[4 * blk + o] = sk; v[4 * blk + o] = sv; } } \
                u32x4 qw, kw, vw, cw; \
                qw.x = cvt_pk_bf16(q[0], q[1]); qw.y = cvt_pk_bf16(q[2], q[3]); qw.z = cvt_pk_bf16(q[4], q[5]); qw.w = cvt_pk_bf16(q[6], q[7]); \
                kw.x = cvt_pk_bf16(k[0], k[1]); kw.y = cvt_pk_bf16(k[2], k[3]); kw.z = cvt_pk_bf16(k[4], k[5]); kw.w = cvt_pk_bf16(k[6], k[7]); \
                vw.x = cvt_pk_bf16(v[0], v[1]); vw.y = cvt_pk_bf16(v[2], v[3]); vw.z = cvt_pk_bf16(v[4], v[5]); vw.w = cvt_pk_bf16(v[6], v[7]); \
                cw.x = cvt_pk_bf16(xc[0], xc[1]); cw.y = cvt_pk_bf16(xc[2], xc[3]); cw.z = cvt_pk_bf16(xc[4], xc[5]); cw.w = cvt_pk_bf16(xc[6], xc[7]); \
                const size_t o4 = (size_t)tok * 4096 + ch; \
                if (HOLD_) { hq = qw; hk = kw; hv = vw; hc = cw; }     \
                else { *(u32x4*)(Q + o4 - 32) = hq; *(u32x4*)(Q + o4) = qw; *(u32x4*)(Kb + o4 - 32) = hk; *(u32x4*)(Kb + o4) = kw; *(u32x4*)(V + o4 - 32) = hv; *(u32x4*)(V + o4) = vw; *(u32x4*)(XC + o4 - 32) = hc; *(u32x4*)(XC + o4) = cw; } \
                const bf16x8 qf = __builtin_bit_cast(bf16x8, qw), kf = __builtin_bit_cast(bf16x8, kw), vf = __builtin_bit_cast(bf16x8, vw); \
                _Pragma("unroll") for (int nt = 0; nt < 2; ++nt) { const LAS unsigned char* wp = Lwif + (nt * 16 + tk) * MLP_WROW + cl * 2; \
                    accp[nt] = __builtin_amdgcn_mfma_f32_16x16x32_bf16(qf, *(const LAS bf16x8*)(wp), accp[nt], 0, 0, 0); \
                    accp[nt] = __builtin_amdgcn_mfma_f32_16x16x32_bf16(kf, *(const LAS bf16x8*)(wp + 1024), accp[nt], 0, 0, 0); \
                    accp[nt] = __builtin_amdgcn_mfma_f32_16x16x32_bf16(vf, *(const LAS bf16x8*)(wp + 2048), accp[nt], 0, 0, 0); } } while (0)
            MLP_LOAD(xrA, 0);
#pragma unroll 1
            for (int step = 0; step < 16; step += 2) {
                MLP_LOAD(xrB, step + 1);
                MLP_COMPUTE(xrA, step, true);
                { const int sn = (step + 2 < 16) ? step + 2 : 15; MLP_LOAD(xrA, sn); }
                MLP_COMPUTE(xrB, step + 1, false);
            }
#undef MLP_LOAD
#undef MLP_COMPUTE
#pragma unroll
            for (int nt = 0; nt < 2; ++nt)
#pragma unroll
                for (int e = 0; e < 4; ++e) pre_part[((size_t)hd * 32 + nt * 16 + tk) * MTOK + tr * 256 + tt * 16 + 4 * g + e] = accp[nt][e];
        }
    }
}

constexpr int ML_QS0 = 0, ML_KS0 = 16384, ML_QS1 = 32768, ML_KS1 = 49152, ML_VS0 = 65536, ML_VS1 = 81920, ML_WV = 98304, ML_SS = 114688, ML_SM = 123904;
constexpr int ML_XS = ML_QS1, ML_XN = ML_QS1;
constexpr int GB_U = 0, GB_MR = 64, GB_W = 128, GB_INT = 192, GB_BND = 256, GB_SC = 320;
constexpr int SM_DIN0 = 768, SM_DIN1 = 832, SM_NV = 896, SM_NVP = 1408, SM_DNQP = 3456, SM_GS = 3968, SM_CMX = 4000, SM_MC = 4032, SM_END = 4096;
static_assert(ML_SM + SM_END * 4 <= LDS_BYTES - 16, "mLSTM LDS");
constexpr float KSCALE = 0.04419417382415922f;

DI s16x4 tr_read(LAS unsigned char* p) { return __builtin_amdgcn_ds_read_tr16_b64_v4i16((LAS s16x4*)p); }
DI int dimg(int row, int ch) { return 2048 * (row >> 3) + 512 * (ch >> 2) + 64 * (row & 7) + 16 * ((ch & 3) ^ ((row >> 2) & 3)); }
DI bf16x8 frag_tr(LAS unsigned char* img, int k0, int c0, int lane) {
    const int h = lane >> 5, blk = (lane >> 4) & 1, q = (lane & 15) >> 2, p = lane & 3;
    const int row = k0 + 8 * h + q, ch = (c0 >> 3) + 2 * blk + (p >> 1), sub = 8 * (p & 1);
    const s16x4 lo = tr_read(img + dimg(row, ch) + sub), hi = tr_read(img + dimg(row + 4, ch) + sub);
    return __builtin_shufflevector(lo, hi, 0, 1, 2, 3, 4, 5, 6, 7);
}
#define MFMA32(a, b, c) __builtin_amdgcn_mfma_f32_32x32x16_bf16((a), (b), (c), 0, 0, 0)
DI void tr_batch4(bf16x8 (&f)[4], unsigned alo, unsigned ahi) {
    s16x4 l0, l1, l2, l3, h0, h1, h2, h3;
    asm volatile("ds_read_b64_tr_b16 %0, %8\n\tds_read_b64_tr_b16 %4, %9\n\tds_read_b64_tr_b16 %1, %8 offset:4096\n\tds_read_b64_tr_b16 %5, %9 offset:4096\n\t"
                 "ds_read_b64_tr_b16 %2, %8 offset:8192\n\tds_read_b64_tr_b16 %6, %9 offset:8192\n\tds_read_b64_tr_b16 %3, %8 offset:12288\n\tds_read_b64_tr_b16 %7, %9 offset:12288\n\t"
                 "s_waitcnt lgkmcnt(0)"
                 : "=&v"(l0), "=&v"(l1), "=&v"(l2), "=&v"(l3), "=&v"(h0), "=&v"(h1), "=&v"(h2), "=&v"(h3) : "v"(alo), "v"(ahi) : "memory");
    f[0] = __builtin_shufflevector(l0, h0, 0, 1, 2, 3, 4, 5, 6, 7); f[1] = __builtin_shufflevector(l1, h1, 0, 1, 2, 3, 4, 5, 6, 7);
    f[2] = __builtin_shufflevector(l2, h2, 0, 1, 2, 3, 4, 5, 6, 7); f[3] = __builtin_shufflevector(l3, h3, 0, 1, 2, 3, 4, 5, 6, 7);
}

DI void tr_issue4(s16x4& l0, s16x4& l1, s16x4& l2, s16x4& l3, s16x4& h0, s16x4& h1, s16x4& h2, s16x4& h3, unsigned alo, unsigned ahi) {
    asm volatile("ds_read_b64_tr_b16 %0, %8\n\tds_read_b64_tr_b16 %4, %9\n\tds_read_b64_tr_b16 %1, %8 offset:4096\n\tds_read_b64_tr_b16 %5, %9 offset:4096\n\t"
                 "ds_read_b64_tr_b16 %2, %8 offset:8192\n\tds_read_b64_tr_b16 %6, %9 offset:8192\n\tds_read_b64_tr_b16 %3, %8 offset:12288\n\tds_read_b64_tr_b16 %7, %9 offset:12288"
                 : "=&v"(l0), "=&v"(l1), "=&v"(l2), "=&v"(l3), "=&v"(h0), "=&v"(h1), "=&v"(h2), "=&v"(h3) : "v"(alo), "v"(ahi) : "memory");
}
DI void tr_wait8(s16x4& l0, s16x4& l1, s16x4& l2, s16x4& l3, s16x4& h0, s16x4& h1, s16x4& h2, s16x4& h3) {
    asm volatile("s_waitcnt lgkmcnt(0)" : "+v"(l0), "+v"(l1), "+v"(l2), "+v"(l3), "+v"(h0), "+v"(h1), "+v"(h2), "+v"(h3) :: "memory");
}
#define TR_CAT(f, l, h) do { f[0] = __builtin_shufflevector(l##0, h##0, 0, 1, 2, 3, 4, 5, 6, 7); f[1] = __builtin_shufflevector(l##1, h##1, 0, 1, 2, 3, 4, 5, 6, 7); \
        f[2] = __builtin_shufflevector(l##2, h##2, 0, 1, 2, 3, 4, 5, 6, 7); f[3] = __builtin_shufflevector(l##3, h##3, 0, 1, 2, 3, 4, 5, 6, 7); } while (0)

template <int I>
DI void ml_step(LAS unsigned char* lds, u32x4 (&Cp)[8][2], f32x16 (&num)[2], f32x16& Sacc, float& dnq, int tid, int lane, int wave, int gb) {
    asm volatile("" : "+v"(lane)); asm volatile("" : "+v"(tid));
    constexpr int QS = (I & 1) ? ML_QS1 : ML_QS0, KS = (I & 1) ? ML_KS1 : ML_KS0;
    const int r = lane & 31, h = lane >> 5, vt = wave & 3, dpar = wave >> 2;
    LAS float* SM = (LAS float*)(lds + ML_SM);
#define ML_SEC1 { const int wS = wave & 3, st = wS >> 1, tt1 = wS & 1, kh = wave >> 2; \
      if (!(st == 1 && tt1 == 0)) { \
        _Pragma("unroll") for (int ks = 0; ks < 4; ++ks) { const int kk = 4 * kh + ks; \
            const bf16x8 a = *(const LAS bf16x8*)(lds + KS + dimg(32 * st + r, 2 * kk + h)); \
            const bf16x8 b = *(const LAS bf16x8*)(lds + QS + dimg(32 * tt1 + r, 2 * kk + h)); \
            Sacc = MFMA32(a, b, Sacc); } } }
#define ML_SEC4 { _Pragma("unroll") for (int jj = 0; jj < 2; ++jj) { const int dl = dpar + 2 * jj; \
        _Pragma("unroll") for (int s2 = 0; s2 < 2; ++s2) { const bf16x8 a = __builtin_bit_cast(bf16x8, Cp[2 * I + jj][s2]); \
            _Pragma("unroll") for (int tt = 0; tt < 2; ++tt) { LAS unsigned char* qb = lds + QS + 8 * h; \
                const s16x4 lo = *(const LAS s16x4*)(qb + dimg(32 * tt + r, 4 * dl + 2 * s2)), hi = *(const LAS s16x4*)(qb + dimg(32 * tt + r, 4 * dl + 2 * s2 + 1)); \
                num[tt] = MFMA32(a, __builtin_shufflevector(lo, hi, 0, 1, 2, 3, 4, 5, 6, 7), num[tt]); } } } }
#define ML_UPD(jj_) { _Pragma("unroll") for (int s2 = 0; s2 < 2; ++s2) { const u32x4 o = Cp[2 * I + (jj_)][s2]; u32x4 n; \
            n.x = cvt_pk_bf16(bf_lo(o.x) * decay + U[8 * s2 + 0], bf_hi(o.x) * decay + U[8 * s2 + 1]); n.y = cvt_pk_bf16(bf_lo(o.y) * decay + U[8 * s2 + 2], bf_hi(o.y) * decay + U[8 * s2 + 3]); \
            n.z = cvt_pk_bf16(bf_lo(o.z) * decay + U[8 * s2 + 4], bf_hi(o.z) * decay + U[8 * s2 + 5]); n.w = cvt_pk_bf16(bf_lo(o.w) * decay + U[8 * s2 + 6], bf_hi(o.w) * decay + U[8 * s2 + 7]); \
            asm volatile("" : "+v"(n)); Cp[2 * I + (jj_)][s2] = n; } }
#define ML_SEC5 { const float decay = SM[gb + GB_SC + 0]; \
      const int blk = (lane >> 4) & 1, q = (lane & 15) >> 2, p = lane & 3, sub = 8 * (p & 1), rlo = 8 * h + q; \
      const unsigned ldsu = (unsigned)(size_t)lds; const int chB = 4 * vt + 2 * blk + (p >> 1), chA0 = 4 * dpar + 2 * blk + (p >> 1), chA1 = chA0 + 8; \
      s16x4 bl0, bl1, bl2, bl3, bh0, bh1, bh2, bh3, al0, al1, al2, al3, ah0, ah1, ah2, ah3, cl0, cl1, cl2, cl3, ch0, ch1, ch2, ch3; \
      tr_issue4(bl0, bl1, bl2, bl3, bh0, bh1, bh2, bh3, ldsu + ML_WV + dimg(rlo, chB) + sub, ldsu + ML_WV + dimg(rlo + 4, chB) + sub); \
      tr_issue4(al0, al1, al2, al3, ah0, ah1, ah2, ah3, ldsu + KS + dimg(rlo, chA0) + sub, ldsu + KS + dimg(rlo + 4, chA0) + sub); \
      tr_wait8(al0, al1, al2, al3, ah0, ah1, ah2, ah3); tr_wait8(bl0, bl1, bl2, bl3, bh0, bh1, bh2, bh3); \
      tr_issue4(cl0, cl1, cl2, cl3, ch0, ch1, ch2, ch3, ldsu + KS + dimg(rlo, chA1) + sub, ldsu + KS + dimg(rlo + 4, chA1) + sub); \
      bf16x8 Bf[4], Af[4]; TR_CAT(Bf, bl, bh); TR_CAT(Af, al, ah); \
      f32x16 U; \
      _Pragma("unroll") for (int e = 0; e < 16; ++e) U[e] = 0.f; \
      _Pragma("unroll") for (int ks = 0; ks < 4; ++ks) U = MFMA32(Af[ks], Bf[ks], U); \
      ML_UPD(0) \
      tr_wait8(cl0, cl1, cl2, cl3, ch0, ch1, ch2, ch3); TR_CAT(Af, cl, ch); \
      _Pragma("unroll") for (int e = 0; e < 16; ++e) U[e] = 0.f; \
      _Pragma("unroll") for (int ks = 0; ks < 4; ++ks) U = MFMA32(Af[ks], Bf[ks], U); \
      ML_UPD(1) }
#define ML_SECV { { const int t = tid & 63, dg = tid >> 6; \
      const u32x4 q0 = *(const LAS u32x4*)(lds + QS + dimg(t, 2 * dg)), q1 = *(const LAS u32x4*)(lds + QS + dimg(t, 2 * dg + 1)); \
      const LAS f32x4* nv = (const LAS f32x4*)(SM + SM_NV + 128 * I + 16 * dg); \
      const f32x4 n0 = nv[0], n1 = nv[1], n2 = nv[2], n3 = nv[3]; \
      dnq += bf_lo(q0.x) * n0.x + bf_hi(q0.x) * n0.y + bf_lo(q0.y) * n0.z + bf_hi(q0.y) * n0.w + bf_lo(q0.z) * n1.x + bf_hi(q0.z) * n1.y + bf_lo(q0.w) * n1.z + bf_hi(q0.w) * n1.w \
           + bf_lo(q1.x) * n2.x + bf_hi(q1.x) * n2.y + bf_lo(q1.y) * n2.z + bf_hi(q1.y) * n2.w + bf_lo(q1.z) * n3.x + bf_hi(q1.z) * n3.y + bf_lo(q1.w) * n3.z + bf_hi(q1.w) * n3.w; } \
    { const int dp = tid & 63, sg = tid >> 6; float a0 = 0.f, a1 = 0.f; \
      const f32x4 wA = *(const LAS f32x4*)(SM + gb + GB_W + 8 * sg), wB = *(const LAS f32x4*)(SM + gb + GB_W + 8 * sg + 4); const float ww[8] = {wA.x, wA.y, wA.z, wA.w, wB.x, wB.y, wB.z, wB.w}; \
      _Pragma("unroll") for (int s = 0; s < 8; ++s) { const unsigned kk2 = *(const LAS unsigned*)(lds + KS + dimg(8 * sg + s, dp >> 2) + 4 * (dp & 3)); a0 += ww[s] * bf_lo(kk2); a1 += ww[s] * bf_hi(kk2); } \
      ((LAS unsigned*)(SM + SM_NVP))[sg * 256 + 64 * I + dp] = cvt_pk_bf16(a0, a1); } }
    ML_SEC1 ML_SEC4 ML_SEC5 ML_SECV
#undef ML_SEC1
#undef ML_SEC4
#undef ML_UPD
#undef ML_SEC5
#undef ML_SECV
}

DI float lane_read(float v, int src_lane) { return __builtin_bit_cast(float, __builtin_amdgcn_ds_bpermute(src_lane << 2, __builtin_bit_cast(int, v))); }
DI void ml_scan(float li_, float lf_, float& u_, float& cm_, float& bs_, int lane) {
    bs_ = lf_;
#pragma unroll
    for (int o_ = 1; o_ < 64; o_ <<= 1) { const float t_ = lane_read(bs_, (lane - o_) & 63); if (lane >= o_) bs_ += t_; }
    u_ = li_ - bs_; cm_ = u_;
#pragma unroll
    for (int o_ = 1; o_ < 64; o_ <<= 1) { const float t_ = lane_read(cm_, (lane - o_) & 63); if (lane >= o_) cm_ = fmaxf(cm_, t_); }
}
DI void ml_gates(LAS float* SM, float u_, float cm_, float bs_, int gbn, float m_, float cmx_, int lane) {
    const float M_ = fmaxf(m_, cm_), Ml_ = fmaxf(m_, cmx_);
    SM[gbn + GB_U + lane] = u_; SM[gbn + GB_MR + lane] = M_; SM[gbn + GB_W + lane] = __expf(u_ - Ml_) * KSCALE; SM[gbn + GB_INT + lane] = __expf(m_ - M_); SM[gbn + GB_BND + lane] = __expf(-(bs_ + M_));
    if (lane == 0) SM[gbn + GB_SC + 0] = __expf(m_ - Ml_);
}

DI void ml_dma_piece(const bf16_t* colbase, int b, int dir, int tau0, LAS unsigned char* tile, int j, int lane) {
    const int pos = lane & 31, rin = pos >> 2, row = 8 * (j >> 1) + rin, ch = 4 * (2 * (j & 1) + (lane >> 5)) + ((pos & 3) ^ ((row >> 2) & 3));
    const int tau = tau0 + row; const size_t tok = (size_t)(b * SEQ + (dir ? SEQ - 1 - tau : tau));
    __builtin_amdgcn_global_load_lds((const unsigned*)(colbase + tok * 4096 + ch * 8), (LAS unsigned*)(tile + 1024 * j), 16, 0, 0);
}

DI void mlstm_phase(const bf16_t* Q, const bf16_t* Kb, const bf16_t* V, const float* pre_part, const float* b_if, float* GLF, bf16_t* HF, bf16_t* HB,
                    LAS unsigned char* lds, int G, int vcu0, int tid0, int lane0, int wave) {
    LAS float* SM = (LAS float*)(lds + ML_SM);
    const int vt = wave & 3, dpar = wave >> 2;
    for (int item = vcu0; item < 256; item += G) {
        const int vs = item & 3, stream = item >> 2, dir = stream & 1, hd = (stream >> 1) & 7, b = stream >> 4;
        bf16_t* H = dir ? HB : HF;
        float* glf = GLF + (size_t)item * 10240;
        const bf16_t* qcol = Q + hd * 512; const bf16_t* kcol = Kb + hd * 512; const bf16_t* vcol = V + hd * 512 + vs * 128;
        __syncthreads();
        int tidp = tid0, lanep = lane0; asm volatile("" : "+v"(tidp)); asm volatile("" : "+v"(lanep));
        for (int tau = tidp; tau < SEQ; tau += NTHREADS) {
            const int tok = b * SEQ + (dir ? SEQ - 1 - tau : tau);
            float li = b_if[dir * 16 + hd], lfr = b_if[dir * 16 + 8 + hd];
#pragma unroll
            for (int h8 = 0; h8 < 8; ++h8) { const float* pp = pre_part + ((size_t)h8 * 32 + dir * 16 + hd) * MTOK + tok; li += pp[0]; lfr += pp[(size_t)8 * MTOK]; }
            glf[tau] = li; glf[2048 + tau] = fminf(lfr, 0.f) - log1pf(__expf(-fabsf(lfr)));
        }
        SM[SM_NV + tidp] = 0.f;
        ml_dma_piece(qcol, b, dir, 0, lds + ML_QS0, 2 * wave, lanep); ml_dma_piece(qcol, b, dir, 0, lds + ML_QS0, 2 * wave + 1, lanep);
        ml_dma_piece(kcol, b, dir, 0, lds + ML_KS0, 2 * wave, lanep); ml_dma_piece(kcol, b, dir, 0, lds + ML_KS0, 2 * wave + 1, lanep);
        ml_dma_piece(vcol, b, dir, 0, lds + ML_VS0, 2 * wave, lanep); ml_dma_piece(vcol, b, dir, 0, lds + ML_VS0, 2 * wave + 1, lanep);
        asm volatile("s_waitcnt vmcnt(0)" ::: "memory");
        __syncthreads();
        float u0 = 0.f, cm0 = 0.f, bs0 = 0.f;
#pragma unroll 1
        for (int cc = wave; cc < 32; cc += 8) {
            const float lic = __hip_atomic_load(glf + 64 * cc + lanep, __ATOMIC_RELAXED, __HIP_MEMORY_SCOPE_AGENT), lfc = __hip_atomic_load(glf + 2048 + 64 * cc + lanep, __ATOMIC_RELAXED, __HIP_MEMORY_SCOPE_AGENT);
            float uu, cmm, bss; ml_scan(lic, lfc, uu, cmm, bss, lanep);
            glf[4096 + 64 * cc + lanep] = uu; glf[6144 + 64 * cc + lanep] = cmm; glf[8192 + 64 * cc + lanep] = bss;
            if (lanep == 63) { SM[SM_GS + cc] = bss; SM[SM_CMX + cc] = cmm; }
            if (cc == 0) { u0 = uu; cm0 = cmm; bs0 = bss; }
        }
        asm volatile("s_waitcnt vmcnt(0)" ::: "memory");
        __syncthreads();
        if (tidp == 0) { float m = 0.f;
#pragma unroll 1
            for (int cc = 0; cc < 32; ++cc) { SM[SM_MC + cc] = m; m = SM[SM_GS + cc] + fmaxf(m, SM[SM_CMX + cc]); } }
        __syncthreads();
        if (wave == 0) ml_gates(SM, u0, cm0, bs0, 0, 0.f, SM[SM_CMX + 0], lanep);
        __syncthreads();
#define ML_WRITE_WV(VS_, gbx_) do { const float w_ = SM[(gbx_) + GB_W + lrow]; \
        _Pragma("unroll") for (int hh_ = 0; hh_ < 2; ++hh_) { const int o_ = dimg(lrow, lcc + 8 * hh_); const u32x4 x_ = *(const LAS u32x4*)(lds + (VS_) + o_); u32x4 y_; \
            y_.x = cvt_pk_bf16(bf_lo(x_.x) * w_, bf_hi(x_.x) * w_); y_.y = cvt_pk_bf16(bf_lo(x_.y) * w_, bf_hi(x_.y) * w_); y_.z = cvt_pk_bf16(bf_lo(x_.z) * w_, bf_hi(x_.z) * w_); y_.w = cvt_pk_bf16(bf_lo(x_.w) * w_, bf_hi(x_.w) * w_); \
            *(LAS u32x4*)(lds + ML_WV + o_) = y_; } } while (0)
        { const int lrow = tidp >> 3, lcc = tidp & 7; ML_WRITE_WV(ML_VS0, 0); }
        u32x4 Cp[8][2];
#pragma unroll
        for (int j = 0; j < 8; ++j) { Cp[j][0] = (u32x4){0u, 0u, 0u, 0u}; Cp[j][1] = (u32x4){0u, 0u, 0u, 0u}; }
#pragma unroll 1
        for (int c = 0; c < 32; ++c) {
            int lane = lane0, tid = tid0; asm volatile("" : "+v"(lane)); asm volatile("" : "+v"(tid));
            const int r = lane & 31, h = lane >> 5, lrow = tid >> 3, lcc = tid & 7;
            const int gb = (c & 1) * 384, gbn = 384 - gb, cn = (c + 1 < 32) ? c + 1 : 31;
            const int VSc = (c & 1) ? ML_VS1 : ML_VS0, VSn = (c & 1) ? ML_VS0 : ML_VS1;
            f32x16 num[2], Sacc; float dnq = 0.f;
#pragma unroll
            for (int e = 0; e < 16; ++e) { num[0][e] = 0.f; num[1][e] = 0.f; Sacc[e] = 0.f; }
#define ML_DMA_QK(QS_, KS_, c_, i_) do { ml_dma_piece(qcol + 128 * (i_), b, dir, 64 * (c_), lds + (QS_), 2 * wave, lane); ml_dma_piece(qcol + 128 * (i_), b, dir, 64 * (c_), lds + (QS_), 2 * wave + 1, lane); \
                ml_dma_piece(kcol + 128 * (i_), b, dir, 64 * (c_), lds + (KS_), 2 * wave, lane); ml_dma_piece(kcol + 128 * (i_), b, dir, 64 * (c_), lds + (KS_), 2 * wave + 1, lane); } while (0)
            asm volatile("s_waitcnt vmcnt(0)" ::: "memory"); __syncthreads(); ML_DMA_QK(ML_QS1, ML_KS1, c, 1);  ml_step<0>(lds, Cp, num, Sacc, dnq, tid, lane, wave, gb);
            asm volatile("s_waitcnt vmcnt(0)" ::: "memory"); __syncthreads(); ML_DMA_QK(ML_QS0, ML_KS0, c, 2);  ml_step<1>(lds, Cp, num, Sacc, dnq, tid, lane, wave, gb);
            asm volatile("s_waitcnt vmcnt(0)" ::: "memory"); __syncthreads(); ML_DMA_QK(ML_QS1, ML_KS1, c, 3);  ml_step<2>(lds, Cp, num, Sacc, dnq, tid, lane, wave, gb);
            asm volatile("s_waitcnt vmcnt(0)" ::: "memory"); __syncthreads(); ML_DMA_QK(ML_QS0, ML_KS0, cn, 0);
            ml_dma_piece(vcol, b, dir, 64 * cn, lds + VSn, 2 * wave, lane); ml_dma_piece(vcol, b, dir, 64 * cn, lds + VSn, 2 * wave + 1, lane);
            ml_step<3>(lds, Cp, num, Sacc, dnq, tid, lane, wave, gb);
            asm volatile("s_waitcnt vmcnt(0)" ::: "memory");
            __syncthreads();
            float un = 0.f, cmn = 0.f, bsn = 0.f;
            if (wave == 0) { un = __hip_atomic_load(glf + 4096 + 64 * cn + lane, __ATOMIC_RELAXED, __HIP_MEMORY_SCOPE_AGENT); cmn = __hip_atomic_load(glf + 6144 + 64 * cn + lane, __ATOMIC_RELAXED, __HIP_MEMORY_SCOPE_AGENT);
                             bsn = __hip_atomic_load(glf + 8192 + 64 * cn + lane, __ATOMIC_RELAXED, __HIP_MEMORY_SCOPE_AGENT); }
            { LAS f32x4* xs = (LAS f32x4*)(lds + ML_XS) + (size_t)((wave & 3) * 4) * 64 + lane;
              if (wave >= 4) {
#pragma unroll
                for (int gq = 0; gq < 4; ++gq) xs[gq * 64] = (f32x4){Sacc[4 * gq], Sacc[4 * gq + 1], Sacc[4 * gq + 2], Sacc[4 * gq + 3]}; } }
            SM[SM_DNQP + (tid >> 6) * 64 + (tid & 63)] = dnq;
            __syncthreads();
            if (wave < 4) {
                const int st = wave >> 1, tt1 = wave & 1, t = 32 * tt1 + r;
                const LAS f32x4* xs = (const LAS f32x4*)(lds + ML_XS) + (size_t)(wave * 4) * 64 + lane;
                const float Mt = SM[gb + GB_MR + t]; float dsum = 0.f;
#pragma unroll
                for (int gq = 0; gq < 4; ++gq) {
                    const f32x4 px = xs[gq * 64]; const int s0 = 32 * st + 8 * gq + 4 * h; const f32x4 us = *(const LAS f32x4*)(SM + gb + GB_U + s0);
                    float vv[4];
#pragma unroll
                    for (int e = 0; e < 4; ++e) { const float raw = (Sacc[4 * gq + e] + px[e]) * KSCALE; vv[e] = (s0 + e <= t) ? raw * __expf(us[e] - Mt) : 0.f; dsum += vv[e]; }
                    u32x2 w; w.x = cvt_pk_bf16(vv[0], vv[1]); w.y = cvt_pk_bf16(vv[2], vv[3]);
                    *(LAS u32x2*)(lds + ML_SS + t * 144 + s0 * 2) = w;
                }
                dsum += __shfl_xor(dsum, 32);
                if (h == 0) SM[(st ? SM_DIN1 : SM_DIN0) + t] = dsum;
            }
#pragma unroll
            for (int tt = 0; tt < 2; ++tt) { const float it = SM[gb + GB_INT + 32 * tt + r]; num[tt] = num[tt] * it; }
            __syncthreads();
#pragma unroll
            for (int k2 = 0; k2 < 2; ++k2) { const int ks = 2 * dpar + k2;
                const bf16x8 a = frag_tr(lds + VSc, 16 * ks, 32 * vt, lane);
#pragma unroll
                for (int tt = 0; tt < 2; ++tt) { const bf16x8 bb = *(const LAS bf16x8*)(lds + ML_SS + (32 * tt + r) * 144 + (16 * ks + 8 * h) * 2); num[tt] = MFMA32(a, bb, num[tt]); } }
            __syncthreads();
            { LAS f32x4* xn = (LAS f32x4*)(lds + ML_XN) + (size_t)(vt * 8) * 64 + lane;
              if (dpar == 1) {
#pragma unroll
                for (int tt = 0; tt < 2; ++tt)
#pragma unroll
                    for (int gq = 0; gq < 4; ++gq) xn[(tt * 4 + gq) * 64] = (f32x4){num[tt][4 * gq], num[tt][4 * gq + 1], num[tt][4 * gq + 2], num[tt][4 * gq + 3]}; } }
            if (wave == 0) ml_gates(SM, un, cmn, bsn, gbn, SM[SM_MC + cn], SM[SM_CMX + cn], lane);
            __syncthreads();
            if (dpar == 0) {
                const LAS f32x4* xn = (const LAS f32x4*)(lds + ML_XN) + (size_t)(vt * 8) * 64 + lane;
#pragma unroll
                for (int tt = 0; tt < 2; ++tt) { const int t = 32 * tt + r; float nq = 0.f;
#pragma unroll
                    for (int gI = 0; gI < 8; ++gI) nq += SM[SM_DNQP + gI * 64 + t];
                    const float den = SM[SM_DIN0 + t] + SM[SM_DIN1 + t] + SM[gb + GB_INT + t] * nq;
                    const float inv = 1.0f / fmaxf(fabsf(den), SM[gb + GB_BND + t]);
                    const int tau = 64 * c + t; const size_t ob = (size_t)(b * SEQ + (dir ? SEQ - 1 - tau : tau)) * 4096 + hd * 512 + vs * 128 + 32 * vt + 4 * h;
#pragma unroll
                    for (int gq = 0; gq < 4; ++gq) { const f32x4 px = xn[(tt * 4 + gq) * 64];
                        u32x2 w; w.x = cvt_pk_bf16((num[tt][4 * gq] + px.x) * inv, (num[tt][4 * gq + 1] + px.y) * inv); w.y = cvt_pk_bf16((num[tt][4 * gq + 2] + px.z) * inv, (num[tt][4 * gq + 3] + px.w) * inv);
                        *(u32x2*)(H + ob + 8 * gq) = w; } }
            }
            ML_WRITE_WV(VSn, gbn);
            { const float decay = SM[gb + GB_SC + 0];
              float acc_ = 0.f; const LAS unsigned* np_ = (const LAS unsigned*)(SM + SM_NVP) + (tid >> 1);
#pragma unroll
              for (int sgx = 0; sgx < 8; ++sgx) { const unsigned pr_ = np_[sgx * 256]; acc_ += (tid & 1) ? bf_hi(pr_) : bf_lo(pr_); }
              SM[SM_NV + tid] = decay * SM[SM_NV + tid] + acc_; }
        }
#undef ML_DMA_QK
#undef ML_WRITE_WV
    }
}

DI void ml_combine_phase(const bf16_t* HF, const bf16_t* HB, const bf16_t* XC, const bf16_t* XZ, const float* norm_g, const float* skip, unsigned char* MO, int gw, int NGW, int lane) {
    for (int idx = gw; idx < MTOK * ML_HEADS; idx += NGW) {
        const int tok = idx >> 3, hd = idx & 7; const int ch = hd * 512 + 8 * lane; const size_t o4 = (size_t)tok * 4096 + ch;
        const u32x4 a = *(const u32x4*)(HF + o4), bq = *(const u32x4*)(HB + o4), xcv = *(const u32x4*)(XC + o4), zv = *(const u32x4*)(XZ + (size_t)tok * 8192 + 4096 + ch);
        float ht[8] = {bf_lo(a.x) + bf_lo(bq.x), bf_hi(a.x) + bf_hi(bq.x), bf_lo(a.y) + bf_lo(bq.y), bf_hi(a.y) + bf_hi(bq.y), bf_lo(a.z) + bf_lo(bq.z), bf_hi(a.z) + bf_hi(bq.z), bf_lo(a.w) + bf_lo(bq.w), bf_hi(a.w) + bf_hi(bq.w)};
        const float xc[8] = {bf_lo(xcv.x), bf_hi(xcv.x), bf_lo(xcv.y), bf_hi(xcv.y), bf_lo(xcv.z), bf_hi(xcv.z), bf_lo(xcv.w), bf_hi(xcv.w)};
        const float z[8] = {bf_lo(zv.x), bf_hi(zv.x), bf_lo(zv.y), bf_hi(zv.y), bf_lo(zv.z), bf_hi(zv.z), bf_lo(zv.w), bf_hi(zv.w)};
        float s = 0.f;
#pragma unroll
        for (int i = 0; i < 8; ++i) s += ht[i];
        const float mu = wave_sum(s) * (1.f / 512.f); float q = 0.f;
#pragma unroll
        for (int i = 0; i < 8; ++i) { ht[i] -= mu; q += ht[i] * ht[i]; }
        const float rstd = 1.0f / sqrtf(wave_sum(q) * (1.f / 512.f) + 1e-5f);
        const f32x4 g0 = *(const f32x4*)(norm_g + ch), g1 = *(const f32x4*)(norm_g + ch + 4), k0 = *(const f32x4*)(skip + ch), k1 = *(const f32x4*)(skip + ch + 4);
        const float gg[8] = {g0.x, g0.y, g0.z, g0.w, g1.x, g1.y, g1.z, g1.w}, sk[8] = {k0.x, k0.y, k0.z, k0.w, k1.x, k1.y, k1.z, k1.w};
        float o[8];
#pragma unroll
        for (int i = 0; i < 8; ++i) o[i] = (ht[i] * rstd * gg[i] + sk[i] * xc[i]) * sigmoid_f(z[i]);
        u32x2 w; w.x = pk4_fp8(o[0] * HSCALE, o[1] * HSCALE, o[2] * HSCALE, o[3] * HSCALE); w.y = pk4_fp8(o[4] * HSCALE, o[5] * HSCALE, o[6] * HSCALE, o[7] * HSCALE);
        *(u32x2*)(MO + o4) = w;
    }
}

DI void moe_offsets(const unsigned* ecnt, int (&cnt)[8], int (&off)[8], int& ntiles) {
    int acc = 0;
#pragma unroll
    for (int e = 0; e < 8; ++e) { cnt[e] = (int)ecnt[64 * e]; off[e] = acc * 256; acc += (cnt[e] + 255) >> 8; }
    ntiles = acc;
}
DI void moe_split_plan(int ntiles, int& nMf, int& nT, int& S) {
    nMf = (ntiles >> 5) << 5; nT = ntiles - nMf; S = 1;
    if (nT > 0) { S = (nT <= 4) ? 7 : (nT <= 8) ? 4 : (nT <= 16) ? 2 : 1; }
    if (S == 1) { nMf = ntiles; nT = 0; }
}
DI pg8::TileMap moe_tilemap(const int (&cnt)[8]) { pg8::TileMap tm; int acc = 0; tm.toff[0] = 0;
#pragma unroll
    for (int e = 0; e < 8; ++e) { acc += (cnt[e] + 255) >> 8; tm.toff[e + 1] = acc; }
    return tm; }
DI void moe_scatter_phase(const unsigned char* HA, unsigned char* HS, const int* tok_e, const int* tok_pos, int* slot_row, const unsigned* ecnt, int* tile_e, int gw, int NGW, int lane) {
    int cnt[8], off[8], ntiles; moe_offsets(ecnt, cnt, off, ntiles);
    if (gw == 0 && lane < 8) { const int e = lane; const int t0 = off[e] >> 8, nt = (cnt[e] + 255) >> 8; for (int t = 0; t < nt; ++t) tile_e[t0 + t] = e; }
    for (int id = gw; id < 2 * MTOK; id += NGW) {
        const int e = tok_e[id], pos = tok_pos[id]; int o = 0;
#pragma unroll
        for (int q = 0; q < 8; ++q) o = (e == q) ? off[q] : o;
        const int row = o + pos;
        if (lane == 0) slot_row[id] = row;
        const u32x4* src = (const u32x4*)(HA + (size_t)(id >> 1) * DM) + lane; u32x4* dst = (u32x4*)(HS + (size_t)row * DM) + lane;
#pragma unroll
        for (int j = 0; j < 2; ++j) dst[64 * j] = src[64 * j];
    }
#pragma unroll 1
    for (int e = 0; e < 8; ++e) { int c = 0, o = 0;
#pragma unroll
        for (int q = 0; q < 8; ++q) { c = (e == q) ? cnt[q] : c; o = (e == q) ? off[q] : o; }
        const int pend = ((c + 255) >> 8) << 8;
        for (int p = c + gw; p < pend; p += NGW) { u32x4* dst = (u32x4*)(HS + (size_t)(o + p) * DM) + lane;
#pragma unroll
            for (int j = 0; j < 2; ++j) dst[64 * j] = (u32x4){0u, 0u, 0u, 0u}; } }
}

DI f32x4 moe_yrow(const bf16_t* YS, const bf16_t* YSP, int r, int rsplit, int S, int nrs, int lane, int j) {
    if (r < rsplit) { const u32x2 a = ((const u32x2*)(YS + (size_t)r * DM) + lane)[64 * j]; return (f32x4){bf_lo(a.x), bf_hi(a.x), bf_lo(a.y), bf_hi(a.y)}; }
    f32x4 acc = (f32x4){0.f, 0.f, 0.f, 0.f};
    for (int s2 = 0; s2 < S; ++s2) { const u32x2 a = ((const u32x2*)(YSP + ((size_t)s2 * nrs + (r - rsplit)) * DM) + lane)[64 * j]; acc += (f32x4){bf_lo(a.x), bf_hi(a.x), bf_lo(a.y), bf_hi(a.y)}; }
    return acc;
}
DI void moe_combine_phase(const bf16_t* X3, const bf16_t* YS, const int* tok_e, const int* tok_pos, const float* tok_w, const float* gate, float* out, const unsigned* ecnt, int gw, int NGW, int lane) {
    int cnt[8], off[8], ntiles; moe_offsets(ecnt, cnt, off, ntiles);
    int nMf, nT, S; moe_split_plan(ntiles, nMf, nT, S); const int rsplit = nMf * 256; const bf16_t* YSP = YS + (size_t)MPAD * DM;
    for (int tok = gw; tok < MTOK; tok += NGW) {
        const int e0 = tok_e[2 * tok], e1 = tok_e[2 * tok + 1]; int o0 = 0, o1 = 0;
#pragma unroll
        for (int q = 0; q < 8; ++q) { o0 = (e0 == q) ? off[q] : o0; o1 = (e1 == q) ? off[q] : o1; }
        const int r0 = o0 + tok_pos[2 * tok], r1 = o1 + tok_pos[2 * tok + 1]; const float w0 = tok_w[2 * tok], w1 = tok_w[2 * tok + 1];
        const u32x2* x = (const u32x2*)(X3 + (size_t)tok * DM) + lane;
        const f32x4* gp = (const f32x4*)(gate + (size_t)(tok >> 11) * 12288) + lane; f32x4* o = (f32x4*)(out + (size_t)tok * DM) + lane;
#pragma unroll
        for (int j = 0; j < 8; ++j) { const f32x4 ya = moe_yrow(YS, YSP, r0, rsplit, S, nT * 256, lane, j), yb = moe_yrow(YS, YSP, r1, rsplit, S, nT * 256, lane, j);
            const u32x2 xr = x[64 * j]; o[64 * j] = (f32x4){bf_lo(xr.x), bf_hi(xr.x), bf_lo(xr.y), bf_hi(xr.y)} + gp[64 * j] * (ya * w0 + yb * w1); }
    }
}

struct Params { const float* in[29]; float* out; unsigned char* ws; int ph_lo, ph_hi; };
static_assert(sizeof(Params) == 31 * 8 + 8, "Params has padding");
constexpr int NPHASE = 20;

#if DBG
#include "dbg_checks.inc"
#endif

__global__ void __launch_bounds__(NTHREADS, 2) mega_fwd(Params p) {
    extern __shared__ __attribute__((aligned(16))) unsigned char lds_raw[];
    LAS unsigned char* lds = (LAS unsigned char*)lds_raw;
    const int tid = threadIdx.x, lane = tid & 63, wave = __builtin_amdgcn_readfirstlane(tid >> 6);
    const int G = gridDim.x, gw = blockIdx.x * NWAVES + wave, NGW = G * NWAVES;
    const int vcu = (G % 8 == 0) ? (int)(blockIdx.x % 8) * (G / 8) + (int)(blockIdx.x / 8) : (int)blockIdx.x;
    const int gwx = vcu * NWAVES + wave;
    unsigned char* ws = p.ws;
    unsigned* ctl = (unsigned*)(ws + WS_CTL);
    volatile LAS unsigned* xbw = (volatile LAS unsigned*)(lds + LDS_BYTES - 16);
    if (tid == 0) { xbw[0] = 0u; xbw[1] = 0u; xbw[2] = 0u; xbw[3] = 0u; }
    __syncthreads();
    XcdBarrier bar = xcd_barrier_post(ctl + CW_BAR, xbw);
    const int lo = p.ph_lo, hi = p.ph_hi;
#ifndef PH_MASK
#define PH_MASK 0xFFFFFFu
#endif
#define IN(k) (((PH_MASK >> (k)) & 1u) && lo <= (k) && (k) < hi)
#define SEAM(k) do { if (IN((k) + 1)) xcd_barrier(bar); } while (0)
#ifndef REP_MASK
#define REP_MASK 0u
#endif
#define PHASE(k, ...) if (IN(k)) { { __VA_ARGS__ } if ((REP_MASK >> (k)) & 1u) { __syncthreads(); { __VA_ARGS__ } } SEAM(k); }

    float* mod = (float*)(ws + WS_MOD);
    float* pre_part = (float*)(ws + WS_PRE);
    int* tok_e = (int*)(ws + WS_ROUTE); int* tok_pos = tok_e + 2 * MTOK; float* tok_w = (float*)(tok_pos + 2 * MTOK); int* slot_row = (int*)(tok_w + 2 * MTOK);
    unsigned* ecnt = ctl + CW_ECNT; int* tile_e = (int*)(ctl + 12288);
    bf16_t* HA = (bf16_t*)(ws + WS_HA); bf16_t* X1 = (bf16_t*)(ws + WS_X1); bf16_t* X2 = (bf16_t*)(ws + WS_X2);
    bf16_t* WT_IN = (bf16_t*)(ws + WS_WT_IN); bf16_t* WT_OUT = (bf16_t*)(ws + WS_WT_OUT); bf16_t* WT_GU = (bf16_t*)(ws + WS_WT_GU); bf16_t* WT_DN = (bf16_t*)(ws + WS_WT_DN);
    bf16_t* WT_MLIN = (bf16_t*)(ws + WS_WT_MLIN); bf16_t* WT_MLOUT = (bf16_t*)(ws + WS_WT_MLOUT); bf16_t* WT_IF = (bf16_t*)(ws + WS_WT_IF);
    unsigned char* WT_MGU = ws + WS_WT_MGU; unsigned char* WT_MD = ws + WS_WT_MD;
    bf16_t* QK = (bf16_t*)(ws + A_QK); bf16_t* QKN = (bf16_t*)(ws + A_QKN); bf16_t* VT = (bf16_t*)(ws + A_VT); bf16_t* ATT = (bf16_t*)(ws + A_ATT); bf16_t* ACT = (bf16_t*)(ws + A_ACT);
    bf16_t* XZ = (bf16_t*)(ws + A_XZ); bf16_t* XC = (bf16_t*)(ws + A_XC); bf16_t* Qm = (bf16_t*)(ws + A_Q); bf16_t* Km = (bf16_t*)(ws + A_K); bf16_t* Vm = (bf16_t*)(ws + A_V);
    bf16_t* HF = (bf16_t*)(ws + A_HF); bf16_t* HB = (bf16_t*)(ws + A_HB); bf16_t* MO = (bf16_t*)(ws + A_MO);
    unsigned char* HS = ws + A_HS; unsigned char* ACTM = ws + A_ACTM; float* YS = (float*)(ws + A_YS);
    const float* x_in = p.in[0];

    PHASE(0,
        mod_phase(p.in[1], p.in[2], p.in[3], mod, lds, G, tid, lane, wave);
        LAS float* scrw = (LAS float*)lds + wave * (64 * 65);
        cvtw_job<0, false>(p.in[6] + 4096, 2048, 2048, 1, WT_IN + (size_t)4096 * 2048, 0, scrw, gw, NGW, lane, 1.f, 6144);
        cvtw_job<0, true>(p.in[6], 2048, 4096, 1, (unsigned char*)ACT + (size_t)32 * 1024 * 1024, 0, scrw, gw, NGW, lane, WSCALE, 6144);
        cvtw_job<0, false>(p.in[10], 2048, 2048, 1, WT_OUT, 0, scrw, gw, NGW, lane, 1.f);
        cvtw_job<1, false>(p.in[11], 2048, FFN, 1, WT_GU, 0, scrw, gw, NGW, lane, 1.f);
        cvtw_job<2, false>(p.in[12], 2048, FFN, 1, WT_GU, 0, scrw, gw, NGW, lane, 1.f);
        cvtw_job<0, false>(p.in[13], FFN, 2048, 1, WT_DN, 0, scrw, gw, NGW, lane, 1.f);
        cvtw_job<0, false>(p.in[14], 2048, 8192, 1, WT_MLIN, 0, scrw, gw, NGW, lane, 1.f);
        cvtw_job<0, true>(p.in[24], 4096, 2048, 1, (unsigned char*)WT_MLOUT, 0, scrw, gw, NGW, lane, WSCALE);
        cvt_job<0>(p.in[20], 12288, 32, 1, WT_IF, 0, scrw, gw, NGW, lane);
        cvtw_job<1, true>(p.in[26], 2048, EDIM, 8, WT_MGU, (size_t)14336 * 2048, scrw, gw, NGW, lane, WSCALE);
        cvtw_job<2, true>(p.in[27], 2048, EDIM, 8, WT_MGU, (size_t)14336 * 2048, scrw, gw, NGW, lane, WSCALE);
        cvtw_job<0, true>(p.in[28], EDIM, 2048, 8, WT_MD, (size_t)2048 * EDIM, scrw, gw, NGW, lane, WSCALE); )
    PHASE(1,  rms_mod_phase<false, true>(x_in, p.in[4], mod + 1 * 2048, mod + 0 * 2048, HA, nullptr, nullptr, nullptr, nullptr, nullptr, (unsigned char*)ACT, gw, NGW, lane); )
    PHASE(2,
        { pg8::Gemm g{(const unsigned char*)ACT, (const unsigned char*)ACT + (size_t)32 * 1024 * 1024, MTOK, 4096, 2048, 0}; pg8::StaticOrder S; S.init(MTOK, 4096, G, (int)blockIdx.x); pg8::EpiQKNorm E{QKN, 4096, p.in[7], p.in[8], 1.0f / (HSCALE * WSCALE)}; pg8::gemm_phase<pg8::EpiQKNorm, pg8::StaticOrder, true>(lds, g, S, E); }
        { pg8::Gemm g{WT_IN + (size_t)4096 * 2048, HA, 2048, MTOK, 2048, 0}; pg8::StaticOrder S; S.init(2048, MTOK, G, (int)blockIdx.x); pg8::EpiBf16 E{VT, MTOK}; pg8::gemm_phase(lds, g, S, E); } )
    PHASE(4,  na_phase(QKN, VT, ATT, p.in[9], lds, G, vcu, tid, lane, wave); )
    PHASE(5,  pg8::Gemm g{ATT, WT_OUT, MTOK, 2048, 2048, 0}; pg8::StaticOrder S; S.init(MTOK, 2048, G, (int)blockIdx.x); pg8::EpiResGate16<false> E{x_in, X1, DM, mod + 2 * 2048, 12288}; pg8::gemm_phase(lds, g, S, E); )
    PHASE(6,  rms_mod_phase<false, false, true>(X1, p.in[5], mod + 4 * 2048, mod + 3 * 2048, HA, nullptr, nullptr, nullptr, nullptr, nullptr, nullptr, gw, NGW, lane); )
    PHASE(7,  pg8::Gemm g{HA, WT_GU, MTOK, 2 * FFN, 2048, 0}; pg8::StaticOrder S; S.init(MTOK, 2 * FFN, G, (int)blockIdx.x); pg8::EpiSwiGLU E{ACT, FFN}; pg8::gemm_phase(lds, g, S, E); )
    PHASE(8,  pg8::Gemm g{ACT, WT_DN, MTOK, 2048, FFN, 0}; pg8::StaticOrder S; S.init(MTOK, 2048, G, (int)blockIdx.x); pg8::EpiResGate16<true> E{X1, X2, DM, mod + 5 * 2048, 12288}; pg8::gemm_phase(lds, g, S, E); )
    PHASE(9,  rms_mod_phase<false, false, true>(X2, p.in[4] + DM, mod + 4 * 12288 + 1 * 2048, mod + 4 * 12288 + 0 * 2048, HA, nullptr, nullptr, nullptr, nullptr, nullptr, nullptr, gw, NGW, lane); )
    PHASE(10,  pg8::Gemm g{HA, WT_MLIN, MTOK, 8192, 2048, 0}; pg8::StaticOrder S; S.init(MTOK, 8192, G, (int)blockIdx.x); pg8::EpiBf16 E{XZ, 8192}; pg8::gemm_phase(lds, g, S, E); )
    PHASE(11,  ml_pre_phase(XZ, p.in[15], p.in[16], p.in[17], p.in[18], p.in[19], WT_IF, XC, Qm, Km, Vm, pre_part, lds, G, tid, lane, wave); )
    PHASE(12,  mlstm_phase(Qm, Km, Vm, pre_part, p.in[21], (float*)(ws + WS_GLF), HF, HB, lds, G, vcu, tid, lane, wave); )
    PHASE(13,  ml_combine_phase(HF, HB, XC, XZ, p.in[23], p.in[22], (unsigned char*)MO, gw, NGW, lane); )
    PHASE(14,  pg8::Gemm g{MO, WT_MLOUT, MTOK, 2048, 4096, 0}; pg8::StaticOrder S; S.init(MTOK, 2048, G, (int)blockIdx.x); pg8::EpiResGate16<true> E{X2, X1, DM, mod + 4 * 12288 + 2 * 2048, 12288, 1.0f / (HSCALE * WSCALE)}; pg8::gemm_phase<pg8::EpiResGate16<true>, pg8::StaticOrder, true>(lds, g, S, E); )
    PHASE(15,  rms_mod_phase<true, false, true>(X1, p.in[5] + DM, mod + 4 * 12288 + 4 * 2048, mod + 4 * 12288 + 3 * 2048, HA, p.in[25], tok_e, tok_pos, tok_w, ecnt, HS, gw, NGW, lane); )
    PHASE(17,  int cnt[8], off[8], ntiles; moe_offsets(ecnt, cnt, off, ntiles);
        pg8::Gemm g{HS, WT_MGU, ntiles * 256, 2 * EDIM, 2048, 0}; pg8::MoeOrder S; S.init(ntiles, 2 * EDIM, G, (int)blockIdx.x, moe_tilemap(cnt), (size_t)14336 * 2048, (size_t)DM);
        pg8::EpiSwiGLU8 E{ACTM, EDIM, 1.0f / (HSCALE * WSCALE), ASCALE}; pg8::gemm_phase<pg8::EpiSwiGLU8, pg8::MoeOrder, true>(lds, g, S, E); )
    PHASE(18,  int cnt[8], off[8], ntiles; moe_offsets(ecnt, cnt, off, ntiles);
        pg8::Gemm g{ACTM, WT_MD, ntiles * 256, 2048, EDIM, 0};
        int nMf, nT, SS; moe_split_plan(ntiles, nMf, nT, SS); bf16_t* YSP = (bf16_t*)YS + (size_t)MPAD * DM;
        { pg8::MoeRowOrder S1; S1.init(nMf, G, (int)blockIdx.x, moe_tilemap(cnt), (size_t)2048 * EDIM); pg8::EpiBf16S E{(bf16_t*)YS, DM, 1.0f / (ASCALE * WSCALE), 0}; pg8::gemm_phase<pg8::EpiBf16S, pg8::MoeRowOrder, true>(lds, g, S1, E); }
        if (nT > 0) { pg8::Gemm g2 = g; g2.ntk = 56 / SS; pg8::MoeSplitOrder S2; S2.init(nMf, nT, SS, (size_t)(EDIM / SS), (int)blockIdx.x, moe_tilemap(cnt), (size_t)2048 * EDIM);
            pg8::EpiBf16S E2{YSP - (size_t)nMf * 256 * DM, DM, 1.0f / (ASCALE * WSCALE), (size_t)nT * 256 * DM}; pg8::gemm_phase<pg8::EpiBf16S, pg8::MoeSplitOrder, true>(lds, g2, S2, E2); } )
    PHASE(19,  moe_combine_phase(X1, (const bf16_t*)YS, tok_e, tok_pos, tok_w, mod + 4 * 12288 + 5 * 2048, p.out, ecnt, gw, NGW, lane); )
#undef IN
#undef SEAM
#undef PHASE
}

extern "C" void kernel_launch(void* const* d_in, const int* in_sizes, int n_in, void* d_out, int out_size, void* d_ws, size_t ws_size, hipStream_t stream) {
    static int grid = 0;
    if (grid == 0) {
        if (n_in != 29 || out_size != MTOK * DM || ws_size < WS_END) { fprintf(stderr, "kernel_launch: unexpected shapes (n_in %d out %d ws %zu need %zu)\n", n_in, out_size, ws_size, (size_t)WS_END); grid = -1; return; }
        int dev = 0, cus = 0, per_cu = 0;
        if (hipGetDevice(&dev) != hipSuccess || hipDeviceGetAttribute(&cus, hipDeviceAttributeMultiprocessorCount, dev) != hipSuccess) { grid = -1; return; }
        if (hipFuncSetAttribute((const void*)mega_fwd, hipFuncAttributeMaxDynamicSharedMemorySize, LDS_BYTES) != hipSuccess) { fprintf(stderr, "kernel_launch: hipFuncSetAttribute failed\n"); grid = -1; return; }
        if (hipOccupancyMaxActiveBlocksPerMultiprocessor(&per_cu, (const void*)mega_fwd, NTHREADS, LDS_BYTES) != hipSuccess || per_cu < 1) { fprintf(stderr, "kernel_launch: occupancy query says %d\n", per_cu); (void)hipGetLastError(); per_cu = 1; }
        grid = cus;
    }
    if (grid < 0) return;
    (void)hipMemsetAsync((char*)d_ws + WS_CTL, 0, CTL_BYTES, stream);
    Params p{};
    for (int i = 0; i < 29; ++i) p.in[i] = (const float*)d_in[i];
    p.out = (float*)d_out; p.ws = (unsigned char*)d_ws;
#if N_LAUNCH_SPLIT
    for (int k = 0; k < NPHASE; ++k) { p.ph_lo = k; p.ph_hi = k + 1; hipLaunchKernelGGL(mega_fwd, dim3(grid), dim3(NTHREADS), LDS_BYTES, stream, p); }
#else
    p.ph_lo = 0; p.ph_hi = NPHASE;
    hipLaunchKernelGGL(mega_fwd, dim3(grid), dim3(NTHREADS), LDS_BYTES, stream, p);
#endif
}
```

```cpp
#define PROBE_HOT 0
#ifndef GEMM_SCH
#define GEMM_SCH 1
#endif
#include <hip/hip_runtime.h>
#include <cstdio>
#include <cstdint>

#ifndef DBG
#define DBG 0
#endif
#ifndef N_LAUNCH_SPLIT
#define N_LAUNCH_SPLIT 0
#endif

#define LAS __attribute__((address_space(3)))
#define GAS __attribute__((address_space(1)))
#define DI __device__ __forceinline__
typedef unsigned short bf16_t;
typedef short bf16x8 __attribute__((ext_vector_type(8)));
typedef short s16x4 __attribute__((ext_vector_type(4)));
typedef float f32x2 __attribute__((ext_vector_type(2)));
typedef float f32x4 __attribute__((ext_vector_type(4)));
typedef float f32x16 __attribute__((ext_vector_type(16)));
typedef unsigned u32x2 __attribute__((ext_vector_type(2)));
typedef unsigned u32x4 __attribute__((ext_vector_type(4)));
typedef int i32x4 __attribute__((ext_vector_type(4)));
typedef int i32x8 __attribute__((ext_vector_type(8)));

constexpr int BATCH = 4, SEQ = 2048, DM = 2048, MTOK = BATCH * SEQ;
constexpr int GRID_W = 64, NA_HEADS = 16, NA_HD = 128;
constexpr int ML_INNER = 4096, ML_HEADS = 8, ML_HD = 512;
constexpr int FFN = 5632, NEXP = 8, EDIM = 7168;
constexpr int MPAD = 2 * MTOK + NEXP * 256;
constexpr int NTHREADS = 512, NWAVES = 8;
constexpr int LDS_BYTES = 147456;

constexpr size_t al256(size_t x) { return (x + 255) & ~(size_t)255; }
constexpr size_t WS_CTL = 0;
constexpr size_t CTL_BYTES = 65536;
constexpr size_t WS_MOD = WS_CTL + CTL_BYTES;
constexpr size_t WS_PRE = WS_MOD + al256((size_t)2 * 4 * 12288 * 4);
constexpr size_t WS_ROUTE = WS_PRE + (size_t)8 * MTOK * 32 * 4;
constexpr size_t WS_GLF = WS_ROUTE + (size_t)4 * MTOK * 2 * 4;
constexpr size_t WS_HA = WS_GLF + (size_t)256 * 10240 * 4;
constexpr size_t WS_X1 = WS_HA + (size_t)MTOK * DM * 2;
constexpr size_t WS_X2 = WS_X1 + (size_t)MTOK * DM * 4;
constexpr size_t WS_WT_IN = WS_X2 + (size_t)MTOK * DM * 4;
constexpr size_t WS_WT_OUT = WS_WT_IN + (size_t)6144 * 2048 * 2;
constexpr size_t WS_WT_GU = WS_WT_OUT + (size_t)2048 * 2048 * 2;
constexpr size_t WS_WT_DN = WS_WT_GU + (size_t)11264 * 2048 * 2;
constexpr size_t WS_WT_MLIN = WS_WT_DN + (size_t)2048 * 5632 * 2;
constexpr size_t WS_WT_MLOUT = WS_WT_MLIN + (size_t)8192 * 2048 * 2;
constexpr size_t WS_WT_IF = WS_WT_MLOUT + (size_t)2048 * 4096 * 2;
constexpr size_t WS_WT_MGU = WS_WT_IF + (size_t)32 * 12288 * 2;
constexpr size_t WS_WT_MD = WS_WT_MGU + (size_t)8 * 14336 * 2048;
constexpr size_t WS_ARENA = WS_WT_MD + (size_t)8 * 2048 * 7168;
constexpr size_t A_QK = WS_ARENA;
constexpr size_t A_QKN = A_QK + (size_t)MTOK * 4096 * 2;
constexpr size_t A_VT = A_QKN + (size_t)MTOK * 4096 * 2;
constexpr size_t A_ATT = A_VT + (size_t)2048 * MTOK * 2;
constexpr size_t A_ACT = A_ATT + (size_t)MTOK * DM * 2;
constexpr size_t A_L0_END = A_ACT + (size_t)MTOK * FFN * 2;
constexpr size_t A_XZ = WS_ARENA;
constexpr size_t A_XC = A_XZ + (size_t)MTOK * 8192 * 2;
constexpr size_t A_Q = A_XC + (size_t)MTOK * 4096 * 2;
constexpr size_t A_K = A_Q + (size_t)MTOK * 4096 * 2;
constexpr size_t A_V = A_K + (size_t)MTOK * 4096 * 2;
constexpr size_t A_HF = A_V + (size_t)MTOK * 4096 * 2;
constexpr size_t A_HB = A_HF + (size_t)MTOK * 4096 * 2;
constexpr size_t A_MO = A_HB + (size_t)MTOK * 4096 * 2;
constexpr size_t A_L1_END = A_MO + (size_t)MTOK * 4096 * 2;
constexpr size_t A_HS = WS_ARENA;
constexpr size_t A_ACTM = A_HS + (size_t)8 * 8192 * DM;
constexpr size_t A_YS = A_ACTM + (size_t)MPAD * EDIM;
constexpr size_t A_L2_END = A_YS + (size_t)MPAD * DM * 4;
constexpr size_t cmax(size_t a, size_t b) { return a > b ? a : b; }
constexpr size_t WS_END = cmax(cmax(A_L0_END, A_L1_END), A_L2_END);

constexpr int CW_BAR = 0;
constexpr int CW_ECNT = 4096;
constexpr int CW_DBG = 8192;

typedef __bf16 bf16x2_t __attribute__((ext_vector_type(2)));
DI unsigned cvt_pk_bf16(float lo, float hi) { const f32x2 v = {lo, hi}; return __builtin_bit_cast(unsigned, __builtin_convertvector(v, bf16x2_t)); }
DI float clamp448(float x) { return __builtin_fminf(__builtin_fmaxf(x, -448.f), 448.f); }
DI unsigned pk4_fp8(float a, float b, float c, float d) {
    int p = 0; p = __builtin_amdgcn_cvt_pk_fp8_f32(clamp448(a), clamp448(b), p, false); p = __builtin_amdgcn_cvt_pk_fp8_f32(clamp448(c), clamp448(d), p, true); return (unsigned)p; }
DI float bf_lo(unsigned u) { return __uint_as_float(u << 16); }
DI float bf_hi(unsigned u) { return __uint_as_float(u & 0xffff0000u); }
DI float bf2f(bf16_t b) { return __uint_as_float(((unsigned)b) << 16); }
DI bf16_t f2bf(float f) { return (bf16_t)(cvt_pk_bf16(f, 0.f) & 0xffffu); }
DI float wave_sum(float v) {
#pragma unroll
    for (int o = 1; o < 64; o <<= 1) v += __shfl_xor(v, o);
    return v;
}
DI float wave_max(float v) {
#pragma unroll
    for (int o = 1; o < 64; o <<= 1) v = fmaxf(v, __shfl_xor(v, o));
    return v;
}
DI float silu_f(float x) { return x / (1.f + __expf(-x)); }
DI float sigmoid_f(float x) { return 1.f / (1.f + __expf(-x)); }
#define LDS_WAIT() asm volatile("s_waitcnt lgkmcnt(0)" ::: "memory")
#define VM_WAIT() asm volatile("s_waitcnt vmcnt(0)" ::: "memory")

#define XB_TMO      128
#define XB_XCNT(j)  (256  + 64 * (j))
#define XB_XSUB(j)  (1280 + 64 * (j))
#define XB_XGEN(j)  (2304 + 64 * (j))
#define XB_TOP      3328
#define XB_TOPGEN   3392
#define XCD_BAR_WORDS 3456
#define XB_SPIN_CAP (1u << 22)

__device__ __forceinline__ unsigned xb_ld(unsigned* p)              { return __hip_atomic_load(p, __ATOMIC_RELAXED, __HIP_MEMORY_SCOPE_AGENT); }
__device__ __forceinline__ unsigned xb_add(unsigned* p, unsigned v) { return __hip_atomic_fetch_add(p, v, __ATOMIC_RELAXED, __HIP_MEMORY_SCOPE_AGENT); }
__device__ __forceinline__ unsigned xb_xcc_id() { return (unsigned)__builtin_amdgcn_s_getreg((3 << 11) | 20) & 0xFu; }
#define XB_SPIN(cond, bar) do { unsigned _sp = 0; while (cond) { __builtin_amdgcn_s_sleep(1); \
    if ((++_sp & 255u) == 0u) { if (xb_ld(&(bar)[XB_TMO])) break; if (_sp > XB_SPIN_CAP) { atomicAdd(&(bar)[XB_TMO], 1u); break; } } } } while (0)

struct XcdBarrier { unsigned* bar; unsigned x; volatile LAS unsigned* st; };

__device__ __forceinline__ XcdBarrier xcd_barrier_post(unsigned* bar, volatile LAS unsigned* st) {
    XcdBarrier b; b.bar = bar; b.x = xb_xcc_id(); b.st = st;
    if (threadIdx.x == 0) (void)xb_add(&bar[XB_XCNT(b.x)], 1u);
    return b;
}
__device__ __forceinline__ void xcd_barrier_complete(unsigned* bar, unsigned x, unsigned& nloc, unsigned& nx) {
    const unsigned G = gridDim.x * gridDim.y * gridDim.z;
    unsigned sum, cnt, mine, sp = 0u;
    for (;;) {
        sum = 0u; cnt = 0u; mine = 0u;
#pragma unroll
        for (unsigned j = 0; j < 16; ++j) { const unsigned c = xb_ld(&bar[XB_XCNT(j)]); sum += c; cnt += (c > 0u) ? 1u : 0u; mine = (j == x) ? c : mine; }
        if (sum == G) break;
        __builtin_amdgcn_s_sleep(1);
        if ((++sp & 255u) == 0u) { if (xb_ld(&bar[XB_TMO])) break; if (sp > XB_SPIN_CAP) { atomicAdd(&bar[XB_TMO], 1u); break; } }
    }
    nloc = mine > 0u ? mine : 1u; nx = cnt > 0u ? cnt : 1u;
}
__device__ __forceinline__ void xcd_barrier(const XcdBarrier& b) {
    asm volatile("s_waitcnt vmcnt(0)" ::: "memory");
    __syncthreads();
    if (threadIdx.x == 0) {
        unsigned* bar = b.bar;
        __builtin_amdgcn_s_waitcnt(0);
        unsigned nloc = b.st[0], nx = b.st[1];
        if (nloc == 0u) { xcd_barrier_complete(bar, b.x, nloc, nx); b.st[0] = nloc; b.st[1] = nx; }
        const unsigned old = xb_add(&bar[XB_XSUB(b.x)], 1u);
        const unsigned gen = old / nloc;
        if (old + 1u == (gen + 1u) * nloc) {
            __builtin_amdgcn_fence(__ATOMIC_RELEASE, "agent");
            asm volatile("s_waitcnt vmcnt(0)" ::: "memory");
            const unsigned og = xb_add(&bar[XB_TOP], 1u);
            const unsigned tg = og / nx;
            if (og + 1u == (tg + 1u) * nx) xb_add(&bar[XB_TOPGEN], 1u);
            else XB_SPIN(xb_ld(&bar[XB_TOPGEN]) == tg, bar);
            __builtin_amdgcn_fence(__ATOMIC_ACQUIRE, "agent");
            xb_add(&bar[XB_XGEN(b.x)], 1u);
            asm volatile("s_waitcnt vmcnt(0)" ::: "memory");
        } else {
            XB_SPIN(xb_ld(&bar[XB_XGEN(b.x)]) == gen, bar);
            __builtin_amdgcn_fence(__ATOMIC_ACQUIRE, "agent");
            asm volatile("s_waitcnt vmcnt(0)" ::: "memory");
        }
    }
    __syncthreads();
}

namespace pg8 {
constexpr int BM = 256, BK = 64, HALF = 128, HTB = HALF * BK * 2, STAGE_BYTES = 8 * HTB, NXCD = 8, WGM = 8;
__host__ __device__ __forceinline__ int lds_byte(int r, int c) { const int st = (r >> 4) * 2 + (c >> 5), rr = r & 15, cc = c & 31, ob = rr * 64 + cc * 2; return st * 1024 + (ob ^ (((ob >> 9) & 1) << 5)); }
__host__ __device__ __forceinline__ void stage_rc(int b, int& R, int& C) { const int st = b / 1024, sb = b % 1024, swz = sb ^ (((sb >> 9) & 1) << 5); R = (st >> 1) * 16 + swz / 64; C = (st & 1) * 32 + (swz % 64) / 2; }
__host__ __device__ __forceinline__ int perm32(int rho) { const int n = rho >> 4, i = rho & 15; return 8 * (i >> 2) + 4 * n + (i & 3); }

struct Unit { int pm, pn; size_t boff; size_t aoff; int slice; };
struct Gemm { const void* A; const void* Bt; int M, N, K; int ntk; };

struct StaticOrder {
    int nM, nN, nwg, G, c;
    __device__ void init(int M, int N, int G_, int c_) { nM = M / BM; nN = N / BM; nwg = nM * nN; G = G_; c = c_; }
    __device__ bool next(int i, Unit& u) const {
        const long L = (long)i * G + c; if (L >= nwg) return false;
        int wgid = (int)L; { const int q = nwg / NXCD, r = nwg % NXCD, xcd = wgid % NXCD, off = wgid / NXCD; wgid = (xcd < r ? xcd * (q + 1) : r * (q + 1) + (xcd - r) * q) + off; }
        const int nig = WGM * nN, gid = wgid / nig, fm = gid * WGM, gsz = (nM - fm) < WGM ? (nM - fm) : WGM;
        u.pm = fm + ((wgid % nig) % gsz); u.pn = (wgid % nig) / gsz; u.boff = 0; u.aoff = 0; u.slice = 0; return true;
    }
};
struct TileMap {
    int toff[9];
    __device__ __forceinline__ void lookup(int pm, int& e, int& k) const {
        e = (pm >= toff[1]) + (pm >= toff[2]) + (pm >= toff[3]) + (pm >= toff[4]) + (pm >= toff[5]) + (pm >= toff[6]) + (pm >= toff[7]);
        int t0 = 0;
#pragma unroll
        for (int q = 1; q < 8; ++q) t0 = (e == q) ? toff[q] : t0;
        k = pm - t0;
    }
};
constexpr int ECAP = 8192;
struct MoeOrder {
    int nM, nN, nwg, G, c; TileMap tm; size_t estride; size_t arowb;
    __device__ void init(int nM_, int N, int G_, int c_, const TileMap& tm_, size_t es, size_t arowb_) { nM = nM_; nN = N / BM; nwg = nM * nN; G = G_; c = c_; tm = tm_; estride = es; arowb = arowb_; }
    __device__ bool next(int i, Unit& u) const {
        const long L = (long)i * G + c; if (L >= nwg) return false;
        int wgid = (int)L; { const int q = nwg / NXCD, r = nwg % NXCD, xcd = wgid % NXCD, off = wgid / NXCD; wgid = (xcd < r ? xcd * (q + 1) : r * (q + 1) + (xcd - r) * q) + off; }
        const int nig = WGM * nN, gid = wgid / nig, fm = gid * WGM, gsz = (nM - fm) < WGM ? (nM - fm) : WGM;
        u.pm = fm + ((wgid % nig) % gsz); u.pn = (wgid % nig) / gsz; int e, k; tm.lookup(u.pm, e, k); u.boff = (size_t)e * estride;
        u.aoff = (size_t)((long)(e * ECAP + 256 * k - 256 * u.pm) * (long)arowb); u.slice = 0; return true;
    }
};

struct MoeRowOrder {
    int nwg, G, c; TileMap tm; size_t estride;
    __device__ void init(int nMf, int G_, int c_, const TileMap& tm_, size_t es) { nwg = nMf * 8; G = G_; c = c_; tm = tm_; estride = es; }
    __device__ bool next(int i, Unit& u) const {
        const long L = (long)i * G + c; if (L >= nwg) return false;
        u.pm = (int)(L >> 3); u.pn = (int)(L & 7); int e, k; tm.lookup(u.pm, e, k); u.boff = (size_t)e * estride; u.aoff = 0; u.slice = 0; return true;
    }
};
struct MoeSplitOrder {
    int pm0, nq, S, c; size_t kslice; TileMap tm; size_t estride;
    __device__ void init(int pm0_, int nT, int S_, size_t ks, int c_, const TileMap& tm_, size_t es) { pm0 = pm0_; S = S_; nq = nT * 8 * S_; kslice = ks; c = c_; tm = tm_; estride = es; }
    __device__ bool next(int i, Unit& u) const {
        if (i != 0 || c >= nq) return false;
        const int un = c / S; u.slice = c - un * S; u.pm = pm0 + (un >> 3); u.pn = un & 7; u.aoff = (size_t)u.slice * kslice; int e, k; tm.lookup(u.pm, e, k); u.boff = (size_t)e * estride + u.aoff; return true;
    }
};
struct EpiBf16 {
    static constexpr bool PERM = true, XBAR = false;
    bf16_t* O; int ldc;
    __device__ __forceinline__ void operator()(const f32x4 (&acc)[2][2][4][2], const Unit& u, int wr, int wc, int fr, int fq) const {
        const int row0 = u.pm * BM + wr * 64 + fr, col0 = u.pn * BM + wc * 32 + 8 * fq;
#pragma unroll
        for (int ai = 0; ai < 2; ++ai)
#pragma unroll
            for (int m = 0; m < 4; ++m) { bf16_t* rowp = O + (size_t)(row0 + ai * HALF + m * 16) * ldc + col0;
#pragma unroll
                for (int bj = 0; bj < 2; ++bj) { const f32x4 v0 = acc[ai][bj][m][0], v1 = acc[ai][bj][m][1];
                    u32x4 w; w.x = cvt_pk_bf16(v0[0], v0[1]); w.y = cvt_pk_bf16(v0[2], v0[3]); w.z = cvt_pk_bf16(v1[0], v1[1]); w.w = cvt_pk_bf16(v1[2], v1[3]);
                    *(u32x4*)(rowp + bj * HALF) = w; } }
    }
};
struct EpiQKNorm {
    static constexpr bool PERM = true, XBAR = true;
    bf16_t* O; int ldc; const float* qg; const float* kg; float sc;
    __device__ __forceinline__ void pre(const f32x4 (&acc)[2][2][4][2], int wr, int wc, int fr, int fq, LAS float* P) const {
#pragma unroll
        for (int ai = 0; ai < 2; ++ai)
#pragma unroll
            for (int m = 0; m < 4; ++m)
#pragma unroll
                for (int bj = 0; bj < 2; ++bj) { const f32x4 a = acc[ai][bj][m][0], b = acc[ai][bj][m][1];
                    float ss = (a[0] * a[0] + a[1] * a[1]) + (a[2] * a[2] + a[3] * a[3]) + (b[0] * b[0] + b[1] * b[1]) + (b[2] * b[2] + b[3] * b[3]);
                    ss += __shfl_xor(ss, 16); ss += __shfl_xor(ss, 32);
                    if (fq == 0) P[((ai * HALF + wr * 64 + m * 16 + fr) * 2 + bj) * 4 + wc] = ss * sc * sc; }
    }
    __device__ __forceinline__ void post(const f32x4 (&acc)[2][2][4][2], const Unit& u, int wr, int wc, int fr, int fq, const LAS float* P) const {
        const int row0 = u.pm * BM + wr * 64 + fr, col0 = u.pn * BM + wc * 32 + 8 * fq;
        f32x4 g0[2], g1[2]; float hs[2];
#pragma unroll
        for (int bj = 0; bj < 2; ++bj) { const int head = 2 * u.pn + bj; const float* gp = (head < 16 ? qg : kg) + wc * 32 + 8 * fq; g0[bj] = *(const f32x4*)gp; g1[bj] = *(const f32x4*)(gp + 4); hs[bj] = head < 16 ? 0.08838834764831845f : 1.0f; }
#pragma unroll
        for (int ai = 0; ai < 2; ++ai)
#pragma unroll
            for (int m = 0; m < 4; ++m) { bf16_t* rowp = O + (size_t)(row0 + ai * HALF + m * 16) * ldc + col0;
#pragma unroll
                for (int bj = 0; bj < 2; ++bj) { const f32x4 ps = *(const LAS f32x4*)(P + ((ai * HALF + wr * 64 + m * 16 + fr) * 2 + bj) * 4);
                    const float rstd = hs[bj] / sqrtf(((ps[0] + ps[1]) + (ps[2] + ps[3])) * (1.f / 128.f) + 1e-6f);
                    const f32x4 v0 = acc[ai][bj][m][0] * g0[bj] * (rstd * sc), v1 = acc[ai][bj][m][1] * g1[bj] * (rstd * sc);
                    u32x4 w; w.x = cvt_pk_bf16(v0[0], v0[1]); w.y = cvt_pk_bf16(v0[2], v0[3]); w.z = cvt_pk_bf16(v1[0], v1[1]); w.w = cvt_pk_bf16(v1[2], v1[3]);
                    *(u32x4*)(rowp + bj * HALF) = w; } }
    }
};
struct EpiBf16S {
    static constexpr bool PERM = true, XBAR = false;
    bf16_t* O; int ldc; float sc; size_t sstride;
    __device__ __forceinline__ void operator()(const f32x4 (&acc)[2][2][4][2], const Unit& u, int wr, int wc, int fr, int fq) const {
        const int row0 = u.pm * BM + wr * 64 + fr, col0 = u.pn * BM + wc * 32 + 8 * fq;
        bf16_t* Os = O + (size_t)u.slice * sstride;
#pragma unroll
        for (int ai = 0; ai < 2; ++ai)
#pragma unroll
            for (int m = 0; m < 4; ++m) { bf16_t* rowp = Os + (size_t)(row0 + ai * HALF + m * 16) * ldc + col0;
#pragma unroll
                for (int bj = 0; bj < 2; ++bj) { const f32x4 v0 = acc[ai][bj][m][0] * sc, v1 = acc[ai][bj][m][1] * sc;
                    u32x4 w; w.x = cvt_pk_bf16(v0[0], v0[1]); w.y = cvt_pk_bf16(v0[2], v0[3]); w.z = cvt_pk_bf16(v1[0], v1[1]); w.w = cvt_pk_bf16(v1[2], v1[3]);
                    *(u32x4*)(rowp + bj * HALF) = w; } }
    }
};
struct EpiSwiGLU {
    static constexpr bool PERM = true, XBAR = false;
    bf16_t* O; int ldc;
    __device__ __forceinline__ void operator()(const f32x4 (&acc)[2][2][4][2], const Unit& u, int wr, int wc, int fr, int fq) const {
        const int row0 = u.pm * BM + wr * 64 + fr, col0 = u.pn * HALF + wc * 32 + 8 * fq;
#pragma unroll
        for (int ai = 0; ai < 2; ++ai)
#pragma unroll
            for (int m = 0; m < 4; ++m) { bf16_t* rowp = O + (size_t)(row0 + ai * HALF + m * 16) * ldc + col0;
                float o[8];
#pragma unroll
                for (int n = 0; n < 2; ++n)
#pragma unroll
                    for (int j = 0; j < 4; ++j) { const float g = acc[ai][0][m][n][j], up = acc[ai][1][m][n][j]; o[n * 4 + j] = g * __builtin_amdgcn_rcpf(1.f + __expf(-g)) * up; }
                u32x4 w; w.x = cvt_pk_bf16(o[0], o[1]); w.y = cvt_pk_bf16(o[2], o[3]); w.z = cvt_pk_bf16(o[4], o[5]); w.w = cvt_pk_bf16(o[6], o[7]);
                *(u32x4*)rowp = w; }
    }
};
struct EpiSwiGLU8 {
    static constexpr bool PERM = true, XBAR = false;
    unsigned char* O; int ldc; float isc, osc;
    __device__ __forceinline__ void operator()(const f32x4 (&acc)[2][2][4][2], const Unit& u, int wr, int wc, int fr, int fq) const {
        const int row0 = u.pm * BM + wr * 64 + fr, col0 = u.pn * HALF + wc * 32 + 8 * fq;
#pragma unroll
        for (int ai = 0; ai < 2; ++ai)
#pragma unroll
            for (int m = 0; m < 4; ++m) { unsigned char* rowp = O + (size_t)(row0 + ai * HALF + m * 16) * ldc + col0;
                float o[8];
#pragma unroll
                for (int n = 0; n < 2; ++n)
#pragma unroll
                    for (int j = 0; j < 4; ++j) { const float g = acc[ai][0][m][n][j] * isc, up = acc[ai][1][m][n][j] * isc; o[n * 4 + j] = g * __builtin_amdgcn_rcpf(1.f + __expf(-g)) * up * osc; }
                u32x2 w; w.x = pk4_fp8(o[0], o[1], o[2], o[3]); w.y = pk4_fp8(o[4], o[5], o[6], o[7]);
                *(u32x2*)rowp = w; }
    }
};
struct EpiResGate {
    static constexpr bool PERM = false, XBAR = false;
    const float* base; float* out; int ldc; const float* gate; int gstride;
    __device__ __forceinline__ void operator()(const f32x4 (&acc)[2][2][4][2], const Unit& u, int wr, int wc, int fr, int fq) const {
        const int row0 = u.pm * BM + wr * 64 + fr, col0 = u.pn * BM + wc * 32 + 4 * fq;
        const float* gp = gate + (size_t)((u.pm * BM) >> 11) * gstride + col0;
        f32x4 gv[2][2];
#pragma unroll
        for (int bj = 0; bj < 2; ++bj)
#pragma unroll
            for (int n = 0; n < 2; ++n) gv[bj][n] = *(const f32x4*)(gp + bj * HALF + n * 16);
#pragma unroll
        for (int ai = 0; ai < 2; ++ai)
#pragma unroll
            for (int m = 0; m < 4; ++m) { const size_t off = (size_t)(row0 + ai * HALF + m * 16) * ldc + col0;
#pragma unroll
                for (int bj = 0; bj < 2; ++bj)
#pragma unroll
                    for (int n = 0; n < 2; ++n) { const f32x4 bs = *(const f32x4*)(base + off + bj * HALF + n * 16);
                        *(f32x4*)(out + off + bj * HALF + n * 16) = bs + gv[bj][n] * acc[ai][bj][m][n]; }
                asm volatile("" ::: "memory"); }
    }
};
template <bool BASE16>
struct EpiResGate16 {
    static constexpr bool PERM = true, XBAR = false;
    const void* base; bf16_t* out; int ldc; const float* gate; int gstride; float sc = 1.0f;
    __device__ __forceinline__ void operator()(const f32x4 (&acc)[2][2][4][2], const Unit& u, int wr, int wc, int fr, int fq) const {
        const int row0 = u.pm * BM + wr * 64 + fr, col0 = u.pn * BM + wc * 32 + 8 * fq;
        const float* gp = gate + (size_t)((u.pm * BM) >> 11) * gstride + col0;
        f32x4 gv[2][2];
#pragma unroll
        for (int bj = 0; bj < 2; ++bj)
#pragma unroll
            for (int n = 0; n < 2; ++n) gv[bj][n] = *(const f32x4*)(gp + bj * HALF + 4 * n) * sc;
#pragma unroll
        for (int ai = 0; ai < 2; ++ai)
#pragma unroll
            for (int m = 0; m < 4; ++m) { const size_t off = (size_t)(row0 + ai * HALF + m * 16) * ldc + col0;
#pragma unroll
                for (int bj = 0; bj < 2; ++bj) { f32x4 b0, b1;
                    if (BASE16) { const u32x4 r = *(const u32x4*)((const bf16_t*)base + off + bj * HALF);
                        b0 = (f32x4){__uint_as_float(r.x << 16), __uint_as_float(r.x & 0xffff0000u), __uint_as_float(r.y << 16), __uint_as_float(r.y & 0xffff0000u)};
                        b1 = (f32x4){__uint_as_float(r.z << 16), __uint_as_float(r.z & 0xffff0000u), __uint_as_float(r.w << 16), __uint_as_float(r.w & 0xffff0000u)}; }
                    else { b0 = *(const f32x4*)((const float*)base + off + bj * HALF); b1 = *(const f32x4*)((const float*)base + off + bj * HALF + 4); }
                    const f32x4 v0 = b0 + gv[bj][0] * acc[ai][bj][m][0], v1 = b1 + gv[bj][1] * acc[ai][bj][m][1];
                    u32x4 w; w.x = cvt_pk_bf16(v0[0], v0[1]); w.y = cvt_pk_bf16(v0[2], v0[3]); w.z = cvt_pk_bf16(v1[0], v1[1]); w.w = cvt_pk_bf16(v1[2], v1[3]);
                    *(u32x4*)(out + off + bj * HALF) = w; }
                asm volatile("" ::: "memory"); }
    }
};
struct EpiF32 {
    static constexpr bool PERM = false, XBAR = false;
    float* C; int ldc; float sc;
    __device__ __forceinline__ void operator()(const f32x4 (&acc)[2][2][4][2], const Unit& u, int wr, int wc, int fr, int fq) const {
        const int row0 = u.pm * BM + wr * 64 + fr, col0 = u.pn * BM + wc * 32 + 4 * fq;
#pragma unroll
        for (int ai = 0; ai < 2; ++ai)
#pragma unroll
            for (int m = 0; m < 4; ++m) { float* rowp = C + (size_t)(row0 + ai * HALF + m * 16) * ldc + col0;
#pragma unroll
                for (int bj = 0; bj < 2; ++bj)
#pragma unroll
                    for (int n = 0; n < 2; ++n) *(f32x4*)(rowp + bj * HALF + n * 16) = acc[ai][bj][m][n] * sc; }
    }
};

template <class Epi, class Sched, bool F8 = false, int HOT = 0, int SCH = GEMM_SCH>
__device__ __forceinline__ void gemm_phase(LAS unsigned char* lds, const Gemm g, const Sched& S, const Epi& E) {
    const int tid = threadIdx.x, wid = __builtin_amdgcn_readfirstlane(tid >> 6), lane = tid & 63, wr = wid >> 2, wc = wid & 3, fr = lane & 15, fq = lane >> 4;
    const int rowb = F8 ? g.K : 2 * g.K, nt = g.ntk ? g.ntk : rowb / (BK * 2);
    unsigned voffA[2], voffB[2];
#pragma unroll
    for (int i = 0; i < 2; ++i) { int R, C; stage_rc(tid * 16 + i * 8192, R, C); const int Rb = Epi::PERM ? ((R & ~31) + perm32(R & 31)) : R;
        voffA[i] = (unsigned)(R * rowb + C * 2); voffB[i] = (unsigned)(Rb * rowb + C * 2); }
    const size_t kstep = (size_t)(BK * 2);
    const size_t hstep = (size_t)HALF * rowb;
    const size_t tstep = 2 * hstep;
    const unsigned ldsw = (unsigned)wid * 1024u;
    const int aoff = lds_byte(wr * 64 + fr, fq * 8), boff = lds_byte(wc * 32 + fr, fq * 8);
#define PG8_SA(b, h) (((b) * 2 + (h)) * HTB)
#define PG8_SB(b, h) ((4 + (b) * 2 + (h)) * HTB)
#define PG8_STAGE(bufoff, gbase, voff) do { _Pragma("unroll") for (int _i = 0; _i < 2; ++_i) \
        __builtin_amdgcn_global_load_lds((const unsigned*)((const char*)(gbase) + (voff)[_i]), (LAS unsigned*)(lds + (bufoff) + ldsw + _i * 8192), 16, 0, 0); } while (0)
#define PG8_LD8(base_) __builtin_shufflevector(*(const LAS i32x4*)(base_), *(const LAS i32x4*)((base_) + 1024), 0, 1, 2, 3, 4, 5, 6, 7)
#define PG8_LDA(dst, b, h) do { _Pragma("unroll") for (int m = 0; m < 4; ++m) { if constexpr (F8) dst##8[m] = PG8_LD8(lds + PG8_SA(b, h) + aoff + m * 2048); \
        else { _Pragma("unroll") for (int k = 0; k < 2; ++k) dst[m][k] = *(const LAS bf16x8*)(lds + PG8_SA(b, h) + aoff + m * 2048 + k * 1024); } } } while (0)
#define PG8_LDB(dst, b, h) do { _Pragma("unroll") for (int n = 0; n < 2; ++n) { if constexpr (F8) dst##8[n] = PG8_LD8(lds + PG8_SB(b, h) + boff + n * 2048); \
        else { _Pragma("unroll") for (int k = 0; k < 2; ++k) dst[n][k] = *(const LAS bf16x8*)(lds + PG8_SB(b, h) + boff + n * 2048 + k * 1024); } } } while (0)
#define PG8_MMA(ai, bj, At, Bt) do { __builtin_amdgcn_s_setprio(1); _Pragma("unroll") for (int m = 0; m < 4; ++m) _Pragma("unroll") for (int n = 0; n < 2; ++n) { \
        if constexpr (F8) { asm volatile("v_mfma_f32_16x16x128_f8f6f4 %0, %1, %2, %0" : "+v"(acc[ai][bj][m][n]) : "v"(Bt##8[n]), "v"(At##8[m])); } \
        else { _Pragma("unroll") for (int k = 0; k < 2; ++k) acc[ai][bj][m][n] = __builtin_amdgcn_mfma_f32_16x16x32_bf16(Bt[n][k], At[m][k], acc[ai][bj][m][n], 0, 0, 0); } } \
        __builtin_amdgcn_s_setprio(0); } while (0)
#define PG8_WAIT_V(n) asm volatile("s_waitcnt vmcnt(" #n ")" ::: "memory")
#define PG8_WAIT_L(n) asm volatile("s_waitcnt lgkmcnt(" #n ")" ::: "memory")
#define PG8_BAR __builtin_amdgcn_s_barrier()
#define PG8_SCHED __builtin_amdgcn_sched_barrier(0)
    Unit cur, nxt; int ui = 0;
    if (!S.next(0, cur)) return;
    f32x4 acc[2][2][4][2];
#pragma unroll
    for (int a = 0; a < 2; ++a)
#pragma unroll
        for (int b = 0; b < 2; ++b)
#pragma unroll
            for (int m = 0; m < 4; ++m)
#pragma unroll
                for (int n = 0; n < 2; ++n) acc[a][b][m][n] = (f32x4){0.f, 0.f, 0.f, 0.f};
    bf16x8 At[4][2], B0[2][2], B1[2][2]; i32x8 At8[4], B08[2], B18[2];
    const char* cA = (const char*)g.A + cur.aoff + (size_t)(HOT ? 0 : cur.pm) * tstep; const char* cB = (const char*)g.Bt + cur.boff + (size_t)(HOT ? 0 : cur.pn) * tstep;
    if constexpr (SCH == 1) {
        PG8_STAGE(PG8_SB(0, 0), cB, voffB); PG8_STAGE(PG8_SB(0, 1), cB + hstep, voffB); PG8_STAGE(PG8_SA(0, 0), cA, voffA); PG8_STAGE(PG8_SA(0, 1), cA + hstep, voffA);
        if (wr == 1) PG8_BAR;
        PG8_WAIT_V(2); PG8_BAR;
        PG8_STAGE(PG8_SB(1, 0), cB + kstep, voffB); PG8_STAGE(PG8_SB(1, 1), cB + hstep + kstep, voffB); PG8_STAGE(PG8_SA(1, 0), cA + kstep, voffA);
        PG8_WAIT_V(6); PG8_BAR;
    } else {
    PG8_STAGE(PG8_SB(0, 0), cB, voffB); PG8_STAGE(PG8_SA(0, 0), cA, voffA); PG8_STAGE(PG8_SB(0, 1), cB + hstep, voffB); PG8_STAGE(PG8_SA(0, 1), cA + hstep, voffA);
    if (wr == 1) PG8_BAR;
    PG8_WAIT_V(4); PG8_BAR;
    PG8_STAGE(PG8_SB(1, 0), cB + kstep, voffB); PG8_STAGE(PG8_SA(1, 0), cA + kstep, voffA); PG8_STAGE(PG8_SB(1, 1), cB + hstep + kstep, voffB);
    PG8_WAIT_V(6); PG8_BAR;
    }
    for (;;) {
        const bool has_next = S.next(ui + 1, nxt);
        const char* nA = has_next ? (const char*)g.A + nxt.aoff + (size_t)(HOT ? 0 : nxt.pm) * tstep : cA; const char* nB = has_next ? (const char*)g.Bt + nxt.boff + (size_t)(HOT ? 0 : nxt.pn) * tstep : cB;
        for (int t = 0; t < nt; t += 2) {
            const bool last = (t == nt - 2);
            const char* a1 = cA + (size_t)(t + 1) * kstep;
            const char* a2 = last ? nA : cA + (size_t)(t + 2) * kstep; const char* b2 = last ? nB : cB + (size_t)(t + 2) * kstep;
            const char* a3 = a2 + kstep; const char* b3 = b2 + kstep;
            if constexpr (SCH == 1) {
                PG8_LDB(B0, 0, 0); PG8_LDB(B1, 0, 1); PG8_SCHED; PG8_LDA(At, 0, 0); PG8_STAGE(PG8_SA(1, 1), a1 + hstep, voffA);
                PG8_WAIT_V(8); PG8_WAIT_L(0); PG8_BAR; PG8_MMA(0, 0, At, B0); PG8_MMA(0, 1, At, B1); PG8_BAR; PG8_SCHED;
                PG8_LDA(At, 0, 1); PG8_STAGE(PG8_SB(0, 0), b2, voffB); PG8_STAGE(PG8_SB(0, 1), b2 + hstep, voffB); PG8_STAGE(PG8_SA(0, 0), a2, voffA);
                PG8_WAIT_V(8); PG8_WAIT_L(0); PG8_BAR; PG8_MMA(1, 0, At, B0); PG8_MMA(1, 1, At, B1); PG8_BAR; PG8_SCHED;
                PG8_LDB(B0, 1, 0); PG8_LDB(B1, 1, 1); PG8_SCHED; PG8_LDA(At, 1, 0); PG8_STAGE(PG8_SA(0, 1), a2 + hstep, voffA);
                PG8_WAIT_V(8); PG8_WAIT_L(0); PG8_BAR; PG8_MMA(0, 0, At, B0); PG8_MMA(0, 1, At, B1); PG8_BAR; PG8_SCHED;
                PG8_LDA(At, 1, 1); PG8_STAGE(PG8_SB(1, 0), b3, voffB); PG8_STAGE(PG8_SB(1, 1), b3 + hstep, voffB); PG8_STAGE(PG8_SA(1, 0), a3, voffA);
                PG8_WAIT_V(8); PG8_WAIT_L(0); PG8_BAR; PG8_MMA(1, 0, At, B0); PG8_MMA(1, 1, At, B1); PG8_BAR; PG8_SCHED;
                continue;
            }
            PG8_LDB(B0, 0, 0); PG8_SCHED; PG8_LDA(At, 0, 0); PG8_STAGE(PG8_SA(1, 1), a1 + hstep, voffA);
            PG8_WAIT_L(8); PG8_BAR; PG8_WAIT_L(0); PG8_MMA(0, 0, At, B0); PG8_BAR; PG8_SCHED;
            PG8_LDB(B1, 0, 1); PG8_STAGE(PG8_SB(0, 0), b2, voffB);
            PG8_BAR; PG8_WAIT_L(0); PG8_MMA(0, 1, At, B1); PG8_BAR;
            PG8_LDA(At, 0, 1); PG8_STAGE(PG8_SA(0, 0), a2, voffA);
            PG8_BAR; PG8_WAIT_L(0); PG8_MMA(1, 0, At, B0); PG8_BAR; PG8_SCHED;
            PG8_STAGE(PG8_SB(0, 1), b2 + hstep, voffB);
            PG8_WAIT_V(6); PG8_BAR; PG8_MMA(1, 1, At, B1); PG8_BAR;
            PG8_LDB(B0, 1, 0); PG8_SCHED; PG8_LDA(At, 1, 0); PG8_STAGE(PG8_SA(0, 1), a2 + hstep, voffA);
            PG8_WAIT_L(8); PG8_BAR; PG8_WAIT_L(0); PG8_MMA(0, 0, At, B0); PG8_BAR; PG8_SCHED;
            PG8_LDB(B1, 1, 1); PG8_STAGE(PG8_SB(1, 0), b3, voffB);
            PG8_BAR; PG8_WAIT_L(0); PG8_MMA(0, 1, At, B1); PG8_BAR;
            PG8_LDA(At, 1, 1); PG8_STAGE(PG8_SA(1, 0), a3, voffA);
            PG8_BAR; PG8_WAIT_L(0); PG8_MMA(1, 0, At, B0); PG8_BAR; PG8_SCHED;
            PG8_STAGE(PG8_SB(1, 1), b3 + hstep, voffB);
            PG8_WAIT_V(6); PG8_BAR; PG8_MMA(1, 1, At, B1); PG8_BAR;
        }
        if constexpr (F8) asm volatile("s_nop 15\n\ts_nop 15" ::: "memory");
        if constexpr (Epi::XBAR) { LAS float* P_ = (LAS float*)(lds + STAGE_BYTES); E.pre(acc, wr, wc, fr, fq, P_); PG8_WAIT_L(0); PG8_BAR; asm volatile("" ::: "memory"); E.post(acc, cur, wr, wc, fr, fq, P_); }
        else E(acc, cur, wr, wc, fr, fq);
        if (!has_next) break;
#pragma unroll
        for (int a = 0; a < 2; ++a)
#pragma unroll
            for (int b = 0; b < 2; ++b)
#pragma unroll
                for (int m = 0; m < 4; ++m)
#pragma unroll
                    for (int n = 0; n < 2; ++n) acc[a][b][m][n] = (f32x4){0.f, 0.f, 0.f, 0.f};
        cur = nxt; cA = nA; cB = nB; ++ui;
    }
    PG8_WAIT_V(0);
    if (wr == 0) PG8_BAR;
    PG8_BAR;
#undef PG8_SA
#undef PG8_SB
#undef PG8_STAGE
#undef PG8_LDA
#undef PG8_LDB
#undef PG8_MMA
#undef PG8_WAIT_V
#undef PG8_WAIT_L
#undef PG8_BAR
#undef PG8_SCHED
}
}

DI void mod_phase(const float* c, const float* mod_w, const float* mod_b, float* mod, LAS unsigned char* lds, int G, int tid, int lane, int wave) {
    LAS f32x4* cact = (LAS f32x4*)lds;
    LAS float* red = (LAS float*)(lds + 32768);
    for (int k = tid; k < DM; k += NTHREADS) { f32x4 v; v.x = silu_f(c[k]); v.y = silu_f(c[DM + k]); v.z = silu_f(c[2 * DM + k]); v.w = silu_f(c[3 * DM + k]); cact[k] = v; }
    __syncthreads();
    for (int it = blockIdx.x; it < 256; it += G) {
        const int l = it >> 7, n0 = (it & 127) * 96;
        float a0[4] = {0.f, 0.f, 0.f, 0.f}, a1[4] = {0.f, 0.f, 0.f, 0.f};
        if (lane < 48) {
            const float* wp = mod_w + ((size_t)l * DM + wave * 256) * 12288 + n0 + 2 * lane;
#pragma unroll 8
            for (int k = 0; k < 256; ++k) { const f32x2 w = *(const f32x2*)(wp + (size_t)k * 12288); const f32x4 cv = cact[wave * 256 + k];
                a0[0] += cv.x * w.x; a1[0] += cv.x * w.y; a0[1] += cv.y * w.x; a1[1] += cv.y * w.y; a0[2] += cv.z * w.x; a1[2] += cv.z * w.y; a0[3] += cv.w * w.x; a1[3] += cv.w * w.y; }
#pragma unroll
            for (int b = 0; b < 4; ++b) { red[(wave * 4 + b) * 96 + 2 * lane] = a0[b]; red[(wave * 4 + b) * 96 + 2 * lane + 1] = a1[b]; }
        }
        __syncthreads();
        if (tid < 384) { const int b = tid / 96, col = tid % 96; float s = mod_b[l * 12288 + n0 + col];
#pragma unroll
            for (int w = 0; w < 8; ++w) s += red[(w * 4 + b) * 96 + col];
            mod[((size_t)l * 4 + b) * 12288 + n0 + col] = s; }
        __syncthreads();
    }
}

template <int MODE>
DI void cvt_item(const float* W, int K, int N, bf16_t* WT, LAS float* scr, int kb, int nb, int lane) {
    const int k0 = 64 * kb, n0 = 32 * nb;
    float v[32];
    const float* wp = W + (size_t)(k0 + (lane >> 5)) * N + n0 + (lane & 31);
#pragma unroll
    for (int i = 0; i < 32; ++i) v[i] = wp[(size_t)(2 * i) * N];
#pragma unroll
    for (int i = 0; i < 32; ++i) scr[(2 * i + (lane >> 5)) * 33 + (lane & 31)] = v[i];
    LDS_WAIT();
    const int c = lane & 7;
#pragma unroll
    for (int j = 0; j < 4; ++j) { const int n = (lane >> 3) + 8 * j; const LAS float* s = scr + (8 * c) * 33 + n;
        u32x4 o; o.x = cvt_pk_bf16(s[0 * 33], s[1 * 33]); o.y = cvt_pk_bf16(s[2 * 33], s[3 * 33]); o.z = cvt_pk_bf16(s[4 * 33], s[5 * 33]); o.w = cvt_pk_bf16(s[6 * 33], s[7 * 33]);
        const int ng = n0 + n; const int row = (MODE == 0) ? ng : ((ng >> 7) * 256 + (ng & 127) + (MODE == 2 ? 128 : 0));
        *(u32x4*)(WT + (size_t)row * K + k0 + 8 * c) = o; }
    LDS_WAIT();
}
template <int MODE>
DI void cvt_item8(const float* W, int K, int N, unsigned char* WT, LAS float* scr, int kb, int nb, int lane, float wsc) {
    const int k0 = 64 * kb, n0 = 32 * nb;
    float v[32];
    const float* wp = W + (size_t)(k0 + (lane >> 5)) * N + n0 + (lane & 31);
#pragma unroll
    for (int i = 0; i < 32; ++i) v[i] = wp[(size_t)(2 * i) * N];
#pragma unroll
    for (int i = 0; i < 32; ++i) scr[(2 * i + (lane >> 5)) * 33 + (lane & 31)] = v[i] * wsc;
    LDS_WAIT();
    const int c = lane & 3;
#pragma unroll
    for (int j = 0; j < 2; ++j) { const int n = (lane >> 2) + 16 * j; const LAS float* s = scr + (16 * c) * 33 + n;
        u32x4 o; o.x = pk4_fp8(s[0 * 33], s[1 * 33], s[2 * 33], s[3 * 33]); o.y = pk4_fp8(s[4 * 33], s[5 * 33], s[6 * 33], s[7 * 33]);
        o.z = pk4_fp8(s[8 * 33], s[9 * 33], s[10 * 33], s[11 * 33]); o.w = pk4_fp8(s[12 * 33], s[13 * 33], s[14 * 33], s[15 * 33]);
        const int ng = n0 + n; const int row = (MODE == 0) ? ng : ((ng >> 7) * 256 + (ng & 127) + (MODE == 2 ? 128 : 0));
        *(u32x4*)(WT + (size_t)row * K + k0 + 16 * c) = o; }
    LDS_WAIT();
}
template <int MODE>
DI void cvt_job8(const float* W, int K, int N, int nbatch, unsigned char* WT, size_t dst_bstride, LAS float* scr, int gw, int NGW, int lane, float wsc) {
    const int nnb = N / 32, per = (K / 64) * nnb, total = per * nbatch;
    for (int it = gw; it < total; it += NGW) {
        const int bt = it / per, r = it - bt * per, kb = r / nnb, nb = r - kb * nnb;
        cvt_item8<MODE>(W + (size_t)bt * K * N, K, N, WT + (size_t)bt * dst_bstride, scr, kb, nb, lane, wsc);
    }
}
template <int MODE>
DI void cvt_job(const float* W, int K, int N, int nbatch, bf16_t* WT, size_t dst_bstride, LAS float* scr, int gw, int NGW, int lane) {
    const int nnb = N / 32, per = (K / 64) * nnb, total = per * nbatch;
    for (int it = gw; it < total; it += NGW) {
        const int bt = it / per, r = it - bt * per, kb = r / nnb, nb = r - kb * nnb;
        cvt_item<MODE>(W + (size_t)bt * K * N, K, N, WT + (size_t)bt * dst_bstride, scr, kb, nb, lane);
    }
}

DI void cvtw_load(f32x4 (&v)[16], const float* wp, int N) {
#pragma unroll
    for (int i = 0; i < 16; ++i) v[i] = __builtin_nontemporal_load((const f32x4*)(wp + (size_t)(4 * i) * N));
}
template <int MODE, bool OUT8>
DI void cvtw_store(const f32x4 (&v)[16], int K, void* WTb, LAS float* scr, int k0, int n0, int lane, float wsc) {
    const int kr = lane >> 4, n4 = lane & 15;
#pragma unroll
    for (int i = 0; i < 16; ++i)
#pragma unroll
        for (int e = 0; e < 4; ++e) scr[(4 * n4 + e) * 65 + 4 * i + kr] = OUT8 ? v[i][e] * wsc : v[i][e];
    LDS_WAIT();
    if (OUT8) {
        unsigned char* WT = (unsigned char*)WTb; const int c = lane & 3;
#pragma unroll
        for (int j = 0; j < 4; ++j) { const int n = (lane >> 2) + 16 * j; const LAS float* s = scr + n * 65 + 16 * c;
            u32x4 o; o.x = pk4_fp8(s[0], s[1], s[2], s[3]); o.y = pk4_fp8(s[4], s[5], s[6], s[7]); o.z = pk4_fp8(s[8], s[9], s[10], s[11]); o.w = pk4_fp8(s[12], s[13], s[14], s[15]);
            const int ng = n0 + n; const int row = (MODE == 0) ? ng : ((ng >> 7) * 256 + (ng & 127) + (MODE == 2 ? 128 : 0));
            *(u32x4*)(WT + (size_t)row * K + k0 + 16 * c) = o; }
    } else {
        bf16_t* WT = (bf16_t*)WTb; const int c = lane & 7;
#pragma unroll
        for (int j = 0; j < 8; ++j) { const int n = (lane >> 3) + 8 * j; const LAS float* s = scr + n * 65 + 8 * c;
            u32x4 o; o.x = cvt_pk_bf16(s[0], s[1]); o.y = cvt_pk_bf16(s[2], s[3]); o.z = cvt_pk_bf16(s[4], s[5]); o.w = cvt_pk_bf16(s[6], s[7]);
            const int ng = n0 + n; const int row = (MODE == 0) ? ng : ((ng >> 7) * 256 + (ng & 127) + (MODE == 2 ? 128 : 0));
            *(u32x4*)(WT + (size_t)row * K + k0 + 8 * c) = o; }
    }
    LDS_WAIT();
}
DI void cvtw_pack8(const f32x4 (&v)[16], LAS float* scr, int lane, float wsc, u32x4 (&o)[4]) {
    const int kr = lane >> 4, n4 = lane & 15;
#pragma unroll
    for (int i = 0; i < 16; ++i)
#pragma unroll
        for (int e = 0; e < 4; ++e) scr[(4 * n4 + e) * 65 + 4 * i + kr] = v[i][e] * wsc;
    LDS_WAIT();
    const int c = lane & 3;
#pragma unroll
    for (int j = 0; j < 4; ++j) { const int n = (lane >> 2) + 16 * j; const LAS float* s = scr + n * 65 + 16 * c;
        o[j].x = pk4_fp8(s[0], s[1], s[2], s[3]); o[j].y = pk4_fp8(s[4], s[5], s[6], s[7]); o[j].z = pk4_fp8(s[8], s[9], s[10], s[11]); o[j].w = pk4_fp8(s[12], s[13], s[14], s[15]); }
    LDS_WAIT();
}
template <int MODE, bool OUT8>
DI void cvtw_job(const float* W, int K, int N, int nbatch, void* WT, size_t dst_bstride_bytes, LAS float* scr, int gw, int NGW, int lane, float wsc, int ld = 0, int off = 0) {
    const int nnb = N / 64, per = (K / 128) * nnb, total = per * nbatch;
    const int pitch = ld ? ld : N;
    const int first = (gw + NGW - (off % NGW)) % NGW;
    if (first >= total) return;
#define CVTW_SRC(it_) ({ const int bt_ = (it_) / per, r_ = (it_) - bt_ * per, kb_ = r_ / nnb, nb_ = r_ - kb_ * nnb; W + (size_t)bt_ * K * pitch + (size_t)(128 * kb_ + (lane >> 4)) * pitch + 64 * nb_ + 4 * (lane & 15); })
    for (int it = first; it < total; it += NGW) {
        const int bt = it / per, r = it - bt * per, kb = r / nnb, nb = r - kb * nnb, k0 = 128 * kb, n0 = 64 * nb;
        f32x4 v0[16], v1[16];
        { const float* wp = CVTW_SRC(it); cvtw_load(v0, wp, pitch); cvtw_load(v1, wp + (size_t)64 * pitch, pitch); }
        void* WTb = (unsigned char*)WT + (size_t)bt * dst_bstride_bytes;
        if (OUT8) {
            u32x4 o0[4], o1[4];
            cvtw_pack8(v0, scr, lane, wsc, o0);
            cvtw_pack8(v1, scr, lane, wsc, o1);
            unsigned char* WT8 = (unsigned char*)WTb; const int c = lane & 3;
#pragma unroll
            for (int j = 0; j < 4; ++j) { const int ng = n0 + (lane >> 2) + 16 * j; const int row = (MODE == 0) ? ng : ((ng >> 7) * 256 + (ng & 127) + (MODE == 2 ? 128 : 0));
                unsigned char* dp = WT8 + (size_t)row * K + k0 + 16 * c; *(u32x4*)dp = o0[j]; *(u32x4*)(dp + 64) = o1[j]; }
        } else {
            cvtw_store<MODE, OUT8>(v0, K, WTb, scr, k0, n0, lane, wsc);
            cvtw_store<MODE, OUT8>(v1, K, WTb, scr, k0 + 64, n0, lane, wsc);
        }
    }
#undef CVTW_SRC
}

constexpr float HSCALE = 8.f, WSCALE = 256.f, ASCALE = 8.f;
template <bool ROUTER, bool OUT8 = false, bool X16 = false>
DI void rms_mod_phase(const void* X, const float* g, const float* scale, const float* shift, bf16_t* out,
                      const float* router, int* tok_e, int* tok_pos, float* tok_w, unsigned* ecnt, unsigned char* HS2, int gw, int NGW, int lane) {
    for (int row = gw; row < MTOK; row += NGW) {
        const int b = row >> 11;
        f32x4 v[8]; float ss = 0.f;
        if (X16) { const u32x2* xr = (const u32x2*)((const bf16_t*)X + (size_t)row * DM) + lane; u32x2 raw[8];
#pragma unroll
            for (int j = 0; j < 8; ++j) raw[j] = xr[64 * j];
#pragma unroll
            for (int j = 0; j < 8; ++j) v[j] = (f32x4){bf_lo(raw[j].x), bf_hi(raw[j].x), bf_lo(raw[j].y), bf_hi(raw[j].y)}; }
        else { const f32x4* xr = (const f32x4*)((const float*)X + (size_t)row * DM) + lane;
#pragma unroll
            for (int j = 0; j < 8; ++j) v[j] = xr[64 * j]; }
#pragma unroll
        for (int j = 0; j < 8; ++j) ss += (v[j].x * v[j].x + v[j].y * v[j].y) + (v[j].z * v[j].z + v[j].w * v[j].w);
        const float rstd = 1.0f / sqrtf(wave_sum(ss) * (1.f / DM) + 1e-6f);
        const f32x4* gp = (const f32x4*)g + lane; const f32x4* sc = (const f32x4*)(scale + (size_t)b * 12288) + lane; const f32x4* sh = (const f32x4*)(shift + (size_t)b * 12288) + lane;
        u32x2* op = (u32x2*)(out + (size_t)row * DM) + lane;
        float lg[8] = {0.f, 0.f, 0.f, 0.f, 0.f, 0.f, 0.f, 0.f}; unsigned h8[8];
#pragma unroll
        for (int j = 0; j < 8; ++j) { const f32x4 gg = gp[64 * j], s1 = sc[64 * j], s2 = sh[64 * j];
            f32x4 h = (v[j] * rstd) * gg; h = h * (s1 + 1.0f) + s2;
            if (ROUTER) { h8[j] = pk4_fp8(h.x * HSCALE, h.y * HSCALE, h.z * HSCALE, h.w * HSCALE); }
            else { u32x2 w; w.x = cvt_pk_bf16(h.x, h.y); w.y = cvt_pk_bf16(h.z, h.w); op[64 * j] = w;
                   if (OUT8) ((unsigned*)(HS2 + (size_t)row * DM) + lane)[64 * j] = pk4_fp8(h.x * HSCALE, h.y * HSCALE, h.z * HSCALE, h.w * HSCALE); }
            if (ROUTER) {
#pragma unroll
                for (int i = 0; i < 4; ++i) { const int cc = 256 * j + 4 * lane + i; const f32x4 r0 = ((const f32x4*)router)[cc * 2], r1 = ((const f32x4*)router)[cc * 2 + 1];
                    lg[0] += h[i] * r0.x; lg[1] += h[i] * r0.y; lg[2] += h[i] * r0.z; lg[3] += h[i] * r0.w; lg[4] += h[i] * r1.x; lg[5] += h[i] * r1.y; lg[6] += h[i] * r1.z; lg[7] += h[i] * r1.w; } } }
        if (ROUTER) {
#pragma unroll
            for (int e = 0; e < 8; ++e) lg[e] = wave_sum(lg[e]);
            if (lane == 0) {
                int i0 = 0; float v0 = lg[0];
#pragma unroll
                for (int e = 1; e < 8; ++e) if (lg[e] > v0) { v0 = lg[e]; i0 = e; }
                int i1 = -1; float v1 = -3.0e38f;
#pragma unroll
                for (int e = 0; e < 8; ++e) if (e != i0 && lg[e] > v1) { v1 = lg[e]; i1 = e; }
                const float w1 = 1.f / (1.f + expf(v0 - v1)), w0 = 1.f - w1;
                const int p0 = (int)__hip_atomic_fetch_add(ecnt + 64 * i0, 1u, __ATOMIC_RELAXED, __HIP_MEMORY_SCOPE_AGENT);
                const int p1 = (int)__hip_atomic_fetch_add(ecnt + 64 * i1, 1u, __ATOMIC_RELAXED, __HIP_MEMORY_SCOPE_AGENT);
                tok_e[2 * row] = i0; tok_e[2 * row + 1] = i1; tok_pos[2 * row] = p0; tok_pos[2 * row + 1] = p1; tok_w[2 * row] = w0; tok_w[2 * row + 1] = w1;
                lg[0] = __int_as_float(i0 * pg8::ECAP + p0); lg[1] = __int_as_float(i1 * pg8::ECAP + p1);
            }
            const int ra = __builtin_amdgcn_readfirstlane(__float_as_int(lg[0])), rb = __builtin_amdgcn_readfirstlane(__float_as_int(lg[1]));
            unsigned* da = (unsigned*)(HS2 + (size_t)ra * DM) + lane; unsigned* db = (unsigned*)(HS2 + (size_t)rb * DM) + lane;
#pragma unroll
            for (int j = 0; j < 8; ++j) { da[64 * j] = h8[j]; db[64 * j] = h8[j]; }
        }
    }
}

DI void qknorm_phase(const bf16_t* QK, bf16_t* QKN, const float* qg, const float* kg, int gw, int NGW, int lane) {
    const int l16 = lane & 15;
    for (int idx = gw * 4 + (lane >> 4); idx < MTOK * 32; idx += NGW * 4) {
        const int hr = idx & 31; const size_t off = (size_t)(idx >> 5) * 4096 + hr * 128 + 8 * l16;
        const u32x4 raw = *(const u32x4*)(QK + off);
        float x[8] = {bf_lo(raw.x), bf_hi(raw.x), bf_lo(raw.y), bf_hi(raw.y), bf_lo(raw.z), bf_hi(raw.z), bf_lo(raw.w), bf_hi(raw.w)};
        float ss = 0.f;
#pragma unroll
        for (int i = 0; i < 8; ++i) ss += x[i] * x[i];
        ss += __shfl_xor(ss, 1); ss += __shfl_xor(ss, 2); ss += __shfl_xor(ss, 4); ss += __shfl_xor(ss, 8);
        const float rstd = (1.0f / sqrtf(ss * (1.f / 128.f) + 1e-6f)) * (hr < 16 ? 0.08838834764831845f : 1.0f);
        const float* gp = (hr < 16 ? qg : kg) + 8 * l16;
        const f32x4 g0 = *(const f32x4*)gp, g1 = *(const f32x4*)(gp + 4);
        u32x4 o; o.x = cvt_pk_bf16(x[0] * rstd * g0.x, x[1] * rstd * g0.y); o.y = cvt_pk_bf16(x[2] * rstd * g0.z, x[3] * rstd * g0.w);
        o.z = cvt_pk_bf16(x[4] * rstd * g1.x, x[5] * rstd * g1.y); o.w = cvt_pk_bf16(x[6] * rstd * g1.z, x[7] * rstd * g1.w);
        *(u32x4*)(QKN + off) = o;
    }
}

constexpr int NA_TBL = 0, NA_BUF = 30720, NA_TILE = 18432;
DI void na_phase(const bf16_t* QKN, const bf16_t* VT, bf16_t* ATT, const float* rpb, LAS unsigned char* lds, int G, int vcu0, int tid, int lane, int wave) {
    LAS float* rpbL = (LAS float*)(lds + NA_TBL);
    for (int i = tid; i < 16 * 465; i += NTHREADS) rpbL[i] = rpb[i];
    const int c16 = lane & 15, g = lane >> 4, unit = wave >> 2, j = wave & 3;
    const int cb = (j == 0) ? 0 : (j == 1) ? 8 : (j == 2) ? 24 : 32;
    const int qc = 16 * j + c16, c0 = min(max(qc - 8, 0), 48);
    const int kcl = 8 * (c16 >> 2) + (c16 & 3);
    for (int p = vcu0; p < 1024; p += G) {
        const int rho = p & 15, hh = (p >> 4) & 15, b = p >> 8;
        const int rA = 2 * rho, r0A = min(max(rA - 4, 0), 24), r0B = min(max(rA + 1 - 4, 0), 24), delta = r0B - r0A, nrows = 8 + delta;
        const int r = rA + unit, r0 = unit ? r0B : r0A;
        const bool shiftB = (unit == 1) && (delta == 1);
        const size_t tq = (size_t)b * SEQ + r * 64 + qc;
        bf16x8 qf[4];
#pragma unroll
        for (int ks = 0; ks < 4; ++ks) qf[ks] = *(const bf16x8*)(QKN + tq * 4096 + hh * 128 + 32 * ks + 8 * g);
        f32x4 S[8][2];
        u32x4 st0, st1;
        const int kkey = tid >> 3, kch = tid & 7;
        const int vd = tid >> 2, vch = tid & 3;
        const bf16_t* kg = QKN + ((size_t)b * SEQ + (size_t)r0A * 64 + kkey) * 4096 + 2048 + hh * 128 + kch * 8;
        const bf16_t* vg = VT + (size_t)(hh * 128 + vd) * MTOK + (size_t)b * SEQ + (size_t)r0A * 64 + vch * 8;
#define NA_LDK(s_) do { st0 = *(const u32x4*)(kg + (size_t)(s_) * 64 * 4096); st1 = *(const u32x4*)(kg + (size_t)(s_) * 64 * 4096 + 64); } while (0)
#define NA_STK(s_) do { LAS unsigned char* t_ = lds + NA_BUF + ((s_) & 1) * NA_TILE + kkey * 272 + kch * 16; *(LAS u32x4*)t_ = st0; *(LAS u32x4*)(t_ + 128) = st1; } while (0)
#define NA_LDV(s_) do { st0 = *(const u32x4*)(vg + (s_) * 64); st1 = *(const u32x4*)(vg + (s_) * 64 + 32); } while (0)
#define NA_STV(s_) do { LAS unsigned char* t_ = lds + NA_BUF + ((s_) & 1) * NA_TILE + vd * 144 + vch * 16; *(LAS u32x4*)t_ = st0; *(LAS u32x4*)(t_ + 64) = st1; } while (0)
#define NA_QK(s_, i_) do { const LAS unsigned char* kb_ = lds + NA_BUF + ((s_) & 1) * NA_TILE + (cb + kcl) * 272 + 16 * g; \
            _Pragma("unroll") for (int hc = 0; hc < 2; ++hc) { f32x4 a = (f32x4){0.f, 0.f, 0.f, 0.f}; \
                _Pragma("unroll") for (int ks = 0; ks < 4; ++ks) a = __builtin_amdgcn_mfma_f32_16x16x32_bf16(*(const LAS bf16x8*)(kb_ + hc * 4 * 272 + 64 * ks), qf[ks], a, 0, 0, 0); S[i_][hc] = a; } } while (0)
#define NA_SROW(s_) do { if ((s_) < nrows) { NA_STK(s_); __syncthreads(); if ((s_) + 1 < nrows) NA_LDK((s_) + 1); \
            if (!shiftB) { if ((s_) < 8) NA_QK(s_, (s_) < 8 ? (s_) : 7); } else { if ((s_) >= 1) NA_QK(s_, (s_) >= 1 ? (s_) - 1 : 0); } } } while (0)
        __syncthreads();
        NA_LDK(0);
        NA_SROW(0); NA_SROW(1); NA_SROW(2); NA_SROW(3); NA_SROW(4); NA_SROW(5); NA_SROW(6); NA_SROW(7); NA_SROW(8);
        NA_LDV(0);
        float mx = -3.0e38f;
        const LAS float* bt = rpbL + hh * 465;
#pragma unroll
        for (int i = 0; i < 8; ++i)
#pragma unroll
            for (int hc = 0; hc < 2; ++hc)
#pragma unroll
                for (int e = 0; e < 4; ++e) {
                    const int kc = cb + 8 * g + 4 * hc + e; const bool valid = (kc >= c0) && (kc < c0 + 16);
                    const int dj = min(max(kc - qc + 15, 0), 30), di = r0 + i - r + 7;
                    const float sv = valid ? S[i][hc][e] + bt[di * 31 + dj] : -3.0e38f;
                    S[i][hc][e] = sv; mx = fmaxf(mx, sv);
                }
        mx = fmaxf(mx, __shfl_xor(mx, 16)); mx = fmaxf(mx, __shfl_xor(mx, 32));
        float sum = 0.f;
#pragma unroll
        for (int i = 0; i < 8; ++i)
#pragma unroll
            for (int hc = 0; hc < 2; ++hc)
#pragma unroll
                for (int e = 0; e < 4; ++e) { const float pv = (S[i][hc][e] > -1.0e38f) ? __expf(S[i][hc][e] - mx) : 0.f; S[i][hc][e] = pv; sum += pv; }
        sum += __shfl_xor(sum, 16); sum += __shfl_xor(sum, 32);
        const float inv = 1.0f / sum;
        f32x4 O[8];
#pragma unroll
        for (int dt = 0; dt < 8; ++dt) O[dt] = (f32x4){0.f, 0.f, 0.f, 0.f};
#define NA_PV(s_, i_) do { u32x4 pw; pw.x = cvt_pk_bf16(S[i_][0][0], S[i_][0][1]); pw.y = cvt_pk_bf16(S[i_][0][2], S[i_][0][3]); pw.z = cvt_pk_bf16(S[i_][1][0], S[i_][1][1]); pw.w = cvt_pk_bf16(S[i_][1][2], S[i_][1][3]); \
            const bf16x8 pf = __builtin_bit_cast(bf16x8, pw); const LAS unsigned char* vb_ = lds + NA_BUF + ((s_) & 1) * NA_TILE + c16 * 144 + (cb + 8 * g) * 2; \
            _Pragma("unroll") for (int dt = 0; dt < 8; ++dt) O[dt] = __builtin_amdgcn_mfma_f32_16x16x32_bf16(*(const LAS bf16x8*)(vb_ + dt * 16 * 144), pf, O[dt], 0, 0, 0); } while (0)
#define NA_VROW(s_) do { if ((s_) < nrows) { NA_STV(s_); __syncthreads(); if ((s_) + 1 < nrows) NA_LDV((s_) + 1); \
            if (!shiftB) { if ((s_) < 8) NA_PV(s_, (s_) < 8 ? (s_) : 7); } else { if ((s_) >= 1) NA_PV(s_, (s_) >= 1 ? (s_) - 1 : 0); } } } while (0)
        __syncthreads();
        NA_VROW(0); NA_VROW(1); NA_VROW(2); NA_VROW(3); NA_VROW(4); NA_VROW(5); NA_VROW(6); NA_VROW(7); NA_VROW(8);
#undef NA_LDK
#undef NA_STK
#undef NA_LDV
#undef NA_STV
#undef NA_QK
#undef NA_SROW
#undef NA_PV
#undef NA_VROW
#pragma unroll
        for (int dt = 0; dt < 8; ++dt) { u32x2 w; w.x = cvt_pk_bf16(O[dt][0] * inv, O[dt][1] * inv); w.y = cvt_pk_bf16(O[dt][2] * inv, O[dt][3] * inv);
            *(u32x2*)(ATT + tq * DM + hh * 128 + 16 * dt + 4 * g) = w; }
    }
}

constexpr int MLP_WIF = 36864, MLP_WROW = 3088;
DI void ml_pre_phase(const bf16_t* XZ, const float* conv_w, const float* conv_b, const float* wq, const float* wk, const float* wv, const bf16_t* WTif,
                     bf16_t* XC, bf16_t* Q, bf16_t* Kb, bf16_t* V, float* pre_part, LAS unsigned char* lds, int G, int tid, int lane, int wave) {
    LAS float* Lcw = (LAS float*)lds;
    LAS float* Lcb = Lcw + 2560;
    LAS float* Lwq = Lcb + 512;
    LAS float* Lwk = Lwq + 2048;
    LAS float* Lwv = Lwk + 2048;
    LAS unsigned char* Lwif = lds + MLP_WIF;
    const int g = lane >> 4, tk = lane & 15;
    for (int item = blockIdx.x; item < 256; item += G) {
        const int hd = item & 7, tr = item >> 3;
        __syncthreads();
        for (int i = tid; i < 2560; i += NTHREADS) Lcw[i] = conv_w[(i >> 9) * 4096 + hd * 512 + (i & 511)];
        Lcb[tid] = conv_b[hd * 512 + tid];
        for (int i = tid; i < 2048; i += NTHREADS) { Lwq[i] = wq[hd * 2048 + i]; Lwk[i] = wk[hd * 2048 + i]; Lwv[i] = wv[hd * 2048 + i]; }
        for (int i = tid; i < 32 * 3 * 64; i += NTHREADS) { const int n = i / 192, rem = i - n * 192, sec = rem >> 6, c16 = rem & 63;
            *(LAS u32x4*)(Lwif + n * MLP_WROW + sec * 1024 + c16 * 16) = *(const u32x4*)(WTif + (size_t)n * 12288 + sec * 4096 + hd * 512 + c16 * 8); }
        __syncthreads();
        for (int tt = wave; tt < 16; tt += 8) {
            const int tok = tr * 256 + tt * 16 + tk, tseq = tok & 2047;
            f32x4 accp[2]; accp[0] = (f32x4){0.f, 0.f, 0.f, 0.f}; accp[1] = (f32x4){0.f, 0.f, 0.f, 0.f};
            u32x4 xrA[5], xrB[5], hq, hk, hv, hc;
#define MLP_LOAD(xr_, step_) do { const int ch_ = hd * 512 + (step_) * 32 + 8 * g; \
                _Pragma("unroll") for (int jt = 0; jt < 5; ++jt) { const int dt = jt - 2; const bool ok = (unsigned)(tseq + dt) < (unsigned)SEQ; \
                    xr_[jt] = (u32x4){0u, 0u, 0u, 0u}; if (ok) xr_[jt] = *(const u32x4*)(XZ + (size_t)(tok + dt) * 8192 + ch_); } } while (0)
#define MLP_COMPUTE(xr_, step_, HOLD_) do { \
                const int cl = (step_) * 32 + 8 * g, ch = hd * 512 + cl; \
                float a[8], xm[8]; \
                { const f32x4 b0 = *(const LAS f32x4*)(Lcb + cl), b1 = *(const LAS f32x4*)(Lcb + cl + 4); \
                  a[0] = b0.x; a[1] = b0.y; a[2] = b0.z; a[3] = b0.w; a[4] = b1.x; a[5] = b1.y; a[6] = b1.z; a[7] = b1.w; } \
                _Pragma("unroll") for (int jt = 0; jt < 5; ++jt) { \
                    const u32x4 xr = xr_[jt]; \
                    const float xv[8] = {bf_lo(xr.x), bf_hi(xr.x), bf_lo(xr.y), bf_hi(xr.y), bf_lo(xr.z), bf_hi(xr.z), bf_lo(xr.w), bf_hi(xr.w)}; \
                    const f32x4 w0 = *(const LAS f32x4*)(Lcw + jt * 512 + cl), w1 = *(const LAS f32x4*)(Lcw + jt * 512 + cl + 4); \
                    a[0] += xv[0] * w0.x; a[1] += xv[1] * w0.y; a[2] += xv[2] * w0.z; a[3] += xv[3] * w0.w; a[4] += xv[4] * w1.x; a[5] += xv[5] * w1.y; a[6] += xv[6] * w1.z; a[7] += xv[7] * w1.w; \
                    if (jt == 2) { _Pragma("unroll") for (int i = 0; i < 8; ++i) xm[i] = xv[i]; } } \
                float xc[8], q[8], k[8], v[8]; \
                _Pragma("unroll") for (int i = 0; i < 8; ++i) xc[i] = silu_f(a[i]); \
                _Pragma("unroll") for (int blk = 0; blk < 2; ++blk) { const int wo = ((cl >> 2) + blk) * 16; \
                    _Pragma("unroll") for (int o = 0; o < 4; ++o) { float sq = 0.f, sk = 0.f, sv = 0.f; \
                        _Pragma("unroll") for (int i = 0; i < 4; ++i) { sq += xc[4 * blk + i] * Lwq[wo + i * 4 + o]; sk += xc[4 * blk + i] * Lwk[wo + i * 4 + o]; sv += xm[4 * blk + i] * Lwv[wo + i * 4 + o]; } \
                        q[4 * blk + o] = sq; k[4 * blk + o] = sk; v[4 * blk + o] = sv; } } \
                u32x4 qw, kw, vw, cw; \
                qw.x = cvt_pk_bf16(q[0], q[1]); qw.y = cvt_pk_bf16(q[2], q[3]); qw.z = cvt_pk_bf16(q[4], q[5]); qw.w = cvt_pk_bf16(q[6], q[7]); \
                kw.x = cvt_pk_bf16(k[0], k[1]); kw.y = cvt_pk_bf16(k[2], k[3]); kw.z = cvt_pk_bf16(k[4], k[5]); kw.w = cvt_pk_bf16(k[6], k[7]); \
                vw.x = cvt_pk_bf16(v[0], v[1]); vw.y = cvt_pk_bf16(v[2], v[3]); vw.z = cvt_pk_bf16(v[4], v[5]); vw.w = cvt_pk_bf16(v[6], v[7]); \
                cw.x = cvt_pk_bf16(xc[0], xc[1]); cw.y = cvt_pk_bf16(xc[2], xc[3]); cw.z = cvt_pk_bf16(xc[4], xc[5]); cw.w = cvt_pk_bf16(xc[6], xc[7]); \
                const size_t o4 = (size_t)tok * 4096 + ch; \
                if (HOLD_) { hq = qw; hk = kw; hv = vw; hc = cw; }     \
                else { *(u32x4*)(Q + o4 - 32) = hq; *(u32x4*)(Q + o4) = qw; *(u32x4*)(Kb + o4 - 32) = hk; *(u32x4*)(Kb + o4) = kw; *(u32x4*)(V + o4 - 32) = hv; *(u32x4*)(V + o4) = vw; *(u32x4*)(XC + o4 - 32) = hc; *(u32x4*)(XC + o4) = cw; } \
                const bf16x8 qf = __builtin_bit_cast(bf16x8, qw), kf = __builtin_bit_cast(bf16x8, kw), vf = __builtin_bit_cast(bf16x8, vw); \
                _Pragma("unroll") for (int nt = 0; nt < 2; ++nt) { const LAS unsigned char* wp = Lwif + (nt * 16 + tk) * MLP_WROW + cl * 2; \
                    accp[nt] = __builtin_amdgcn_mfma_f32_16x16x32_bf16(qf, *(const LAS bf16x8*)(wp), accp[nt], 0, 0, 0); \
                    accp[nt] = __builtin_amdgcn_mfma_f32_16x16x32_bf16(kf, *(const LAS bf16x8*)(wp + 1024), accp[nt], 0, 0, 0); \
                    accp[nt] = __builtin_amdgcn_mfma_f32_16x16x32_bf16(vf, *(const LAS bf16x8*)(wp + 2048), accp[nt], 0, 0, 0); } } while (0)
            MLP_LOAD(xrA, 0);
#pragma unroll 1
            for (int step = 0; step < 16; step += 2) {
                MLP_LOAD(xrB, step + 1);
                MLP_COMPUTE(xrA, step, true);
                { const int sn = (step + 2 < 16) ? step + 2 : 15; MLP_LOAD(xrA, sn); }
                MLP_COMPUTE(xrB, step + 1, false);
            }
#undef MLP_LOAD
#undef MLP_COMPUTE
#pragma unroll
            for (int nt = 0; nt < 2; ++nt)
#pragma unroll
                for (int e = 0; e < 4; ++e) pre_part[((size_t)hd * 32 + nt * 16 + tk) * MTOK + tr * 256 + tt * 16 + 4 * g + e] = accp[nt][e];
        }
    }
}

constexpr int ML_QS0 = 0, ML_KS0 = 16384, ML_QS1 = 32768, ML_KS1 = 49152, ML_VS0 = 65536, ML_VS1 = 81920, ML_WV = 98304, ML_SS = 114688, ML_SM = 123904;
constexpr int ML_XS = ML_QS1, ML_XN = ML_QS1;
constexpr int GB_U = 0, GB_MR = 64, GB_W = 128, GB_INT = 192, GB_BND = 256, GB_SC = 320;
constexpr int SM_DIN0 = 768, SM_DIN1 = 832, SM_NV = 896, SM_NVP = 1408, SM_DNQP = 3456, SM_GS = 3968, SM_CMX = 4000, SM_MC = 4032, SM_END = 4096;
static_assert(ML_SM + SM_END * 4 <= LDS_BYTES - 16, "mLSTM LDS");
constexpr float KSCALE = 0.04419417382415922f;

DI s16x4 tr_read(LAS unsigned char* p) { return __builtin_amdgcn_ds_read_tr16_b64_v4i16((LAS s16x4*)p); }
DI int dimg(int row, int ch) { return 2048 * (row >> 3) + 512 * (ch >> 2) + 64 * (row & 7) + 16 * ((ch & 3) ^ ((row >> 2) & 3)); }
DI bf16x8 frag_tr(LAS unsigned char* img, int k0, int c0, int lane) {
    const int h = lane >> 5, blk = (lane >> 4) & 1, q = (lane & 15) >> 2, p = lane & 3;
    const int row = k0 + 8 * h + q, ch = (c0 >> 3) + 2 * blk + (p >> 1), sub = 8 * (p & 1);
    const s16x4 lo = tr_read(img + dimg(row, ch) + sub), hi = tr_read(img + dimg(row + 4, ch) + sub);
    return __builtin_shufflevector(lo, hi, 0, 1, 2, 3, 4, 5, 6, 7);
}
#define MFMA32(a, b, c) __builtin_amdgcn_mfma_f32_32x32x16_bf16((a), (b), (c), 0, 0, 0)
DI void tr_batch4(bf16x8 (&f)[4], unsigned alo, unsigned ahi) {
    s16x4 l0, l1, l2, l3, h0, h1, h2, h3;
    asm volatile("ds_read_b64_tr_b16 %0, %8\n\tds_read_b64_tr_b16 %4, %9\n\tds_read_b64_tr_b16 %1, %8 offset:4096\n\tds_read_b64_tr_b16 %5, %9 offset:4096\n\t"
                 "ds_read_b64_tr_b16 %2, %8 offset:8192\n\tds_read_b64_tr_b16 %6, %9 offset:8192\n\tds_read_b64_tr_b16 %3, %8 offset:12288\n\tds_read_b64_tr_b16 %7, %9 offset:12288\n\t"
                 "s_waitcnt lgkmcnt(0)"
                 : "=&v"(l0), "=&v"(l1), "=&v"(l2), "=&v"(l3), "=&v"(h0), "=&v"(h1), "=&v"(h2), "=&v"(h3) : "v"(alo), "v"(ahi) : "memory");
    f[0] = __builtin_shufflevector(l0, h0, 0, 1, 2, 3, 4, 5, 6, 7); f[1] = __builtin_shufflevector(l1, h1, 0, 1, 2, 3, 4, 5, 6, 7);
    f[2] = __builtin_shufflevector(l2, h2, 0, 1, 2, 3, 4, 5, 6, 7); f[3] = __builtin_shufflevector(l3, h3, 0, 1, 2, 3, 4, 5, 6, 7);
}

DI void tr_issue4(s16x4& l0, s16x4& l1, s16x4& l2, s16x4& l3, s16x4& h0, s16x4& h1, s16x4& h2, s16x4& h3, unsigned alo, unsigned ahi) {
    asm volatile("ds_read_b64_tr_b16 %0, %8\n\tds_read_b64_tr_b16 %4, %9\n\tds_read_b64_tr_b16 %1, %8 offset:4096\n\tds_read_b64_tr_b16 %5, %9 offset:4096\n\t"
                 "ds_read_b64_tr_b16 %2, %8 offset:8192\n\tds_read_b64_tr_b16 %6, %9 offset:8192\n\tds_read_b64_tr_b16 %3, %8 offset:12288\n\tds_read_b64_tr_b16 %7, %9 offset:12288"
                 : "=&v"(l0), "=&v"(l1), "=&v"(l2), "=&v"(l3), "=&v"(h0), "=&v"(h1), "=&v"(h2), "=&v"(h3) : "v"(alo), "v"(ahi) : "memory");
}
DI void tr_wait8(s16x4& l0, s16x4& l1, s16x4& l2, s16x4& l3, s16x4& h0, s16x4& h1, s16x4& h2, s16x4& h3) {
    asm volatile("s_waitcnt lgkmcnt(0)" : "+v"(l0), "+v"(l1), "+v"(l2), "+v"(l3), "+v"(h0), "+v"(h1), "+v"(h2), "+v"(h3) :: "memory");
}
#define TR_CAT(f, l, h) do { f[0] = __builtin_shufflevector(l##0, h##0, 0, 1, 2, 3, 4, 5, 6, 7); f[1] = __builtin_shufflevector(l##1, h##1, 0, 1, 2, 3, 4, 5, 6, 7); \
        f[2] = __builtin_shufflevector(l##2, h##2, 0, 1, 2, 3, 4, 5, 6, 7); f[3] = __builtin_shufflevector(l##3, h##3, 0, 1, 2, 3, 4, 5, 6, 7); } while (0)

template <int I>
DI void ml_step(LAS unsigned char* lds, u32x4 (&Cp)[8][2], f32x16 (&num)[2], f32x16& Sacc, float& dnq, int tid, int lane, int wave, int gb) {
    asm volatile("" : "+v"(lane)); asm volatile("" : "+v"(tid));
    constexpr int QS = (I & 1) ? ML_QS1 : ML_QS0, KS = (I & 1) ? ML_KS1 : ML_KS0;
    const int r = lane & 31, h = lane >> 5, vt = wave & 3, dpar = wave >> 2;
    LAS float* SM = (LAS float*)(lds + ML_SM);
#define ML_SEC1 { const int wS = wave & 3, st = wS >> 1, tt1 = wS & 1, kh = wave >> 2; \
      if (!(st == 1 && tt1 == 0)) { \
        _Pragma("unroll") for (int ks = 0; ks < 4; ++ks) { const int kk = 4 * kh + ks; \
            const bf16x8 a = *(const LAS bf16x8*)(lds + KS + dimg(32 * st + r, 2 * kk + h)); \
            const bf16x8 b = *(const LAS bf16x8*)(lds + QS + dimg(32 * tt1 + r, 2 * kk + h)); \
            Sacc = MFMA32(a, b, Sacc); } } }
#define ML_SEC4 { _Pragma("unroll") for (int jj = 0; jj < 2; ++jj) { const int dl = dpar + 2 * jj; \
        _Pragma("unroll") for (int s2 = 0; s2 < 2; ++s2) { const bf16x8 a = __builtin_bit_cast(bf16x8, Cp[2 * I + jj][s2]); \
            _Pragma("unroll") for (int tt = 0; tt < 2; ++tt) { LAS unsigned char* qb = lds + QS + 8 * h; \
                const s16x4 lo = *(const LAS s16x4*)(qb + dimg(32 * tt + r, 4 * dl + 2 * s2)), hi = *(const LAS s16x4*)(qb + dimg(32 * tt + r, 4 * dl + 2 * s2 + 1)); \
                num[tt] = MFMA32(a, __builtin_shufflevector(lo, hi, 0, 1, 2, 3, 4, 5, 6, 7), num[tt]); } } } }
#define ML_UPD(jj_) { _Pragma("unroll") for (int s2 = 0; s2 < 2; ++s2) { const u32x4 o = Cp[2 * I + (jj_)][s2]; u32x4 n; \
            n.x = cvt_pk_bf16(bf_lo(o.x) * decay + U[8 * s2 + 0], bf_hi(o.x) * decay + U[8 * s2 + 1]); n.y = cvt_pk_bf16(bf_lo(o.y) * decay + U[8 * s2 + 2], bf_hi(o.y) * decay + U[8 * s2 + 3]); \
            n.z = cvt_pk_bf16(bf_lo(o.z) * decay + U[8 * s2 + 4], bf_hi(o.z) * decay + U[8 * s2 + 5]); n.w = cvt_pk_bf16(bf_lo(o.w) * decay + U[8 * s2 + 6], bf_hi(o.w) * decay + U[8 * s2 + 7]); \
            asm volatile("" : "+v"(n)); Cp[2 * I + (jj_)][s2] = n; } }
#define ML_SEC5 { const float decay = SM[gb + GB_SC + 0]; \
      const int blk = (lane >> 4) & 1, q = (lane & 15) >> 2, p = lane & 3, sub = 8 * (p & 1), rlo = 8 * h + q; \
      const unsigned ldsu = (unsigned)(size_t)lds; const int chB = 4 * vt + 2 * blk + (p >> 1), chA0 = 4 * dpar + 2 * blk + (p >> 1), chA1 = chA0 + 8; \
      s16x4 bl0, bl1, bl2, bl3, bh0, bh1, bh2, bh3, al0, al1, al2, al3, ah0, ah1, ah2, ah3, cl0, cl1, cl2, cl3, ch0, ch1, ch2, ch3; \
      tr_issue4(bl0, bl1, bl2, bl3, bh0, bh1, bh2, bh3, ldsu + ML_WV + dimg(rlo, chB) + sub, ldsu + ML_WV + dimg(rlo + 4, chB) + sub); \
      tr_issue4(al0, al1, al2, al3, ah0, ah1, ah2, ah3, ldsu + KS + dimg(rlo, chA0) + sub, ldsu + KS + dimg(rlo + 4, chA0) + sub); \
      tr_wait8(al0, al1, al2, al3, ah0, ah1, ah2, ah3); tr_wait8(bl0, bl1, bl2, bl3, bh0, bh1, bh2, bh3); \
      tr_issue4(cl0, cl1, cl2, cl3, ch0, ch1, ch2, ch3, ldsu + KS + dimg(rlo, chA1) + sub, ldsu + KS + dimg(rlo + 4, chA1) + sub); \
      bf16x8 Bf[4], Af[4]; TR_CAT(Bf, bl, bh); TR_CAT(Af, al, ah); \
      f32x16 U; \
      _Pragma("unroll") for (int e = 0; e < 16; ++e) U[e] = 0.f; \
      _Pragma("unroll") for (int ks = 0; ks < 4; ++ks) U = MFMA32(Af[ks], Bf[ks], U); \
      ML_UPD(0) \
      tr_wait8(cl0, cl1, cl2, cl3, ch0, ch1, ch2, ch3); TR_CAT(Af, cl, ch); \
      _Pragma("unroll") for (int e = 0; e < 16; ++e) U[e] = 0.f; \
      _Pragma("unroll") for (int ks = 0; ks < 4; ++ks) U = MFMA32(Af[ks], Bf[ks], U); \
      ML_UPD(1) }
#define ML_SECV { { const int t = tid & 63, dg = tid >> 6; \
      const u32x4 q0 = *(const LAS u32x4*)(lds + QS + dimg(t, 2 * dg)), q1 = *(const LAS u32x4*)(lds + QS + dimg(t, 2 * dg + 1)); \
      const LAS f32x4* nv = (const LAS f32x4*)(SM + SM_NV + 128 * I + 16 * dg); \
      const f32x4 n0 = nv[0], n1 = nv[1], n2 = nv[2], n3 = nv[3]; \
      dnq += bf_lo(q0.x) * n0.x + bf_hi(q0.x) * n0.y + bf_lo(q0.y) * n0.z + bf_hi(q0.y) * n0.w + bf_lo(q0.z) * n1.x + bf_hi(q0.z) * n1.y + bf_lo(q0.w) * n1.z + bf_hi(q0.w) * n1.w \
           + bf_lo(q1.x) * n2.x + bf_hi(q1.x) * n2.y + bf_lo(q1.y) * n2.z + bf_hi(q1.y) * n2.w + bf_lo(q1.z) * n3.x + bf_hi(q1.z) * n3.y + bf_lo(q1.w) * n3.z + bf_hi(q1.w) * n3.w; } \
    { const int dp = tid & 63, sg = tid >> 6; float a0 = 0.f, a1 = 0.f; \
      const f32x4 wA = *(const LAS f32x4*)(SM + gb + GB_W + 8 * sg), wB = *(const LAS f32x4*)(SM + gb + GB_W + 8 * sg + 4); const float ww[8] = {wA.x, wA.y, wA.z, wA.w, wB.x, wB.y, wB.z, wB.w}; \
      _Pragma("unroll") for (int s = 0; s < 8; ++s) { const unsigned kk2 = *(const LAS unsigned*)(lds + KS + dimg(8 * sg + s, dp >> 2) + 4 * (dp & 3)); a0 += ww[s] * bf_lo(kk2); a1 += ww[s] * bf_hi(kk2); } \
      ((LAS unsigned*)(SM + SM_NVP))[sg * 256 + 64 * I + dp] = cvt_pk_bf16(a0, a1); } }
    ML_SEC1 ML_SEC4 ML_SEC5 ML_SECV
#undef ML_SEC1
#undef ML_SEC4
#undef ML_UPD
#undef ML_SEC5
#undef ML_SECV
}

DI float lane_read(float v, int src_lane) { return __builtin_bit_cast(float, __builtin_amdgcn_ds_bpermute(src_lane << 2, __builtin_bit_cast(int, v))); }
DI void ml_scan(float li_, float lf_, float& u_, float& cm_, float& bs_, int lane) {
    bs_ = lf_;
#pragma unroll
    for (int o_ = 1; o_ < 64; o_ <<= 1) { const float t_ = lane_read(bs_, (lane - o_) & 63); if (lane >= o_) bs_ += t_; }
    u_ = li_ - bs_; cm_ = u_;
#pragma unroll
    for (int o_ = 1; o_ < 64; o_ <<= 1) { const float t_ = lane_read(cm_, (lane - o_) & 63); if (lane >= o_) cm_ = fmaxf(cm_, t_); }
}
DI void ml_gates(LAS float* SM, float u_, float cm_, float bs_, int gbn, float m_, float cmx_, int lane) {
    const float M_ = fmaxf(m_, cm_), Ml_ = fmaxf(m_, cmx_);
    SM[gbn + GB_U + lane] = u_; SM[gbn + GB_MR + lane] = M_; SM[gbn + GB_W + lane] = __expf(u_ - Ml_) * KSCALE; SM[gbn + GB_INT + lane] = __expf(m_ - M_); SM[gbn + GB_BND + lane] = __expf(-(bs_ + M_));
    if (lane == 0) SM[gbn + GB_SC + 0] = __expf(m_ - Ml_);
}

DI void ml_dma_piece(const bf16_t* colbase, int b, int dir, int tau0, LAS unsigned char* tile, int j, int lane) {
    const int pos = lane & 31, rin = pos >> 2, row = 8 * (j >> 1) + rin, ch = 4 * (2 * (j & 1) + (lane >> 5)) + ((pos & 3) ^ ((row >> 2) & 3));
    const int tau = tau0 + row; const size_t tok = (size_t)(b * SEQ + (dir ? SEQ - 1 - tau : tau));
    __builtin_amdgcn_global_load_lds((const unsigned*)(colbase + tok * 4096 + ch * 8), (LAS unsigned*)(tile + 1024 * j), 16, 0, 0);
}

DI void mlstm_phase(const bf16_t* Q, const bf16_t* Kb, const bf16_t* V, const float* pre_part, const float* b_if, float* GLF, bf16_t* HF, bf16_t* HB,
                    LAS unsigned char* lds, int G, int vcu0, int tid0, int lane0, int wave) {
    LAS float* SM = (LAS float*)(lds + ML_SM);
    const int vt = wave & 3, dpar = wave >> 2;
    for (int item = vcu0; item < 256; item += G) {
        const int vs = item & 3, stream = item >> 2, dir = stream & 1, hd = (stream >> 1) & 7, b = stream >> 4;
        bf16_t* H = dir ? HB : HF;
        float* glf = GLF + (size_t)item * 10240;
        const bf16_t* qcol = Q + hd * 512; const bf16_t* kcol = Kb + hd * 512; const bf16_t* vcol = V + hd * 512 + vs * 128;
        __syncthreads();
        int tidp = tid0, lanep = lane0; asm volatile("" : "+v"(tidp)); asm volatile("" : "+v"(lanep));
        for (int tau = tidp; tau < SEQ; tau += NTHREADS) {
            const int tok = b * SEQ + (dir ? SEQ - 1 - tau : tau);
            float li = b_if[dir * 16 + hd], lfr = b_if[dir * 16 + 8 + hd];
#pragma unroll
            for (int h8 = 0; h8 < 8; ++h8) { const float* pp = pre_part + ((size_t)h8 * 32 + dir * 16 + hd) * MTOK + tok; li += pp[0]; lfr += pp[(size_t)8 * MTOK]; }
            glf[tau] = li; glf[2048 + tau] = fminf(lfr, 0.f) - log1pf(__expf(-fabsf(lfr)));
        }
        SM[SM_NV + tidp] = 0.f;
        ml_dma_piece(qcol, b, dir, 0, lds + ML_QS0, 2 * wave, lanep); ml_dma_piece(qcol, b, dir, 0, lds + ML_QS0, 2 * wave + 1, lanep);
        ml_dma_piece(kcol, b, dir, 0, lds + ML_KS0, 2 * wave, lanep); ml_dma_piece(kcol, b, dir, 0, lds + ML_KS0, 2 * wave + 1, lanep);
        ml_dma_piece(vcol, b, dir, 0, lds + ML_VS0, 2 * wave, lanep); ml_dma_piece(vcol, b, dir, 0, lds + ML_VS0, 2 * wave + 1, lanep);
        asm volatile("s_waitcnt vmcnt(0)" ::: "memory");
        __syncthreads();
        float u0 = 0.f, cm0 = 0.f, bs0 = 0.f;
#pragma unroll 1
        for (int cc = wave; cc < 32; cc += 8) {
            const float lic = __hip_atomic_load(glf + 64 * cc + lanep, __ATOMIC_RELAXED, __HIP_MEMORY_SCOPE_AGENT), lfc = __hip_atomic_load(glf + 2048 + 64 * cc + lanep, __ATOMIC_RELAXED, __HIP_MEMORY_SCOPE_AGENT);
            float uu, cmm, bss; ml_scan(lic, lfc, uu, cmm, bss, lanep);
            glf[4096 + 64 * cc + lanep] = uu; glf[6144 + 64 * cc + lanep] = cmm; glf[8192 + 64 * cc + lanep] = bss;
            if (lanep == 63) { SM[SM_GS + cc] = bss; SM[SM_CMX + cc] = cmm; }
            if (cc == 0) { u0 = uu; cm0 = cmm; bs0 = bss; }
        }
        asm volatile("s_waitcnt vmcnt(0)" ::: "memory");
        __syncthreads();
        if (tidp == 0) { float m = 0.f;
#pragma unroll 1
            for (int cc = 0; cc < 32; ++cc) { SM[SM_MC + cc] = m; m = SM[SM_GS + cc] + fmaxf(m, SM[SM_CMX + cc]); } }
        __syncthreads();
        if (wave == 0) ml_gates(SM, u0, cm0, bs0, 0, 0.f, SM[SM_CMX + 0], lanep);
        __syncthreads();
#define ML_WRITE_WV(VS_, gbx_) do { const float w_ = SM[(gbx_) + GB_W + lrow]; \
        _Pragma("unroll") for (int hh_ = 0; hh_ < 2; ++hh_) { const int o_ = dimg(lrow, lcc + 8 * hh_); const u32x4 x_ = *(const LAS u32x4*)(lds + (VS_) + o_); u32x4 y_; \
            y_.x = cvt_pk_bf16(bf_lo(x_.x) * w_, bf_hi(x_.x) * w_); y_.y = cvt_pk_bf16(bf_lo(x_.y) * w_, bf_hi(x_.y) * w_); y_.z = cvt_pk_bf16(bf_lo(x_.z) * w_, bf_hi(x_.z) * w_); y_.w = cvt_pk_bf16(bf_lo(x_.w) * w_, bf_hi(x_.w) * w_); \
            *(LAS u32x4*)(lds + ML_WV + o_) = y_; } } while (0)
        { const int lrow = tidp >> 3, lcc = tidp & 7; ML_WRITE_WV(ML_VS0, 0); }
        u32x4 Cp[8][2];
#pragma unroll
        for (int j = 0; j < 8; ++j) { Cp[j][0] = (u32x4){0u, 0u, 0u, 0u}; Cp[j][1] = (u32x4){0u, 0u, 0u, 0u}; }
#pragma unroll 1
        for (int c = 0; c < 32; ++c) {
            int lane = lane0, tid = tid0; asm volatile("" : "+v"(lane)); asm volatile("" : "+v"(tid));
            const int r = lane & 31, h = lane >> 5, lrow = tid >> 3, lcc = tid & 7;
            const int gb = (c & 1) * 384, gbn = 384 - gb, cn = (c + 1 < 32) ? c + 1 : 31;
            const int VSc = (c & 1) ? ML_VS1 : ML_VS0, VSn = (c & 1) ? ML_VS0 : ML_VS1;
            f32x16 num[2], Sacc; float dnq = 0.f;
#pragma unroll
            for (int e = 0; e < 16; ++e) { num[0][e] = 0.f; num[1][e] = 0.f; Sacc[e] = 0.f; }
#define ML_DMA_QK(QS_, KS_, c_, i_) do { ml_dma_piece(qcol + 128 * (i_), b, dir, 64 * (c_), lds + (QS_), 2 * wave, lane); ml_dma_piece(qcol + 128 * (i_), b, dir, 64 * (c_), lds + (QS_), 2 * wave + 1, lane); \
                ml_dma_piece(kcol + 128 * (i_), b, dir, 64 * (c_), lds + (KS_), 2 * wave, lane); ml_dma_piece(kcol + 128 * (i_), b, dir, 64 * (c_), lds + (KS_), 2 * wave + 1, lane); } while (0)
            asm volatile("s_waitcnt vmcnt(0)" ::: "memory"); __syncthreads(); ML_DMA_QK(ML_QS1, ML_KS1, c, 1);  ml_step<0>(lds, Cp, num, Sacc, dnq, tid, lane, wave, gb);
            asm volatile("s_waitcnt vmcnt(0)" ::: "memory"); __syncthreads(); ML_DMA_QK(ML_QS0, ML_KS0, c, 2);  ml_step<1>(lds, Cp, num, Sacc, dnq, tid, lane, wave, gb);
            asm volatile("s_waitcnt vmcnt(0)" ::: "memory"); __syncthreads(); ML_DMA_QK(ML_QS1, ML_KS1, c, 3);  ml_step<2>(lds, Cp, num, Sacc, dnq, tid, lane, wave, gb);
            asm volatile("s_waitcnt vmcnt(0)" ::: "memory"); __syncthreads(); ML_DMA_QK(ML_QS0, ML_KS0, cn, 0);
            ml_dma_piece(vcol, b, dir, 64 * cn, lds + VSn, 2 * wave, lane); ml_dma_piece(vcol, b, dir, 64 * cn, lds + VSn, 2 * wave + 1, lane);
            ml_step<3>(lds, Cp, num, Sacc, dnq, tid, lane, wave, gb);
            asm volatile("s_waitcnt vmcnt(0)" ::: "memory");
            __syncthreads();
            float un = 0.f, cmn = 0.f, bsn = 0.f;
            if (wave == 0) { un = __hip_atomic_load(glf + 4096 + 64 * cn + lane, __ATOMIC_RELAXED, __HIP_MEMORY_SCOPE_AGENT); cmn = __hip_atomic_load(glf + 6144 + 64 * cn + lane, __ATOMIC_RELAXED, __HIP_MEMORY_SCOPE_AGENT);
                             bsn = __hip_atomic_load(glf + 8192 + 64 * cn + lane, __ATOMIC_RELAXED, __HIP_MEMORY_SCOPE_AGENT); }
            { LAS f32x4* xs = (LAS f32x4*)(lds + ML_XS) + (size_t)((wave & 3) * 4) * 64 + lane;
              if (wave >= 4) {
#pragma unroll
                for (int gq = 0; gq < 4; ++gq) xs[gq * 64] = (f32x4){Sacc[4 * gq], Sacc[4 * gq + 1], Sacc[4 * gq + 2], Sacc[4 * gq + 3]}; } }
            SM[SM_DNQP + (tid >> 6) * 64 + (tid & 63)] = dnq;
            __syncthreads();
            if (wave < 4) {
                const int st = wave >> 1, tt1 = wave & 1, t = 32 * tt1 + r;
                const LAS f32x4* xs = (const LAS f32x4*)(lds + ML_XS) + (size_t)(wave * 4) * 64 + lane;
                const float Mt = SM[gb + GB_MR + t]; float dsum = 0.f;
#pragma unroll
                for (int gq = 0; gq < 4; ++gq) {
                    const f32x4 px = xs[gq * 64]; const int s0 = 32 * st + 8 * gq + 4 * h; const f32x4 us = *(const LAS f32x4*)(SM + gb + GB_U + s0);
                    float vv[4];
#pragma unroll
                    for (int e = 0; e < 4; ++e) { const float raw = (Sacc[4 * gq + e] + px[e]) * KSCALE; vv[e] = (s0 + e <= t) ? raw * __expf(us[e] - Mt) : 0.f; dsum += vv[e]; }
                    u32x2 w; w.x = cvt_pk_bf16(vv[0], vv[1]); w.y = cvt_pk_bf16(vv[2], vv[3]);
                    *(LAS u32x2*)(lds + ML_SS + t * 144 + s0 * 2) = w;
                }
                dsum += __shfl_xor(dsum, 32);
                if (h == 0) SM[(st ? SM_DIN1 : SM_DIN0) + t] = dsum;
            }
#pragma unroll
            for (int tt = 0; tt < 2; ++tt) { const float it = SM[gb + GB_INT + 32 * tt + r]; num[tt] = num[tt] * it; }
            __syncthreads();
#pragma unroll
            for (int k2 = 0; k2 < 2; ++k2) { const int ks = 2 * dpar + k2;
                const bf16x8 a = frag_tr(lds + VSc, 16 * ks, 32 * vt, lane);
#pragma unroll
                for (int tt = 0; tt < 2; ++tt) { const bf16x8 bb = *(const LAS bf16x8*)(lds + ML_SS + (32 * tt + r) * 144 + (16 * ks + 8 * h) * 2); num[tt] = MFMA32(a, bb, num[tt]); } }
            __syncthreads();
            { LAS f32x4* xn = (LAS f32x4*)(lds + ML_XN) + (size_t)(vt * 8) * 64 + lane;
              if (dpar == 1) {
#pragma unroll
                for (int tt = 0; tt < 2; ++tt)
#pragma unroll
                    for (int gq = 0; gq < 4; ++gq) xn[(tt * 4 + gq) * 64] = (f32x4){num[tt][4 * gq], num[tt][4 * gq + 1], num[tt][4 * gq + 2], num[tt][4 * gq + 3]}; } }
            if (wave == 0) ml_gates(SM, un, cmn, bsn, gbn, SM[SM_MC + cn], SM[SM_CMX + cn], lane);
            __syncthreads();
            if (dpar == 0) {
                const LAS f32x4* xn = (const LAS f32x4*)(lds + ML_XN) + (size_t)(vt * 8) * 64 + lane;
#pragma unroll
                for (int tt = 0; tt < 2; ++tt) { const int t = 32 * tt + r; float nq = 0.f;
#pragma unroll
                    for (int gI = 0; gI < 8; ++gI) nq += SM[SM_DNQP + gI * 64 + t];
                    const float den = SM[SM_DIN0 + t] + SM[SM_DIN1 + t] + SM[gb + GB_INT + t] * nq;
                    const float inv = 1.0f / fmaxf(fabsf(den), SM[gb + GB_BND + t]);
                    const int tau = 64 * c + t; const size_t ob = (size_t)(b * SEQ + (dir ? SEQ - 1 - tau : tau)) * 4096 + hd * 512 + vs * 128 + 32 * vt + 4 * h;
#pragma unroll
                    for (int gq = 0; gq < 4; ++gq) { const f32x4 px = xn[(tt * 4 + gq) * 64];
                        u32x2 w; w.x = cvt_pk_bf16((num[tt][4 * gq] + px.x) * inv, (num[tt][4 * gq + 1] + px.y) * inv); w.y = cvt_pk_bf16((num[tt][4 * gq + 2] + px.z) * inv, (num[tt][4 * gq + 3] + px.w) * inv);
                        *(u32x2*)(H + ob + 8 * gq) = w; } }
            }
            ML_WRITE_WV(VSn, gbn);
            { const float decay = SM[gb + GB_SC + 0];
              float acc_ = 0.f; const LAS unsigned* np_ = (const LAS unsigned*)(SM + SM_NVP) + (tid >> 1);
#pragma unroll
              for (int sgx = 0; sgx < 8; ++sgx) { const unsigned pr_ = np_[sgx * 256]; acc_ += (tid & 1) ? bf_hi(pr_) : bf_lo(pr_); }
              SM[SM_NV + tid] = decay * SM[SM_NV + tid] + acc_; }
        }
#undef ML_DMA_QK
#undef ML_WRITE_WV
    }
}

DI void ml_combine_phase(const bf16_t* HF, const bf16_t* HB, const bf16_t* XC, const bf16_t* XZ, const float* norm_g, const float* skip, unsigned char* MO, int gw, int NGW, int lane) {
    for (int idx = gw; idx < MTOK * ML_HEADS; idx += NGW) {
        const int tok = idx >> 3, hd = idx & 7; const int ch = hd * 512 + 8 * lane; const size_t o4 = (size_t)tok * 4096 + ch;
        const u32x4 a = *(const u32x4*)(HF + o4), bq = *(const u32x4*)(HB + o4), xcv = *(const u32x4*)(XC + o4), zv = *(const u32x4*)(XZ + (size_t)tok * 8192 + 4096 + ch);
        float ht[8] = {bf_lo(a.x) + bf_lo(bq.x), bf_hi(a.x) + bf_hi(bq.x), bf_lo(a.y) + bf_lo(bq.y), bf_hi(a.y) + bf_hi(bq.y), bf_lo(a.z) + bf_lo(bq.z), bf_hi(a.z) + bf_hi(bq.z), bf_lo(a.w) + bf_lo(bq.w), bf_hi(a.w) + bf_hi(bq.w)};
        const float xc[8] = {bf_lo(xcv.x), bf_hi(xcv.x), bf_lo(xcv.y), bf_hi(xcv.y), bf_lo(xcv.z), bf_hi(xcv.z), bf_lo(xcv.w), bf_hi(xcv.w)};
        const float z[8] = {bf_lo(zv.x), bf_hi(zv.x), bf_lo(zv.y), bf_hi(zv.y), bf_lo(zv.z), bf_hi(zv.z), bf_lo(zv.w), bf_hi(zv.w)};
        float s = 0.f;
#pragma unroll
        for (int i = 0; i < 8; ++i) s += ht[i];
        const float mu = wave_sum(s) * (1.f / 512.f); float q = 0.f;
#pragma unroll
        for (int i = 0; i < 8; ++i) { ht[i] -= mu; q += ht[i] * ht[i]; }
        const float rstd = 1.0f / sqrtf(wave_sum(q) * (1.f / 512.f) + 1e-5f);
        const f32x4 g0 = *(const f32x4*)(norm_g + ch), g1 = *(const f32x4*)(norm_g + ch + 4), k0 = *(const f32x4*)(skip + ch), k1 = *(const f32x4*)(skip + ch + 4);
        const float gg[8] = {g0.x, g0.y, g0.z, g0.w, g1.x, g1.y, g1.z, g1.w}, sk[8] = {k0.x, k0.y, k0.z, k0.w, k1.x, k1.y, k1.z, k1.w};
        float o[8];
#pragma unroll
        for (int i = 0; i < 8; ++i) o[i] = (ht[i] * rstd * gg[i] + sk[i] * xc[i]) * sigmoid_f(z[i]);
        u32x2 w; w.x = pk4_fp8(o[0] * HSCALE, o[1] * HSCALE, o[2] * HSCALE, o[3] * HSCALE); w.y = pk4_fp8(o[4] * HSCALE, o[5] * HSCALE, o[6] * HSCALE, o[7] * HSCALE);
        *(u32x2*)(MO + o4) = w;
    }
}

DI void moe_offsets(const unsigned* ecnt, int (&cnt)[8], int (&off)[8], int& ntiles) {
    int acc = 0;
#pragma unroll
    for (int e = 0; e < 8; ++e) { cnt[e] = (int)ecnt[64 * e]; off[e] = acc * 256; acc += (cnt[e] + 255) >> 8; }
    ntiles = acc;
}
DI void moe_split_plan(int ntiles, int& nMf, int& nT, int& S) {
    nMf = (ntiles >> 5) << 5; nT = ntiles - nMf; S = 1;
    if (nT > 0) { S = (nT <= 4) ? 7 : (nT <= 8) ? 4 : (nT <= 16) ? 2 : 1; }
    if (S == 1) { nMf = ntiles; nT = 0; }
}
DI pg8::TileMap moe_tilemap(const int (&cnt)[8]) { pg8::TileMap tm; int acc = 0; tm.toff[0] = 0;
#pragma unroll
    for (int e = 0; e < 8; ++e) { acc += (cnt[e] + 255) >> 8; tm.toff[e + 1] = acc; }
    return tm; }
DI void moe_scatter_phase(const unsigned char* HA, unsigned char* HS, const int* tok_e, const int* tok_pos, int* slot_row, const unsigned* ecnt, int* tile_e, int gw, int NGW, int lane) {
    int cnt[8], off[8], ntiles; moe_offsets(ecnt, cnt, off, ntiles);
    if (gw == 0 && lane < 8) { const int e = lane; const int t0 = off[e] >> 8, nt = (cnt[e] + 255) >> 8; for (int t = 0; t < nt; ++t) tile_e[t0 + t] = e; }
    for (int id = gw; id < 2 * MTOK; id += NGW) {
        const int e = tok_e[id], pos = tok_pos[id]; int o = 0;
#pragma unroll
        for (int q = 0; q < 8; ++q) o = (e == q) ? off[q] : o;
        const int row = o + pos;
        if (lane == 0) slot_row[id] = row;
        const u32x4* src = (const u32x4*)(HA + (size_t)(id >> 1) * DM) + lane; u32x4* dst = (u32x4*)(HS + (size_t)row * DM) + lane;
#pragma unroll
        for (int j = 0; j < 2; ++j) dst[64 * j] = src[64 * j];
    }
#pragma unroll 1
    for (int e = 0; e < 8; ++e) { int c = 0, o = 0;
#pragma unroll
        for (int q = 0; q < 8; ++q) { c = (e == q) ? cnt[q] : c; o = (e == q) ? off[q] : o; }
        const int pend = ((c + 255) >> 8) << 8;
        for (int p = c + gw; p < pend; p += NGW) { u32x4* dst = (u32x4*)(HS + (size_t)(o + p) * DM) + lane;
#pragma unroll
            for (int j = 0; j < 2; ++j) dst[64 * j] = (u32x4){0u, 0u, 0u, 0u}; } }
}

DI f32x4 moe_yrow(const bf16_t* YS, const bf16_t* YSP, int r, int rsplit, int S, int nrs, int lane, int j) {
    if (r < rsplit) { const u32x2 a = ((const u32x2*)(YS + (size_t)r * DM) + lane)[64 * j]; return (f32x4){bf_lo(a.x), bf_hi(a.x), bf_lo(a.y), bf_hi(a.y)}; }
    f32x4 acc = (f32x4){0.f, 0.f, 0.f, 0.f};
    for (int s2 = 0; s2 < S; ++s2) { const u32x2 a = ((const u32x2*)(YSP + ((size_t)s2 * nrs + (r - rsplit)) * DM) + lane)[64 * j]; acc += (f32x4){bf_lo(a.x), bf_hi(a.x), bf_lo(a.y), bf_hi(a.y)}; }
    return acc;
}
DI void moe_combine_phase(const bf16_t* X3, const bf16_t* YS, const int* tok_e, const int* tok_pos, const float* tok_w, const float* gate, float* out, const unsigned* ecnt, int gw, int NGW, int lane) {
    int cnt[8], off[8], ntiles; moe_offsets(ecnt, cnt, off, ntiles);
    int nMf, nT, S; moe_split_plan(ntiles, nMf, nT, S); const int rsplit = nMf * 256; const bf16_t* YSP = YS + (size_t)MPAD * DM;
    for (int tok = gw; tok < MTOK; tok += NGW) {
        const int e0 = tok_e[2 * tok], e1 = tok_e[2 * tok + 1]; int o0 = 0, o1 = 0;
#pragma unroll
        for (int q = 0; q < 8; ++q) { o0 = (e0 == q) ? off[q] : o0; o1 = (e1 == q) ? off[q] : o1; }
        const int r0 = o0 + tok_pos[2 * tok], r1 = o1 + tok_pos[2 * tok + 1]; const float w0 = tok_w[2 * tok], w1 = tok_w[2 * tok + 1];
        const u32x2* x = (const u32x2*)(X3 + (size_t)tok * DM) + lane;
        const f32x4* gp = (const f32x4*)(gate + (size_t)(tok >> 11) * 12288) + lane; f32x4* o = (f32x4*)(out + (size_t)tok * DM) + lane;
#pragma unroll
        for (int j = 0; j < 8; ++j) { const f32x4 ya = moe_yrow(YS, YSP, r0, rsplit, S, nT * 256, lane, j), yb = moe_yrow(YS, YSP, r1, rsplit, S, nT * 256, lane, j);
            const u32x2 xr = x[64 * j]; o[64 * j] = (f32x4){bf_lo(xr.x), bf_hi(xr.x), bf_lo(xr.y), bf_hi(xr.y)} + gp[64 * j] * (ya * w0 + yb * w1); }
    }
}

struct Params { const float* in[29]; float* out; unsigned char* ws; int ph_lo, ph_hi; };
static_assert(sizeof(Params) == 31 * 8 + 8, "Params has padding");
constexpr int NPHASE = 20;

#if DBG
#include "dbg_checks.inc"
#endif

__global__ void __launch_bounds__(NTHREADS, 2) mega_fwd(Params p) {
    extern __shared__ __attribute__((aligned(16))) unsigned char lds_raw[];
    LAS unsigned char* lds = (LAS unsigned char*)lds_raw;
    const int tid = threadIdx.x, lane = tid & 63, wave = __builtin_amdgcn_readfirstlane(tid >> 6);
    const int G = gridDim.x, gw = blockIdx.x * NWAVES + wave, NGW = G * NWAVES;
    const int vcu = (G % 8 == 0) ? (int)(blockIdx.x % 8) * (G / 8) + (int)(blockIdx.x / 8) : (int)blockIdx.x;
    const int gwx = vcu * NWAVES + wave;
    unsigned char* ws = p.ws;
    unsigned* ctl = (unsigned*)(ws + WS_CTL);
    volatile LAS unsigned* xbw = (volatile LAS unsigned*)(lds + LDS_BYTES - 16);
    if (tid == 0) { xbw[0] = 0u; xbw[1] = 0u; xbw[2] = 0u; xbw[3] = 0u; }
    __syncthreads();
    XcdBarrier bar = xcd_barrier_post(ctl + CW_BAR, xbw);
    const int lo = p.ph_lo, hi = p.ph_hi;
#ifndef PH_MASK
#define PH_MASK 0xFFFFFFu
#endif
#define IN(k) (((PH_MASK >> (k)) & 1u) && lo <= (k) && (k) < hi)
#define SEAM(k) do { if (IN((k) + 1)) xcd_barrier(bar); } while (0)
#ifndef REP_MASK
#define REP_MASK 0u
#endif
#define PHASE(k, ...) if (IN(k)) { { __VA_ARGS__ } if ((REP_MASK >> (k)) & 1u) { __syncthreads(); { __VA_ARGS__ } } SEAM(k); }

    float* mod = (float*)(ws + WS_MOD);
    float* pre_part = (float*)(ws + WS_PRE);
    int* tok_e = (int*)(ws + WS_ROUTE); int* tok_pos = tok_e + 2 * MTOK; float* tok_w = (float*)(tok_pos + 2 * MTOK); int* slot_row = (int*)(tok_w + 2 * MTOK);
    unsigned* ecnt = ctl + CW_ECNT; int* tile_e = (int*)(ctl + 12288);
    bf16_t* HA = (bf16_t*)(ws + WS_HA); bf16_t* X1 = (bf16_t*)(ws + WS_X1); bf16_t* X2 = (bf16_t*)(ws + WS_X2);
    bf16_t* WT_IN = (bf16_t*)(ws + WS_WT_IN); bf16_t* WT_OUT = (bf16_t*)(ws + WS_WT_OUT); bf16_t* WT_GU = (bf16_t*)(ws + WS_WT_GU); bf16_t* WT_DN = (bf16_t*)(ws + WS_WT_DN);
    bf16_t* WT_MLIN = (bf16_t*)(ws + WS_WT_MLIN); bf16_t* WT_MLOUT = (bf16_t*)(ws + WS_WT_MLOUT); bf16_t* WT_IF = (bf16_t*)(ws + WS_WT_IF);
    unsigned char* WT_MGU = ws + WS_WT_MGU; unsigned char* WT_MD = ws + WS_WT_MD;
    bf16_t* QK = (bf16_t*)(ws + A_QK); bf16_t* QKN = (bf16_t*)(ws + A_QKN); bf16_t* VT = (bf16_t*)(ws + A_VT); bf16_t* ATT = (bf16_t*)(ws + A_ATT); bf16_t* ACT = (bf16_t*)(ws + A_ACT);
    bf16_t* XZ = (bf16_t*)(ws + A_XZ); bf16_t* XC = (bf16_t*)(ws + A_XC); bf16_t* Qm = (bf16_t*)(ws + A_Q); bf16_t* Km = (bf16_t*)(ws + A_K); bf16_t* Vm = (bf16_t*)(ws + A_V);
    bf16_t* HF = (bf16_t*)(ws + A_HF); bf16_t* HB = (bf16_t*)(ws + A_HB); bf16_t* MO = (bf16_t*)(ws + A_MO);
    unsigned char* HS = ws + A_HS; unsigned char* ACTM = ws + A_ACTM; float* YS = (float*)(ws + A_YS);
    const float* x_in = p.in[0];

    PHASE(0,
        mod_phase(p.in[1], p.in[2], p.in[3], mod, lds, G, tid, lane, wave);
        LAS float* scrw = (LAS float*)lds + wave * (64 * 65);
        cvtw_job<0, false>(p.in[6] + 4096, 2048, 2048, 1, WT_IN + (size_t)4096 * 2048, 0, scrw, gw, NGW, lane, 1.f, 6144, 0);
        cvtw_job<0, true>(p.in[6], 2048, 4096, 1, (unsigned char*)ACT + (size_t)32 * 1024 * 1024, 0, scrw, gw, NGW, lane, WSCALE, 6144, 512);
        cvtw_job<0, false>(p.in[10], 2048, 2048, 1, WT_OUT, 0, scrw, gw, NGW, lane, 1.f, 0, 1536);
        cvtw_job<1, false>(p.in[11], 2048, FFN, 1, WT_GU, 0, scrw, gw, NGW, lane, 1.f, 0, 2048);
        cvtw_job<2, false>(p.in[12], 2048, FFN, 1, WT_GU, 0, scrw, gw, NGW, lane, 1.f, 0, 3456);
        cvtw_job<0, false>(p.in[13], FFN, 2048, 1, WT_DN, 0, scrw, gw, NGW, lane, 1.f, 0, 4864);
        cvtw_job<0, false>(p.in[14], 2048, 8192, 1, WT_MLIN, 0, scrw, gw, NGW, lane, 1.f, 0, 6272);
        cvtw_job<0, true>(p.in[24], 4096, 2048, 1, (unsigned char*)WT_MLOUT, 0, scrw, gw, NGW, lane, WSCALE, 0, 8320);
        cvt_job<0>(p.in[20], 12288, 32, 1, WT_IF, 0, scrw, gw, NGW, lane);
        cvtw_job<1, true>(p.in[26], 2048, EDIM, 8, WT_MGU, (size_t)14336 * 2048, scrw, gw, NGW, lane, WSCALE, 0, 9344);
        cvtw_job<2, true>(p.in[27], 2048, EDIM, 8, WT_MGU, (size_t)14336 * 2048, scrw, gw, NGW, lane, WSCALE, 0, 9344 + 14336);
        cvtw_job<0, true>(p.in[28], EDIM, 2048, 8, WT_MD, (size_t)2048 * EDIM, scrw, gw, NGW, lane, WSCALE, 0, 9344 + 2 * 14336); )
    PHASE(1,  rms_mod_phase<false, true>(x_in, p.in[4], mod + 1 * 2048, mod + 0 * 2048, HA, nullptr, nullptr, nullptr, nullptr, nullptr, (unsigned char*)ACT, gw, NGW, lane); )
    PHASE(2,
        { pg8::Gemm g{(const unsigned char*)ACT, (const unsigned char*)ACT + (size_t)32 * 1024 * 1024, MTOK, 4096, 2048, 0}; pg8::StaticOrder S; S.init(MTOK, 4096, G, (int)blockIdx.x); pg8::EpiQKNorm E{QKN, 4096, p.in[7], p.in[8], 1.0f / (HSCALE * WSCALE)}; pg8::gemm_phase<pg8::EpiQKNorm, pg8::StaticOrder, true>(lds, g, S, E); }
        { pg8::Gemm g{WT_IN + (size_t)4096 * 2048, HA, 2048, MTOK, 2048, 0}; pg8::StaticOrder S; S.init(2048, MTOK, G, (int)blockIdx.x); pg8::EpiBf16 E{VT, MTOK}; pg8::gemm_phase(lds, g, S, E); } )
    PHASE(4,  na_phase(QKN, VT, ATT, p.in[9], lds, G, vcu, tid, lane, wave); )
    PHASE(5,  pg8::Gemm g{ATT, WT_OUT, MTOK, 2048, 2048, 0}; pg8::StaticOrder S; S.init(MTOK, 2048, G, (int)blockIdx.x); pg8::EpiResGate16<false> E{x_in, X1, DM, mod + 2 * 2048, 12288}; pg8::gemm_phase(lds, g, S, E); )
    PHASE(6,  rms_mod_phase<false, false, true>(X1, p.in[5], mod + 4 * 2048, mod + 3 * 2048, HA, nullptr, nullptr, nullptr, nullptr, nullptr, nullptr, gw, NGW, lane); )
    PHASE(7,  pg8::Gemm g{HA, WT_GU, MTOK, 2 * FFN, 2048, 0}; pg8::StaticOrder S; S.init(MTOK, 2 * FFN, G, (int)blockIdx.x); pg8::EpiSwiGLU E{ACT, FFN}; pg8::gemm_phase(lds, g, S, E); )
    PHASE(8,  pg8::Gemm g{ACT, WT_DN, MTOK, 2048, FFN, 0}; pg8::StaticOrder S; S.init(MTOK, 2048, G, (int)blockIdx.x); pg8::EpiResGate16<true> E{X1, X2, DM, mod + 5 * 2048, 12288}; pg8::gemm_phase(lds, g, S, E); )
    PHASE(9,  rms_mod_phase<false, false, true>(X2, p.in[4] + DM, mod + 4 * 12288 + 1 * 2048, mod + 4 * 12288 + 0 * 2048, HA, nullptr, nullptr, nullptr, nullptr, nullptr, nullptr, gw, NGW, lane); )
    PHASE(10,  pg8::Gemm g{HA, WT_MLIN, MTOK, 8192, 2048, 0}; pg8::StaticOrder S; S.init(MTOK, 8192, G, (int)blockIdx.x); pg8::EpiBf16 E{XZ, 8192}; pg8::gemm_phase(lds, g, S, E); )
    PHASE(11,  ml_pre_phase(XZ, p.in[15], p.in[16], p.in[17], p.in[18], p.in[19], WT_IF, XC, Qm, Km, Vm, pre_part, lds, G, tid, lane, wave); )
    PHASE(12,  mlstm_phase(Qm, Km, Vm, pre_part, p.in[21], (float*)(ws + WS_GLF), HF, HB, lds, G, vcu, tid, lane, wave); )
    PHASE(13,  ml_combine_phase(HF, HB, XC, XZ, p.in[23], p.in[22], (unsigned char*)MO, gw, NGW, lane); )
    PHASE(14,  pg8::Gemm g{MO, WT_MLOUT, MTOK, 2048, 4096, 0}; pg8::StaticOrder S; S.init(MTOK, 2048, G, (int)blockIdx.x); pg8::EpiResGate16<true> E{X2, X1, DM, mod + 4 * 12288 + 2 * 2048, 12288, 1.0f / (HSCALE * WSCALE)}; pg8::gemm_phase<pg8::EpiResGate16<true>, pg8::StaticOrder, true>(lds, g, S, E); )
    PHASE(15,  rms_mod_phase<true, false, true>(X1, p.in[5] + DM, mod + 4 * 12288 + 4 * 2048, mod + 4 * 12288 + 3 * 2048, HA, p.in[25], tok_e, tok_pos, tok_w, ecnt, HS, gw, NGW, lane); )
    PHASE(17,  int cnt[8], off[8], ntiles; moe_offsets(ecnt, cnt, off, ntiles);
        pg8::Gemm g{HS, WT_MGU, ntiles * 256, 2 * EDIM, 2048, 0}; pg8::MoeOrder S; S.init(ntiles, 2 * EDIM, G, (int)blockIdx.x, moe_tilemap(cnt), (size_t)14336 * 2048, (size_t)DM);
        pg8::EpiSwiGLU8 E{ACTM, EDIM, 1.0f / (HSCALE * WSCALE), ASCALE}; pg8::gemm_phase<pg8::EpiSwiGLU8, pg8::MoeOrder, true>(lds, g, S, E); )
    PHASE(18,  int cnt[8], off[8], ntiles; moe_offsets(ecnt, cnt, off, ntiles);
        pg8::Gemm g{ACTM, WT_MD, ntiles * 256, 2048, EDIM, 0};
        int nMf, nT, SS; moe_split_plan(ntiles, nMf, nT, SS); bf16_t* YSP = (bf16_t*)YS + (size_t)MPAD * DM;
        { pg8::MoeRowOrder S1; S1.init(nMf, G, (int)blockIdx.x, moe_tilemap(cnt), (size_t)2048 * EDIM); pg8::EpiBf16S E{(bf16_t*)YS, DM, 1.0f / (ASCALE * WSCALE), 0}; pg8::gemm_phase<pg8::EpiBf16S, pg8::MoeRowOrder, true>(lds, g, S1, E); }
        if (nT > 0) { pg8::Gemm g2 = g; g2.ntk = 56 / SS; pg8::MoeSplitOrder S2; S2.init(nMf, nT, SS, (size_t)(EDIM / SS), (int)blockIdx.x, moe_tilemap(cnt), (size_t)2048 * EDIM);
            pg8::EpiBf16S E2{YSP - (size_t)nMf * 256 * DM, DM, 1.0f / (ASCALE * WSCALE), (size_t)nT * 256 * DM}; pg8::gemm_phase<pg8::EpiBf16S, pg8::MoeSplitOrder, true>(lds, g2, S2, E2); } )
    PHASE(19,  moe_combine_phase(X1, (const bf16_t*)YS, tok_e, tok_pos, tok_w, mod + 4 * 12288 + 5 * 2048, p.out, ecnt, gw, NGW, lane); )
#undef IN
#undef SEAM
#undef PHASE
}

extern "C" void kernel_launch(void* const* d_in, const int* in_sizes, int n_in, void* d_out, int out_size, void* d_ws, size_t ws_size, hipStream_t stream) {
    static int grid = 0;
    if (grid == 0) {
        if (n_in != 29 || out_size != MTOK * DM || ws_size < WS_END) { fprintf(stderr, "kernel_launch: unexpected shapes (n_in %d out %d ws %zu need %zu)\n", n_in, out_size, ws_size, (size_t)WS_END); grid = -1; return; }
        int dev = 0, cus = 0, per_cu = 0;
        if (hipGetDevice(&dev) != hipSuccess || hipDeviceGetAttribute(&cus, hipDeviceAttributeMultiprocessorCount, dev) != hipSuccess) { grid = -1; return; }
        if (hipFuncSetAttribute((const void*)mega_fwd, hipFuncAttributeMaxDynamicSharedMemorySize, LDS_BYTES) != hipSuccess) { fprintf(stderr, "kernel_launch: hipFuncSetAttribute failed\n"); grid = -1; return; }
        if (hipOccupancyMaxActiveBlocksPerMultiprocessor(&per_cu, (const void*)mega_fwd, NTHREADS, LDS_BYTES) != hipSuccess || per_cu < 1) { fprintf(stderr, "kernel_launch: occupancy query says %d\n", per_cu); (void)hipGetLastError(); per_cu = 1; }
        grid = cus;
    }
    if (grid < 0) return;
    (void)hipMemsetAsync((char*)d_ws + WS_CTL, 0, CTL_BYTES, stream);
    Params p{};
    for (int i = 0; i < 29; ++i) p.in[i] = (const float*)d_in[i];
    p.out = (float*)d_out; p.ws = (unsigned char*)d_ws;
#if N_LAUNCH_SPLIT
    for (int k = 0; k < NPHASE; ++k) { p.ph_lo = k; p.ph_hi = k + 1; hipLaunchKernelGGL(mega_fwd, dim3(grid), dim3(NTHREADS), LDS_BYTES, stream, p); }
#else
    p.ph_lo = 0; p.ph_hi = NPHASE;
    hipLaunchKernelGGL(mega_fwd, dim3(grid), dim3(NTHREADS), LDS_BYTES, stream, p);
#endif
}
```

```cpp
#define PROBE_HOT 0
#ifndef GEMM_SCH
#define GEMM_SCH 1
#endif
#include <hip/hip_runtime.h>
#include <cstdio>
#include <cstdint>

#ifndef DBG
#define DBG 0
#endif
#ifndef N_LAUNCH_SPLIT
#define N_LAUNCH_SPLIT 0
#endif

#define LAS __attribute__((address_space(3)))
#define GAS __attribute__((address_space(1)))
#define DI __device__ __forceinline__
typedef unsigned short bf16_t;
typedef short bf16x8 __attribute__((ext_vector_type(8)));
typedef short s16x4 __attribute__((ext_vector_type(4)));
typedef float f32x2 __attribute__((ext_vector_type(2)));
typedef float f32x4 __attribute__((ext_vector_type(4)));
typedef float f32x16 __attribute__((ext_vector_type(16)));
typedef unsigned u32x2 __attribute__((ext_vector_type(2)));
typedef unsigned u32x4 __attribute__((ext_vector_type(4)));
typedef int i32x4 __attribute__((ext_vector_type(4)));
typedef int i32x8 __attribute__((ext_vector_type(8)));

constexpr int BATCH = 4, SEQ = 2048, DM = 2048, MTOK = BATCH * SEQ;
constexpr int GRID_W = 64, NA_HEADS = 16, NA_HD = 128;
constexpr int ML_INNER = 4096, ML_HEADS = 8, ML_HD = 512;
constexpr int FFN = 5632, NEXP = 8, EDIM = 7168;
constexpr int MPAD = 2 * MTOK + NEXP * 256;
constexpr int NTHREADS = 512, NWAVES = 8;
constexpr int LDS_BYTES = 147456;

constexpr size_t al256(size_t x) { return (x + 255) & ~(size_t)255; }
constexpr size_t WS_CTL = 0;
constexpr size_t CTL_BYTES = 65536;
constexpr size_t WS_MOD = WS_CTL + CTL_BYTES;
constexpr size_t WS_PRE = WS_MOD + al256((size_t)2 * 4 * 12288 * 4);
constexpr size_t WS_ROUTE = WS_PRE + (size_t)8 * MTOK * 32 * 4;
constexpr size_t WS_GLF = WS_ROUTE + (size_t)4 * MTOK * 2 * 4;
constexpr size_t WS_HA = WS_GLF + (size_t)256 * 10240 * 4;
constexpr size_t WS_X1 = WS_HA + (size_t)MTOK * DM * 2;
constexpr size_t WS_X2 = WS_X1 + (size_t)MTOK * DM * 4;
constexpr size_t WS_WT_IN = WS_X2 + (size_t)MTOK * DM * 4;
constexpr size_t WS_WT_OUT = WS_WT_IN + (size_t)6144 * 2048 * 2;
constexpr size_t WS_WT_GU = WS_WT_OUT + (size_t)2048 * 2048 * 2;
constexpr size_t WS_WT_DN = WS_WT_GU + (size_t)11264 * 2048 * 2;
constexpr size_t WS_WT_MLIN = WS_WT_DN + (size_t)2048 * 5632 * 2;
constexpr size_t WS_WT_MLOUT = WS_WT_MLIN + (size_t)8192 * 2048 * 2;
constexpr size_t WS_WT_IF = WS_WT_MLOUT + (size_t)2048 * 4096 * 2;
constexpr size_t WS_WT_MGU = WS_WT_IF + (size_t)32 * 12288 * 2;
constexpr size_t WS_WT_MD = WS_WT_MGU + (size_t)8 * 14336 * 2048;
constexpr size_t WS_ARENA = WS_WT_MD + (size_t)8 * 2048 * 7168;
constexpr size_t A_QK = WS_ARENA;
constexpr size_t A_QKN = A_QK + (size_t)MTOK * 4096 * 2;
constexpr size_t A_VT = A_QKN + (size_t)MTOK * 4096 * 2;
constexpr size_t A_ATT = A_VT + (size_t)2048 * MTOK * 2;
constexpr size_t A_ACT = A_ATT + (size_t)MTOK * DM * 2;
constexpr size_t A_L0_END = A_ACT + (size_t)MTOK * FFN * 2;
constexpr size_t A_XZ = WS_ARENA;
constexpr size_t A_XC = A_XZ + (size_t)MTOK * 8192 * 2;
constexpr size_t A_Q = A_XC + (size_t)MTOK * 4096 * 2;
constexpr size_t A_K = A_Q + (size_t)MTOK * 4096 * 2;
constexpr size_t A_V = A_K + (size_t)MTOK * 4096 * 2;
constexpr size_t A_HF = A_V + (size_t)MTOK * 4096 * 2;
constexpr size_t A_HB = A_HF + (size_t)MTOK * 4096 * 2;
constexpr size_t A_MO = A_HB + (size_t)MTOK * 4096 * 2;
constexpr size_t A_L1_END = A_MO + (size_t)MTOK * 4096 * 2;
constexpr size_t A_HS = WS_ARENA;
constexpr size_t A_ACTM = A_HS + (size_t)8 * 8192 * DM;
constexpr size_t A_YS = A_ACTM + (size_t)MPAD * EDIM;
constexpr size_t A_L2_END = A_YS + (size_t)MPAD * DM * 4;
constexpr size_t cmax(size_t a, size_t b) { return a > b ? a : b; }
constexpr size_t WS_END = cmax(cmax(A_L0_END, A_L1_END), A_L2_END);

constexpr int CW_BAR = 0;
constexpr int CW_ECNT = 4096;
constexpr int CW_DBG = 8192;

typedef __bf16 bf16x2_t __attribute__((ext_vector_type(2)));
DI unsigned cvt_pk_bf16(float lo, float hi) { const f32x2 v = {lo, hi}; return __builtin_bit_cast(unsigned, __builtin_convertvector(v, bf16x2_t)); }
DI float clamp448(float x) { return __builtin_fminf(__builtin_fmaxf(x, -448.f), 448.f); }
DI unsigned pk4_fp8(float a, float b, float c, float d) {
    int p = 0; p = __builtin_amdgcn_cvt_pk_fp8_f32(clamp448(a), clamp448(b), p, false); p = __builtin_amdgcn_cvt_pk_fp8_f32(clamp448(c), clamp448(d), p, true); return (unsigned)p; }
DI float bf_lo(unsigned u) { return __uint_as_float(u << 16); }
DI float bf_hi(unsigned u) { return __uint_as_float(u & 0xffff0000u); }
DI float bf2f(bf16_t b) { return __uint_as_float(((unsigned)b) << 16); }
DI bf16_t f2bf(float f) { return (bf16_t)(cvt_pk_bf16(f, 0.f) & 0xffffu); }
DI float wave_sum(float v) {
#pragma unroll
    for (int o = 1; o < 64; o <<= 1) v += __shfl_xor(v, o);
    return v;
}
DI float wave_max(float v) {
#pragma unroll
    for (int o = 1; o < 64; o <<= 1) v = fmaxf(v, __shfl_xor(v, o));
    return v;
}
DI float silu_f(float x) { return x / (1.f + __expf(-x)); }
DI float sigmoid_f(float x) { return 1.f / (1.f + __expf(-x)); }
#define LDS_WAIT() asm volatile("s_waitcnt lgkmcnt(0)" ::: "memory")
#define VM_WAIT() asm volatile("s_waitcnt vmcnt(0)" ::: "memory")

#define XB_TMO      128
#define XB_XCNT(j)  (256  + 64 * (j))
#define XB_XSUB(j)  (1280 + 64 * (j))
#define XB_XGEN(j)  (2304 + 64 * (j))
#define XB_TOP      3328
#define XB_TOPGEN   3392
#define XCD_BAR_WORDS 3456
#define XB_SPIN_CAP (1u << 22)

__device__ __forceinline__ unsigned xb_ld(unsigned* p)              { return __hip_atomic_load(p, __ATOMIC_RELAXED, __HIP_MEMORY_SCOPE_AGENT); }
__device__ __forceinline__ unsigned xb_add(unsigned* p, unsigned v) { return __hip_atomic_fetch_add(p, v, __ATOMIC_RELAXED, __HIP_MEMORY_SCOPE_AGENT); }
__device__ __forceinline__ unsigned xb_xcc_id() { return (unsigned)__builtin_amdgcn_s_getreg((3 << 11) | 20) & 0xFu; }
#define XB_SPIN(cond, bar) do { unsigned _sp = 0; while (cond) { __builtin_amdgcn_s_sleep(1); \
    if ((++_sp & 255u) == 0u) { if (xb_ld(&(bar)[XB_TMO])) break; if (_sp > XB_SPIN_CAP) { atomicAdd(&(bar)[XB_TMO], 1u); break; } } } } while (0)

struct XcdBarrier { unsigned* bar; unsigned x; volatile LAS unsigned* st; };

__device__ __forceinline__ XcdBarrier xcd_barrier_post(unsigned* bar, volatile LAS unsigned* st) {
    XcdBarrier b; b.bar = bar; b.x = xb_xcc_id(); b.st = st;
    if (threadIdx.x == 0) (void)xb_add(&bar[XB_XCNT(b.x)], 1u);
    return b;
}
__device__ __forceinline__ void xcd_barrier_complete(unsigned* bar, unsigned x, unsigned& nloc, unsigned& nx) {
    const unsigned G = gridDim.x * gridDim.y * gridDim.z;
    unsigned sum, cnt, mine, sp = 0u;
    for (;;) {
        sum = 0u; cnt = 0u; mine = 0u;
#pragma unroll
        for (unsigned j = 0; j < 16; ++j) { const unsigned c = xb_ld(&bar[XB_XCNT(j)]); sum += c; cnt += (c > 0u) ? 1u : 0u; mine = (j == x) ? c : mine; }
        if (sum == G) break;
        __builtin_amdgcn_s_sleep(1);
        if ((++sp & 255u) == 0u) { if (xb_ld(&bar[XB_TMO])) break; if (sp > XB_SPIN_CAP) { atomicAdd(&bar[XB_TMO], 1u); break; } }
    }
    nloc = mine > 0u ? mine : 1u; nx = cnt > 0u ? cnt : 1u;
}
__device__ __forceinline__ void xcd_barrier(const XcdBarrier& b) {
    asm volatile("s_waitcnt vmcnt(0)" ::: "memory");
    __syncthreads();
    if (threadIdx.x == 0) {
        unsigned* bar = b.bar;
        __builtin_amdgcn_s_waitcnt(0);
        unsigned nloc = b.st[0], nx = b.st[1];
        if (nloc == 0u) { xcd_barrier_complete(bar, b.x, nloc, nx); b.st[0] = nloc; b.st[1] = nx; }
        const unsigned old = xb_add(&bar[XB_XSUB(b.x)], 1u);
        const unsigned gen = old / nloc;
        if (old + 1u == (gen + 1u) * nloc) {
            __builtin_amdgcn_fence(__ATOMIC_RELEASE, "agent");
            asm volatile("s_waitcnt vmcnt(0)" ::: "memory");
            const unsigned og = xb_add(&bar[XB_TOP], 1u);
            const unsigned tg = og / nx;
            if (og + 1u == (tg + 1u) * nx) xb_add(&bar[XB_TOPGEN], 1u);
            else XB_SPIN(xb_ld(&bar[XB_TOPGEN]) == tg, bar);
            __builtin_amdgcn_fence(__ATOMIC_ACQUIRE, "agent");
            xb_add(&bar[XB_XGEN(b.x)], 1u);
            asm volatile("s_waitcnt vmcnt(0)" ::: "memory");
        } else {
            XB_SPIN(xb_ld(&bar[XB_XGEN(b.x)]) == gen, bar);
            __builtin_amdgcn_fence(__ATOMIC_ACQUIRE, "agent");
            asm volatile("s_waitcnt vmcnt(0)" ::: "memory");
        }
    }
    __syncthreads();
}

namespace pg8 {
constexpr int BM = 256, BK = 64, HALF = 128, HTB = HALF * BK * 2, STAGE_BYTES = 8 * HTB, NXCD = 8, WGM = 8;
__host__ __device__ __forceinline__ int lds_byte(int r, int c) { const int st = (r >> 4) * 2 + (c >> 5), rr = r & 15, cc = c & 31, ob = rr * 64 + cc * 2; return st * 1024 + (ob ^ (((ob >> 9) & 1) << 5)); }
__host__ __device__ __forceinline__ void stage_rc(int b, int& R, int& C) { const int st = b / 1024, sb = b % 1024, swz = sb ^ (((sb >> 9) & 1) << 5); R = (st >> 1) * 16 + swz / 64; C = (st & 1) * 32 + (swz % 64) / 2; }
__host__ __device__ __forceinline__ int perm32(int rho) { const int n = rho >> 4, i = rho & 15; return 8 * (i >> 2) + 4 * n + (i & 3); }

struct Unit { int pm, pn; size_t boff; size_t aoff; int slice; };
struct Gemm { const void* A; const void* Bt; int M, N, K; int ntk; };

struct StaticOrder {
    int nM, nN, nwg, G, c;
    __device__ void init(int M, int N, int G_, int c_) { nM = M / BM; nN = N / BM; nwg = nM * nN; G = G_; c = c_; }
    __device__ bool next(int i, Unit& u) const {
        const long L = (long)i * G + c; if (L >= nwg) return false;
        int wgid = (int)L; { const int q = nwg / NXCD, r = nwg % NXCD, xcd = wgid % NXCD, off = wgid / NXCD; wgid = (xcd < r ? xcd * (q + 1) : r * (q + 1) + (xcd - r) * q) + off; }
        const int nig = WGM * nN, gid = wgid / nig, fm = gid * WGM, gsz = (nM - fm) < WGM ? (nM - fm) : WGM;
        u.pm = fm + ((wgid % nig) % gsz); u.pn = (wgid % nig) / gsz; u.boff = 0; u.aoff = 0; u.slice = 0; return true;
    }
};
struct TileMap {
    int toff[9];
    __device__ __forceinline__ void lookup(int pm, int& e, int& k) const {
        e = (pm >= toff[1]) + (pm >= toff[2]) + (pm >= toff[3]) + (pm >= toff[4]) + (pm >= toff[5]) + (pm >= toff[6]) + (pm >= toff[7]);
        int t0 = 0;
#pragma unroll
        for (int q = 1; q < 8; ++q) t0 = (e == q) ? toff[q] : t0;
        k = pm - t0;
    }
};
constexpr int ECAP = 8192;
struct MoeOrder {
    int nM, nN, nwg, G, c; TileMap tm; size_t estride; size_t arowb;
    __device__ void init(int nM_, int N, int G_, int c_, const TileMap& tm_, size_t es, size_t arowb_) { nM = nM_; nN = N / BM; nwg = nM * nN; G = G_; c = c_; tm = tm_; estride = es; arowb = arowb_; }
    __device__ bool next(int i, Unit& u) const {
        const long L = (long)i * G + c; if (L >= nwg) return false;
        int wgid = (int)L; { const int q = nwg / NXCD, r = nwg % NXCD, xcd = wgid % NXCD, off = wgid / NXCD; wgid = (xcd < r ? xcd * (q + 1) : r * (q + 1) + (xcd - r) * q) + off; }
        const int nig = WGM * nN, gid = wgid / nig, fm = gid * WGM, gsz = (nM - fm) < WGM ? (nM - fm) : WGM;
        u.pm = fm + ((wgid % nig) % gsz); u.pn = (wgid % nig) / gsz; int e, k; tm.lookup(u.pm, e, k); u.boff = (size_t)e * estride;
        u.aoff = (size_t)((long)(e * ECAP + 256 * k - 256 * u.pm) * (long)arowb); u.slice = 0; return true;
    }
};

struct MoeRowOrder {
    int nwg, G, c; TileMap tm; size_t estride;
    __device__ void init(int nMf, int G_, int c_, const TileMap& tm_, size_t es) { nwg = nMf * 8; G = G_; c = c_; tm = tm_; estride = es; }
    __device__ bool next(int i, Unit& u) const {
        const long L = (long)i * G + c; if (L >= nwg) return false;
        u.pm = (int)(L >> 3); u.pn = (int)(L & 7); int e, k; tm.lookup(u.pm, e, k); u.boff = (size_t)e * estride; u.aoff = 0; u.slice = 0; return true;
    }
};
struct MoeSplitOrder {
    int pm0, nq, S, c; size_t kslice; TileMap tm; size_t estride;
    __device__ void init(int pm0_, int nT, int S_, size_t ks, int c_, const TileMap& tm_, size_t es) { pm0 = pm0_; S = S_; nq = nT * 8 * S_; kslice = ks; c = c_; tm = tm_; estride = es; }
    __device__ bool next(int i, Unit& u) const {
        if (i != 0 || c >= nq) return false;
        const int un = c / S; u.slice = c - un * S; u.pm = pm0 + (un >> 3); u.pn = un & 7; u.aoff = (size_t)u.slice * kslice; int e, k; tm.lookup(u.pm, e, k); u.boff = (size_t)e * estride + u.aoff; return true;
    }
};
struct EpiBf16 {
    static constexpr bool PERM = true, XBAR = false;
    bf16_t* O; int ldc;
    __device__ __forceinline__ void operator()(const f32x4 (&acc)[2][2][4][2], const Unit& u, int wr, int wc, int fr, int fq) const {
        const int row0 = u.pm * BM + wr * 64 + fr, col0 = u.pn * BM + wc * 32 + 8 * fq;
#pragma unroll
        for (int ai = 0; ai < 2; ++ai)
#pragma unroll
            for (int m = 0; m < 4; ++m) { bf16_t* rowp = O + (size_t)(row0 + ai * HALF + m * 16) * ldc + col0;
#pragma unroll
                for (int bj = 0; bj < 2; ++bj) { const f32x4 v0 = acc[ai][bj][m][0], v1 = acc[ai][bj][m][1];
                    u32x4 w; w.x = cvt_pk_bf16(v0[0], v0[1]); w.y = cvt_pk_bf16(v0[2], v0[3]); w.z = cvt_pk_bf16(v1[0], v1[1]); w.w = cvt_pk_bf16(v1[2], v1[3]);
                    *(u32x4*)(rowp + bj * HALF) = w; } }
    }
};
struct EpiQKNorm {
    static constexpr bool PERM = true, XBAR = true;
    bf16_t* O; int ldc; const float* qg; const float* kg; float sc;
    __device__ __forceinline__ void pre(const f32x4 (&acc)[2][2][4][2], int wr, int wc, int fr, int fq, LAS float* P) const {
#pragma unroll
        for (int ai = 0; ai < 2; ++ai)
#pragma unroll
            for (int m = 0; m < 4; ++m)
#pragma unroll
                for (int bj = 0; bj < 2; ++bj) { const f32x4 a = acc[ai][bj][m][0], b = acc[ai][bj][m][1];
                    float ss = (a[0] * a[0] + a[1] * a[1]) + (a[2] * a[2] + a[3] * a[3]) + (b[0] * b[0] + b[1] * b[1]) + (b[2] * b[2] + b[3] * b[3]);
                    ss += __shfl_xor(ss, 16); ss += __shfl_xor(ss, 32);
                    if (fq == 0) P[((ai * HALF + wr * 64 + m * 16 + fr) * 2 + bj) * 4 + wc] = ss * sc * sc; }
    }
    __device__ __forceinline__ void post(const f32x4 (&acc)[2][2][4][2], const Unit& u, int wr, int wc, int fr, int fq, const LAS float* P) const {
        const int row0 = u.pm * BM + wr * 64 + fr, col0 = u.pn * BM + wc * 32 + 8 * fq;
        f32x4 g0[2], g1[2]; float hs[2];
#pragma unroll
        for (int bj = 0; bj < 2; ++bj) { const int head = 2 * u.pn + bj; const float* gp = (head < 16 ? qg : kg) + wc * 32 + 8 * fq; g0[bj] = *(const f32x4*)gp; g1[bj] = *(const f32x4*)(gp + 4); hs[bj] = head < 16 ? 0.08838834764831845f : 1.0f; }
#pragma unroll
        for (int ai = 0; ai < 2; ++ai)
#pragma unroll
            for (int m = 0; m < 4; ++m) { bf16_t* rowp = O + (size_t)(row0 + ai * HALF + m * 16) * ldc + col0;
#pragma unroll
                for (int bj = 0; bj < 2; ++bj) { const f32x4 ps = *(const LAS f32x4*)(P + ((ai * HALF + wr * 64 + m * 16 + fr) * 2 + bj) * 4);
                    const float rstd = hs[bj] / sqrtf(((ps[0] + ps[1]) + (ps[2] + ps[3])) * (1.f / 128.f) + 1e-6f);
                    const f32x4 v0 = acc[ai][bj][m][0] * g0[bj] * (rstd * sc), v1 = acc[ai][bj][m][1] * g1[bj] * (rstd * sc);
                    u32x4 w; w.x = cvt_pk_bf16(v0[0], v0[1]); w.y = cvt_pk_bf16(v0[2], v0[3]); w.z = cvt_pk_bf16(v1[0], v1[1]); w.w = cvt_pk_bf16(v1[2], v1[3]);
                    *(u32x4*)(rowp + bj * HALF) = w; } }
    }
};
struct EpiBf16S {
    static constexpr bool PERM = true, XBAR = false;
    bf16_t* O; int ldc; float sc; size_t sstride;
    __device__ __forceinline__ void operator()(const f32x4 (&acc)[2][2][4][2], const Unit& u, int wr, int wc, int fr, int fq) const {
        const int row0 = u.pm * BM + wr * 64 + fr, col0 = u.pn * BM + wc * 32 + 8 * fq;
        bf16_t* Os = O + (size_t)u.slice * sstride;
#pragma unroll
        for (int ai = 0; ai < 2; ++ai)
#pragma unroll
            for (int m = 0; m < 4; ++m) { bf16_t* rowp = Os + (size_t)(row0 + ai * HALF + m * 16) * ldc + col0;
#pragma unroll
                for (int bj = 0; bj < 2; ++bj) { const f32x4 v0 = acc[ai][bj][m][0] * sc, v1 = acc[ai][bj][m][1] * sc;
                    u32x4 w; w.x = cvt_pk_bf16(v0[0], v0[1]); w.y = cvt_pk_bf16(v0[2], v0[3]); w.z = cvt_pk_bf16(v1[0], v1[1]); w.w = cvt_pk_bf16(v1[2], v1[3]);
                    *(u32x4*)(rowp + bj * HALF) = w; } }
    }
};
struct EpiSwiGLU {
    static constexpr bool PERM = true, XBAR = false;
    bf16_t* O; int ldc;
    __device__ __forceinline__ void operator()(const f32x4 (&acc)[2][2][4][2], const Unit& u, int wr, int wc, int fr, int fq) const {
        const int row0 = u.pm * BM + wr * 64 + fr, col0 = u.pn * HALF + wc * 32 + 8 * fq;
#pragma unroll
        for (int ai = 0; ai < 2; ++ai)
#pragma unroll
            for (int m = 0; m < 4; ++m) { bf16_t* rowp = O + (size_t)(row0 + ai * HALF + m * 16) * ldc + col0;
                float o[8];
#pragma unroll
                for (int n = 0; n < 2; ++n)
#pragma unroll
                    for (int j = 0; j < 4; ++j) { const float g = acc[ai][0][m][n][j], up = acc[ai][1][m][n][j]; o[n * 4 + j] = g * __builtin_amdgcn_rcpf(1.f + __expf(-g)) * up; }
                u32x4 w; w.x = cvt_pk_bf16(o[0], o[1]); w.y = cvt_pk_bf16(o[2], o[3]); w.z = cvt_pk_bf16(o[4], o[5]); w.w = cvt_pk_bf16(o[6], o[7]);
                *(u32x4*)rowp = w; }
    }
};
struct EpiSwiGLU8 {
    static constexpr bool PERM = true, XBAR = false;
    unsigned char* O; int ldc; float isc, osc;
    __device__ __forceinline__ void operator()(const f32x4 (&acc)[2][2][4][2], const Unit& u, int wr, int wc, int fr, int fq) const {
        const int row0 = u.pm * BM + wr * 64 + fr, col0 = u.pn * HALF + wc * 32 + 8 * fq;
#pragma unroll
        for (int ai = 0; ai < 2; ++ai)
#pragma unroll
            for (int m = 0; m < 4; ++m) { unsigned char* rowp = O + (size_t)(row0 + ai * HALF + m * 16) * ldc + col0;
                float o[8];
#pragma unroll
                for (int n = 0; n < 2; ++n)
#pragma unroll
                    for (int j = 0; j < 4; ++j) { const float g = acc[ai][0][m][n][j] * isc, up = acc[ai][1][m][n][j] * isc; o[n * 4 + j] = g * __builtin_amdgcn_rcpf(1.f + __expf(-g)) * up * osc; }
                u32x2 w; w.x = pk4_fp8(o[0], o[1], o[2], o[3]); w.y = pk4_fp8(o[4], o[5], o[6], o[7]);
                *(u32x2*)rowp = w; }
    }
};
struct EpiResGate {
    static constexpr bool PERM = false, XBAR = false;
    const float* base; float* out; int ldc; const float* gate; int gstride;
    __device__ __forceinline__ void operator()(const f32x4 (&acc)[2][2][4][2], const Unit& u, int wr, int wc, int fr, int fq) const {
        const int row0 = u.pm * BM + wr * 64 + fr, col0 = u.pn * BM + wc * 32 + 4 * fq;
        const float* gp = gate + (size_t)((u.pm * BM) >> 11) * gstride + col0;
        f32x4 gv[2][2];
#pragma unroll
        for (int bj = 0; bj < 2; ++bj)
#pragma unroll
            for (int n = 0; n < 2; ++n) gv[bj][n] = *(const f32x4*)(gp + bj * HALF + n * 16);
#pragma unroll
        for (int ai = 0; ai < 2; ++ai)
#pragma unroll
            for (int m = 0; m < 4; ++m) { const size_t off = (size_t)(row0 + ai * HALF + m * 16) * ldc + col0;
#pragma unroll
                for (int bj = 0; bj < 2; ++bj)
#pragma unroll
                    for (int n = 0; n < 2; ++n) { const f32x4 bs = *(const f32x4*)(base + off + bj * HALF + n * 16);
                        *(f32x4*)(out + off + bj * HALF + n * 16) = bs + gv[bj][n] * acc[ai][bj][m][n]; }
                asm volatile("" ::: "memory"); }
    }
};
template <bool BASE16>
struct EpiResGate16 {
    static constexpr bool PERM = true, XBAR = false;
    const void* base; bf16_t* out; int ldc; const float* gate; int gstride; float sc = 1.0f;
    __device__ __forceinline__ void operator()(const f32x4 (&acc)[2][2][4][2], const Unit& u, int wr, int wc, int fr, int fq) const {
        const int row0 = u.pm * BM + wr * 64 + fr, col0 = u.pn * BM + wc * 32 + 8 * fq;
        const float* gp = gate + (size_t)((u.pm * BM) >> 11) * gstride + col0;
        f32x4 gv[2][2];
#pragma unroll
        for (int bj = 0; bj < 2; ++bj)
#pragma unroll
            for (int n = 0; n < 2; ++n) gv[bj][n] = *(const f32x4*)(gp + bj * HALF + 4 * n) * sc;
#pragma unroll
        for (int ai = 0; ai < 2; ++ai)
#pragma unroll
            for (int m = 0; m < 4; ++m) { const size_t off = (size_t)(row0 + ai * HALF + m * 16) * ldc + col0;
#pragma unroll
                for (int bj = 0; bj < 2; ++bj) { f32x4 b0, b1;
                    if (BASE16) { const u32x4 r = *(const u32x4*)((const bf16_t*)base + off + bj * HALF);
                        b0 = (f32x4){__uint_as_float(r.x << 16), __uint_as_float(r.x & 0xffff0000u), __uint_as_float(r.y << 16), __uint_as_float(r.y & 0xffff0000u)};
                        b1 = (f32x4){__uint_as_float(r.z << 16), __uint_as_float(r.z & 0xffff0000u), __uint_as_float(r.w << 16), __uint_as_float(r.w & 0xffff0000u)}; }
                    else { b0 = *(const f32x4*)((const float*)base + off + bj * HALF); b1 = *(const f32x4*)((const float*)base + off + bj * HALF + 4); }
                    const f32x4 v0 = b0 + gv[bj][0] * acc[ai][bj][m][0], v1 = b1 + gv[bj][1] * acc[ai][bj][m][1];
                    u32x4 w; w.x = cvt_pk_bf16(v0[0], v0[1]); w.y = cvt_pk_bf16(v0[2], v0[3]); w.z = cvt_pk_bf16(v1[0], v1[1]); w.w = cvt_pk_bf16(v1[2], v1[3]);
                    *(u32x4*)(out + off + bj * HALF) = w; }
                asm volatile("" ::: "memory"); }
    }
};
struct EpiF32 {
    static constexpr bool PERM = false, XBAR = false;
    float* C; int ldc; float sc;
    __device__ __forceinline__ void operator()(const f32x4 (&acc)[2][2][4][2], const Unit& u, int wr, int wc, int fr, int fq) const {
        const int row0 = u.pm * BM + wr * 64 + fr, col0 = u.pn * BM + wc * 32 + 4 * fq;
#pragma unroll
        for (int ai = 0; ai < 2; ++ai)
#pragma unroll
            for (int m = 0; m < 4; ++m) { float* rowp = C + (size_t)(row0 + ai * HALF + m * 16) * ldc + col0;
#pragma unroll
                for (int bj = 0; bj < 2; ++bj)
#pragma unroll
                    for (int n = 0; n < 2; ++n) *(f32x4*)(rowp + bj * HALF + n * 16) = acc[ai][bj][m][n] * sc; }
    }
};

template <class Epi, class Sched, bool F8 = false, int HOT = 0, int SCH = GEMM_SCH>
__device__ __forceinline__ void gemm_phase(LAS unsigned char* lds, const Gemm g, const Sched& S, const Epi& E) {
    int tid = threadIdx.x; asm volatile("" : "+v"(tid));
    const int wid = __builtin_amdgcn_readfirstlane(tid >> 6), lane = tid & 63, wr = wid >> 2, wc = wid & 3, fr = lane & 15, fq = lane >> 4;
    const int rowb = F8 ? g.K : 2 * g.K, nt = g.ntk ? g.ntk : rowb / (BK * 2);
    unsigned voffA[2], voffB[2];
#pragma unroll
    for (int i = 0; i < 2; ++i) { int R, C; stage_rc(tid * 16 + i * 8192, R, C); const int Rb = Epi::PERM ? ((R & ~31) + perm32(R & 31)) : R;
        voffA[i] = (unsigned)(R * rowb + C * 2); voffB[i] = (unsigned)(Rb * rowb + C * 2); }
    const size_t kstep = (size_t)(BK * 2);
    const size_t hstep = (size_t)HALF * rowb;
    const size_t tstep = 2 * hstep;
    const unsigned ldsw = (unsigned)wid * 1024u;
    const int aoff = lds_byte(wr * 64 + fr, fq * 8), boff = lds_byte(wc * 32 + fr, fq * 8);
#define PG8_SA(b, h) (((b) * 2 + (h)) * HTB)
#define PG8_SB(b, h) ((4 + (b) * 2 + (h)) * HTB)
#define PG8_STAGE(bufoff, gbase, voff) do { _Pragma("unroll") for (int _i = 0; _i < 2; ++_i) \
        __builtin_amdgcn_global_load_lds((const unsigned*)((const char*)(gbase) + (voff)[_i]), (LAS unsigned*)(lds + (bufoff) + ldsw + _i * 8192), 16, 0, 0); } while (0)
#define PG8_LD8(base_) __builtin_shufflevector(*(const LAS i32x4*)(base_), *(const LAS i32x4*)((base_) + 1024), 0, 1, 2, 3, 4, 5, 6, 7)
#define PG8_LDA(dst, b, h) do { _Pragma("unroll") for (int m = 0; m < 4; ++m) { if constexpr (F8) dst##8[m] = PG8_LD8(lds + PG8_SA(b, h) + aoff + m * 2048); \
        else { _Pragma("unroll") for (int k = 0; k < 2; ++k) dst[m][k] = *(const LAS bf16x8*)(lds + PG8_SA(b, h) + aoff + m * 2048 + k * 1024); } } } while (0)
#define PG8_LDB(dst, b, h) do { _Pragma("unroll") for (int n = 0; n < 2; ++n) { if constexpr (F8) dst##8[n] = PG8_LD8(lds + PG8_SB(b, h) + boff + n * 2048); \
        else { _Pragma("unroll") for (int k = 0; k < 2; ++k) dst[n][k] = *(const LAS bf16x8*)(lds + PG8_SB(b, h) + boff + n * 2048 + k * 1024); } } } while (0)
#define PG8_MMA(ai, bj, At, Bt) do { __builtin_amdgcn_s_setprio(1); _Pragma("unroll") for (int m = 0; m < 4; ++m) _Pragma("unroll") for (int n = 0; n < 2; ++n) { \
        if constexpr (F8) { asm volatile("v_mfma_f32_16x16x128_f8f6f4 %0, %1, %2, %0" : "+v"(acc[ai][bj][m][n]) : "v"(Bt##8[n]), "v"(At##8[m])); } \
        else { _Pragma("unroll") for (int k = 0; k < 2; ++k) acc[ai][bj][m][n] = __builtin_amdgcn_mfma_f32_16x16x32_bf16(Bt[n][k], At[m][k], acc[ai][bj][m][n], 0, 0, 0); } } \
        __builtin_amdgcn_s_setprio(0); } while (0)
#define PG8_WAIT_V(n) asm volatile("s_waitcnt vmcnt(" #n ")" ::: "memory")
#define PG8_WAIT_L(n) asm volatile("s_waitcnt lgkmcnt(" #n ")" ::: "memory")
#define PG8_BAR __builtin_amdgcn_s_barrier()
#define PG8_SCHED __builtin_amdgcn_sched_barrier(0)
    Unit cur, nxt; int ui = 0;
    if (!S.next(0, cur)) return;
    f32x4 acc[2][2][4][2];
#pragma unroll
    for (int a = 0; a < 2; ++a)
#pragma unroll
        for (int b = 0; b < 2; ++b)
#pragma unroll
            for (int m = 0; m < 4; ++m)
#pragma unroll
                for (int n = 0; n < 2; ++n) acc[a][b][m][n] = (f32x4){0.f, 0.f, 0.f, 0.f};
    bf16x8 At[4][2], B0[2][2], B1[2][2]; i32x8 At8[4], B08[2], B18[2];
    const char* cA = (const char*)g.A + cur.aoff + (size_t)(HOT ? 0 : cur.pm) * tstep; const char* cB = (const char*)g.Bt + cur.boff + (size_t)(HOT ? 0 : cur.pn) * tstep;
    if constexpr (SCH == 1) {
        PG8_STAGE(PG8_SB(0, 0), cB, voffB); PG8_STAGE(PG8_SB(0, 1), cB + hstep, voffB); PG8_STAGE(PG8_SA(0, 0), cA, voffA); PG8_STAGE(PG8_SA(0, 1), cA + hstep, voffA);
        if (wr == 1) PG8_BAR;
        PG8_WAIT_V(2); PG8_BAR;
        PG8_STAGE(PG8_SB(1, 0), cB + kstep, voffB); PG8_STAGE(PG8_SB(1, 1), cB + hstep + kstep, voffB); PG8_STAGE(PG8_SA(1, 0), cA + kstep, voffA);
        PG8_WAIT_V(6); PG8_BAR;
    } else {
    PG8_STAGE(PG8_SB(0, 0), cB, voffB); PG8_STAGE(PG8_SA(0, 0), cA, voffA); PG8_STAGE(PG8_SB(0, 1), cB + hstep, voffB); PG8_STAGE(PG8_SA(0, 1), cA + hstep, voffA);
    if (wr == 1) PG8_BAR;
    PG8_WAIT_V(4); PG8_BAR;
    PG8_STAGE(PG8_SB(1, 0), cB + kstep, voffB); PG8_STAGE(PG8_SA(1, 0), cA + kstep, voffA); PG8_STAGE(PG8_SB(1, 1), cB + hstep + kstep, voffB);
    PG8_WAIT_V(6); PG8_BAR;
    }
    for (;;) {
        const bool has_next = S.next(ui + 1, nxt);
        const char* nA = has_next ? (const char*)g.A + nxt.aoff + (size_t)(HOT ? 0 : nxt.pm) * tstep : cA; const char* nB = has_next ? (const char*)g.Bt + nxt.boff + (size_t)(HOT ? 0 : nxt.pn) * tstep : cB;
        for (int t = 0; t < nt; t += 2) {
            const bool last = (t == nt - 2);
            const char* a1 = cA + (size_t)(t + 1) * kstep;
            const char* a2 = last ? nA : cA + (size_t)(t + 2) * kstep; const char* b2 = last ? nB : cB + (size_t)(t + 2) * kstep;
            const char* a3 = a2 + kstep; const char* b3 = b2 + kstep;
            if constexpr (SCH == 1) {
                PG8_LDB(B0, 0, 0); PG8_LDB(B1, 0, 1); PG8_SCHED; PG8_LDA(At, 0, 0); PG8_STAGE(PG8_SA(1, 1), a1 + hstep, voffA);
                PG8_WAIT_V(8); PG8_WAIT_L(0); PG8_BAR; PG8_MMA(0, 0, At, B0); PG8_MMA(0, 1, At, B1); PG8_BAR; PG8_SCHED;
                PG8_LDA(At, 0, 1); PG8_STAGE(PG8_SB(0, 0), b2, voffB); PG8_STAGE(PG8_SB(0, 1), b2 + hstep, voffB); PG8_STAGE(PG8_SA(0, 0), a2, voffA);
                PG8_WAIT_V(8); PG8_WAIT_L(0); PG8_BAR; PG8_MMA(1, 0, At, B0); PG8_MMA(1, 1, At, B1); PG8_BAR; PG8_SCHED;
                PG8_LDB(B0, 1, 0); PG8_LDB(B1, 1, 1); PG8_SCHED; PG8_LDA(At, 1, 0); PG8_STAGE(PG8_SA(0, 1), a2 + hstep, voffA);
                PG8_WAIT_V(8); PG8_WAIT_L(0); PG8_BAR; PG8_MMA(0, 0, At, B0); PG8_MMA(0, 1, At, B1); PG8_BAR; PG8_SCHED;
                PG8_LDA(At, 1, 1); PG8_STAGE(PG8_SB(1, 0), b3, voffB); PG8_STAGE(PG8_SB(1, 1), b3 + hstep, voffB); PG8_STAGE(PG8_SA(1, 0), a3, voffA);
                PG8_WAIT_V(8); PG8_WAIT_L(0); PG8_BAR; PG8_MMA(1, 0, At, B0); PG8_MMA(1, 1, At, B1); PG8_BAR; PG8_SCHED;
                continue;
            }
            PG8_LDB(B0, 0, 0); PG8_SCHED; PG8_LDA(At, 0, 0); PG8_STAGE(PG8_SA(1, 1), a1 + hstep, voffA);
            PG8_WAIT_L(8); PG8_BAR; PG8_WAIT_L(0); PG8_MMA(0, 0, At, B0); PG8_BAR; PG8_SCHED;
            PG8_LDB(B1, 0, 1); PG8_STAGE(PG8_SB(0, 0), b2, voffB);
            PG8_BAR; PG8_WAIT_L(0); PG8_MMA(0, 1, At, B1); PG8_BAR;
            PG8_LDA(At, 0, 1); PG8_STAGE(PG8_SA(0, 0), a2, voffA);
            PG8_BAR; PG8_WAIT_L(0); PG8_MMA(1, 0, At, B0); PG8_BAR; PG8_SCHED;
            PG8_STAGE(PG8_SB(0, 1), b2 + hstep, voffB);
            PG8_WAIT_V(6); PG8_BAR; PG8_MMA(1, 1, At, B1); PG8_BAR;
            PG8_LDB(B0, 1, 0); PG8_SCHED; PG8_LDA(At, 1, 0); PG8_STAGE(PG8_SA(0, 1), a2 + hstep, voffA);
            PG8_WAIT_L(8); PG8_BAR; PG8_WAIT_L(0); PG8_MMA(0, 0, At, B0); PG8_BAR; PG8_SCHED;
            PG8_LDB(B1, 1, 1); PG8_STAGE(PG8_SB(1, 0), b3, voffB);
            PG8_BAR; PG8_WAIT_L(0); PG8_MMA(0, 1, At, B1); PG8_BAR;
            PG8_LDA(At, 1, 1); PG8_STAGE(PG8_SA(1, 0), a3, voffA);
            PG8_BAR; PG8_WAIT_L(0); PG8_MMA(1, 0, At, B0); PG8_BAR; PG8_SCHED;
            PG8_STAGE(PG8_SB(1, 1), b3 + hstep, voffB);
            PG8_WAIT_V(6); PG8_BAR; PG8_MMA(1, 1, At, B1); PG8_BAR;
        }
        if constexpr (F8) asm volatile("s_nop 15\n\ts_nop 15" ::: "memory");
        if constexpr (Epi::XBAR) { LAS float* P_ = (LAS float*)(lds + STAGE_BYTES); E.pre(acc, wr, wc, fr, fq, P_); PG8_WAIT_L(0); PG8_BAR; asm volatile("" ::: "memory"); E.post(acc, cur, wr, wc, fr, fq, P_); }
        else E(acc, cur, wr, wc, fr, fq);
        if (!has_next) break;
#pragma unroll
        for (int a = 0; a < 2; ++a)
#pragma unroll
            for (int b = 0; b < 2; ++b)
#pragma unroll
                for (int m = 0; m < 4; ++m)
#pragma unroll
                    for (int n = 0; n < 2; ++n) acc[a][b][m][n] = (f32x4){0.f, 0.f, 0.f, 0.f};
        cur = nxt; cA = nA; cB = nB; ++ui;
    }
    PG8_WAIT_V(0);
    if (wr == 0) PG8_BAR;
    PG8_BAR;
#undef PG8_SA
#undef PG8_SB
#undef PG8_STAGE
#undef PG8_LDA
#undef PG8_LDB
#undef PG8_MMA
#undef PG8_WAIT_V
#undef PG8_WAIT_L
#undef PG8_BAR
#undef PG8_SCHED
}
}

DI void mod_phase(const float* c, const float* mod_w, const float* mod_b, float* mod, LAS unsigned char* lds, int G, int tid, int lane, int wave) {
    LAS f32x4* cact = (LAS f32x4*)lds;
    LAS float* red = (LAS float*)(lds + 32768);
    for (int k = tid; k < DM; k += NTHREADS) { f32x4 v; v.x = silu_f(c[k]); v.y = silu_f(c[DM + k]); v.z = silu_f(c[2 * DM + k]); v.w = silu_f(c[3 * DM + k]); cact[k] = v; }
    __syncthreads();
    for (int it = blockIdx.x; it < 256; it += G) {
        const int l = it >> 7, n0 = (it & 127) * 96;
        float a0[4] = {0.f, 0.f, 0.f, 0.f}, a1[4] = {0.f, 0.f, 0.f, 0.f};
        if (lane < 48) {
            const float* wp = mod_w + ((size_t)l * DM + wave * 256) * 12288 + n0 + 2 * lane;
#pragma unroll 8
            for (int k = 0; k < 256; ++k) { const f32x2 w = *(const f32x2*)(wp + (size_t)k * 12288); const f32x4 cv = cact[wave * 256 + k];
                a0[0] += cv.x * w.x; a1[0] += cv.x * w.y; a0[1] += cv.y * w.x; a1[1] += cv.y * w.y; a0[2] += cv.z * w.x; a1[2] += cv.z * w.y; a0[3] += cv.w * w.x; a1[3] += cv.w * w.y; }
#pragma unroll
            for (int b = 0; b < 4; ++b) { red[(wave * 4 + b) * 96 + 2 * lane] = a0[b]; red[(wave * 4 + b) * 96 + 2 * lane + 1] = a1[b]; }
        }
        __syncthreads();
        if (tid < 384) { const int b = tid / 96, col = tid % 96; float s = mod_b[l * 12288 + n0 + col];
#pragma unroll
            for (int w = 0; w < 8; ++w) s += red[(w * 4 + b) * 96 + col];
            mod[((size_t)l * 4 + b) * 12288 + n0 + col] = s; }
        __syncthreads();
    }
}

template <int MODE>
DI void cvt_item(const float* W, int K, int N, bf16_t* WT, LAS float* scr, int kb, int nb, int lane) {
    const int k0 = 64 * kb, n0 = 32 * nb;
    float v[32];
    const float* wp = W + (size_t)(k0 + (lane >> 5)) * N + n0 + (lane & 31);
#pragma unroll
    for (int i = 0; i < 32; ++i) v[i] = wp[(size_t)(2 * i) * N];
#pragma unroll
    for (int i = 0; i < 32; ++i) scr[(2 * i + (lane >> 5)) * 33 + (lane & 31)] = v[i];
    LDS_WAIT();
    const int c = lane & 7;
#pragma unroll
    for (int j = 0; j < 4; ++j) { const int n = (lane >> 3) + 8 * j; const LAS float* s = scr + (8 * c) * 33 + n;
        u32x4 o; o.x = cvt_pk_bf16(s[0 * 33], s[1 * 33]); o.y = cvt_pk_bf16(s[2 * 33], s[3 * 33]); o.z = cvt_pk_bf16(s[4 * 33], s[5 * 33]); o.w = cvt_pk_bf16(s[6 * 33], s[7 * 33]);
        const int ng = n0 + n; const int row = (MODE == 0) ? ng : ((ng >> 7) * 256 + (ng & 127) + (MODE == 2 ? 128 : 0));
        *(u32x4*)(WT + (size_t)row * K + k0 + 8 * c) = o; }
    LDS_WAIT();
}
template <int MODE>
DI void cvt_item8(const float* W, int K, int N, unsigned char* WT, LAS float* scr, int kb, int nb, int lane, float wsc) {
    const int k0 = 64 * kb, n0 = 32 * nb;
    float v[32];
    const float* wp = W + (size_t)(k0 + (lane >> 5)) * N + n0 + (lane & 31);
#pragma unroll
    for (int i = 0; i < 32; ++i) v[i] = wp[(size_t)(2 * i) * N];
#pragma unroll
    for (int i = 0; i < 32; ++i) scr[(2 * i + (lane >> 5)) * 33 + (lane & 31)] = v[i] * wsc;
    LDS_WAIT();
    const int c = lane & 3;
#pragma unroll
    for (int j = 0; j < 2; ++j) { const int n = (lane >> 2) + 16 * j; const LAS float* s = scr + (16 * c) * 33 + n;
        u32x4 o; o.x = pk4_fp8(s[0 * 33], s[1 * 33], s[2 * 33], s[3 * 33]); o.y = pk4_fp8(s[4 * 33], s[5 * 33], s[6 * 33], s[7 * 33]);
        o.z = pk4_fp8(s[8 * 33], s[9 * 33], s[10 * 33], s[11 * 33]); o.w = pk4_fp8(s[12 * 33], s[13 * 33], s[14 * 33], s[15 * 33]);
        const int ng = n0 + n; const int row = (MODE == 0) ? ng : ((ng >> 7) * 256 + (ng & 127) + (MODE == 2 ? 128 : 0));
        *(u32x4*)(WT + (size_t)row * K + k0 + 16 * c) = o; }
    LDS_WAIT();
}
template <int MODE>
DI void cvt_job8(const float* W, int K, int N, int nbatch, unsigned char* WT, size_t dst_bstride, LAS float* scr, int gw, int NGW, int lane, float wsc) {
    const int nnb = N / 32, per = (K / 64) * nnb, total = per * nbatch;
    for (int it = gw; it < total; it += NGW) {
        const int bt = it / per, r = it - bt * per, kb = r / nnb, nb = r - kb * nnb;
        cvt_item8<MODE>(W + (size_t)bt * K * N, K, N, WT + (size_t)bt * dst_bstride, scr, kb, nb, lane, wsc);
    }
}
template <int MODE>
DI void cvt_job(const float* W, int K, int N, int nbatch, bf16_t* WT, size_t dst_bstride, LAS float* scr, int gw, int NGW, int lane) {
    const int nnb = N / 32, per = (K / 64) * nnb, total = per * nbatch;
    for (int it = gw; it < total; it += NGW) {
        const int bt = it / per, r = it - bt * per, kb = r / nnb, nb = r - kb * nnb;
        cvt_item<MODE>(W + (size_t)bt * K * N, K, N, WT + (size_t)bt * dst_bstride, scr, kb, nb, lane);
    }
}

DI void cvtw_load(f32x4 (&v)[16], const float* wp, int N) {
#pragma unroll
    for (int i = 0; i < 16; ++i) v[i] = __builtin_nontemporal_load((const f32x4*)(wp + (size_t)(4 * i) * N));
}
template <int MODE, bool OUT8>
DI void cvtw_store(const f32x4 (&v)[16], int K, void* WTb, LAS float* scr, int k0, int n0, int lane, float wsc) {
    const int kr = lane >> 4, n4 = lane & 15;
#pragma unroll
    for (int i = 0; i < 16; ++i)
#pragma unroll
        for (int e = 0; e < 4; ++e) scr[(4 * n4 + e) * 65 + 4 * i + kr] = OUT8 ? v[i][e] * wsc : v[i][e];
    LDS_WAIT();
    if (OUT8) {
        unsigned char* WT = (unsigned char*)WTb; const int c = lane & 3;
#pragma unroll
        for (int j = 0; j < 4; ++j) { const int n = (lane >> 2) + 16 * j; const LAS float* s = scr + n * 65 + 16 * c;
            u32x4 o; o.x = pk4_fp8(s[0], s[1], s[2], s[3]); o.y = pk4_fp8(s[4], s[5], s[6], s[7]); o.z = pk4_fp8(s[8], s[9], s[10], s[11]); o.w = pk4_fp8(s[12], s[13], s[14], s[15]);
            const int ng = n0 + n; const int row = (MODE == 0) ? ng : ((ng >> 7) * 256 + (ng & 127) + (MODE == 2 ? 128 : 0));
            *(u32x4*)(WT + (size_t)row * K + k0 + 16 * c) = o; }
    } else {
        bf16_t* WT = (bf16_t*)WTb; const int c = lane & 7;
#pragma unroll
        for (int j = 0; j < 8; ++j) { const int n = (lane >> 3) + 8 * j; const LAS float* s = scr + n * 65 + 8 * c;
            u32x4 o; o.x = cvt_pk_bf16(s[0], s[1]); o.y = cvt_pk_bf16(s[2], s[3]); o.z = cvt_pk_bf16(s[4], s[5]); o.w = cvt_pk_bf16(s[6], s[7]);
            const int ng = n0 + n; const int row = (MODE == 0) ? ng : ((ng >> 7) * 256 + (ng & 127) + (MODE == 2 ? 128 : 0));
            *(u32x4*)(WT + (size_t)row * K + k0 + 8 * c) = o; }
    }
    LDS_WAIT();
}
DI void cvtw_pack8(const f32x4 (&v)[16], LAS float* scr, int lane, float wsc, u32x4 (&o)[4]) {
    const int kr = lane >> 4, n4 = lane & 15;
#pragma unroll
    for (int i = 0; i < 16; ++i)
#pragma unroll
        for (int e = 0; e < 4; ++e) scr[(4 * n4 + e) * 65 + 4 * i + kr] = v[i][e] * wsc;
    LDS_WAIT();
    const int c = lane & 3;
#pragma unroll
    for (int j = 0; j < 4; ++j) { const int n = (lane >> 2) + 16 * j; const LAS float* s = scr + n * 65 + 16 * c;
        o[j].x = pk4_fp8(s[0], s[1], s[2], s[3]); o[j].y = pk4_fp8(s[4], s[5], s[6], s[7]); o[j].z = pk4_fp8(s[8], s[9], s[10], s[11]); o[j].w = pk4_fp8(s[12], s[13], s[14], s[15]); }
    LDS_WAIT();
}
template <int MODE, bool OUT8>
DI void cvtw_job(const float* W, int K, int N, int nbatch, void* WT, size_t dst_bstride_bytes, LAS float* scr, int gw, int NGW, int lane, float wsc, int ld = 0, int off = 0) {
    const int nnb = N / 64, per = (K / 128) * nnb, total = per * nbatch;
    const int pitch = ld ? ld : N;
    const int first = (gw + NGW - (off % NGW)) % NGW;
    if (first >= total) return;
#define CVTW_SRC(it_) ({ const int bt_ = (it_) / per, r_ = (it_) - bt_ * per, kb_ = r_ / nnb, nb_ = r_ - kb_ * nnb; W + (size_t)bt_ * K * pitch + (size_t)(128 * kb_ + (lane >> 4)) * pitch + 64 * nb_ + 4 * (lane & 15); })
    for (int it = first; it < total; it += NGW) {
        const int bt = it / per, r = it - bt * per, kb = r / nnb, nb = r - kb * nnb, k0 = 128 * kb, n0 = 64 * nb;
        f32x4 v0[16], v1[16];
        { const float* wp = CVTW_SRC(it); cvtw_load(v0, wp, pitch); cvtw_load(v1, wp + (size_t)64 * pitch, pitch); }
        void* WTb = (unsigned char*)WT + (size_t)bt * dst_bstride_bytes;
        if (OUT8) {
            u32x4 o0[4], o1[4];
            cvtw_pack8(v0, scr, lane, wsc, o0);
            cvtw_pack8(v1, scr, lane, wsc, o1);
            unsigned char* WT8 = (unsigned char*)WTb; const int c = lane & 3;
#pragma unroll
            for (int j = 0; j < 4; ++j) { const int ng = n0 + (lane >> 2) + 16 * j; const int row = (MODE == 0) ? ng : ((ng >> 7) * 256 + (ng & 127) + (MODE == 2 ? 128 : 0));
                unsigned char* dp = WT8 + (size_t)row * K + k0 + 16 * c; *(u32x4*)dp = o0[j]; *(u32x4*)(dp + 64) = o1[j]; }
        } else {
            cvtw_store<MODE, OUT8>(v0, K, WTb, scr, k0, n0, lane, wsc);
            cvtw_store<MODE, OUT8>(v1, K, WTb, scr, k0 + 64, n0, lane, wsc);
        }
    }
#undef CVTW_SRC
}

constexpr float HSCALE = 8.f, WSCALE = 256.f, ASCALE = 8.f;
template <bool ROUTER, bool OUT8 = false, bool X16 = false>
DI void rms_mod_phase(const void* X, const float* g, const float* scale, const float* shift, bf16_t* out,
                      const float* router, int* tok_e, int* tok_pos, float* tok_w, unsigned* ecnt, unsigned char* HS2, int gw, int NGW, int lane) {
    for (int row = gw; row < MTOK; row += NGW) {
        const int b = row >> 11;
        f32x4 v[8]; float ss = 0.f;
        if (X16) { const u32x2* xr = (const u32x2*)((const bf16_t*)X + (size_t)row * DM) + lane; u32x2 raw[8];
#pragma unroll
            for (int j = 0; j < 8; ++j) raw[j] = xr[64 * j];
#pragma unroll
            for (int j = 0; j < 8; ++j) v[j] = (f32x4){bf_lo(raw[j].x), bf_hi(raw[j].x), bf_lo(raw[j].y), bf_hi(raw[j].y)}; }
        else { const f32x4* xr = (const f32x4*)((const float*)X + (size_t)row * DM) + lane;
#pragma unroll
            for (int j = 0; j < 8; ++j) v[j] = xr[64 * j]; }
#pragma unroll
        for (int j = 0; j < 8; ++j) ss += (v[j].x * v[j].x + v[j].y * v[j].y) + (v[j].z * v[j].z + v[j].w * v[j].w);
        const float rstd = 1.0f / sqrtf(wave_sum(ss) * (1.f / DM) + 1e-6f);
        const f32x4* gp = (const f32x4*)g + lane; const f32x4* sc = (const f32x4*)(scale + (size_t)b * 12288) + lane; const f32x4* sh = (const f32x4*)(shift + (size_t)b * 12288) + lane;
        u32x2* op = (u32x2*)(out + (size_t)row * DM) + lane;
        float lg[8] = {0.f, 0.f, 0.f, 0.f, 0.f, 0.f, 0.f, 0.f}; unsigned h8[8];
#pragma unroll
        for (int j = 0; j < 8; ++j) { const f32x4 gg = gp[64 * j], s1 = sc[64 * j], s2 = sh[64 * j];
            f32x4 h = (v[j] * rstd) * gg; h = h * (s1 + 1.0f) + s2;
            if (ROUTER) { h8[j] = pk4_fp8(h.x * HSCALE, h.y * HSCALE, h.z * HSCALE, h.w * HSCALE); }
            else { u32x2 w; w.x = cvt_pk_bf16(h.x, h.y); w.y = cvt_pk_bf16(h.z, h.w); op[64 * j] = w;
                   if (OUT8) ((unsigned*)(HS2 + (size_t)row * DM) + lane)[64 * j] = pk4_fp8(h.x * HSCALE, h.y * HSCALE, h.z * HSCALE, h.w * HSCALE); }
            if (ROUTER) {
#pragma unroll
                for (int i = 0; i < 4; ++i) { const int cc = 256 * j + 4 * lane + i; const f32x4 r0 = ((const f32x4*)router)[cc * 2], r1 = ((const f32x4*)router)[cc * 2 + 1];
                    lg[0] += h[i] * r0.x; lg[1] += h[i] * r0.y; lg[2] += h[i] * r0.z; lg[3] += h[i] * r0.w; lg[4] += h[i] * r1.x; lg[5] += h[i] * r1.y; lg[6] += h[i] * r1.z; lg[7] += h[i] * r1.w; } } }
        if (ROUTER) {
#pragma unroll
            for (int e = 0; e < 8; ++e) lg[e] = wave_sum(lg[e]);
            if (lane == 0) {
                int i0 = 0; float v0 = lg[0];
#pragma unroll
                for (int e = 1; e < 8; ++e) if (lg[e] > v0) { v0 = lg[e]; i0 = e; }
                int i1 = -1; float v1 = -3.0e38f;
#pragma unroll
                for (int e = 0; e < 8; ++e) if (e != i0 && lg[e] > v1) { v1 = lg[e]; i1 = e; }
                const float w1 = 1.f / (1.f + expf(v0 - v1)), w0 = 1.f - w1;
                const int p0 = (int)__hip_atomic_fetch_add(ecnt + 64 * i0, 1u, __ATOMIC_RELAXED, __HIP_MEMORY_SCOPE_AGENT);
                const int p1 = (int)__hip_atomic_fetch_add(ecnt + 64 * i1, 1u, __ATOMIC_RELAXED, __HIP_MEMORY_SCOPE_AGENT);
                tok_e[2 * row] = i0; tok_e[2 * row + 1] = i1; tok_pos[2 * row] = p0; tok_pos[2 * row + 1] = p1; tok_w[2 * row] = w0; tok_w[2 * row + 1] = w1;
                lg[0] = __int_as_float(i0 * pg8::ECAP + p0); lg[1] = __int_as_float(i1 * pg8::ECAP + p1);
            }
            const int ra = __builtin_amdgcn_readfirstlane(__float_as_int(lg[0])), rb = __builtin_amdgcn_readfirstlane(__float_as_int(lg[1]));
            unsigned* da = (unsigned*)(HS2 + (size_t)ra * DM) + lane; unsigned* db = (unsigned*)(HS2 + (size_t)rb * DM) + lane;
#pragma unroll
            for (int j = 0; j < 8; ++j) { da[64 * j] = h8[j]; db[64 * j] = h8[j]; }
        }
    }
}

DI void qknorm_phase(const bf16_t* QK, bf16_t* QKN, const float* qg, const float* kg, int gw, int NGW, int lane) {
    const int l16 = lane & 15;
    for (int idx = gw * 4 + (lane >> 4); idx < MTOK * 32; idx += NGW * 4) {
        const int hr = idx & 31; const size_t off = (size_t)(idx >> 5) * 4096 + hr * 128 + 8 * l16;
        const u32x4 raw = *(const u32x4*)(QK + off);
        float x[8] = {bf_lo(raw.x), bf_hi(raw.x), bf_lo(raw.y), bf_hi(raw.y), bf_lo(raw.z), bf_hi(raw.z), bf_lo(raw.w), bf_hi(raw.w)};
        float ss = 0.f;
#pragma unroll
        for (int i = 0; i < 8; ++i) ss += x[i] * x[i];
        ss += __shfl_xor(ss, 1); ss += __shfl_xor(ss, 2); ss += __shfl_xor(ss, 4); ss += __shfl_xor(ss, 8);
        const float rstd = (1.0f / sqrtf(ss * (1.f / 128.f) + 1e-6f)) * (hr < 16 ? 0.08838834764831845f : 1.0f);
        const float* gp = (hr < 16 ? qg : kg) + 8 * l16;
        const f32x4 g0 = *(const f32x4*)gp, g1 = *(const f32x4*)(gp + 4);
        u32x4 o; o.x = cvt_pk_bf16(x[0] * rstd * g0.x, x[1] * rstd * g0.y); o.y = cvt_pk_bf16(x[2] * rstd * g0.z, x[3] * rstd * g0.w);
        o.z = cvt_pk_bf16(x[4] * rstd * g1.x, x[5] * rstd * g1.y); o.w = cvt_pk_bf16(x[6] * rstd * g1.z, x[7] * rstd * g1.w);
        *(u32x4*)(QKN + off) = o;
    }
}

constexpr int NA_TBL = 0, NA_BUF = 30720, NA_TILE = 18432;
DI void na_phase(const bf16_t* QKN, const bf16_t* VT, bf16_t* ATT, const float* rpb, LAS unsigned char* lds, int G, int vcu0, int tid, int lane, int wave) {
    LAS float* rpbL = (LAS float*)(lds + NA_TBL);
    for (int i = tid; i < 16 * 465; i += NTHREADS) rpbL[i] = rpb[i];
    const int c16 = lane & 15, g = lane >> 4, unit = wave >> 2, j = wave & 3;
    const int cb = (j == 0) ? 0 : (j == 1) ? 8 : (j == 2) ? 24 : 32;
    const int qc = 16 * j + c16, c0 = min(max(qc - 8, 0), 48);
    const int kcl = 8 * (c16 >> 2) + (c16 & 3);
    for (int p = vcu0; p < 1024; p += G) {
        const int rho = p & 15, hh = (p >> 4) & 15, b = p >> 8;
        const int rA = 2 * rho, r0A = min(max(rA - 4, 0), 24), r0B = min(max(rA + 1 - 4, 0), 24), delta = r0B - r0A, nrows = 8 + delta;
        const int r = rA + unit, r0 = unit ? r0B : r0A;
        const bool shiftB = (unit == 1) && (delta == 1);
        const size_t tq = (size_t)b * SEQ + r * 64 + qc;
        bf16x8 qf[4];
#pragma unroll
        for (int ks = 0; ks < 4; ++ks) qf[ks] = *(const bf16x8*)(QKN + tq * 4096 + hh * 128 + 32 * ks + 8 * g);
        f32x4 S[8][2];
        u32x4 st0, st1;
        const int kkey = tid >> 3, kch = tid & 7;
        const int vd = tid >> 2, vch = tid & 3;
        const bf16_t* kg = QKN + ((size_t)b * SEQ + (size_t)r0A * 64 + kkey) * 4096 + 2048 + hh * 128 + kch * 8;
        const bf16_t* vg = VT + (size_t)(hh * 128 + vd) * MTOK + (size_t)b * SEQ + (size_t)r0A * 64 + vch * 8;
#define NA_LDK(s_) do { st0 = *(const u32x4*)(kg + (size_t)(s_) * 64 * 4096); st1 = *(const u32x4*)(kg + (size_t)(s_) * 64 * 4096 + 64); } while (0)
#define NA_STK(s_) do { LAS unsigned char* t_ = lds + NA_BUF + ((s_) & 1) * NA_TILE + kkey * 272 + kch * 16; *(LAS u32x4*)t_ = st0; *(LAS u32x4*)(t_ + 128) = st1; } while (0)
#define NA_LDV(s_) do { st0 = *(const u32x4*)(vg + (s_) * 64); st1 = *(const u32x4*)(vg + (s_) * 64 + 32); } while (0)
#define NA_STV(s_) do { LAS unsigned char* t_ = lds + NA_BUF + ((s_) & 1) * NA_TILE + vd * 144 + vch * 16; *(LAS u32x4*)t_ = st0; *(LAS u32x4*)(t_ + 64) = st1; } while (0)
#define NA_QK(s_, i_) do { const LAS unsigned char* kb_ = lds + NA_BUF + ((s_) & 1) * NA_TILE + (cb + kcl) * 272 + 16 * g; \
            _Pragma("unroll") for (int hc = 0; hc < 2; ++hc) { f32x4 a = (f32x4){0.f, 0.f, 0.f, 0.f}; \
                _Pragma("unroll") for (int ks = 0; ks < 4; ++ks) a = __builtin_amdgcn_mfma_f32_16x16x32_bf16(*(const LAS bf16x8*)(kb_ + hc * 4 * 272 + 64 * ks), qf[ks], a, 0, 0, 0); S[i_][hc] = a; } } while (0)
#define NA_SROW(s_) do { if ((s_) < nrows) { NA_STK(s_); __syncthreads(); if ((s_) + 1 < nrows) NA_LDK((s_) + 1); \
            if (!shiftB) { if ((s_) < 8) NA_QK(s_, (s_) < 8 ? (s_) : 7); } else { if ((s_) >= 1) NA_QK(s_, (s_) >= 1 ? (s_) - 1 : 0); } } } while (0)
        __syncthreads();
        NA_LDK(0);
        NA_SROW(0); NA_SROW(1); NA_SROW(2); NA_SROW(3); NA_SROW(4); NA_SROW(5); NA_SROW(6); NA_SROW(7); NA_SROW(8);
        NA_LDV(0);
        float mx = -3.0e38f;
        const LAS float* bt = rpbL + hh * 465;
#pragma unroll
        for (int i = 0; i < 8; ++i)
#pragma unroll
            for (int hc = 0; hc < 2; ++hc)
#pragma unroll
                for (int e = 0; e < 4; ++e) {
                    const int kc = cb + 8 * g + 4 * hc + e; const bool valid = (kc >= c0) && (kc < c0 + 16);
                    const int dj = min(max(kc - qc + 15, 0), 30), di = r0 + i - r + 7;
                    const float sv = valid ? S[i][hc][e] + bt[di * 31 + dj] : -3.0e38f;
                    S[i][hc][e] = sv; mx = fmaxf(mx, sv);
                }
        mx = fmaxf(mx, __shfl_xor(mx, 16)); mx = fmaxf(mx, __shfl_xor(mx, 32));
        float sum = 0.f;
#pragma unroll
        for (int i = 0; i < 8; ++i)
#pragma unroll
            for (int hc = 0; hc < 2; ++hc)
#pragma unroll
                for (int e = 0; e < 4; ++e) { const float pv = (S[i][hc][e] > -1.0e38f) ? __expf(S[i][hc][e] - mx) : 0.f; S[i][hc][e] = pv; sum += pv; }
        sum += __shfl_xor(sum, 16); sum += __shfl_xor(sum, 32);
        const float inv = 1.0f / sum;
        f32x4 O[8];
#pragma unroll
        for (int dt = 0; dt < 8; ++dt) O[dt] = (f32x4){0.f, 0.f, 0.f, 0.f};
#define NA_PV(s_, i_) do { u32x4 pw; pw.x = cvt_pk_bf16(S[i_][0][0], S[i_][0][1]); pw.y = cvt_pk_bf16(S[i_][0][2], S[i_][0][3]); pw.z = cvt_pk_bf16(S[i_][1][0], S[i_][1][1]); pw.w = cvt_pk_bf16(S[i_][1][2], S[i_][1][3]); \
            const bf16x8 pf = __builtin_bit_cast(bf16x8, pw); const LAS unsigned char* vb_ = lds + NA_BUF + ((s_) & 1) * NA_TILE + c16 * 144 + (cb + 8 * g) * 2; \
            _Pragma("unroll") for (int dt = 0; dt < 8; ++dt) O[dt] = __builtin_amdgcn_mfma_f32_16x16x32_bf16(*(const LAS bf16x8*)(vb_ + dt * 16 * 144), pf, O[dt], 0, 0, 0); } while (0)
#define NA_VROW(s_) do { if ((s_) < nrows) { NA_STV(s_); __syncthreads(); if ((s_) + 1 < nrows) NA_LDV((s_) + 1); \
            if (!shiftB) { if ((s_) < 8) NA_PV(s_, (s_) < 8 ? (s_) : 7); } else { if ((s_) >= 1) NA_PV(s_, (s_) >= 1 ? (s_) - 1 : 0); } } } while (0)
        __syncthreads();
        NA_VROW(0); NA_VROW(1); NA_VROW(2); NA_VROW(3); NA_VROW(4); NA_VROW(5); NA_VROW(6); NA_VROW(7); NA_VROW(8);
#undef NA_LDK
#undef NA_STK
#undef NA_LDV
#undef NA_STV
#undef NA_QK
#undef NA_SROW
#undef NA_PV
#undef NA_VROW
#pragma unroll
        for (int dt = 0; dt < 8; ++dt) { u32x2 w; w.x = cvt_pk_bf16(O[dt][0] * inv, O[dt][1] * inv); w.y = cvt_pk_bf16(O[dt][2] * inv, O[dt][3] * inv);
            *(u32x2*)(ATT + tq * DM + hh * 128 + 16 * dt + 4 * g) = w; }
    }
}

constexpr int MLP_WIF = 36864, MLP_WROW = 3088;
DI void ml_pre_phase(const bf16_t* XZ, const float* conv_w, const float* conv_b, const float* wq, const float* wk, const float* wv, const bf16_t* WTif,
                     bf16_t* XC, bf16_t* Q, bf16_t* Kb, bf16_t* V, float* pre_part, LAS unsigned char* lds, int G, int tid, int lane, int wave) {
    LAS float* Lcw = (LAS float*)lds;
    LAS float* Lcb = Lcw + 2560;
    LAS float* Lwq = Lcb + 512;
    LAS float* Lwk = Lwq + 2048;
    LAS float* Lwv = Lwk + 2048;
    LAS unsigned char* Lwif = lds + MLP_WIF;
    const int g = lane >> 4, tk = lane & 15;
    for (int item = blockIdx.x; item < 256; item += G) {
        const int hd = item & 7, tr = item >> 3;
        __syncthreads();
        for (int i = tid; i < 2560; i += NTHREADS) Lcw[i] = conv_w[(i >> 9) * 4096 + hd * 512 + (i & 511)];
        Lcb[tid] = conv_b[hd * 512 + tid];
        for (int i = tid; i < 2048; i += NTHREADS) { Lwq[i] = wq[hd * 2048 + i]; Lwk[i] = wk[hd * 2048 + i]; Lwv[i] = wv[hd * 2048 + i]; }
        for (int i = tid; i < 32 * 3 * 64; i += NTHREADS) { const int n = i / 192, rem = i - n * 192, sec = rem >> 6, c16 = rem & 63;
            *(LAS u32x4*)(Lwif + n * MLP_WROW + sec * 1024 + c16 * 16) = *(const u32x4*)(WTif + (size_t)n * 12288 + sec * 4096 + hd * 512 + c16 * 8); }
        __syncthreads();
        for (int tt = wave; tt < 16; tt += 8) {
            const int tok = tr * 256 + tt * 16 + tk, tseq = tok & 2047;
            f32x4 accp[2]; accp[0] = (f32x4){0.f, 0.f, 0.f, 0.f}; accp[1] = (f32x4){0.f, 0.f, 0.f, 0.f};
            u32x4 xrA[5], xrB[5], hq, hk, hv, hc;
#define MLP_LOAD(xr_, step_) do { const int ch_ = hd * 512 + (step_) * 32 + 8 * g; \
                _Pragma("unroll") for (int jt = 0; jt < 5; ++jt) { const int dt = jt - 2; const bool ok = (unsigned)(tseq + dt) < (unsigned)SEQ; \
                    xr_[jt] = (u32x4){0u, 0u, 0u, 0u}; if (ok) xr_[jt] = *(const u32x4*)(XZ + (size_t)(tok + dt) * 8192 + ch_); } } while (0)
#define MLP_COMPUTE(xr_, step_, HOLD_) do { \
                const int cl = (step_) * 32 + 8 * g, ch = hd * 512 + cl; \
                float a[8], xm[8]; \
                { const f32x4 b0 = *(const LAS f32x4*)(Lcb + cl), b1 = *(const LAS f32x4*)(Lcb + cl + 4); \
                  a[0] = b0.x; a[1] = b0.y; a[2] = b0.z; a[3] = b0.w; a[4] = b1.x; a[5] = b1.y; a[6] = b1.z; a[7] = b1.w; } \
                _Pragma("unroll") for (int jt = 0; jt < 5; ++jt) { \
                    const u32x4 xr = xr_[jt]; \
                    const float xv[8] = {bf_lo(xr.x), bf_hi(xr.x), bf_lo(xr.y), bf_hi(xr.y), bf_lo(xr.z), bf_hi(xr.z), bf_lo(xr.w), bf_hi(xr.w)}; \
                    const f32x4 w0 = *(const LAS f32x4*)(Lcw + jt * 512 + cl), w1 = *(const LAS f32x4*)(Lcw + jt * 512 + cl + 4); \
                    a[0] += xv[0] * w0.x; a[1] += xv[1] * w0.y; a[2] += xv[2] * w0.z; a[3] += xv[3] * w0.w; a[4] += xv[4] * w1.x; a[5] += xv[5] * w1.y; a[6] += xv[6] * w1.z; a[7] += xv[7] * w1.w; \
                    if (jt == 2) { _Pragma("unroll") for (int i = 0; i < 8; ++i) xm[i] = xv[i]; } } \
                float xc[8], q[8], k[8], v[8]; \
                _Pragma("unroll") for (int i = 0; i < 8; ++i) xc[i] = silu_f(a[i]); \
                _Pragma("unroll") for (int blk = 0; blk < 2; ++blk) { const int wo = ((cl >> 2) + blk) * 16; \
                    _Pragma("unroll") for (int o = 0; o < 4; ++o) { float sq = 0.f, sk = 0.f, sv = 0.f; \
                        _Pragma("unroll") for (int i = 0; i < 4; ++i) { sq += xc[4 * blk + i] * Lwq[wo + i * 4 + o]; sk += xc[4 * blk + i] * Lwk[wo + i * 4 + o]; sv += xm[4 * blk + i] * Lwv[wo + i * 4 + o]; } \
                        q[4 * blk + o] = sq; k[4 * blk + o] = sk; v[4 * blk + o] = sv; } } \
                u32x4 qw, kw, vw, cw; \
                qw.x = cvt_pk_bf16(q[0], q[1]); qw.y = cvt_pk_bf16(q[2], q[3]); qw.z = cvt_pk_bf16(q[4], q[5]); qw.w = cvt_pk_bf16(q[6], q[7]); \
                kw.x = cvt_pk_bf16(k[0], k[1]); kw.y = cvt_pk_bf16(k[2], k[3]); kw.z = cvt_pk_bf16(k[4], k[5]); kw.w = cvt_pk_bf16(k[6], k[7]); \
                vw.x = cvt_pk_bf16(v[0], v[1]); vw.y = cvt_pk_bf16(v[2], v[3]); vw.z = cvt_pk_bf16(v[4], v[5]); vw.w = cvt_pk_bf16(v[6], v[7]); \
                cw.x = cvt_pk_bf16(xc[0], xc[1]); cw.y = cvt_pk_bf16(xc[2], xc[3]); cw.z = cvt_pk_bf16(xc[4], xc[5]); cw.w = cvt_pk_bf16(xc[6], xc[7]); \
                const size_t o4 = (size_t)tok * 4096 + ch; \
                if (HOLD_) { hq = qw; hk = kw; hv = vw; hc = cw; }     \
                else { *(u32x4*)(Q + o4 - 32) = hq; *(u32x4*)(Q + o4) = qw; *(u32x4*)(Kb + o4 - 32) = hk; *(u32x4*)(Kb + o4) = kw; *(u32x4*)(V + o4 - 32) = hv; *(u32x4*)(V + o4) = vw; *(u32x4*)(XC + o4 - 32) = hc; *(u32x4*)(XC + o4) = cw; } \
                const bf16x8 qf = __builtin_bit_cast(bf16x8, qw), kf = __builtin_bit_cast(bf16x8, kw), vf = __builtin_bit_cast(bf16x8, vw); \
                _Pragma("unroll") for (int nt = 0; nt < 2; ++nt) { const LAS unsigned char* wp = Lwif + (nt * 16 + tk) * MLP_WROW + cl * 2; \
                    accp[nt] = __builtin_amdgcn_mfma_f32_16x16x32_bf16(qf, *(const LAS bf16x8*)(wp), accp[nt], 0, 0, 0); \
                    accp[nt] = __builtin_amdgcn_mfma_f32_16x16x32_bf16(kf, *(const LAS bf16x8*)(wp + 1024), accp[nt], 0, 0, 0); \
                    accp[nt] = __builtin_amdgcn_mfma_f32_16x16x32_bf16(vf, *(const LAS bf16x8*)(wp + 2048), accp[nt], 0, 0, 0); } } while (0)
            MLP_LOAD(xrA, 0);
#pragma unroll 1
            for (int step = 0; step < 16; step += 2) {
                MLP_LOAD(xrB, step + 1);
                MLP_COMPUTE(xrA, step, true);
                { const int sn = (step + 2 < 16) ? step + 2 : 15; MLP_LOAD(xrA, sn); }
                MLP_COMPUTE(xrB, step + 1, false);
            }
#undef MLP_LOAD
#undef MLP_COMPUTE
#pragma unroll
            for (int nt = 0; nt < 2; ++nt)
#pragma unroll
                for (int e = 0; e < 4; ++e) pre_part[((size_t)hd * 32 + nt * 16 + tk) * MTOK + tr * 256 + tt * 16 + 4 * g + e] = accp[nt][e];
        }
    }
}

constexpr int ML_QS0 = 0, ML_KS0 = 16384, ML_QS1 = 32768, ML_KS1 = 49152, ML_VS0 = 65536, ML_VS1 = 81920, ML_WV = 98304, ML_SS = 114688, ML_SM = 123904;
constexpr int ML_XS = ML_QS1, ML_XN = ML_QS1;
constexpr int GB_U = 0, GB_MR = 64, GB_W = 128, GB_INT = 192, GB_BND = 256, GB_SC = 320;
constexpr int SM_DIN0 = 768, SM_DIN1 = 832, SM_NV = 896, SM_NVP = 1408, SM_DNQP = 3456, SM_GS = 3968, SM_CMX = 4000, SM_MC = 4032, SM_END = 4096;
static_assert(ML_SM + SM_END * 4 <= LDS_BYTES - 16, "mLSTM LDS");
constexpr float KSCALE = 0.04419417382415922f;

DI s16x4 tr_read(LAS unsigned char* p) { return __builtin_amdgcn_ds_read_tr16_b64_v4i16((LAS s16x4*)p); }
DI int dimg(int row, int ch) { return 2048 * (row >> 3) + 512 * (ch >> 2) + 64 * (row & 7) + 16 * ((ch & 3) ^ ((row >> 2) & 3)); }
DI bf16x8 frag_tr(LAS unsigned char* img, int k0, int c0, int lane) {
    const int h = lane >> 5, blk = (lane >> 4) & 1, q = (lane & 15) >> 2, p = lane & 3;
    const int row = k0 + 8 * h + q, ch = (c0 >> 3) + 2 * blk + (p >> 1), sub = 8 * (p & 1);
    const s16x4 lo = tr_read(img + dimg(row, ch) + sub), hi = tr_read(img + dimg(row + 4, ch) + sub);
    return __builtin_shufflevector(lo, hi, 0, 1, 2, 3, 4, 5, 6, 7);
}
#define MFMA32(a, b, c) __builtin_amdgcn_mfma_f32_32x32x16_bf16((a), (b), (c), 0, 0, 0)
DI void tr_batch4(bf16x8 (&f)[4], unsigned alo, unsigned ahi) {
    s16x4 l0, l1, l2, l3, h0, h1, h2, h3;
    asm volatile("ds_read_b64_tr_b16 %0, %8\n\tds_read_b64_tr_b16 %4, %9\n\tds_read_b64_tr_b16 %1, %8 offset:4096\n\tds_read_b64_tr_b16 %5, %9 offset:4096\n\t"
                 "ds_read_b64_tr_b16 %2, %8 offset:8192\n\tds_read_b64_tr_b16 %6, %9 offset:8192\n\tds_read_b64_tr_b16 %3, %8 offset:12288\n\tds_read_b64_tr_b16 %7, %9 offset:12288\n\t"
                 "s_waitcnt lgkmcnt(0)"
                 : "=&v"(l0), "=&v"(l1), "=&v"(l2), "=&v"(l3), "=&v"(h0), "=&v"(h1), "=&v"(h2), "=&v"(h3) : "v"(alo), "v"(ahi) : "memory");
    f[0] = __builtin_shufflevector(l0, h0, 0, 1, 2, 3, 4, 5, 6, 7); f[1] = __builtin_shufflevector(l1, h1, 0, 1, 2, 3, 4, 5, 6, 7);
    f[2] = __builtin_shufflevector(l2, h2, 0, 1, 2, 3, 4, 5, 6, 7); f[3] = __builtin_shufflevector(l3, h3, 0, 1, 2, 3, 4, 5, 6, 7);
}

DI void tr_issue4(s16x4& l0, s16x4& l1, s16x4& l2, s16x4& l3, s16x4& h0, s16x4& h1, s16x4& h2, s16x4& h3, unsigned alo, unsigned ahi) {
    asm volatile("ds_read_b64_tr_b16 %0, %8\n\tds_read_b64_tr_b16 %4, %9\n\tds_read_b64_tr_b16 %1, %8 offset:4096\n\tds_read_b64_tr_b16 %5, %9 offset:4096\n\t"
                 "ds_read_b64_tr_b16 %2, %8 offset:8192\n\tds_read_b64_tr_b16 %6, %9 offset:8192\n\tds_read_b64_tr_b16 %3, %8 offset:12288\n\tds_read_b64_tr_b16 %7, %9 offset:12288"
                 : "=&v"(l0), "=&v"(l1), "=&v"(l2), "=&v"(l3), "=&v"(h0), "=&v"(h1), "=&v"(h2), "=&v"(h3) : "v"(alo), "v"(ahi) : "memory");
}
DI void tr_wait8(s16x4& l0, s16x4& l1, s16x4& l2, s16x4& l3, s16x4& h0, s16x4& h1, s16x4& h2, s16x4& h3) {
    asm volatile("s_waitcnt lgkmcnt(0)" : "+v"(l0), "+v"(l1), "+v"(l2), "+v"(l3), "+v"(h0), "+v"(h1), "+v"(h2), "+v"(h3) :: "memory");
}
#define TR_CAT(f, l, h) do { f[0] = __builtin_shufflevector(l##0, h##0, 0, 1, 2, 3, 4, 5, 6, 7); f[1] = __builtin_shufflevector(l##1, h##1, 0, 1, 2, 3, 4, 5, 6, 7); \
        f[2] = __builtin_shufflevector(l##2, h##2, 0, 1, 2, 3, 4, 5, 6, 7); f[3] = __builtin_shufflevector(l##3, h##3, 0, 1, 2, 3, 4, 5, 6, 7); } while (0)

template <int I>
DI void ml_step(LAS unsigned char* lds, u32x4 (&Cp)[8][2], f32x16 (&num)[2], f32x16& Sacc, float& dnq, int tid, int lane, int wave, int gb) {
    asm volatile("" : "+v"(lane)); asm volatile("" : "+v"(tid));
    constexpr int QS = (I & 1) ? ML_QS1 : ML_QS0, KS = (I & 1) ? ML_KS1 : ML_KS0;
    const int r = lane & 31, h = lane >> 5, vt = wave & 3, dpar = wave >> 2;
    LAS float* SM = (LAS float*)(lds + ML_SM);
#define ML_SEC1 { const int wS = wave & 3, st = wS >> 1, tt1 = wS & 1, kh = wave >> 2; \
      if (!(st == 1 && tt1 == 0)) { \
        _Pragma("unroll") for (int ks = 0; ks < 4; ++ks) { const int kk = 4 * kh + ks; \
            const bf16x8 a = *(const LAS bf16x8*)(lds + KS + dimg(32 * st + r, 2 * kk + h)); \
            const bf16x8 b = *(const LAS bf16x8*)(lds + QS + dimg(32 * tt1 + r, 2 * kk + h)); \
            Sacc = MFMA32(a, b, Sacc); } } }
#define ML_SEC4 { _Pragma("unroll") for (int jj = 0; jj < 2; ++jj) { const int dl = dpar + 2 * jj; \
        _Pragma("unroll") for (int s2 = 0; s2 < 2; ++s2) { const bf16x8 a = __builtin_bit_cast(bf16x8, Cp[2 * I + jj][s2]); \
            _Pragma("unroll") for (int tt = 0; tt < 2; ++tt) { LAS unsigned char* qb = lds + QS + 8 * h; \
                const s16x4 lo = *(const LAS s16x4*)(qb + dimg(32 * tt + r, 4 * dl + 2 * s2)), hi = *(const LAS s16x4*)(qb + dimg(32 * tt + r, 4 * dl + 2 * s2 + 1)); \
                num[tt] = MFMA32(a, __builtin_shufflevector(lo, hi, 0, 1, 2, 3, 4, 5, 6, 7), num[tt]); } } } }
#define ML_UPD(jj_) { _Pragma("unroll") for (int s2 = 0; s2 < 2; ++s2) { const u32x4 o = Cp[2 * I + (jj_)][s2]; u32x4 n; \
            n.x = cvt_pk_bf16(bf_lo(o.x) * decay + U[8 * s2 + 0], bf_hi(o.x) * decay + U[8 * s2 + 1]); n.y = cvt_pk_bf16(bf_lo(o.y) * decay + U[8 * s2 + 2], bf_hi(o.y) * decay + U[8 * s2 + 3]); \
            n.z = cvt_pk_bf16(bf_lo(o.z) * decay + U[8 * s2 + 4], bf_hi(o.z) * decay + U[8 * s2 + 5]); n.w = cvt_pk_bf16(bf_lo(o.w) * decay + U[8 * s2 + 6], bf_hi(o.w) * decay + U[8 * s2 + 7]); \
            asm volatile("" : "+v"(n)); Cp[2 * I + (jj_)][s2] = n; } }
#define ML_SEC5 { const float decay = SM[gb + GB_SC + 0]; \
      const int blk = (lane >> 4) & 1, q = (lane & 15) >> 2, p = lane & 3, sub = 8 * (p & 1), rlo = 8 * h + q; \
      const unsigned ldsu = (unsigned)(size_t)lds; const int chB = 4 * vt + 2 * blk + (p >> 1), chA0 = 4 * dpar + 2 * blk + (p >> 1), chA1 = chA0 + 8; \
      s16x4 bl0, bl1, bl2, bl3, bh0, bh1, bh2, bh3, al0, al1, al2, al3, ah0, ah1, ah2, ah3, cl0, cl1, cl2, cl3, ch0, ch1, ch2, ch3; \
      tr_issue4(bl0, bl1, bl2, bl3, bh0, bh1, bh2, bh3, ldsu + ML_WV + dimg(rlo, chB) + sub, ldsu + ML_WV + dimg(rlo + 4, chB) + sub); \
      tr_issue4(al0, al1, al2, al3, ah0, ah1, ah2, ah3, ldsu + KS + dimg(rlo, chA0) + sub, ldsu + KS + dimg(rlo + 4, chA0) + sub); \
      tr_wait8(al0, al1, al2, al3, ah0, ah1, ah2, ah3); tr_wait8(bl0, bl1, bl2, bl3, bh0, bh1, bh2, bh3); \
      tr_issue4(cl0, cl1, cl2, cl3, ch0, ch1, ch2, ch3, ldsu + KS + dimg(rlo, chA1) + sub, ldsu + KS + dimg(rlo + 4, chA1) + sub); \
      bf16x8 Bf[4], Af[4]; TR_CAT(Bf, bl, bh); TR_CAT(Af, al, ah); \
      f32x16 U; \
      _Pragma("unroll") for (int e = 0; e < 16; ++e) U[e] = 0.f; \
      _Pragma("unroll") for (int ks = 0; ks < 4; ++ks) U = MFMA32(Af[ks], Bf[ks], U); \
      ML_UPD(0) \
      tr_wait8(cl0, cl1, cl2, cl3, ch0, ch1, ch2, ch3); TR_CAT(Af, cl, ch); \
      _Pragma("unroll") for (int e = 0; e < 16; ++e) U[e] = 0.f; \
      _Pragma("unroll") for (int ks = 0; ks < 4; ++ks) U = MFMA32(Af[ks], Bf[ks], U); \
      ML_UPD(1) }
#define ML_SECV { { const int t = tid & 63, dg = tid >> 6; \
      const u32x4 q0 = *(const LAS u32x4*)(lds + QS + dimg(t, 2 * dg)), q1 = *(const LAS u32x4*)(lds + QS + dimg(t, 2 * dg + 1)); \
      const LAS f32x4* nv = (const LAS f32x4*)(SM + SM_NV + 128 * I + 16 * dg); \
      const f32x4 n0 = nv[0], n1 = nv[1], n2 = nv[2], n3 = nv[3]; \
      dnq += bf_lo(q0.x) * n0.x + bf_hi(q0.x) * n0.y + bf_lo(q0.y) * n0.z + bf_hi(q0.y) * n0.w + bf_lo(q0.z) * n1.x + bf_hi(q0.z) * n1.y + bf_lo(q0.w) * n1.z + bf_hi(q0.w) * n1.w \
           + bf_lo(q1.x) * n2.x + bf_hi(q1.x) * n2.y + bf_lo(q1.y) * n2.z + bf_hi(q1.y) * n2.w + bf_lo(q1.z) * n3.x + bf_hi(q1.z) * n3.y + bf_lo(q1.w) * n3.z + bf_hi(q1.w) * n3.w; } \
    { const int dp = tid & 63, sg = tid >> 6; float a0 = 0.f, a1 = 0.f; \
      const f32x4 wA = *(const LAS f32x4*)(SM + gb + GB_W + 8 * sg), wB = *(const LAS f32x4*)(SM + gb + GB_W + 8 * sg + 4); const float ww[8] = {wA.x, wA.y, wA.z, wA.w, wB.x, wB.y, wB.z, wB.w}; \
      _Pragma("unroll") for (int s = 0; s < 8; ++s) { const unsigned kk2 = *(const LAS unsigned*)(lds + KS + dimg(8 * sg + s, dp >> 2) + 4 * (dp & 3)); a0 += ww[s] * bf_lo(kk2); a1 += ww[s] * bf_hi(kk2); } \
      ((LAS unsigned*)(SM + SM_NVP))[sg * 256 + 64 * I + dp] = cvt_pk_bf16(a0, a1); } }
    ML_SEC1 ML_SEC4 ML_SEC5 ML_SECV
#undef ML_SEC1
#undef ML_SEC4
#undef ML_UPD
#undef ML_SEC5
#undef ML_SECV
}

DI float lane_read(float v, int src_lane) { return __builtin_bit_cast(float, __builtin_amdgcn_ds_bpermute(src_lane << 2, __builtin_bit_cast(int, v))); }
DI void ml_scan(float li_, float lf_, float& u_, float& cm_, float& bs_, int lane) {
    bs_ = lf_;
#pragma unroll
    for (int o_ = 1; o_ < 64; o_ <<= 1) { const float t_ = lane_read(bs_, (lane - o_) & 63); if (lane >= o_) bs_ += t_; }
    u_ = li_ - bs_; cm_ = u_;
#pragma unroll
    for (int o_ = 1; o_ < 64; o_ <<= 1) { const float t_ = lane_read(cm_, (lane - o_) & 63); if (lane >= o_) cm_ = fmaxf(cm_, t_); }
}
DI void ml_gates(LAS float* SM, float u_, float cm_, float bs_, int gbn, float m_, float cmx_, int lane) {
    const float M_ = fmaxf(m_, cm_), Ml_ = fmaxf(m_, cmx_);
    SM[gbn + GB_U + lane] = u_; SM[gbn + GB_MR + lane] = M_; SM[gbn + GB_W + lane] = __expf(u_ - Ml_) * KSCALE; SM[gbn + GB_INT + lane] = __expf(m_ - M_); SM[gbn + GB_BND + lane] = __expf(-(bs_ + M_));
    if (lane == 0) SM[gbn + GB_SC + 0] = __expf(m_ - Ml_);
}

DI void ml_dma_piece(const bf16_t* colbase, int b, int dir, int tau0, LAS unsigned char* tile, int j, int lane) {
    const int pos = lane & 31, rin = pos >> 2, row = 8 * (j >> 1) + rin, ch = 4 * (2 * (j & 1) + (lane >> 5)) + ((pos & 3) ^ ((row >> 2) & 3));
    const int tau = tau0 + row; const size_t tok = (size_t)(b * SEQ + (dir ? SEQ - 1 - tau : tau));
    __builtin_amdgcn_global_load_lds((const unsigned*)(colbase + tok * 4096 + ch * 8), (LAS unsigned*)(tile + 1024 * j), 16, 0, 0);
}

DI void mlstm_phase(const bf16_t* Q, const bf16_t* Kb, const bf16_t* V, const float* pre_part, const float* b_if, float* GLF, bf16_t* HF, bf16_t* HB,
                    LAS unsigned char* lds, int G, int vcu0, int tid0, int lane0, int wave) {
    LAS float* SM = (LAS float*)(lds + ML_SM);
    const int vt = wave & 3, dpar = wave >> 2;
    for (int item = vcu0; item < 256; item += G) {
        const int vs = item & 3, stream = item >> 2, dir = stream & 1, hd = (stream >> 1) & 7, b = stream >> 4;
        bf16_t* H = dir ? HB : HF;
        float* glf = GLF + (size_t)item * 10240;
        const bf16_t* qcol = Q + hd * 512; const bf16_t* kcol = Kb + hd * 512; const bf16_t* vcol = V + hd * 512 + vs * 128;
        __syncthreads();
        int tidp = tid0, lanep = lane0; asm volatile("" : "+v"(tidp)); asm volatile("" : "+v"(lanep));
        for (int tau = tidp; tau < SEQ; tau += NTHREADS) {
            const int tok = b * SEQ + (dir ? SEQ - 1 - tau : tau);
            float li = b_if[dir * 16 + hd], lfr = b_if[dir * 16 + 8 + hd];
#pragma unroll
            for (int h8 = 0; h8 < 8; ++h8) { const float* pp = pre_part + ((size_t)h8 * 32 + dir * 16 + hd) * MTOK + tok; li += pp[0]; lfr += pp[(size_t)8 * MTOK]; }
            glf[tau] = li; glf[2048 + tau] = fminf(lfr, 0.f) - log1pf(__expf(-fabsf(lfr)));
        }
        SM[SM_NV + tidp] = 0.f;
        ml_dma_piece(qcol, b, dir, 0, lds + ML_QS0, 2 * wave, lanep); ml_dma_piece(qcol, b, dir, 0, lds + ML_QS0, 2 * wave + 1, lanep);
        ml_dma_piece(kcol, b, dir, 0, lds + ML_KS0, 2 * wave, lanep); ml_dma_piece(kcol, b, dir, 0, lds + ML_KS0, 2 * wave + 1, lanep);
        ml_dma_piece(vcol, b, dir, 0, lds + ML_VS0, 2 * wave, lanep); ml_dma_piece(vcol, b, dir, 0, lds + ML_VS0, 2 * wave + 1, lanep);
        asm volatile("s_waitcnt vmcnt(0)" ::: "memory");
        __syncthreads();
        float u0 = 0.f, cm0 = 0.f, bs0 = 0.f;
#pragma unroll 1
        for (int cc = wave; cc < 32; cc += 8) {
            const float lic = __hip_atomic_load(glf + 64 * cc + lanep, __ATOMIC_RELAXED, __HIP_MEMORY_SCOPE_AGENT), lfc = __hip_atomic_load(glf + 2048 + 64 * cc + lanep, __ATOMIC_RELAXED, __HIP_MEMORY_SCOPE_AGENT);
            float uu, cmm, bss; ml_scan(lic, lfc, uu, cmm, bss, lanep);
            glf[4096 + 64 * cc + lanep] = uu; glf[6144 + 64 * cc + lanep] = cmm; glf[8192 + 64 * cc + lanep] = bss;
            if (lanep == 63) { SM[SM_GS + cc] = bss; SM[SM_CMX + cc] = cmm; }
            if (cc == 0) { u0 = uu; cm0 = cmm; bs0 = bss; }
        }
        asm volatile("s_waitcnt vmcnt(0)" ::: "memory");
        __syncthreads();
        if (tidp == 0) { float m = 0.f;
#pragma unroll 1
            for (int cc = 0; cc < 32; ++cc) { SM[SM_MC + cc] = m; m = SM[SM_GS + cc] + fmaxf(m, SM[SM_CMX + cc]); } }
        __syncthreads();
        if (wave == 0) ml_gates(SM, u0, cm0, bs0, 0, 0.f, SM[SM_CMX + 0], lanep);
        __syncthreads();
#define ML_WRITE_WV(VS_, gbx_) do { const float w_ = SM[(gbx_) + GB_W + lrow]; \
        _Pragma("unroll") for (int hh_ = 0; hh_ < 2; ++hh_) { const int o_ = dimg(lrow, lcc + 8 * hh_); const u32x4 x_ = *(const LAS u32x4*)(lds + (VS_) + o_); u32x4 y_; \
            y_.x = cvt_pk_bf16(bf_lo(x_.x) * w_, bf_hi(x_.x) * w_); y_.y = cvt_pk_bf16(bf_lo(x_.y) * w_, bf_hi(x_.y) * w_); y_.z = cvt_pk_bf16(bf_lo(x_.z) * w_, bf_hi(x_.z) * w_); y_.w = cvt_pk_bf16(bf_lo(x_.w) * w_, bf_hi(x_.w) * w_); \
            *(LAS u32x4*)(lds + ML_WV + o_) = y_; } } while (0)
        { const int lrow = tidp >> 3, lcc = tidp & 7; ML_WRITE_WV(ML_VS0, 0); }
        u32x4 Cp[8][2];
#pragma unroll
        for (int j = 0; j < 8; ++j) { Cp[j][0] = (u32x4){0u, 0u, 0u, 0u}; Cp[j][1] = (u32x4){0u, 0u, 0u, 0u}; }
#pragma unroll 1
        for (int c = 0; c < 32; ++c) {
            int lane = lane0, tid = tid0; asm volatile("" : "+v"(lane)); asm volatile("" : "+v"(tid));
            const int r = lane & 31, h = lane >> 5, lrow = tid >> 3, lcc = tid & 7;
            const int gb = (c & 1) * 384, gbn = 384 - gb, cn = (c + 1 < 32) ? c + 1 : 31;
            const int VSc = (c & 1) ? ML_VS1 : ML_VS0, VSn = (c & 1) ? ML_VS0 : ML_VS1;
            f32x16 num[2], Sacc; float dnq = 0.f;
#pragma unroll
            for (int e = 0; e < 16; ++e) { num[0][e] = 0.f; num[1][e] = 0.f; Sacc[e] = 0.f; }
#define ML_DMA_QK(QS_, KS_, c_, i_) do { ml_dma_piece(qcol + 128 * (i_), b, dir, 64 * (c_), lds + (QS_), 2 * wave, lane); ml_dma_piece(qcol + 128 * (i_), b, dir, 64 * (c_), lds + (QS_), 2 * wave + 1, lane); \
                ml_dma_piece(kcol + 128 * (i_), b, dir, 64 * (c_), lds + (KS_), 2 * wave, lane); ml_dma_piece(kcol + 128 * (i_), b, dir, 64 * (c_), lds + (KS_), 2 * wave + 1, lane); } while (0)
            asm volatile("s_waitcnt vmcnt(0)" ::: "memory"); __syncthreads(); ML_DMA_QK(ML_QS1, ML_KS1, c, 1);  ml_step<0>(lds, Cp, num, Sacc, dnq, tid, lane, wave, gb);
            asm volatile("s_waitcnt vmcnt(0)" ::: "memory"); __syncthreads(); ML_DMA_QK(ML_QS0, ML_KS0, c, 2);  ml_step<1>(lds, Cp, num, Sacc, dnq, tid, lane, wave, gb);
            asm volatile("s_waitcnt vmcnt(0)" ::: "memory"); __syncthreads(); ML_DMA_QK(ML_QS1, ML_KS1, c, 3);  ml_step<2>(lds, Cp, num, Sacc, dnq, tid, lane, wave, gb);
            asm volatile("s_waitcnt vmcnt(0)" ::: "memory"); __syncthreads(); ML_DMA_QK(ML_QS0, ML_KS0, cn, 0);
            ml_dma_piece(vcol, b, dir, 64 * cn, lds + VSn, 2 * wave, lane); ml_dma_piece(vcol, b, dir, 64 * cn, lds + VSn, 2 * wave + 1, lane);
            ml_step<3>(lds, Cp, num, Sacc, dnq, tid, lane, wave, gb);
            asm volatile("s_waitcnt vmcnt(0)" ::: "memory");
            __syncthreads();
            float un = 0.f, cmn = 0.f, bsn = 0.f;
            if (wave == 0) { un = __hip_atomic_load(glf + 4096 + 64 * cn + lane, __ATOMIC_RELAXED, __HIP_MEMORY_SCOPE_AGENT); cmn = __hip_atomic_load(glf + 6144 + 64 * cn + lane, __ATOMIC_RELAXED, __HIP_MEMORY_SCOPE_AGENT);
                             bsn = __hip_atomic_load(glf + 8192 + 64 * cn + lane, __ATOMIC_RELAXED, __HIP_MEMORY_SCOPE_AGENT); }
            { LAS f32x4* xs = (LAS f32x4*)(lds + ML_XS) + (size_t)((wave & 3) * 4) * 64 + lane;
              if (wave >= 4) {
#pragma unroll
                for (int gq = 0; gq < 4; ++gq) xs[gq * 64] = (f32x4){Sacc[4 * gq], Sacc[4 * gq + 1], Sacc[4 * gq + 2], Sacc[4 * gq + 3]}; } }
            SM[SM_DNQP + (tid >> 6) * 64 + (tid & 63)] = dnq;
            __syncthreads();
            if (wave < 4) {
                const int st = wave >> 1, tt1 = wave & 1, t = 32 * tt1 + r;
                const LAS f32x4* xs = (const LAS f32x4*)(lds + ML_XS) + (size_t)(wave * 4) * 64 + lane;
                const float Mt = SM[gb + GB_MR + t]; float dsum = 0.f;
#pragma unroll
                for (int gq = 0; gq < 4; ++gq) {
                    const f32x4 px = xs[gq * 64]; const int s0 = 32 * st + 8 * gq + 4 * h; const f32x4 us = *(const LAS f32x4*)(SM + gb + GB_U + s0);
                    float vv[4];
#pragma unroll
                    for (int e = 0; e < 4; ++e) { const float raw = (Sacc[4 * gq + e] + px[e]) * KSCALE; vv[e] = (s0 + e <= t) ? raw * __expf(us[e] - Mt) : 0.f; dsum += vv[e]; }
                    u32x2 w; w.x = cvt_pk_bf16(vv[0], vv[1]); w.y = cvt_pk_bf16(vv[2], vv[3]);
                    *(LAS u32x2*)(lds + ML_SS + t * 144 + s0 * 2) = w;
                }
                dsum += __shfl_xor(dsum, 32);
                if (h == 0) SM[(st ? SM_DIN1 : SM_DIN0) + t] = dsum;
            }
#pragma unroll
            for (int tt = 0; tt < 2; ++tt) { const float it = SM[gb + GB_INT + 32 * tt + r]; num[tt] = num[tt] * it; }
            __syncthreads();
#pragma unroll
            for (int k2 = 0; k2 < 2; ++k2) { const int ks = 2 * dpar + k2;
                const bf16x8 a = frag_tr(lds + VSc, 16 * ks, 32 * vt, lane);
#pragma unroll
                for (int tt = 0; tt < 2; ++tt) { const bf16x8 bb = *(const LAS bf16x8*)(lds + ML_SS + (32 * tt + r) * 144 + (16 * ks + 8 * h) * 2); num[tt] = MFMA32(a, bb, num[tt]); } }
            __syncthreads();
            { LAS f32x4* xn = (LAS f32x4*)(lds + ML_XN) + (size_t)(vt * 8) * 64 + lane;
              if (dpar == 1) {
#pragma unroll
                for (int tt = 0; tt < 2; ++tt)
#pragma unroll
                    for (int gq = 0; gq < 4; ++gq) xn[(tt * 4 + gq) * 64] = (f32x4){num[tt][4 * gq], num[tt][4 * gq + 1], num[tt][4 * gq + 2], num[tt][4 * gq + 3]}; } }
            if (wave == 0) ml_gates(SM, un, cmn, bsn, gbn, SM[SM_MC + cn], SM[SM_CMX + cn], lane);
            __syncthreads();
            if (dpar == 0) {
                const LAS f32x4* xn = (const LAS f32x4*)(lds + ML_XN) + (size_t)(vt * 8) * 64 + lane;
#pragma unroll
                for (int tt = 0; tt < 2; ++tt) { const int t = 32 * tt + r; float nq = 0.f;
#pragma unroll
                    for (int gI = 0; gI < 8; ++gI) nq += SM[SM_DNQP + gI * 64 + t];
                    const float den = SM[SM_DIN0 + t] + SM[SM_DIN1 + t] + SM[gb + GB_INT + t] * nq;
                    const float inv = 1.0f / fmaxf(fabsf(den), SM[gb + GB_BND + t]);
                    const int tau = 64 * c + t; const size_t ob = (size_t)(b * SEQ + (dir ? SEQ - 1 - tau : tau)) * 4096 + hd * 512 + vs * 128 + 32 * vt + 4 * h;
#pragma unroll
                    for (int gq = 0; gq < 4; ++gq) { const f32x4 px = xn[(tt * 4 + gq) * 64];
                        u32x2 w; w.x = cvt_pk_bf16((num[tt][4 * gq] + px.x) * inv, (num[tt][4 * gq + 1] + px.y) * inv); w.y = cvt_pk_bf16((num[tt][4 * gq + 2] + px.z) * inv, (num[tt][4 * gq + 3] + px.w) * inv);
                        *(u32x2*)(H + ob + 8 * gq) = w; } }
            }
            ML_WRITE_WV(VSn, gbn);
            { const float decay = SM[gb + GB_SC + 0];
              float acc_ = 0.f; const LAS unsigned* np_ = (const LAS unsigned*)(SM + SM_NVP) + (tid >> 1);
#pragma unroll
              for (int sgx = 0; sgx < 8; ++sgx) { const unsigned pr_ = np_[sgx * 256]; acc_ += (tid & 1) ? bf_hi(pr_) : bf_lo(pr_); }
              SM[SM_NV + tid] = decay * SM[SM_NV + tid] + acc_; }
        }
#undef ML_DMA_QK
#undef ML_WRITE_WV
    }
}

DI void ml_combine_phase(const bf16_t* HF, const bf16_t* HB, const bf16_t* XC, const bf16_t* XZ, const float* norm_g, const float* skip, unsigned char* MO, int gw, int NGW, int lane) {
    for (int idx = gw; idx < MTOK * ML_HEADS; idx += NGW) {
        const int tok = idx >> 3, hd = idx & 7; const int ch = hd * 512 + 8 * lane; const size_t o4 = (size_t)tok * 4096 + ch;
        const u32x4 a = *(const u32x4*)(HF + o4), bq = *(const u32x4*)(HB + o4), xcv = *(const u32x4*)(XC + o4), zv = *(const u32x4*)(XZ + (size_t)tok * 8192 + 4096 + ch);
        float ht[8] = {bf_lo(a.x) + bf_lo(bq.x), bf_hi(a.x) + bf_hi(bq.x), bf_lo(a.y) + bf_lo(bq.y), bf_hi(a.y) + bf_hi(bq.y), bf_lo(a.z) + bf_lo(bq.z), bf_hi(a.z) + bf_hi(bq.z), bf_lo(a.w) + bf_lo(bq.w), bf_hi(a.w) + bf_hi(bq.w)};
        const float xc[8] = {bf_lo(xcv.x), bf_hi(xcv.x), bf_lo(xcv.y), bf_hi(xcv.y), bf_lo(xcv.z), bf_hi(xcv.z), bf_lo(xcv.w), bf_hi(xcv.w)};
        const float z[8] = {bf_lo(zv.x), bf_hi(zv.x), bf_lo(zv.y), bf_hi(zv.y), bf_lo(zv.z), bf_hi(zv.z), bf_lo(zv.w), bf_hi(zv.w)};
        float s = 0.f;
#pragma unroll
        for (int i = 0; i < 8; ++i) s += ht[i];
        const float mu = wave_sum(s) * (1.f / 512.f); float q = 0.f;
#pragma unroll
        for (int i = 0; i < 8; ++i) { ht[i] -= mu; q += ht[i] * ht[i]; }
        const float rstd = 1.0f / sqrtf(wave_sum(q) * (1.f / 512.f) + 1e-5f);
        const f32x4 g0 = *(const f32x4*)(norm_g + ch), g1 = *(const f32x4*)(norm_g + ch + 4), k0 = *(const f32x4*)(skip + ch), k1 = *(const f32x4*)(skip + ch + 4);
        const float gg[8] = {g0.x, g0.y, g0.z, g0.w, g1.x, g1.y, g1.z, g1.w}, sk[8] = {k0.x, k0.y, k0.z, k0.w, k1.x, k1.y, k1.z, k1.w};
        float o[8];
#pragma unroll
        for (int i = 0; i < 8; ++i) o[i] = (ht[i] * rstd * gg[i] + sk[i] * xc[i]) * sigmoid_f(z[i]);
        u32x2 w; w.x = pk4_fp8(o[0] * HSCALE, o[1] * HSCALE, o[2] * HSCALE, o[3] * HSCALE); w.y = pk4_fp8(o[4] * HSCALE, o[5] * HSCALE, o[6] * HSCALE, o[7] * HSCALE);
        *(u32x2*)(MO + o4) = w;
    }
}

DI void moe_offsets(const unsigned* ecnt, int (&cnt)[8], int (&off)[8], int& ntiles) {
    int acc = 0;
#pragma unroll
    for (int e = 0; e < 8; ++e) { cnt[e] = (int)ecnt[64 * e]; off[e] = acc * 256; acc += (cnt[e] + 255) >> 8; }
    ntiles = acc;
}
DI void moe_split_plan(int ntiles, int& nMf, int& nT, int& S) {
    nMf = (ntiles >> 5) << 5; nT = ntiles - nMf; S = 1;
    if (nT > 0) { S = (nT <= 4) ? 7 : (nT <= 8) ? 4 : (nT <= 16) ? 2 : 1; }
    if (S == 1) { nMf = ntiles; nT = 0; }
}
DI pg8::TileMap moe_tilemap(const int (&cnt)[8]) { pg8::TileMap tm; int acc = 0; tm.toff[0] = 0;
#pragma unroll
    for (int e = 0; e < 8; ++e) { acc += (cnt[e] + 255) >> 8; tm.toff[e + 1] = acc; }
    return tm; }
DI void moe_scatter_phase(const unsigned char* HA, unsigned char* HS, const int* tok_e, const int* tok_pos, int* slot_row, const unsigned* ecnt, int* tile_e, int gw, int NGW, int lane) {
    int cnt[8], off[8], ntiles; moe_offsets(ecnt, cnt, off, ntiles);
    if (gw == 0 && lane < 8) { const int e = lane; const int t0 = off[e] >> 8, nt = (cnt[e] + 255) >> 8; for (int t = 0; t < nt; ++t) tile_e[t0 + t] = e; }
    for (int id = gw; id < 2 * MTOK; id += NGW) {
        const int e = tok_e[id], pos = tok_pos[id]; int o = 0;
#pragma unroll
        for (int q = 0; q < 8; ++q) o = (e == q) ? off[q] : o;
        const int row = o + pos;
        if (lane == 0) slot_row[id] = row;
        const u32x4* src = (const u32x4*)(HA + (size_t)(id >> 1) * DM) + lane; u32x4* dst = (u32x4*)(HS + (size_t)row * DM) + lane;
#pragma unroll
        for (int j = 0; j < 2; ++j) dst[64 * j] = src[64 * j];
    }
#pragma unroll 1
    for (int e = 0; e < 8; ++e) { int c = 0, o = 0;
#pragma unroll
        for (int q = 0; q < 8; ++q) { c = (e == q) ? cnt[q] : c; o = (e == q) ? off[q] : o; }
        const int pend = ((c + 255) >> 8) << 8;
        for (int p = c + gw; p < pend; p += NGW) { u32x4* dst = (u32x4*)(HS + (size_t)(o + p) * DM) + lane;
#pragma unroll
            for (int j = 0; j < 2; ++j) dst[64 * j] = (u32x4){0u, 0u, 0u, 0u}; } }
}

DI f32x4 moe_yrow(const bf16_t* YS, const bf16_t* YSP, int r, int rsplit, int S, int nrs, int lane, int j) {
    if (r < rsplit) { const u32x2 a = ((const u32x2*)(YS + (size_t)r * DM) + lane)[64 * j]; return (f32x4){bf_lo(a.x), bf_hi(a.x), bf_lo(a.y), bf_hi(a.y)}; }
    f32x4 acc = (f32x4){0.f, 0.f, 0.f, 0.f};
    for (int s2 = 0; s2 < S; ++s2) { const u32x2 a = ((const u32x2*)(YSP + ((size_t)s2 * nrs + (r - rsplit)) * DM) + lane)[64 * j]; acc += (f32x4){bf_lo(a.x), bf_hi(a.x), bf_lo(a.y), bf_hi(a.y)}; }
    return acc;
}
DI void moe_combine_phase(const bf16_t* X3, const bf16_t* YS, const int* tok_e, const int* tok_pos, const float* tok_w, const float* gate, float* out, const unsigned* ecnt, int gw, int NGW, int lane) {
    int cnt[8], off[8], ntiles; moe_offsets(ecnt, cnt, off, ntiles);
    int nMf, nT, S; moe_split_plan(ntiles, nMf, nT, S); const int rsplit = nMf * 256; const bf16_t* YSP = YS + (size_t)MPAD * DM;
    for (int tok = gw; tok < MTOK; tok += NGW) {
        const int e0 = tok_e[2 * tok], e1 = tok_e[2 * tok + 1]; int o0 = 0, o1 = 0;
#pragma unroll
        for (int q = 0; q < 8; ++q) { o0 = (e0 == q) ? off[q] : o0; o1 = (e1 == q) ? off[q] : o1; }
        const int r0 = o0 + tok_pos[2 * tok], r1 = o1 + tok_pos[2 * tok + 1]; const float w0 = tok_w[2 * tok], w1 = tok_w[2 * tok + 1];
        const u32x2* x = (const u32x2*)(X3 + (size_t)tok * DM) + lane;
        const f32x4* gp = (const f32x4*)(gate + (size_t)(tok >> 11) * 12288) + lane; f32x4* o = (f32x4*)(out + (size_t)tok * DM) + lane;
#pragma unroll
        for (int j = 0; j < 8; ++j) { const f32x4 ya = moe_yrow(YS, YSP, r0, rsplit, S, nT * 256, lane, j), yb = moe_yrow(YS, YSP, r1, rsplit, S, nT * 256, lane, j);
            const u32x2 xr = x[64 * j]; o[64 * j] = (f32x4){bf_lo(xr.x), bf_hi(xr.x), bf_lo(xr.y), bf_hi(xr.y)} + gp[64 * j] * (ya * w0 + yb * w1); }
    }
}

struct Params { const float* in[29]; float* out; unsigned char* ws; int ph_lo, ph_hi; };
static_assert(sizeof(Params) == 31 * 8 + 8, "Params has padding");
constexpr int NPHASE = 20;

#if DBG
#include "dbg_checks.inc"
#endif

__global__ void __launch_bounds__(NTHREADS, 2) mega_fwd(Params p) {
    extern __shared__ __attribute__((aligned(16))) unsigned char lds_raw[];
    LAS unsigned char* lds = (LAS unsigned char*)lds_raw;
    const int tid = threadIdx.x, lane = tid & 63, wave = __builtin_amdgcn_readfirstlane(tid >> 6);
    const int G = gridDim.x, gw = blockIdx.x * NWAVES + wave, NGW = G * NWAVES;
    const int vcu = (G % 8 == 0) ? (int)(blockIdx.x % 8) * (G / 8) + (int)(blockIdx.x / 8) : (int)blockIdx.x;
    const int gwx = vcu * NWAVES + wave;
    unsigned char* ws = p.ws;
    unsigned* ctl = (unsigned*)(ws + WS_CTL);
    volatile LAS unsigned* xbw = (volatile LAS unsigned*)(lds + LDS_BYTES - 16);
    if (tid == 0) { xbw[0] = 0u; xbw[1] = 0u; xbw[2] = 0u; xbw[3] = 0u; }
    __syncthreads();
    XcdBarrier bar = xcd_barrier_post(ctl + CW_BAR, xbw);
    const int lo = p.ph_lo, hi = p.ph_hi;
#ifndef PH_MASK
#define PH_MASK 0xFFFFFFu
#endif
#define IN(k) (((PH_MASK >> (k)) & 1u) && lo <= (k) && (k) < hi)
#define SEAM(k) do { if (IN((k) + 1)) xcd_barrier(bar); } while (0)
#ifndef REP_MASK
#define REP_MASK 0u
#endif
#define PHASE(k, ...) if (IN(k)) { { __VA_ARGS__ } if ((REP_MASK >> (k)) & 1u) { __syncthreads(); { __VA_ARGS__ } } SEAM(k); }

    float* mod = (float*)(ws + WS_MOD);
    float* pre_part = (float*)(ws + WS_PRE);
    int* tok_e = (int*)(ws + WS_ROUTE); int* tok_pos = tok_e + 2 * MTOK; float* tok_w = (float*)(tok_pos + 2 * MTOK); int* slot_row = (int*)(tok_w + 2 * MTOK);
    unsigned* ecnt = ctl + CW_ECNT; int* tile_e = (int*)(ctl + 12288);
    bf16_t* HA = (bf16_t*)(ws + WS_HA); bf16_t* X1 = (bf16_t*)(ws + WS_X1); bf16_t* X2 = (bf16_t*)(ws + WS_X2);
    bf16_t* WT_IN = (bf16_t*)(ws + WS_WT_IN); bf16_t* WT_OUT = (bf16_t*)(ws + WS_WT_OUT); bf16_t* WT_GU = (bf16_t*)(ws + WS_WT_GU); bf16_t* WT_DN = (bf16_t*)(ws + WS_WT_DN);
    bf16_t* WT_MLIN = (bf16_t*)(ws + WS_WT_MLIN); bf16_t* WT_MLOUT = (bf16_t*)(ws + WS_WT_MLOUT); bf16_t* WT_IF = (bf16_t*)(ws + WS_WT_IF);
    unsigned char* WT_MGU = ws + WS_WT_MGU; unsigned char* WT_MD = ws + WS_WT_MD;
    bf16_t* QK = (bf16_t*)(ws + A_QK); bf16_t* QKN = (bf16_t*)(ws + A_QKN); bf16_t* VT = (bf16_t*)(ws + A_VT); bf16_t* ATT = (bf16_t*)(ws + A_ATT); bf16_t* ACT = (bf16_t*)(ws + A_ACT);
    bf16_t* XZ = (bf16_t*)(ws + A_XZ); bf16_t* XC = (bf16_t*)(ws + A_XC); bf16_t* Qm = (bf16_t*)(ws + A_Q); bf16_t* Km = (bf16_t*)(ws + A_K); bf16_t* Vm = (bf16_t*)(ws + A_V);
    bf16_t* HF = (bf16_t*)(ws + A_HF); bf16_t* HB = (bf16_t*)(ws + A_HB); bf16_t* MO = (bf16_t*)(ws + A_MO);
    unsigned char* HS = ws + A_HS; unsigned char* ACTM = ws + A_ACTM; float* YS = (float*)(ws + A_YS);
    const float* x_in = p.in[0];

    PHASE(0,
        mod_phase(p.in[1], p.in[2], p.in[3], mod, lds, G, tid, lane, wave);
        LAS float* scrw = (LAS float*)lds + wave * (64 * 65);
        cvtw_job<0, false>(p.in[6] + 4096, 2048, 2048, 1, WT_IN + (size_t)4096 * 2048, 0, scrw, gw, NGW, lane, 1.f, 6144, 0);
        cvtw_job<0, true>(p.in[6], 2048, 4096, 1, (unsigned char*)ACT + (size_t)32 * 1024 * 1024, 0, scrw, gw, NGW, lane, WSCALE, 6144, 512);
        cvtw_job<0, false>(p.in[10], 2048, 2048, 1, WT_OUT, 0, scrw, gw, NGW, lane, 1.f, 0, 1536);
        cvtw_job<1, false>(p.in[11], 2048, FFN, 1, WT_GU, 0, scrw, gw, NGW, lane, 1.f, 0, 2048);
        cvtw_job<2, false>(p.in[12], 2048, FFN, 1, WT_GU, 0, scrw, gw, NGW, lane, 1.f, 0, 3456);
        cvtw_job<0, false>(p.in[13], FFN, 2048, 1, WT_DN, 0, scrw, gw, NGW, lane, 1.f, 0, 4864);
        cvtw_job<0, false>(p.in[14], 2048, 4096, 1, WT_MLIN, 0, scrw, gw, NGW, lane, 1.f, 8192, 6272);
        cvtw_job<0, true>(p.in[14] + 4096, 2048, 4096, 1, (unsigned char*)WT_MLIN + (size_t)16 * 1024 * 1024, 0, scrw, gw, NGW, lane, WSCALE, 8192, 7296);
        cvtw_job<0, true>(p.in[24], 4096, 2048, 1, (unsigned char*)WT_MLOUT, 0, scrw, gw, NGW, lane, WSCALE, 0, 8320);
        cvt_job<0>(p.in[20], 12288, 32, 1, WT_IF, 0, scrw, gw, NGW, lane);
        cvtw_job<1, true>(p.in[26], 2048, EDIM, 8, WT_MGU, (size_t)14336 * 2048, scrw, gw, NGW, lane, WSCALE, 0, 9344);
        cvtw_job<2, true>(p.in[27], 2048, EDIM, 8, WT_MGU, (size_t)14336 * 2048, scrw, gw, NGW, lane, WSCALE, 0, 9344 + 14336);
        cvtw_job<0, true>(p.in[28], EDIM, 2048, 8, WT_MD, (size_t)2048 * EDIM, scrw, gw, NGW, lane, WSCALE, 0, 9344 + 2 * 14336); )
    PHASE(1,  rms_mod_phase<false, true>(x_in, p.in[4], mod + 1 * 2048, mod + 0 * 2048, HA, nullptr, nullptr, nullptr, nullptr, nullptr, (unsigned char*)ACT, gw, NGW, lane); )
    PHASE(2,
        { pg8::Gemm g{(const unsigned char*)ACT, (const unsigned char*)ACT + (size_t)32 * 1024 * 1024, MTOK, 4096, 2048, 0}; pg8::StaticOrder S; S.init(MTOK, 4096, G, (int)blockIdx.x); pg8::EpiQKNorm E{QKN, 4096, p.in[7], p.in[8], 1.0f / (HSCALE * WSCALE)}; pg8::gemm_phase<pg8::EpiQKNorm, pg8::StaticOrder, true>(lds, g, S, E); }
        { pg8::Gemm g{WT_IN + (size_t)4096 * 2048, HA, 2048, MTOK, 2048, 0}; pg8::StaticOrder S; S.init(2048, MTOK, G, (int)blockIdx.x); pg8::EpiBf16 E{VT, MTOK}; pg8::gemm_phase(lds, g, S, E); } )
    PHASE(4,  na_phase(QKN, VT, ATT, p.in[9], lds, G, vcu, tid, lane, wave); )
    PHASE(5,  pg8::Gemm g{ATT, WT_OUT, MTOK, 2048, 2048, 0}; pg8::StaticOrder S; S.init(MTOK, 2048, G, (int)blockIdx.x); pg8::EpiResGate16<false> E{x_in, X1, DM, mod + 2 * 2048, 12288}; pg8::gemm_phase(lds, g, S, E); )
    PHASE(6,  rms_mod_phase<false, false, true>(X1, p.in[5], mod + 4 * 2048, mod + 3 * 2048, HA, nullptr, nullptr, nullptr, nullptr, nullptr, nullptr, gw, NGW, lane); )
    PHASE(7,  pg8::Gemm g{HA, WT_GU, MTOK, 2 * FFN, 2048, 0}; pg8::StaticOrder S; S.init(MTOK, 2 * FFN, G, (int)blockIdx.x); pg8::EpiSwiGLU E{ACT, FFN}; pg8::gemm_phase(lds, g, S, E); )
    PHASE(8,  pg8::Gemm g{ACT, WT_DN, MTOK, 2048, FFN, 0}; pg8::StaticOrder S; S.init(MTOK, 2048, G, (int)blockIdx.x); pg8::EpiResGate16<true> E{X1, X2, DM, mod + 5 * 2048, 12288}; pg8::gemm_phase(lds, g, S, E); )
    PHASE(9,  rms_mod_phase<false, true, true>(X2, p.in[4] + DM, mod + 4 * 12288 + 1 * 2048, mod + 4 * 12288 + 0 * 2048, HA, nullptr, nullptr, nullptr, nullptr, nullptr, (unsigned char*)MO, gw, NGW, lane); )
    PHASE(10,
        { pg8::Gemm g{HA, WT_MLIN, MTOK, 4096, 2048, 0}; pg8::StaticOrder S; S.init(MTOK, 4096, G, (int)blockIdx.x); pg8::EpiBf16 E{XZ, 8192}; pg8::gemm_phase(lds, g, S, E); }
        { pg8::Gemm g{(const unsigned char*)MO, (const unsigned char*)WT_MLIN + (size_t)16 * 1024 * 1024, MTOK, 4096, 2048, 0}; pg8::StaticOrder S; S.init(MTOK, 4096, G, (int)blockIdx.x);
          pg8::EpiBf16S E{XZ + 4096, 8192, 1.0f / (HSCALE * WSCALE), 0}; pg8::gemm_phase<pg8::EpiBf16S, pg8::StaticOrder, true>(lds, g, S, E); } )
    PHASE(11,  ml_pre_phase(XZ, p.in[15], p.in[16], p.in[17], p.in[18], p.in[19], WT_IF, XC, Qm, Km, Vm, pre_part, lds, G, tid, lane, wave); )
    PHASE(12,  mlstm_phase(Qm, Km, Vm, pre_part, p.in[21], (float*)(ws + WS_GLF), HF, HB, lds, G, vcu, tid, lane, wave); )
    PHASE(13,  ml_combine_phase(HF, HB, XC, XZ, p.in[23], p.in[22], (unsigned char*)MO, gw, NGW, lane); )
    PHASE(14,  pg8::Gemm g{MO, WT_MLOUT, MTOK, 2048, 4096, 0}; pg8::StaticOrder S; S.init(MTOK, 2048, G, (int)blockIdx.x); pg8::EpiResGate16<true> E{X2, X1, DM, mod + 4 * 12288 + 2 * 2048, 12288, 1.0f / (HSCALE * WSCALE)}; pg8::gemm_phase<pg8::EpiResGate16<true>, pg8::StaticOrder, true>(lds, g, S, E); )
    PHASE(15,  rms_mod_phase<true, false, true>(X1, p.in[5] + DM, mod + 4 * 12288 + 4 * 2048, mod + 4 * 12288 + 3 * 2048, HA, p.in[25], tok_e, tok_pos, tok_w, ecnt, HS, gw, NGW, lane); )
    PHASE(17,  int cnt[8], off[8], ntiles; moe_offsets(ecnt, cnt, off, ntiles);
        pg8::Gemm g{HS, WT_MGU, ntiles * 256, 2 * EDIM, 2048, 0}; pg8::MoeOrder S; S.init(ntiles, 2 * EDIM, G, (int)blockIdx.x, moe_tilemap(cnt), (size_t)14336 * 2048, (size_t)DM);
        pg8::EpiSwiGLU8 E{ACTM, EDIM, 1.0f / (HSCALE * WSCALE), ASCALE}; pg8::gemm_phase<pg8::EpiSwiGLU8, pg8::MoeOrder, true>(lds, g, S, E); )
    PHASE(18,  int cnt[8], off[8], ntiles; moe_offsets(ecnt, cnt, off, ntiles);
        pg8::Gemm g{ACTM, WT_MD, ntiles * 256, 2048, EDIM, 0};
        int nMf, nT, SS; moe_split_plan(ntiles, nMf, nT, SS); bf16_t* YSP = (bf16_t*)YS + (size_t)MPAD * DM;
        { pg8::MoeRowOrder S1; S1.init(nMf, G, (int)blockIdx.x, moe_tilemap(cnt), (size_t)2048 * EDIM); pg8::EpiBf16S E{(bf16_t*)YS, DM, 1.0f / (ASCALE * WSCALE), 0}; pg8::gemm_phase<pg8::EpiBf16S, pg8::MoeRowOrder, true>(lds, g, S1, E); }
        if (nT > 0) { pg8::Gemm g2 = g; g2.ntk = 56 / SS; pg8::MoeSplitOrder S2; S2.init(nMf, nT, SS, (size_t)(EDIM / SS), (int)blockIdx.x, moe_tilemap(cnt), (size_t)2048 * EDIM);
            pg8::EpiBf16S E2{YSP - (size_t)nMf * 256 * DM, DM, 1.0f / (ASCALE * WSCALE), (size_t)nT * 256 * DM}; pg8::gemm_phase<pg8::EpiBf16S, pg8::MoeSplitOrder, true>(lds, g2, S2, E2); } )
    PHASE(19,  moe_combine_phase(X1, (const bf16_t*)YS, tok_e, tok_pos, tok_w, mod + 4 * 12288 + 5 * 2048, p.out, ecnt, gw, NGW, lane); )
#undef IN
#undef SEAM
#undef PHASE
}

extern "C" void kernel_launch(void* const* d_in, const int* in_sizes, int n_in, void* d_out, int out_size, void* d_ws, size_t ws_size, hipStream_t stream) {
    static int grid = 0;
    if (grid == 0) {
        if (n_in != 29 || out_size != MTOK * DM || ws_size < WS_END) { fprintf(stderr, "kernel_launch: unexpected shapes (n_in %d out %d ws %zu need %zu)\n", n_in, out_size, ws_size, (size_t)WS_END); grid = -1; return; }
        int dev = 0, cus = 0, per_cu = 0;
        if (hipGetDevice(&dev) != hipSuccess || hipDeviceGetAttribute(&cus, hipDeviceAttributeMultiprocessorCount, dev) != hipSuccess) { grid = -1; return; }
        if (hipFuncSetAttribute((const void*)mega_fwd, hipFuncAttributeMaxDynamicSharedMemorySize, LDS_BYTES) != hipSuccess) { fprintf(stderr, "kernel_launch: hipFuncSetAttribute failed\n"); grid = -1; return; }
        if (hipOccupancyMaxActiveBlocksPerMultiprocessor(&per_cu, (const void*)mega_fwd, NTHREADS, LDS_BYTES) != hipSuccess || per_cu < 1) { fprintf(stderr, "kernel_launch: occupancy query says %d\n", per_cu); (void)hipGetLastError(); per_cu = 1; }
        grid = cus;
    }
    if (grid < 0) return;
    (void)hipMemsetAsync((char*)d_ws + WS_CTL, 0, CTL_BYTES, stream);
    Params p{};
    for (int i = 0; i < 29; ++i) p.in[i] = (const float*)d_in[i];
    p.out = (float*)d_out; p.ws = (unsigned char*)d_ws;
#if N_LAUNCH_SPLIT
    for (int k = 0; k < NPHASE; ++k) { p.ph_lo = k; p.ph_hi = k + 1; hipLaunchKernelGGL(mega_fwd, dim3(grid), dim3(NTHREADS), LDS_BYTES, stream, p); }
#else
    p.ph_lo = 0; p.ph_hi = NPHASE;
    hipLaunchKernelGGL(mega_fwd, dim3(grid), dim3(NTHREADS), LDS_BYTES, stream, p);
#endif
}
```

```cpp
#ifndef GEMM_SCH
#define GEMM_SCH 1
#endif
#include <hip/hip_runtime.h>
#include <cstdio>
#include <cstdint>

#ifndef DBG
#define DBG 0
#endif
#ifndef N_LAUNCH_SPLIT
#define N_LAUNCH_SPLIT 0
#endif

#define LAS __attribute__((address_space(3)))
#define GAS __attribute__((address_space(1)))
#define DI __device__ __forceinline__
typedef unsigned short bf16_t;
typedef short bf16x8 __attribute__((ext_vector_type(8)));
typedef short s16x4 __attribute__((ext_vector_type(4)));
typedef float f32x2 __attribute__((ext_vector_type(2)));
typedef float f32x4 __attribute__((ext_vector_type(4)));
typedef float f32x16 __attribute__((ext_vector_type(16)));
typedef unsigned u32x2 __attribute__((ext_vector_type(2)));
typedef unsigned u32x4 __attribute__((ext_vector_type(4)));
typedef int i32x4 __attribute__((ext_vector_type(4)));
typedef int i32x8 __attribute__((ext_vector_type(8)));

constexpr int BATCH = 4, SEQ = 2048, DM = 2048, MTOK = BATCH * SEQ;
constexpr int GRID_W = 64, NA_HEADS = 16, NA_HD = 128;
constexpr int ML_INNER = 4096, ML_HEADS = 8, ML_HD = 512;
constexpr int FFN = 5632, NEXP = 8, EDIM = 7168;
constexpr int MPAD = 2 * MTOK + NEXP * 256;
constexpr int NTHREADS = 512, NWAVES = 8;
constexpr int LDS_BYTES = 147456;

constexpr size_t al256(size_t x) { return (x + 255) & ~(size_t)255; }
constexpr size_t WS_CTL = 0;
constexpr size_t CTL_BYTES = 65536;
constexpr size_t WS_MOD = WS_CTL + CTL_BYTES;
constexpr size_t WS_PRE = WS_MOD + al256((size_t)2 * 4 * 12288 * 4);
constexpr size_t WS_ROUTE = WS_PRE + (size_t)8 * MTOK * 32 * 4;
constexpr size_t WS_GLF = WS_ROUTE + (size_t)4 * MTOK * 2 * 4;
constexpr size_t WS_HA = WS_GLF + (size_t)256 * 10240 * 4;
constexpr size_t WS_X1 = WS_HA + (size_t)MTOK * DM * 2;
constexpr size_t WS_X2 = WS_X1 + (size_t)MTOK * DM * 4;
constexpr size_t WS_WT_IN = WS_X2 + (size_t)MTOK * DM * 4;
constexpr size_t WS_WT_OUT = WS_WT_IN + (size_t)6144 * 2048 * 2;
constexpr size_t WS_WT_GU = WS_WT_OUT + (size_t)2048 * 2048 * 2;
constexpr size_t WS_WT_DN = WS_WT_GU + (size_t)11264 * 2048 * 2;
constexpr size_t WS_WT_MLIN = WS_WT_DN + (size_t)2048 * 5632 * 2;
constexpr size_t WS_WT_MLOUT = WS_WT_MLIN + (size_t)8192 * 2048 * 2;
constexpr size_t WS_WT_IF = WS_WT_MLOUT + (size_t)2048 * 4096 * 2;
constexpr size_t WS_WT_MGU = WS_WT_IF + (size_t)32 * 12288 * 2;
constexpr size_t WS_WT_MD = WS_WT_MGU + (size_t)8 * 14336 * 2048;
constexpr size_t WS_ARENA = WS_WT_MD + (size_t)8 * 2048 * 7168;
constexpr size_t A_QK = WS_ARENA;
constexpr size_t A_QKN = A_QK + (size_t)MTOK * 4096 * 2;
constexpr size_t A_VT = A_QKN + (size_t)MTOK * 4096 * 2;
constexpr size_t A_ATT = A_VT + (size_t)2048 * MTOK * 2;
constexpr size_t A_ACT = A_ATT + (size_t)MTOK * DM * 2;
constexpr size_t A_L0_END = A_ACT + (size_t)MTOK * FFN * 2;
constexpr size_t A_XZ = WS_ARENA;
constexpr size_t A_XC = A_XZ + (size_t)MTOK * 8192 * 2;
constexpr size_t A_Q = A_XC + (size_t)MTOK * 4096 * 2;
constexpr size_t A_K = A_Q + (size_t)MTOK * 4096 * 2;
constexpr size_t A_V = A_K + (size_t)MTOK * 4096 * 2;
constexpr size_t A_HF = A_V + (size_t)MTOK * 4096 * 2;
constexpr size_t A_HB = A_HF + (size_t)MTOK * 4096 * 2;
constexpr size_t A_MO = A_HB + (size_t)MTOK * 4096 * 2;
constexpr size_t A_L1_END = A_MO + (size_t)MTOK * 4096 * 2;
constexpr size_t A_HS = WS_ARENA;
constexpr size_t A_ACTM = A_HS + (size_t)8 * 8192 * DM;
constexpr size_t A_YS = A_ACTM + (size_t)MPAD * EDIM;
constexpr size_t A_L2_END = A_YS + (size_t)MPAD * DM * 4;
constexpr size_t cmax(size_t a, size_t b) { return a > b ? a : b; }
constexpr size_t WS_END = cmax(cmax(A_L0_END, A_L1_END), A_L2_END);

constexpr int CW_BAR = 0;
constexpr int CW_ECNT = 4096;
constexpr int CW_DBG = 8192;

typedef __bf16 bf16x2_t __attribute__((ext_vector_type(2)));
DI unsigned cvt_pk_bf16(float lo, float hi) { const f32x2 v = {lo, hi}; return __builtin_bit_cast(unsigned, __builtin_convertvector(v, bf16x2_t)); }
DI float clamp448(float x) { return __builtin_fminf(__builtin_fmaxf(x, -448.f), 448.f); }
DI unsigned pk4_fp8(float a, float b, float c, float d) {
    int p = 0; p = __builtin_amdgcn_cvt_pk_fp8_f32(clamp448(a), clamp448(b), p, false); p = __builtin_amdgcn_cvt_pk_fp8_f32(clamp448(c), clamp448(d), p, true); return (unsigned)p; }
DI float bf_lo(unsigned u) { return __uint_as_float(u << 16); }
DI float bf_hi(unsigned u) { return __uint_as_float(u & 0xffff0000u); }
DI float bf2f(bf16_t b) { return __uint_as_float(((unsigned)b) << 16); }
DI bf16_t f2bf(float f) { return (bf16_t)(cvt_pk_bf16(f, 0.f) & 0xffffu); }
DI float wave_sum(float v) {
#pragma unroll
    for (int o = 1; o < 64; o <<= 1) v += __shfl_xor(v, o);
    return v;
}
DI float wave_max(float v) {
#pragma unroll
    for (int o = 1; o < 64; o <<= 1) v = fmaxf(v, __shfl_xor(v, o));
    return v;
}
DI float silu_f(float x) { return x / (1.f + __expf(-x)); }
DI float sigmoid_f(float x) { return 1.f / (1.f + __expf(-x)); }
#define LDS_WAIT() asm volatile("s_waitcnt lgkmcnt(0)" ::: "memory")
#define VM_WAIT() asm volatile("s_waitcnt vmcnt(0)" ::: "memory")

#define XB_TMO      128
#define XB_XCNT(j)  (256  + 64 * (j))
#define XB_XSUB(j)  (1280 + 64 * (j))
#define XB_XGEN(j)  (2304 + 64 * (j))
#define XB_TOP      3328
#define XB_TOPGEN   3392
#define XCD_BAR_WORDS 3456
#define XB_SPIN_CAP (1u << 22)

__device__ __forceinline__ unsigned xb_ld(unsigned* p)              { return __hip_atomic_load(p, __ATOMIC_RELAXED, __HIP_MEMORY_SCOPE_AGENT); }
__device__ __forceinline__ unsigned xb_add(unsigned* p, unsigned v) { return __hip_atomic_fetch_add(p, v, __ATOMIC_RELAXED, __HIP_MEMORY_SCOPE_AGENT); }
__device__ __forceinline__ unsigned xb_xcc_id() { return (unsigned)__builtin_amdgcn_s_getreg((3 << 11) | 20) & 0xFu; }
#define XB_SPIN(cond, bar) do { unsigned _sp = 0; while (cond) { __builtin_amdgcn_s_sleep(1); \
    if ((++_sp & 255u) == 0u) { if (xb_ld(&(bar)[XB_TMO])) break; if (_sp > XB_SPIN_CAP) { atomicAdd(&(bar)[XB_TMO], 1u); break; } } } } while (0)

struct XcdBarrier { unsigned* bar; unsigned x; volatile LAS unsigned* st; };

__device__ __forceinline__ XcdBarrier xcd_barrier_post(unsigned* bar, volatile LAS unsigned* st) {
    XcdBarrier b; b.bar = bar; b.x = xb_xcc_id(); b.st = st;
    if (threadIdx.x == 0) (void)xb_add(&bar[XB_XCNT(b.x)], 1u);
    return b;
}
__device__ __forceinline__ void xcd_barrier_complete(unsigned* bar, unsigned x, unsigned& nloc, unsigned& nx) {
    const unsigned G = gridDim.x * gridDim.y * gridDim.z;
    unsigned sum, cnt, mine, sp = 0u;
    for (;;) {
        sum = 0u; cnt = 0u; mine = 0u;
#pragma unroll
        for (unsigned j = 0; j < 16; ++j) { const unsigned c = xb_ld(&bar[XB_XCNT(j)]); sum += c; cnt += (c > 0u) ? 1u : 0u; mine = (j == x) ? c : mine; }
        if (sum == G) break;
        __builtin_amdgcn_s_sleep(1);
        if ((++sp & 255u) == 0u) { if (xb_ld(&bar[XB_TMO])) break; if (sp > XB_SPIN_CAP) { atomicAdd(&bar[XB_TMO], 1u); break; } }
    }
    nloc = mine > 0u ? mine : 1u; nx = cnt > 0u ? cnt : 1u;
}
__device__ __forceinline__ void xcd_barrier(const XcdBarrier& b) {
    asm volatile("s_waitcnt vmcnt(0)" ::: "memory");
    __syncthreads();
    if (threadIdx.x == 0) {
        unsigned* bar = b.bar;
        __builtin_amdgcn_s_waitcnt(0);
        unsigned nloc = b.st[0], nx = b.st[1];
        if (nloc == 0u) { xcd_barrier_complete(bar, b.x, nloc, nx); b.st[0] = nloc; b.st[1] = nx; }
        const unsigned old = xb_add(&bar[XB_XSUB(b.x)], 1u);
        const unsigned gen = old / nloc;
        if (old + 1u == (gen + 1u) * nloc) {
            __builtin_amdgcn_fence(__ATOMIC_RELEASE, "agent");
            asm volatile("s_waitcnt vmcnt(0)" ::: "memory");
            const unsigned og = xb_add(&bar[XB_TOP], 1u);
            const unsigned tg = og / nx;
            if (og + 1u == (tg + 1u) * nx) xb_add(&bar[XB_TOPGEN], 1u);
            else XB_SPIN(xb_ld(&bar[XB_TOPGEN]) == tg, bar);
            __builtin_amdgcn_fence(__ATOMIC_ACQUIRE, "agent");
            xb_add(&bar[XB_XGEN(b.x)], 1u);
            asm volatile("s_waitcnt vmcnt(0)" ::: "memory");
        } else {
            XB_SPIN(xb_ld(&bar[XB_XGEN(b.x)]) == gen, bar);
            __builtin_amdgcn_fence(__ATOMIC_ACQUIRE, "agent");
            asm volatile("s_waitcnt vmcnt(0)" ::: "memory");
        }
    }
    __syncthreads();
}

namespace pg8 {
constexpr int BM = 256, BK = 64, HALF = 128, HTB = HALF * BK * 2, STAGE_BYTES = 8 * HTB, NXCD = 8, WGM = 8;
__host__ __device__ __forceinline__ int lds_byte(int r, int c) { const int st = (r >> 4) * 2 + (c >> 5), rr = r & 15, cc = c & 31, ob = rr * 64 + cc * 2; return st * 1024 + (ob ^ (((ob >> 9) & 1) << 5)); }
__host__ __device__ __forceinline__ void stage_rc(int b, int& R, int& C) { const int st = b / 1024, sb = b % 1024, swz = sb ^ (((sb >> 9) & 1) << 5); R = (st >> 1) * 16 + swz / 64; C = (st & 1) * 32 + (swz % 64) / 2; }
__host__ __device__ __forceinline__ int perm32(int rho) { const int n = rho >> 4, i = rho & 15; return 8 * (i >> 2) + 4 * n + (i & 3); }

struct Unit { int pm, pn; size_t boff; size_t aoff; int slice; };
struct Gemm { const void* A; const void* Bt; int M, N, K; int ntk; };

struct StaticOrder {
    int nM, nN, nwg, G, c;
    __device__ void init(int M, int N, int G_, int c_) { nM = M / BM; nN = N / BM; nwg = nM * nN; G = G_; c = c_; }
    __device__ bool next(int i, Unit& u) const {
        const long L = (long)i * G + c; if (L >= nwg) return false;
        int wgid = (int)L; { const int q = nwg / NXCD, r = nwg % NXCD, xcd = wgid % NXCD, off = wgid / NXCD; wgid = (xcd < r ? xcd * (q + 1) : r * (q + 1) + (xcd - r) * q) + off; }
        const int nig = WGM * nN, gid = wgid / nig, fm = gid * WGM, gsz = (nM - fm) < WGM ? (nM - fm) : WGM;
        u.pm = fm + ((wgid % nig) % gsz); u.pn = (wgid % nig) / gsz; u.boff = 0; u.aoff = 0; u.slice = 0; return true;
    }
};
struct TileMap {
    int toff[9];
    __device__ __forceinline__ void lookup(int pm, int& e, int& k) const {
        e = (pm >= toff[1]) + (pm >= toff[2]) + (pm >= toff[3]) + (pm >= toff[4]) + (pm >= toff[5]) + (pm >= toff[6]) + (pm >= toff[7]);
        int t0 = 0;
#pragma unroll
        for (int q = 1; q < 8; ++q) t0 = (e == q) ? toff[q] : t0;
        k = pm - t0;
    }
};
constexpr int ECAP = 8192;
struct MoeOrder {
    int nM, nN, nwg, G, c; TileMap tm; size_t estride; size_t arowb;
    __device__ void init(int nM_, int N, int G_, int c_, const TileMap& tm_, size_t es, size_t arowb_) { nM = nM_; nN = N / BM; nwg = nM * nN; G = G_; c = c_; tm = tm_; estride = es; arowb = arowb_; }
    __device__ bool next(int i, Unit& u) const {
        const long L = (long)i * G + c; if (L >= nwg) return false;
        int wgid = (int)L; { const int q = nwg / NXCD, r = nwg % NXCD, xcd = wgid % NXCD, off = wgid / NXCD; wgid = (xcd < r ? xcd * (q + 1) : r * (q + 1) + (xcd - r) * q) + off; }
        const int nig = WGM * nN, gid = wgid / nig, fm = gid * WGM, gsz = (nM - fm) < WGM ? (nM - fm) : WGM;
        u.pm = fm + ((wgid % nig) % gsz); u.pn = (wgid % nig) / gsz; int e, k; tm.lookup(u.pm, e, k); u.boff = (size_t)e * estride;
        u.aoff = (size_t)((long)(e * ECAP + 256 * k - 256 * u.pm) * (long)arowb); u.slice = 0; return true;
    }
};

struct MoeRowOrder {
    int nwg, G, c; TileMap tm; size_t estride;
    __device__ void init(int nMf, int G_, int c_, const TileMap& tm_, size_t es) { nwg = nMf * 8; G = G_; c = c_; tm = tm_; estride = es; }
    __device__ bool next(int i, Unit& u) const {
        const long L = (long)i * G + c; if (L >= nwg) return false;
        u.pm = (int)(L >> 3); u.pn = (int)(L & 7); int e, k; tm.lookup(u.pm, e, k); u.boff = (size_t)e * estride; u.aoff = 0; u.slice = 0; return true;
    }
};
struct MoeSplitOrder {
    int pm0, nq, S, c; size_t kslice; TileMap tm; size_t estride;
    __device__ void init(int pm0_, int nT, int S_, size_t ks, int c_, const TileMap& tm_, size_t es) { pm0 = pm0_; S = S_; nq = nT * 8 * S_; kslice = ks; c = c_; tm = tm_; estride = es; }
    __device__ bool next(int i, Unit& u) const {
        if (i != 0 || c >= nq) return false;
        const int un = c / S; u.slice = c - un * S; u.pm = pm0 + (un >> 3); u.pn = un & 7; u.aoff = (size_t)u.slice * kslice; int e, k; tm.lookup(u.pm, e, k); u.boff = (size_t)e * estride + u.aoff; return true;
    }
};
struct EpiBf16 {
    static constexpr bool PERM = true, XBAR = false;
    bf16_t* O; int ldc;
    __device__ __forceinline__ void operator()(const f32x4 (&acc)[2][2][4][2], const Unit& u, int wr, int wc, int fr, int fq) const {
        const int row0 = u.pm * BM + wr * 64 + fr, col0 = u.pn * BM + wc * 32 + 8 * fq;
#pragma unroll
        for (int ai = 0; ai < 2; ++ai)
#pragma unroll
            for (int m = 0; m < 4; ++m) { bf16_t* rowp = O + (size_t)(row0 + ai * HALF + m * 16) * ldc + col0;
#pragma unroll
                for (int bj = 0; bj < 2; ++bj) { const f32x4 v0 = acc[ai][bj][m][0], v1 = acc[ai][bj][m][1];
                    u32x4 w; w.x = cvt_pk_bf16(v0[0], v0[1]); w.y = cvt_pk_bf16(v0[2], v0[3]); w.z = cvt_pk_bf16(v1[0], v1[1]); w.w = cvt_pk_bf16(v1[2], v1[3]);
                    *(u32x4*)(rowp + bj * HALF) = w; } }
    }
};
struct EpiQKNorm {
    static constexpr bool PERM = true, XBAR = true;
    bf16_t* O; int ldc; const float* qg; const float* kg; float sc;
    __device__ __forceinline__ void pre(const f32x4 (&acc)[2][2][4][2], int wr, int wc, int fr, int fq, LAS float* P) const {
#pragma unroll
        for (int ai = 0; ai < 2; ++ai)
#pragma unroll
            for (int m = 0; m < 4; ++m)
#pragma unroll
                for (int bj = 0; bj < 2; ++bj) { const f32x4 a = acc[ai][bj][m][0], b = acc[ai][bj][m][1];
                    float ss = (a[0] * a[0] + a[1] * a[1]) + (a[2] * a[2] + a[3] * a[3]) + (b[0] * b[0] + b[1] * b[1]) + (b[2] * b[2] + b[3] * b[3]);
                    ss += __shfl_xor(ss, 16); ss += __shfl_xor(ss, 32);
                    if (fq == 0) P[((ai * HALF + wr * 64 + m * 16 + fr) * 2 + bj) * 4 + wc] = ss * sc * sc; }
    }
    __device__ __forceinline__ void post(const f32x4 (&acc)[2][2][4][2], const Unit& u, int wr, int wc, int fr, int fq, const LAS float* P) const {
        const int row0 = u.pm * BM + wr * 64 + fr, col0 = u.pn * BM + wc * 32 + 8 * fq;
        f32x4 g0[2], g1[2]; float hs[2];
#pragma unroll
        for (int bj = 0; bj < 2; ++bj) { const int head = 2 * u.pn + bj; const float* gp = (head < 16 ? qg : kg) + wc * 32 + 8 * fq; g0[bj] = *(const f32x4*)gp; g1[bj] = *(const f32x4*)(gp + 4); hs[bj] = head < 16 ? 0.08838834764831845f : 1.0f; }
#pragma unroll
        for (int ai = 0; ai < 2; ++ai)
#pragma unroll
            for (int m = 0; m < 4; ++m) { bf16_t* rowp = O + (size_t)(row0 + ai * HALF + m * 16) * ldc + col0;
#pragma unroll
                for (int bj = 0; bj < 2; ++bj) { const f32x4 ps = *(const LAS f32x4*)(P + ((ai * HALF + wr * 64 + m * 16 + fr) * 2 + bj) * 4);
                    const float rstd = hs[bj] / sqrtf(((ps[0] + ps[1]) + (ps[2] + ps[3])) * (1.f / 128.f) + 1e-6f);
                    const f32x4 v0 = acc[ai][bj][m][0] * g0[bj] * (rstd * sc), v1 = acc[ai][bj][m][1] * g1[bj] * (rstd * sc);
                    u32x4 w; w.x = cvt_pk_bf16(v0[0], v0[1]); w.y = cvt_pk_bf16(v0[2], v0[3]); w.z = cvt_pk_bf16(v1[0], v1[1]); w.w = cvt_pk_bf16(v1[2], v1[3]);
                    *(u32x4*)(rowp + bj * HALF) = w; } }
    }
};
struct EpiBf16S {
    static constexpr bool PERM = true, XBAR = false;
    bf16_t* O; int ldc; float sc; size_t sstride;
    __device__ __forceinline__ void operator()(const f32x4 (&acc)[2][2][4][2], const Unit& u, int wr, int wc, int fr, int fq) const {
        const int row0 = u.pm * BM + wr * 64 + fr, col0 = u.pn * BM + wc * 32 + 8 * fq;
        bf16_t* Os = O + (size_t)u.slice * sstride;
#pragma unroll
        for (int ai = 0; ai < 2; ++ai)
#pragma unroll
            for (int m = 0; m < 4; ++m) { bf16_t* rowp = Os + (size_t)(row0 + ai * HALF + m * 16) * ldc + col0;
#pragma unroll
                for (int bj = 0; bj < 2; ++bj) { const f32x4 v0 = acc[ai][bj][m][0] * sc, v1 = acc[ai][bj][m][1] * sc;
                    u32x4 w; w.x = cvt_pk_bf16(v0[0], v0[1]); w.y = cvt_pk_bf16(v0[2], v0[3]); w.z = cvt_pk_bf16(v1[0], v1[1]); w.w = cvt_pk_bf16(v1[2], v1[3]);
                    *(u32x4*)(rowp + bj * HALF) = w; } }
    }
};
struct EpiSwiGLU {
    static constexpr bool PERM = true, XBAR = false;
    bf16_t* O; int ldc;
    __device__ __forceinline__ void operator()(const f32x4 (&acc)[2][2][4][2], const Unit& u, int wr, int wc, int fr, int fq) const {
        const int row0 = u.pm * BM + wr * 64 + fr, col0 = u.pn * HALF + wc * 32 + 8 * fq;
#pragma unroll
        for (int ai = 0; ai < 2; ++ai)
#pragma unroll
            for (int m = 0; m < 4; ++m) { bf16_t* rowp = O + (size_t)(row0 + ai * HALF + m * 16) * ldc + col0;
                float o[8];
#pragma unroll
                for (int n = 0; n < 2; ++n)
#pragma unroll
                    for (int j = 0; j < 4; ++j) { const float g = acc[ai][0][m][n][j], up = acc[ai][1][m][n][j]; o[n * 4 + j] = g * __builtin_amdgcn_rcpf(1.f + __expf(-g)) * up; }
                u32x4 w; w.x = cvt_pk_bf16(o[0], o[1]); w.y = cvt_pk_bf16(o[2], o[3]); w.z = cvt_pk_bf16(o[4], o[5]); w.w = cvt_pk_bf16(o[6], o[7]);
                *(u32x4*)rowp = w; }
    }
};
struct EpiSwiGLU8 {
    static constexpr bool PERM = true, XBAR = false;
    unsigned char* O; int ldc; float isc, osc;
    __device__ __forceinline__ void operator()(const f32x4 (&acc)[2][2][4][2], const Unit& u, int wr, int wc, int fr, int fq) const {
        const int row0 = u.pm * BM + wr * 64 + fr, col0 = u.pn * HALF + wc * 32 + 8 * fq;
#pragma unroll
        for (int ai = 0; ai < 2; ++ai)
#pragma unroll
            for (int m = 0; m < 4; ++m) { unsigned char* rowp = O + (size_t)(row0 + ai * HALF + m * 16) * ldc + col0;
                float o[8];
#pragma unroll
                for (int n = 0; n < 2; ++n)
#pragma unroll
                    for (int j = 0; j < 4; ++j) { const float g = acc[ai][0][m][n][j] * isc, up = acc[ai][1][m][n][j] * isc; o[n * 4 + j] = g * __builtin_amdgcn_rcpf(1.f + __expf(-g)) * up * osc; }
                u32x2 w; w.x = pk4_fp8(o[0], o[1], o[2], o[3]); w.y = pk4_fp8(o[4], o[5], o[6], o[7]);
                *(u32x2*)rowp = w; }
    }
};
struct EpiResGate {
    static constexpr bool PERM = false, XBAR = false;
    const float* base; float* out; int ldc; const float* gate; int gstride;
    __device__ __forceinline__ void operator()(const f32x4 (&acc)[2][2][4][2], const Unit& u, int wr, int wc, int fr, int fq) const {
        const int row0 = u.pm * BM + wr * 64 + fr, col0 = u.pn * BM + wc * 32 + 4 * fq;
        const float* gp = gate + (size_t)((u.pm * BM) >> 11) * gstride + col0;
        f32x4 gv[2][2];
#pragma unroll
        for (int bj = 0; bj < 2; ++bj)
#pragma unroll
            for (int n = 0; n < 2; ++n) gv[bj][n] = *(const f32x4*)(gp + bj * HALF + n * 16);
#pragma unroll
        for (int ai = 0; ai < 2; ++ai)
#pragma unroll
            for (int m = 0; m < 4; ++m) { const size_t off = (size_t)(row0 + ai * HALF + m * 16) * ldc + col0;
#pragma unroll
                for (int bj = 0; bj < 2; ++bj)
#pragma unroll
                    for (int n = 0; n < 2; ++n) { const f32x4 bs = *(const f32x4*)(base + off + bj * HALF + n * 16);
                        *(f32x4*)(out + off + bj * HALF + n * 16) = bs + gv[bj][n] * acc[ai][bj][m][n]; }
                asm volatile("" ::: "memory"); }
    }
};
template <bool BASE16>
struct EpiResGate16 {
    static constexpr bool PERM = true, XBAR = false;
    const void* base; bf16_t* out; int ldc; const float* gate; int gstride; float sc = 1.0f;
    __device__ __forceinline__ void operator()(const f32x4 (&acc)[2][2][4][2], const Unit& u, int wr, int wc, int fr, int fq) const {
        const int row0 = u.pm * BM + wr * 64 + fr, col0 = u.pn * BM + wc * 32 + 8 * fq;
        const float* gp = gate + (size_t)((u.pm * BM) >> 11) * gstride + col0;
        f32x4 gv[2][2];
#pragma unroll
        for (int bj = 0; bj < 2; ++bj)
#pragma unroll
            for (int n = 0; n < 2; ++n) gv[bj][n] = *(const f32x4*)(gp + bj * HALF + 4 * n) * sc;
#pragma unroll
        for (int ai = 0; ai < 2; ++ai)
#pragma unroll
            for (int m = 0; m < 4; ++m) { const size_t off = (size_t)(row0 + ai * HALF + m * 16) * ldc + col0;
#pragma unroll
                for (int bj = 0; bj < 2; ++bj) { f32x4 b0, b1;
                    if (BASE16) { const u32x4 r = *(const u32x4*)((const bf16_t*)base + off + bj * HALF);
                        b0 = (f32x4){__uint_as_float(r.x << 16), __uint_as_float(r.x & 0xffff0000u), __uint_as_float(r.y << 16), __uint_as_float(r.y & 0xffff0000u)};
                        b1 = (f32x4){__uint_as_float(r.z << 16), __uint_as_float(r.z & 0xffff0000u), __uint_as_float(r.w << 16), __uint_as_float(r.w & 0xffff0000u)}; }
                    else { b0 = *(const f32x4*)((const float*)base + off + bj * HALF); b1 = *(const f32x4*)((const float*)base + off + bj * HALF + 4); }
                    const f32x4 v0 = b0 + gv[bj][0] * acc[ai][bj][m][0], v1 = b1 + gv[bj][1] * acc[ai][bj][m][1];
                    u32x4 w; w.x = cvt_pk_bf16(v0[0], v0[1]); w.y = cvt_pk_bf16(v0[2], v0[3]); w.z = cvt_pk_bf16(v1[0], v1[1]); w.w = cvt_pk_bf16(v1[2], v1[3]);
                    *(u32x4*)(out + off + bj * HALF) = w; }
                asm volatile("" ::: "memory"); }
    }
};
struct EpiF32 {
    static constexpr bool PERM = false, XBAR = false;
    float* C; int ldc; float sc;
    __device__ __forceinline__ void operator()(const f32x4 (&acc)[2][2][4][2], const Unit& u, int wr, int wc, int fr, int fq) const {
        const int row0 = u.pm * BM + wr * 64 + fr, col0 = u.pn * BM + wc * 32 + 4 * fq;
#pragma unroll
        for (int ai = 0; ai < 2; ++ai)
#pragma unroll
            for (int m = 0; m < 4; ++m) { float* rowp = C + (size_t)(row0 + ai * HALF + m * 16) * ldc + col0;
#pragma unroll
                for (int bj = 0; bj < 2; ++bj)
#pragma unroll
                    for (int n = 0; n < 2; ++n) *(f32x4*)(rowp + bj * HALF + n * 16) = acc[ai][bj][m][n] * sc; }
    }
};

template <class Epi, class Sched, bool F8 = false, int HOT = 0, int SCH = GEMM_SCH>
__device__ __forceinline__ void gemm_phase(LAS unsigned char* lds, const Gemm g, const Sched& S, const Epi& E) {
    int tid = threadIdx.x; asm volatile("" : "+v"(tid));
    const int wid = __builtin_amdgcn_readfirstlane(tid >> 6), lane = tid & 63, wr = wid >> 2, wc = wid & 3, fr = lane & 15, fq = lane >> 4;
    const int rowb = F8 ? g.K : 2 * g.K, nt = g.ntk ? g.ntk : rowb / (BK * 2);
    unsigned voffA[2], voffB[2];
#pragma unroll
    for (int i = 0; i < 2; ++i) { int R, C; stage_rc(tid * 16 + i * 8192, R, C); const int Rb = Epi::PERM ? ((R & ~31) + perm32(R & 31)) : R;
        voffA[i] = (unsigned)(R * rowb + C * 2); voffB[i] = (unsigned)(Rb * rowb + C * 2); }
    const size_t kstep = (size_t)(BK * 2);
    const size_t hstep = (size_t)HALF * rowb;
    const size_t tstep = 2 * hstep;
    const unsigned ldsw = (unsigned)wid * 1024u;
    const int aoff = lds_byte(wr * 64 + fr, fq * 8), boff = lds_byte(wc * 32 + fr, fq * 8);
#define PG8_SA(b, h) (((b) * 2 + (h)) * HTB)
#define PG8_SB(b, h) ((4 + (b) * 2 + (h)) * HTB)
#define PG8_STAGE(bufoff, gbase, voff) do { _Pragma("unroll") for (int _i = 0; _i < 2; ++_i) \
        __builtin_amdgcn_global_load_lds((const unsigned*)((const char*)(gbase) + (voff)[_i]), (LAS unsigned*)(lds + (bufoff) + ldsw + _i * 8192), 16, 0, 0); } while (0)
#define PG8_LD8(base_) __builtin_shufflevector(*(const LAS i32x4*)(base_), *(const LAS i32x4*)((base_) + 1024), 0, 1, 2, 3, 4, 5, 6, 7)
#define PG8_LDA(dst, b, h) do { _Pragma("unroll") for (int m = 0; m < 4; ++m) { if constexpr (F8) dst##8[m] = PG8_LD8(lds + PG8_SA(b, h) + aoff + m * 2048); \
        else { _Pragma("unroll") for (int k = 0; k < 2; ++k) dst[m][k] = *(const LAS bf16x8*)(lds + PG8_SA(b, h) + aoff + m * 2048 + k * 1024); } } } while (0)
#define PG8_LDB(dst, b, h) do { _Pragma("unroll") for (int n = 0; n < 2; ++n) { if constexpr (F8) dst##8[n] = PG8_LD8(lds + PG8_SB(b, h) + boff + n * 2048); \
        else { _Pragma("unroll") for (int k = 0; k < 2; ++k) dst[n][k] = *(const LAS bf16x8*)(lds + PG8_SB(b, h) + boff + n * 2048 + k * 1024); } } } while (0)
#define PG8_MMA(ai, bj, At, Bt) do { __builtin_amdgcn_s_setprio(1); _Pragma("unroll") for (int m = 0; m < 4; ++m) _Pragma("unroll") for (int n = 0; n < 2; ++n) { \
        if constexpr (F8) { asm volatile("v_mfma_f32_16x16x128_f8f6f4 %0, %1, %2, %0" : "+v"(acc[ai][bj][m][n]) : "v"(Bt##8[n]), "v"(At##8[m])); } \
        else { _Pragma("unroll") for (int k = 0; k < 2; ++k) acc[ai][bj][m][n] = __builtin_amdgcn_mfma_f32_16x16x32_bf16(Bt[n][k], At[m][k], acc[ai][bj][m][n], 0, 0, 0); } } \
        __builtin_amdgcn_s_setprio(0); } while (0)
#define PG8_WAIT_V(n) asm volatile("s_waitcnt vmcnt(" #n ")" ::: "memory")
#define PG8_WAIT_L(n) asm volatile("s_waitcnt lgkmcnt(" #n ")" ::: "memory")
#define PG8_BAR __builtin_amdgcn_s_barrier()
#define PG8_SCHED __builtin_amdgcn_sched_barrier(0)
    Unit cur, nxt; int ui = 0;
    if (!S.next(0, cur)) return;
    f32x4 acc[2][2][4][2];
#pragma unroll
    for (int a = 0; a < 2; ++a)
#pragma unroll
        for (int b = 0; b < 2; ++b)
#pragma unroll
            for (int m = 0; m < 4; ++m)
#pragma unroll
                for (int n = 0; n < 2; ++n) acc[a][b][m][n] = (f32x4){0.f, 0.f, 0.f, 0.f};
    bf16x8 At[4][2], B0[2][2], B1[2][2]; i32x8 At8[4], B08[2], B18[2];
    const char* cA = (const char*)g.A + cur.aoff + (size_t)(HOT ? 0 : cur.pm) * tstep; const char* cB = (const char*)g.Bt + cur.boff + (size_t)(HOT ? 0 : cur.pn) * tstep;
    if constexpr (SCH == 1) {
        PG8_STAGE(PG8_SB(0, 0), cB, voffB); PG8_STAGE(PG8_SB(0, 1), cB + hstep, voffB); PG8_STAGE(PG8_SA(0, 0), cA, voffA); PG8_STAGE(PG8_SA(0, 1), cA + hstep, voffA);
        if (wr == 1) PG8_BAR;
        PG8_WAIT_V(2); PG8_BAR;
        PG8_STAGE(PG8_SB(1, 0), cB + kstep, voffB); PG8_STAGE(PG8_SB(1, 1), cB + hstep + kstep, voffB); PG8_STAGE(PG8_SA(1, 0), cA + kstep, voffA);
        PG8_WAIT_V(6); PG8_BAR;
    } else {
    PG8_STAGE(PG8_SB(0, 0), cB, voffB); PG8_STAGE(PG8_SA(0, 0), cA, voffA); PG8_STAGE(PG8_SB(0, 1), cB + hstep, voffB); PG8_STAGE(PG8_SA(0, 1), cA + hstep, voffA);
    if (wr == 1) PG8_BAR;
    PG8_WAIT_V(4); PG8_BAR;
    PG8_STAGE(PG8_SB(1, 0), cB + kstep, voffB); PG8_STAGE(PG8_SA(1, 0), cA + kstep, voffA); PG8_STAGE(PG8_SB(1, 1), cB + hstep + kstep, voffB);
    PG8_WAIT_V(6); PG8_BAR;
    }
    for (;;) {
        const bool has_next = S.next(ui + 1, nxt);
        const char* nA = has_next ? (const char*)g.A + nxt.aoff + (size_t)(HOT ? 0 : nxt.pm) * tstep : cA; const char* nB = has_next ? (const char*)g.Bt + nxt.boff + (size_t)(HOT ? 0 : nxt.pn) * tstep : cB;
        for (int t = 0; t < nt; t += 2) {
            const bool last = (t == nt - 2);
            const char* a1 = cA + (size_t)(t + 1) * kstep;
            const char* a2 = last ? nA : cA + (size_t)(t + 2) * kstep; const char* b2 = last ? nB : cB + (size_t)(t + 2) * kstep;
            const char* a3 = a2 + kstep; const char* b3 = b2 + kstep;
            if constexpr (SCH == 1) {
                PG8_LDB(B0, 0, 0); PG8_LDB(B1, 0, 1); PG8_SCHED; PG8_LDA(At, 0, 0); PG8_STAGE(PG8_SA(1, 1), a1 + hstep, voffA);
                PG8_WAIT_V(8); PG8_WAIT_L(0); PG8_BAR; PG8_MMA(0, 0, At, B0); PG8_MMA(0, 1, At, B1); PG8_BAR; PG8_SCHED;
                PG8_LDA(At, 0, 1); PG8_STAGE(PG8_SB(0, 0), b2, voffB); PG8_STAGE(PG8_SB(0, 1), b2 + hstep, voffB); PG8_STAGE(PG8_SA(0, 0), a2, voffA);
                PG8_WAIT_V(8); PG8_WAIT_L(0); PG8_BAR; PG8_MMA(1, 0, At, B0); PG8_MMA(1, 1, At, B1); PG8_BAR; PG8_SCHED;
                PG8_LDB(B0, 1, 0); PG8_LDB(B1, 1, 1); PG8_SCHED; PG8_LDA(At, 1, 0); PG8_STAGE(PG8_SA(0, 1), a2 + hstep, voffA);
                PG8_WAIT_V(8); PG8_WAIT_L(0); PG8_BAR; PG8_MMA(0, 0, At, B0); PG8_MMA(0, 1, At, B1); PG8_BAR; PG8_SCHED;
                PG8_LDA(At, 1, 1); PG8_STAGE(PG8_SB(1, 0), b3, voffB); PG8_STAGE(PG8_SB(1, 1), b3 + hstep, voffB); PG8_STAGE(PG8_SA(1, 0), a3, voffA);
                PG8_WAIT_V(8); PG8_WAIT_L(0); PG8_BAR; PG8_MMA(1, 0, At, B0); PG8_MMA(1, 1, At, B1); PG8_BAR; PG8_SCHED;
                continue;
            }
            PG8_LDB(B0, 0, 0); PG8_SCHED; PG8_LDA(At, 0, 0); PG8_STAGE(PG8_SA(1, 1), a1 + hstep, voffA);
            PG8_WAIT_L(8); PG8_BAR; PG8_WAIT_L(0); PG8_MMA(0, 0, At, B0); PG8_BAR; PG8_SCHED;
            PG8_LDB(B1, 0, 1); PG8_STAGE(PG8_SB(0, 0), b2, voffB);
            PG8_BAR; PG8_WAIT_L(0); PG8_MMA(0, 1, At, B1); PG8_BAR;
            PG8_LDA(At, 0, 1); PG8_STAGE(PG8_SA(0, 0), a2, voffA);
            PG8_BAR; PG8_WAIT_L(0); PG8_MMA(1, 0, At, B0); PG8_BAR; PG8_SCHED;
            PG8_STAGE(PG8_SB(0, 1), b2 + hstep, voffB);
            PG8_WAIT_V(6); PG8_BAR; PG8_MMA(1, 1, At, B1); PG8_BAR;
            PG8_LDB(B0, 1, 0); PG8_SCHED; PG8_LDA(At, 1, 0); PG8_STAGE(PG8_SA(0, 1), a2 + hstep, voffA);
            PG8_WAIT_L(8); PG8_BAR; PG8_WAIT_L(0); PG8_MMA(0, 0, At, B0); PG8_BAR; PG8_SCHED;
            PG8_LDB(B1, 1, 1); PG8_STAGE(PG8_SB(1, 0), b3, voffB);
            PG8_BAR; PG8_WAIT_L(0); PG8_MMA(0, 1, At, B1); PG8_BAR;
            PG8_LDA(At, 1, 1); PG8_STAGE(PG8_SA(1, 0), a3, voffA);
            PG8_BAR; PG8_WAIT_L(0); PG8_MMA(1, 0, At, B0); PG8_BAR; PG8_SCHED;
            PG8_STAGE(PG8_SB(1, 1), b3 + hstep, voffB);
            PG8_WAIT_V(6); PG8_BAR; PG8_MMA(1, 1, At, B1); PG8_BAR;
        }
        if constexpr (F8) asm volatile("s_nop 15\n\ts_nop 15" ::: "memory");
        if constexpr (Epi::XBAR) { LAS float* P_ = (LAS float*)(lds + STAGE_BYTES); E.pre(acc, wr, wc, fr, fq, P_); PG8_WAIT_L(0); PG8_BAR; asm volatile("" ::: "memory"); E.post(acc, cur, wr, wc, fr, fq, P_); }
        else E(acc, cur, wr, wc, fr, fq);
        if (!has_next) break;
#pragma unroll
        for (int a = 0; a < 2; ++a)
#pragma unroll
            for (int b = 0; b < 2; ++b)
#pragma unroll
                for (int m = 0; m < 4; ++m)
#pragma unroll
                    for (int n = 0; n < 2; ++n) acc[a][b][m][n] = (f32x4){0.f, 0.f, 0.f, 0.f};
        cur = nxt; cA = nA; cB = nB; ++ui;
    }
    PG8_WAIT_V(0);
    if (wr == 0) PG8_BAR;
    PG8_BAR;
#undef PG8_SA
#undef PG8_SB
#undef PG8_STAGE
#undef PG8_LDA
#undef PG8_LDB
#undef PG8_MMA
#undef PG8_WAIT_V
#undef PG8_WAIT_L
#undef PG8_BAR
#undef PG8_SCHED
}
}

DI void mod_phase(const float* c, const float* mod_w, const float* mod_b, float* mod, LAS unsigned char* lds, int G, int tid, int lane, int wave) {
    LAS f32x4* cact = (LAS f32x4*)lds;
    LAS float* red = (LAS float*)(lds + 32768);
    for (int k = tid; k < DM; k += NTHREADS) { f32x4 v; v.x = silu_f(c[k]); v.y = silu_f(c[DM + k]); v.z = silu_f(c[2 * DM + k]); v.w = silu_f(c[3 * DM + k]); cact[k] = v; }
    __syncthreads();
    for (int it = blockIdx.x; it < 256; it += G) {
        const int l = it >> 7, n0 = (it & 127) * 96;
        float a0[4] = {0.f, 0.f, 0.f, 0.f}, a1[4] = {0.f, 0.f, 0.f, 0.f};
        if (lane < 48) {
            const float* wp = mod_w + ((size_t)l * DM + wave * 256) * 12288 + n0 + 2 * lane;
#pragma unroll 8
            for (int k = 0; k < 256; ++k) { const f32x2 w = *(const f32x2*)(wp + (size_t)k * 12288); const f32x4 cv = cact[wave * 256 + k];
                a0[0] += cv.x * w.x; a1[0] += cv.x * w.y; a0[1] += cv.y * w.x; a1[1] += cv.y * w.y; a0[2] += cv.z * w.x; a1[2] += cv.z * w.y; a0[3] += cv.w * w.x; a1[3] += cv.w * w.y; }
#pragma unroll
            for (int b = 0; b < 4; ++b) { red[(wave * 4 + b) * 96 + 2 * lane] = a0[b]; red[(wave * 4 + b) * 96 + 2 * lane + 1] = a1[b]; }
        }
        __syncthreads();
        if (tid < 384) { const int b = tid / 96, col = tid % 96; float s = mod_b[l * 12288 + n0 + col];
#pragma unroll
            for (int w = 0; w < 8; ++w) s += red[(w * 4 + b) * 96 + col];
            mod[((size_t)l * 4 + b) * 12288 + n0 + col] = s; }
        __syncthreads();
    }
}

template <int MODE>
DI void cvt_item(const float* W, int K, int N, bf16_t* WT, LAS float* scr, int kb, int nb, int lane) {
    const int k0 = 64 * kb, n0 = 32 * nb;
    float v[32];
    const float* wp = W + (size_t)(k0 + (lane >> 5)) * N + n0 + (lane & 31);
#pragma unroll
    for (int i = 0; i < 32; ++i) v[i] = wp[(size_t)(2 * i) * N];
#pragma unroll
    for (int i = 0; i < 32; ++i) scr[(2 * i + (lane >> 5)) * 33 + (lane & 31)] = v[i];
    LDS_WAIT();
    const int c = lane & 7;
#pragma unroll
    for (int j = 0; j < 4; ++j) { const int n = (lane >> 3) + 8 * j; const LAS float* s = scr + (8 * c) * 33 + n;
        u32x4 o; o.x = cvt_pk_bf16(s[0 * 33], s[1 * 33]); o.y = cvt_pk_bf16(s[2 * 33], s[3 * 33]); o.z = cvt_pk_bf16(s[4 * 33], s[5 * 33]); o.w = cvt_pk_bf16(s[6 * 33], s[7 * 33]);
        const int ng = n0 + n; const int row = (MODE == 0) ? ng : ((ng >> 7) * 256 + (ng & 127) + (MODE == 2 ? 128 : 0));
        *(u32x4*)(WT + (size_t)row * K + k0 + 8 * c) = o; }
    LDS_WAIT();
}
template <int MODE>
DI void cvt_item8(const float* W, int K, int N, unsigned char* WT, LAS float* scr, int kb, int nb, int lane, float wsc) {
    const int k0 = 64 * kb, n0 = 32 * nb;
    float v[32];
    const float* wp = W + (size_t)(k0 + (lane >> 5)) * N + n0 + (lane & 31);
#pragma unroll
    for (int i = 0; i < 32; ++i) v[i] = wp[(size_t)(2 * i) * N];
#pragma unroll
    for (int i = 0; i < 32; ++i) scr[(2 * i + (lane >> 5)) * 33 + (lane & 31)] = v[i] * wsc;
    LDS_WAIT();
    const int c = lane & 3;
#pragma unroll
    for (int j = 0; j < 2; ++j) { const int n = (lane >> 2) + 16 * j; const LAS float* s = scr + (16 * c) * 33 + n;
        u32x4 o; o.x = pk4_fp8(s[0 * 33], s[1 * 33], s[2 * 33], s[3 * 33]); o.y = pk4_fp8(s[4 * 33], s[5 * 33], s[6 * 33], s[7 * 33]);
        o.z = pk4_fp8(s[8 * 33], s[9 * 33], s[10 * 33], s[11 * 33]); o.w = pk4_fp8(s[12 * 33], s[13 * 33], s[14 * 33], s[15 * 33]);
        const int ng = n0 + n; const int row = (MODE == 0) ? ng : ((ng >> 7) * 256 + (ng & 127) + (MODE == 2 ? 128 : 0));
        *(u32x4*)(WT + (size_t)row * K + k0 + 16 * c) = o; }
    LDS_WAIT();
}
template <int MODE>
DI void cvt_job8(const float* W, int K, int N, int nbatch, unsigned char* WT, size_t dst_bstride, LAS float* scr, int gw, int NGW, int lane, float wsc) {
    const int nnb = N / 32, per = (K / 64) * nnb, total = per * nbatch;
    for (int it = gw; it < total; it += NGW) {
        const int bt = it / per, r = it - bt * per, kb = r / nnb, nb = r - kb * nnb;
        cvt_item8<MODE>(W + (size_t)bt * K * N, K, N, WT + (size_t)bt * dst_bstride, scr, kb, nb, lane, wsc);
    }
}
template <int MODE>
DI void cvt_job(const float* W, int K, int N, int nbatch, bf16_t* WT, size_t dst_bstride, LAS float* scr, int gw, int NGW, int lane) {
    const int nnb = N / 32, per = (K / 64) * nnb, total = per * nbatch;
    for (int it = gw; it < total; it += NGW) {
        const int bt = it / per, r = it - bt * per, kb = r / nnb, nb = r - kb * nnb;
        cvt_item<MODE>(W + (size_t)bt * K * N, K, N, WT + (size_t)bt * dst_bstride, scr, kb, nb, lane);
    }
}

DI void cvtw_load(f32x4 (&v)[16], const float* wp, int N) {
#pragma unroll
    for (int i = 0; i < 16; ++i) v[i] = __builtin_nontemporal_load((const f32x4*)(wp + (size_t)(4 * i) * N));
}
template <int MODE, bool OUT8>
DI void cvtw_store(const f32x4 (&v)[16], int K, void* WTb, LAS float* scr, int k0, int n0, int lane, float wsc) {
    const int kr = lane >> 4, n4 = lane & 15;
#pragma unroll
    for (int i = 0; i < 16; ++i)
#pragma unroll
        for (int e = 0; e < 4; ++e) scr[(4 * n4 + e) * 65 + 4 * i + kr] = OUT8 ? v[i][e] * wsc : v[i][e];
    LDS_WAIT();
    if (OUT8) {
        unsigned char* WT = (unsigned char*)WTb; const int c = lane & 3;
#pragma unroll
        for (int j = 0; j < 4; ++j) { const int n = (lane >> 2) + 16 * j; const LAS float* s = scr + n * 65 + 16 * c;
            u32x4 o; o.x = pk4_fp8(s[0], s[1], s[2], s[3]); o.y = pk4_fp8(s[4], s[5], s[6], s[7]); o.z = pk4_fp8(s[8], s[9], s[10], s[11]); o.w = pk4_fp8(s[12], s[13], s[14], s[15]);
            const int ng = n0 + n; const int row = (MODE == 0) ? ng : ((ng >> 7) * 256 + (ng & 127) + (MODE == 2 ? 128 : 0));
            *(u32x4*)(WT + (size_t)row * K + k0 + 16 * c) = o; }
    } else {
        bf16_t* WT = (bf16_t*)WTb; const int c = lane & 7;
#pragma unroll
        for (int j = 0; j < 8; ++j) { const int n = (lane >> 3) + 8 * j; const LAS float* s = scr + n * 65 + 8 * c;
            u32x4 o; o.x = cvt_pk_bf16(s[0], s[1]); o.y = cvt_pk_bf16(s[2], s[3]); o.z = cvt_pk_bf16(s[4], s[5]); o.w = cvt_pk_bf16(s[6], s[7]);
            const int ng = n0 + n; const int row = (MODE == 0) ? ng : ((ng >> 7) * 256 + (ng & 127) + (MODE == 2 ? 128 : 0));
            *(u32x4*)(WT + (size_t)row * K + k0 + 8 * c) = o; }
    }
    LDS_WAIT();
}
DI void cvtw_pack8(const f32x4 (&v)[16], LAS float* scr, int lane, float wsc, u32x4 (&o)[4]) {
    const int kr = lane >> 4, n4 = lane & 15;
#pragma unroll
    for (int i = 0; i < 16; ++i)
#pragma unroll
        for (int e = 0; e < 4; ++e) scr[(4 * n4 + e) * 65 + 4 * i + kr] = v[i][e] * wsc;
    LDS_WAIT();
    const int c = lane & 3;
#pragma unroll
    for (int j = 0; j < 4; ++j) { const int n = (lane >> 2) + 16 * j; const LAS float* s = scr + n * 65 + 16 * c;
        o[j].x = pk4_fp8(s[0], s[1], s[2], s[3]); o[j].y = pk4_fp8(s[4], s[5], s[6], s[7]); o[j].z = pk4_fp8(s[8], s[9], s[10], s[11]); o[j].w = pk4_fp8(s[12], s[13], s[14], s[15]); }
    LDS_WAIT();
}
template <int MODE, bool OUT8>
DI void cvtw_job(const float* W, int K, int N, int nbatch, void* WT, size_t dst_bstride_bytes, LAS float* scr, int gw, int NGW, int lane, float wsc, int ld = 0, int off = 0) {
    const int nnb = N / 64, per = (K / 128) * nnb, total = per * nbatch;
    const int pitch = ld ? ld : N;
    const int first = (gw + NGW - (off % NGW)) % NGW;
    if (first >= total) return;
#define CVTW_SRC(it_) ({ const int bt_ = (it_) / per, r_ = (it_) - bt_ * per, kb_ = r_ / nnb, nb_ = r_ - kb_ * nnb; W + (size_t)bt_ * K * pitch + (size_t)(128 * kb_ + (lane >> 4)) * pitch + 64 * nb_ + 4 * (lane & 15); })
    for (int it = first; it < total; it += NGW) {
        const int bt = it / per, r = it - bt * per, kb = r / nnb, nb = r - kb * nnb, k0 = 128 * kb, n0 = 64 * nb;
        f32x4 v0[16], v1[16];
        { const float* wp = CVTW_SRC(it); cvtw_load(v0, wp, pitch); cvtw_load(v1, wp + (size_t)64 * pitch, pitch); }
        void* WTb = (unsigned char*)WT + (size_t)bt * dst_bstride_bytes;
        if (OUT8) {
            u32x4 o0[4], o1[4];
            cvtw_pack8(v0, scr, lane, wsc, o0);
            cvtw_pack8(v1, scr, lane, wsc, o1);
            unsigned char* WT8 = (unsigned char*)WTb; const int c = lane & 3;
#pragma unroll
            for (int j = 0; j < 4; ++j) { const int ng = n0 + (lane >> 2) + 16 * j; const int row = (MODE == 0) ? ng : ((ng >> 7) * 256 + (ng & 127) + (MODE == 2 ? 128 : 0));
                unsigned char* dp = WT8 + (size_t)row * K + k0 + 16 * c; *(u32x4*)dp = o0[j]; *(u32x4*)(dp + 64) = o1[j]; }
        } else {
            cvtw_store<MODE, OUT8>(v0, K, WTb, scr, k0, n0, lane, wsc);
            cvtw_store<MODE, OUT8>(v1, K, WTb, scr, k0 + 64, n0, lane, wsc);
        }
    }
#undef CVTW_SRC
}

constexpr float HSCALE = 8.f, WSCALE = 256.f, ASCALE = 8.f;
template <bool ROUTER, bool OUT8 = false, bool X16 = false>
DI void rms_mod_phase(const void* X, const float* g, const float* scale, const float* shift, bf16_t* out,
                      const float* router, int* tok_e, int* tok_pos, float* tok_w, unsigned* ecnt, unsigned char* HS2, int gw, int NGW, int lane) {
    for (int row = gw; row < MTOK; row += NGW) {
        const int b = row >> 11;
        f32x4 v[8]; float ss = 0.f;
        if (X16) { const u32x2* xr = (const u32x2*)((const bf16_t*)X + (size_t)row * DM) + lane; u32x2 raw[8];
#pragma unroll
            for (int j = 0; j < 8; ++j) raw[j] = xr[64 * j];
#pragma unroll
            for (int j = 0; j < 8; ++j) v[j] = (f32x4){bf_lo(raw[j].x), bf_hi(raw[j].x), bf_lo(raw[j].y), bf_hi(raw[j].y)}; }
        else { const f32x4* xr = (const f32x4*)((const float*)X + (size_t)row * DM) + lane;
#pragma unroll
            for (int j = 0; j < 8; ++j) v[j] = xr[64 * j]; }
#pragma unroll
        for (int j = 0; j < 8; ++j) ss += (v[j].x * v[j].x + v[j].y * v[j].y) + (v[j].z * v[j].z + v[j].w * v[j].w);
        const float rstd = 1.0f / sqrtf(wave_sum(ss) * (1.f / DM) + 1e-6f);
        const f32x4* gp = (const f32x4*)g + lane; const f32x4* sc = (const f32x4*)(scale + (size_t)b * 12288) + lane; const f32x4* sh = (const f32x4*)(shift + (size_t)b * 12288) + lane;
        u32x2* op = (u32x2*)(out + (size_t)row * DM) + lane;
        float lg[8] = {0.f, 0.f, 0.f, 0.f, 0.f, 0.f, 0.f, 0.f}; unsigned h8[8];
#pragma unroll
        for (int j = 0; j < 8; ++j) { const f32x4 gg = gp[64 * j], s1 = sc[64 * j], s2 = sh[64 * j];
            f32x4 h = (v[j] * rstd) * gg; h = h * (s1 + 1.0f) + s2;
            if (ROUTER) { h8[j] = pk4_fp8(h.x * HSCALE, h.y * HSCALE, h.z * HSCALE, h.w * HSCALE); }
            else { u32x2 w; w.x = cvt_pk_bf16(h.x, h.y); w.y = cvt_pk_bf16(h.z, h.w); op[64 * j] = w;
                   if (OUT8) ((unsigned*)(HS2 + (size_t)row * DM) + lane)[64 * j] = pk4_fp8(h.x * HSCALE, h.y * HSCALE, h.z * HSCALE, h.w * HSCALE); }
            if (ROUTER) {
#pragma unroll
                for (int i = 0; i < 4; ++i) { const int cc = 256 * j + 4 * lane + i; const f32x4 r0 = ((const f32x4*)router)[cc * 2], r1 = ((const f32x4*)router)[cc * 2 + 1];
                    lg[0] += h[i] * r0.x; lg[1] += h[i] * r0.y; lg[2] += h[i] * r0.z; lg[3] += h[i] * r0.w; lg[4] += h[i] * r1.x; lg[5] += h[i] * r1.y; lg[6] += h[i] * r1.z; lg[7] += h[i] * r1.w; } } }
        if (ROUTER) {
#pragma unroll
            for (int e = 0; e < 8; ++e) lg[e] = wave_sum(lg[e]);
            if (lane == 0) {
                int i0 = 0; float v0 = lg[0];
#pragma unroll
                for (int e = 1; e < 8; ++e) if (lg[e] > v0) { v0 = lg[e]; i0 = e; }
                int i1 = -1; float v1 = -3.0e38f;
#pragma unroll
                for (int e = 0; e < 8; ++e) if (e != i0 && lg[e] > v1) { v1 = lg[e]; i1 = e; }
                const float w1 = 1.f / (1.f + expf(v0 - v1)), w0 = 1.f - w1;
                const int p0 = (int)__hip_atomic_fetch_add(ecnt + 64 * i0, 1u, __ATOMIC_RELAXED, __HIP_MEMORY_SCOPE_AGENT);
                const int p1 = (int)__hip_atomic_fetch_add(ecnt + 64 * i1, 1u, __ATOMIC_RELAXED, __HIP_MEMORY_SCOPE_AGENT);
                tok_e[2 * row] = i0; tok_e[2 * row + 1] = i1; tok_pos[2 * row] = p0; tok_pos[2 * row + 1] = p1; tok_w[2 * row] = w0; tok_w[2 * row + 1] = w1;
                lg[0] = __int_as_float(i0 * pg8::ECAP + p0); lg[1] = __int_as_float(i1 * pg8::ECAP + p1);
            }
            const int ra = __builtin_amdgcn_readfirstlane(__float_as_int(lg[0])), rb = __builtin_amdgcn_readfirstlane(__float_as_int(lg[1]));
            unsigned* da = (unsigned*)(HS2 + (size_t)ra * DM) + lane; unsigned* db = (unsigned*)(HS2 + (size_t)rb * DM) + lane;
#pragma unroll
            for (int j = 0; j < 8; ++j) { da[64 * j] = h8[j]; db[64 * j] = h8[j]; }
        }
    }
}

DI void qknorm_phase(const bf16_t* QK, bf16_t* QKN, const float* qg, const float* kg, int gw, int NGW, int lane) {
    const int l16 = lane & 15;
    for (int idx = gw * 4 + (lane >> 4); idx < MTOK * 32; idx += NGW * 4) {
        const int hr = idx & 31; const size_t off = (size_t)(idx >> 5) * 4096 + hr * 128 + 8 * l16;
        const u32x4 raw = *(const u32x4*)(QK + off);
        float x[8] = {bf_lo(raw.x), bf_hi(raw.x), bf_lo(raw.y), bf_hi(raw.y), bf_lo(raw.z), bf_hi(raw.z), bf_lo(raw.w), bf_hi(raw.w)};
        float ss = 0.f;
#pragma unroll
        for (int i = 0; i < 8; ++i) ss += x[i] * x[i];
        ss += __shfl_xor(ss, 1); ss += __shfl_xor(ss, 2); ss += __shfl_xor(ss, 4); ss += __shfl_xor(ss, 8);
        const float rstd = (1.0f / sqrtf(ss * (1.f / 128.f) + 1e-6f)) * (hr < 16 ? 0.08838834764831845f : 1.0f);
        const float* gp = (hr < 16 ? qg : kg) + 8 * l16;
        const f32x4 g0 = *(const f32x4*)gp, g1 = *(const f32x4*)(gp + 4);
        u32x4 o; o.x = cvt_pk_bf16(x[0] * rstd * g0.x, x[1] * rstd * g0.y); o.y = cvt_pk_bf16(x[2] * rstd * g0.z, x[3] * rstd * g0.w);
        o.z = cvt_pk_bf16(x[4] * rstd * g1.x, x[5] * rstd * g1.y); o.w = cvt_pk_bf16(x[6] * rstd * g1.z, x[7] * rstd * g1.w);
        *(u32x4*)(QKN + off) = o;
    }
}

constexpr int NA_TBL = 0, NA_BUF = 30720, NA_TILE = 18432;
DI void na_phase(const bf16_t* QKN, const bf16_t* VT, bf16_t* ATT, const float* rpb, LAS unsigned char* lds, int G, int vcu0, int tid, int lane, int wave) {
    LAS float* rpbL = (LAS float*)(lds + NA_TBL);
    for (int i = tid; i < 16 * 465; i += NTHREADS) rpbL[i] = rpb[i];
    const int c16 = lane & 15, g = lane >> 4, unit = wave >> 2, j = wave & 3;
    const int cb = (j == 0) ? 0 : (j == 1) ? 8 : (j == 2) ? 24 : 32;
    const int qc = 16 * j + c16, c0 = min(max(qc - 8, 0), 48);
    const int kcl = 8 * (c16 >> 2) + (c16 & 3);
    for (int p = vcu0; p < 1024; p += G) {
        const int rho = p & 15, hh = (p >> 4) & 15, b = p >> 8;
        const int rA = 2 * rho, r0A = min(max(rA - 4, 0), 24), r0B = min(max(rA + 1 - 4, 0), 24), delta = r0B - r0A, nrows = 8 + delta;
        const int r = rA + unit, r0 = unit ? r0B : r0A;
        const bool shiftB = (unit == 1) && (delta == 1);
        const size_t tq = (size_t)b * SEQ + r * 64 + qc;
        bf16x8 qf[4];
#pragma unroll
        for (int ks = 0; ks < 4; ++ks) qf[ks] = *(const bf16x8*)(QKN + tq * 4096 + hh * 128 + 32 * ks + 8 * g);
        f32x4 S[8][2];
        u32x4 st0, st1;
        const int kkey = tid >> 3, kch = tid & 7;
        const int vd = tid >> 2, vch = tid & 3;
        const bf16_t* kg = QKN + ((size_t)b * SEQ + (size_t)r0A * 64 + kkey) * 4096 + 2048 + hh * 128 + kch * 8;
        const bf16_t* vg = VT + (size_t)(hh * 128 + vd) * MTOK + (size_t)b * SEQ + (size_t)r0A * 64 + vch * 8;
#define NA_LDK(s_) do { st0 = *(const u32x4*)(kg + (size_t)(s_) * 64 * 4096); st1 = *(const u32x4*)(kg + (size_t)(s_) * 64 * 4096 + 64); } while (0)
#define NA_STK(s_) do { LAS unsigned char* t_ = lds + NA_BUF + ((s_) & 1) * NA_TILE + kkey * 272 + kch * 16; *(LAS u32x4*)t_ = st0; *(LAS u32x4*)(t_ + 128) = st1; } while (0)
#define NA_LDV(s_) do { st0 = *(const u32x4*)(vg + (s_) * 64); st1 = *(const u32x4*)(vg + (s_) * 64 + 32); } while (0)
#define NA_STV(s_) do { LAS unsigned char* t_ = lds + NA_BUF + ((s_) & 1) * NA_TILE + vd * 144 + vch * 16; *(LAS u32x4*)t_ = st0; *(LAS u32x4*)(t_ + 64) = st1; } while (0)
#define NA_QK(s_, i_) do { const LAS unsigned char* kb_ = lds + NA_BUF + ((s_) & 1) * NA_TILE + (cb + kcl) * 272 + 16 * g; \
            _Pragma("unroll") for (int hc = 0; hc < 2; ++hc) { f32x4 a = (f32x4){0.f, 0.f, 0.f, 0.f}; \
                _Pragma("unroll") for (int ks = 0; ks < 4; ++ks) a = __builtin_amdgcn_mfma_f32_16x16x32_bf16(*(const LAS bf16x8*)(kb_ + hc * 4 * 272 + 64 * ks), qf[ks], a, 0, 0, 0); S[i_][hc] = a; } } while (0)
#define NA_SROW(s_) do { if ((s_) < nrows) { NA_STK(s_); __syncthreads(); if ((s_) + 1 < nrows) NA_LDK((s_) + 1); \
            if (!shiftB) { if ((s_) < 8) NA_QK(s_, (s_) < 8 ? (s_) : 7); } else { if ((s_) >= 1) NA_QK(s_, (s_) >= 1 ? (s_) - 1 : 0); } } } while (0)
        __syncthreads();
        NA_LDK(0);
        NA_SROW(0); NA_SROW(1); NA_SROW(2); NA_SROW(3); NA_SROW(4); NA_SROW(5); NA_SROW(6); NA_SROW(7); NA_SROW(8);
        NA_LDV(0);
        float mx = -3.0e38f;
        const LAS float* bt = rpbL + hh * 465;
#pragma unroll
        for (int i = 0; i < 8; ++i)
#pragma unroll
            for (int hc = 0; hc < 2; ++hc)
#pragma unroll
                for (int e = 0; e < 4; ++e) {
                    const int kc = cb + 8 * g + 4 * hc + e; const bool valid = (kc >= c0) && (kc < c0 + 16);
                    const int dj = min(max(kc - qc + 15, 0), 30), di = r0 + i - r + 7;
                    const float sv = valid ? S[i][hc][e] + bt[di * 31 + dj] : -3.0e38f;
                    S[i][hc][e] = sv; mx = fmaxf(mx, sv);
                }
        mx = fmaxf(mx, __shfl_xor(mx, 16)); mx = fmaxf(mx, __shfl_xor(mx, 32));
        float sum = 0.f;
#pragma unroll
        for (int i = 0; i < 8; ++i)
#pragma unroll
            for (int hc = 0; hc < 2; ++hc)
#pragma unroll
                for (int e = 0; e < 4; ++e) { const float pv = (S[i][hc][e] > -1.0e38f) ? __expf(S[i][hc][e] - mx) : 0.f; S[i][hc][e] = pv; sum += pv; }
        sum += __shfl_xor(sum, 16); sum += __shfl_xor(sum, 32);
        const float inv = 1.0f / sum;
        f32x4 O[8];
#pragma unroll
        for (int dt = 0; dt < 8; ++dt) O[dt] = (f32x4){0.f, 0.f, 0.f, 0.f};
#define NA_PV(s_, i_) do { u32x4 pw; pw.x = cvt_pk_bf16(S[i_][0][0], S[i_][0][1]); pw.y = cvt_pk_bf16(S[i_][0][2], S[i_][0][3]); pw.z = cvt_pk_bf16(S[i_][1][0], S[i_][1][1]); pw.w = cvt_pk_bf16(S[i_][1][2], S[i_][1][3]); \
            const bf16x8 pf = __builtin_bit_cast(bf16x8, pw); const LAS unsigned char* vb_ = lds + NA_BUF + ((s_) & 1) * NA_TILE + c16 * 144 + (cb + 8 * g) * 2; \
            _Pragma("unroll") for (int dt = 0; dt < 8; ++dt) O[dt] = __builtin_amdgcn_mfma_f32_16x16x32_bf16(*(const LAS bf16x8*)(vb_ + dt * 16 * 144), pf, O[dt], 0, 0, 0); } while (0)
#define NA_VROW(s_) do { if ((s_) < nrows) { NA_STV(s_); __syncthreads(); if ((s_) + 1 < nrows) NA_LDV((s_) + 1); \
            if (!shiftB) { if ((s_) < 8) NA_PV(s_, (s_) < 8 ? (s_) : 7); } else { if ((s_) >= 1) NA_PV(s_, (s_) >= 1 ? (s_) - 1 : 0); } } } while (0)
        __syncthreads();
        NA_VROW(0); NA_VROW(1); NA_VROW(2); NA_VROW(3); NA_VROW(4); NA_VROW(5); NA_VROW(6); NA_VROW(7); NA_VROW(8);
#undef NA_LDK
#undef NA_STK
#undef NA_LDV
#undef NA_STV
#undef NA_QK
#undef NA_SROW
#undef NA_PV
#undef NA_VROW
#pragma unroll
        for (int dt = 0; dt < 8; ++dt) { u32x2 w; w.x = cvt_pk_bf16(O[dt][0] * inv, O[dt][1] * inv); w.y = cvt_pk_bf16(O[dt][2] * inv, O[dt][3] * inv);
            *(u32x2*)(ATT + tq * DM + hh * 128 + 16 * dt + 4 * g) = w; }
    }
}

constexpr int MLP_WIF = 36864, MLP_WROW = 3088;
DI void ml_pre_phase(const bf16_t* XZ, const float* conv_w, const float* conv_b, const float* wq, const float* wk, const float* wv, const bf16_t* WTif,
                     bf16_t* XC, bf16_t* Q, bf16_t* Kb, bf16_t* V, float* pre_part, LAS unsigned char* lds, int G, int tid, int lane, int wave) {
    LAS float* Lcw = (LAS float*)lds;
    LAS float* Lcb = Lcw + 2560;
    LAS float* Lwq = Lcb + 512;
    LAS float* Lwk = Lwq + 2048;
    LAS float* Lwv = Lwk + 2048;
    LAS unsigned char* Lwif = lds + MLP_WIF;
    const int g = lane >> 4, tk = lane & 15;
    for (int item = blockIdx.x; item < 256; item += G) {
        const int hd = item & 7, tr = item >> 3;
        __syncthreads();
        for (int i = tid; i < 2560; i += NTHREADS) Lcw[i] = conv_w[(i >> 9) * 4096 + hd * 512 + (i & 511)];
        Lcb[tid] = conv_b[hd * 512 + tid];
        for (int i = tid; i < 2048; i += NTHREADS) { Lwq[i] = wq[hd * 2048 + i]; Lwk[i] = wk[hd * 2048 + i]; Lwv[i] = wv[hd * 2048 + i]; }
        for (int i = tid; i < 32 * 3 * 64; i += NTHREADS) { const int n = i / 192, rem = i - n * 192, sec = rem >> 6, c16 = rem & 63;
            *(LAS u32x4*)(Lwif + n * MLP_WROW + sec * 1024 + c16 * 16) = *(const u32x4*)(WTif + (size_t)n * 12288 + sec * 4096 + hd * 512 + c16 * 8); }
        __syncthreads();
        for (int tt = wave; tt < 16; tt += 8) {
            const int tok = tr * 256 + tt * 16 + tk, tseq = tok & 2047;
            f32x4 accp[2]; accp[0] = (f32x4){0.f, 0.f, 0.f, 0.f}; accp[1] = (f32x4){0.f, 0.f, 0.f, 0.f};
            u32x4 xrA[5], xrB[5], hq, hk, hv, hc;
#define MLP_LOAD(xr_, step_) do { const int ch_ = hd * 512 + (step_) * 32 + 8 * g; \
                _Pragma("unroll") for (int jt = 0; jt < 5; ++jt) { const int dt = jt - 2; const bool ok = (unsigned)(tseq + dt) < (unsigned)SEQ; \
                    xr_[jt] = (u32x4){0u, 0u, 0u, 0u}; if (ok) xr_[jt] = *(const u32x4*)(XZ + (size_t)(tok + dt) * 8192 + ch_); } } while (0)
#define MLP_COMPUTE(xr_, step_, HOLD_) do { \
                const int cl = (step_) * 32 + 8 * g, ch = hd * 512 + cl; \
                float a[8], xm[8]; \
                { const f32x4 b0 = *(const LAS f32x4*)(Lcb + cl), b1 = *(const LAS f32x4*)(Lcb + cl + 4); \
                  a[0] = b0.x; a[1] = b0.y; a[2] = b0.z; a[3] = b0.w; a[4] = b1.x; a[5] = b1.y; a[6] = b1.z; a[7] = b1.w; } \
                _Pragma("unroll") for (int jt = 0; jt < 5; ++jt) { \
                    const u32x4 xr = xr_[jt]; \
                    const float xv[8] = {bf_lo(xr.x), bf_hi(xr.x), bf_lo(xr.y), bf_hi(xr.y), bf_lo(xr.z), bf_hi(xr.z), bf_lo(xr.w), bf_hi(xr.w)}; \
                    const f32x4 w0 = *(const LAS f32x4*)(Lcw + jt * 512 + cl), w1 = *(const LAS f32x4*)(Lcw + jt * 512 + cl + 4); \
                    a[0] += xv[0] * w0.x; a[1] += xv[1] * w0.y; a[2] += xv[2] * w0.z; a[3] += xv[3] * w0.w; a[4] += xv[4] * w1.x; a[5] += xv[5] * w1.y; a[6] += xv[6] * w1.z; a[7] += xv[7] * w1.w; \
                    if (jt == 2) { _Pragma("unroll") for (int i = 0; i < 8; ++i) xm[i] = xv[i]; } } \
                float xc[8], q[8], k[8], v[8]; \
                _Pragma("unroll") for (int i = 0; i < 8; ++i) xc[i] = silu_f(a[i]); \
                _Pragma("unroll") for (int blk = 0; blk < 2; ++blk) { const int wo = ((cl >> 2) + blk) * 16; \
                    _Pragma("unroll") for (int o = 0; o < 4; ++o) { float sq = 0.f, sk = 0.f, sv = 0.f; \
                        _Pragma("unroll") for (int i = 0; i < 4; ++i) { sq += xc[4 * blk + i] * Lwq[wo + i * 4 + o]; sk += xc[4 * blk + i] * Lwk[wo + i * 4 + o]; sv += xm[4 * blk + i] * Lwv[wo + i * 4 + o]; } \
                        q[4 * blk + o] = sq; k[4 * blk + o] = sk; v[4 * blk + o] = sv; } } \
                u32x4 qw, kw, vw, cw; \
                qw.x = cvt_pk_bf16(q[0], q[1]); qw.y = cvt_pk_bf16(q[2], q[3]); qw.z = cvt_pk_bf16(q[4], q[5]); qw.w = cvt_pk_bf16(q[6], q[7]); \
                kw.x = cvt_pk_bf16(k[0], k[1]); kw.y = cvt_pk_bf16(k[2], k[3]); kw.z = cvt_pk_bf16(k[4], k[5]); kw.w = cvt_pk_bf16(k[6], k[7]); \
                vw.x = cvt_pk_bf16(v[0], v[1]); vw.y = cvt_pk_bf16(v[2], v[3]); vw.z = cvt_pk_bf16(v[4], v[5]); vw.w = cvt_pk_bf16(v[6], v[7]); \
                cw.x = cvt_pk_bf16(xc[0], xc[1]); cw.y = cvt_pk_bf16(xc[2], xc[3]); cw.z = cvt_pk_bf16(xc[4], xc[5]); cw.w = cvt_pk_bf16(xc[6], xc[7]); \
                const size_t o4 = (size_t)tok * 4096 + ch; \
                if (HOLD_) { hq = qw; hk = kw; hv = vw; hc = cw; }     \
                else { *(u32x4*)(Q + o4 - 32) = hq; *(u32x4*)(Q + o4) = qw; *(u32x4*)(Kb + o4 - 32) = hk; *(u32x4*)(Kb + o4) = kw; *(u32x4*)(V + o4 - 32) = hv; *(u32x4*)(V + o4) = vw; *(u32x4*)(XC + o4 - 32) = hc; *(u32x4*)(XC + o4) = cw; } \
                const bf16x8 qf = __builtin_bit_cast(bf16x8, qw), kf = __builtin_bit_cast(bf16x8, kw), vf = __builtin_bit_cast(bf16x8, vw); \
                _Pragma("unroll") for (int nt = 0; nt < 2; ++nt) { const LAS unsigned char* wp = Lwif + (nt * 16 + tk) * MLP_WROW + cl * 2; \
                    accp[nt] = __builtin_amdgcn_mfma_f32_16x16x32_bf16(qf, *(const LAS bf16x8*)(wp), accp[nt], 0, 0, 0); \
                    accp[nt] = __builtin_amdgcn_mfma_f32_16x16x32_bf16(kf, *(const LAS bf16x8*)(wp + 1024), accp[nt], 0, 0, 0); \
                    accp[nt] = __builtin_amdgcn_mfma_f32_16x16x32_bf16(vf, *(const LAS bf16x8*)(wp + 2048), accp[nt], 0, 0, 0); } } while (0)
            MLP_LOAD(xrA, 0);
#pragma unroll 1
            for (int step = 0; step < 16; step += 2) {
                MLP_LOAD(xrB, step + 1);
                MLP_COMPUTE(xrA, step, true);
                { const int sn = (step + 2 < 16) ? step + 2 : 15; MLP_LOAD(xrA, sn); }
                MLP_COMPUTE(xrB, step + 1, false);
            }
#undef MLP_LOAD
#undef MLP_COMPUTE
#pragma unroll
            for (int nt = 0; nt < 2; ++nt)
#pragma unroll
                for (int e = 0; e < 4; ++e) pre_part[((size_t)hd * 32 + nt * 16 + tk) * MTOK + tr * 256 + tt * 16 + 4 * g + e] = accp[nt][e];
        }
    }
}

constexpr int ML_QS0 = 0, ML_KS0 = 16384, ML_QS1 = 32768, ML_KS1 = 49152, ML_VS0 = 65536, ML_VS1 = 81920, ML_WV = 98304, ML_SS = 114688, ML_SM = 123904;
constexpr int ML_XS = ML_QS1, ML_XN = ML_QS1;
constexpr int GB_U = 0, GB_MR = 64, GB_W = 128, GB_INT = 192, GB_BND = 256, GB_SC = 320;
constexpr int SM_DIN0 = 768, SM_DIN1 = 832, SM_NV = 896, SM_NVP = 1408, SM_DNQP = 3456, SM_GS = 3968, SM_CMX = 4000, SM_MC = 4032, SM_END = 4096;
static_assert(ML_SM + SM_END * 4 <= LDS_BYTES - 16, "mLSTM LDS");
constexpr float KSCALE = 0.04419417382415922f;

DI s16x4 tr_read(LAS unsigned char* p) { return __builtin_amdgcn_ds_read_tr16_b64_v4i16((LAS s16x4*)p); }
DI int dimg(int row, int ch) { return 2048 * (row >> 3) + 512 * (ch >> 2) + 64 * (row & 7) + 16 * ((ch & 3) ^ ((row >> 2) & 3)); }
DI bf16x8 frag_tr(LAS unsigned char* img, int k0, int c0, int lane) {
    const int h = lane >> 5, blk = (lane >> 4) & 1, q = (lane & 15) >> 2, p = lane & 3;
    const int row = k0 + 8 * h + q, ch = (c0 >> 3) + 2 * blk + (p >> 1), sub = 8 * (p & 1);
    const s16x4 lo = tr_read(img + dimg(row, ch) + sub), hi = tr_read(img + dimg(row + 4, ch) + sub);
    return __builtin_shufflevector(lo, hi, 0, 1, 2, 3, 4, 5, 6, 7);
}
#define MFMA32(a, b, c) __builtin_amdgcn_mfma_f32_32x32x16_bf16((a), (b), (c), 0, 0, 0)
DI void tr_batch4(bf16x8 (&f)[4], unsigned alo, unsigned ahi) {
    s16x4 l0, l1, l2, l3, h0, h1, h2, h3;
    asm volatile("ds_read_b64_tr_b16 %0, %8\n\tds_read_b64_tr_b16 %4, %9\n\tds_read_b64_tr_b16 %1, %8 offset:4096\n\tds_read_b64_tr_b16 %5, %9 offset:4096\n\t"
                 "ds_read_b64_tr_b16 %2, %8 offset:8192\n\tds_read_b64_tr_b16 %6, %9 offset:8192\n\tds_read_b64_tr_b16 %3, %8 offset:12288\n\tds_read_b64_tr_b16 %7, %9 offset:12288\n\t"
                 "s_waitcnt lgkmcnt(0)"
                 : "=&v"(l0), "=&v"(l1), "=&v"(l2), "=&v"(l3), "=&v"(h0), "=&v"(h1), "=&v"(h2), "=&v"(h3) : "v"(alo), "v"(ahi) : "memory");
    f[0] = __builtin_shufflevector(l0, h0, 0, 1, 2, 3, 4, 5, 6, 7); f[1] = __builtin_shufflevector(l1, h1, 0, 1, 2, 3, 4, 5, 6, 7);
    f[2] = __builtin_shufflevector(l2, h2, 0, 1, 2, 3, 4, 5, 6, 7); f[3] = __builtin_shufflevector(l3, h3, 0, 1, 2, 3, 4, 5, 6, 7);
}

DI void tr_issue4(s16x4& l0, s16x4& l1, s16x4& l2, s16x4& l3, s16x4& h0, s16x4& h1, s16x4& h2, s16x4& h3, unsigned alo, unsigned ahi) {
    asm volatile("ds_read_b64_tr_b16 %0, %8\n\tds_read_b64_tr_b16 %4, %9\n\tds_read_b64_tr_b16 %1, %8 offset:4096\n\tds_read_b64_tr_b16 %5, %9 offset:4096\n\t"
                 "ds_read_b64_tr_b16 %2, %8 offset:8192\n\tds_read_b64_tr_b16 %6, %9 offset:8192\n\tds_read_b64_tr_b16 %3, %8 offset:12288\n\tds_read_b64_tr_b16 %7, %9 offset:12288"
                 : "=&v"(l0), "=&v"(l1), "=&v"(l2), "=&v"(l3), "=&v"(h0), "=&v"(h1), "=&v"(h2), "=&v"(h3) : "v"(alo), "v"(ahi) : "memory");
}
DI void tr_wait8(s16x4& l0, s16x4& l1, s16x4& l2, s16x4& l3, s16x4& h0, s16x4& h1, s16x4& h2, s16x4& h3) {
    asm volatile("s_waitcnt lgkmcnt(0)" : "+v"(l0), "+v"(l1), "+v"(l2), "+v"(l3), "+v"(h0), "+v"(h1), "+v"(h2), "+v"(h3) :: "memory");
}
#define TR_CAT(f, l, h) do { f[0] = __builtin_shufflevector(l##0, h##0, 0, 1, 2, 3, 4, 5, 6, 7); f[1] = __builtin_shufflevector(l##1, h##1, 0, 1, 2, 3, 4, 5, 6, 7); \
        f[2] = __builtin_shufflevector(l##2, h##2, 0, 1, 2, 3, 4, 5, 6, 7); f[3] = __builtin_shufflevector(l##3, h##3, 0, 1, 2, 3, 4, 5, 6, 7); } while (0)

template <int I>
DI void ml_step(LAS unsigned char* lds, u32x4 (&Cp)[8][2], f32x16 (&num)[2], f32x16& Sacc, float& dnq, int tid, int lane, int wave, int gb) {
    asm volatile("" : "+v"(lane)); asm volatile("" : "+v"(tid));
    constexpr int QS = (I & 1) ? ML_QS1 : ML_QS0, KS = (I & 1) ? ML_KS1 : ML_KS0;
    const int r = lane & 31, h = lane >> 5, vt = wave & 3, dpar = wave >> 2;
    LAS float* SM = (LAS float*)(lds + ML_SM);
#define ML_SEC1 { const int wS = wave & 3, st = wS >> 1, tt1 = wS & 1, kh = wave >> 2; \
      if (!(st == 1 && tt1 == 0)) { \
        _Pragma("unroll") for (int ks = 0; ks < 4; ++ks) { const int kk = 4 * kh + ks; \
            const bf16x8 a = *(const LAS bf16x8*)(lds + KS + dimg(32 * st + r, 2 * kk + h)); \
            const bf16x8 b = *(const LAS bf16x8*)(lds + QS + dimg(32 * tt1 + r, 2 * kk + h)); \
            Sacc = MFMA32(a, b, Sacc); } } }
#define ML_SEC4 { _Pragma("unroll") for (int jj = 0; jj < 2; ++jj) { const int dl = dpar + 2 * jj; \
        _Pragma("unroll") for (int s2 = 0; s2 < 2; ++s2) { const bf16x8 a = __builtin_bit_cast(bf16x8, Cp[2 * I + jj][s2]); \
            _Pragma("unroll") for (int tt = 0; tt < 2; ++tt) { LAS unsigned char* qb = lds + QS + 8 * h; \
                const s16x4 lo = *(const LAS s16x4*)(qb + dimg(32 * tt + r, 4 * dl + 2 * s2)), hi = *(const LAS s16x4*)(qb + dimg(32 * tt + r, 4 * dl + 2 * s2 + 1)); \
                num[tt] = MFMA32(a, __builtin_shufflevector(lo, hi, 0, 1, 2, 3, 4, 5, 6, 7), num[tt]); } } } }
#define ML_UPD(jj_) { _Pragma("unroll") for (int s2 = 0; s2 < 2; ++s2) { const u32x4 o = Cp[2 * I + (jj_)][s2]; u32x4 n; \
            n.x = cvt_pk_bf16(bf_lo(o.x) * decay + U[8 * s2 + 0], bf_hi(o.x) * decay + U[8 * s2 + 1]); n.y = cvt_pk_bf16(bf_lo(o.y) * decay + U[8 * s2 + 2], bf_hi(o.y) * decay + U[8 * s2 + 3]); \
            n.z = cvt_pk_bf16(bf_lo(o.z) * decay + U[8 * s2 + 4], bf_hi(o.z) * decay + U[8 * s2 + 5]); n.w = cvt_pk_bf16(bf_lo(o.w) * decay + U[8 * s2 + 6], bf_hi(o.w) * decay + U[8 * s2 + 7]); \
            asm volatile("" : "+v"(n)); Cp[2 * I + (jj_)][s2] = n; } }
#define ML_SEC5 { const float decay = SM[gb + GB_SC + 0]; \
      const int blk = (lane >> 4) & 1, q = (lane & 15) >> 2, p = lane & 3, sub = 8 * (p & 1), rlo = 8 * h + q; \
      const unsigned ldsu = (unsigned)(size_t)lds; const int chB = 4 * vt + 2 * blk + (p >> 1), chA0 = 4 * dpar + 2 * blk + (p >> 1), chA1 = chA0 + 8; \
      s16x4 bl0, bl1, bl2, bl3, bh0, bh1, bh2, bh3, al0, al1, al2, al3, ah0, ah1, ah2, ah3, cl0, cl1, cl2, cl3, ch0, ch1, ch2, ch3; \
      tr_issue4(bl0, bl1, bl2, bl3, bh0, bh1, bh2, bh3, ldsu + ML_WV + dimg(rlo, chB) + sub, ldsu + ML_WV + dimg(rlo + 4, chB) + sub); \
      tr_issue4(al0, al1, al2, al3, ah0, ah1, ah2, ah3, ldsu + KS + dimg(rlo, chA0) + sub, ldsu + KS + dimg(rlo + 4, chA0) + sub); \
      tr_wait8(al0, al1, al2, al3, ah0, ah1, ah2, ah3); tr_wait8(bl0, bl1, bl2, bl3, bh0, bh1, bh2, bh3); \
      tr_issue4(cl0, cl1, cl2, cl3, ch0, ch1, ch2, ch3, ldsu + KS + dimg(rlo, chA1) + sub, ldsu + KS + dimg(rlo + 4, chA1) + sub); \
      bf16x8 Bf[4], Af[4]; TR_CAT(Bf, bl, bh); TR_CAT(Af, al, ah); \
      f32x16 U; \
      _Pragma("unroll") for (int e = 0; e < 16; ++e) U[e] = 0.f; \
      _Pragma("unroll") for (int ks = 0; ks < 4; ++ks) U = MFMA32(Af[ks], Bf[ks], U); \
      ML_UPD(0) \
      tr_wait8(cl0, cl1, cl2, cl3, ch0, ch1, ch2, ch3); TR_CAT(Af, cl, ch); \
      _Pragma("unroll") for (int e = 0; e < 16; ++e) U[e] = 0.f; \
      _Pragma("unroll") for (int ks = 0; ks < 4; ++ks) U = MFMA32(Af[ks], Bf[ks], U); \
      ML_UPD(1) }
#define ML_SECV { { const int t = tid & 63, dg = tid >> 6; \
      const u32x4 q0 = *(const LAS u32x4*)(lds + QS + dimg(t, 2 * dg)), q1 = *(const LAS u32x4*)(lds + QS + dimg(t, 2 * dg + 1)); \
      const LAS f32x4* nv = (const LAS f32x4*)(SM + SM_NV + 128 * I + 16 * dg); \
      const f32x4 n0 = nv[0], n1 = nv[1], n2 = nv[2], n3 = nv[3]; \
      dnq += bf_lo(q0.x) * n0.x + bf_hi(q0.x) * n0.y + bf_lo(q0.y) * n0.z + bf_hi(q0.y) * n0.w + bf_lo(q0.z) * n1.x + bf_hi(q0.z) * n1.y + bf_lo(q0.w) * n1.z + bf_hi(q0.w) * n1.w \
           + bf_lo(q1.x) * n2.x + bf_hi(q1.x) * n2.y + bf_lo(q1.y) * n2.z + bf_hi(q1.y) * n2.w + bf_lo(q1.z) * n3.x + bf_hi(q1.z) * n3.y + bf_lo(q1.w) * n3.z + bf_hi(q1.w) * n3.w; } \
    { const int dp = tid & 63, sg = tid >> 6; float a0 = 0.f, a1 = 0.f; \
      const f32x4 wA = *(const LAS f32x4*)(SM + gb + GB_W + 8 * sg), wB = *(const LAS f32x4*)(SM + gb + GB_W + 8 * sg + 4); const float ww[8] = {wA.x, wA.y, wA.z, wA.w, wB.x, wB.y, wB.z, wB.w}; \
      _Pragma("unroll") for (int s = 0; s < 8; ++s) { const unsigned kk2 = *(const LAS unsigned*)(lds + KS + dimg(8 * sg + s, dp >> 2) + 4 * (dp & 3)); a0 += ww[s] * bf_lo(kk2); a1 += ww[s] * bf_hi(kk2); } \
      ((LAS unsigned*)(SM + SM_NVP))[sg * 256 + 64 * I + dp] = cvt_pk_bf16(a0, a1); } }
    ML_SEC1 ML_SEC4 ML_SEC5 ML_SECV
#undef ML_SEC1
#undef ML_SEC4
#undef ML_UPD
#undef ML_SEC5
#undef ML_SECV
}

DI float lane_read(float v, int src_lane) { return __builtin_bit_cast(float, __builtin_amdgcn_ds_bpermute(src_lane << 2, __builtin_bit_cast(int, v))); }
DI void ml_scan(float li_, float lf_, float& u_, float& cm_, float& bs_, int lane) {
    bs_ = lf_;
#pragma unroll
    for (int o_ = 1; o_ < 64; o_ <<= 1) { const float t_ = lane_read(bs_, (lane - o_) & 63); if (lane >= o_) bs_ += t_; }
    u_ = li_ - bs_; cm_ = u_;
#pragma unroll
    for (int o_ = 1; o_ < 64; o_ <<= 1) { const float t_ = lane_read(cm_, (lane - o_) & 63); if (lane >= o_) cm_ = fmaxf(cm_, t_); }
}
DI void ml_gates(LAS float* SM, float u_, float cm_, float bs_, int gbn, float m_, float cmx_, int lane) {
    const float M_ = fmaxf(m_, cm_), Ml_ = fmaxf(m_, cmx_);
    SM[gbn + GB_U + lane] = u_; SM[gbn + GB_MR + lane] = M_; SM[gbn + GB_W + lane] = __expf(u_ - Ml_) * KSCALE; SM[gbn + GB_INT + lane] = __expf(m_ - M_); SM[gbn + GB_BND + lane] = __expf(-(bs_ + M_));
    if (lane == 0) SM[gbn + GB_SC + 0] = __expf(m_ - Ml_);
}

DI void ml_dma_piece(const bf16_t* colbase, int b, int dir, int tau0, LAS unsigned char* tile, int j, int lane) {
    const int pos = lane & 31, rin = pos >> 2, row = 8 * (j >> 1) + rin, ch = 4 * (2 * (j & 1) + (lane >> 5)) + ((pos & 3) ^ ((row >> 2) & 3));
    const int tau = tau0 + row; const size_t tok = (size_t)(b * SEQ + (dir ? SEQ - 1 - tau : tau));
    __builtin_amdgcn_global_load_lds((const unsigned*)(colbase + tok * 4096 + ch * 8), (LAS unsigned*)(tile + 1024 * j), 16, 0, 0);
}

DI void mlstm_phase(const bf16_t* Q, const bf16_t* Kb, const bf16_t* V, const float* pre_part, const float* b_if, float* GLF, bf16_t* HF, bf16_t* HB,
                    LAS unsigned char* lds, int G, int vcu0, int tid0, int lane0, int wave) {
    LAS float* SM = (LAS float*)(lds + ML_SM);
    const int vt = wave & 3, dpar = wave >> 2;
    for (int item = vcu0; item < 256; item += G) {
        const int vs = item & 3, stream = item >> 2, dir = stream & 1, hd = (stream >> 1) & 7, b = stream >> 4;
        bf16_t* H = dir ? HB : HF;
        float* glf = GLF + (size_t)item * 10240;
        const bf16_t* qcol = Q + hd * 512; const bf16_t* kcol = Kb + hd * 512; const bf16_t* vcol = V + hd * 512 + vs * 128;
        __syncthreads();
        int tidp = tid0, lanep = lane0; asm volatile("" : "+v"(tidp)); asm volatile("" : "+v"(lanep));
        for (int tau = tidp; tau < SEQ; tau += NTHREADS) {
            const int tok = b * SEQ + (dir ? SEQ - 1 - tau : tau);
            float li = b_if[dir * 16 + hd], lfr = b_if[dir * 16 + 8 + hd];
#pragma unroll
            for (int h8 = 0; h8 < 8; ++h8) { const float* pp = pre_part + ((size_t)h8 * 32 + dir * 16 + hd) * MTOK + tok; li += pp[0]; lfr += pp[(size_t)8 * MTOK]; }
            glf[tau] = li; glf[2048 + tau] = fminf(lfr, 0.f) - log1pf(__expf(-fabsf(lfr)));
        }
        SM[SM_NV + tidp] = 0.f;
        ml_dma_piece(qcol, b, dir, 0, lds + ML_QS0, 2 * wave, lanep); ml_dma_piece(qcol, b, dir, 0, lds + ML_QS0, 2 * wave + 1, lanep);
        ml_dma_piece(kcol, b, dir, 0, lds + ML_KS0, 2 * wave, lanep); ml_dma_piece(kcol, b, dir, 0, lds + ML_KS0, 2 * wave + 1, lanep);
        ml_dma_piece(vcol, b, dir, 0, lds + ML_VS0, 2 * wave, lanep); ml_dma_piece(vcol, b, dir, 0, lds + ML_VS0, 2 * wave + 1, lanep);
        asm volatile("s_waitcnt vmcnt(0)" ::: "memory");
        __syncthreads();
        float u0 = 0.f, cm0 = 0.f, bs0 = 0.f;
#pragma unroll 1
        for (int cc = wave; cc < 32; cc += 8) {
            const float lic = __hip_atomic_load(glf + 64 * cc + lanep, __ATOMIC_RELAXED, __HIP_MEMORY_SCOPE_AGENT), lfc = __hip_atomic_load(glf + 2048 + 64 * cc + lanep, __ATOMIC_RELAXED, __HIP_MEMORY_SCOPE_AGENT);
            float uu, cmm, bss; ml_scan(lic, lfc, uu, cmm, bss, lanep);
            glf[4096 + 64 * cc + lanep] = uu; glf[6144 + 64 * cc + lanep] = cmm; glf[8192 + 64 * cc + lanep] = bss;
            if (lanep == 63) { SM[SM_GS + cc] = bss; SM[SM_CMX + cc] = cmm; }
            if (cc == 0) { u0 = uu; cm0 = cmm; bs0 = bss; }
        }
        asm volatile("s_waitcnt vmcnt(0)" ::: "memory");
        __syncthreads();
        if (tidp == 0) { float m = 0.f;
#pragma unroll 1
            for (int cc = 0; cc < 32; ++cc) { SM[SM_MC + cc] = m; m = SM[SM_GS + cc] + fmaxf(m, SM[SM_CMX + cc]); } }
        __syncthreads();
        if (wave == 0) ml_gates(SM, u0, cm0, bs0, 0, 0.f, SM[SM_CMX + 0], lanep);
        __syncthreads();
#define ML_WRITE_WV(VS_, gbx_) do { const float w_ = SM[(gbx_) + GB_W + lrow]; \
        _Pragma("unroll") for (int hh_ = 0; hh_ < 2; ++hh_) { const int o_ = dimg(lrow, lcc + 8 * hh_); const u32x4 x_ = *(const LAS u32x4*)(lds + (VS_) + o_); u32x4 y_; \
            y_.x = cvt_pk_bf16(bf_lo(x_.x) * w_, bf_hi(x_.x) * w_); y_.y = cvt_pk_bf16(bf_lo(x_.y) * w_, bf_hi(x_.y) * w_); y_.z = cvt_pk_bf16(bf_lo(x_.z) * w_, bf_hi(x_.z) * w_); y_.w = cvt_pk_bf16(bf_lo(x_.w) * w_, bf_hi(x_.w) * w_); \
            *(LAS u32x4*)(lds + ML_WV + o_) = y_; } } while (0)
        { const int lrow = tidp >> 3, lcc = tidp & 7; ML_WRITE_WV(ML_VS0, 0); }
        u32x4 Cp[8][2];
#pragma unroll
        for (int j = 0; j < 8; ++j) { Cp[j][0] = (u32x4){0u, 0u, 0u, 0u}; Cp[j][1] = (u32x4){0u, 0u, 0u, 0u}; }
#pragma unroll 1
        for (int c = 0; c < 32; ++c) {
            int lane = lane0, tid = tid0; asm volatile("" : "+v"(lane)); asm volatile("" : "+v"(tid));
            const int r = lane & 31, h = lane >> 5, lrow = tid >> 3, lcc = tid & 7;
            const int gb = (c & 1) * 384, gbn = 384 - gb, cn = (c + 1 < 32) ? c + 1 : 31;
            const int VSc = (c & 1) ? ML_VS1 : ML_VS0, VSn = (c & 1) ? ML_VS0 : ML_VS1;
            f32x16 num[2], Sacc; float dnq = 0.f;
#pragma unroll
            for (int e = 0; e < 16; ++e) { num[0][e] = 0.f; num[1][e] = 0.f; Sacc[e] = 0.f; }
#define ML_DMA_QK(QS_, KS_, c_, i_) do { ml_dma_piece(qcol + 128 * (i_), b, dir, 64 * (c_), lds + (QS_), 2 * wave, lane); ml_dma_piece(qcol + 128 * (i_), b, dir, 64 * (c_), lds + (QS_), 2 * wave + 1, lane); \
                ml_dma_piece(kcol + 128 * (i_), b, dir, 64 * (c_), lds + (KS_), 2 * wave, lane); ml_dma_piece(kcol + 128 * (i_), b, dir, 64 * (c_), lds + (KS_), 2 * wave + 1, lane); } while (0)
            asm volatile("s_waitcnt vmcnt(0)" ::: "memory"); __syncthreads(); ML_DMA_QK(ML_QS1, ML_KS1, c, 1);  ml_step<0>(lds, Cp, num, Sacc, dnq, tid, lane, wave, gb);
            asm volatile("s_waitcnt vmcnt(0)" ::: "memory"); __syncthreads(); ML_DMA_QK(ML_QS0, ML_KS0, c, 2);  ml_step<1>(lds, Cp, num, Sacc, dnq, tid, lane, wave, gb);
            asm volatile("s_waitcnt vmcnt(0)" ::: "memory"); __syncthreads(); ML_DMA_QK(ML_QS1, ML_KS1, c, 3);  ml_step<2>(lds, Cp, num, Sacc, dnq, tid, lane, wave, gb);
            asm volatile("s_waitcnt vmcnt(0)" ::: "memory"); __syncthreads(); ML_DMA_QK(ML_QS0, ML_KS0, cn, 0);
            ml_dma_piece(vcol, b, dir, 64 * cn, lds + VSn, 2 * wave, lane); ml_dma_piece(vcol, b, dir, 64 * cn, lds + VSn, 2 * wave + 1, lane);
            ml_step<3>(lds, Cp, num, Sacc, dnq, tid, lane, wave, gb);
            asm volatile("s_waitcnt vmcnt(0)" ::: "memory");
            __syncthreads();
            float un = 0.f, cmn = 0.f, bsn = 0.f;
            if (wave == 0) { un = __hip_atomic_load(glf + 4096 + 64 * cn + lane, __ATOMIC_RELAXED, __HIP_MEMORY_SCOPE_AGENT); cmn = __hip_atomic_load(glf + 6144 + 64 * cn + lane, __ATOMIC_RELAXED, __HIP_MEMORY_SCOPE_AGENT);
                             bsn = __hip_atomic_load(glf + 8192 + 64 * cn + lane, __ATOMIC_RELAXED, __HIP_MEMORY_SCOPE_AGENT); }
            { LAS f32x4* xs = (LAS f32x4*)(lds + ML_XS) + (size_t)((wave & 3) * 4) * 64 + lane;
              if (wave >= 4) {
#pragma unroll
                for (int gq = 0; gq < 4; ++gq) xs[gq * 64] = (f32x4){Sacc[4 * gq], Sacc[4 * gq + 1], Sacc[4 * gq + 2], Sacc[4 * gq + 3]}; } }
            SM[SM_DNQP + (tid >> 6) * 64 + (tid & 63)] = dnq;
            __syncthreads();
            if (wave < 4) {
                const int st = wave >> 1, tt1 = wave & 1, t = 32 * tt1 + r;
                const LAS f32x4* xs = (const LAS f32x4*)(lds + ML_XS) + (size_t)(wave * 4) * 64 + lane;
                const float Mt = SM[gb + GB_MR + t]; float dsum = 0.f;
#pragma unroll
                for (int gq = 0; gq < 4; ++gq) {
                    const f32x4 px = xs[gq * 64]; const int s0 = 32 * st + 8 * gq + 4 * h; const f32x4 us = *(const LAS f32x4*)(SM + gb + GB_U + s0);
                    float vv[4];
#pragma unroll
                    for (int e = 0; e < 4; ++e) { const float raw = (Sacc[4 * gq + e] + px[e]) * KSCALE; vv[e] = (s0 + e <= t) ? raw * __expf(us[e] - Mt) : 0.f; dsum += vv[e]; }
                    u32x2 w; w.x = cvt_pk_bf16(vv[0], vv[1]); w.y = cvt_pk_bf16(vv[2], vv[3]);
                    *(LAS u32x2*)(lds + ML_SS + t * 144 + s0 * 2) = w;
                }
                dsum += __shfl_xor(dsum, 32);
                if (h == 0) SM[(st ? SM_DIN1 : SM_DIN0) + t] = dsum;
            }
#pragma unroll
            for (int tt = 0; tt < 2; ++tt) { const float it = SM[gb + GB_INT + 32 * tt + r]; num[tt] = num[tt] * it; }
            __syncthreads();
#pragma unroll
            for (int k2 = 0; k2 < 2; ++k2) { const int ks = 2 * dpar + k2;
                const bf16x8 a = frag_tr(lds + VSc, 16 * ks, 32 * vt, lane);
#pragma unroll
                for (int tt = 0; tt < 2; ++tt) { const bf16x8 bb = *(const LAS bf16x8*)(lds + ML_SS + (32 * tt + r) * 144 + (16 * ks + 8 * h) * 2); num[tt] = MFMA32(a, bb, num[tt]); } }
            __syncthreads();
            { LAS f32x4* xn = (LAS f32x4*)(lds + ML_XN) + (size_t)(vt * 8) * 64 + lane;
              if (dpar == 1) {
#pragma unroll
                for (int tt = 0; tt < 2; ++tt)
#pragma unroll
                    for (int gq = 0; gq < 4; ++gq) xn[(tt * 4 + gq) * 64] = (f32x4){num[tt][4 * gq], num[tt][4 * gq + 1], num[tt][4 * gq + 2], num[tt][4 * gq + 3]}; } }
            if (wave == 0) ml_gates(SM, un, cmn, bsn, gbn, SM[SM_MC + cn], SM[SM_CMX + cn], lane);
            __syncthreads();
            if (dpar == 0) {
                const LAS f32x4* xn = (const LAS f32x4*)(lds + ML_XN) + (size_t)(vt * 8) * 64 + lane;
#pragma unroll
                for (int tt = 0; tt < 2; ++tt) { const int t = 32 * tt + r; float nq = 0.f;
#pragma unroll
                    for (int gI = 0; gI < 8; ++gI) nq += SM[SM_DNQP + gI * 64 + t];
                    const float den = SM[SM_DIN0 + t] + SM[SM_DIN1 + t] + SM[gb + GB_INT + t] * nq;
                    const float inv = 1.0f / fmaxf(fabsf(den), SM[gb + GB_BND + t]);
                    const int tau = 64 * c + t; const size_t ob = (size_t)(b * SEQ + (dir ? SEQ - 1 - tau : tau)) * 4096 + hd * 512 + vs * 128 + 32 * vt + 4 * h;
#pragma unroll
                    for (int gq = 0; gq < 4; ++gq) { const f32x4 px = xn[(tt * 4 + gq) * 64];
                        u32x2 w; w.x = cvt_pk_bf16((num[tt][4 * gq] + px.x) * inv, (num[tt][4 * gq + 1] + px.y) * inv); w.y = cvt_pk_bf16((num[tt][4 * gq + 2] + px.z) * inv, (num[tt][4 * gq + 3] + px.w) * inv);
                        *(u32x2*)(H + ob + 8 * gq) = w; } }
            }
            ML_WRITE_WV(VSn, gbn);
            { const float decay = SM[gb + GB_SC + 0];
              float acc_ = 0.f; const LAS unsigned* np_ = (const LAS unsigned*)(SM + SM_NVP) + (tid >> 1);
#pragma unroll
              for (int sgx = 0; sgx < 8; ++sgx) { const unsigned pr_ = np_[sgx * 256]; acc_ += (tid & 1) ? bf_hi(pr_) : bf_lo(pr_); }
              SM[SM_NV + tid] = decay * SM[SM_NV + tid] + acc_; }
        }
#undef ML_DMA_QK
#undef ML_WRITE_WV
    }
}

DI void ml_combine_phase(const bf16_t* HF, const bf16_t* HB, const bf16_t* XC, const bf16_t* XZ, const float* norm_g, const float* skip, unsigned char* MO, int gw, int NGW, int lane) {
    for (int idx = gw; idx < MTOK * ML_HEADS; idx += NGW) {
        const int tok = idx >> 3, hd = idx & 7; const int ch = hd * 512 + 8 * lane; const size_t o4 = (size_t)tok * 4096 + ch;
        const u32x4 a = *(const u32x4*)(HF + o4), bq = *(const u32x4*)(HB + o4), xcv = *(const u32x4*)(XC + o4), zv = *(const u32x4*)(XZ + (size_t)tok * 8192 + 4096 + ch);
        float ht[8] = {bf_lo(a.x) + bf_lo(bq.x), bf_hi(a.x) + bf_hi(bq.x), bf_lo(a.y) + bf_lo(bq.y), bf_hi(a.y) + bf_hi(bq.y), bf_lo(a.z) + bf_lo(bq.z), bf_hi(a.z) + bf_hi(bq.z), bf_lo(a.w) + bf_lo(bq.w), bf_hi(a.w) + bf_hi(bq.w)};
        const float xc[8] = {bf_lo(xcv.x), bf_hi(xcv.x), bf_lo(xcv.y), bf_hi(xcv.y), bf_lo(xcv.z), bf_hi(xcv.z), bf_lo(xcv.w), bf_hi(xcv.w)};
        const float z[8] = {bf_lo(zv.x), bf_hi(zv.x), bf_lo(zv.y), bf_hi(zv.y), bf_lo(zv.z), bf_hi(zv.z), bf_lo(zv.w), bf_hi(zv.w)};
        float s = 0.f;
#pragma unroll
        for (int i = 0; i < 8; ++i) s += ht[i];
        const float mu = wave_sum(s) * (1.f / 512.f); float q = 0.f;
#pragma unroll
        for (int i = 0; i < 8; ++i) { ht[i] -= mu; q += ht[i] * ht[i]; }
        const float rstd = 1.0f / sqrtf(wave_sum(q) * (1.f / 512.f) + 1e-5f);
        const f32x4 g0 = *(const f32x4*)(norm_g + ch), g1 = *(const f32x4*)(norm_g + ch + 4), k0 = *(const f32x4*)(skip + ch), k1 = *(const f32x4*)(skip + ch + 4);
        const float gg[8] = {g0.x, g0.y, g0.z, g0.w, g1.x, g1.y, g1.z, g1.w}, sk[8] = {k0.x, k0.y, k0.z, k0.w, k1.x, k1.y, k1.z, k1.w};
        float o[8];
#pragma unroll
        for (int i = 0; i < 8; ++i) o[i] = (ht[i] * rstd * gg[i] + sk[i] * xc[i]) * sigmoid_f(z[i]);
        u32x2 w; w.x = pk4_fp8(o[0] * HSCALE, o[1] * HSCALE, o[2] * HSCALE, o[3] * HSCALE); w.y = pk4_fp8(o[4] * HSCALE, o[5] * HSCALE, o[6] * HSCALE, o[7] * HSCALE);
        *(u32x2*)(MO + o4) = w;
    }
}

DI void moe_offsets(const unsigned* ecnt, int (&cnt)[8], int (&off)[8], int& ntiles) {
    int acc = 0;
#pragma unroll
    for (int e = 0; e < 8; ++e) { cnt[e] = (int)ecnt[64 * e]; off[e] = acc * 256; acc += (cnt[e] + 255) >> 8; }
    ntiles = acc;
}
DI void moe_split_plan(int ntiles, int& nMf, int& nT, int& S) {
    nMf = (ntiles >> 5) << 5; nT = ntiles - nMf; S = 1;
    if (nT > 0) { S = (nT <= 4) ? 7 : (nT <= 8) ? 4 : (nT <= 16) ? 2 : 1; }
    if (S == 1) { nMf = ntiles; nT = 0; }
}
DI pg8::TileMap moe_tilemap(const int (&cnt)[8]) { pg8::TileMap tm; int acc = 0; tm.toff[0] = 0;
#pragma unroll
    for (int e = 0; e < 8; ++e) { acc += (cnt[e] + 255) >> 8; tm.toff[e + 1] = acc; }
    return tm; }
DI void moe_scatter_phase(const unsigned char* HA, unsigned char* HS, const int* tok_e, const int* tok_pos, int* slot_row, const unsigned* ecnt, int* tile_e, int gw, int NGW, int lane) {
    int cnt[8], off[8], ntiles; moe_offsets(ecnt, cnt, off, ntiles);
    if (gw == 0 && lane < 8) { const int e = lane; const int t0 = off[e] >> 8, nt = (cnt[e] + 255) >> 8; for (int t = 0; t < nt; ++t) tile_e[t0 + t] = e; }
    for (int id = gw; id < 2 * MTOK; id += NGW) {
        const int e = tok_e[id], pos = tok_pos[id]; int o = 0;
#pragma unroll
        for (int q = 0; q < 8; ++q) o = (e == q) ? off[q] : o;
        const int row = o + pos;
        if (lane == 0) slot_row[id] = row;
        const u32x4* src = (const u32x4*)(HA + (size_t)(id >> 1) * DM) + lane; u32x4* dst = (u32x4*)(HS + (size_t)row * DM) + lane;
#pragma unroll
        for (int j = 0; j < 2; ++j) dst[64 * j] = src[64 * j];
    }
#pragma unroll 1
    for (int e = 0; e < 8; ++e) { int c = 0, o = 0;
#pragma unroll
        for (int q = 0; q < 8; ++q) { c = (e == q) ? cnt[q] : c; o = (e == q) ? off[q] : o; }
        const int pend = ((c + 255) >> 8) << 8;
        for (int p = c + gw; p < pend; p += NGW) { u32x4* dst = (u32x4*)(HS + (size_t)(o + p) * DM) + lane;
#pragma unroll
            for (int j = 0; j < 2; ++j) dst[64 * j] = (u32x4){0u, 0u, 0u, 0u}; } }
}

DI f32x4 moe_yrow(const bf16_t* YS, const bf16_t* YSP, int r, int rsplit, int S, int nrs, int lane, int j) {
    if (r < rsplit) { const u32x2 a = ((const u32x2*)(YS + (size_t)r * DM) + lane)[64 * j]; return (f32x4){bf_lo(a.x), bf_hi(a.x), bf_lo(a.y), bf_hi(a.y)}; }
    f32x4 acc = (f32x4){0.f, 0.f, 0.f, 0.f};
    for (int s2 = 0; s2 < S; ++s2) { const u32x2 a = ((const u32x2*)(YSP + ((size_t)s2 * nrs + (r - rsplit)) * DM) + lane)[64 * j]; acc += (f32x4){bf_lo(a.x), bf_hi(a.x), bf_lo(a.y), bf_hi(a.y)}; }
    return acc;
}
DI void moe_combine_phase(const bf16_t* X3, const bf16_t* YS, const int* tok_e, const int* tok_pos, const float* tok_w, const float* gate, float* out, const unsigned* ecnt, int gw, int NGW, int lane) {
    int cnt[8], off[8], ntiles; moe_offsets(ecnt, cnt, off, ntiles);
    int nMf, nT, S; moe_split_plan(ntiles, nMf, nT, S); const int rsplit = nMf * 256; const bf16_t* YSP = YS + (size_t)MPAD * DM;
    for (int tok = gw; tok < MTOK; tok += NGW) {
        const int e0 = tok_e[2 * tok], e1 = tok_e[2 * tok + 1]; int o0 = 0, o1 = 0;
#pragma unroll
        for (int q = 0; q < 8; ++q) { o0 = (e0 == q) ? off[q] : o0; o1 = (e1 == q) ? off[q] : o1; }
        const int r0 = o0 + tok_pos[2 * tok], r1 = o1 + tok_pos[2 * tok + 1]; const float w0 = tok_w[2 * tok], w1 = tok_w[2 * tok + 1];
        const u32x2* x = (const u32x2*)(X3 + (size_t)tok * DM) + lane;
        const f32x4* gp = (const f32x4*)(gate + (size_t)(tok >> 11) * 12288) + lane; f32x4* o = (f32x4*)(out + (size_t)tok * DM) + lane;
#pragma unroll
        for (int j = 0; j < 8; ++j) { const f32x4 ya = moe_yrow(YS, YSP, r0, rsplit, S, nT * 256, lane, j), yb = moe_yrow(YS, YSP, r1, rsplit, S, nT * 256, lane, j);
            const u32x2 xr = x[64 * j]; o[64 * j] = (f32x4){bf_lo(xr.x), bf_hi(xr.x), bf_lo(xr.y), bf_hi(xr.y)} + gp[64 * j] * (ya * w0 + yb * w1); }
    }
}

struct Params { const float* in[29]; float* out; unsigned char* ws; int ph_lo, ph_hi; };
static_assert(sizeof(Params) == 31 * 8 + 8, "Params has padding");
constexpr int NPHASE = 20;

#if DBG
#include "dbg_checks.inc"
#endif

__global__ void __launch_bounds__(NTHREADS, 2) mega_fwd(Params p) {
    extern __shared__ __attribute__((aligned(16))) unsigned char lds_raw[];
    LAS unsigned char* lds = (LAS unsigned char*)lds_raw;
    const int tid = threadIdx.x, lane = tid & 63, wave = __builtin_amdgcn_readfirstlane(tid >> 6);
    const int G = gridDim.x, gw = blockIdx.x * NWAVES + wave, NGW = G * NWAVES;
    const int vcu = (G % 8 == 0) ? (int)(blockIdx.x % 8) * (G / 8) + (int)(blockIdx.x / 8) : (int)blockIdx.x;
    const int gwx = vcu * NWAVES + wave;
    unsigned char* ws = p.ws;
    unsigned* ctl = (unsigned*)(ws + WS_CTL);
    volatile LAS unsigned* xbw = (volatile LAS unsigned*)(lds + LDS_BYTES - 16);
    if (tid == 0) { xbw[0] = 0u; xbw[1] = 0u; xbw[2] = 0u; xbw[3] = 0u; }
    __syncthreads();
    XcdBarrier bar = xcd_barrier_post(ctl + CW_BAR, xbw);
    const int lo = p.ph_lo, hi = p.ph_hi;
#ifndef PH_MASK
#define PH_MASK 0xFFFFFFu
#endif
#define IN(k) (((PH_MASK >> (k)) & 1u) && lo <= (k) && (k) < hi)
#define SEAM(k) do { if (IN((k) + 1)) xcd_barrier(bar); } while (0)
#ifndef REP_MASK
#define REP_MASK 0u
#endif
#define PHASE(k, ...) if (IN(k)) { { __VA_ARGS__ } if ((REP_MASK >> (k)) & 1u) { __syncthreads(); { __VA_ARGS__ } } SEAM(k); }

    float* mod = (float*)(ws + WS_MOD);
    float* pre_part = (float*)(ws + WS_PRE);
    int* tok_e = (int*)(ws + WS_ROUTE); int* tok_pos = tok_e + 2 * MTOK; float* tok_w = (float*)(tok_pos + 2 * MTOK); int* slot_row = (int*)(tok_w + 2 * MTOK);
    unsigned* ecnt = ctl + CW_ECNT; int* tile_e = (int*)(ctl + 12288);
    bf16_t* HA = (bf16_t*)(ws + WS_HA); bf16_t* X1 = (bf16_t*)(ws + WS_X1); bf16_t* X2 = (bf16_t*)(ws + WS_X2);
    bf16_t* WT_IN = (bf16_t*)(ws + WS_WT_IN); bf16_t* WT_OUT = (bf16_t*)(ws + WS_WT_OUT); bf16_t* WT_GU = (bf16_t*)(ws + WS_WT_GU); bf16_t* WT_DN = (bf16_t*)(ws + WS_WT_DN);
    bf16_t* WT_MLIN = (bf16_t*)(ws + WS_WT_MLIN); bf16_t* WT_MLOUT = (bf16_t*)(ws + WS_WT_MLOUT); bf16_t* WT_IF = (bf16_t*)(ws + WS_WT_IF);
    unsigned char* WT_MGU = ws + WS_WT_MGU; unsigned char* WT_MD = ws + WS_WT_MD;
    bf16_t* QK = (bf16_t*)(ws + A_QK); bf16_t* QKN = (bf16_t*)(ws + A_QKN); bf16_t* VT = (bf16_t*)(ws + A_VT); bf16_t* ATT = (bf16_t*)(ws + A_ATT); bf16_t* ACT = (bf16_t*)(ws + A_ACT);
    bf16_t* XZ = (bf16_t*)(ws + A_XZ); bf16_t* XC = (bf16_t*)(ws + A_XC); bf16_t* Qm = (bf16_t*)(ws + A_Q); bf16_t* Km = (bf16_t*)(ws + A_K); bf16_t* Vm = (bf16_t*)(ws + A_V);
    bf16_t* HF = (bf16_t*)(ws + A_HF); bf16_t* HB = (bf16_t*)(ws + A_HB); bf16_t* MO = (bf16_t*)(ws + A_MO);
    unsigned char* HS = ws + A_HS; unsigned char* ACTM = ws + A_ACTM; float* YS = (float*)(ws + A_YS);
    const float* x_in = p.in[0];

    PHASE(0,
        mod_phase(p.in[1], p.in[2], p.in[3], mod, lds, G, tid, lane, wave);
        LAS float* scrw = (LAS float*)lds + wave * (64 * 65);
        cvtw_job<0, false>(p.in[6] + 4096, 2048, 2048, 1, WT_IN + (size_t)4096 * 2048, 0, scrw, gw, NGW, lane, 1.f, 6144, 0);
        cvtw_job<0, true>(p.in[6], 2048, 4096, 1, (unsigned char*)ACT + (size_t)32 * 1024 * 1024, 0, scrw, gw, NGW, lane, WSCALE, 6144, 512);
        cvtw_job<0, false>(p.in[10], 2048, 2048, 1, WT_OUT, 0, scrw, gw, NGW, lane, 1.f, 0, 1536);
        cvtw_job<1, false>(p.in[11], 2048, FFN, 1, WT_GU, 0, scrw, gw, NGW, lane, 1.f, 0, 2048);
        cvtw_job<2, false>(p.in[12], 2048, FFN, 1, WT_GU, 0, scrw, gw, NGW, lane, 1.f, 0, 3456);
        cvtw_job<0, false>(p.in[13], FFN, 2048, 1, WT_DN, 0, scrw, gw, NGW, lane, 1.f, 0, 4864);
        cvtw_job<0, false>(p.in[14], 2048, 4096, 1, WT_MLIN, 0, scrw, gw, NGW, lane, 1.f, 8192, 6272);
        cvtw_job<0, true>(p.in[14] + 4096, 2048, 4096, 1, (unsigned char*)WT_MLIN + (size_t)16 * 1024 * 1024, 0, scrw, gw, NGW, lane, WSCALE, 8192, 7296);
        cvtw_job<0, true>(p.in[24], 4096, 2048, 1, (unsigned char*)WT_MLOUT, 0, scrw, gw, NGW, lane, WSCALE, 0, 8320);
        cvt_job<0>(p.in[20], 12288, 32, 1, WT_IF, 0, scrw, gw, NGW, lane);
        cvtw_job<1, true>(p.in[26], 2048, EDIM, 8, WT_MGU, (size_t)14336 * 2048, scrw, gw, NGW, lane, WSCALE, 0, 9344);
        cvtw_job<2, true>(p.in[27], 2048, EDIM, 8, WT_MGU, (size_t)14336 * 2048, scrw, gw, NGW, lane, WSCALE, 0, 9344 + 14336);
        cvtw_job<0, true>(p.in[28], EDIM, 2048, 8, WT_MD, (size_t)2048 * EDIM, scrw, gw, NGW, lane, WSCALE, 0, 9344 + 2 * 14336); )
    PHASE(1,  rms_mod_phase<false, true>(x_in, p.in[4], mod + 1 * 2048, mod + 0 * 2048, HA, nullptr, nullptr, nullptr, nullptr, nullptr, (unsigned char*)ACT, gw, NGW, lane); )
    PHASE(2,
        { pg8::Gemm g{(const unsigned char*)ACT, (const unsigned char*)ACT + (size_t)32 * 1024 * 1024, MTOK, 4096, 2048, 0}; pg8::StaticOrder S; S.init(MTOK, 4096, G, (int)blockIdx.x); pg8::EpiQKNorm E{QKN, 4096, p.in[7], p.in[8], 1.0f / (HSCALE * WSCALE)}; pg8::gemm_phase<pg8::EpiQKNorm, pg8::StaticOrder, true>(lds, g, S, E); }
        { pg8::Gemm g{WT_IN + (size_t)4096 * 2048, HA, 2048, MTOK, 2048, 0}; pg8::StaticOrder S; S.init(2048, MTOK, G, (int)blockIdx.x); pg8::EpiBf16 E{VT, MTOK}; pg8::gemm_phase(lds, g, S, E); } )
    PHASE(4,  na_phase(QKN, VT, ATT, p.in[9], lds, G, vcu, tid, lane, wave); )
    PHASE(5,  pg8::Gemm g{ATT, WT_OUT, MTOK, 2048, 2048, 0}; pg8::StaticOrder S; S.init(MTOK, 2048, G, (int)blockIdx.x); pg8::EpiResGate16<false> E{x_in, X1, DM, mod + 2 * 2048, 12288}; pg8::gemm_phase(lds, g, S, E); )
    PHASE(6,  rms_mod_phase<false, false, true>(X1, p.in[5], mod + 4 * 2048, mod + 3 * 2048, HA, nullptr, nullptr, nullptr, nullptr, nullptr, nullptr, gw, NGW, lane); )
    PHASE(7,  pg8::Gemm g{HA, WT_GU, MTOK, 2 * FFN, 2048, 0}; pg8::StaticOrder S; S.init(MTOK, 2 * FFN, G, (int)blockIdx.x); pg8::EpiSwiGLU E{ACT, FFN}; pg8::gemm_phase(lds, g, S, E); )
    PHASE(8,  pg8::Gemm g{ACT, WT_DN, MTOK, 2048, FFN, 0}; pg8::StaticOrder S; S.init(MTOK, 2048, G, (int)blockIdx.x); pg8::EpiResGate16<true> E{X1, X2, DM, mod + 5 * 2048, 12288}; pg8::gemm_phase(lds, g, S, E); )
    PHASE(9,  rms_mod_phase<false, true, true>(X2, p.in[4] + DM, mod + 4 * 12288 + 1 * 2048, mod + 4 * 12288 + 0 * 2048, HA, nullptr, nullptr, nullptr, nullptr, nullptr, (unsigned char*)MO, gw, NGW, lane); )
    PHASE(10,
        { pg8::Gemm g{HA, WT_MLIN, MTOK, 4096, 2048, 0}; pg8::StaticOrder S; S.init(MTOK, 4096, G, (int)blockIdx.x); pg8::EpiBf16 E{XZ, 8192}; pg8::gemm_phase(lds, g, S, E); }
        { pg8::Gemm g{(const unsigned char*)MO, (const unsigned char*)WT_MLIN + (size_t)16 * 1024 * 1024, MTOK, 4096, 2048, 0}; pg8::StaticOrder S; S.init(MTOK, 4096, G, (int)blockIdx.x);
          pg8::EpiBf16S E{XZ + 4096, 8192, 1.0f / (HSCALE * WSCALE), 0}; pg8::gemm_phase<pg8::EpiBf16S, pg8::StaticOrder, true>(lds, g, S, E); } )
    PHASE(11,  ml_pre_phase(XZ, p.in[15], p.in[16], p.in[17], p.in[18], p.in[19], WT_IF, XC, Qm, Km, Vm, pre_part, lds, G, tid, lane, wave); )
    PHASE(12,  mlstm_phase(Qm, Km, Vm, pre_part, p.in[21], (float*)(ws + WS_GLF), HF, HB, lds, G, vcu, tid, lane, wave); )
    PHASE(13,  ml_combine_phase(HF, HB, XC, XZ, p.in[23], p.in[22], (unsigned char*)MO, gw, NGW, lane); )
    PHASE(14,  pg8::Gemm g{MO, WT_MLOUT, MTOK, 2048, 4096, 0}; pg8::StaticOrder S; S.init(MTOK, 2048, G, (int)blockIdx.x); pg8::EpiResGate16<true> E{X2, X1, DM, mod + 4 * 12288 + 2 * 2048, 12288, 1.0f / (HSCALE * WSCALE)}; pg8::gemm_phase<pg8::EpiResGate16<true>, pg8::StaticOrder, true>(lds, g, S, E); )
    PHASE(15,  rms_mod_phase<true, false, true>(X1, p.in[5] + DM, mod + 4 * 12288 + 4 * 2048, mod + 4 * 12288 + 3 * 2048, HA, p.in[25], tok_e, tok_pos, tok_w, ecnt, HS, gw, NGW, lane); )
    PHASE(17,  int cnt[8], off[8], ntiles; moe_offsets(ecnt, cnt, off, ntiles);
        pg8::Gemm g{HS, WT_MGU, ntiles * 256, 2 * EDIM, 2048, 0}; pg8::MoeOrder S; S.init(ntiles, 2 * EDIM, G, (int)blockIdx.x, moe_tilemap(cnt), (size_t)14336 * 2048, (size_t)DM);
        pg8::EpiSwiGLU8 E{ACTM, EDIM, 1.0f / (HSCALE * WSCALE), ASCALE}; pg8::gemm_phase<pg8::EpiSwiGLU8, pg8::MoeOrder, true>(lds, g, S, E); )
    PHASE(18,  int cnt[8], off[8], ntiles; moe_offsets(ecnt, cnt, off, ntiles);
        pg8::Gemm g{ACTM, WT_MD, ntiles * 256, 2048, EDIM, 0};
        int nMf, nT, SS; moe_split_plan(ntiles, nMf, nT, SS); bf16_t* YSP = (bf16_t*)YS + (size_t)MPAD * DM;
        { pg8::MoeRowOrder S1; S1.init(nMf, G, (int)blockIdx.x, moe_tilemap(cnt), (size_t)2048 * EDIM); pg8::EpiBf16S E{(bf16_t*)YS, DM, 1.0f / (ASCALE * WSCALE), 0}; pg8::gemm_phase<pg8::EpiBf16S, pg8::MoeRowOrder, true>(lds, g, S1, E); }
        if (nT > 0) { pg8::Gemm g2 = g; g2.ntk = 56 / SS; pg8::MoeSplitOrder S2; S2.init(nMf, nT, SS, (size_t)(EDIM / SS), (int)blockIdx.x, moe_tilemap(cnt), (size_t)2048 * EDIM);
            pg8::EpiBf16S E2{YSP - (size_t)nMf * 256 * DM, DM, 1.0f / (ASCALE * WSCALE), (size_t)nT * 256 * DM}; pg8::gemm_phase<pg8::EpiBf16S, pg8::MoeSplitOrder, true>(lds, g2, S2, E2); } )
    PHASE(19,  moe_combine_phase(X1, (const bf16_t*)YS, tok_e, tok_pos, tok_w, mod + 4 * 12288 + 5 * 2048, p.out, ecnt, gw, NGW, lane); )
#undef IN
#undef SEAM
#undef PHASE
}

extern "C" void kernel_launch(void* const* d_in, const int* in_sizes, int n_in, void* d_out, int out_size, void* d_ws, size_t ws_size, hipStream_t stream) {
    static int grid = 0;
    if (grid == 0) {
        if (n_in != 29 || out_size != MTOK * DM || ws_size < WS_END) { fprintf(stderr, "kernel_launch: unexpected shapes (n_in %d out %d ws %zu need %zu)\n", n_in, out_size, ws_size, (size_t)WS_END); grid = -1; return; }
        int dev = 0, cus = 0, per_cu = 0;
        if (hipGetDevice(&dev) != hipSuccess || hipDeviceGetAttribute(&cus, hipDeviceAttributeMultiprocessorCount, dev) != hipSuccess) { grid = -1; return; }
        if (hipFuncSetAttribute((const void*)mega_fwd, hipFuncAttributeMaxDynamicSharedMemorySize, LDS_BYTES) != hipSuccess) { fprintf(stderr, "kernel_launch: hipFuncSetAttribute failed\n"); grid = -1; return; }
        if (hipOccupancyMaxActiveBlocksPerMultiprocessor(&per_cu, (const void*)mega_fwd, NTHREADS, LDS_BYTES) != hipSuccess || per_cu < 1) { fprintf(stderr, "kernel_launch: occupancy query says %d\n", per_cu); (void)hipGetLastError(); per_cu = 1; }
        grid = cus;
    }
    if (grid < 0) return;
    (void)hipMemsetAsync((char*)d_ws + WS_CTL, 0, CTL_BYTES, stream);
    Params p{};
    for (int i = 0; i < 29; ++i) p.in[i] = (const float*)d_in[i];
    p.out = (float*)d_out; p.ws = (unsigned char*)d_ws;
#if N_LAUNCH_SPLIT
    for (int k = 0; k < NPHASE; ++k) { p.ph_lo = k; p.ph_hi = k + 1; hipLaunchKernelGGL(mega_fwd, dim3(grid), dim3(NTHREADS), LDS_BYTES, stream, p); }
#else
    p.ph_lo = 0; p.ph_hi = NPHASE;
    hipLaunchKernelGGL(mega_fwd, dim3(grid), dim3(NTHREADS), LDS_BYTES, stream, p);
#endif
}
```

```cpp
#ifndef GEMM_SCH
#define GEMM_SCH 1
#endif
#include <hip/hip_runtime.h>
#include <cstdio>
#include <cstdint>

#ifndef DBG
#define DBG 0
#endif
#ifndef N_LAUNCH_SPLIT
#define N_LAUNCH_SPLIT 0
#endif

#define LAS __attribute__((address_space(3)))
#define GAS __attribute__((address_space(1)))
#define DI __device__ __forceinline__
typedef unsigned short bf16_t;
typedef short bf16x8 __attribute__((ext_vector_type(8)));
typedef short s16x4 __attribute__((ext_vector_type(4)));
typedef float f32x2 __attribute__((ext_vector_type(2)));
typedef float f32x4 __attribute__((ext_vector_type(4)));
typedef float f32x16 __attribute__((ext_vector_type(16)));
typedef unsigned u32x2 __attribute__((ext_vector_type(2)));
typedef unsigned u32x4 __attribute__((ext_vector_type(4)));
typedef int i32x4 __attribute__((ext_vector_type(4)));
typedef int i32x8 __attribute__((ext_vector_type(8)));

constexpr int BATCH = 4, SEQ = 2048, DM = 2048, MTOK = BATCH * SEQ;
constexpr int GRID_W = 64, NA_HEADS = 16, NA_HD = 128;
constexpr int ML_INNER = 4096, ML_HEADS = 8, ML_HD = 512;
constexpr int FFN = 5632, NEXP = 8, EDIM = 7168;
constexpr int MPAD = 2 * MTOK + NEXP * 256;
constexpr int NTHREADS = 512, NWAVES = 8;
constexpr int LDS_BYTES = 147456;

constexpr size_t al256(size_t x) { return (x + 255) & ~(size_t)255; }
constexpr size_t WS_CTL = 0;
constexpr size_t CTL_BYTES = 65536;
constexpr size_t WS_MOD = WS_CTL + CTL_BYTES;
constexpr size_t WS_PRE = WS_MOD + al256((size_t)2 * 4 * 12288 * 4);
constexpr size_t WS_ROUTE = WS_PRE + (size_t)8 * MTOK * 32 * 4;
constexpr size_t WS_GLF = WS_ROUTE + (size_t)4 * MTOK * 2 * 4;
constexpr size_t WS_HA = WS_GLF + (size_t)256 * 10240 * 4;
constexpr size_t WS_X1 = WS_HA + (size_t)MTOK * DM * 2;
constexpr size_t WS_X2 = WS_X1 + (size_t)MTOK * DM * 4;
constexpr size_t WS_WT_IN = WS_X2 + (size_t)MTOK * DM * 4;
constexpr size_t WS_WT_OUT = WS_WT_IN + (size_t)6144 * 2048 * 2;
constexpr size_t WS_WT_GU = WS_WT_OUT + (size_t)2048 * 2048 * 2;
constexpr size_t WS_WT_DN = WS_WT_GU + (size_t)11264 * 2048 * 2;
constexpr size_t WS_WT_MLIN = WS_WT_DN + (size_t)2048 * 5632 * 2;
constexpr size_t WS_WT_MLOUT = WS_WT_MLIN + (size_t)8192 * 2048 * 2;
constexpr size_t WS_WT_IF = WS_WT_MLOUT + (size_t)2048 * 4096 * 2;
constexpr size_t WS_WT_MGU = WS_WT_IF + (size_t)32 * 12288 * 2;
constexpr size_t WS_WT_MD = WS_WT_MGU + (size_t)8 * 14336 * 2048;
constexpr size_t WS_ARENA = WS_WT_MD + (size_t)8 * 2048 * 7168;
constexpr size_t A_QK = WS_ARENA;
constexpr size_t A_QKN = A_QK + (size_t)MTOK * 4096 * 2;
constexpr size_t A_VT = A_QKN + (size_t)MTOK * 4096 * 2;
constexpr size_t A_ATT = A_VT + (size_t)2048 * MTOK * 2;
constexpr size_t A_ACT = A_ATT + (size_t)MTOK * DM * 2;
constexpr size_t A_L0_END = A_ACT + (size_t)MTOK * FFN * 2;
constexpr size_t A_XZ = WS_ARENA;
constexpr size_t A_XC = A_XZ + (size_t)MTOK * 8192 * 2;
constexpr size_t A_Q = A_XC + (size_t)MTOK * 4096 * 2;
constexpr size_t A_K = A_Q + (size_t)MTOK * 4096 * 2;
constexpr size_t A_V = A_K + (size_t)MTOK * 4096 * 2;
constexpr size_t A_HF = A_V + (size_t)MTOK * 4096 * 2;
constexpr size_t A_HB = A_HF + (size_t)MTOK * 4096 * 2;
constexpr size_t A_MO = A_HB + (size_t)MTOK * 4096 * 2;
constexpr size_t A_L1_END = A_MO + (size_t)MTOK * 4096 * 2;
constexpr size_t A_HS = WS_ARENA;
constexpr size_t A_ACTM = A_HS + (size_t)8 * 8192 * DM;
constexpr size_t A_YS = A_ACTM + (size_t)MPAD * EDIM;
constexpr size_t A_L2_END = A_YS + (size_t)MPAD * DM * 4;
constexpr size_t cmax(size_t a, size_t b) { return a > b ? a : b; }
constexpr size_t WS_END = cmax(cmax(A_L0_END, A_L1_END), A_L2_END);

constexpr int CW_BAR = 0;
constexpr int CW_ECNT = 4096;
constexpr int CW_DBG = 8192;

typedef __bf16 bf16x2_t __attribute__((ext_vector_type(2)));
DI unsigned cvt_pk_bf16(float lo, float hi) { const f32x2 v = {lo, hi}; return __builtin_bit_cast(unsigned, __builtin_convertvector(v, bf16x2_t)); }
DI float clamp448(float x) { return __builtin_fminf(__builtin_fmaxf(x, -448.f), 448.f); }
DI unsigned pk4_fp8(float a, float b, float c, float d) {
    int p = 0; p = __builtin_amdgcn_cvt_pk_fp8_f32(clamp448(a), clamp448(b), p, false); p = __builtin_amdgcn_cvt_pk_fp8_f32(clamp448(c), clamp448(d), p, true); return (unsigned)p; }
DI float bf_lo(unsigned u) { return __uint_as_float(u << 16); }
DI float bf_hi(unsigned u) { return __uint_as_float(u & 0xffff0000u); }
DI float bf2f(bf16_t b) { return __uint_as_float(((unsigned)b) << 16); }
DI bf16_t f2bf(float f) { return (bf16_t)(cvt_pk_bf16(f, 0.f) & 0xffffu); }
DI float wave_sum(float v) {
#pragma unroll
    for (int o = 1; o < 64; o <<= 1) v += __shfl_xor(v, o);
    return v;
}
DI float wave_max(float v) {
#pragma unroll
    for (int o = 1; o < 64; o <<= 1) v = fmaxf(v, __shfl_xor(v, o));
    return v;
}
DI float silu_f(float x) { return x / (1.f + __expf(-x)); }
DI float sigmoid_f(float x) { return 1.f / (1.f + __expf(-x)); }
#define LDS_WAIT() asm volatile("s_waitcnt lgkmcnt(0)" ::: "memory")
#define VM_WAIT() asm volatile("s_waitcnt vmcnt(0)" ::: "memory")

#define XB_TMO      128
#define XB_XCNT(j)  (256  + 64 * (j))
#define XB_XSUB(j)  (1280 + 64 * (j))
#define XB_XGEN(j)  (2304 + 64 * (j))
#define XB_TOP      3328
#define XB_TOPGEN   3392
#define XCD_BAR_WORDS 3456
#define XB_SPIN_CAP (1u << 22)

__device__ __forceinline__ unsigned xb_ld(unsigned* p)              { return __hip_atomic_load(p, __ATOMIC_RELAXED, __HIP_MEMORY_SCOPE_AGENT); }
__device__ __forceinline__ unsigned xb_add(unsigned* p, unsigned v) { return __hip_atomic_fetch_add(p, v, __ATOMIC_RELAXED, __HIP_MEMORY_SCOPE_AGENT); }
__device__ __forceinline__ unsigned xb_xcc_id() { return (unsigned)__builtin_amdgcn_s_getreg((3 << 11) | 20) & 0xFu; }
#define XB_SPIN(cond, bar) do { unsigned _sp = 0; while (cond) { __builtin_amdgcn_s_sleep(1); \
    if ((++_sp & 255u) == 0u) { if (xb_ld(&(bar)[XB_TMO])) break; if (_sp > XB_SPIN_CAP) { atomicAdd(&(bar)[XB_TMO], 1u); break; } } } } while (0)

struct XcdBarrier { unsigned* bar; unsigned x; volatile LAS unsigned* st; };

__device__ __forceinline__ XcdBarrier xcd_barrier_post(unsigned* bar, volatile LAS unsigned* st) {
    XcdBarrier b; b.bar = bar; b.x = xb_xcc_id(); b.st = st;
    if (threadIdx.x == 0) (void)xb_add(&bar[XB_XCNT(b.x)], 1u);
    return b;
}
__device__ __forceinline__ void xcd_barrier_complete(unsigned* bar, unsigned x, unsigned& nloc, unsigned& nx) {
    const unsigned G = gridDim.x * gridDim.y * gridDim.z;
    unsigned sum, cnt, mine, sp = 0u;
    for (;;) {
        sum = 0u; cnt = 0u; mine = 0u;
#pragma unroll
        for (unsigned j = 0; j < 16; ++j) { const unsigned c = xb_ld(&bar[XB_XCNT(j)]); sum += c; cnt += (c > 0u) ? 1u : 0u; mine = (j == x) ? c : mine; }
        if (sum == G) break;
        __builtin_amdgcn_s_sleep(1);
        if ((++sp & 255u) == 0u) { if (xb_ld(&bar[XB_TMO])) break; if (sp > XB_SPIN_CAP) { atomicAdd(&bar[XB_TMO], 1u); break; } }
    }
    nloc = mine > 0u ? mine : 1u; nx = cnt > 0u ? cnt : 1u;
}
__device__ __forceinline__ void xcd_barrier(const XcdBarrier& b) {
    asm volatile("s_waitcnt vmcnt(0)" ::: "memory");
    __syncthreads();
    if (threadIdx.x == 0) {
        unsigned* bar = b.bar;
        __builtin_amdgcn_s_waitcnt(0);
        unsigned nloc = b.st[0], nx = b.st[1];
        if (nloc == 0u) { xcd_barrier_complete(bar, b.x, nloc, nx); b.st[0] = nloc; b.st[1] = nx; }
        const unsigned old = xb_add(&bar[XB_XSUB(b.x)], 1u);
        const unsigned gen = old / nloc;
        if (old + 1u == (gen + 1u) * nloc) {
            __builtin_amdgcn_fence(__ATOMIC_RELEASE, "agent");
            asm volatile("s_waitcnt vmcnt(0)" ::: "memory");
            const unsigned og = xb_add(&bar[XB_TOP], 1u);
            const unsigned tg = og / nx;
            if (og + 1u == (tg + 1u) * nx) xb_add(&bar[XB_TOPGEN], 1u);
            else XB_SPIN(xb_ld(&bar[XB_TOPGEN]) == tg, bar);
            __builtin_amdgcn_fence(__ATOMIC_ACQUIRE, "agent");
            xb_add(&bar[XB_XGEN(b.x)], 1u);
            asm volatile("s_waitcnt vmcnt(0)" ::: "memory");
        } else {
            XB_SPIN(xb_ld(&bar[XB_XGEN(b.x)]) == gen, bar);
            __builtin_amdgcn_fence(__ATOMIC_ACQUIRE, "agent");
            asm volatile("s_waitcnt vmcnt(0)" ::: "memory");
        }
    }
    __syncthreads();
}

namespace pg8 {
constexpr int BM = 256, BK = 64, HALF = 128, HTB = HALF * BK * 2, STAGE_BYTES = 8 * HTB, NXCD = 8, WGM = 8;
__host__ __device__ __forceinline__ int lds_byte(int r, int c) { const int st = (r >> 4) * 2 + (c >> 5), rr = r & 15, cc = c & 31, ob = rr * 64 + cc * 2; return st * 1024 + (ob ^ (((ob >> 9) & 1) << 5)); }
__host__ __device__ __forceinline__ void stage_rc(int b, int& R, int& C) { const int st = b / 1024, sb = b % 1024, swz = sb ^ (((sb >> 9) & 1) << 5); R = (st >> 1) * 16 + swz / 64; C = (st & 1) * 32 + (swz % 64) / 2; }
__host__ __device__ __forceinline__ int perm32(int rho) { const int n = rho >> 4, i = rho & 15; return 8 * (i >> 2) + 4 * n + (i & 3); }

struct Unit { int pm, pn; size_t boff; size_t aoff; int slice; };
struct Gemm { const void* A; const void* Bt; int M, N, K; int ntk; };

struct StaticOrder {
    int nM, nN, nwg, G, c;
    __device__ void init(int M, int N, int G_, int c_) { nM = M / BM; nN = N / BM; nwg = nM * nN; G = G_; c = c_; }
    __device__ bool next(int i, Unit& u) const {
        const long L = (long)i * G + c; if (L >= nwg) return false;
        int wgid = (int)L; { const int q = nwg / NXCD, r = nwg % NXCD, xcd = wgid % NXCD, off = wgid / NXCD; wgid = (xcd < r ? xcd * (q + 1) : r * (q + 1) + (xcd - r) * q) + off; }
        const int nig = WGM * nN, gid = wgid / nig, fm = gid * WGM, gsz = (nM - fm) < WGM ? (nM - fm) : WGM;
        u.pm = fm + ((wgid % nig) % gsz); u.pn = (wgid % nig) / gsz; u.boff = 0; u.aoff = 0; u.slice = 0; return true;
    }
};
struct TileMap {
    int toff[9];
    __device__ __forceinline__ void lookup(int pm, int& e, int& k) const {
        e = (pm >= toff[1]) + (pm >= toff[2]) + (pm >= toff[3]) + (pm >= toff[4]) + (pm >= toff[5]) + (pm >= toff[6]) + (pm >= toff[7]);
        int t0 = 0;
#pragma unroll
        for (int q = 1; q < 8; ++q) t0 = (e == q) ? toff[q] : t0;
        k = pm - t0;
    }
};
constexpr int ECAP = 8192;
struct MoeOrder {
    int nM, nN, nwg, G, c; TileMap tm; size_t estride; size_t arowb;
    __device__ void init(int nM_, int N, int G_, int c_, const TileMap& tm_, size_t es, size_t arowb_) { nM = nM_; nN = N / BM; nwg = nM * nN; G = G_; c = c_; tm = tm_; estride = es; arowb = arowb_; }
    __device__ bool next(int i, Unit& u) const {
        const long L = (long)i * G + c; if (L >= nwg) return false;
        int wgid = (int)L; { const int q = nwg / NXCD, r = nwg % NXCD, xcd = wgid % NXCD, off = wgid / NXCD; wgid = (xcd < r ? xcd * (q + 1) : r * (q + 1) + (xcd - r) * q) + off; }
        const int nig = WGM * nN, gid = wgid / nig, fm = gid * WGM, gsz = (nM - fm) < WGM ? (nM - fm) : WGM;
        u.pm = fm + ((wgid % nig) % gsz); u.pn = (wgid % nig) / gsz; int e, k; tm.lookup(u.pm, e, k); u.boff = (size_t)e * estride;
        u.aoff = (size_t)((long)(e * ECAP + 256 * k - 256 * u.pm) * (long)arowb); u.slice = 0; return true;
    }
};

struct MoeRowOrder {
    int nwg, G, c; TileMap tm; size_t estride;
    __device__ void init(int nMf, int G_, int c_, const TileMap& tm_, size_t es) { nwg = nMf * 8; G = G_; c = c_; tm = tm_; estride = es; }
    __device__ bool next(int i, Unit& u) const {
        const long L = (long)i * G + c; if (L >= nwg) return false;
        u.pm = (int)(L >> 3); u.pn = (int)(L & 7); int e, k; tm.lookup(u.pm, e, k); u.boff = (size_t)e * estride; u.aoff = 0; u.slice = 0; return true;
    }
};
struct MoeSplitOrder {
    int pm0, nq, S, c; size_t kslice; TileMap tm; size_t estride;
    __device__ void init(int pm0_, int nT, int S_, size_t ks, int c_, const TileMap& tm_, size_t es) { pm0 = pm0_; S = S_; nq = nT * 8 * S_; kslice = ks; c = c_; tm = tm_; estride = es; }
    __device__ bool next(int i, Unit& u) const {
        if (i != 0 || c >= nq) return false;
        const int un = c / S; u.slice = c - un * S; u.pm = pm0 + (un >> 3); u.pn = un & 7; u.aoff = (size_t)u.slice * kslice; int e, k; tm.lookup(u.pm, e, k); u.boff = (size_t)e * estride + u.aoff; return true;
    }
};
struct EpiBf16 {
    static constexpr bool PERM = true, XBAR = false;
    bf16_t* O; int ldc;
    __device__ __forceinline__ void operator()(const f32x4 (&acc)[2][2][4][2], const Unit& u, int wr, int wc, int fr, int fq) const {
        const int row0 = u.pm * BM + wr * 64 + fr, col0 = u.pn * BM + wc * 32 + 8 * fq;
#pragma unroll
        for (int ai = 0; ai < 2; ++ai)
#pragma unroll
            for (int m = 0; m < 4; ++m) { bf16_t* rowp = O + (size_t)(row0 + ai * HALF + m * 16) * ldc + col0;
#pragma unroll
                for (int bj = 0; bj < 2; ++bj) { const f32x4 v0 = acc[ai][bj][m][0], v1 = acc[ai][bj][m][1];
                    u32x4 w; w.x = cvt_pk_bf16(v0[0], v0[1]); w.y = cvt_pk_bf16(v0[2], v0[3]); w.z = cvt_pk_bf16(v1[0], v1[1]); w.w = cvt_pk_bf16(v1[2], v1[3]);
                    *(u32x4*)(rowp + bj * HALF) = w; } }
    }
};
struct EpiQKNorm {
    static constexpr bool PERM = true, XBAR = true;
    bf16_t* O; int ldc; const float* qg; const float* kg; float sc;
    __device__ __forceinline__ void pre(const f32x4 (&acc)[2][2][4][2], int wr, int wc, int fr, int fq, LAS float* P) const {
#pragma unroll
        for (int ai = 0; ai < 2; ++ai)
#pragma unroll
            for (int m = 0; m < 4; ++m)
#pragma unroll
                for (int bj = 0; bj < 2; ++bj) { const f32x4 a = acc[ai][bj][m][0], b = acc[ai][bj][m][1];
                    float ss = (a[0] * a[0] + a[1] * a[1]) + (a[2] * a[2] + a[3] * a[3]) + (b[0] * b[0] + b[1] * b[1]) + (b[2] * b[2] + b[3] * b[3]);
                    ss += __shfl_xor(ss, 16); ss += __shfl_xor(ss, 32);
                    if (fq == 0) P[((ai * HALF + wr * 64 + m * 16 + fr) * 2 + bj) * 4 + wc] = ss * sc * sc; }
    }
    __device__ __forceinline__ void post(const f32x4 (&acc)[2][2][4][2], const Unit& u, int wr, int wc, int fr, int fq, const LAS float* P) const {
        const int row0 = u.pm * BM + wr * 64 + fr, col0 = u.pn * BM + wc * 32 + 8 * fq;
        f32x4 g0[2], g1[2]; float hs[2];
#pragma unroll
        for (int bj = 0; bj < 2; ++bj) { const int head = 2 * u.pn + bj; const float* gp = (head < 16 ? qg : kg) + wc * 32 + 8 * fq; g0[bj] = *(const f32x4*)gp; g1[bj] = *(const f32x4*)(gp + 4); hs[bj] = head < 16 ? 0.08838834764831845f : 1.0f; }
#pragma unroll
        for (int ai = 0; ai < 2; ++ai)
#pragma unroll
            for (int m = 0; m < 4; ++m) { bf16_t* rowp = O + (size_t)(row0 + ai * HALF + m * 16) * ldc + col0;
#pragma unroll
                for (int bj = 0; bj < 2; ++bj) { const f32x4 ps = *(const LAS f32x4*)(P + ((ai * HALF + wr * 64 + m * 16 + fr) * 2 + bj) * 4);
                    const float rstd = hs[bj] / sqrtf(((ps[0] + ps[1]) + (ps[2] + ps[3])) * (1.f / 128.f) + 1e-6f);
                    const f32x4 v0 = acc[ai][bj][m][0] * g0[bj] * (rstd * sc), v1 = acc[ai][bj][m][1] * g1[bj] * (rstd * sc);
                    u32x4 w; w.x = cvt_pk_bf16(v0[0], v0[1]); w.y = cvt_pk_bf16(v0[2], v0[3]); w.z = cvt_pk_bf16(v1[0], v1[1]); w.w = cvt_pk_bf16(v1[2], v1[3]);
                    *(u32x4*)(rowp + bj * HALF) = w; } }
    }
};
struct EpiBf16S {
    static constexpr bool PERM = true, XBAR = false;
    bf16_t* O; int ldc; float sc; size_t sstride;
    __device__ __forceinline__ void operator()(const f32x4 (&acc)[2][2][4][2], const Unit& u, int wr, int wc, int fr, int fq) const {
        const int row0 = u.pm * BM + wr * 64 + fr, col0 = u.pn * BM + wc * 32 + 8 * fq;
        bf16_t* Os = O + (size_t)u.slice * sstride;
#pragma unroll
        for (int ai = 0; ai < 2; ++ai)
#pragma unroll
            for (int m = 0; m < 4; ++m) { bf16_t* rowp = Os + (size_t)(row0 + ai * HALF + m * 16) * ldc + col0;
#pragma unroll
                for (int bj = 0; bj < 2; ++bj) { const f32x4 v0 = acc[ai][bj][m][0] * sc, v1 = acc[ai][bj][m][1] * sc;
                    u32x4 w; w.x = cvt_pk_bf16(v0[0], v0[1]); w.y = cvt_pk_bf16(v0[2], v0[3]); w.z = cvt_pk_bf16(v1[0], v1[1]); w.w = cvt_pk_bf16(v1[2], v1[3]);
                    *(u32x4*)(rowp + bj * HALF) = w; } }
    }
};
struct EpiSwiGLU {
    static constexpr bool PERM = true, XBAR = false;
    bf16_t* O; int ldc;
    __device__ __forceinline__ void operator()(const f32x4 (&acc)[2][2][4][2], const Unit& u, int wr, int wc, int fr, int fq) const {
        const int row0 = u.pm * BM + wr * 64 + fr, col0 = u.pn * HALF + wc * 32 + 8 * fq;
#pragma unroll
        for (int ai = 0; ai < 2; ++ai)
#pragma unroll
            for (int m = 0; m < 4; ++m) { bf16_t* rowp = O + (size_t)(row0 + ai * HALF + m * 16) * ldc + col0;
                float o[8];
#pragma unroll
                for (int n = 0; n < 2; ++n)
#pragma unroll
                    for (int j = 0; j < 4; ++j) { const float g = acc[ai][0][m][n][j], up = acc[ai][1][m][n][j]; o[n * 4 + j] = g * __builtin_amdgcn_rcpf(1.f + __expf(-g)) * up; }
                u32x4 w; w.x = cvt_pk_bf16(o[0], o[1]); w.y = cvt_pk_bf16(o[2], o[3]); w.z = cvt_pk_bf16(o[4], o[5]); w.w = cvt_pk_bf16(o[6], o[7]);
                *(u32x4*)rowp = w; }
    }
};
struct EpiSwiGLU8 {
    static constexpr bool PERM = true, XBAR = false;
    unsigned char* O; int ldc; float isc, osc;
    __device__ __forceinline__ void operator()(const f32x4 (&acc)[2][2][4][2], const Unit& u, int wr, int wc, int fr, int fq) const {
        const int row0 = u.pm * BM + wr * 64 + fr, col0 = u.pn * HALF + wc * 32 + 8 * fq;
#pragma unroll
        for (int ai = 0; ai < 2; ++ai)
#pragma unroll
            for (int m = 0; m < 4; ++m) { unsigned char* rowp = O + (size_t)(row0 + ai * HALF + m * 16) * ldc + col0;
                float o[8];
#pragma unroll
                for (int n = 0; n < 2; ++n)
#pragma unroll
                    for (int j = 0; j < 4; ++j) { const float g = acc[ai][0][m][n][j] * isc, up = acc[ai][1][m][n][j] * isc; o[n * 4 + j] = g * __builtin_amdgcn_rcpf(1.f + __expf(-g)) * up * osc; }
                u32x2 w; w.x = pk4_fp8(o[0], o[1], o[2], o[3]); w.y = pk4_fp8(o[4], o[5], o[6], o[7]);
                *(u32x2*)rowp = w; }
    }
};
struct EpiResGate {
    static constexpr bool PERM = false, XBAR = false;
    const float* base; float* out; int ldc; const float* gate; int gstride;
    __device__ __forceinline__ void operator()(const f32x4 (&acc)[2][2][4][2], const Unit& u, int wr, int wc, int fr, int fq) const {
        const int row0 = u.pm * BM + wr * 64 + fr, col0 = u.pn * BM + wc * 32 + 4 * fq;
        const float* gp = gate + (size_t)((u.pm * BM) >> 11) * gstride + col0;
        f32x4 gv[2][2];
#pragma unroll
        for (int bj = 0; bj < 2; ++bj)
#pragma unroll
            for (int n = 0; n < 2; ++n) gv[bj][n] = *(const f32x4*)(gp + bj * HALF + n * 16);
#pragma unroll
        for (int ai = 0; ai < 2; ++ai)
#pragma unroll
            for (int m = 0; m < 4; ++m) { const size_t off = (size_t)(row0 + ai * HALF + m * 16) * ldc + col0;
#pragma unroll
                for (int bj = 0; bj < 2; ++bj)
#pragma unroll
                    for (int n = 0; n < 2; ++n) { const f32x4 bs = *(const f32x4*)(base + off + bj * HALF + n * 16);
                        *(f32x4*)(out + off + bj * HALF + n * 16) = bs + gv[bj][n] * acc[ai][bj][m][n]; }
                asm volatile("" ::: "memory"); }
    }
};
template <bool BASE16>
struct EpiResGate16 {
    static constexpr bool PERM = true, XBAR = false;
    const void* base; bf16_t* out; int ldc; const float* gate; int gstride; float sc = 1.0f;
    __device__ __forceinline__ void operator()(const f32x4 (&acc)[2][2][4][2], const Unit& u, int wr, int wc, int fr, int fq) const {
        const int row0 = u.pm * BM + wr * 64 + fr, col0 = u.pn * BM + wc * 32 + 8 * fq;
        const float* gp = gate + (size_t)((u.pm * BM) >> 11) * gstride + col0;
        f32x4 gv[2][2];
#pragma unroll
        for (int bj = 0; bj < 2; ++bj)
#pragma unroll
            for (int n = 0; n < 2; ++n) gv[bj][n] = *(const f32x4*)(gp + bj * HALF + 4 * n) * sc;
#pragma unroll
        for (int ai = 0; ai < 2; ++ai)
#pragma unroll
            for (int m = 0; m < 4; ++m) { const size_t off = (size_t)(row0 + ai * HALF + m * 16) * ldc + col0;
#pragma unroll
                for (int bj = 0; bj < 2; ++bj) { f32x4 b0, b1;
                    if (BASE16) { const u32x4 r = *(const u32x4*)((const bf16_t*)base + off + bj * HALF);
                        b0 = (f32x4){__uint_as_float(r.x << 16), __uint_as_float(r.x & 0xffff0000u), __uint_as_float(r.y << 16), __uint_as_float(r.y & 0xffff0000u)};
                        b1 = (f32x4){__uint_as_float(r.z << 16), __uint_as_float(r.z & 0xffff0000u), __uint_as_float(r.w << 16), __uint_as_float(r.w & 0xffff0000u)}; }
                    else { b0 = *(const f32x4*)((const float*)base + off + bj * HALF); b1 = *(const f32x4*)((const float*)base + off + bj * HALF + 4); }
                    const f32x4 v0 = b0 + gv[bj][0] * acc[ai][bj][m][0], v1 = b1 + gv[bj][1] * acc[ai][bj][m][1];
                    u32x4 w; w.x = cvt_pk_bf16(v0[0], v0[1]); w.y = cvt_pk_bf16(v0[2], v0[3]); w.z = cvt_pk_bf16(v1[0], v1[1]); w.w = cvt_pk_bf16(v1[2], v1[3]);
                    *(u32x4*)(out + off + bj * HALF) = w; }
                asm volatile("" ::: "memory"); }
    }
};
struct EpiF32 {
    static constexpr bool PERM = false, XBAR = false;
    float* C; int ldc; float sc;
    __device__ __forceinline__ void operator()(const f32x4 (&acc)[2][2][4][2], const Unit& u, int wr, int wc, int fr, int fq) const {
        const int row0 = u.pm * BM + wr * 64 + fr, col0 = u.pn * BM + wc * 32 + 4 * fq;
#pragma unroll
        for (int ai = 0; ai < 2; ++ai)
#pragma unroll
            for (int m = 0; m < 4; ++m) { float* rowp = C + (size_t)(row0 + ai * HALF + m * 16) * ldc + col0;
#pragma unroll
                for (int bj = 0; bj < 2; ++bj)
#pragma unroll
                    for (int n = 0; n < 2; ++n) *(f32x4*)(rowp + bj * HALF + n * 16) = acc[ai][bj][m][n] * sc; }
    }
};

template <class Epi, class Sched, bool F8 = false, int HOT = 0, int SCH = GEMM_SCH>
__device__ __forceinline__ void gemm_phase(LAS unsigned char* lds, const Gemm g, const Sched& S, const Epi& E) {
    int tid = threadIdx.x; asm volatile("" : "+v"(tid));
    const int wid = __builtin_amdgcn_readfirstlane(tid >> 6), lane = tid & 63, wr = wid >> 2, wc = wid & 3, fr = lane & 15, fq = lane >> 4;
    const int rowb = F8 ? g.K : 2 * g.K, nt = g.ntk ? g.ntk : rowb / (BK * 2);
    unsigned voffA[2], voffB[2];
#pragma unroll
    for (int i = 0; i < 2; ++i) { int R, C; stage_rc(tid * 16 + i * 8192, R, C); const int Rb = Epi::PERM ? ((R & ~31) + perm32(R & 31)) : R;
        voffA[i] = (unsigned)(R * rowb + C * 2); voffB[i] = (unsigned)(Rb * rowb + C * 2); }
    const size_t kstep = (size_t)(BK * 2);
    const size_t hstep = (size_t)HALF * rowb;
    const size_t tstep = 2 * hstep;
    const unsigned ldsw = (unsigned)wid * 1024u;
    const int aoff = lds_byte(wr * 64 + fr, fq * 8), boff = lds_byte(wc * 32 + fr, fq * 8);
#define PG8_SA(b, h) (((b) * 2 + (h)) * HTB)
#define PG8_SB(b, h) ((4 + (b) * 2 + (h)) * HTB)
#define PG8_STAGE(bufoff, gbase, voff) do { _Pragma("unroll") for (int _i = 0; _i < 2; ++_i) \
        __builtin_amdgcn_global_load_lds((const unsigned*)((const char*)(gbase) + (voff)[_i]), (LAS unsigned*)(lds + (bufoff) + ldsw + _i * 8192), 16, 0, 0); } while (0)
#define PG8_LD8(base_) __builtin_shufflevector(*(const LAS i32x4*)(base_), *(const LAS i32x4*)((base_) + 1024), 0, 1, 2, 3, 4, 5, 6, 7)
#define PG8_LDA(dst, b, h) do { _Pragma("unroll") for (int m = 0; m < 4; ++m) { if constexpr (F8) dst##8[m] = PG8_LD8(lds + PG8_SA(b, h) + aoff + m * 2048); \
        else { _Pragma("unroll") for (int k = 0; k < 2; ++k) dst[m][k] = *(const LAS bf16x8*)(lds + PG8_SA(b, h) + aoff + m * 2048 + k * 1024); } } } while (0)
#define PG8_LDB(dst, b, h) do { _Pragma("unroll") for (int n = 0; n < 2; ++n) { if constexpr (F8) dst##8[n] = PG8_LD8(lds + PG8_SB(b, h) + boff + n * 2048); \
        else { _Pragma("unroll") for (int k = 0; k < 2; ++k) dst[n][k] = *(const LAS bf16x8*)(lds + PG8_SB(b, h) + boff + n * 2048 + k * 1024); } } } while (0)
#define PG8_MMA(ai, bj, At, Bt) do { __builtin_amdgcn_s_setprio(1); _Pragma("unroll") for (int m = 0; m < 4; ++m) _Pragma("unroll") for (int n = 0; n < 2; ++n) { \
        if constexpr (F8) { asm volatile("v_mfma_f32_16x16x128_f8f6f4 %0, %1, %2, %0" : "+v"(acc[ai][bj][m][n]) : "v"(Bt##8[n]), "v"(At##8[m])); } \
        else { _Pragma("unroll") for (int k = 0; k < 2; ++k) acc[ai][bj][m][n] = __builtin_amdgcn_mfma_f32_16x16x32_bf16(Bt[n][k], At[m][k], acc[ai][bj][m][n], 0, 0, 0); } } \
        __builtin_amdgcn_s_setprio(0); } while (0)
#define PG8_WAIT_V(n) asm volatile("s_waitcnt vmcnt(" #n ")" ::: "memory")
#define PG8_WAIT_L(n) asm volatile("s_waitcnt lgkmcnt(" #n ")" ::: "memory")
#define PG8_BAR __builtin_amdgcn_s_barrier()
#define PG8_SCHED __builtin_amdgcn_sched_barrier(0)
    Unit cur, nxt; int ui = 0;
    if (!S.next(0, cur)) return;
    f32x4 acc[2][2][4][2];
#pragma unroll
    for (int a = 0; a < 2; ++a)
#pragma unroll
        for (int b = 0; b < 2; ++b)
#pragma unroll
            for (int m = 0; m < 4; ++m)
#pragma unroll
                for (int n = 0; n < 2; ++n) acc[a][b][m][n] = (f32x4){0.f, 0.f, 0.f, 0.f};
    bf16x8 At[4][2], B0[2][2], B1[2][2]; i32x8 At8[4], B08[2], B18[2];
    const char* cA = (const char*)g.A + cur.aoff + (size_t)(HOT ? 0 : cur.pm) * tstep; const char* cB = (const char*)g.Bt + cur.boff + (size_t)(HOT ? 0 : cur.pn) * tstep;
    if constexpr (SCH == 1) {
        PG8_STAGE(PG8_SB(0, 0), cB, voffB); PG8_STAGE(PG8_SB(0, 1), cB + hstep, voffB); PG8_STAGE(PG8_SA(0, 0), cA, voffA); PG8_STAGE(PG8_SA(0, 1), cA + hstep, voffA);
        if (wr == 1) PG8_BAR;
        PG8_WAIT_V(2); PG8_BAR;
        PG8_STAGE(PG8_SB(1, 0), cB + kstep, voffB); PG8_STAGE(PG8_SB(1, 1), cB + hstep + kstep, voffB); PG8_STAGE(PG8_SA(1, 0), cA + kstep, voffA);
        PG8_WAIT_V(6); PG8_BAR;
    } else {
    PG8_STAGE(PG8_SB(0, 0), cB, voffB); PG8_STAGE(PG8_SA(0, 0), cA, voffA); PG8_STAGE(PG8_SB(0, 1), cB + hstep, voffB); PG8_STAGE(PG8_SA(0, 1), cA + hstep, voffA);
    if (wr == 1) PG8_BAR;
    PG8_WAIT_V(4); PG8_BAR;
    PG8_STAGE(PG8_SB(1, 0), cB + kstep, voffB); PG8_STAGE(PG8_SA(1, 0), cA + kstep, voffA); PG8_STAGE(PG8_SB(1, 1), cB + hstep + kstep, voffB);
    PG8_WAIT_V(6); PG8_BAR;
    }
    for (;;) {
        const bool has_next = S.next(ui + 1, nxt);
        const char* nA = has_next ? (const char*)g.A + nxt.aoff + (size_t)(HOT ? 0 : nxt.pm) * tstep : cA; const char* nB = has_next ? (const char*)g.Bt + nxt.boff + (size_t)(HOT ? 0 : nxt.pn) * tstep : cB;
        for (int t = 0; t < nt; t += 2) {
            const bool last = (t == nt - 2);
            const char* a1 = cA + (size_t)(t + 1) * kstep;
            const char* a2 = last ? nA : cA + (size_t)(t + 2) * kstep; const char* b2 = last ? nB : cB + (size_t)(t + 2) * kstep;
            const char* a3 = a2 + kstep; const char* b3 = b2 + kstep;
            if constexpr (SCH == 1) {
                PG8_LDB(B0, 0, 0); PG8_LDB(B1, 0, 1); PG8_SCHED; PG8_LDA(At, 0, 0); PG8_STAGE(PG8_SA(1, 1), a1 + hstep, voffA);
                PG8_WAIT_V(8); PG8_WAIT_L(0); PG8_BAR; PG8_MMA(0, 0, At, B0); PG8_MMA(0, 1, At, B1); PG8_BAR; PG8_SCHED;
                PG8_LDA(At, 0, 1); PG8_STAGE(PG8_SB(0, 0), b2, voffB); PG8_STAGE(PG8_SB(0, 1), b2 + hstep, voffB); PG8_STAGE(PG8_SA(0, 0), a2, voffA);
                PG8_WAIT_V(8); PG8_WAIT_L(0); PG8_BAR; PG8_MMA(1, 0, At, B0); PG8_MMA(1, 1, At, B1); PG8_BAR; PG8_SCHED;
                PG8_LDB(B0, 1, 0); PG8_LDB(B1, 1, 1); PG8_SCHED; PG8_LDA(At, 1, 0); PG8_STAGE(PG8_SA(0, 1), a2 + hstep, voffA);
                PG8_WAIT_V(8); PG8_WAIT_L(0); PG8_BAR; PG8_MMA(0, 0, At, B0); PG8_MMA(0, 1, At, B1); PG8_BAR; PG8_SCHED;
                PG8_LDA(At, 1, 1); PG8_STAGE(PG8_SB(1, 0), b3, voffB); PG8_STAGE(PG8_SB(1, 1), b3 + hstep, voffB); PG8_STAGE(PG8_SA(1, 0), a3, voffA);
                PG8_WAIT_V(8); PG8_WAIT_L(0); PG8_BAR; PG8_MMA(1, 0, At, B0); PG8_MMA(1, 1, At, B1); PG8_BAR; PG8_SCHED;
                continue;
            }
            PG8_LDB(B0, 0, 0); PG8_SCHED; PG8_LDA(At, 0, 0); PG8_STAGE(PG8_SA(1, 1), a1 + hstep, voffA);
            PG8_WAIT_L(8); PG8_BAR; PG8_WAIT_L(0); PG8_MMA(0, 0, At, B0); PG8_BAR; PG8_SCHED;
            PG8_LDB(B1, 0, 1); PG8_STAGE(PG8_SB(0, 0), b2, voffB);
            PG8_BAR; PG8_WAIT_L(0); PG8_MMA(0, 1, At, B1); PG8_BAR;
            PG8_LDA(At, 0, 1); PG8_STAGE(PG8_SA(0, 0), a2, voffA);
            PG8_BAR; PG8_WAIT_L(0); PG8_MMA(1, 0, At, B0); PG8_BAR; PG8_SCHED;
            PG8_STAGE(PG8_SB(0, 1), b2 + hstep, voffB);
            PG8_WAIT_V(6); PG8_BAR; PG8_MMA(1, 1, At, B1); PG8_BAR;
            PG8_LDB(B0, 1, 0); PG8_SCHED; PG8_LDA(At, 1, 0); PG8_STAGE(PG8_SA(0, 1), a2 + hstep, voffA);
            PG8_WAIT_L(8); PG8_BAR; PG8_WAIT_L(0); PG8_MMA(0, 0, At, B0); PG8_BAR; PG8_SCHED;
            PG8_LDB(B1, 1, 1); PG8_STAGE(PG8_SB(1, 0), b3, voffB);
            PG8_BAR; PG8_WAIT_L(0); PG8_MMA(0, 1, At, B1); PG8_BAR;
            PG8_LDA(At, 1, 1); PG8_STAGE(PG8_SA(1, 0), a3, voffA);
            PG8_BAR; PG8_WAIT_L(0); PG8_MMA(1, 0, At, B0); PG8_BAR; PG8_SCHED;
            PG8_STAGE(PG8_SB(1, 1), b3 + hstep, voffB);
            PG8_WAIT_V(6); PG8_BAR; PG8_MMA(1, 1, At, B1); PG8_BAR;
        }
        if constexpr (F8) asm volatile("s_nop 15\n\ts_nop 15" ::: "memory");
        if constexpr (Epi::XBAR) { LAS float* P_ = (LAS float*)(lds + STAGE_BYTES); E.pre(acc, wr, wc, fr, fq, P_); PG8_WAIT_L(0); PG8_BAR; asm volatile("" ::: "memory"); E.post(acc, cur, wr, wc, fr, fq, P_); }
        else E(acc, cur, wr, wc, fr, fq);
        if (!has_next) break;
#pragma unroll
        for (int a = 0; a < 2; ++a)
#pragma unroll
            for (int b = 0; b < 2; ++b)
#pragma unroll
                for (int m = 0; m < 4; ++m)
#pragma unroll
                    for (int n = 0; n < 2; ++n) acc[a][b][m][n] = (f32x4){0.f, 0.f, 0.f, 0.f};
        cur = nxt; cA = nA; cB = nB; ++ui;
    }
    PG8_WAIT_V(0);
    if (wr == 0) PG8_BAR;
    PG8_BAR;
#undef PG8_SA
#undef PG8_SB
#undef PG8_STAGE
#undef PG8_LDA
#undef PG8_LDB
#undef PG8_MMA
#undef PG8_WAIT_V
#undef PG8_WAIT_L
#undef PG8_BAR
#undef PG8_SCHED
}
}

DI void mod_phase(const float* c, const float* mod_w, const float* mod_b, float* mod, LAS unsigned char* lds, int G, int tid, int lane, int wave) {
    LAS f32x4* cact = (LAS f32x4*)lds;
    LAS float* red = (LAS float*)(lds + 32768);
    for (int k = tid; k < DM; k += NTHREADS) { f32x4 v; v.x = silu_f(c[k]); v.y = silu_f(c[DM + k]); v.z = silu_f(c[2 * DM + k]); v.w = silu_f(c[3 * DM + k]); cact[k] = v; }
    __syncthreads();
    for (int it = blockIdx.x; it < 256; it += G) {
        const int l = it >> 7, n0 = (it & 127) * 96;
        float a0[4] = {0.f, 0.f, 0.f, 0.f}, a1[4] = {0.f, 0.f, 0.f, 0.f};
        if (lane < 48) {
            const float* wp = mod_w + ((size_t)l * DM + wave * 256) * 12288 + n0 + 2 * lane;
#pragma unroll 8
            for (int k = 0; k < 256; ++k) { const f32x2 w = *(const f32x2*)(wp + (size_t)k * 12288); const f32x4 cv = cact[wave * 256 + k];
                a0[0] += cv.x * w.x; a1[0] += cv.x * w.y; a0[1] += cv.y * w.x; a1[1] += cv.y * w.y; a0[2] += cv.z * w.x; a1[2] += cv.z * w.y; a0[3] += cv.w * w.x; a1[3] += cv.w * w.y; }
#pragma unroll
            for (int b = 0; b < 4; ++b) { red[(wave * 4 + b) * 96 + 2 * lane] = a0[b]; red[(wave * 4 + b) * 96 + 2 * lane + 1] = a1[b]; }
        }
        __syncthreads();
        if (tid < 384) { const int b = tid / 96, col = tid % 96; float s = mod_b[l * 12288 + n0 + col];
#pragma unroll
            for (int w = 0; w < 8; ++w) s += red[(w * 4 + b) * 96 + col];
            mod[((size_t)l * 4 + b) * 12288 + n0 + col] = s; }
        __syncthreads();
    }
}

template <int MODE>
DI void cvt_item(const float* W, int K, int N, bf16_t* WT, LAS float* scr, int kb, int nb, int lane) {
    const int k0 = 64 * kb, n0 = 32 * nb;
    float v[32];
    const float* wp = W + (size_t)(k0 + (lane >> 5)) * N + n0 + (lane & 31);
#pragma unroll
    for (int i = 0; i < 32; ++i) v[i] = wp[(size_t)(2 * i) * N];
#pragma unroll
    for (int i = 0; i < 32; ++i) scr[(2 * i + (lane >> 5)) * 33 + (lane & 31)] = v[i];
    LDS_WAIT();
    const int c = lane & 7;
#pragma unroll
    for (int j = 0; j < 4; ++j) { const int n = (lane >> 3) + 8 * j; const LAS float* s = scr + (8 * c) * 33 + n;
        u32x4 o; o.x = cvt_pk_bf16(s[0 * 33], s[1 * 33]); o.y = cvt_pk_bf16(s[2 * 33], s[3 * 33]); o.z = cvt_pk_bf16(s[4 * 33], s[5 * 33]); o.w = cvt_pk_bf16(s[6 * 33], s[7 * 33]);
        const int ng = n0 + n; const int row = (MODE == 0) ? ng : ((ng >> 7) * 256 + (ng & 127) + (MODE == 2 ? 128 : 0));
        *(u32x4*)(WT + (size_t)row * K + k0 + 8 * c) = o; }
    LDS_WAIT();
}
template <int MODE>
DI void cvt_item8(const float* W, int K, int N, unsigned char* WT, LAS float* scr, int kb, int nb, int lane, float wsc) {
    const int k0 = 64 * kb, n0 = 32 * nb;
    float v[32];
    const float* wp = W + (size_t)(k0 + (lane >> 5)) * N + n0 + (lane & 31);
#pragma unroll
    for (int i = 0; i < 32; ++i) v[i] = wp[(size_t)(2 * i) * N];
#pragma unroll
    for (int i = 0; i < 32; ++i) scr[(2 * i + (lane >> 5)) * 33 + (lane & 31)] = v[i] * wsc;
    LDS_WAIT();
    const int c = lane & 3;
#pragma unroll
    for (int j = 0; j < 2; ++j) { const int n = (lane >> 2) + 16 * j; const LAS float* s = scr + (16 * c) * 33 + n;
        u32x4 o; o.x = pk4_fp8(s[0 * 33], s[1 * 33], s[2 * 33], s[3 * 33]); o.y = pk4_fp8(s[4 * 33], s[5 * 33], s[6 * 33], s[7 * 33]);
        o.z = pk4_fp8(s[8 * 33], s[9 * 33], s[10 * 33], s[11 * 33]); o.w = pk4_fp8(s[12 * 33], s[13 * 33], s[14 * 33], s[15 * 33]);
        const int ng = n0 + n; const int row = (MODE == 0) ? ng : ((ng >> 7) * 256 + (ng & 127) + (MODE == 2 ? 128 : 0));
        *(u32x4*)(WT + (size_t)row * K + k0 + 16 * c) = o; }
    LDS_WAIT();
}
template <int MODE>
DI void cvt_job8(const float* W, int K, int N, int nbatch, unsigned char* WT, size_t dst_bstride, LAS float* scr, int gw, int NGW, int lane, float wsc) {
    const int nnb = N / 32, per = (K / 64) * nnb, total = per * nbatch;
    for (int it = gw; it < total; it += NGW) {
        const int bt = it / per, r = it - bt * per, kb = r / nnb, nb = r - kb * nnb;
        cvt_item8<MODE>(W + (size_t)bt * K * N, K, N, WT + (size_t)bt * dst_bstride, scr, kb, nb, lane, wsc);
    }
}
template <int MODE>
DI void cvt_job(const float* W, int K, int N, int nbatch, bf16_t* WT, size_t dst_bstride, LAS float* scr, int gw, int NGW, int lane) {
    const int nnb = N / 32, per = (K / 64) * nnb, total = per * nbatch;
    for (int it = gw; it < total; it += NGW) {
        const int bt = it / per, r = it - bt * per, kb = r / nnb, nb = r - kb * nnb;
        cvt_item<MODE>(W + (size_t)bt * K * N, K, N, WT + (size_t)bt * dst_bstride, scr, kb, nb, lane);
    }
}

DI void cvtw_load(f32x4 (&v)[16], const float* wp, int N) {
#pragma unroll
    for (int i = 0; i < 16; ++i) v[i] = __builtin_nontemporal_load((const f32x4*)(wp + (size_t)(4 * i) * N));
}
template <int MODE, bool OUT8>
DI void cvtw_store(const f32x4 (&v)[16], int K, void* WTb, LAS float* scr, int k0, int n0, int lane, float wsc) {
    const int kr = lane >> 4, n4 = lane & 15;
#pragma unroll
    for (int i = 0; i < 16; ++i)
#pragma unroll
        for (int e = 0; e < 4; ++e) scr[(4 * n4 + e) * 65 + 4 * i + kr] = OUT8 ? v[i][e] * wsc : v[i][e];
    LDS_WAIT();
    if (OUT8) {
        unsigned char* WT = (unsigned char*)WTb; const int c = lane & 3;
#pragma unroll
        for (int j = 0; j < 4; ++j) { const int n = (lane >> 2) + 16 * j; const LAS float* s = scr + n * 65 + 16 * c;
            u32x4 o; o.x = pk4_fp8(s[0], s[1], s[2], s[3]); o.y = pk4_fp8(s[4], s[5], s[6], s[7]); o.z = pk4_fp8(s[8], s[9], s[10], s[11]); o.w = pk4_fp8(s[12], s[13], s[14], s[15]);
            const int ng = n0 + n; const int row = (MODE == 0) ? ng : ((ng >> 7) * 256 + (ng & 127) + (MODE == 2 ? 128 : 0));
            *(u32x4*)(WT + (size_t)row * K + k0 + 16 * c) = o; }
    } else {
        bf16_t* WT = (bf16_t*)WTb; const int c = lane & 7;
#pragma unroll
        for (int j = 0; j < 8; ++j) { const int n = (lane >> 3) + 8 * j; const LAS float* s = scr + n * 65 + 8 * c;
            u32x4 o; o.x = cvt_pk_bf16(s[0], s[1]); o.y = cvt_pk_bf16(s[2], s[3]); o.z = cvt_pk_bf16(s[4], s[5]); o.w = cvt_pk_bf16(s[6], s[7]);
            const int ng = n0 + n; const int row = (MODE == 0) ? ng : ((ng >> 7) * 256 + (ng & 127) + (MODE == 2 ? 128 : 0));
            *(u32x4*)(WT + (size_t)row * K + k0 + 8 * c) = o; }
    }
    LDS_WAIT();
}
DI void cvtw_pack8(const f32x4 (&v)[16], LAS float* scr, int lane, float wsc, u32x4 (&o)[4]) {
    const int kr = lane >> 4, n4 = lane & 15;
#pragma unroll
    for (int i = 0; i < 16; ++i)
#pragma unroll
        for (int e = 0; e < 4; ++e) scr[(4 * n4 + e) * 65 + 4 * i + kr] = v[i][e] * wsc;
    LDS_WAIT();
    const int c = lane & 3;
#pragma unroll
    for (int j = 0; j < 4; ++j) { const int n = (lane >> 2) + 16 * j; const LAS float* s = scr + n * 65 + 16 * c;
        o[j].x = pk4_fp8(s[0], s[1], s[2], s[3]); o[j].y = pk4_fp8(s[4], s[5], s[6], s[7]); o[j].z = pk4_fp8(s[8], s[9], s[10], s[11]); o[j].w = pk4_fp8(s[12], s[13], s[14], s[15]); }
    LDS_WAIT();
}
template <int MODE, bool OUT8>
DI void cvtw_job(const float* W, int K, int N, int nbatch, void* WT, size_t dst_bstride_bytes, LAS float* scr, int gw, int NGW, int lane, float wsc, int ld = 0, int off = 0) {
    const int nnb = N / 64, per = (K / 128) * nnb, total = per * nbatch;
    const int pitch = ld ? ld : N;
    const int first = (gw + NGW - (off % NGW)) % NGW;
    if (first >= total) return;
#define CVTW_SRC(it_) ({ const int bt_ = (it_) / per, r_ = (it_) - bt_ * per, kb_ = r_ / nnb, nb_ = r_ - kb_ * nnb; W + (size_t)bt_ * K * pitch + (size_t)(128 * kb_ + (lane >> 4)) * pitch + 64 * nb_ + 4 * (lane & 15); })
    for (int it = first; it < total; it += NGW) {
        const int bt = it / per, r = it - bt * per, kb = r / nnb, nb = r - kb * nnb, k0 = 128 * kb, n0 = 64 * nb;
        f32x4 v0[16], v1[16];
        { const float* wp = CVTW_SRC(it); cvtw_load(v0, wp, pitch); cvtw_load(v1, wp + (size_t)64 * pitch, pitch); }
        void* WTb = (unsigned char*)WT + (size_t)bt * dst_bstride_bytes;
        if (OUT8) {
            u32x4 o0[4], o1[4];
            cvtw_pack8(v0, scr, lane, wsc, o0);
            cvtw_pack8(v1, scr, lane, wsc, o1);
            unsigned char* WT8 = (unsigned char*)WTb; const int c = lane & 3;
#pragma unroll
            for (int j = 0; j < 4; ++j) { const int ng = n0 + (lane >> 2) + 16 * j; const int row = (MODE == 0) ? ng : ((ng >> 7) * 256 + (ng & 127) + (MODE == 2 ? 128 : 0));
                unsigned char* dp = WT8 + (size_t)row * K + k0 + 16 * c; *(u32x4*)dp = o0[j]; *(u32x4*)(dp + 64) = o1[j]; }
        } else {
            cvtw_store<MODE, OUT8>(v0, K, WTb, scr, k0, n0, lane, wsc);
            cvtw_store<MODE, OUT8>(v1, K, WTb, scr, k0 + 64, n0, lane, wsc);
        }
    }
#undef CVTW_SRC
}

constexpr float HSCALE = 8.f, WSCALE = 256.f, ASCALE = 8.f;
template <bool ROUTER, bool OUT8 = false, bool X16 = false>
DI void rms_mod_phase(const void* X, const float* g, const float* scale, const float* shift, bf16_t* out,
                      const float* router, int* tok_e, int* tok_pos, float* tok_w, unsigned* ecnt, unsigned char* HS2, int gw, int NGW, int lane, LAS float* rl = nullptr, int tid = 0) {
    if (ROUTER) {
        for (int c = tid; c < DM; c += NTHREADS) { const f32x4 r0 = ((const f32x4*)router)[2 * c], r1 = ((const f32x4*)router)[2 * c + 1];
            rl[c] = r0.x; rl[DM + c] = r0.y; rl[2 * DM + c] = r0.z; rl[3 * DM + c] = r0.w; rl[4 * DM + c] = r1.x; rl[5 * DM + c] = r1.y; rl[6 * DM + c] = r1.z; rl[7 * DM + c] = r1.w; }
        __syncthreads();
    }
    for (int row0 = 4 * gw; row0 < MTOK; row0 += 4 * NGW) {
        const int b = row0 >> 11;
        const f32x4* gp = (const f32x4*)g + lane; const f32x4* sc = (const f32x4*)(scale + (size_t)b * 12288) + lane; const f32x4* sh = (const f32x4*)(shift + (size_t)b * 12288) + lane;
        f32x4 gm[8], shv[8];
        if (!ROUTER) {
#pragma unroll
          for (int j = 0; j < 8; ++j) { gm[j] = gp[64 * j] * (sc[64 * j] + 1.0f); shv[j] = sh[64 * j]; } }
#pragma unroll 1
      for (int rr = 0; rr < 4; ++rr) { const int row = row0 + rr;
        f32x4 v[8]; float ss = 0.f;
        if (X16) { const u32x2* xr = (const u32x2*)((const bf16_t*)X + (size_t)row * DM) + lane; u32x2 raw[8];
#pragma unroll
            for (int j = 0; j < 8; ++j) raw[j] = xr[64 * j];
#pragma unroll
            for (int j = 0; j < 8; ++j) v[j] = (f32x4){bf_lo(raw[j].x), bf_hi(raw[j].x), bf_lo(raw[j].y), bf_hi(raw[j].y)}; }
        else { const f32x4* xr = (const f32x4*)((const float*)X + (size_t)row * DM) + lane;
#pragma unroll
            for (int j = 0; j < 8; ++j) v[j] = xr[64 * j]; }
#pragma unroll
        for (int j = 0; j < 8; ++j) ss += (v[j].x * v[j].x + v[j].y * v[j].y) + (v[j].z * v[j].z + v[j].w * v[j].w);
        const float rstd = 1.0f / sqrtf(wave_sum(ss) * (1.f / DM) + 1e-6f);
        u32x2* op = (u32x2*)(out + (size_t)row * DM) + lane;
        float lg[8] = {0.f, 0.f, 0.f, 0.f, 0.f, 0.f, 0.f, 0.f}; unsigned h8[8];
#pragma unroll
        for (int j = 0; j < 8; ++j) {
            const f32x4 h = ROUTER ? (v[j] * rstd) * (gp[64 * j] * (sc[64 * j] + 1.0f)) + sh[64 * j] : (v[j] * rstd) * gm[j] + shv[j];
            if (ROUTER) { h8[j] = pk4_fp8(h.x * HSCALE, h.y * HSCALE, h.z * HSCALE, h.w * HSCALE); }
            else { u32x2 w; w.x = cvt_pk_bf16(h.x, h.y); w.y = cvt_pk_bf16(h.z, h.w); op[64 * j] = w;
                   if (OUT8) ((unsigned*)(HS2 + (size_t)row * DM) + lane)[64 * j] = pk4_fp8(h.x * HSCALE, h.y * HSCALE, h.z * HSCALE, h.w * HSCALE); }
            if (ROUTER) {
#pragma unroll
                for (int e = 0; e < 8; ++e) { const f32x4 we = *(const LAS f32x4*)(rl + e * DM + 256 * j + 4 * lane); lg[e] += (h.x * we.x + h.y * we.y) + (h.z * we.z + h.w * we.w); }
                __builtin_amdgcn_sched_barrier(0); } }
        if (ROUTER) {
#pragma unroll
            for (int e = 0; e < 8; ++e) lg[e] = wave_sum(lg[e]);
            if (lane == 0) {
                int i0 = 0; float v0 = lg[0];
#pragma unroll
                for (int e = 1; e < 8; ++e) if (lg[e] > v0) { v0 = lg[e]; i0 = e; }
                int i1 = -1; float v1 = -3.0e38f;
#pragma unroll
                for (int e = 0; e < 8; ++e) if (e != i0 && lg[e] > v1) { v1 = lg[e]; i1 = e; }
                const float w1 = 1.f / (1.f + expf(v0 - v1)), w0 = 1.f - w1;
                const int p0 = (int)__hip_atomic_fetch_add(ecnt + 64 * i0, 1u, __ATOMIC_RELAXED, __HIP_MEMORY_SCOPE_AGENT);
                const int p1 = (int)__hip_atomic_fetch_add(ecnt + 64 * i1, 1u, __ATOMIC_RELAXED, __HIP_MEMORY_SCOPE_AGENT);
                tok_e[2 * row] = i0; tok_e[2 * row + 1] = i1; tok_pos[2 * row] = p0; tok_pos[2 * row + 1] = p1; tok_w[2 * row] = w0; tok_w[2 * row + 1] = w1;
                lg[0] = __int_as_float(i0 * pg8::ECAP + p0); lg[1] = __int_as_float(i1 * pg8::ECAP + p1);
            }
            const int ra = __builtin_amdgcn_readfirstlane(__float_as_int(lg[0])), rb = __builtin_amdgcn_readfirstlane(__float_as_int(lg[1]));
            unsigned* da = (unsigned*)(HS2 + (size_t)ra * DM) + lane; unsigned* db = (unsigned*)(HS2 + (size_t)rb * DM) + lane;
#pragma unroll
            for (int j = 0; j < 8; ++j) { da[64 * j] = h8[j]; db[64 * j] = h8[j]; }
        }
      }
    }
}

DI void qknorm_phase(const bf16_t* QK, bf16_t* QKN, const float* qg, const float* kg, int gw, int NGW, int lane) {
    const int l16 = lane & 15;
    for (int idx = gw * 4 + (lane >> 4); idx < MTOK * 32; idx += NGW * 4) {
        const int hr = idx & 31; const size_t off = (size_t)(idx >> 5) * 4096 + hr * 128 + 8 * l16;
        const u32x4 raw = *(const u32x4*)(QK + off);
        float x[8] = {bf_lo(raw.x), bf_hi(raw.x), bf_lo(raw.y), bf_hi(raw.y), bf_lo(raw.z), bf_hi(raw.z), bf_lo(raw.w), bf_hi(raw.w)};
        float ss = 0.f;
#pragma unroll
        for (int i = 0; i < 8; ++i) ss += x[i] * x[i];
        ss += __shfl_xor(ss, 1); ss += __shfl_xor(ss, 2); ss += __shfl_xor(ss, 4); ss += __shfl_xor(ss, 8);
        const float rstd = (1.0f / sqrtf(ss * (1.f / 128.f) + 1e-6f)) * (hr < 16 ? 0.08838834764831845f : 1.0f);
        const float* gp = (hr < 16 ? qg : kg) + 8 * l16;
        const f32x4 g0 = *(const f32x4*)gp, g1 = *(const f32x4*)(gp + 4);
        u32x4 o; o.x = cvt_pk_bf16(x[0] * rstd * g0.x, x[1] * rstd * g0.y); o.y = cvt_pk_bf16(x[2] * rstd * g0.z, x[3] * rstd * g0.w);
        o.z = cvt_pk_bf16(x[4] * rstd * g1.x, x[5] * rstd * g1.y); o.w = cvt_pk_bf16(x[6] * rstd * g1.z, x[7] * rstd * g1.w);
        *(u32x4*)(QKN + off) = o;
    }
}

constexpr int NA_TBL = 0, NA_BUF = 30720, NA_TILE = 18432;
DI void na_phase(const bf16_t* QKN, const bf16_t* VT, bf16_t* ATT, const float* rpb, LAS unsigned char* lds, int G, int vcu0, int tid, int lane, int wave) {
    LAS float* rpbL = (LAS float*)(lds + NA_TBL);
    for (int i = tid; i < 16 * 465; i += NTHREADS) rpbL[i] = rpb[i];
    const int c16 = lane & 15, g = lane >> 4, unit = wave >> 2, j = wave & 3;
    const int cb = (j == 0) ? 0 : (j == 1) ? 8 : (j == 2) ? 24 : 32;
    const int qc = 16 * j + c16, c0 = min(max(qc - 8, 0), 48);
    const int kcl = 8 * (c16 >> 2) + (c16 & 3);
    for (int p = vcu0; p < 1024; p += G) {
        const int rho = p & 15, hh = (p >> 4) & 15, b = p >> 8;
        const int rA = 2 * rho, r0A = min(max(rA - 4, 0), 24), r0B = min(max(rA + 1 - 4, 0), 24), delta = r0B - r0A, nrows = 8 + delta;
        const int r = rA + unit, r0 = unit ? r0B : r0A;
        const bool shiftB = (unit == 1) && (delta == 1);
        const size_t tq = (size_t)b * SEQ + r * 64 + qc;
        bf16x8 qf[4];
#pragma unroll
        for (int ks = 0; ks < 4; ++ks) qf[ks] = *(const bf16x8*)(QKN + tq * 4096 + hh * 128 + 32 * ks + 8 * g);
        f32x4 S[8][2];
        u32x4 st0, st1;
        const int kkey = tid >> 3, kch = tid & 7;
        const int vd = tid >> 2, vch = tid & 3;
        const bf16_t* kg = QKN + ((size_t)b * SEQ + (size_t)r0A * 64 + kkey) * 4096 + 2048 + hh * 128 + kch * 8;
        const bf16_t* vg = VT + (size_t)(hh * 128 + vd) * MTOK + (size_t)b * SEQ + (size_t)r0A * 64 + vch * 8;
#define NA_LDK(s_) do { st0 = *(const u32x4*)(kg + (size_t)(s_) * 64 * 4096); st1 = *(const u32x4*)(kg + (size_t)(s_) * 64 * 4096 + 64); } while (0)
#define NA_STK(s_) do { LAS unsigned char* t_ = lds + NA_BUF + ((s_) & 1) * NA_TILE + kkey * 272 + kch * 16; *(LAS u32x4*)t_ = st0; *(LAS u32x4*)(t_ + 128) = st1; } while (0)
#define NA_LDV(s_) do { st0 = *(const u32x4*)(vg + (s_) * 64); st1 = *(const u32x4*)(vg + (s_) * 64 + 32); } while (0)
#define NA_STV(s_) do { LAS unsigned char* t_ = lds + NA_BUF + ((s_) & 1) * NA_TILE + vd * 144 + vch * 16; *(LAS u32x4*)t_ = st0; *(LAS u32x4*)(t_ + 64) = st1; } while (0)
#define NA_QK(s_, i_) do { const LAS unsigned char* kb_ = lds + NA_BUF + ((s_) & 1) * NA_TILE + (cb + kcl) * 272 + 16 * g; \
            _Pragma("unroll") for (int hc = 0; hc < 2; ++hc) { f32x4 a = (f32x4){0.f, 0.f, 0.f, 0.f}; \
                _Pragma("unroll") for (int ks = 0; ks < 4; ++ks) a = __builtin_amdgcn_mfma_f32_16x16x32_bf16(*(const LAS bf16x8*)(kb_ + hc * 4 * 272 + 64 * ks), qf[ks], a, 0, 0, 0); S[i_][hc] = a; } } while (0)
#define NA_SROW(s_) do { if ((s_) < nrows) { NA_STK(s_); __syncthreads(); if ((s_) + 1 < nrows) NA_LDK((s_) + 1); \
            if (!shiftB) { if ((s_) < 8) NA_QK(s_, (s_) < 8 ? (s_) : 7); } else { if ((s_) >= 1) NA_QK(s_, (s_) >= 1 ? (s_) - 1 : 0); } } } while (0)
        __syncthreads();
        NA_LDK(0);
        NA_SROW(0); NA_SROW(1); NA_SROW(2); NA_SROW(3); NA_SROW(4); NA_SROW(5); NA_SROW(6); NA_SROW(7); NA_SROW(8);
        NA_LDV(0);
        float mx = -3.0e38f;
        const LAS float* bt = rpbL + hh * 465;
#pragma unroll
        for (int i = 0; i < 8; ++i)
#pragma unroll
            for (int hc = 0; hc < 2; ++hc)
#pragma unroll
                for (int e = 0; e < 4; ++e) {
                    const int kc = cb + 8 * g + 4 * hc + e; const bool valid = (kc >= c0) && (kc < c0 + 16);
                    const int dj = min(max(kc - qc + 15, 0), 30), di = r0 + i - r + 7;
                    const float sv = valid ? S[i][hc][e] + bt[di * 31 + dj] : -3.0e38f;
                    S[i][hc][e] = sv; mx = fmaxf(mx, sv);
                }
        mx = fmaxf(mx, __shfl_xor(mx, 16)); mx = fmaxf(mx, __shfl_xor(mx, 32));
        float sum = 0.f;
#pragma unroll
        for (int i = 0; i < 8; ++i)
#pragma unroll
            for (int hc = 0; hc < 2; ++hc)
#pragma unroll
                for (int e = 0; e < 4; ++e) { const float pv = (S[i][hc][e] > -1.0e38f) ? __expf(S[i][hc][e] - mx) : 0.f; S[i][hc][e] = pv; sum += pv; }
        sum += __shfl_xor(sum, 16); sum += __shfl_xor(sum, 32);
        const float inv = 1.0f / sum;
        f32x4 O[8];
#pragma unroll
        for (int dt = 0; dt < 8; ++dt) O[dt] = (f32x4){0.f, 0.f, 0.f, 0.f};
#define NA_PV(s_, i_) do { u32x4 pw; pw.x = cvt_pk_bf16(S[i_][0][0], S[i_][0][1]); pw.y = cvt_pk_bf16(S[i_][0][2], S[i_][0][3]); pw.z = cvt_pk_bf16(S[i_][1][0], S[i_][1][1]); pw.w = cvt_pk_bf16(S[i_][1][2], S[i_][1][3]); \
            const bf16x8 pf = __builtin_bit_cast(bf16x8, pw); const LAS unsigned char* vb_ = lds + NA_BUF + ((s_) & 1) * NA_TILE + c16 * 144 + (cb + 8 * g) * 2; \
            _Pragma("unroll") for (int dt = 0; dt < 8; ++dt) O[dt] = __builtin_amdgcn_mfma_f32_16x16x32_bf16(*(const LAS bf16x8*)(vb_ + dt * 16 * 144), pf, O[dt], 0, 0, 0); } while (0)
#define NA_VROW(s_) do { if ((s_) < nrows) { NA_STV(s_); __syncthreads(); if ((s_) + 1 < nrows) NA_LDV((s_) + 1); \
            if (!shiftB) { if ((s_) < 8) NA_PV(s_, (s_) < 8 ? (s_) : 7); } else { if ((s_) >= 1) NA_PV(s_, (s_) >= 1 ? (s_) - 1 : 0); } } } while (0)
        __syncthreads();
        NA_VROW(0); NA_VROW(1); NA_VROW(2); NA_VROW(3); NA_VROW(4); NA_VROW(5); NA_VROW(6); NA_VROW(7); NA_VROW(8);
#undef NA_LDK
#undef NA_STK
#undef NA_LDV
#undef NA_STV
#undef NA_QK
#undef NA_SROW
#undef NA_PV
#undef NA_VROW
#pragma unroll
        for (int dt = 0; dt < 8; ++dt) { u32x2 w; w.x = cvt_pk_bf16(O[dt][0] * inv, O[dt][1] * inv); w.y = cvt_pk_bf16(O[dt][2] * inv, O[dt][3] * inv);
            *(u32x2*)(ATT + tq * DM + hh * 128 + 16 * dt + 4 * g) = w; }
    }
}

constexpr int MLP_WIF = 36864, MLP_WROW = 3088;
DI void ml_pre_phase(const bf16_t* XZ, const float* conv_w, const float* conv_b, const float* wq, const float* wk, const float* wv, const bf16_t* WTif,
                     bf16_t* XC, bf16_t* Q, bf16_t* Kb, bf16_t* V, float* pre_part, LAS unsigned char* lds, int G, int tid, int lane, int wave) {
    LAS float* Lcw = (LAS float*)lds;
    LAS float* Lcb = Lcw + 2560;
    LAS float* Lwq = Lcb + 512;
    LAS float* Lwk = Lwq + 2048;
    LAS float* Lwv = Lwk + 2048;
    LAS unsigned char* Lwif = lds + MLP_WIF;
    const int g = lane >> 4, tk = lane & 15;
    for (int item = blockIdx.x; item < 256; item += G) {
        const int hd = item & 7, tr = item >> 3;
        __syncthreads();
        for (int i = tid; i < 2560; i += NTHREADS) Lcw[i] = conv_w[(i >> 9) * 4096 + hd * 512 + (i & 511)];
        Lcb[tid] = conv_b[hd * 512 + tid];
        for (int i = tid; i < 2048; i += NTHREADS) { Lwq[i] = wq[hd * 2048 + i]; Lwk[i] = wk[hd * 2048 + i]; Lwv[i] = wv[hd * 2048 + i]; }
        for (int i = tid; i < 32 * 3 * 64; i += NTHREADS) { const int n = i / 192, rem = i - n * 192, sec = rem >> 6, c16 = rem & 63;
            *(LAS u32x4*)(Lwif + n * MLP_WROW + sec * 1024 + c16 * 16) = *(const u32x4*)(WTif + (size_t)n * 12288 + sec * 4096 + hd * 512 + c16 * 8); }
        __syncthreads();
        for (int tt = wave; tt < 16; tt += 8) {
            const int tok = tr * 256 + tt * 16 + tk, tseq = tok & 2047;
            f32x4 accp[2]; accp[0] = (f32x4){0.f, 0.f, 0.f, 0.f}; accp[1] = (f32x4){0.f, 0.f, 0.f, 0.f};
            u32x4 xrA[5], xrB[5], hq, hk, hv, hc;
#define MLP_LOAD(xr_, step_) do { const int ch_ = hd * 512 + (step_) * 32 + 8 * g; \
                _Pragma("unroll") for (int jt = 0; jt < 5; ++jt) { const int dt = jt - 2; const bool ok = (unsigned)(tseq + dt) < (unsigned)SEQ; \
                    xr_[jt] = (u32x4){0u, 0u, 0u, 0u}; if (ok) xr_[jt] = *(const u32x4*)(XZ + (size_t)(tok + dt) * 8192 + ch_); } } while (0)
#define MLP_COMPUTE(xr_, step_, HOLD_) do { \
                const int cl = (step_) * 32 + 8 * g, ch = hd * 512 + cl; \
                float a[8], xm[8]; \
                { const f32x4 b0 = *(const LAS f32x4*)(Lcb + cl), b1 = *(const LAS f32x4*)(Lcb + cl + 4); \
                  a[0] = b0.x; a[1] = b0.y; a[2] = b0.z; a[3] = b0.w; a[4] = b1.x; a[5] = b1.y; a[6] = b1.z; a[7] = b1.w; } \
                _Pragma("unroll") for (int jt = 0; jt < 5; ++jt) { \
                    const u32x4 xr = xr_[jt]; \
                    const float xv[8] = {bf_lo(xr.x), bf_hi(xr.x), bf_lo(xr.y), bf_hi(xr.y), bf_lo(xr.z), bf_hi(xr.z), bf_lo(xr.w), bf_hi(xr.w)}; \
                    const f32x4 w0 = *(const LAS f32x4*)(Lcw + jt * 512 + cl), w1 = *(const LAS f32x4*)(Lcw + jt * 512 + cl + 4); \
                    a[0] += xv[0] * w0.x; a[1] += xv[1] * w0.y; a[2] += xv[2] * w0.z; a[3] += xv[3] * w0.w; a[4] += xv[4] * w1.x; a[5] += xv[5] * w1.y; a[6] += xv[6] * w1.z; a[7] += xv[7] * w1.w; \
                    if (jt == 2) { _Pragma("unroll") for (int i = 0; i < 8; ++i) xm[i] = xv[i]; } } \
                float xc[8], q[8], k[8], v[8]; \
                _Pragma("unroll") for (int i = 0; i < 8; ++i) xc[i] = silu_f(a[i]); \
                _Pragma("unroll") for (int blk = 0; blk < 2; ++blk) { const int wo = ((cl >> 2) + blk) * 16; \
                    _Pragma("unroll") for (int o = 0; o < 4; ++o) { float sq = 0.f, sk = 0.f, sv = 0.f; \
                        _Pragma("unroll") for (int i = 0; i < 4; ++i) { sq += xc[4 * blk + i] * Lwq[wo + i * 4 + o]; sk += xc[4 * blk + i] * Lwk[wo + i * 4 + o]; sv += xm[4 * blk + i] * Lwv[wo + i * 4 + o]; } \
                        q[4 * blk + o] = sq; k[4 * blk + o] = sk; v[4 * blk + o] = sv; } } \
                u32x4 qw, kw, vw, cw; \
                qw.x = cvt_pk_bf16(q[0], q[1]); qw.y = cvt_pk_bf16(q[2], q[3]); qw.z = cvt_pk_bf16(q[4], q[5]); qw.w = cvt_pk_bf16(q[6], q[7]); \
                kw.x = cvt_pk_bf16(k[0], k[1]); kw.y = cvt_pk_bf16(k[2], k[3]); kw.z = cvt_pk_bf16(k[4], k[5]); kw.w = cvt_pk_bf16(k[6], k[7]); \
                vw.x = cvt_pk_bf16(v[0], v[1]); vw.y = cvt_pk_bf16(v[2], v[3]); vw.z = cvt_pk_bf16(v[4], v[5]); vw.w = cvt_pk_bf16(v[6], v[7]); \
                cw.x = cvt_pk_bf16(xc[0], xc[1]); cw.y = cvt_pk_bf16(xc[2], xc[3]); cw.z = cvt_pk_bf16(xc[4], xc[5]); cw.w = cvt_pk_bf16(xc[6], xc[7]); \
                const size_t o4 = (size_t)tok * 4096 + ch; \
                if (HOLD_) { hq = qw; hk = kw; hv = vw; hc = cw; }     \
                else { *(u32x4*)(Q + o4 - 32) = hq; *(u32x4*)(Q + o4) = qw; *(u32x4*)(Kb + o4 - 32) = hk; *(u32x4*)(Kb + o4) = kw; *(u32x4*)(V + o4 - 32) = hv; *(u32x4*)(V + o4) = vw; *(u32x4*)(XC + o4 - 32) = hc; *(u32x4*)(XC + o4) = cw; } \
                const bf16x8 qf = __builtin_bit_cast(bf16x8, qw), kf = __builtin_bit_cast(bf16x8, kw), vf = __builtin_bit_cast(bf16x8, vw); \
                _Pragma("unroll") for (int nt = 0; nt < 2; ++nt) { const LAS unsigned char* wp = Lwif + (nt * 16 + tk) * MLP_WROW + cl * 2; \
                    accp[nt] = __builtin_amdgcn_mfma_f32_16x16x32_bf16(qf, *(const LAS bf16x8*)(wp), accp[nt], 0, 0, 0); \
                    accp[nt] = __builtin_amdgcn_mfma_f32_16x16x32_bf16(kf, *(const LAS bf16x8*)(wp + 1024), accp[nt], 0, 0, 0); \
                    accp[nt] = __builtin_amdgcn_mfma_f32_16x16x32_bf16(vf, *(const LAS bf16x8*)(wp + 2048), accp[nt], 0, 0, 0); } } while (0)
            MLP_LOAD(xrA, 0);
#pragma unroll 1
            for (int step = 0; step < 16; step += 2) {
                MLP_LOAD(xrB, step + 1);
                MLP_COMPUTE(xrA, step, true);
                { const int sn = (step + 2 < 16) ? step + 2 : 15; MLP_LOAD(xrA, sn); }
                MLP_COMPUTE(xrB, step + 1, false);
            }
#undef MLP_LOAD
#undef MLP_COMPUTE
#pragma unroll
            for (int nt = 0; nt < 2; ++nt)
#pragma unroll
                for (int e = 0; e < 4; ++e) pre_part[((size_t)hd * 32 + nt * 16 + tk) * MTOK + tr * 256 + tt * 16 + 4 * g + e] = accp[nt][e];
        }
    }
}

constexpr int ML_QS0 = 0, ML_KS0 = 16384, ML_QS1 = 32768, ML_KS1 = 49152, ML_VS0 = 65536, ML_VS1 = 81920, ML_WV = 98304, ML_SS = 114688, ML_SM = 123904;
constexpr int ML_XS = ML_QS1, ML_XN = ML_QS1;
constexpr int GB_U = 0, GB_MR = 64, GB_W = 128, GB_INT = 192, GB_BND = 256, GB_SC = 320;
constexpr int SM_DIN0 = 768, SM_DIN1 = 832, SM_NV = 896, SM_NVP = 1408, SM_DNQP = 3456, SM_GS = 3968, SM_CMX = 4000, SM_MC = 4032, SM_END = 4096;
static_assert(ML_SM + SM_END * 4 <= LDS_BYTES - 16, "mLSTM LDS");
constexpr float KSCALE = 0.04419417382415922f;

DI s16x4 tr_read(LAS unsigned char* p) { return __builtin_amdgcn_ds_read_tr16_b64_v4i16((LAS s16x4*)p); }
DI int dimg(int row, int ch) { return 2048 * (row >> 3) + 512 * (ch >> 2) + 64 * (row & 7) + 16 * ((ch & 3) ^ ((row >> 2) & 3)); }
DI bf16x8 frag_tr(LAS unsigned char* img, int k0, int c0, int lane) {
    const int h = lane >> 5, blk = (lane >> 4) & 1, q = (lane & 15) >> 2, p = lane & 3;
    const int row = k0 + 8 * h + q, ch = (c0 >> 3) + 2 * blk + (p >> 1), sub = 8 * (p & 1);
    const s16x4 lo = tr_read(img + dimg(row, ch) + sub), hi = tr_read(img + dimg(row + 4, ch) + sub);
    return __builtin_shufflevector(lo, hi, 0, 1, 2, 3, 4, 5, 6, 7);
}
#define MFMA32(a, b, c) __builtin_amdgcn_mfma_f32_32x32x16_bf16((a), (b), (c), 0, 0, 0)
DI void tr_batch4(bf16x8 (&f)[4], unsigned alo, unsigned ahi) {
    s16x4 l0, l1, l2, l3, h0, h1, h2, h3;
    asm volatile("ds_read_b64_tr_b16 %0, %8\n\tds_read_b64_tr_b16 %4, %9\n\tds_read_b64_tr_b16 %1, %8 offset:4096\n\tds_read_b64_tr_b16 %5, %9 offset:4096\n\t"
                 "ds_read_b64_tr_b16 %2, %8 offset:8192\n\tds_read_b64_tr_b16 %6, %9 offset:8192\n\tds_read_b64_tr_b16 %3, %8 offset:12288\n\tds_read_b64_tr_b16 %7, %9 offset:12288\n\t"
                 "s_waitcnt lgkmcnt(0)"
                 : "=&v"(l0), "=&v"(l1), "=&v"(l2), "=&v"(l3), "=&v"(h0), "=&v"(h1), "=&v"(h2), "=&v"(h3) : "v"(alo), "v"(ahi) : "memory");
    f[0] = __builtin_shufflevector(l0, h0, 0, 1, 2, 3, 4, 5, 6, 7); f[1] = __builtin_shufflevector(l1, h1, 0, 1, 2, 3, 4, 5, 6, 7);
    f[2] = __builtin_shufflevector(l2, h2, 0, 1, 2, 3, 4, 5, 6, 7); f[3] = __builtin_shufflevector(l3, h3, 0, 1, 2, 3, 4, 5, 6, 7);
}

DI void tr_issue4(s16x4& l0, s16x4& l1, s16x4& l2, s16x4& l3, s16x4& h0, s16x4& h1, s16x4& h2, s16x4& h3, unsigned alo, unsigned ahi) {
    asm volatile("ds_read_b64_tr_b16 %0, %8\n\tds_read_b64_tr_b16 %4, %9\n\tds_read_b64_tr_b16 %1, %8 offset:4096\n\tds_read_b64_tr_b16 %5, %9 offset:4096\n\t"
                 "ds_read_b64_tr_b16 %2, %8 offset:8192\n\tds_read_b64_tr_b16 %6, %9 offset:8192\n\tds_read_b64_tr_b16 %3, %8 offset:12288\n\tds_read_b64_tr_b16 %7, %9 offset:12288"
                 : "=&v"(l0), "=&v"(l1), "=&v"(l2), "=&v"(l3), "=&v"(h0), "=&v"(h1), "=&v"(h2), "=&v"(h3) : "v"(alo), "v"(ahi) : "memory");
}
DI void tr_wait8(s16x4& l0, s16x4& l1, s16x4& l2, s16x4& l3, s16x4& h0, s16x4& h1, s16x4& h2, s16x4& h3) {
    asm volatile("s_waitcnt lgkmcnt(0)" : "+v"(l0), "+v"(l1), "+v"(l2), "+v"(l3), "+v"(h0), "+v"(h1), "+v"(h2), "+v"(h3) :: "memory");
}
#define TR_CAT(f, l, h) do { f[0] = __builtin_shufflevector(l##0, h##0, 0, 1, 2, 3, 4, 5, 6, 7); f[1] = __builtin_shufflevector(l##1, h##1, 0, 1, 2, 3, 4, 5, 6, 7); \
        f[2] = __builtin_shufflevector(l##2, h##2, 0, 1, 2, 3, 4, 5, 6, 7); f[3] = __builtin_shufflevector(l##3, h##3, 0, 1, 2, 3, 4, 5, 6, 7); } while (0)

template <int I>
DI void ml_step(LAS unsigned char* lds, u32x4 (&Cp)[8][2], f32x16 (&num)[2], f32x16& Sacc, float& dnq, int tid, int lane, int wave, int gb) {
    asm volatile("" : "+v"(lane)); asm volatile("" : "+v"(tid));
    constexpr int QS = (I & 1) ? ML_QS1 : ML_QS0, KS = (I & 1) ? ML_KS1 : ML_KS0;
    const int r = lane & 31, h = lane >> 5, vt = wave & 3, dpar = wave >> 2;
    LAS float* SM = (LAS float*)(lds + ML_SM);
#define ML_SEC1 { const int wS = wave & 3, st = wS >> 1, tt1 = wS & 1, kh = wave >> 2; \
      if (!(st == 1 && tt1 == 0)) { \
        _Pragma("unroll") for (int ks = 0; ks < 4; ++ks) { const int kk = 4 * kh + ks; \
            const bf16x8 a = *(const LAS bf16x8*)(lds + KS + dimg(32 * st + r, 2 * kk + h)); \
            const bf16x8 b = *(const LAS bf16x8*)(lds + QS + dimg(32 * tt1 + r, 2 * kk + h)); \
            Sacc = MFMA32(a, b, Sacc); } } }
#define ML_SEC4 { _Pragma("unroll") for (int jj = 0; jj < 2; ++jj) { const int dl = dpar + 2 * jj; \
        _Pragma("unroll") for (int s2 = 0; s2 < 2; ++s2) { const bf16x8 a = __builtin_bit_cast(bf16x8, Cp[2 * I + jj][s2]); \
            _Pragma("unroll") for (int tt = 0; tt < 2; ++tt) { LAS unsigned char* qb = lds + QS + 8 * h; \
                const s16x4 lo = *(const LAS s16x4*)(qb + dimg(32 * tt + r, 4 * dl + 2 * s2)), hi = *(const LAS s16x4*)(qb + dimg(32 * tt + r, 4 * dl + 2 * s2 + 1)); \
                num[tt] = MFMA32(a, __builtin_shufflevector(lo, hi, 0, 1, 2, 3, 4, 5, 6, 7), num[tt]); } } } }
#define ML_UPD(jj_) { _Pragma("unroll") for (int s2 = 0; s2 < 2; ++s2) { const u32x4 o = Cp[2 * I + (jj_)][s2]; u32x4 n; \
            n.x = cvt_pk_bf16(bf_lo(o.x) * decay + U[8 * s2 + 0], bf_hi(o.x) * decay + U[8 * s2 + 1]); n.y = cvt_pk_bf16(bf_lo(o.y) * decay + U[8 * s2 + 2], bf_hi(o.y) * decay + U[8 * s2 + 3]); \
            n.z = cvt_pk_bf16(bf_lo(o.z) * decay + U[8 * s2 + 4], bf_hi(o.z) * decay + U[8 * s2 + 5]); n.w = cvt_pk_bf16(bf_lo(o.w) * decay + U[8 * s2 + 6], bf_hi(o.w) * decay + U[8 * s2 + 7]); \
            asm volatile("" : "+v"(n)); Cp[2 * I + (jj_)][s2] = n; } }
#define ML_SEC5 { const float decay = SM[gb + GB_SC + 0]; \
      const int blk = (lane >> 4) & 1, q = (lane & 15) >> 2, p = lane & 3, sub = 8 * (p & 1), rlo = 8 * h + q; \
      const unsigned ldsu = (unsigned)(size_t)lds; const int chB = 4 * vt + 2 * blk + (p >> 1), chA0 = 4 * dpar + 2 * blk + (p >> 1), chA1 = chA0 + 8; \
      s16x4 bl0, bl1, bl2, bl3, bh0, bh1, bh2, bh3, al0, al1, al2, al3, ah0, ah1, ah2, ah3, cl0, cl1, cl2, cl3, ch0, ch1, ch2, ch3; \
      tr_issue4(bl0, bl1, bl2, bl3, bh0, bh1, bh2, bh3, ldsu + ML_WV + dimg(rlo, chB) + sub, ldsu + ML_WV + dimg(rlo + 4, chB) + sub); \
      tr_issue4(al0, al1, al2, al3, ah0, ah1, ah2, ah3, ldsu + KS + dimg(rlo, chA0) + sub, ldsu + KS + dimg(rlo + 4, chA0) + sub); \
      tr_wait8(al0, al1, al2, al3, ah0, ah1, ah2, ah3); tr_wait8(bl0, bl1, bl2, bl3, bh0, bh1, bh2, bh3); \
      tr_issue4(cl0, cl1, cl2, cl3, ch0, ch1, ch2, ch3, ldsu + KS + dimg(rlo, chA1) + sub, ldsu + KS + dimg(rlo + 4, chA1) + sub); \
      bf16x8 Bf[4], Af[4]; TR_CAT(Bf, bl, bh); TR_CAT(Af, al, ah); \
      f32x16 U; \
      _Pragma("unroll") for (int e = 0; e < 16; ++e) U[e] = 0.f; \
      _Pragma("unroll") for (int ks = 0; ks < 4; ++ks) U = MFMA32(Af[ks], Bf[ks], U); \
      ML_UPD(0) \
      tr_wait8(cl0, cl1, cl2, cl3, ch0, ch1, ch2, ch3); TR_CAT(Af, cl, ch); \
      _Pragma("unroll") for (int e = 0; e < 16; ++e) U[e] = 0.f; \
      _Pragma("unroll") for (int ks = 0; ks < 4; ++ks) U = MFMA32(Af[ks], Bf[ks], U); \
      ML_UPD(1) }
#define ML_SECV { { const int t = tid & 63, dg = tid >> 6; \
      const u32x4 q0 = *(const LAS u32x4*)(lds + QS + dimg(t, 2 * dg)), q1 = *(const LAS u32x4*)(lds + QS + dimg(t, 2 * dg + 1)); \
      const LAS f32x4* nv = (const LAS f32x4*)(SM + SM_NV + 128 * I + 16 * dg); \
      const f32x4 n0 = nv[0], n1 = nv[1], n2 = nv[2], n3 = nv[3]; \
      dnq += bf_lo(q0.x) * n0.x + bf_hi(q0.x) * n0.y + bf_lo(q0.y) * n0.z + bf_hi(q0.y) * n0.w + bf_lo(q0.z) * n1.x + bf_hi(q0.z) * n1.y + bf_lo(q0.w) * n1.z + bf_hi(q0.w) * n1.w \
           + bf_lo(q1.x) * n2.x + bf_hi(q1.x) * n2.y + bf_lo(q1.y) * n2.z + bf_hi(q1.y) * n2.w + bf_lo(q1.z) * n3.x + bf_hi(q1.z) * n3.y + bf_lo(q1.w) * n3.z + bf_hi(q1.w) * n3.w; } \
    { const int dp = tid & 63, sg = tid >> 6; float a0 = 0.f, a1 = 0.f; \
      const f32x4 wA = *(const LAS f32x4*)(SM + gb + GB_W + 8 * sg), wB = *(const LAS f32x4*)(SM + gb + GB_W + 8 * sg + 4); const float ww[8] = {wA.x, wA.y, wA.z, wA.w, wB.x, wB.y, wB.z, wB.w}; \
      _Pragma("unroll") for (int s = 0; s < 8; ++s) { const unsigned kk2 = *(const LAS unsigned*)(lds + KS + dimg(8 * sg + s, dp >> 2) + 4 * (dp & 3)); a0 += ww[s] * bf_lo(kk2); a1 += ww[s] * bf_hi(kk2); } \
      ((LAS unsigned*)(SM + SM_NVP))[sg * 256 + 64 * I + dp] = cvt_pk_bf16(a0, a1); } }
    ML_SEC1 ML_SEC4 ML_SEC5 ML_SECV
#undef ML_SEC1
#undef ML_SEC4
#undef ML_UPD
#undef ML_SEC5
#undef ML_SECV
}

DI float lane_read(float v, int src_lane) { return __builtin_bit_cast(float, __builtin_amdgcn_ds_bpermute(src_lane << 2, __builtin_bit_cast(int, v))); }
DI void ml_scan(float li_, float lf_, float& u_, float& cm_, float& bs_, int lane) {
    bs_ = lf_;
#pragma unroll
    for (int o_ = 1; o_ < 64; o_ <<= 1) { const float t_ = lane_read(bs_, (lane - o_) & 63); if (lane >= o_) bs_ += t_; }
    u_ = li_ - bs_; cm_ = u_;
#pragma unroll
    for (int o_ = 1; o_ < 64; o_ <<= 1) { const float t_ = lane_read(cm_, (lane - o_) & 63); if (lane >= o_) cm_ = fmaxf(cm_, t_); }
}
DI void ml_gates(LAS float* SM, float u_, float cm_, float bs_, int gbn, float m_, float cmx_, int lane) {
    const float M_ = fmaxf(m_, cm_), Ml_ = fmaxf(m_, cmx_);
    SM[gbn + GB_U + lane] = u_; SM[gbn + GB_MR + lane] = M_; SM[gbn + GB_W + lane] = __expf(u_ - Ml_) * KSCALE; SM[gbn + GB_INT + lane] = __expf(m_ - M_); SM[gbn + GB_BND + lane] = __expf(-(bs_ + M_));
    if (lane == 0) SM[gbn + GB_SC + 0] = __expf(m_ - Ml_);
}

DI void ml_dma_piece(const bf16_t* colbase, int b, int dir, int tau0, LAS unsigned char* tile, int j, int lane) {
    const int pos = lane & 31, rin = pos >> 2, row = 8 * (j >> 1) + rin, ch = 4 * (2 * (j & 1) + (lane >> 5)) + ((pos & 3) ^ ((row >> 2) & 3));
    const int tau = tau0 + row; const size_t tok = (size_t)(b * SEQ + (dir ? SEQ - 1 - tau : tau));
    __builtin_amdgcn_global_load_lds((const unsigned*)(colbase + tok * 4096 + ch * 8), (LAS unsigned*)(tile + 1024 * j), 16, 0, 0);
}

DI void mlstm_phase(const bf16_t* Q, const bf16_t* Kb, const bf16_t* V, const float* pre_part, const float* b_if, float* GLF, bf16_t* HF, bf16_t* HB,
                    LAS unsigned char* lds, int G, int vcu0, int tid0, int lane0, int wave) {
    LAS float* SM = (LAS float*)(lds + ML_SM);
    const int vt = wave & 3, dpar = wave >> 2;
    for (int item = vcu0; item < 256; item += G) {
        const int vs = item & 3, stream = item >> 2, dir = stream & 1, hd = (stream >> 1) & 7, b = stream >> 4;
        bf16_t* H = dir ? HB : HF;
        float* glf = GLF + (size_t)item * 10240;
        const bf16_t* qcol = Q + hd * 512; const bf16_t* kcol = Kb + hd * 512; const bf16_t* vcol = V + hd * 512 + vs * 128;
        __syncthreads();
        int tidp = tid0, lanep = lane0; asm volatile("" : "+v"(tidp)); asm volatile("" : "+v"(lanep));
        for (int tau = tidp; tau < SEQ; tau += NTHREADS) {
            const int tok = b * SEQ + (dir ? SEQ - 1 - tau : tau);
            float li = b_if[dir * 16 + hd], lfr = b_if[dir * 16 + 8 + hd];
#pragma unroll
            for (int h8 = 0; h8 < 8; ++h8) { const float* pp = pre_part + ((size_t)h8 * 32 + dir * 16 + hd) * MTOK + tok; li += pp[0]; lfr += pp[(size_t)8 * MTOK]; }
            glf[tau] = li; glf[2048 + tau] = fminf(lfr, 0.f) - log1pf(__expf(-fabsf(lfr)));
        }
        SM[SM_NV + tidp] = 0.f;
        ml_dma_piece(qcol, b, dir, 0, lds + ML_QS0, 2 * wave, lanep); ml_dma_piece(qcol, b, dir, 0, lds + ML_QS0, 2 * wave + 1, lanep);
        ml_dma_piece(kcol, b, dir, 0, lds + ML_KS0, 2 * wave, lanep); ml_dma_piece(kcol, b, dir, 0, lds + ML_KS0, 2 * wave + 1, lanep);
        ml_dma_piece(vcol, b, dir, 0, lds + ML_VS0, 2 * wave, lanep); ml_dma_piece(vcol, b, dir, 0, lds + ML_VS0, 2 * wave + 1, lanep);
        asm volatile("s_waitcnt vmcnt(0)" ::: "memory");
        __syncthreads();
        float u0 = 0.f, cm0 = 0.f, bs0 = 0.f;
#pragma unroll 1
        for (int cc = wave; cc < 32; cc += 8) {
            const float lic = __hip_atomic_load(glf + 64 * cc + lanep, __ATOMIC_RELAXED, __HIP_MEMORY_SCOPE_AGENT), lfc = __hip_atomic_load(glf + 2048 + 64 * cc + lanep, __ATOMIC_RELAXED, __HIP_MEMORY_SCOPE_AGENT);
            float uu, cmm, bss; ml_scan(lic, lfc, uu, cmm, bss, lanep);
            glf[4096 + 64 * cc + lanep] = uu; glf[6144 + 64 * cc + lanep] = cmm; glf[8192 + 64 * cc + lanep] = bss;
            if (lanep == 63) { SM[SM_GS + cc] = bss; SM[SM_CMX + cc] = cmm; }
            if (cc == 0) { u0 = uu; cm0 = cmm; bs0 = bss; }
        }
        asm volatile("s_waitcnt vmcnt(0)" ::: "memory");
        __syncthreads();
        if (tidp == 0) { float m = 0.f;
#pragma unroll 1
            for (int cc = 0; cc < 32; ++cc) { SM[SM_MC + cc] = m; m = SM[SM_GS + cc] + fmaxf(m, SM[SM_CMX + cc]); } }
        __syncthreads();
        if (wave == 0) ml_gates(SM, u0, cm0, bs0, 0, 0.f, SM[SM_CMX + 0], lanep);
        __syncthreads();
#define ML_WRITE_WV(VS_, gbx_) do { const float w_ = SM[(gbx_) + GB_W + lrow]; \
        _Pragma("unroll") for (int hh_ = 0; hh_ < 2; ++hh_) { const int o_ = dimg(lrow, lcc + 8 * hh_); const u32x4 x_ = *(const LAS u32x4*)(lds + (VS_) + o_); u32x4 y_; \
            y_.x = cvt_pk_bf16(bf_lo(x_.x) * w_, bf_hi(x_.x) * w_); y_.y = cvt_pk_bf16(bf_lo(x_.y) * w_, bf_hi(x_.y) * w_); y_.z = cvt_pk_bf16(bf_lo(x_.z) * w_, bf_hi(x_.z) * w_); y_.w = cvt_pk_bf16(bf_lo(x_.w) * w_, bf_hi(x_.w) * w_); \
            *(LAS u32x4*)(lds + ML_WV + o_) = y_; } } while (0)
        { const int lrow = tidp >> 3, lcc = tidp & 7; ML_WRITE_WV(ML_VS0, 0); }
        u32x4 Cp[8][2];
#pragma unroll
        for (int j = 0; j < 8; ++j) { Cp[j][0] = (u32x4){0u, 0u, 0u, 0u}; Cp[j][1] = (u32x4){0u, 0u, 0u, 0u}; }
#pragma unroll 1
        for (int c = 0; c < 32; ++c) {
            int lane = lane0, tid = tid0; asm volatile("" : "+v"(lane)); asm volatile("" : "+v"(tid));
            const int r = lane & 31, h = lane >> 5, lrow = tid >> 3, lcc = tid & 7;
            const int gb = (c & 1) * 384, gbn = 384 - gb, cn = (c + 1 < 32) ? c + 1 : 31;
            const int VSc = (c & 1) ? ML_VS1 : ML_VS0, VSn = (c & 1) ? ML_VS0 : ML_VS1;
            f32x16 num[2], Sacc; float dnq = 0.f;
#pragma unroll
            for (int e = 0; e < 16; ++e) { num[0][e] = 0.f; num[1][e] = 0.f; Sacc[e] = 0.f; }
#define ML_DMA_QK(QS_, KS_, c_, i_) do { ml_dma_piece(qcol + 128 * (i_), b, dir, 64 * (c_), lds + (QS_), 2 * wave, lane); ml_dma_piece(qcol + 128 * (i_), b, dir, 64 * (c_), lds + (QS_), 2 * wave + 1, lane); \
                ml_dma_piece(kcol + 128 * (i_), b, dir, 64 * (c_), lds + (KS_), 2 * wave, lane); ml_dma_piece(kcol + 128 * (i_), b, dir, 64 * (c_), lds + (KS_), 2 * wave + 1, lane); } while (0)
            asm volatile("s_waitcnt vmcnt(0)" ::: "memory"); __syncthreads(); ML_DMA_QK(ML_QS1, ML_KS1, c, 1);  ml_step<0>(lds, Cp, num, Sacc, dnq, tid, lane, wave, gb);
            asm volatile("s_waitcnt vmcnt(0)" ::: "memory"); __syncthreads(); ML_DMA_QK(ML_QS0, ML_KS0, c, 2);  ml_step<1>(lds, Cp, num, Sacc, dnq, tid, lane, wave, gb);
            asm volatile("s_waitcnt vmcnt(0)" ::: "memory"); __syncthreads(); ML_DMA_QK(ML_QS1, ML_KS1, c, 3);  ml_step<2>(lds, Cp, num, Sacc, dnq, tid, lane, wave, gb);
            asm volatile("s_waitcnt vmcnt(0)" ::: "memory"); __syncthreads(); ML_DMA_QK(ML_QS0, ML_KS0, cn, 0);
            ml_dma_piece(vcol, b, dir, 64 * cn, lds + VSn, 2 * wave, lane); ml_dma_piece(vcol, b, dir, 64 * cn, lds + VSn, 2 * wave + 1, lane);
            ml_step<3>(lds, Cp, num, Sacc, dnq, tid, lane, wave, gb);
            asm volatile("s_waitcnt vmcnt(0)" ::: "memory");
            __syncthreads();
            float un = 0.f, cmn = 0.f, bsn = 0.f;
            if (wave == 0) { un = __hip_atomic_load(glf + 4096 + 64 * cn + lane, __ATOMIC_RELAXED, __HIP_MEMORY_SCOPE_AGENT); cmn = __hip_atomic_load(glf + 6144 + 64 * cn + lane, __ATOMIC_RELAXED, __HIP_MEMORY_SCOPE_AGENT);
                             bsn = __hip_atomic_load(glf + 8192 + 64 * cn + lane, __ATOMIC_RELAXED, __HIP_MEMORY_SCOPE_AGENT); }
            { LAS f32x4* xs = (LAS f32x4*)(lds + ML_XS) + (size_t)((wave & 3) * 4) * 64 + lane;
              if (wave >= 4) {
#pragma unroll
                for (int gq = 0; gq < 4; ++gq) xs[gq * 64] = (f32x4){Sacc[4 * gq], Sacc[4 * gq + 1], Sacc[4 * gq + 2], Sacc[4 * gq + 3]}; } }
            SM[SM_DNQP + (tid >> 6) * 64 + (tid & 63)] = dnq;
            __syncthreads();
            if (wave < 4) {
                const int st = wave >> 1, tt1 = wave & 1, t = 32 * tt1 + r;
                const LAS f32x4* xs = (const LAS f32x4*)(lds + ML_XS) + (size_t)(wave * 4) * 64 + lane;
                const float Mt = SM[gb + GB_MR + t]; float dsum = 0.f;
#pragma unroll
                for (int gq = 0; gq < 4; ++gq) {
                    const f32x4 px = xs[gq * 64]; const int s0 = 32 * st + 8 * gq + 4 * h; const f32x4 us = *(const LAS f32x4*)(SM + gb + GB_U + s0);
                    float vv[4];
#pragma unroll
                    for (int e = 0; e < 4; ++e) { const float raw = (Sacc[4 * gq + e] + px[e]) * KSCALE; vv[e] = (s0 + e <= t) ? raw * __expf(us[e] - Mt) : 0.f; dsum += vv[e]; }
                    u32x2 w; w.x = cvt_pk_bf16(vv[0], vv[1]); w.y = cvt_pk_bf16(vv[2], vv[3]);
                    *(LAS u32x2*)(lds + ML_SS + t * 144 + s0 * 2) = w;
                }
                dsum += __shfl_xor(dsum, 32);
                if (h == 0) SM[(st ? SM_DIN1 : SM_DIN0) + t] = dsum;
            }
#pragma unroll
            for (int tt = 0; tt < 2; ++tt) { const float it = SM[gb + GB_INT + 32 * tt + r]; num[tt] = num[tt] * it; }
            __syncthreads();
#pragma unroll
            for (int k2 = 0; k2 < 2; ++k2) { const int ks = 2 * dpar + k2;
                const bf16x8 a = frag_tr(lds + VSc, 16 * ks, 32 * vt, lane);
#pragma unroll
                for (int tt = 0; tt < 2; ++tt) { const bf16x8 bb = *(const LAS bf16x8*)(lds + ML_SS + (32 * tt + r) * 144 + (16 * ks + 8 * h) * 2); num[tt] = MFMA32(a, bb, num[tt]); } }
            __syncthreads();
            { LAS f32x4* xn = (LAS f32x4*)(lds + ML_XN) + (size_t)(vt * 8) * 64 + lane;
              if (dpar == 1) {
#pragma unroll
                for (int tt = 0; tt < 2; ++tt)
#pragma unroll
                    for (int gq = 0; gq < 4; ++gq) xn[(tt * 4 + gq) * 64] = (f32x4){num[tt][4 * gq], num[tt][4 * gq + 1], num[tt][4 * gq + 2], num[tt][4 * gq + 3]}; } }
            if (wave == 0) ml_gates(SM, un, cmn, bsn, gbn, SM[SM_MC + cn], SM[SM_CMX + cn], lane);
            __syncthreads();
            if (dpar == 0) {
                const LAS f32x4* xn = (const LAS f32x4*)(lds + ML_XN) + (size_t)(vt * 8) * 64 + lane;
#pragma unroll
                for (int tt = 0; tt < 2; ++tt) { const int t = 32 * tt + r; float nq = 0.f;
#pragma unroll
                    for (int gI = 0; gI < 8; ++gI) nq += SM[SM_DNQP + gI * 64 + t];
                    const float den = SM[SM_DIN0 + t] + SM[SM_DIN1 + t] + SM[gb + GB_INT + t] * nq;
                    const float inv = 1.0f / fmaxf(fabsf(den), SM[gb + GB_BND + t]);
                    const int tau = 64 * c + t; const size_t ob = (size_t)(b * SEQ + (dir ? SEQ - 1 - tau : tau)) * 4096 + hd * 512 + vs * 128 + 32 * vt + 4 * h;
#pragma unroll
                    for (int gq = 0; gq < 4; ++gq) { const f32x4 px = xn[(tt * 4 + gq) * 64];
                        u32x2 w; w.x = cvt_pk_bf16((num[tt][4 * gq] + px.x) * inv, (num[tt][4 * gq + 1] + px.y) * inv); w.y = cvt_pk_bf16((num[tt][4 * gq + 2] + px.z) * inv, (num[tt][4 * gq + 3] + px.w) * inv);
                        *(u32x2*)(H + ob + 8 * gq) = w; } }
            }
            ML_WRITE_WV(VSn, gbn);
            { const float decay = SM[gb + GB_SC + 0];
              float acc_ = 0.f; const LAS unsigned* np_ = (const LAS unsigned*)(SM + SM_NVP) + (tid >> 1);
#pragma unroll
              for (int sgx = 0; sgx < 8; ++sgx) { const unsigned pr_ = np_[sgx * 256]; acc_ += (tid & 1) ? bf_hi(pr_) : bf_lo(pr_); }
              SM[SM_NV + tid] = decay * SM[SM_NV + tid] + acc_; }
        }
#undef ML_DMA_QK
#undef ML_WRITE_WV
    }
}

DI void ml_combine_phase(const bf16_t* HF, const bf16_t* HB, const bf16_t* XC, const bf16_t* XZ, const float* norm_g, const float* skip, unsigned char* MO, int gw, int NGW, int lane) {
    for (int idx = gw; idx < MTOK * ML_HEADS; idx += NGW) {
        const int tok = idx >> 3, hd = idx & 7; const int ch = hd * 512 + 8 * lane; const size_t o4 = (size_t)tok * 4096 + ch;
        const u32x4 a = *(const u32x4*)(HF + o4), bq = *(const u32x4*)(HB + o4), xcv = *(const u32x4*)(XC + o4), zv = *(const u32x4*)(XZ + (size_t)tok * 8192 + 4096 + ch);
        float ht[8] = {bf_lo(a.x) + bf_lo(bq.x), bf_hi(a.x) + bf_hi(bq.x), bf_lo(a.y) + bf_lo(bq.y), bf_hi(a.y) + bf_hi(bq.y), bf_lo(a.z) + bf_lo(bq.z), bf_hi(a.z) + bf_hi(bq.z), bf_lo(a.w) + bf_lo(bq.w), bf_hi(a.w) + bf_hi(bq.w)};
        const float xc[8] = {bf_lo(xcv.x), bf_hi(xcv.x), bf_lo(xcv.y), bf_hi(xcv.y), bf_lo(xcv.z), bf_hi(xcv.z), bf_lo(xcv.w), bf_hi(xcv.w)};
        const float z[8] = {bf_lo(zv.x), bf_hi(zv.x), bf_lo(zv.y), bf_hi(zv.y), bf_lo(zv.z), bf_hi(zv.z), bf_lo(zv.w), bf_hi(zv.w)};
        float s = 0.f;
#pragma unroll
        for (int i = 0; i < 8; ++i) s += ht[i];
        const float mu = wave_sum(s) * (1.f / 512.f); float q = 0.f;
#pragma unroll
        for (int i = 0; i < 8; ++i) { ht[i] -= mu; q += ht[i] * ht[i]; }
        const float rstd = 1.0f / sqrtf(wave_sum(q) * (1.f / 512.f) + 1e-5f);
        const f32x4 g0 = *(const f32x4*)(norm_g + ch), g1 = *(const f32x4*)(norm_g + ch + 4), k0 = *(const f32x4*)(skip + ch), k1 = *(const f32x4*)(skip + ch + 4);
        const float gg[8] = {g0.x, g0.y, g0.z, g0.w, g1.x, g1.y, g1.z, g1.w}, sk[8] = {k0.x, k0.y, k0.z, k0.w, k1.x, k1.y, k1.z, k1.w};
        float o[8];
#pragma unroll
        for (int i = 0; i < 8; ++i) o[i] = (ht[i] * rstd * gg[i] + sk[i] * xc[i]) * sigmoid_f(z[i]);
        u32x2 w; w.x = pk4_fp8(o[0] * HSCALE, o[1] * HSCALE, o[2] * HSCALE, o[3] * HSCALE); w.y = pk4_fp8(o[4] * HSCALE, o[5] * HSCALE, o[6] * HSCALE, o[7] * HSCALE);
        *(u32x2*)(MO + o4) = w;
    }
}

DI void moe_offsets(const unsigned* ecnt, int (&cnt)[8], int (&off)[8], int& ntiles) {
    int acc = 0;
#pragma unroll
    for (int e = 0; e < 8; ++e) { cnt[e] = (int)ecnt[64 * e]; off[e] = acc * 256; acc += (cnt[e] + 255) >> 8; }
    ntiles = acc;
}
DI void moe_split_plan(int ntiles, int& nMf, int& nT, int& S) {
    nMf = (ntiles >> 5) << 5; nT = ntiles - nMf; S = 1;
    if (nT > 0) { S = (nT <= 4) ? 7 : (nT <= 8) ? 4 : (nT <= 16) ? 2 : 1; }
    if (S == 1) { nMf = ntiles; nT = 0; }
}
DI pg8::TileMap moe_tilemap(const int (&cnt)[8]) { pg8::TileMap tm; int acc = 0; tm.toff[0] = 0;
#pragma unroll
    for (int e = 0; e < 8; ++e) { acc += (cnt[e] + 255) >> 8; tm.toff[e + 1] = acc; }
    return tm; }
DI void moe_scatter_phase(const unsigned char* HA, unsigned char* HS, const int* tok_e, const int* tok_pos, int* slot_row, const unsigned* ecnt, int* tile_e, int gw, int NGW, int lane) {
    int cnt[8], off[8], ntiles; moe_offsets(ecnt, cnt, off, ntiles);
    if (gw == 0 && lane < 8) { const int e = lane; const int t0 = off[e] >> 8, nt = (cnt[e] + 255) >> 8; for (int t = 0; t < nt; ++t) tile_e[t0 + t] = e; }
    for (int id = gw; id < 2 * MTOK; id += NGW) {
        const int e = tok_e[id], pos = tok_pos[id]; int o = 0;
#pragma unroll
        for (int q = 0; q < 8; ++q) o = (e == q) ? off[q] : o;
        const int row = o + pos;
        if (lane == 0) slot_row[id] = row;
        const u32x4* src = (const u32x4*)(HA + (size_t)(id >> 1) * DM) + lane; u32x4* dst = (u32x4*)(HS + (size_t)row * DM) + lane;
#pragma unroll
        for (int j = 0; j < 2; ++j) dst[64 * j] = src[64 * j];
    }
#pragma unroll 1
    for (int e = 0; e < 8; ++e) { int c = 0, o = 0;
#pragma unroll
        for (int q = 0; q < 8; ++q) { c = (e == q) ? cnt[q] : c; o = (e == q) ? off[q] : o; }
        const int pend = ((c + 255) >> 8) << 8;
        for (int p = c + gw; p < pend; p += NGW) { u32x4* dst = (u32x4*)(HS + (size_t)(o + p) * DM) + lane;
#pragma unroll
            for (int j = 0; j < 2; ++j) dst[64 * j] = (u32x4){0u, 0u, 0u, 0u}; } }
}

DI f32x4 moe_yrow(const bf16_t* YS, const bf16_t* YSP, int r, int rsplit, int S, int nrs, int lane, int j) {
    if (r < rsplit) { const u32x2 a = ((const u32x2*)(YS + (size_t)r * DM) + lane)[64 * j]; return (f32x4){bf_lo(a.x), bf_hi(a.x), bf_lo(a.y), bf_hi(a.y)}; }
    f32x4 acc = (f32x4){0.f, 0.f, 0.f, 0.f};
    for (int s2 = 0; s2 < S; ++s2) { const u32x2 a = ((const u32x2*)(YSP + ((size_t)s2 * nrs + (r - rsplit)) * DM) + lane)[64 * j]; acc += (f32x4){bf_lo(a.x), bf_hi(a.x), bf_lo(a.y), bf_hi(a.y)}; }
    return acc;
}
DI void moe_combine_phase(const bf16_t* X3, const bf16_t* YS, const int* tok_e, const int* tok_pos, const float* tok_w, const float* gate, float* out, const unsigned* ecnt, int gw, int NGW, int lane) {
    int cnt[8], off[8], ntiles; moe_offsets(ecnt, cnt, off, ntiles);
    int nMf, nT, S; moe_split_plan(ntiles, nMf, nT, S); const int rsplit = nMf * 256; const bf16_t* YSP = YS + (size_t)MPAD * DM;
    for (int tok = gw; tok < MTOK; tok += NGW) {
        const int e0 = tok_e[2 * tok], e1 = tok_e[2 * tok + 1]; int o0 = 0, o1 = 0;
#pragma unroll
        for (int q = 0; q < 8; ++q) { o0 = (e0 == q) ? off[q] : o0; o1 = (e1 == q) ? off[q] : o1; }
        const int r0 = o0 + tok_pos[2 * tok], r1 = o1 + tok_pos[2 * tok + 1]; const float w0 = tok_w[2 * tok], w1 = tok_w[2 * tok + 1];
        const u32x2* x = (const u32x2*)(X3 + (size_t)tok * DM) + lane;
        const f32x4* gp = (const f32x4*)(gate + (size_t)(tok >> 11) * 12288) + lane; f32x4* o = (f32x4*)(out + (size_t)tok * DM) + lane;
#pragma unroll
        for (int j = 0; j < 8; ++j) { const f32x4 ya = moe_yrow(YS, YSP, r0, rsplit, S, nT * 256, lane, j), yb = moe_yrow(YS, YSP, r1, rsplit, S, nT * 256, lane, j);
            const u32x2 xr = x[64 * j]; o[64 * j] = (f32x4){bf_lo(xr.x), bf_hi(xr.x), bf_lo(xr.y), bf_hi(xr.y)} + gp[64 * j] * (ya * w0 + yb * w1); }
    }
}

struct Params { const float* in[29]; float* out; unsigned char* ws; int ph_lo, ph_hi; };
static_assert(sizeof(Params) == 31 * 8 + 8, "Params has padding");
constexpr int NPHASE = 20;

#if DBG
#include "dbg_checks.inc"
#endif

__global__ void __launch_bounds__(NTHREADS, 2) mega_fwd(Params p) {
    extern __shared__ __attribute__((aligned(16))) unsigned char lds_raw[];
    LAS unsigned char* lds = (LAS unsigned char*)lds_raw;
    const int tid = threadIdx.x, lane = tid & 63, wave = __builtin_amdgcn_readfirstlane(tid >> 6);
    const int G = gridDim.x, gw = blockIdx.x * NWAVES + wave, NGW = G * NWAVES;
    const int vcu = (G % 8 == 0) ? (int)(blockIdx.x % 8) * (G / 8) + (int)(blockIdx.x / 8) : (int)blockIdx.x;
    const int gwx = vcu * NWAVES + wave;
    unsigned char* ws = p.ws;
    unsigned* ctl = (unsigned*)(ws + WS_CTL);
    volatile LAS unsigned* xbw = (volatile LAS unsigned*)(lds + LDS_BYTES - 16);
    if (tid == 0) { xbw[0] = 0u; xbw[1] = 0u; xbw[2] = 0u; xbw[3] = 0u; }
    __syncthreads();
    XcdBarrier bar = xcd_barrier_post(ctl + CW_BAR, xbw);
    const int lo = p.ph_lo, hi = p.ph_hi;
#ifndef PH_MASK
#define PH_MASK 0xFFFFFFu
#endif
#define IN(k) (((PH_MASK >> (k)) & 1u) && lo <= (k) && (k) < hi)
#define SEAM(k) do { if (IN((k) + 1)) xcd_barrier(bar); } while (0)
#ifndef REP_MASK
#define REP_MASK 0u
#endif
#define PHASE(k, ...) if (IN(k)) { { __VA_ARGS__ } if ((REP_MASK >> (k)) & 1u) { __syncthreads(); { __VA_ARGS__ } } SEAM(k); }

    float* mod = (float*)(ws + WS_MOD);
    float* pre_part = (float*)(ws + WS_PRE);
    int* tok_e = (int*)(ws + WS_ROUTE); int* tok_pos = tok_e + 2 * MTOK; float* tok_w = (float*)(tok_pos + 2 * MTOK); int* slot_row = (int*)(tok_w + 2 * MTOK);
    unsigned* ecnt = ctl + CW_ECNT; int* tile_e = (int*)(ctl + 12288);
    bf16_t* HA = (bf16_t*)(ws + WS_HA); bf16_t* X1 = (bf16_t*)(ws + WS_X1); bf16_t* X2 = (bf16_t*)(ws + WS_X2);
    bf16_t* WT_IN = (bf16_t*)(ws + WS_WT_IN); bf16_t* WT_OUT = (bf16_t*)(ws + WS_WT_OUT); bf16_t* WT_GU = (bf16_t*)(ws + WS_WT_GU); bf16_t* WT_DN = (bf16_t*)(ws + WS_WT_DN);
    bf16_t* WT_MLIN = (bf16_t*)(ws + WS_WT_MLIN); bf16_t* WT_MLOUT = (bf16_t*)(ws + WS_WT_MLOUT); bf16_t* WT_IF = (bf16_t*)(ws + WS_WT_IF);
    unsigned char* WT_MGU = ws + WS_WT_MGU; unsigned char* WT_MD = ws + WS_WT_MD;
    bf16_t* QK = (bf16_t*)(ws + A_QK); bf16_t* QKN = (bf16_t*)(ws + A_QKN); bf16_t* VT = (bf16_t*)(ws + A_VT); bf16_t* ATT = (bf16_t*)(ws + A_ATT); bf16_t* ACT = (bf16_t*)(ws + A_ACT);
    bf16_t* XZ = (bf16_t*)(ws + A_XZ); bf16_t* XC = (bf16_t*)(ws + A_XC); bf16_t* Qm = (bf16_t*)(ws + A_Q); bf16_t* Km = (bf16_t*)(ws + A_K); bf16_t* Vm = (bf16_t*)(ws + A_V);
    bf16_t* HF = (bf16_t*)(ws + A_HF); bf16_t* HB = (bf16_t*)(ws + A_HB); bf16_t* MO = (bf16_t*)(ws + A_MO);
    unsigned char* HS = ws + A_HS; unsigned char* ACTM = ws + A_ACTM; float* YS = (float*)(ws + A_YS);
    const float* x_in = p.in[0];

    PHASE(0,
        mod_phase(p.in[1], p.in[2], p.in[3], mod, lds, G, tid, lane, wave);
        LAS float* scrw = (LAS float*)lds + wave * (64 * 65);
        cvtw_job<0, false>(p.in[6] + 4096, 2048, 2048, 1, WT_IN + (size_t)4096 * 2048, 0, scrw, gw, NGW, lane, 1.f, 6144, 0);
        cvtw_job<0, true>(p.in[6], 2048, 4096, 1, (unsigned char*)ACT + (size_t)32 * 1024 * 1024, 0, scrw, gw, NGW, lane, WSCALE, 6144, 512);
        cvtw_job<0, false>(p.in[10], 2048, 2048, 1, WT_OUT, 0, scrw, gw, NGW, lane, 1.f, 0, 1536);
        cvtw_job<1, false>(p.in[11], 2048, FFN, 1, WT_GU, 0, scrw, gw, NGW, lane, 1.f, 0, 2048);
        cvtw_job<2, false>(p.in[12], 2048, FFN, 1, WT_GU, 0, scrw, gw, NGW, lane, 1.f, 0, 3456);
        cvtw_job<0, false>(p.in[13], FFN, 2048, 1, WT_DN, 0, scrw, gw, NGW, lane, 1.f, 0, 4864);
        cvtw_job<0, false>(p.in[14], 2048, 4096, 1, WT_MLIN, 0, scrw, gw, NGW, lane, 1.f, 8192, 6272);
        cvtw_job<0, true>(p.in[14] + 4096, 2048, 4096, 1, (unsigned char*)WT_MLIN + (size_t)16 * 1024 * 1024, 0, scrw, gw, NGW, lane, WSCALE, 8192, 7296);
        cvtw_job<0, true>(p.in[24], 4096, 2048, 1, (unsigned char*)WT_MLOUT, 0, scrw, gw, NGW, lane, WSCALE, 0, 8320);
        cvt_job<0>(p.in[20], 12288, 32, 1, WT_IF, 0, scrw, gw, NGW, lane);
        cvtw_job<1, true>(p.in[26], 2048, EDIM, 8, WT_MGU, (size_t)14336 * 2048, scrw, gw, NGW, lane, WSCALE, 0, 9344);
        cvtw_job<2, true>(p.in[27], 2048, EDIM, 8, WT_MGU, (size_t)14336 * 2048, scrw, gw, NGW, lane, WSCALE, 0, 9344 + 14336);
        cvtw_job<0, true>(p.in[28], EDIM, 2048, 8, WT_MD, (size_t)2048 * EDIM, scrw, gw, NGW, lane, WSCALE, 0, 9344 + 2 * 14336); )
    PHASE(1,  rms_mod_phase<false, true>(x_in, p.in[4], mod + 1 * 2048, mod + 0 * 2048, HA, nullptr, nullptr, nullptr, nullptr, nullptr, (unsigned char*)ACT, gw, NGW, lane); )
    PHASE(2,
        { pg8::Gemm g{(const unsigned char*)ACT, (const unsigned char*)ACT + (size_t)32 * 1024 * 1024, MTOK, 4096, 2048, 0}; pg8::StaticOrder S; S.init(MTOK, 4096, G, (int)blockIdx.x); pg8::EpiQKNorm E{QKN, 4096, p.in[7], p.in[8], 1.0f / (HSCALE * WSCALE)}; pg8::gemm_phase<pg8::EpiQKNorm, pg8::StaticOrder, true>(lds, g, S, E); }
        { pg8::Gemm g{WT_IN + (size_t)4096 * 2048, HA, 2048, MTOK, 2048, 0}; pg8::StaticOrder S; S.init(2048, MTOK, G, (int)blockIdx.x); pg8::EpiBf16 E{VT, MTOK}; pg8::gemm_phase(lds, g, S, E); } )
    PHASE(4,  na_phase(QKN, VT, ATT, p.in[9], lds, G, vcu, tid, lane, wave); )
    PHASE(5,  pg8::Gemm g{ATT, WT_OUT, MTOK, 2048, 2048, 0}; pg8::StaticOrder S; S.init(MTOK, 2048, G, (int)blockIdx.x); pg8::EpiResGate16<false> E{x_in, X1, DM, mod + 2 * 2048, 12288}; pg8::gemm_phase(lds, g, S, E); )
    PHASE(6,  rms_mod_phase<false, false, true>(X1, p.in[5], mod + 4 * 2048, mod + 3 * 2048, HA, nullptr, nullptr, nullptr, nullptr, nullptr, nullptr, gw, NGW, lane); )
    PHASE(7,  pg8::Gemm g{HA, WT_GU, MTOK, 2 * FFN, 2048, 0}; pg8::StaticOrder S; S.init(MTOK, 2 * FFN, G, (int)blockIdx.x); pg8::EpiSwiGLU E{ACT, FFN}; pg8::gemm_phase(lds, g, S, E); )
    PHASE(8,  pg8::Gemm g{ACT, WT_DN, MTOK, 2048, FFN, 0}; pg8::StaticOrder S; S.init(MTOK, 2048, G, (int)blockIdx.x); pg8::EpiResGate16<true> E{X1, X2, DM, mod + 5 * 2048, 12288}; pg8::gemm_phase(lds, g, S, E); )
    PHASE(9,  rms_mod_phase<false, true, true>(X2, p.in[4] + DM, mod + 4 * 12288 + 1 * 2048, mod + 4 * 12288 + 0 * 2048, HA, nullptr, nullptr, nullptr, nullptr, nullptr, (unsigned char*)MO, gw, NGW, lane); )
    PHASE(10,
        { pg8::Gemm g{HA, WT_MLIN, MTOK, 4096, 2048, 0}; pg8::StaticOrder S; S.init(MTOK, 4096, G, (int)blockIdx.x); pg8::EpiBf16 E{XZ, 8192}; pg8::gemm_phase(lds, g, S, E); }
        { pg8::Gemm g{(const unsigned char*)MO, (const unsigned char*)WT_MLIN + (size_t)16 * 1024 * 1024, MTOK, 4096, 2048, 0}; pg8::StaticOrder S; S.init(MTOK, 4096, G, (int)blockIdx.x);
          pg8::EpiBf16S E{XZ + 4096, 8192, 1.0f / (HSCALE * WSCALE), 0}; pg8::gemm_phase<pg8::EpiBf16S, pg8::StaticOrder, true>(lds, g, S, E); } )
    PHASE(11,  ml_pre_phase(XZ, p.in[15], p.in[16], p.in[17], p.in[18], p.in[19], WT_IF, XC, Qm, Km, Vm, pre_part, lds, G, tid, lane, wave); )
    PHASE(12,  mlstm_phase(Qm, Km, Vm, pre_part, p.in[21], (float*)(ws + WS_GLF), HF, HB, lds, G, vcu, tid, lane, wave); )
    PHASE(13,  ml_combine_phase(HF, HB, XC, XZ, p.in[23], p.in[22], (unsigned char*)MO, gw, NGW, lane); )
    PHASE(14,  pg8::Gemm g{MO, WT_MLOUT, MTOK, 2048, 4096, 0}; pg8::StaticOrder S; S.init(MTOK, 2048, G, (int)blockIdx.x); pg8::EpiResGate16<true> E{X2, X1, DM, mod + 4 * 12288 + 2 * 2048, 12288, 1.0f / (HSCALE * WSCALE)}; pg8::gemm_phase<pg8::EpiResGate16<true>, pg8::StaticOrder, true>(lds, g, S, E); )
    PHASE(15,  rms_mod_phase<true, false, true>(X1, p.in[5] + DM, mod + 4 * 12288 + 4 * 2048, mod + 4 * 12288 + 3 * 2048, HA, p.in[25], tok_e, tok_pos, tok_w, ecnt, HS, gw, NGW, lane, (LAS float*)lds, tid); )
    PHASE(17,  int cnt[8], off[8], ntiles; moe_offsets(ecnt, cnt, off, ntiles);
        pg8::Gemm g{HS, WT_MGU, ntiles * 256, 2 * EDIM, 2048, 0}; pg8::MoeOrder S; S.init(ntiles, 2 * EDIM, G, (int)blockIdx.x, moe_tilemap(cnt), (size_t)14336 * 2048, (size_t)DM);
        pg8::EpiSwiGLU8 E{ACTM, EDIM, 1.0f / (HSCALE * WSCALE), ASCALE}; pg8::gemm_phase<pg8::EpiSwiGLU8, pg8::MoeOrder, true>(lds, g, S, E); )
    PHASE(18,  int cnt[8], off[8], ntiles; moe_offsets(ecnt, cnt, off, ntiles);
        pg8::Gemm g{ACTM, WT_MD, ntiles * 256, 2048, EDIM, 0};
        int nMf, nT, SS; moe_split_plan(ntiles, nMf, nT, SS); bf16_t* YSP = (bf16_t*)YS + (size_t)MPAD * DM;
        { pg8::MoeRowOrder S1; S1.init(nMf, G, (int)blockIdx.x, moe_tilemap(cnt), (size_t)2048 * EDIM); pg8::EpiBf16S E{(bf16_t*)YS, DM, 1.0f / (ASCALE * WSCALE), 0}; pg8::gemm_phase<pg8::EpiBf16S, pg8::MoeRowOrder, true>(lds, g, S1, E); }
        if (nT > 0) { pg8::Gemm g2 = g; g2.ntk = 56 / SS; pg8::MoeSplitOrder S2; S2.init(nMf, nT, SS, (size_t)(EDIM / SS), (int)blockIdx.x, moe_tilemap(cnt), (size_t)2048 * EDIM);
            pg8::EpiBf16S E2{YSP - (size_t)nMf * 256 * DM, DM, 1.0f / (ASCALE * WSCALE), (size_t)nT * 256 * DM}; pg8::gemm_phase<pg8::EpiBf16S, pg8::MoeSplitOrder, true>(lds, g2, S2, E2); } )
    PHASE(19,  moe_combine_phase(X1, (const bf16_t*)YS, tok_e, tok_pos, tok_w, mod + 4 * 12288 + 5 * 2048, p.out, ecnt, gw, NGW, lane); )
#undef IN
#undef SEAM
#undef PHASE
}

extern "C" void kernel_launch(void* const* d_in, const int* in_sizes, int n_in, void* d_out, int out_size, void* d_ws, size_t ws_size, hipStream_t stream) {
    static int grid = 0;
    if (grid == 0) {
        if (n_in != 29 || out_size != MTOK * DM || ws_size < WS_END) { fprintf(stderr, "kernel_launch: unexpected shapes (n_in %d out %d ws %zu need %zu)\n", n_in, out_size, ws_size, (size_t)WS_END); grid = -1; return; }
        int dev = 0, cus = 0, per_cu = 0;
        if (hipGetDevice(&dev) != hipSuccess || hipDeviceGetAttribute(&cus, hipDeviceAttributeMultiprocessorCount, dev) != hipSuccess) { grid = -1; return; }
        if (hipFuncSetAttribute((const void*)mega_fwd, hipFuncAttributeMaxDynamicSharedMemorySize, LDS_BYTES) != hipSuccess) { fprintf(stderr, "kernel_launch: hipFuncSetAttribute failed\n"); grid = -1; return; }
        if (hipOccupancyMaxActiveBlocksPerMultiprocessor(&per_cu, (const void*)mega_fwd, NTHREADS, LDS_BYTES) != hipSuccess || per_cu < 1) { fprintf(stderr, "kernel_launch: occupancy query says %d\n", per_cu); (void)hipGetLastError(); per_cu = 1; }
        grid = cus;
    }
    if (grid < 0) return;
    (void)hipMemsetAsync((char*)d_ws + WS_CTL, 0, CTL_BYTES, stream);
    Params p{};
    for (int i = 0; i < 29; ++i) p.in[i] = (const float*)d_in[i];
    p.out = (float*)d_out; p.ws = (unsigned char*)d_ws;
#if N_LAUNCH_SPLIT
    for (int k = 0; k < NPHASE; ++k) { p.ph_lo = k; p.ph_hi = k + 1; hipLaunchKernelGGL(mega_fwd, dim3(grid), dim3(NTHREADS), LDS_BYTES, stream, p); }
#else
    p.ph_lo = 0; p.ph_hi = NPHASE;
    hipLaunchKernelGGL(mega_fwd, dim3(grid), dim3(NTHREADS), LDS_BYTES, stream, p);
#endif
}
```

```cpp
#ifndef GEMM_SCH
#define GEMM_SCH 1
#endif
#include <hip/hip_runtime.h>
#include <cstdio>
#include <cstdint>

#ifndef DBG
#define DBG 0
#endif
#ifndef N_LAUNCH_SPLIT
#define N_LAUNCH_SPLIT 0
#endif

#define LAS __attribute__((address_space(3)))
#define GAS __attribute__((address_space(1)))
#define DI __device__ __forceinline__
typedef unsigned short bf16_t;
typedef short bf16x8 __attribute__((ext_vector_type(8)));
typedef short s16x4 __attribute__((ext_vector_type(4)));
typedef float f32x2 __attribute__((ext_vector_type(2)));
typedef float f32x4 __attribute__((ext_vector_type(4)));
typedef float f32x16 __attribute__((ext_vector_type(16)));
typedef unsigned u32x2 __attribute__((ext_vector_type(2)));
typedef unsigned u32x4 __attribute__((ext_vector_type(4)));
typedef int i32x4 __attribute__((ext_vector_type(4)));
typedef int i32x8 __attribute__((ext_vector_type(8)));

constexpr int BATCH = 4, SEQ = 2048, DM = 2048, MTOK = BATCH * SEQ;
constexpr int GRID_W = 64, NA_HEADS = 16, NA_HD = 128;
constexpr int ML_INNER = 4096, ML_HEADS = 8, ML_HD = 512;
constexpr int FFN = 5632, NEXP = 8, EDIM = 7168;
constexpr int MPAD = 2 * MTOK + NEXP * 256;
constexpr int NTHREADS = 512, NWAVES = 8;
constexpr int LDS_BYTES = 147456;

constexpr size_t al256(size_t x) { return (x + 255) & ~(size_t)255; }
constexpr size_t WS_CTL = 0;
constexpr size_t CTL_BYTES = 65536;
constexpr size_t WS_MOD = WS_CTL + CTL_BYTES;
constexpr size_t WS_PRE = WS_MOD + al256((size_t)2 * 4 * 12288 * 4);
constexpr size_t WS_ROUTE = WS_PRE + (size_t)8 * MTOK * 32 * 4;
constexpr size_t WS_GLF = WS_ROUTE + (size_t)4 * MTOK * 2 * 4;
constexpr size_t WS_HA = WS_GLF + (size_t)256 * 10240 * 4;
constexpr size_t WS_X1 = WS_HA + (size_t)MTOK * DM * 2;
constexpr size_t WS_X2 = WS_X1 + (size_t)MTOK * DM * 4;
constexpr size_t WS_WT_IN = WS_X2 + (size_t)MTOK * DM * 4;
constexpr size_t WS_WT_OUT = WS_WT_IN + (size_t)6144 * 2048 * 2;
constexpr size_t WS_WT_GU = WS_WT_OUT + (size_t)2048 * 2048 * 2;
constexpr size_t WS_WT_DN = WS_WT_GU + (size_t)11264 * 2048 * 2;
constexpr size_t WS_WT_MLIN = WS_WT_DN + (size_t)2048 * 5632 * 2;
constexpr size_t WS_WT_MLOUT = WS_WT_MLIN + (size_t)8192 * 2048 * 2;
constexpr size_t WS_WT_IF = WS_WT_MLOUT + (size_t)2048 * 4096 * 2;
constexpr size_t WS_WT_MGU = WS_WT_IF + (size_t)32 * 12288 * 2;
constexpr size_t WS_WT_MD = WS_WT_MGU + (size_t)8 * 14336 * 2048;
constexpr size_t WS_ARENA = WS_WT_MD + (size_t)8 * 2048 * 7168;
constexpr size_t A_QK = WS_ARENA;
constexpr size_t A_QKN = A_QK + (size_t)MTOK * 4096 * 2;
constexpr size_t A_VT = A_QKN + (size_t)MTOK * 4096 * 2;
constexpr size_t A_ATT = A_VT + (size_t)2048 * MTOK * 2;
constexpr size_t A_ACT = A_ATT + (size_t)MTOK * DM * 2;
constexpr size_t A_L0_END = A_ACT + (size_t)MTOK * FFN * 2;
constexpr size_t A_XZ = WS_ARENA;
constexpr size_t A_XC = A_XZ + (size_t)MTOK * 8192 * 2;
constexpr size_t A_Q = A_XC + (size_t)MTOK * 4096 * 2;
constexpr size_t A_K = A_Q + (size_t)MTOK * 4096 * 2;
constexpr size_t A_V = A_K + (size_t)MTOK * 4096 * 2;
constexpr size_t A_HF = A_V + (size_t)MTOK * 4096 * 2;
constexpr size_t A_HB = A_HF + (size_t)MTOK * 4096 * 2;
constexpr size_t A_MO = A_HB + (size_t)MTOK * 4096 * 2;
constexpr size_t A_L1_END = A_MO + (size_t)MTOK * 4096 * 2;
constexpr size_t A_HS = WS_ARENA;
constexpr size_t A_ACTM = A_HS + (size_t)8 * 8192 * DM;
constexpr size_t A_YS = A_ACTM + (size_t)MPAD * EDIM;
constexpr size_t A_L2_END = A_YS + (size_t)MPAD * DM * 4;
constexpr size_t cmax(size_t a, size_t b) { return a > b ? a : b; }
constexpr size_t WS_END = cmax(cmax(A_L0_END, A_L1_END), A_L2_END);

constexpr int CW_BAR = 0;
constexpr int CW_ECNT = 4096;
constexpr int CW_DBG = 8192;

typedef __bf16 bf16x2_t __attribute__((ext_vector_type(2)));
DI unsigned cvt_pk_bf16(float lo, float hi) { const f32x2 v = {lo, hi}; return __builtin_bit_cast(unsigned, __builtin_convertvector(v, bf16x2_t)); }
DI float clamp448(float x) { return __builtin_fminf(__builtin_fmaxf(x, -448.f), 448.f); }
DI unsigned pk4_fp8(float a, float b, float c, float d) {
    int p = 0; p = __builtin_amdgcn_cvt_pk_fp8_f32(clamp448(a), clamp448(b), p, false); p = __builtin_amdgcn_cvt_pk_fp8_f32(clamp448(c), clamp448(d), p, true); return (unsigned)p; }
DI float bf_lo(unsigned u) { return __uint_as_float(u << 16); }
DI float bf_hi(unsigned u) { return __uint_as_float(u & 0xffff0000u); }
DI float bf2f(bf16_t b) { return __uint_as_float(((unsigned)b) << 16); }
DI bf16_t f2bf(float f) { return (bf16_t)(cvt_pk_bf16(f, 0.f) & 0xffffu); }
DI float wave_sum(float v) {
#pragma unroll
    for (int o = 1; o < 64; o <<= 1) v += __shfl_xor(v, o);
    return v;
}
DI float wave_max(float v) {
#pragma unroll
    for (int o = 1; o < 64; o <<= 1) v = fmaxf(v, __shfl_xor(v, o));
    return v;
}
DI float silu_f(float x) { return x / (1.f + __expf(-x)); }
DI float sigmoid_f(float x) { return 1.f / (1.f + __expf(-x)); }
#define LDS_WAIT() asm volatile("s_waitcnt lgkmcnt(0)" ::: "memory")
#define VM_WAIT() asm volatile("s_waitcnt vmcnt(0)" ::: "memory")

#define XB_TMO      128
#define XB_XCNT(j)  (256  + 64 * (j))
#define XB_XSUB(j)  (1280 + 64 * (j))
#define XB_XGEN(j)  (2304 + 64 * (j))
#define XB_TOP      3328
#define XB_TOPGEN   3392
#define XCD_BAR_WORDS 3456
#define XB_SPIN_CAP (1u << 22)

__device__ __forceinline__ unsigned xb_ld(unsigned* p)              { return __hip_atomic_load(p, __ATOMIC_RELAXED, __HIP_MEMORY_SCOPE_AGENT); }
__device__ __forceinline__ unsigned xb_add(unsigned* p, unsigned v) { return __hip_atomic_fetch_add(p, v, __ATOMIC_RELAXED, __HIP_MEMORY_SCOPE_AGENT); }
__device__ __forceinline__ unsigned xb_xcc_id() { return (unsigned)__builtin_amdgcn_s_getreg((3 << 11) | 20) & 0xFu; }
#define XB_SPIN(cond, bar) do { unsigned _sp = 0; while (cond) { __builtin_amdgcn_s_sleep(1); \
    if ((++_sp & 255u) == 0u) { if (xb_ld(&(bar)[XB_TMO])) break; if (_sp > XB_SPIN_CAP) { atomicAdd(&(bar)[XB_TMO], 1u); break; } } } } while (0)

struct XcdBarrier { unsigned* bar; unsigned x; volatile LAS unsigned* st; };

__device__ __forceinline__ XcdBarrier xcd_barrier_post(unsigned* bar, volatile LAS unsigned* st) {
    XcdBarrier b; b.bar = bar; b.x = xb_xcc_id(); b.st = st;
    if (threadIdx.x == 0) (void)xb_add(&bar[XB_XCNT(b.x)], 1u);
    return b;
}
__device__ __forceinline__ void xcd_barrier_complete(unsigned* bar, unsigned x, unsigned& nloc, unsigned& nx) {
    const unsigned G = gridDim.x * gridDim.y * gridDim.z;
    unsigned sum, cnt, mine, sp = 0u;
    for (;;) {
        sum = 0u; cnt = 0u; mine = 0u;
#pragma unroll
        for (unsigned j = 0; j < 16; ++j) { const unsigned c = xb_ld(&bar[XB_XCNT(j)]); sum += c; cnt += (c > 0u) ? 1u : 0u; mine = (j == x) ? c : mine; }
        if (sum == G) break;
        __builtin_amdgcn_s_sleep(1);
        if ((++sp & 255u) == 0u) { if (xb_ld(&bar[XB_TMO])) break; if (sp > XB_SPIN_CAP) { atomicAdd(&bar[XB_TMO], 1u); break; } }
    }
    nloc = mine > 0u ? mine : 1u; nx = cnt > 0u ? cnt : 1u;
}
__device__ __forceinline__ void xcd_barrier(const XcdBarrier& b) {
    asm volatile("s_waitcnt vmcnt(0)" ::: "memory");
    __syncthreads();
    if (threadIdx.x == 0) {
        unsigned* bar = b.bar;
        __builtin_amdgcn_s_waitcnt(0);
        unsigned nloc = b.st[0], nx = b.st[1];
        if (nloc == 0u) { xcd_barrier_complete(bar, b.x, nloc, nx); b.st[0] = nloc; b.st[1] = nx; }
        const unsigned old = xb_add(&bar[XB_XSUB(b.x)], 1u);
        const unsigned gen = old / nloc;
        if (old + 1u == (gen + 1u) * nloc) {
            __builtin_amdgcn_fence(__ATOMIC_RELEASE, "agent");
            asm volatile("s_waitcnt vmcnt(0)" ::: "memory");
            const unsigned og = xb_add(&bar[XB_TOP], 1u);
            const unsigned tg = og / nx;
            if (og + 1u == (tg + 1u) * nx) xb_add(&bar[XB_TOPGEN], 1u);
            else XB_SPIN(xb_ld(&bar[XB_TOPGEN]) == tg, bar);
            __builtin_amdgcn_fence(__ATOMIC_ACQUIRE, "agent");
            xb_add(&bar[XB_XGEN(b.x)], 1u);
            asm volatile("s_waitcnt vmcnt(0)" ::: "memory");
        } else {
            XB_SPIN(xb_ld(&bar[XB_XGEN(b.x)]) == gen, bar);
            __builtin_amdgcn_fence(__ATOMIC_ACQUIRE, "agent");
            asm volatile("s_waitcnt vmcnt(0)" ::: "memory");
        }
    }
    __syncthreads();
}

namespace pg8 {
constexpr int BM = 256, BK = 64, HALF = 128, HTB = HALF * BK * 2, STAGE_BYTES = 8 * HTB, NXCD = 8, WGM = 8;
__host__ __device__ __forceinline__ int lds_byte(int r, int c) { const int st = (r >> 4) * 2 + (c >> 5), rr = r & 15, cc = c & 31, ob = rr * 64 + cc * 2; return st * 1024 + (ob ^ (((ob >> 9) & 1) << 5)); }
__host__ __device__ __forceinline__ void stage_rc(int b, int& R, int& C) { const int st = b / 1024, sb = b % 1024, swz = sb ^ (((sb >> 9) & 1) << 5); R = (st >> 1) * 16 + swz / 64; C = (st & 1) * 32 + (swz % 64) / 2; }
__host__ __device__ __forceinline__ int perm32(int rho) { const int n = rho >> 4, i = rho & 15; return 8 * (i >> 2) + 4 * n + (i & 3); }

struct Unit { int pm, pn; size_t boff; size_t aoff; int slice; };
struct Gemm { const void* A; const void* Bt; int M, N, K; int ntk; };

struct StaticOrder {
    int nM, nN, nwg, G, c;
    __device__ void init(int M, int N, int G_, int c_) { nM = M / BM; nN = N / BM; nwg = nM * nN; G = G_; c = c_; }
    __device__ bool next(int i, Unit& u) const {
        const long L = (long)i * G + c; if (L >= nwg) return false;
        int wgid = (int)L; { const int q = nwg / NXCD, r = nwg % NXCD, xcd = wgid % NXCD, off = wgid / NXCD; wgid = (xcd < r ? xcd * (q + 1) : r * (q + 1) + (xcd - r) * q) + off; }
        const int nig = WGM * nN, gid = wgid / nig, fm = gid * WGM, gsz = (nM - fm) < WGM ? (nM - fm) : WGM;
        u.pm = fm + ((wgid % nig) % gsz); u.pn = (wgid % nig) / gsz; u.boff = 0; u.aoff = 0; u.slice = 0; return true;
    }
};
struct TileMap {
    int toff[9];
    __device__ __forceinline__ void lookup(int pm, int& e, int& k) const {
        e = (pm >= toff[1]) + (pm >= toff[2]) + (pm >= toff[3]) + (pm >= toff[4]) + (pm >= toff[5]) + (pm >= toff[6]) + (pm >= toff[7]);
        int t0 = 0;
#pragma unroll
        for (int q = 1; q < 8; ++q) t0 = (e == q) ? toff[q] : t0;
        k = pm - t0;
    }
};
constexpr int ECAP = 8192;
struct MoeOrder {
    int nM, nN, nwg, G, c; TileMap tm; size_t estride; size_t arowb;
    __device__ void init(int nM_, int N, int G_, int c_, const TileMap& tm_, size_t es, size_t arowb_) { nM = nM_; nN = N / BM; nwg = nM * nN; G = G_; c = c_; tm = tm_; estride = es; arowb = arowb_; }
    __device__ bool next(int i, Unit& u) const {
        const long L = (long)i * G + c; if (L >= nwg) return false;
        int wgid = (int)L; { const int q = nwg / NXCD, r = nwg % NXCD, xcd = wgid % NXCD, off = wgid / NXCD; wgid = (xcd < r ? xcd * (q + 1) : r * (q + 1) + (xcd - r) * q) + off; }
        const int nig = WGM * nN, gid = wgid / nig, fm = gid * WGM, gsz = (nM - fm) < WGM ? (nM - fm) : WGM;
        u.pm = fm + ((wgid % nig) % gsz); u.pn = (wgid % nig) / gsz; int e, k; tm.lookup(u.pm, e, k); u.boff = (size_t)e * estride;
        u.aoff = (size_t)((long)(e * ECAP + 256 * k - 256 * u.pm) * (long)arowb); u.slice = 0; return true;
    }
};

struct MoeRowOrder {
    int nwg, G, c; TileMap tm; size_t estride;
    __device__ void init(int nMf, int G_, int c_, const TileMap& tm_, size_t es) { nwg = nMf * 8; G = G_; c = c_; tm = tm_; estride = es; }
    __device__ bool next(int i, Unit& u) const {
        const long L = (long)i * G + c; if (L >= nwg) return false;
        u.pm = (int)(L >> 3); u.pn = (int)(L & 7); int e, k; tm.lookup(u.pm, e, k); u.boff = (size_t)e * estride; u.aoff = 0; u.slice = 0; return true;
    }
};
struct MoeSplitOrder {
    int pm0, nq, S, c; size_t kslice; TileMap tm; size_t estride;
    __device__ void init(int pm0_, int nT, int S_, size_t ks, int c_, const TileMap& tm_, size_t es) { pm0 = pm0_; S = S_; nq = nT * 8 * S_; kslice = ks; c = c_; tm = tm_; estride = es; }
    __device__ bool next(int i, Unit& u) const {
        if (i != 0 || c >= nq) return false;
        const int un = c / S; u.slice = c - un * S; u.pm = pm0 + (un >> 3); u.pn = un & 7; u.aoff = (size_t)u.slice * kslice; int e, k; tm.lookup(u.pm, e, k); u.boff = (size_t)e * estride + u.aoff; return true;
    }
};
struct EpiBf16 {
    static constexpr bool PERM = true, XBAR = false;
    bf16_t* O; int ldc;
    __device__ __forceinline__ void operator()(const f32x4 (&acc)[2][2][4][2], const Unit& u, int wr, int wc, int fr, int fq) const {
        const int row0 = u.pm * BM + wr * 64 + fr, col0 = u.pn * BM + wc * 32 + 8 * fq;
#pragma unroll
        for (int ai = 0; ai < 2; ++ai)
#pragma unroll
            for (int m = 0; m < 4; ++m) { bf16_t* rowp = O + (size_t)(row0 + ai * HALF + m * 16) * ldc + col0;
#pragma unroll
                for (int bj = 0; bj < 2; ++bj) { const f32x4 v0 = acc[ai][bj][m][0], v1 = acc[ai][bj][m][1];
                    u32x4 w; w.x = cvt_pk_bf16(v0[0], v0[1]); w.y = cvt_pk_bf16(v0[2], v0[3]); w.z = cvt_pk_bf16(v1[0], v1[1]); w.w = cvt_pk_bf16(v1[2], v1[3]);
                    *(u32x4*)(rowp + bj * HALF) = w; } }
    }
};
struct EpiQKNorm {
    static constexpr bool PERM = true, XBAR = true;
    bf16_t* O; int ldc; const float* qg; const float* kg; float sc;
    __device__ __forceinline__ void pre(const f32x4 (&acc)[2][2][4][2], int wr, int wc, int fr, int fq, LAS float* P) const {
#pragma unroll
        for (int ai = 0; ai < 2; ++ai)
#pragma unroll
            for (int m = 0; m < 4; ++m)
#pragma unroll
                for (int bj = 0; bj < 2; ++bj) { const f32x4 a = acc[ai][bj][m][0], b = acc[ai][bj][m][1];
                    float ss = (a[0] * a[0] + a[1] * a[1]) + (a[2] * a[2] + a[3] * a[3]) + (b[0] * b[0] + b[1] * b[1]) + (b[2] * b[2] + b[3] * b[3]);
                    ss += __shfl_xor(ss, 16); ss += __shfl_xor(ss, 32);
                    if (fq == 0) P[((ai * HALF + wr * 64 + m * 16 + fr) * 2 + bj) * 4 + wc] = ss * sc * sc; }
    }
    __device__ __forceinline__ void post(const f32x4 (&acc)[2][2][4][2], const Unit& u, int wr, int wc, int fr, int fq, const LAS float* P) const {
        const int row0 = u.pm * BM + wr * 64 + fr, col0 = u.pn * BM + wc * 32 + 8 * fq;
        f32x4 g0[2], g1[2]; float hs[2];
#pragma unroll
        for (int bj = 0; bj < 2; ++bj) { const int head = 2 * u.pn + bj; const float* gp = (head < 16 ? qg : kg) + wc * 32 + 8 * fq; g0[bj] = *(const f32x4*)gp; g1[bj] = *(const f32x4*)(gp + 4); hs[bj] = head < 16 ? 0.08838834764831845f : 1.0f; }
#pragma unroll
        for (int ai = 0; ai < 2; ++ai)
#pragma unroll
            for (int m = 0; m < 4; ++m) { bf16_t* rowp = O + (size_t)(row0 + ai * HALF + m * 16) * ldc + col0;
#pragma unroll
                for (int bj = 0; bj < 2; ++bj) { const f32x4 ps = *(const LAS f32x4*)(P + ((ai * HALF + wr * 64 + m * 16 + fr) * 2 + bj) * 4);
                    const float rstd = hs[bj] / sqrtf(((ps[0] + ps[1]) + (ps[2] + ps[3])) * (1.f / 128.f) + 1e-6f);
                    const f32x4 v0 = acc[ai][bj][m][0] * g0[bj] * (rstd * sc), v1 = acc[ai][bj][m][1] * g1[bj] * (rstd * sc);
                    u32x4 w; w.x = cvt_pk_bf16(v0[0], v0[1]); w.y = cvt_pk_bf16(v0[2], v0[3]); w.z = cvt_pk_bf16(v1[0], v1[1]); w.w = cvt_pk_bf16(v1[2], v1[3]);
                    *(u32x4*)(rowp + bj * HALF) = w; } }
    }
};
struct EpiBf16S {
    static constexpr bool PERM = true, XBAR = false;
    bf16_t* O; int ldc; float sc; size_t sstride;
    __device__ __forceinline__ void operator()(const f32x4 (&acc)[2][2][4][2], const Unit& u, int wr, int wc, int fr, int fq) const {
        const int row0 = u.pm * BM + wr * 64 + fr, col0 = u.pn * BM + wc * 32 + 8 * fq;
        bf16_t* Os = O + (size_t)u.slice * sstride;
#pragma unroll
        for (int ai = 0; ai < 2; ++ai)
#pragma unroll
            for (int m = 0; m < 4; ++m) { bf16_t* rowp = Os + (size_t)(row0 + ai * HALF + m * 16) * ldc + col0;
#pragma unroll
                for (int bj = 0; bj < 2; ++bj) { const f32x4 v0 = acc[ai][bj][m][0] * sc, v1 = acc[ai][bj][m][1] * sc;
                    u32x4 w; w.x = cvt_pk_bf16(v0[0], v0[1]); w.y = cvt_pk_bf16(v0[2], v0[3]); w.z = cvt_pk_bf16(v1[0], v1[1]); w.w = cvt_pk_bf16(v1[2], v1[3]);
                    *(u32x4*)(rowp + bj * HALF) = w; } }
    }
};
struct EpiSwiGLU {
    static constexpr bool PERM = true, XBAR = false;
    bf16_t* O; int ldc;
    __device__ __forceinline__ void operator()(const f32x4 (&acc)[2][2][4][2], const Unit& u, int wr, int wc, int fr, int fq) const {
        const int row0 = u.pm * BM + wr * 64 + fr, col0 = u.pn * HALF + wc * 32 + 8 * fq;
#pragma unroll
        for (int ai = 0; ai < 2; ++ai)
#pragma unroll
            for (int m = 0; m < 4; ++m) { bf16_t* rowp = O + (size_t)(row0 + ai * HALF + m * 16) * ldc + col0;
                float o[8];
#pragma unroll
                for (int n = 0; n < 2; ++n)
#pragma unroll
                    for (int j = 0; j < 4; ++j) { const float g = acc[ai][0][m][n][j], up = acc[ai][1][m][n][j]; o[n * 4 + j] = g * __builtin_amdgcn_rcpf(1.f + __expf(-g)) * up; }
                u32x4 w; w.x = cvt_pk_bf16(o[0], o[1]); w.y = cvt_pk_bf16(o[2], o[3]); w.z = cvt_pk_bf16(o[4], o[5]); w.w = cvt_pk_bf16(o[6], o[7]);
                *(u32x4*)rowp = w; }
    }
};
struct EpiSwiGLU8 {
    static constexpr bool PERM = true, XBAR = false;
    unsigned char* O; int ldc; float isc, osc;
    __device__ __forceinline__ void operator()(const f32x4 (&acc)[2][2][4][2], const Unit& u, int wr, int wc, int fr, int fq) const {
        const int row0 = u.pm * BM + wr * 64 + fr, col0 = u.pn * HALF + wc * 32 + 8 * fq;
#pragma unroll
        for (int ai = 0; ai < 2; ++ai)
#pragma unroll
            for (int m = 0; m < 4; ++m) { unsigned char* rowp = O + (size_t)(row0 + ai * HALF + m * 16) * ldc + col0;
                float o[8];
#pragma unroll
                for (int n = 0; n < 2; ++n)
#pragma unroll
                    for (int j = 0; j < 4; ++j) { const float g = acc[ai][0][m][n][j] * isc, up = acc[ai][1][m][n][j] * isc; o[n * 4 + j] = g * __builtin_amdgcn_rcpf(1.f + __expf(-g)) * up * osc; }
                u32x2 w; w.x = pk4_fp8(o[0], o[1], o[2], o[3]); w.y = pk4_fp8(o[4], o[5], o[6], o[7]);
                *(u32x2*)rowp = w; }
    }
};
struct EpiResGate {
    static constexpr bool PERM = false, XBAR = false;
    const float* base; float* out; int ldc; const float* gate; int gstride;
    __device__ __forceinline__ void operator()(const f32x4 (&acc)[2][2][4][2], const Unit& u, int wr, int wc, int fr, int fq) const {
        const int row0 = u.pm * BM + wr * 64 + fr, col0 = u.pn * BM + wc * 32 + 4 * fq;
        const float* gp = gate + (size_t)((u.pm * BM) >> 11) * gstride + col0;
        f32x4 gv[2][2];
#pragma unroll
        for (int bj = 0; bj < 2; ++bj)
#pragma unroll
            for (int n = 0; n < 2; ++n) gv[bj][n] = *(const f32x4*)(gp + bj * HALF + n * 16);
#pragma unroll
        for (int ai = 0; ai < 2; ++ai)
#pragma unroll
            for (int m = 0; m < 4; ++m) { const size_t off = (size_t)(row0 + ai * HALF + m * 16) * ldc + col0;
#pragma unroll
                for (int bj = 0; bj < 2; ++bj)
#pragma unroll
                    for (int n = 0; n < 2; ++n) { const f32x4 bs = *(const f32x4*)(base + off + bj * HALF + n * 16);
                        *(f32x4*)(out + off + bj * HALF + n * 16) = bs + gv[bj][n] * acc[ai][bj][m][n]; }
                asm volatile("" ::: "memory"); }
    }
};
template <bool BASE16>
struct EpiResGate16 {
    static constexpr bool PERM = true, XBAR = false;
    const void* base; bf16_t* out; int ldc; const float* gate; int gstride; float sc = 1.0f;
    __device__ __forceinline__ void operator()(const f32x4 (&acc)[2][2][4][2], const Unit& u, int wr, int wc, int fr, int fq) const {
        const int row0 = u.pm * BM + wr * 64 + fr, col0 = u.pn * BM + wc * 32 + 8 * fq;
        const float* gp = gate + (size_t)((u.pm * BM) >> 11) * gstride + col0;
        f32x4 gv[2][2];
#pragma unroll
        for (int bj = 0; bj < 2; ++bj)
#pragma unroll
            for (int n = 0; n < 2; ++n) gv[bj][n] = *(const f32x4*)(gp + bj * HALF + 4 * n) * sc;
#pragma unroll
        for (int ai = 0; ai < 2; ++ai)
#pragma unroll
            for (int m = 0; m < 4; ++m) { const size_t off = (size_t)(row0 + ai * HALF + m * 16) * ldc + col0;
#pragma unroll
                for (int bj = 0; bj < 2; ++bj) { f32x4 b0, b1;
                    if (BASE16) { const u32x4 r = *(const u32x4*)((const bf16_t*)base + off + bj * HALF);
                        b0 = (f32x4){__uint_as_float(r.x << 16), __uint_as_float(r.x & 0xffff0000u), __uint_as_float(r.y << 16), __uint_as_float(r.y & 0xffff0000u)};
                        b1 = (f32x4){__uint_as_float(r.z << 16), __uint_as_float(r.z & 0xffff0000u), __uint_as_float(r.w << 16), __uint_as_float(r.w & 0xffff0000u)}; }
                    else { b0 = *(const f32x4*)((const float*)base + off + bj * HALF); b1 = *(const f32x4*)((const float*)base + off + bj * HALF + 4); }
                    const f32x4 v0 = b0 + gv[bj][0] * acc[ai][bj][m][0], v1 = b1 + gv[bj][1] * acc[ai][bj][m][1];
                    u32x4 w; w.x = cvt_pk_bf16(v0[0], v0[1]); w.y = cvt_pk_bf16(v0[2], v0[3]); w.z = cvt_pk_bf16(v1[0], v1[1]); w.w = cvt_pk_bf16(v1[2], v1[3]);
                    *(u32x4*)(out + off + bj * HALF) = w; }
                asm volatile("" ::: "memory"); }
    }
};
struct EpiF32 {
    static constexpr bool PERM = false, XBAR = false;
    float* C; int ldc; float sc;
    __device__ __forceinline__ void operator()(const f32x4 (&acc)[2][2][4][2], const Unit& u, int wr, int wc, int fr, int fq) const {
        const int row0 = u.pm * BM + wr * 64 + fr, col0 = u.pn * BM + wc * 32 + 4 * fq;
#pragma unroll
        for (int ai = 0; ai < 2; ++ai)
#pragma unroll
            for (int m = 0; m < 4; ++m) { float* rowp = C + (size_t)(row0 + ai * HALF + m * 16) * ldc + col0;
#pragma unroll
                for (int bj = 0; bj < 2; ++bj)
#pragma unroll
                    for (int n = 0; n < 2; ++n) *(f32x4*)(rowp + bj * HALF + n * 16) = acc[ai][bj][m][n] * sc; }
    }
};

template <class Epi, class Sched, bool F8 = false, int HOT = 0, int SCH = GEMM_SCH>
__device__ __forceinline__ void gemm_phase(LAS unsigned char* lds, const Gemm g, const Sched& S, const Epi& E) {
    int tid = threadIdx.x; asm volatile("" : "+v"(tid));
    const int wid = __builtin_amdgcn_readfirstlane(tid >> 6), lane = tid & 63, wr = wid >> 2, wc = wid & 3, fr = lane & 15, fq = lane >> 4;
    const int rowb = F8 ? g.K : 2 * g.K, nt = g.ntk ? g.ntk : rowb / (BK * 2);
    unsigned voffA[2], voffB[2];
#pragma unroll
    for (int i = 0; i < 2; ++i) { int R, C; stage_rc(tid * 16 + i * 8192, R, C); const int Rb = Epi::PERM ? ((R & ~31) + perm32(R & 31)) : R;
        voffA[i] = (unsigned)(R * rowb + C * 2); voffB[i] = (unsigned)(Rb * rowb + C * 2); }
    const size_t kstep = (size_t)(BK * 2);
    const size_t hstep = (size_t)HALF * rowb;
    const size_t tstep = 2 * hstep;
    const unsigned ldsw = (unsigned)wid * 1024u;
    const int aoff = lds_byte(wr * 64 + fr, fq * 8), boff = lds_byte(wc * 32 + fr, fq * 8);
#define PG8_SA(b, h) (((b) * 2 + (h)) * HTB)
#define PG8_SB(b, h) ((4 + (b) * 2 + (h)) * HTB)
#define PG8_STAGE(bufoff, gbase, voff) do { _Pragma("unroll") for (int _i = 0; _i < 2; ++_i) \
        __builtin_amdgcn_global_load_lds((const unsigned*)((const char*)(gbase) + (voff)[_i]), (LAS unsigned*)(lds + (bufoff) + ldsw + _i * 8192), 16, 0, 0); } while (0)
#define PG8_LD8(base_) __builtin_shufflevector(*(const LAS i32x4*)(base_), *(const LAS i32x4*)((base_) + 1024), 0, 1, 2, 3, 4, 5, 6, 7)
#define PG8_LDA(dst, b, h) do { _Pragma("unroll") for (int m = 0; m < 4; ++m) { if constexpr (F8) dst##8[m] = PG8_LD8(lds + PG8_SA(b, h) + aoff + m * 2048); \
        else { _Pragma("unroll") for (int k = 0; k < 2; ++k) dst[m][k] = *(const LAS bf16x8*)(lds + PG8_SA(b, h) + aoff + m * 2048 + k * 1024); } } } while (0)
#define PG8_LDB(dst, b, h) do { _Pragma("unroll") for (int n = 0; n < 2; ++n) { if constexpr (F8) dst##8[n] = PG8_LD8(lds + PG8_SB(b, h) + boff + n * 2048); \
        else { _Pragma("unroll") for (int k = 0; k < 2; ++k) dst[n][k] = *(const LAS bf16x8*)(lds + PG8_SB(b, h) + boff + n * 2048 + k * 1024); } } } while (0)
#define PG8_MMA(ai, bj, At, Bt) do { __builtin_amdgcn_s_setprio(1); _Pragma("unroll") for (int m = 0; m < 4; ++m) _Pragma("unroll") for (int n = 0; n < 2; ++n) { \
        if constexpr (F8) { asm volatile("v_mfma_f32_16x16x128_f8f6f4 %0, %1, %2, %0" : "+v"(acc[ai][bj][m][n]) : "v"(Bt##8[n]), "v"(At##8[m])); } \
        else { _Pragma("unroll") for (int k = 0; k < 2; ++k) acc[ai][bj][m][n] = __builtin_amdgcn_mfma_f32_16x16x32_bf16(Bt[n][k], At[m][k], acc[ai][bj][m][n], 0, 0, 0); } } \
        __builtin_amdgcn_s_setprio(0); } while (0)
#define PG8_WAIT_V(n) asm volatile("s_waitcnt vmcnt(" #n ")" ::: "memory")
#define PG8_WAIT_L(n) asm volatile("s_waitcnt lgkmcnt(" #n ")" ::: "memory")
#define PG8_BAR __builtin_amdgcn_s_barrier()
#define PG8_SCHED __builtin_amdgcn_sched_barrier(0)
    Unit cur, nxt; int ui = 0;
    if (!S.next(0, cur)) return;
    f32x4 acc[2][2][4][2];
#pragma unroll
    for (int a = 0; a < 2; ++a)
#pragma unroll
        for (int b = 0; b < 2; ++b)
#pragma unroll
            for (int m = 0; m < 4; ++m)
#pragma unroll
                for (int n = 0; n < 2; ++n) acc[a][b][m][n] = (f32x4){0.f, 0.f, 0.f, 0.f};
    bf16x8 At[4][2], B0[2][2], B1[2][2]; i32x8 At8[4], B08[2], B18[2];
    const char* cA = (const char*)g.A + cur.aoff + (size_t)(HOT ? 0 : cur.pm) * tstep; const char* cB = (const char*)g.Bt + cur.boff + (size_t)(HOT ? 0 : cur.pn) * tstep;
    if constexpr (SCH == 1) {
        PG8_STAGE(PG8_SB(0, 0), cB, voffB); PG8_STAGE(PG8_SB(0, 1), cB + hstep, voffB); PG8_STAGE(PG8_SA(0, 0), cA, voffA); PG8_STAGE(PG8_SA(0, 1), cA + hstep, voffA);
        if (wr == 1) PG8_BAR;
        PG8_WAIT_V(2); PG8_BAR;
        PG8_STAGE(PG8_SB(1, 0), cB + kstep, voffB); PG8_STAGE(PG8_SB(1, 1), cB + hstep + kstep, voffB); PG8_STAGE(PG8_SA(1, 0), cA + kstep, voffA);
        PG8_WAIT_V(6); PG8_BAR;
    } else {
    PG8_STAGE(PG8_SB(0, 0), cB, voffB); PG8_STAGE(PG8_SA(0, 0), cA, voffA); PG8_STAGE(PG8_SB(0, 1), cB + hstep, voffB); PG8_STAGE(PG8_SA(0, 1), cA + hstep, voffA);
    if (wr == 1) PG8_BAR;
    PG8_WAIT_V(4); PG8_BAR;
    PG8_STAGE(PG8_SB(1, 0), cB + kstep, voffB); PG8_STAGE(PG8_SA(1, 0), cA + kstep, voffA); PG8_STAGE(PG8_SB(1, 1), cB + hstep + kstep, voffB);
    PG8_WAIT_V(6); PG8_BAR;
    }
    for (;;) {
        const bool has_next = S.next(ui + 1, nxt);
        const char* nA = has_next ? (const char*)g.A + nxt.aoff + (size_t)(HOT ? 0 : nxt.pm) * tstep : cA; const char* nB = has_next ? (const char*)g.Bt + nxt.boff + (size_t)(HOT ? 0 : nxt.pn) * tstep : cB;
        for (int t = 0; t < nt; t += 2) {
            const bool last = (t == nt - 2);
            const char* a1 = cA + (size_t)(t + 1) * kstep;
            const char* a2 = last ? nA : cA + (size_t)(t + 2) * kstep; const char* b2 = last ? nB : cB + (size_t)(t + 2) * kstep;
            const char* a3 = a2 + kstep; const char* b3 = b2 + kstep;
            if constexpr (SCH == 1) {
                PG8_LDB(B0, 0, 0); PG8_LDB(B1, 0, 1); PG8_SCHED; PG8_LDA(At, 0, 0); PG8_STAGE(PG8_SA(1, 1), a1 + hstep, voffA);
                PG8_WAIT_V(8); PG8_WAIT_L(0); PG8_BAR; PG8_MMA(0, 0, At, B0); PG8_MMA(0, 1, At, B1); PG8_BAR; PG8_SCHED;
                PG8_LDA(At, 0, 1); PG8_STAGE(PG8_SB(0, 0), b2, voffB); PG8_STAGE(PG8_SB(0, 1), b2 + hstep, voffB); PG8_STAGE(PG8_SA(0, 0), a2, voffA);
                PG8_WAIT_V(8); PG8_WAIT_L(0); PG8_BAR; PG8_MMA(1, 0, At, B0); PG8_MMA(1, 1, At, B1); PG8_BAR; PG8_SCHED;
                PG8_LDB(B0, 1, 0); PG8_LDB(B1, 1, 1); PG8_SCHED; PG8_LDA(At, 1, 0); PG8_STAGE(PG8_SA(0, 1), a2 + hstep, voffA);
                PG8_WAIT_V(8); PG8_WAIT_L(0); PG8_BAR; PG8_MMA(0, 0, At, B0); PG8_MMA(0, 1, At, B1); PG8_BAR; PG8_SCHED;
                PG8_LDA(At, 1, 1); PG8_STAGE(PG8_SB(1, 0), b3, voffB); PG8_STAGE(PG8_SB(1, 1), b3 + hstep, voffB); PG8_STAGE(PG8_SA(1, 0), a3, voffA);
                PG8_WAIT_V(8); PG8_WAIT_L(0); PG8_BAR; PG8_MMA(1, 0, At, B0); PG8_MMA(1, 1, At, B1); PG8_BAR; PG8_SCHED;
                continue;
            }
            PG8_LDB(B0, 0, 0); PG8_SCHED; PG8_LDA(At, 0, 0); PG8_STAGE(PG8_SA(1, 1), a1 + hstep, voffA);
            PG8_WAIT_L(8); PG8_BAR; PG8_WAIT_L(0); PG8_MMA(0, 0, At, B0); PG8_BAR; PG8_SCHED;
            PG8_LDB(B1, 0, 1); PG8_STAGE(PG8_SB(0, 0), b2, voffB);
            PG8_BAR; PG8_WAIT_L(0); PG8_MMA(0, 1, At, B1); PG8_BAR;
            PG8_LDA(At, 0, 1); PG8_STAGE(PG8_SA(0, 0), a2, voffA);
            PG8_BAR; PG8_WAIT_L(0); PG8_MMA(1, 0, At, B0); PG8_BAR; PG8_SCHED;
            PG8_STAGE(PG8_SB(0, 1), b2 + hstep, voffB);
            PG8_WAIT_V(6); PG8_BAR; PG8_MMA(1, 1, At, B1); PG8_BAR;
            PG8_LDB(B0, 1, 0); PG8_SCHED; PG8_LDA(At, 1, 0); PG8_STAGE(PG8_SA(0, 1), a2 + hstep, voffA);
            PG8_WAIT_L(8); PG8_BAR; PG8_WAIT_L(0); PG8_MMA(0, 0, At, B0); PG8_BAR; PG8_SCHED;
            PG8_LDB(B1, 1, 1); PG8_STAGE(PG8_SB(1, 0), b3, voffB);
            PG8_BAR; PG8_WAIT_L(0); PG8_MMA(0, 1, At, B1); PG8_BAR;
            PG8_LDA(At, 1, 1); PG8_STAGE(PG8_SA(1, 0), a3, voffA);
            PG8_BAR; PG8_WAIT_L(0); PG8_MMA(1, 0, At, B0); PG8_BAR; PG8_SCHED;
            PG8_STAGE(PG8_SB(1, 1), b3 + hstep, voffB);
            PG8_WAIT_V(6); PG8_BAR; PG8_MMA(1, 1, At, B1); PG8_BAR;
        }
        if constexpr (F8) asm volatile("s_nop 15\n\ts_nop 15" ::: "memory");
        if constexpr (Epi::XBAR) { LAS float* P_ = (LAS float*)(lds + STAGE_BYTES); E.pre(acc, wr, wc, fr, fq, P_); PG8_WAIT_L(0); PG8_BAR; asm volatile("" ::: "memory"); E.post(acc, cur, wr, wc, fr, fq, P_); }
        else E(acc, cur, wr, wc, fr, fq);
        if (!has_next) break;
#pragma unroll
        for (int a = 0; a < 2; ++a)
#pragma unroll
            for (int b = 0; b < 2; ++b)
#pragma unroll
                for (int m = 0; m < 4; ++m)
#pragma unroll
                    for (int n = 0; n < 2; ++n) acc[a][b][m][n] = (f32x4){0.f, 0.f, 0.f, 0.f};
        cur = nxt; cA = nA; cB = nB; ++ui;
    }
    PG8_WAIT_V(0);
    if (wr == 0) PG8_BAR;
    PG8_BAR;
#undef PG8_SA
#undef PG8_SB
#undef PG8_STAGE
#undef PG8_LDA
#undef PG8_LDB
#undef PG8_MMA
#undef PG8_WAIT_V
#undef PG8_WAIT_L
#undef PG8_BAR
#undef PG8_SCHED
}
}

DI void mod_phase(const float* c, const float* mod_w, const float* mod_b, float* mod, LAS unsigned char* lds, int G, int tid, int lane, int wave) {
    LAS f32x4* cact = (LAS f32x4*)lds;
    LAS float* red = (LAS float*)(lds + 32768);
    for (int k = tid; k < DM; k += NTHREADS) { f32x4 v; v.x = silu_f(c[k]); v.y = silu_f(c[DM + k]); v.z = silu_f(c[2 * DM + k]); v.w = silu_f(c[3 * DM + k]); cact[k] = v; }
    __syncthreads();
    for (int it = blockIdx.x; it < 256; it += G) {
        const int l = it >> 7, n0 = (it & 127) * 96;
        float a0[4] = {0.f, 0.f, 0.f, 0.f}, a1[4] = {0.f, 0.f, 0.f, 0.f};
        if (lane < 48) {
            const float* wp = mod_w + ((size_t)l * DM + wave * 256) * 12288 + n0 + 2 * lane;
#pragma unroll 8
            for (int k = 0; k < 256; ++k) { const f32x2 w = *(const f32x2*)(wp + (size_t)k * 12288); const f32x4 cv = cact[wave * 256 + k];
                a0[0] += cv.x * w.x; a1[0] += cv.x * w.y; a0[1] += cv.y * w.x; a1[1] += cv.y * w.y; a0[2] += cv.z * w.x; a1[2] += cv.z * w.y; a0[3] += cv.w * w.x; a1[3] += cv.w * w.y; }
#pragma unroll
            for (int b = 0; b < 4; ++b) { red[(wave * 4 + b) * 96 + 2 * lane] = a0[b]; red[(wave * 4 + b) * 96 + 2 * lane + 1] = a1[b]; }
        }
        __syncthreads();
        if (tid < 384) { const int b = tid / 96, col = tid % 96; float s = mod_b[l * 12288 + n0 + col];
#pragma unroll
            for (int w = 0; w < 8; ++w) s += red[(w * 4 + b) * 96 + col];
            mod[((size_t)l * 4 + b) * 12288 + n0 + col] = s; }
        __syncthreads();
    }
}

template <int MODE>
DI void cvt_item(const float* W, int K, int N, bf16_t* WT, LAS float* scr, int kb, int nb, int lane) {
    const int k0 = 64 * kb, n0 = 32 * nb;
    float v[32];
    const float* wp = W + (size_t)(k0 + (lane >> 5)) * N + n0 + (lane & 31);
#pragma unroll
    for (int i = 0; i < 32; ++i) v[i] = wp[(size_t)(2 * i) * N];
#pragma unroll
    for (int i = 0; i < 32; ++i) scr[(2 * i + (lane >> 5)) * 33 + (lane & 31)] = v[i];
    LDS_WAIT();
    const int c = lane & 7;
#pragma unroll
    for (int j = 0; j < 4; ++j) { const int n = (lane >> 3) + 8 * j; const LAS float* s = scr + (8 * c) * 33 + n;
        u32x4 o; o.x = cvt_pk_bf16(s[0 * 33], s[1 * 33]); o.y = cvt_pk_bf16(s[2 * 33], s[3 * 33]); o.z = cvt_pk_bf16(s[4 * 33], s[5 * 33]); o.w = cvt_pk_bf16(s[6 * 33], s[7 * 33]);
        const int ng = n0 + n; const int row = (MODE == 0) ? ng : ((ng >> 7) * 256 + (ng & 127) + (MODE == 2 ? 128 : 0));
        *(u32x4*)(WT + (size_t)row * K + k0 + 8 * c) = o; }
    LDS_WAIT();
}
template <int MODE>
DI void cvt_item8(const float* W, int K, int N, unsigned char* WT, LAS float* scr, int kb, int nb, int lane, float wsc) {
    const int k0 = 64 * kb, n0 = 32 * nb;
    float v[32];
    const float* wp = W + (size_t)(k0 + (lane >> 5)) * N + n0 + (lane & 31);
#pragma unroll
    for (int i = 0; i < 32; ++i) v[i] = wp[(size_t)(2 * i) * N];
#pragma unroll
    for (int i = 0; i < 32; ++i) scr[(2 * i + (lane >> 5)) * 33 + (lane & 31)] = v[i] * wsc;
    LDS_WAIT();
    const int c = lane & 3;
#pragma unroll
    for (int j = 0; j < 2; ++j) { const int n = (lane >> 2) + 16 * j; const LAS float* s = scr + (16 * c) * 33 + n;
        u32x4 o; o.x = pk4_fp8(s[0 * 33], s[1 * 33], s[2 * 33], s[3 * 33]); o.y = pk4_fp8(s[4 * 33], s[5 * 33], s[6 * 33], s[7 * 33]);
        o.z = pk4_fp8(s[8 * 33], s[9 * 33], s[10 * 33], s[11 * 33]); o.w = pk4_fp8(s[12 * 33], s[13 * 33], s[14 * 33], s[15 * 33]);
        const int ng = n0 + n; const int row = (MODE == 0) ? ng : ((ng >> 7) * 256 + (ng & 127) + (MODE == 2 ? 128 : 0));
        *(u32x4*)(WT + (size_t)row * K + k0 + 16 * c) = o; }
    LDS_WAIT();
}
template <int MODE>
DI void cvt_job8(const float* W, int K, int N, int nbatch, unsigned char* WT, size_t dst_bstride, LAS float* scr, int gw, int NGW, int lane, float wsc) {
    const int nnb = N / 32, per = (K / 64) * nnb, total = per * nbatch;
    for (int it = gw; it < total; it += NGW) {
        const int bt = it / per, r = it - bt * per, kb = r / nnb, nb = r - kb * nnb;
        cvt_item8<MODE>(W + (size_t)bt * K * N, K, N, WT + (size_t)bt * dst_bstride, scr, kb, nb, lane, wsc);
    }
}
template <int MODE>
DI void cvt_job(const float* W, int K, int N, int nbatch, bf16_t* WT, size_t dst_bstride, LAS float* scr, int gw, int NGW, int lane) {
    const int nnb = N / 32, per = (K / 64) * nnb, total = per * nbatch;
    for (int it = gw; it < total; it += NGW) {
        const int bt = it / per, r = it - bt * per, kb = r / nnb, nb = r - kb * nnb;
        cvt_item<MODE>(W + (size_t)bt * K * N, K, N, WT + (size_t)bt * dst_bstride, scr, kb, nb, lane);
    }
}

DI void cvtw_load(f32x4 (&v)[16], const float* wp, int N) {
#pragma unroll
    for (int i = 0; i < 16; ++i) v[i] = __builtin_nontemporal_load((const f32x4*)(wp + (size_t)(4 * i) * N));
}
template <int MODE, bool OUT8>
DI void cvtw_store(const f32x4 (&v)[16], int K, void* WTb, LAS float* scr, int k0, int n0, int lane, float wsc) {
    const int kr = lane >> 4, n4 = lane & 15;
#pragma unroll
    for (int i = 0; i < 16; ++i)
#pragma unroll
        for (int e = 0; e < 4; ++e) scr[(4 * n4 + e) * 65 + 4 * i + kr] = OUT8 ? v[i][e] * wsc : v[i][e];
    LDS_WAIT();
    if (OUT8) {
        unsigned char* WT = (unsigned char*)WTb; const int c = lane & 3;
#pragma unroll
        for (int j = 0; j < 4; ++j) { const int n = (lane >> 2) + 16 * j; const LAS float* s = scr + n * 65 + 16 * c;
            u32x4 o; o.x = pk4_fp8(s[0], s[1], s[2], s[3]); o.y = pk4_fp8(s[4], s[5], s[6], s[7]); o.z = pk4_fp8(s[8], s[9], s[10], s[11]); o.w = pk4_fp8(s[12], s[13], s[14], s[15]);
            const int ng = n0 + n; const int row = (MODE == 0) ? ng : ((ng >> 7) * 256 + (ng & 127) + (MODE == 2 ? 128 : 0));
            *(u32x4*)(WT + (size_t)row * K + k0 + 16 * c) = o; }
    } else {
        bf16_t* WT = (bf16_t*)WTb; const int c = lane & 7;
#pragma unroll
        for (int j = 0; j < 8; ++j) { const int n = (lane >> 3) + 8 * j; const LAS float* s = scr + n * 65 + 8 * c;
            u32x4 o; o.x = cvt_pk_bf16(s[0], s[1]); o.y = cvt_pk_bf16(s[2], s[3]); o.z = cvt_pk_bf16(s[4], s[5]); o.w = cvt_pk_bf16(s[6], s[7]);
            const int ng = n0 + n; const int row = (MODE == 0) ? ng : ((ng >> 7) * 256 + (ng & 127) + (MODE == 2 ? 128 : 0));
            *(u32x4*)(WT + (size_t)row * K + k0 + 8 * c) = o; }
    }
    LDS_WAIT();
}
DI void cvtw_pack8(const f32x4 (&v)[16], LAS float* scr, int lane, float wsc, u32x4 (&o)[4]) {
    const int kr = lane >> 4, n4 = lane & 15;
#pragma unroll
    for (int i = 0; i < 16; ++i)
#pragma unroll
        for (int e = 0; e < 4; ++e) scr[(4 * n4 + e) * 65 + 4 * i + kr] = v[i][e] * wsc;
    LDS_WAIT();
    const int c = lane & 3;
#pragma unroll
    for (int j = 0; j < 4; ++j) { const int n = (lane >> 2) + 16 * j; const LAS float* s = scr + n * 65 + 16 * c;
        o[j].x = pk4_fp8(s[0], s[1], s[2], s[3]); o[j].y = pk4_fp8(s[4], s[5], s[6], s[7]); o[j].z = pk4_fp8(s[8], s[9], s[10], s[11]); o[j].w = pk4_fp8(s[12], s[13], s[14], s[15]); }
    LDS_WAIT();
}
template <int MODE, bool OUT8>
DI void cvtw_job(const float* W, int K, int N, int nbatch, void* WT, size_t dst_bstride_bytes, LAS float* scr, int gw, int NGW, int lane, float wsc, int ld = 0, int off = 0) {
    const int nnb = N / 64, per = (K / 128) * nnb, total = per * nbatch;
    const int pitch = ld ? ld : N;
    const int first = (gw + NGW - (off % NGW)) % NGW;
    if (first >= total) return;
#define CVTW_SRC(it_) ({ const int bt_ = (it_) / per, r_ = (it_) - bt_ * per, kb_ = r_ / nnb, nb_ = r_ - kb_ * nnb; W + (size_t)bt_ * K * pitch + (size_t)(128 * kb_ + (lane >> 4)) * pitch + 64 * nb_ + 4 * (lane & 15); })
    for (int it = first; it < total; it += NGW) {
        const int bt = it / per, r = it - bt * per, kb = r / nnb, nb = r - kb * nnb, k0 = 128 * kb, n0 = 64 * nb;
        f32x4 v0[16], v1[16];
        { const float* wp = CVTW_SRC(it); cvtw_load(v0, wp, pitch); cvtw_load(v1, wp + (size_t)64 * pitch, pitch); }
        void* WTb = (unsigned char*)WT + (size_t)bt * dst_bstride_bytes;
        if (OUT8) {
            u32x4 o0[4], o1[4];
            cvtw_pack8(v0, scr, lane, wsc, o0);
            cvtw_pack8(v1, scr, lane, wsc, o1);
            unsigned char* WT8 = (unsigned char*)WTb; const int c = lane & 3;
#pragma unroll
            for (int j = 0; j < 4; ++j) { const int ng = n0 + (lane >> 2) + 16 * j; const int row = (MODE == 0) ? ng : ((ng >> 7) * 256 + (ng & 127) + (MODE == 2 ? 128 : 0));
                unsigned char* dp = WT8 + (size_t)row * K + k0 + 16 * c; *(u32x4*)dp = o0[j]; *(u32x4*)(dp + 64) = o1[j]; }
        } else {
            cvtw_store<MODE, OUT8>(v0, K, WTb, scr, k0, n0, lane, wsc);
            cvtw_store<MODE, OUT8>(v1, K, WTb, scr, k0 + 64, n0, lane, wsc);
        }
    }
#undef CVTW_SRC
}

constexpr float HSCALE = 8.f, WSCALE = 256.f, ASCALE = 8.f;
template <bool ROUTER, bool OUT8 = false, bool X16 = false>
DI void rms_mod_phase(const void* X, const float* g, const float* scale, const float* shift, bf16_t* out,
                      const float* router, int* tok_e, int* tok_pos, float* tok_w, unsigned* ecnt, unsigned char* HS2, int gw, int NGW, int lane, LAS float* rl = nullptr, int tid = 0) {
    if (ROUTER) {
        for (int c = tid; c < DM; c += NTHREADS) { const f32x4 r0 = ((const f32x4*)router)[2 * c], r1 = ((const f32x4*)router)[2 * c + 1];
            rl[c] = r0.x; rl[DM + c] = r0.y; rl[2 * DM + c] = r0.z; rl[3 * DM + c] = r0.w; rl[4 * DM + c] = r1.x; rl[5 * DM + c] = r1.y; rl[6 * DM + c] = r1.z; rl[7 * DM + c] = r1.w; }
        __syncthreads();
    }
    for (int row0 = 4 * gw; row0 < MTOK; row0 += 4 * NGW) {
        const int b = row0 >> 11;
        const f32x4* gp = (const f32x4*)g + lane; const f32x4* sc = (const f32x4*)(scale + (size_t)b * 12288) + lane; const f32x4* sh = (const f32x4*)(shift + (size_t)b * 12288) + lane;
        f32x4 gm[8], shv[8];
        if (!ROUTER) {
#pragma unroll
          for (int j = 0; j < 8; ++j) { gm[j] = gp[64 * j] * (sc[64 * j] + 1.0f); shv[j] = sh[64 * j]; } }
#pragma unroll 1
      for (int rr = 0; rr < 4; ++rr) { const int row = row0 + rr;
        f32x4 v[8]; float ss = 0.f;
        if (X16) { const u32x2* xr = (const u32x2*)((const bf16_t*)X + (size_t)row * DM) + lane; u32x2 raw[8];
#pragma unroll
            for (int j = 0; j < 8; ++j) raw[j] = xr[64 * j];
#pragma unroll
            for (int j = 0; j < 8; ++j) v[j] = (f32x4){bf_lo(raw[j].x), bf_hi(raw[j].x), bf_lo(raw[j].y), bf_hi(raw[j].y)}; }
        else { const f32x4* xr = (const f32x4*)((const float*)X + (size_t)row * DM) + lane;
#pragma unroll
            for (int j = 0; j < 8; ++j) v[j] = xr[64 * j]; }
#pragma unroll
        for (int j = 0; j < 8; ++j) ss += (v[j].x * v[j].x + v[j].y * v[j].y) + (v[j].z * v[j].z + v[j].w * v[j].w);
        const float rstd = 1.0f / sqrtf(wave_sum(ss) * (1.f / DM) + 1e-6f);
        u32x2* op = (u32x2*)(out + (size_t)row * DM) + lane;
        float lg[8] = {0.f, 0.f, 0.f, 0.f, 0.f, 0.f, 0.f, 0.f}; unsigned h8[8];
#pragma unroll
        for (int j = 0; j < 8; ++j) {
            const f32x4 h = ROUTER ? (v[j] * rstd) * (gp[64 * j] * (sc[64 * j] + 1.0f)) + sh[64 * j] : (v[j] * rstd) * gm[j] + shv[j];
            if (ROUTER) { h8[j] = pk4_fp8(h.x * HSCALE, h.y * HSCALE, h.z * HSCALE, h.w * HSCALE); }
            else { u32x2 w; w.x = cvt_pk_bf16(h.x, h.y); w.y = cvt_pk_bf16(h.z, h.w); op[64 * j] = w;
                   if (OUT8) ((unsigned*)(HS2 + (size_t)row * DM) + lane)[64 * j] = pk4_fp8(h.x * HSCALE, h.y * HSCALE, h.z * HSCALE, h.w * HSCALE); }
            if (ROUTER) {
#pragma unroll
                for (int e = 0; e < 8; ++e) { const f32x4 we = *(const LAS f32x4*)(rl + e * DM + 256 * j + 4 * lane); lg[e] += (h.x * we.x + h.y * we.y) + (h.z * we.z + h.w * we.w); }
                __builtin_amdgcn_sched_barrier(0); } }
        if (ROUTER) {
#pragma unroll
            for (int e = 0; e < 8; ++e) lg[e] = wave_sum(lg[e]);
            if (lane == 0) {
                int i0 = 0; float v0 = lg[0];
#pragma unroll
                for (int e = 1; e < 8; ++e) if (lg[e] > v0) { v0 = lg[e]; i0 = e; }
                int i1 = -1; float v1 = -3.0e38f;
#pragma unroll
                for (int e = 0; e < 8; ++e) if (e != i0 && lg[e] > v1) { v1 = lg[e]; i1 = e; }
                const float w1 = 1.f / (1.f + expf(v0 - v1)), w0 = 1.f - w1;
                const int p0 = (int)__hip_atomic_fetch_add(ecnt + 64 * i0, 1u, __ATOMIC_RELAXED, __HIP_MEMORY_SCOPE_AGENT);
                const int p1 = (int)__hip_atomic_fetch_add(ecnt + 64 * i1, 1u, __ATOMIC_RELAXED, __HIP_MEMORY_SCOPE_AGENT);
                tok_e[2 * row] = i0; tok_e[2 * row + 1] = i1; tok_pos[2 * row] = p0; tok_pos[2 * row + 1] = p1; tok_w[2 * row] = w0; tok_w[2 * row + 1] = w1;
                lg[0] = __int_as_float(i0 * pg8::ECAP + p0); lg[1] = __int_as_float(i1 * pg8::ECAP + p1);
            }
            const int ra = __builtin_amdgcn_readfirstlane(__float_as_int(lg[0])), rb = __builtin_amdgcn_readfirstlane(__float_as_int(lg[1]));
            unsigned* da = (unsigned*)(HS2 + (size_t)ra * DM) + lane; unsigned* db = (unsigned*)(HS2 + (size_t)rb * DM) + lane;
#pragma unroll
            for (int j = 0; j < 8; ++j) { da[64 * j] = h8[j]; db[64 * j] = h8[j]; }
        }
      }
    }
}

DI void qknorm_phase(const bf16_t* QK, bf16_t* QKN, const float* qg, const float* kg, int gw, int NGW, int lane) {
    const int l16 = lane & 15;
    for (int idx = gw * 4 + (lane >> 4); idx < MTOK * 32; idx += NGW * 4) {
        const int hr = idx & 31; const size_t off = (size_t)(idx >> 5) * 4096 + hr * 128 + 8 * l16;
        const u32x4 raw = *(const u32x4*)(QK + off);
        float x[8] = {bf_lo(raw.x), bf_hi(raw.x), bf_lo(raw.y), bf_hi(raw.y), bf_lo(raw.z), bf_hi(raw.z), bf_lo(raw.w), bf_hi(raw.w)};
        float ss = 0.f;
#pragma unroll
        for (int i = 0; i < 8; ++i) ss += x[i] * x[i];
        ss += __shfl_xor(ss, 1); ss += __shfl_xor(ss, 2); ss += __shfl_xor(ss, 4); ss += __shfl_xor(ss, 8);
        const float rstd = (1.0f / sqrtf(ss * (1.f / 128.f) + 1e-6f)) * (hr < 16 ? 0.08838834764831845f : 1.0f);
        const float* gp = (hr < 16 ? qg : kg) + 8 * l16;
        const f32x4 g0 = *(const f32x4*)gp, g1 = *(const f32x4*)(gp + 4);
        u32x4 o; o.x = cvt_pk_bf16(x[0] * rstd * g0.x, x[1] * rstd * g0.y); o.y = cvt_pk_bf16(x[2] * rstd * g0.z, x[3] * rstd * g0.w);
        o.z = cvt_pk_bf16(x[4] * rstd * g1.x, x[5] * rstd * g1.y); o.w = cvt_pk_bf16(x[6] * rstd * g1.z, x[7] * rstd * g1.w);
        *(u32x4*)(QKN + off) = o;
    }
}

constexpr int NA_TBL = 0, NA_BUF = 30720, NA_TILE = 18432;
DI void na_phase(const bf16_t* QKN, const bf16_t* VT, bf16_t* ATT, const float* rpb, LAS unsigned char* lds, int G, int vcu0, int tid, int lane, int wave) {
    LAS float* rpbL = (LAS float*)(lds + NA_TBL);
    for (int i = tid; i < 16 * 465; i += NTHREADS) rpbL[i] = rpb[i];
    const int c16 = lane & 15, g = lane >> 4, unit = wave >> 2, j = wave & 3;
    const int cb = (j == 0) ? 0 : (j == 1) ? 8 : (j == 2) ? 24 : 32;
    const int qc = 16 * j + c16, c0 = min(max(qc - 8, 0), 48);
    const int kcl = 8 * (c16 >> 2) + (c16 & 3);
    for (int p = vcu0; p < 1024; p += G) {
        const int rho = p & 15, hh = (p >> 4) & 15, b = p >> 8;
        const int rA = 2 * rho, r0A = min(max(rA - 4, 0), 24), r0B = min(max(rA + 1 - 4, 0), 24), delta = r0B - r0A, nrows = 8 + delta;
        const int r = rA + unit, r0 = unit ? r0B : r0A;
        const bool shiftB = (unit == 1) && (delta == 1);
        const size_t tq = (size_t)b * SEQ + r * 64 + qc;
        bf16x8 qf[4];
#pragma unroll
        for (int ks = 0; ks < 4; ++ks) qf[ks] = *(const bf16x8*)(QKN + tq * 4096 + hh * 128 + 32 * ks + 8 * g);
        f32x4 S[8][2];
        u32x4 st0, st1;
        const int kkey = tid >> 3, kch = tid & 7;
        const int vd = tid >> 2, vch = tid & 3;
        const bf16_t* kg = QKN + ((size_t)b * SEQ + (size_t)r0A * 64 + kkey) * 4096 + 2048 + hh * 128 + kch * 8;
        const bf16_t* vg = VT + (size_t)(hh * 128 + vd) * MTOK + (size_t)b * SEQ + (size_t)r0A * 64 + vch * 8;
#define NA_LDK(s_) do { st0 = *(const u32x4*)(kg + (size_t)(s_) * 64 * 4096); st1 = *(const u32x4*)(kg + (size_t)(s_) * 64 * 4096 + 64); } while (0)
#define NA_STK(s_) do { LAS unsigned char* t_ = lds + NA_BUF + ((s_) & 1) * NA_TILE + kkey * 272 + kch * 16; *(LAS u32x4*)t_ = st0; *(LAS u32x4*)(t_ + 128) = st1; } while (0)
#define NA_LDV(s_) do { st0 = *(const u32x4*)(vg + (s_) * 64); st1 = *(const u32x4*)(vg + (s_) * 64 + 32); } while (0)
#define NA_STV(s_) do { LAS unsigned char* t_ = lds + NA_BUF + ((s_) & 1) * NA_TILE + vd * 144 + vch * 16; *(LAS u32x4*)t_ = st0; *(LAS u32x4*)(t_ + 64) = st1; } while (0)
#define NA_QK(s_, i_) do { const LAS unsigned char* kb_ = lds + NA_BUF + ((s_) & 1) * NA_TILE + (cb + kcl) * 272 + 16 * g; \
            _Pragma("unroll") for (int hc = 0; hc < 2; ++hc) { f32x4 a = (f32x4){0.f, 0.f, 0.f, 0.f}; \
                _Pragma("unroll") for (int ks = 0; ks < 4; ++ks) a = __builtin_amdgcn_mfma_f32_16x16x32_bf16(*(const LAS bf16x8*)(kb_ + hc * 4 * 272 + 64 * ks), qf[ks], a, 0, 0, 0); S[i_][hc] = a; } } while (0)
#define NA_SROW(s_) do { if ((s_) < nrows) { NA_STK(s_); __syncthreads(); if ((s_) + 1 < nrows) NA_LDK((s_) + 1); \
            if (!shiftB) { if ((s_) < 8) NA_QK(s_, (s_) < 8 ? (s_) : 7); } else { if ((s_) >= 1) NA_QK(s_, (s_) >= 1 ? (s_) - 1 : 0); } } } while (0)
        __syncthreads();
        NA_LDK(0);
        NA_SROW(0); NA_SROW(1); NA_SROW(2); NA_SROW(3); NA_SROW(4); NA_SROW(5); NA_SROW(6); NA_SROW(7); NA_SROW(8);
        NA_LDV(0);
        float mx = -3.0e38f;
        const LAS float* bt = rpbL + hh * 465;
#pragma unroll
        for (int i = 0; i < 8; ++i)
#pragma unroll
            for (int hc = 0; hc < 2; ++hc)
#pragma unroll
                for (int e = 0; e < 4; ++e) {
                    const int kc = cb + 8 * g + 4 * hc + e; const bool valid = (kc >= c0) && (kc < c0 + 16);
                    const int dj = min(max(kc - qc + 15, 0), 30), di = r0 + i - r + 7;
                    const float sv = valid ? S[i][hc][e] + bt[di * 31 + dj] : -3.0e38f;
                    S[i][hc][e] = sv; mx = fmaxf(mx, sv);
                }
        mx = fmaxf(mx, __shfl_xor(mx, 16)); mx = fmaxf(mx, __shfl_xor(mx, 32));
        float sum = 0.f;
#pragma unroll
        for (int i = 0; i < 8; ++i)
#pragma unroll
            for (int hc = 0; hc < 2; ++hc)
#pragma unroll
                for (int e = 0; e < 4; ++e) { const float pv = (S[i][hc][e] > -1.0e38f) ? __expf(S[i][hc][e] - mx) : 0.f; S[i][hc][e] = pv; sum += pv; }
        sum += __shfl_xor(sum, 16); sum += __shfl_xor(sum, 32);
        const float inv = 1.0f / sum;
        f32x4 O[8];
#pragma unroll
        for (int dt = 0; dt < 8; ++dt) O[dt] = (f32x4){0.f, 0.f, 0.f, 0.f};
#define NA_PV(s_, i_) do { u32x4 pw; pw.x = cvt_pk_bf16(S[i_][0][0], S[i_][0][1]); pw.y = cvt_pk_bf16(S[i_][0][2], S[i_][0][3]); pw.z = cvt_pk_bf16(S[i_][1][0], S[i_][1][1]); pw.w = cvt_pk_bf16(S[i_][1][2], S[i_][1][3]); \
            const bf16x8 pf = __builtin_bit_cast(bf16x8, pw); const LAS unsigned char* vb_ = lds + NA_BUF + ((s_) & 1) * NA_TILE + c16 * 144 + (cb + 8 * g) * 2; \
            _Pragma("unroll") for (int dt = 0; dt < 8; ++dt) O[dt] = __builtin_amdgcn_mfma_f32_16x16x32_bf16(*(const LAS bf16x8*)(vb_ + dt * 16 * 144), pf, O[dt], 0, 0, 0); } while (0)
#define NA_VROW(s_) do { if ((s_) < nrows) { NA_STV(s_); __syncthreads(); if ((s_) + 1 < nrows) NA_LDV((s_) + 1); \
            if (!shiftB) { if ((s_) < 8) NA_PV(s_, (s_) < 8 ? (s_) : 7); } else { if ((s_) >= 1) NA_PV(s_, (s_) >= 1 ? (s_) - 1 : 0); } } } while (0)
        __syncthreads();
        NA_VROW(0); NA_VROW(1); NA_VROW(2); NA_VROW(3); NA_VROW(4); NA_VROW(5); NA_VROW(6); NA_VROW(7); NA_VROW(8);
#undef NA_LDK
#undef NA_STK
#undef NA_LDV
#undef NA_STV
#undef NA_QK
#undef NA_SROW
#undef NA_PV
#undef NA_VROW
#pragma unroll
        for (int dt = 0; dt < 8; ++dt) { u32x2 w; w.x = cvt_pk_bf16(O[dt][0] * inv, O[dt][1] * inv); w.y = cvt_pk_bf16(O[dt][2] * inv, O[dt][3] * inv);
            *(u32x2*)(ATT + tq * DM + hh * 128 + 16 * dt + 4 * g) = w; }
    }
}

constexpr int MLP_WIF = 36864, MLP_WROW = 3088;
DI void ml_pre_phase(const bf16_t* XZ, const float* conv_w, const float* conv_b, const float* wq, const float* wk, const float* wv, const bf16_t* WTif,
                     bf16_t* XC, bf16_t* Q, bf16_t* Kb, bf16_t* V, float* pre_part, LAS unsigned char* lds, int G, int tid, int lane, int wave) {
    LAS float* Lcw = (LAS float*)lds;
    LAS float* Lcb = Lcw + 2560;
    LAS float* Lwq = Lcb + 512;
    LAS float* Lwk = Lwq + 2048;
    LAS float* Lwv = Lwk + 2048;
    LAS unsigned char* Lwif = lds + MLP_WIF;
    const int g = lane >> 4, tk = lane & 15;
    for (int item = blockIdx.x; item < 256; item += G) {
        const int hd = item & 7, tr = item >> 3;
        __syncthreads();
        for (int i = tid; i < 2560; i += NTHREADS) Lcw[i] = conv_w[(i >> 9) * 4096 + hd * 512 + (i & 511)];
        Lcb[tid] = conv_b[hd * 512 + tid];
        for (int i = tid; i < 2048; i += NTHREADS) { Lwq[i] = wq[hd * 2048 + i]; Lwk[i] = wk[hd * 2048 + i]; Lwv[i] = wv[hd * 2048 + i]; }
        for (int i = tid; i < 32 * 3 * 64; i += NTHREADS) { const int n = i / 192, rem = i - n * 192, sec = rem >> 6, c16 = rem & 63;
            *(LAS u32x4*)(Lwif + n * MLP_WROW + sec * 1024 + c16 * 16) = *(const u32x4*)(WTif + (size_t)n * 12288 + sec * 4096 + hd * 512 + c16 * 8); }
        __syncthreads();
        for (int tt = wave; tt < 16; tt += 8) {
            const int tok = tr * 256 + tt * 16 + tk, tseq = tok & 2047;
            f32x4 accp[2]; accp[0] = (f32x4){0.f, 0.f, 0.f, 0.f}; accp[1] = (f32x4){0.f, 0.f, 0.f, 0.f};
            u32x4 xrA[5], xrB[5], hq, hk, hv, hc;
#define MLP_LOAD(xr_, step_) do { const int ch_ = hd * 512 + (step_) * 32 + 8 * g; \
                _Pragma("unroll") for (int jt = 0; jt < 5; ++jt) { const int dt = jt - 2; const bool ok = (unsigned)(tseq + dt) < (unsigned)SEQ; \
                    xr_[jt] = (u32x4){0u, 0u, 0u, 0u}; if (ok) xr_[jt] = *(const u32x4*)(XZ + (size_t)(tok + dt) * 8192 + ch_); } } while (0)
#define MLP_COMPUTE(xr_, step_, HOLD_) do { \
                const int cl = (step_) * 32 + 8 * g, ch = hd * 512 + cl; \
                float a[8], xm[8]; \
                { const f32x4 b0 = *(const LAS f32x4*)(Lcb + cl), b1 = *(const LAS f32x4*)(Lcb + cl + 4); \
                  a[0] = b0.x; a[1] = b0.y; a[2] = b0.z; a[3] = b0.w; a[4] = b1.x; a[5] = b1.y; a[6] = b1.z; a[7] = b1.w; } \
                _Pragma("unroll") for (int jt = 0; jt < 5; ++jt) { \
                    const u32x4 xr = xr_[jt]; \
                    const float xv[8] = {bf_lo(xr.x), bf_hi(xr.x), bf_lo(xr.y), bf_hi(xr.y), bf_lo(xr.z), bf_hi(xr.z), bf_lo(xr.w), bf_hi(xr.w)}; \
                    const f32x4 w0 = *(const LAS f32x4*)(Lcw + jt * 512 + cl), w1 = *(const LAS f32x4*)(Lcw + jt * 512 + cl + 4); \
                    a[0] += xv[0] * w0.x; a[1] += xv[1] * w0.y; a[2] += xv[2] * w0.z; a[3] += xv[3] * w0.w; a[4] += xv[4] * w1.x; a[5] += xv[5] * w1.y; a[6] += xv[6] * w1.z; a[7] += xv[7] * w1.w; \
                    if (jt == 2) { _Pragma("unroll") for (int i = 0; i < 8; ++i) xm[i] = xv[i]; } } \
                float xc[8], q[8], k[8], v[8]; \
                _Pragma("unroll") for (int i = 0; i < 8; ++i) xc[i] = silu_f(a[i]); \
                _Pragma("unroll") for (int blk = 0; blk < 2; ++blk) { const int wo = ((cl >> 2) + blk) * 16; \
                    _Pragma("unroll") for (int o = 0; o < 4; ++o) { float sq = 0.f, sk = 0.f, sv = 0.f; \
                        _Pragma("unroll") for (int i = 0; i < 4; ++i) { sq += xc[4 * blk + i] * Lwq[wo + i * 4 + o]; sk += xc[4 * blk + i] * Lwk[wo + i * 4 + o]; sv += xm[4 * blk + i] * Lwv[wo + i * 4 + o]; } \
                        q[4 * blk + o] = sq; k[4 * blk + o] = sk; v[4 * blk + o] = sv; } } \
                u32x4 qw, kw, vw, cw; \
                qw.x = cvt_pk_bf16(q[0], q[1]); qw.y = cvt_pk_bf16(q[2], q[3]); qw.z = cvt_pk_bf16(q[4], q[5]); qw.w = cvt_pk_bf16(q[6], q[7]); \
                kw.x = cvt_pk_bf16(k[0], k[1]); kw.y = cvt_pk_bf16(k[2], k[3]); kw.z = cvt_pk_bf16(k[4], k[5]); kw.w = cvt_pk_bf16(k[6], k[7]); \
                vw.x = cvt_pk_bf16(v[0], v[1]); vw.y = cvt_pk_bf16(v[2], v[3]); vw.z = cvt_pk_bf16(v[4], v[5]); vw.w = cvt_pk_bf16(v[6], v[7]); \
                cw.x = cvt_pk_bf16(xc[0], xc[1]); cw.y = cvt_pk_bf16(xc[2], xc[3]); cw.z = cvt_pk_bf16(xc[4], xc[5]); cw.w = cvt_pk_bf16(xc[6], xc[7]); \
                const size_t o4 = (size_t)tok * 4096 + ch; \
                if (HOLD_) { hq = qw; hk = kw; hv = vw; hc = cw; }     \
                else { *(u32x4*)(Q + o4 - 32) = hq; *(u32x4*)(Q + o4) = qw; *(u32x4*)(Kb + o4 - 32) = hk; *(u32x4*)(Kb + o4) = kw; *(u32x4*)(V + o4 - 32) = hv; *(u32x4*)(V + o4) = vw; *(u32x4*)(XC + o4 - 32) = hc; *(u32x4*)(XC + o4) = cw; } \
                const bf16x8 qf = __builtin_bit_cast(bf16x8, qw), kf = __builtin_bit_cast(bf16x8, kw), vf = __builtin_bit_cast(bf16x8, vw); \
                _Pragma("unroll") for (int nt = 0; nt < 2; ++nt) { const LAS unsigned char* wp = Lwif + (nt * 16 + tk) * MLP_WROW + cl * 2; \
                    accp[nt] = __builtin_amdgcn_mfma_f32_16x16x32_bf16(qf, *(const LAS bf16x8*)(wp), accp[nt], 0, 0, 0); \
                    accp[nt] = __builtin_amdgcn_mfma_f32_16x16x32_bf16(kf, *(const LAS bf16x8*)(wp + 1024), accp[nt], 0, 0, 0); \
                    accp[nt] = __builtin_amdgcn_mfma_f32_16x16x32_bf16(vf, *(const LAS bf16x8*)(wp + 2048), accp[nt], 0, 0, 0); } } while (0)
            MLP_LOAD(xrA, 0);
#pragma unroll 1
            for (int step = 0; step < 16; step += 2) {
                MLP_LOAD(xrB, step + 1);
                MLP_COMPUTE(xrA, step, true);
                { const int sn = (step + 2 < 16) ? step + 2 : 15; MLP_LOAD(xrA, sn); }
                MLP_COMPUTE(xrB, step + 1, false);
            }
#undef MLP_LOAD
#undef MLP_COMPUTE
#pragma unroll
            for (int nt = 0; nt < 2; ++nt)
#pragma unroll
                for (int e = 0; e < 4; ++e) pre_part[((size_t)hd * 32 + nt * 16 + tk) * MTOK + tr * 256 + tt * 16 + 4 * g + e] = accp[nt][e];
        }
    }
}

constexpr int ML_QS0 = 0, ML_KS0 = 16384, ML_QS1 = 32768, ML_KS1 = 49152, ML_VS0 = 65536, ML_VS1 = 81920, ML_WV = 98304, ML_SS = 114688, ML_SM = 123904;
constexpr int ML_XS = ML_QS1, ML_XN = ML_QS1;
constexpr int GB_U = 0, GB_MR = 64, GB_W = 128, GB_INT = 192, GB_BND = 256, GB_SC = 320;
constexpr int SM_DIN0 = 768, SM_DIN1 = 832, SM_NV = 896, SM_NVP = 1408, SM_DNQP = 3456, SM_GS = 3968, SM_CMX = 4000, SM_MC = 4032, SM_END = 4096;
static_assert(ML_SM + SM_END * 4 <= LDS_BYTES - 16, "mLSTM LDS");
constexpr float KSCALE = 0.04419417382415922f;

DI s16x4 tr_read(LAS unsigned char* p) { return __builtin_amdgcn_ds_read_tr16_b64_v4i16((LAS s16x4*)p); }
DI int dimg(int row, int ch) { return 2048 * (row >> 3) + 512 * (ch >> 2) + 64 * (row & 7) + 16 * ((ch & 3) ^ ((row >> 2) & 3)); }
DI bf16x8 frag_tr(LAS unsigned char* img, int k0, int c0, int lane) {
    const int h = lane >> 5, blk = (lane >> 4) & 1, q = (lane & 15) >> 2, p = lane & 3;
    const int row = k0 + 8 * h + q, ch = (c0 >> 3) + 2 * blk + (p >> 1), sub = 8 * (p & 1);
    const s16x4 lo = tr_read(img + dimg(row, ch) + sub), hi = tr_read(img + dimg(row + 4, ch) + sub);
    return __builtin_shufflevector(lo, hi, 0, 1, 2, 3, 4, 5, 6, 7);
}
#define MFMA32(a, b, c) __builtin_amdgcn_mfma_f32_32x32x16_bf16((a), (b), (c), 0, 0, 0)
DI void tr_batch4(bf16x8 (&f)[4], unsigned alo, unsigned ahi) {
    s16x4 l0, l1, l2, l3, h0, h1, h2, h3;
    asm volatile("ds_read_b64_tr_b16 %0, %8\n\tds_read_b64_tr_b16 %4, %9\n\tds_read_b64_tr_b16 %1, %8 offset:4096\n\tds_read_b64_tr_b16 %5, %9 offset:4096\n\t"
                 "ds_read_b64_tr_b16 %2, %8 offset:8192\n\tds_read_b64_tr_b16 %6, %9 offset:8192\n\tds_read_b64_tr_b16 %3, %8 offset:12288\n\tds_read_b64_tr_b16 %7, %9 offset:12288\n\t"
                 "s_waitcnt lgkmcnt(0)"
                 : "=&v"(l0), "=&v"(l1), "=&v"(l2), "=&v"(l3), "=&v"(h0), "=&v"(h1), "=&v"(h2), "=&v"(h3) : "v"(alo), "v"(ahi) : "memory");
    f[0] = __builtin_shufflevector(l0, h0, 0, 1, 2, 3, 4, 5, 6, 7); f[1] = __builtin_shufflevector(l1, h1, 0, 1, 2, 3, 4, 5, 6, 7);
    f[2] = __builtin_shufflevector(l2, h2, 0, 1, 2, 3, 4, 5, 6, 7); f[3] = __builtin_shufflevector(l3, h3, 0, 1, 2, 3, 4, 5, 6, 7);
}

DI void tr_issue4(s16x4& l0, s16x4& l1, s16x4& l2, s16x4& l3, s16x4& h0, s16x4& h1, s16x4& h2, s16x4& h3, unsigned alo, unsigned ahi) {
    asm volatile("ds_read_b64_tr_b16 %0, %8\n\tds_read_b64_tr_b16 %4, %9\n\tds_read_b64_tr_b16 %1, %8 offset:4096\n\tds_read_b64_tr_b16 %5, %9 offset:4096\n\t"
                 "ds_read_b64_tr_b16 %2, %8 offset:8192\n\tds_read_b64_tr_b16 %6, %9 offset:8192\n\tds_read_b64_tr_b16 %3, %8 offset:12288\n\tds_read_b64_tr_b16 %7, %9 offset:12288"
                 : "=&v"(l0), "=&v"(l1), "=&v"(l2), "=&v"(l3), "=&v"(h0), "=&v"(h1), "=&v"(h2), "=&v"(h3) : "v"(alo), "v"(ahi) : "memory");
}
DI void tr_wait8(s16x4& l0, s16x4& l1, s16x4& l2, s16x4& l3, s16x4& h0, s16x4& h1, s16x4& h2, s16x4& h3) {
    asm volatile("s_waitcnt lgkmcnt(0)" : "+v"(l0), "+v"(l1), "+v"(l2), "+v"(l3), "+v"(h0), "+v"(h1), "+v"(h2), "+v"(h3) :: "memory");
}
#define TR_CAT(f, l, h) do { f[0] = __builtin_shufflevector(l##0, h##0, 0, 1, 2, 3, 4, 5, 6, 7); f[1] = __builtin_shufflevector(l##1, h##1, 0, 1, 2, 3, 4, 5, 6, 7); \
        f[2] = __builtin_shufflevector(l##2, h##2, 0, 1, 2, 3, 4, 5, 6, 7); f[3] = __builtin_shufflevector(l##3, h##3, 0, 1, 2, 3, 4, 5, 6, 7); } while (0)

template <int I>
DI void ml_step(LAS unsigned char* lds, u32x4 (&Cp)[8][2], f32x16 (&num)[2], f32x16& Sacc, float& dnq, int tid, int lane, int wave, int gb) {
    asm volatile("" : "+v"(lane)); asm volatile("" : "+v"(tid));
    constexpr int QS = (I & 1) ? ML_QS1 : ML_QS0, KS = (I & 1) ? ML_KS1 : ML_KS0;
    const int r = lane & 31, h = lane >> 5, vt = wave & 3, dpar = wave >> 2;
    LAS float* SM = (LAS float*)(lds + ML_SM);
#define ML_SEC1 { const int wS = wave & 3, st = wS >> 1, tt1 = wS & 1, kh = wave >> 2; \
      if (!(st == 1 && tt1 == 0)) { \
        _Pragma("unroll") for (int ks = 0; ks < 4; ++ks) { const int kk = 4 * kh + ks; \
            const bf16x8 a = *(const LAS bf16x8*)(lds + KS + dimg(32 * st + r, 2 * kk + h)); \
            const bf16x8 b = *(const LAS bf16x8*)(lds + QS + dimg(32 * tt1 + r, 2 * kk + h)); \
            Sacc = MFMA32(a, b, Sacc); } } }
#define ML_SEC4 { _Pragma("unroll") for (int jj = 0; jj < 2; ++jj) { const int dl = dpar + 2 * jj; \
        _Pragma("unroll") for (int s2 = 0; s2 < 2; ++s2) { const bf16x8 a = __builtin_bit_cast(bf16x8, Cp[2 * I + jj][s2]); \
            _Pragma("unroll") for (int tt = 0; tt < 2; ++tt) { LAS unsigned char* qb = lds + QS + 8 * h; \
                const s16x4 lo = *(const LAS s16x4*)(qb + dimg(32 * tt + r, 4 * dl + 2 * s2)), hi = *(const LAS s16x4*)(qb + dimg(32 * tt + r, 4 * dl + 2 * s2 + 1)); \
                num[tt] = MFMA32(a, __builtin_shufflevector(lo, hi, 0, 1, 2, 3, 4, 5, 6, 7), num[tt]); } } } }
#define ML_UPD(jj_) { _Pragma("unroll") for (int s2 = 0; s2 < 2; ++s2) { const u32x4 o = Cp[2 * I + (jj_)][s2]; u32x4 n; \
            n.x = cvt_pk_bf16(bf_lo(o.x) * decay + U[8 * s2 + 0], bf_hi(o.x) * decay + U[8 * s2 + 1]); n.y = cvt_pk_bf16(bf_lo(o.y) * decay + U[8 * s2 + 2], bf_hi(o.y) * decay + U[8 * s2 + 3]); \
            n.z = cvt_pk_bf16(bf_lo(o.z) * decay + U[8 * s2 + 4], bf_hi(o.z) * decay + U[8 * s2 + 5]); n.w = cvt_pk_bf16(bf_lo(o.w) * decay + U[8 * s2 + 6], bf_hi(o.w) * decay + U[8 * s2 + 7]); \
            asm volatile("" : "+v"(n)); Cp[2 * I + (jj_)][s2] = n; } }
#define ML_SEC5 { const float decay = SM[gb + GB_SC + 0]; \
      const int blk = (lane >> 4) & 1, q = (lane & 15) >> 2, p = lane & 3, sub = 8 * (p & 1), rlo = 8 * h + q; \
      const unsigned ldsu = (unsigned)(size_t)lds; const int chB = 4 * vt + 2 * blk + (p >> 1), chA0 = 4 * dpar + 2 * blk + (p >> 1), chA1 = chA0 + 8; \
      s16x4 bl0, bl1, bl2, bl3, bh0, bh1, bh2, bh3, al0, al1, al2, al3, ah0, ah1, ah2, ah3, cl0, cl1, cl2, cl3, ch0, ch1, ch2, ch3; \
      tr_issue4(bl0, bl1, bl2, bl3, bh0, bh1, bh2, bh3, ldsu + ML_WV + dimg(rlo, chB) + sub, ldsu + ML_WV + dimg(rlo + 4, chB) + sub); \
      tr_issue4(al0, al1, al2, al3, ah0, ah1, ah2, ah3, ldsu + KS + dimg(rlo, chA0) + sub, ldsu + KS + dimg(rlo + 4, chA0) + sub); \
      tr_wait8(al0, al1, al2, al3, ah0, ah1, ah2, ah3); tr_wait8(bl0, bl1, bl2, bl3, bh0, bh1, bh2, bh3); \
      tr_issue4(cl0, cl1, cl2, cl3, ch0, ch1, ch2, ch3, ldsu + KS + dimg(rlo, chA1) + sub, ldsu + KS + dimg(rlo + 4, chA1) + sub); \
      bf16x8 Bf[4], Af[4]; TR_CAT(Bf, bl, bh); TR_CAT(Af, al, ah); \
      f32x16 U; \
      _Pragma("unroll") for (int e = 0; e < 16; ++e) U[e] = 0.f; \
      _Pragma("unroll") for (int ks = 0; ks < 4; ++ks) U = MFMA32(Af[ks], Bf[ks], U); \
      ML_UPD(0) \
      tr_wait8(cl0, cl1, cl2, cl3, ch0, ch1, ch2, ch3); TR_CAT(Af, cl, ch); \
      _Pragma("unroll") for (int e = 0; e < 16; ++e) U[e] = 0.f; \
      _Pragma("unroll") for (int ks = 0; ks < 4; ++ks) U = MFMA32(Af[ks], Bf[ks], U); \
      ML_UPD(1) }
#define ML_SECV { { const int t = tid & 63, dg = tid >> 6; \
      const u32x4 q0 = *(const LAS u32x4*)(lds + QS + dimg(t, 2 * dg)), q1 = *(const LAS u32x4*)(lds + QS + dimg(t, 2 * dg + 1)); \
      const LAS f32x4* nv = (const LAS f32x4*)(SM + SM_NV + 128 * I + 16 * dg); \
      const f32x4 n0 = nv[0], n1 = nv[1], n2 = nv[2], n3 = nv[3]; \
      dnq += bf_lo(q0.x) * n0.x + bf_hi(q0.x) * n0.y + bf_lo(q0.y) * n0.z + bf_hi(q0.y) * n0.w + bf_lo(q0.z) * n1.x + bf_hi(q0.z) * n1.y + bf_lo(q0.w) * n1.z + bf_hi(q0.w) * n1.w \
           + bf_lo(q1.x) * n2.x + bf_hi(q1.x) * n2.y + bf_lo(q1.y) * n2.z + bf_hi(q1.y) * n2.w + bf_lo(q1.z) * n3.x + bf_hi(q1.z) * n3.y + bf_lo(q1.w) * n3.z + bf_hi(q1.w) * n3.w; } \
    { const int dp = tid & 63, sg = tid >> 6; float a0 = 0.f, a1 = 0.f; \
      const f32x4 wA = *(const LAS f32x4*)(SM + gb + GB_W + 8 * sg), wB = *(const LAS f32x4*)(SM + gb + GB_W + 8 * sg + 4); const float ww[8] = {wA.x, wA.y, wA.z, wA.w, wB.x, wB.y, wB.z, wB.w}; \
      _Pragma("unroll") for (int s = 0; s < 8; ++s) { const unsigned kk2 = *(const LAS unsigned*)(lds + KS + dimg(8 * sg + s, dp >> 2) + 4 * (dp & 3)); a0 += ww[s] * bf_lo(kk2); a1 += ww[s] * bf_hi(kk2); } \
      ((LAS unsigned*)(SM + SM_NVP))[sg * 256 + 64 * I + dp] = cvt_pk_bf16(a0, a1); } }
    ML_SEC1 ML_SEC4 ML_SEC5 ML_SECV
#undef ML_SEC1
#undef ML_SEC4
#undef ML_UPD
#undef ML_SEC5
#undef ML_SECV
}

DI float lane_read(float v, int src_lane) { return __builtin_bit_cast(float, __builtin_amdgcn_ds_bpermute(src_lane << 2, __builtin_bit_cast(int, v))); }
DI void ml_scan(float li_, float lf_, float& u_, float& cm_, float& bs_, int lane) {
    bs_ = lf_;
#pragma unroll
    for (int o_ = 1; o_ < 64; o_ <<= 1) { const float t_ = lane_read(bs_, (lane - o_) & 63); if (lane >= o_) bs_ += t_; }
    u_ = li_ - bs_; cm_ = u_;
#pragma unroll
    for (int o_ = 1; o_ < 64; o_ <<= 1) { const float t_ = lane_read(cm_, (lane - o_) & 63); if (lane >= o_) cm_ = fmaxf(cm_, t_); }
}
DI void ml_gates(LAS float* SM, float u_, float cm_, float bs_, int gbn, float m_, float cmx_, int lane) {
    const float M_ = fmaxf(m_, cm_), Ml_ = fmaxf(m_, cmx_);
    SM[gbn + GB_U + lane] = u_; SM[gbn + GB_MR + lane] = M_; SM[gbn + GB_W + lane] = __expf(u_ - Ml_) * KSCALE; SM[gbn + GB_INT + lane] = __expf(m_ - M_); SM[gbn + GB_BND + lane] = __expf(-(bs_ + M_));
    if (lane == 0) SM[gbn + GB_SC + 0] = __expf(m_ - Ml_);
}

DI void ml_dma_piece(const bf16_t* colbase, int b, int dir, int tau0, LAS unsigned char* tile, int j, int lane) {
    const int pos = lane & 31, rin = pos >> 2, row = 8 * (j >> 1) + rin, ch = 4 * (2 * (j & 1) + (lane >> 5)) + ((pos & 3) ^ ((row >> 2) & 3));
    const int tau = tau0 + row; const size_t tok = (size_t)(b * SEQ + (dir ? SEQ - 1 - tau : tau));
    __builtin_amdgcn_global_load_lds((const unsigned*)(colbase + tok * 4096 + ch * 8), (LAS unsigned*)(tile + 1024 * j), 16, 0, 0);
}

DI void mlstm_phase(const bf16_t* Q, const bf16_t* Kb, const bf16_t* V, const float* pre_part, const float* b_if, float* GLF, bf16_t* HF, bf16_t* HB,
                    LAS unsigned char* lds, int G, int vcu0, int tid0, int lane0, int wave) {
    LAS float* SM = (LAS float*)(lds + ML_SM);
    const int vt = wave & 3, dpar = wave >> 2;
    for (int item = vcu0; item < 256; item += G) {
        const int vs = item & 3, stream = item >> 2, dir = stream & 1, hd = (stream >> 1) & 7, b = stream >> 4;
        bf16_t* H = dir ? HB : HF;
        float* glf = GLF + (size_t)item * 10240;
        const bf16_t* qcol = Q + hd * 512; const bf16_t* kcol = Kb + hd * 512; const bf16_t* vcol = V + hd * 512 + vs * 128;
        __syncthreads();
        int tidp = tid0, lanep = lane0; asm volatile("" : "+v"(tidp)); asm volatile("" : "+v"(lanep));
        for (int tau = tidp; tau < SEQ; tau += NTHREADS) {
            const int tok = b * SEQ + (dir ? SEQ - 1 - tau : tau);
            float li = b_if[dir * 16 + hd], lfr = b_if[dir * 16 + 8 + hd];
#pragma unroll
            for (int h8 = 0; h8 < 8; ++h8) { const float* pp = pre_part + ((size_t)h8 * 32 + dir * 16 + hd) * MTOK + tok; li += pp[0]; lfr += pp[(size_t)8 * MTOK]; }
            glf[tau] = li; glf[2048 + tau] = fminf(lfr, 0.f) - log1pf(__expf(-fabsf(lfr)));
        }
        SM[SM_NV + tidp] = 0.f;
        ml_dma_piece(qcol, b, dir, 0, lds + ML_QS0, 2 * wave, lanep); ml_dma_piece(qcol, b, dir, 0, lds + ML_QS0, 2 * wave + 1, lanep);
        ml_dma_piece(kcol, b, dir, 0, lds + ML_KS0, 2 * wave, lanep); ml_dma_piece(kcol, b, dir, 0, lds + ML_KS0, 2 * wave + 1, lanep);
        ml_dma_piece(vcol, b, dir, 0, lds + ML_VS0, 2 * wave, lanep); ml_dma_piece(vcol, b, dir, 0, lds + ML_VS0, 2 * wave + 1, lanep);
        asm volatile("s_waitcnt vmcnt(0)" ::: "memory");
        __syncthreads();
        float u0 = 0.f, cm0 = 0.f, bs0 = 0.f;
#pragma unroll 1
        for (int cc = wave; cc < 32; cc += 8) {
            const float lic = __hip_atomic_load(glf + 64 * cc + lanep, __ATOMIC_RELAXED, __HIP_MEMORY_SCOPE_AGENT), lfc = __hip_atomic_load(glf + 2048 + 64 * cc + lanep, __ATOMIC_RELAXED, __HIP_MEMORY_SCOPE_AGENT);
            float uu, cmm, bss; ml_scan(lic, lfc, uu, cmm, bss, lanep);
            glf[4096 + 64 * cc + lanep] = uu; glf[6144 + 64 * cc + lanep] = cmm; glf[8192 + 64 * cc + lanep] = bss;
            if (lanep == 63) { SM[SM_GS + cc] = bss; SM[SM_CMX + cc] = cmm; }
            if (cc == 0) { u0 = uu; cm0 = cmm; bs0 = bss; }
        }
        asm volatile("s_waitcnt vmcnt(0)" ::: "memory");
        __syncthreads();
        if (tidp == 0) { float m = 0.f;
#pragma unroll 1
            for (int cc = 0; cc < 32; ++cc) { SM[SM_MC + cc] = m; m = SM[SM_GS + cc] + fmaxf(m, SM[SM_CMX + cc]); } }
        __syncthreads();
        if (wave == 0) ml_gates(SM, u0, cm0, bs0, 0, 0.f, SM[SM_CMX + 0], lanep);
        __syncthreads();
#define ML_WRITE_WV(VS_, gbx_) do { const float w_ = SM[(gbx_) + GB_W + lrow]; \
        _Pragma("unroll") for (int hh_ = 0; hh_ < 2; ++hh_) { const int o_ = dimg(lrow, lcc + 8 * hh_); const u32x4 x_ = *(const LAS u32x4*)(lds + (VS_) + o_); u32x4 y_; \
            y_.x = cvt_pk_bf16(bf_lo(x_.x) * w_, bf_hi(x_.x) * w_); y_.y = cvt_pk_bf16(bf_lo(x_.y) * w_, bf_hi(x_.y) * w_); y_.z = cvt_pk_bf16(bf_lo(x_.z) * w_, bf_hi(x_.z) * w_); y_.w = cvt_pk_bf16(bf_lo(x_.w) * w_, bf_hi(x_.w) * w_); \
            *(LAS u32x4*)(lds + ML_WV + o_) = y_; } } while (0)
        { const int lrow = tidp >> 3, lcc = tidp & 7; ML_WRITE_WV(ML_VS0, 0); }
        u32x4 Cp[8][2];
#pragma unroll
        for (int j = 0; j < 8; ++j) { Cp[j][0] = (u32x4){0u, 0u, 0u, 0u}; Cp[j][1] = (u32x4){0u, 0u, 0u, 0u}; }
#pragma unroll 1
        for (int c = 0; c < 32; ++c) {
            int lane = lane0, tid = tid0; asm volatile("" : "+v"(lane)); asm volatile("" : "+v"(tid));
            const int r = lane & 31, h = lane >> 5, lrow = tid >> 3, lcc = tid & 7;
            const int gb = (c & 1) * 384, gbn = 384 - gb, cn = (c + 1 < 32) ? c + 1 : 31;
            const int VSc = (c & 1) ? ML_VS1 : ML_VS0, VSn = (c & 1) ? ML_VS0 : ML_VS1;
            f32x16 num[2], Sacc; float dnq = 0.f;
#pragma unroll
            for (int e = 0; e < 16; ++e) { num[0][e] = 0.f; num[1][e] = 0.f; Sacc[e] = 0.f; }
#define ML_DMA_QK(QS_, KS_, c_, i_) do { ml_dma_piece(qcol + 128 * (i_), b, dir, 64 * (c_), lds + (QS_), 2 * wave, lane); ml_dma_piece(qcol + 128 * (i_), b, dir, 64 * (c_), lds + (QS_), 2 * wave + 1, lane); \
                ml_dma_piece(kcol + 128 * (i_), b, dir, 64 * (c_), lds + (KS_), 2 * wave, lane); ml_dma_piece(kcol + 128 * (i_), b, dir, 64 * (c_), lds + (KS_), 2 * wave + 1, lane); } while (0)
            asm volatile("s_waitcnt vmcnt(0)" ::: "memory"); __syncthreads(); ML_DMA_QK(ML_QS1, ML_KS1, c, 1);  ml_step<0>(lds, Cp, num, Sacc, dnq, tid, lane, wave, gb);
            asm volatile("s_waitcnt vmcnt(0)" ::: "memory"); __syncthreads(); ML_DMA_QK(ML_QS0, ML_KS0, c, 2);  ml_step<1>(lds, Cp, num, Sacc, dnq, tid, lane, wave, gb);
            asm volatile("s_waitcnt vmcnt(0)" ::: "memory"); __syncthreads(); ML_DMA_QK(ML_QS1, ML_KS1, c, 3);  ml_step<2>(lds, Cp, num, Sacc, dnq, tid, lane, wave, gb);
            asm volatile("s_waitcnt vmcnt(0)" ::: "memory"); __syncthreads(); ML_DMA_QK(ML_QS0, ML_KS0, cn, 0);
            ml_dma_piece(vcol, b, dir, 64 * cn, lds + VSn, 2 * wave, lane); ml_dma_piece(vcol, b, dir, 64 * cn, lds + VSn, 2 * wave + 1, lane);
            ml_step<3>(lds, Cp, num, Sacc, dnq, tid, lane, wave, gb);
            asm volatile("s_waitcnt vmcnt(0)" ::: "memory");
            __syncthreads();
            float un = 0.f, cmn = 0.f, bsn = 0.f;
            if (wave == 0) { un = __hip_atomic_load(glf + 4096 + 64 * cn + lane, __ATOMIC_RELAXED, __HIP_MEMORY_SCOPE_AGENT); cmn = __hip_atomic_load(glf + 6144 + 64 * cn + lane, __ATOMIC_RELAXED, __HIP_MEMORY_SCOPE_AGENT);
                             bsn = __hip_atomic_load(glf + 8192 + 64 * cn + lane, __ATOMIC_RELAXED, __HIP_MEMORY_SCOPE_AGENT); }
            { LAS f32x4* xs = (LAS f32x4*)(lds + ML_XS) + (size_t)((wave & 3) * 4) * 64 + lane;
              if (wave >= 4) {
#pragma unroll
                for (int gq = 0; gq < 4; ++gq) xs[gq * 64] = (f32x4){Sacc[4 * gq], Sacc[4 * gq + 1], Sacc[4 * gq + 2], Sacc[4 * gq + 3]}; } }
            SM[SM_DNQP + (tid >> 6) * 64 + (tid & 63)] = dnq;
            __syncthreads();
            if (wave < 4) {
                const int st = wave >> 1, tt1 = wave & 1, t = 32 * tt1 + r;
                const LAS f32x4* xs = (const LAS f32x4*)(lds + ML_XS) + (size_t)(wave * 4) * 64 + lane;
                const float Mt = SM[gb + GB_MR + t]; float dsum = 0.f;
#pragma unroll
                for (int gq = 0; gq < 4; ++gq) {
                    const f32x4 px = xs[gq * 64]; const int s0 = 32 * st + 8 * gq + 4 * h; const f32x4 us = *(const LAS f32x4*)(SM + gb + GB_U + s0);
                    float vv[4];
#pragma unroll
                    for (int e = 0; e < 4; ++e) { const float raw = (Sacc[4 * gq + e] + px[e]) * KSCALE; vv[e] = (s0 + e <= t) ? raw * __expf(us[e] - Mt) : 0.f; dsum += vv[e]; }
                    u32x2 w; w.x = cvt_pk_bf16(vv[0], vv[1]); w.y = cvt_pk_bf16(vv[2], vv[3]);
                    *(LAS u32x2*)(lds + ML_SS + t * 144 + s0 * 2) = w;
                }
                dsum += __shfl_xor(dsum, 32);
                if (h == 0) SM[(st ? SM_DIN1 : SM_DIN0) + t] = dsum;
            }
#pragma unroll
            for (int tt = 0; tt < 2; ++tt) { const float it = SM[gb + GB_INT + 32 * tt + r]; num[tt] = num[tt] * it; }
            __syncthreads();
#pragma unroll
            for (int k2 = 0; k2 < 2; ++k2) { const int ks = 2 * dpar + k2;
                const bf16x8 a = frag_tr(lds + VSc, 16 * ks, 32 * vt, lane);
#pragma unroll
                for (int tt = 0; tt < 2; ++tt) { const bf16x8 bb = *(const LAS bf16x8*)(lds + ML_SS + (32 * tt + r) * 144 + (16 * ks + 8 * h) * 2); num[tt] = MFMA32(a, bb, num[tt]); } }
            __syncthreads();
            { LAS f32x4* xn = (LAS f32x4*)(lds + ML_XN) + (size_t)(vt * 8) * 64 + lane;
              if (dpar == 1) {
#pragma unroll
                for (int tt = 0; tt < 2; ++tt)
#pragma unroll
                    for (int gq = 0; gq < 4; ++gq) xn[(tt * 4 + gq) * 64] = (f32x4){num[tt][4 * gq], num[tt][4 * gq + 1], num[tt][4 * gq + 2], num[tt][4 * gq + 3]}; } }
            if (wave == 0) ml_gates(SM, un, cmn, bsn, gbn, SM[SM_MC + cn], SM[SM_CMX + cn], lane);
            __syncthreads();
            if (dpar == 0) {
                const LAS f32x4* xn = (const LAS f32x4*)(lds + ML_XN) + (size_t)(vt * 8) * 64 + lane;
#pragma unroll
                for (int tt = 0; tt < 2; ++tt) { const int t = 32 * tt + r; float nq = 0.f;
#pragma unroll
                    for (int gI = 0; gI < 8; ++gI) nq += SM[SM_DNQP + gI * 64 + t];
                    const float den = SM[SM_DIN0 + t] + SM[SM_DIN1 + t] + SM[gb + GB_INT + t] * nq;
                    const float inv = 1.0f / fmaxf(fabsf(den), SM[gb + GB_BND + t]);
                    const int tau = 64 * c + t; const size_t ob = (size_t)(b * SEQ + (dir ? SEQ - 1 - tau : tau)) * 4096 + hd * 512 + vs * 128 + 32 * vt + 4 * h;
#pragma unroll
                    for (int gq = 0; gq < 4; ++gq) { const f32x4 px = xn[(tt * 4 + gq) * 64];
                        u32x2 w; w.x = cvt_pk_bf16((num[tt][4 * gq] + px.x) * inv, (num[tt][4 * gq + 1] + px.y) * inv); w.y = cvt_pk_bf16((num[tt][4 * gq + 2] + px.z) * inv, (num[tt][4 * gq + 3] + px.w) * inv);
                        *(u32x2*)(H + ob + 8 * gq) = w; } }
            }
            ML_WRITE_WV(VSn, gbn);
            { const float decay = SM[gb + GB_SC + 0];
              float acc_ = 0.f; const LAS unsigned* np_ = (const LAS unsigned*)(SM + SM_NVP) + (tid >> 1);
#pragma unroll
              for (int sgx = 0; sgx < 8; ++sgx) { const unsigned pr_ = np_[sgx * 256]; acc_ += (tid & 1) ? bf_hi(pr_) : bf_lo(pr_); }
              SM[SM_NV + tid] = decay * SM[SM_NV + tid] + acc_; }
        }
#undef ML_DMA_QK
#undef ML_WRITE_WV
    }
}

DI void ml_combine_phase(const bf16_t* HF, const bf16_t* HB, const bf16_t* XC, const bf16_t* XZ, const float* norm_g, const float* skip, unsigned char* MO, int gw, int NGW, int lane) {
    const int hd = gw & 7, ch = hd * 512 + 8 * lane;
    const f32x4 g0 = *(const f32x4*)(norm_g + ch), g1 = *(const f32x4*)(norm_g + ch + 4), k0 = *(const f32x4*)(skip + ch), k1 = *(const f32x4*)(skip + ch + 4);
    const float gg[8] = {g0.x, g0.y, g0.z, g0.w, g1.x, g1.y, g1.z, g1.w}, sk[8] = {k0.x, k0.y, k0.z, k0.w, k1.x, k1.y, k1.z, k1.w};
    for (int idx = gw; idx < MTOK * ML_HEADS; idx += NGW) {
        const int tok = idx >> 3; const size_t o4 = (size_t)tok * 4096 + ch;
        const u32x4 a = *(const u32x4*)(HF + o4), bq = *(const u32x4*)(HB + o4), xcv = *(const u32x4*)(XC + o4), zv = *(const u32x4*)(XZ + (size_t)tok * 8192 + 4096 + ch);
        float ht[8] = {bf_lo(a.x) + bf_lo(bq.x), bf_hi(a.x) + bf_hi(bq.x), bf_lo(a.y) + bf_lo(bq.y), bf_hi(a.y) + bf_hi(bq.y), bf_lo(a.z) + bf_lo(bq.z), bf_hi(a.z) + bf_hi(bq.z), bf_lo(a.w) + bf_lo(bq.w), bf_hi(a.w) + bf_hi(bq.w)};
        const float xc[8] = {bf_lo(xcv.x), bf_hi(xcv.x), bf_lo(xcv.y), bf_hi(xcv.y), bf_lo(xcv.z), bf_hi(xcv.z), bf_lo(xcv.w), bf_hi(xcv.w)};
        const float z[8] = {bf_lo(zv.x), bf_hi(zv.x), bf_lo(zv.y), bf_hi(zv.y), bf_lo(zv.z), bf_hi(zv.z), bf_lo(zv.w), bf_hi(zv.w)};
        float s = 0.f;
#pragma unroll
        for (int i = 0; i < 8; ++i) s += ht[i];
        const float mu = wave_sum(s) * (1.f / 512.f); float q = 0.f;
#pragma unroll
        for (int i = 0; i < 8; ++i) { ht[i] -= mu; q += ht[i] * ht[i]; }
        const float rstd = 1.0f / sqrtf(wave_sum(q) * (1.f / 512.f) + 1e-5f);
        float o[8];
#pragma unroll
        for (int i = 0; i < 8; ++i) o[i] = (ht[i] * rstd * gg[i] + sk[i] * xc[i]) * sigmoid_f(z[i]);
        u32x2 w; w.x = pk4_fp8(o[0] * HSCALE, o[1] * HSCALE, o[2] * HSCALE, o[3] * HSCALE); w.y = pk4_fp8(o[4] * HSCALE, o[5] * HSCALE, o[6] * HSCALE, o[7] * HSCALE);
        *(u32x2*)(MO + o4) = w;
    }
}

DI void moe_offsets(const unsigned* ecnt, int (&cnt)[8], int (&off)[8], int& ntiles) {
    int acc = 0;
#pragma unroll
    for (int e = 0; e < 8; ++e) { cnt[e] = (int)ecnt[64 * e]; off[e] = acc * 256; acc += (cnt[e] + 255) >> 8; }
    ntiles = acc;
}
DI void moe_split_plan(int ntiles, int& nMf, int& nT, int& S) {
    nMf = (ntiles >> 5) << 5; nT = ntiles - nMf; S = 1;
    if (nT > 0) { S = (nT <= 4) ? 7 : (nT <= 8) ? 4 : (nT <= 16) ? 2 : 1; }
    if (S == 1) { nMf = ntiles; nT = 0; }
}
DI pg8::TileMap moe_tilemap(const int (&cnt)[8]) { pg8::TileMap tm; int acc = 0; tm.toff[0] = 0;
#pragma unroll
    for (int e = 0; e < 8; ++e) { acc += (cnt[e] + 255) >> 8; tm.toff[e + 1] = acc; }
    return tm; }
DI void moe_scatter_phase(const unsigned char* HA, unsigned char* HS, const int* tok_e, const int* tok_pos, int* slot_row, const unsigned* ecnt, int* tile_e, int gw, int NGW, int lane) {
    int cnt[8], off[8], ntiles; moe_offsets(ecnt, cnt, off, ntiles);
    if (gw == 0 && lane < 8) { const int e = lane; const int t0 = off[e] >> 8, nt = (cnt[e] + 255) >> 8; for (int t = 0; t < nt; ++t) tile_e[t0 + t] = e; }
    for (int id = gw; id < 2 * MTOK; id += NGW) {
        const int e = tok_e[id], pos = tok_pos[id]; int o = 0;
#pragma unroll
        for (int q = 0; q < 8; ++q) o = (e == q) ? off[q] : o;
        const int row = o + pos;
        if (lane == 0) slot_row[id] = row;
        const u32x4* src = (const u32x4*)(HA + (size_t)(id >> 1) * DM) + lane; u32x4* dst = (u32x4*)(HS + (size_t)row * DM) + lane;
#pragma unroll
        for (int j = 0; j < 2; ++j) dst[64 * j] = src[64 * j];
    }
#pragma unroll 1
    for (int e = 0; e < 8; ++e) { int c = 0, o = 0;
#pragma unroll
        for (int q = 0; q < 8; ++q) { c = (e == q) ? cnt[q] : c; o = (e == q) ? off[q] : o; }
        const int pend = ((c + 255) >> 8) << 8;
        for (int p = c + gw; p < pend; p += NGW) { u32x4* dst = (u32x4*)(HS + (size_t)(o + p) * DM) + lane;
#pragma unroll
            for (int j = 0; j < 2; ++j) dst[64 * j] = (u32x4){0u, 0u, 0u, 0u}; } }
}

DI f32x4 moe_yrow(const bf16_t* YS, const bf16_t* YSP, int r, int rsplit, int S, int nrs, int lane, int j) {
    if (r < rsplit) { const u32x2 a = ((const u32x2*)(YS + (size_t)r * DM) + lane)[64 * j]; return (f32x4){bf_lo(a.x), bf_hi(a.x), bf_lo(a.y), bf_hi(a.y)}; }
    f32x4 acc = (f32x4){0.f, 0.f, 0.f, 0.f};
    for (int s2 = 0; s2 < S; ++s2) { const u32x2 a = ((const u32x2*)(YSP + ((size_t)s2 * nrs + (r - rsplit)) * DM) + lane)[64 * j]; acc += (f32x4){bf_lo(a.x), bf_hi(a.x), bf_lo(a.y), bf_hi(a.y)}; }
    return acc;
}
DI void moe_combine_phase(const bf16_t* X3, const bf16_t* YS, const int* tok_e, const int* tok_pos, const float* tok_w, const float* gate, float* out, const unsigned* ecnt, int gw, int NGW, int lane) {
    int cnt[8], off[8], ntiles; moe_offsets(ecnt, cnt, off, ntiles);
    int nMf, nT, S; moe_split_plan(ntiles, nMf, nT, S); const int rsplit = nMf * 256; const bf16_t* YSP = YS + (size_t)MPAD * DM;
    for (int tok0 = 4 * gw; tok0 < MTOK; tok0 += 4 * NGW) {
      f32x4 gt[8];
      { const f32x4* gp = (const f32x4*)(gate + (size_t)(tok0 >> 11) * 12288) + lane;
#pragma unroll
        for (int j = 0; j < 8; ++j) gt[j] = gp[64 * j]; }
#pragma unroll 1
      for (int tq = 0; tq < 4; ++tq) { const int tok = tok0 + tq;
        const int e0 = tok_e[2 * tok], e1 = tok_e[2 * tok + 1]; int o0 = 0, o1 = 0;
#pragma unroll
        for (int q = 0; q < 8; ++q) { o0 = (e0 == q) ? off[q] : o0; o1 = (e1 == q) ? off[q] : o1; }
        const int r0 = o0 + tok_pos[2 * tok], r1 = o1 + tok_pos[2 * tok + 1]; const float w0 = tok_w[2 * tok], w1 = tok_w[2 * tok + 1];
        const u32x2* x = (const u32x2*)(X3 + (size_t)tok * DM) + lane;
        f32x4* o = (f32x4*)(out + (size_t)tok * DM) + lane;
#pragma unroll
        for (int j = 0; j < 8; ++j) { const f32x4 ya = moe_yrow(YS, YSP, r0, rsplit, S, nT * 256, lane, j), yb = moe_yrow(YS, YSP, r1, rsplit, S, nT * 256, lane, j);
            const u32x2 xr = x[64 * j]; o[64 * j] = (f32x4){bf_lo(xr.x), bf_hi(xr.x), bf_lo(xr.y), bf_hi(xr.y)} + gt[j] * (ya * w0 + yb * w1); }
      }
    }
}

struct Params { const float* in[29]; float* out; unsigned char* ws; int ph_lo, ph_hi; };
static_assert(sizeof(Params) == 31 * 8 + 8, "Params has padding");
constexpr int NPHASE = 20;

#if DBG
#include "dbg_checks.inc"
#endif

__global__ void __launch_bounds__(NTHREADS, 2) mega_fwd(Params p) {
    extern __shared__ __attribute__((aligned(16))) unsigned char lds_raw[];
    LAS unsigned char* lds = (LAS unsigned char*)lds_raw;
    const int tid = threadIdx.x, lane = tid & 63, wave = __builtin_amdgcn_readfirstlane(tid >> 6);
    const int G = gridDim.x, gw = blockIdx.x * NWAVES + wave, NGW = G * NWAVES;
    const int vcu = (G % 8 == 0) ? (int)(blockIdx.x % 8) * (G / 8) + (int)(blockIdx.x / 8) : (int)blockIdx.x;
    const int gwx = vcu * NWAVES + wave;
    unsigned char* ws = p.ws;
    unsigned* ctl = (unsigned*)(ws + WS_CTL);
    volatile LAS unsigned* xbw = (volatile LAS unsigned*)(lds + LDS_BYTES - 16);
    if (tid == 0) { xbw[0] = 0u; xbw[1] = 0u; xbw[2] = 0u; xbw[3] = 0u; }
    __syncthreads();
    XcdBarrier bar = xcd_barrier_post(ctl + CW_BAR, xbw);
    const int lo = p.ph_lo, hi = p.ph_hi;
#ifndef PH_MASK
#define PH_MASK 0xFFFFFFu
#endif
#define IN(k) (((PH_MASK >> (k)) & 1u) && lo <= (k) && (k) < hi)
#define SEAM(k) do { if (IN((k) + 1)) xcd_barrier(bar); } while (0)
#ifndef REP_MASK
#define REP_MASK 0u
#endif
#define PHASE(k, ...) if (IN(k)) { { __VA_ARGS__ } if ((REP_MASK >> (k)) & 1u) { __syncthreads(); { __VA_ARGS__ } } SEAM(k); }

    float* mod = (float*)(ws + WS_MOD);
    float* pre_part = (float*)(ws + WS_PRE);
    int* tok_e = (int*)(ws + WS_ROUTE); int* tok_pos = tok_e + 2 * MTOK; float* tok_w = (float*)(tok_pos + 2 * MTOK); int* slot_row = (int*)(tok_w + 2 * MTOK);
    unsigned* ecnt = ctl + CW_ECNT; int* tile_e = (int*)(ctl + 12288);
    bf16_t* HA = (bf16_t*)(ws + WS_HA); bf16_t* X1 = (bf16_t*)(ws + WS_X1); bf16_t* X2 = (bf16_t*)(ws + WS_X2);
    bf16_t* WT_IN = (bf16_t*)(ws + WS_WT_IN); bf16_t* WT_OUT = (bf16_t*)(ws + WS_WT_OUT); bf16_t* WT_GU = (bf16_t*)(ws + WS_WT_GU); bf16_t* WT_DN = (bf16_t*)(ws + WS_WT_DN);
    bf16_t* WT_MLIN = (bf16_t*)(ws + WS_WT_MLIN); bf16_t* WT_MLOUT = (bf16_t*)(ws + WS_WT_MLOUT); bf16_t* WT_IF = (bf16_t*)(ws + WS_WT_IF);
    unsigned char* WT_MGU = ws + WS_WT_MGU; unsigned char* WT_MD = ws + WS_WT_MD;
    bf16_t* QK = (bf16_t*)(ws + A_QK); bf16_t* QKN = (bf16_t*)(ws + A_QKN); bf16_t* VT = (bf16_t*)(ws + A_VT); bf16_t* ATT = (bf16_t*)(ws + A_ATT); bf16_t* ACT = (bf16_t*)(ws + A_ACT);
    bf16_t* XZ = (bf16_t*)(ws + A_XZ); bf16_t* XC = (bf16_t*)(ws + A_XC); bf16_t* Qm = (bf16_t*)(ws + A_Q); bf16_t* Km = (bf16_t*)(ws + A_K); bf16_t* Vm = (bf16_t*)(ws + A_V);
    bf16_t* HF = (bf16_t*)(ws + A_HF); bf16_t* HB = (bf16_t*)(ws + A_HB); bf16_t* MO = (bf16_t*)(ws + A_MO);
    unsigned char* HS = ws + A_HS; unsigned char* ACTM = ws + A_ACTM; float* YS = (float*)(ws + A_YS);
    const float* x_in = p.in[0];

    PHASE(0,
        mod_phase(p.in[1], p.in[2], p.in[3], mod, lds, G, tid, lane, wave);
        LAS float* scrw = (LAS float*)lds + wave * (64 * 65);
        cvtw_job<0, false>(p.in[6] + 4096, 2048, 2048, 1, WT_IN + (size_t)4096 * 2048, 0, scrw, gw, NGW, lane, 1.f, 6144, 0);
        cvtw_job<0, true>(p.in[6], 2048, 4096, 1, (unsigned char*)ACT + (size_t)32 * 1024 * 1024, 0, scrw, gw, NGW, lane, WSCALE, 6144, 512);
        cvtw_job<0, false>(p.in[10], 2048, 2048, 1, WT_OUT, 0, scrw, gw, NGW, lane, 1.f, 0, 1536);
        cvtw_job<1, false>(p.in[11], 2048, FFN, 1, WT_GU, 0, scrw, gw, NGW, lane, 1.f, 0, 2048);
        cvtw_job<2, false>(p.in[12], 2048, FFN, 1, WT_GU, 0, scrw, gw, NGW, lane, 1.f, 0, 3456);
        cvtw_job<0, false>(p.in[13], FFN, 2048, 1, WT_DN, 0, scrw, gw, NGW, lane, 1.f, 0, 4864);
        cvtw_job<0, false>(p.in[14], 2048, 4096, 1, WT_MLIN, 0, scrw, gw, NGW, lane, 1.f, 8192, 6272);
        cvtw_job<0, true>(p.in[14] + 4096, 2048, 4096, 1, (unsigned char*)WT_MLIN + (size_t)16 * 1024 * 1024, 0, scrw, gw, NGW, lane, WSCALE, 8192, 7296);
        cvtw_job<0, true>(p.in[24], 4096, 2048, 1, (unsigned char*)WT_MLOUT, 0, scrw, gw, NGW, lane, WSCALE, 0, 8320);
        cvt_job<0>(p.in[20], 12288, 32, 1, WT_IF, 0, scrw, gw, NGW, lane);
        cvtw_job<1, true>(p.in[26], 2048, EDIM, 8, WT_MGU, (size_t)14336 * 2048, scrw, gw, NGW, lane, WSCALE, 0, 9344);
        cvtw_job<2, true>(p.in[27], 2048, EDIM, 8, WT_MGU, (size_t)14336 * 2048, scrw, gw, NGW, lane, WSCALE, 0, 9344 + 14336);
        cvtw_job<0, true>(p.in[28], EDIM, 2048, 8, WT_MD, (size_t)2048 * EDIM, scrw, gw, NGW, lane, WSCALE, 0, 9344 + 2 * 14336); )
    PHASE(1,  rms_mod_phase<false, true>(x_in, p.in[4], mod + 1 * 2048, mod + 0 * 2048, HA, nullptr, nullptr, nullptr, nullptr, nullptr, (unsigned char*)ACT, gw, NGW, lane); )
    PHASE(2,
        { pg8::Gemm g{(const unsigned char*)ACT, (const unsigned char*)ACT + (size_t)32 * 1024 * 1024, MTOK, 4096, 2048, 0}; pg8::StaticOrder S; S.init(MTOK, 4096, G, (int)blockIdx.x); pg8::EpiQKNorm E{QKN, 4096, p.in[7], p.in[8], 1.0f / (HSCALE * WSCALE)}; pg8::gemm_phase<pg8::EpiQKNorm, pg8::StaticOrder, true>(lds, g, S, E); }
        { pg8::Gemm g{WT_IN + (size_t)4096 * 2048, HA, 2048, MTOK, 2048, 0}; pg8::StaticOrder S; S.init(2048, MTOK, G, (int)blockIdx.x); pg8::EpiBf16 E{VT, MTOK}; pg8::gemm_phase(lds, g, S, E); } )
    PHASE(4,  na_phase(QKN, VT, ATT, p.in[9], lds, G, vcu, tid, lane, wave); )
    PHASE(5,  pg8::Gemm g{ATT, WT_OUT, MTOK, 2048, 2048, 0}; pg8::StaticOrder S; S.init(MTOK, 2048, G, (int)blockIdx.x); pg8::EpiResGate16<false> E{x_in, X1, DM, mod + 2 * 2048, 12288}; pg8::gemm_phase(lds, g, S, E); )
    PHASE(6,  rms_mod_phase<false, false, true>(X1, p.in[5], mod + 4 * 2048, mod + 3 * 2048, HA, nullptr, nullptr, nullptr, nullptr, nullptr, nullptr, gw, NGW, lane); )
    PHASE(7,  pg8::Gemm g{HA, WT_GU, MTOK, 2 * FFN, 2048, 0}; pg8::StaticOrder S; S.init(MTOK, 2 * FFN, G, (int)blockIdx.x); pg8::EpiSwiGLU E{ACT, FFN}; pg8::gemm_phase(lds, g, S, E); )
    PHASE(8,  pg8::Gemm g{ACT, WT_DN, MTOK, 2048, FFN, 0}; pg8::StaticOrder S; S.init(MTOK, 2048, G, (int)blockIdx.x); pg8::EpiResGate16<true> E{X1, X2, DM, mod + 5 * 2048, 12288}; pg8::gemm_phase(lds, g, S, E); )
    PHASE(9,  rms_mod_phase<false, true, true>(X2, p.in[4] + DM, mod + 4 * 12288 + 1 * 2048, mod + 4 * 12288 + 0 * 2048, HA, nullptr, nullptr, nullptr, nullptr, nullptr, (unsigned char*)MO, gw, NGW, lane); )
    PHASE(10,
        { pg8::Gemm g{HA, WT_MLIN, MTOK, 4096, 2048, 0}; pg8::StaticOrder S; S.init(MTOK, 4096, G, (int)blockIdx.x); pg8::EpiBf16 E{XZ, 8192}; pg8::gemm_phase(lds, g, S, E); }
        { pg8::Gemm g{(const unsigned char*)MO, (const unsigned char*)WT_MLIN + (size_t)16 * 1024 * 1024, MTOK, 4096, 2048, 0}; pg8::StaticOrder S; S.init(MTOK, 4096, G, (int)blockIdx.x);
          pg8::EpiBf16S E{XZ + 4096, 8192, 1.0f / (HSCALE * WSCALE), 0}; pg8::gemm_phase<pg8::EpiBf16S, pg8::StaticOrder, true>(lds, g, S, E); } )
    PHASE(11,  ml_pre_phase(XZ, p.in[15], p.in[16], p.in[17], p.in[18], p.in[19], WT_IF, XC, Qm, Km, Vm, pre_part, lds, G, tid, lane, wave); )
    PHASE(12,  mlstm_phase(Qm, Km, Vm, pre_part, p.in[21], (float*)(ws + WS_GLF), HF, HB, lds, G, vcu, tid, lane, wave); )
    PHASE(13,  ml_combine_phase(HF, HB, XC, XZ, p.in[23], p.in[22], (unsigned char*)MO, gw, NGW, lane); )
    PHASE(14,  pg8::Gemm g{MO, WT_MLOUT, MTOK, 2048, 4096, 0}; pg8::StaticOrder S; S.init(MTOK, 2048, G, (int)blockIdx.x); pg8::EpiResGate16<true> E{X2, X1, DM, mod + 4 * 12288 + 2 * 2048, 12288, 1.0f / (HSCALE * WSCALE)}; pg8::gemm_phase<pg8::EpiResGate16<true>, pg8::StaticOrder, true>(lds, g, S, E); )
    PHASE(15,  rms_mod_phase<true, false, true>(X1, p.in[5] + DM, mod + 4 * 12288 + 4 * 2048, mod + 4 * 12288 + 3 * 2048, HA, p.in[25], tok_e, tok_pos, tok_w, ecnt, HS, gw, NGW, lane, (LAS float*)lds, tid); )
    PHASE(17,  int cnt[8], off[8], ntiles; moe_offsets(ecnt, cnt, off, ntiles);
        pg8::Gemm g{HS, WT_MGU, ntiles * 256, 2 * EDIM, 2048, 0}; pg8::MoeOrder S; S.init(ntiles, 2 * EDIM, G, (int)blockIdx.x, moe_tilemap(cnt), (size_t)14336 * 2048, (size_t)DM);
        pg8::EpiSwiGLU8 E{ACTM, EDIM, 1.0f / (HSCALE * WSCALE), ASCALE}; pg8::gemm_phase<pg8::EpiSwiGLU8, pg8::MoeOrder, true>(lds, g, S, E); )
    PHASE(18,  int cnt[8], off[8], ntiles; moe_offsets(ecnt, cnt, off, ntiles);
        pg8::Gemm g{ACTM, WT_MD, ntiles * 256, 2048, EDIM, 0};
        int nMf, nT, SS; moe_split_plan(ntiles, nMf, nT, SS); bf16_t* YSP = (bf16_t*)YS + (size_t)MPAD * DM;
        { pg8::MoeRowOrder S1; S1.init(nMf, G, (int)blockIdx.x, moe_tilemap(cnt), (size_t)2048 * EDIM); pg8::EpiBf16S E{(bf16_t*)YS, DM, 1.0f / (ASCALE * WSCALE), 0}; pg8::gemm_phase<pg8::EpiBf16S, pg8::MoeRowOrder, true>(lds, g, S1, E); }
        if (nT > 0) { pg8::Gemm g2 = g; g2.ntk = 56 / SS; pg8::MoeSplitOrder S2; S2.init(nMf, nT, SS, (size_t)(EDIM / SS), (int)blockIdx.x, moe_tilemap(cnt), (size_t)2048 * EDIM);
            pg8::EpiBf16S E2{YSP - (size_t)nMf * 256 * DM, DM, 1.0f / (ASCALE * WSCALE), (size_t)nT * 256 * DM}; pg8::gemm_phase<pg8::EpiBf16S, pg8::MoeSplitOrder, true>(lds, g2, S2, E2); } )
    PHASE(19,  moe_combine_phase(X1, (const bf16_t*)YS, tok_e, tok_pos, tok_w, mod + 4 * 12288 + 5 * 2048, p.out, ecnt, gw, NGW, lane); )
#undef IN
#undef SEAM
#undef PHASE
}

extern "C" void kernel_launch(void* const* d_in, const int* in_sizes, int n_in, void* d_out, int out_size, void* d_ws, size_t ws_size, hipStream_t stream) {
    static int grid = 0;
    if (grid == 0) {
        if (n_in != 29 || out_size != MTOK * DM || ws_size < WS_END) { fprintf(stderr, "kernel_launch: unexpected shapes (n_in %d out %d ws %zu need %zu)\n", n_in, out_size, ws_size, (size_t)WS_END); grid = -1; return; }
        int dev = 0, cus = 0, per_cu = 0;
        if (hipGetDevice(&dev) != hipSuccess || hipDeviceGetAttribute(&cus, hipDeviceAttributeMultiprocessorCount, dev) != hipSuccess) { grid = -1; return; }
        if (hipFuncSetAttribute((const void*)mega_fwd, hipFuncAttributeMaxDynamicSharedMemorySize, LDS_BYTES) != hipSuccess) { fprintf(stderr, "kernel_launch: hipFuncSetAttribute failed\n"); grid = -1; return; }
        if (hipOccupancyMaxActiveBlocksPerMultiprocessor(&per_cu, (const void*)mega_fwd, NTHREADS, LDS_BYTES) != hipSuccess || per_cu < 1) { fprintf(stderr, "kernel_launch: occupancy query says %d\n", per_cu); (void)hipGetLastError(); per_cu = 1; }
        grid = cus;
    }
    if (grid < 0) return;
    (void)hipMemsetAsync((char*)d_ws + WS_CTL, 0, CTL_BYTES, stream);
    Params p{};
    for (int i = 0; i < 29; ++i) p.in[i] = (const float*)d_in[i];
    p.out = (float*)d_out; p.ws = (unsigned char*)d_ws;
#if N_LAUNCH_SPLIT
    for (int k = 0; k < NPHASE; ++k) { p.ph_lo = k; p.ph_hi = k + 1; hipLaunchKernelGGL(mega_fwd, dim3(grid), dim3(NTHREADS), LDS_BYTES, stream, p); }
#else
    p.ph_lo = 0; p.ph_hi = NPHASE;
    hipLaunchKernelGGL(mega_fwd, dim3(grid), dim3(NTHREADS), LDS_BYTES, stream, p);
#endif
}
```

```cpp
#ifndef GEMM_SCH
#define GEMM_SCH 1
#endif
#include <hip/hip_runtime.h>
#include <cstdio>
#include <cstdint>

#ifndef DBG
#define DBG 0
#endif
#ifndef N_LAUNCH_SPLIT
#define N_LAUNCH_SPLIT 0
#endif

#define LAS __attribute__((address_space(3)))
#define GAS __attribute__((address_space(1)))
#define DI __device__ __forceinline__
typedef unsigned short bf16_t;
typedef short bf16x8 __attribute__((ext_vector_type(8)));
typedef short s16x4 __attribute__((ext_vector_type(4)));
typedef float f32x2 __attribute__((ext_vector_type(2)));
typedef float f32x4 __attribute__((ext_vector_type(4)));
typedef float f32x16 __attribute__((ext_vector_type(16)));
typedef unsigned u32x2 __attribute__((ext_vector_type(2)));
typedef unsigned u32x4 __attribute__((ext_vector_type(4)));
typedef int i32x4 __attribute__((ext_vector_type(4)));
typedef int i32x8 __attribute__((ext_vector_type(8)));

constexpr int BATCH = 4, SEQ = 2048, DM = 2048, MTOK = BATCH * SEQ;
constexpr int GRID_W = 64, NA_HEADS = 16, NA_HD = 128;
constexpr int ML_INNER = 4096, ML_HEADS = 8, ML_HD = 512;
constexpr int FFN = 5632, NEXP = 8, EDIM = 7168;
constexpr int MPAD = 2 * MTOK + NEXP * 256;
constexpr int NTHREADS = 512, NWAVES = 8;
constexpr int LDS_BYTES = 147456;

constexpr size_t al256(size_t x) { return (x + 255) & ~(size_t)255; }
constexpr size_t WS_CTL = 0;
constexpr size_t CTL_BYTES = 65536;
constexpr size_t WS_MOD = WS_CTL + CTL_BYTES;
constexpr size_t WS_PRE = WS_MOD + al256((size_t)2 * 4 * 12288 * 4);
constexpr size_t WS_ROUTE = WS_PRE + (size_t)8 * MTOK * 32 * 4;
constexpr size_t WS_GLF = WS_ROUTE + (size_t)4 * MTOK * 2 * 4;
constexpr size_t WS_HA = WS_GLF + (size_t)256 * 10240 * 4;
constexpr size_t WS_X1 = WS_HA + (size_t)MTOK * DM * 2;
constexpr size_t WS_X2 = WS_X1 + (size_t)MTOK * DM * 4;
constexpr size_t WS_WT_IN = WS_X2 + (size_t)MTOK * DM * 4;
constexpr size_t WS_WT_OUT = WS_WT_IN + (size_t)6144 * 2048 * 2;
constexpr size_t WS_WT_GU = WS_WT_OUT + (size_t)2048 * 2048 * 2;
constexpr size_t WS_WT_DN = WS_WT_GU + (size_t)11264 * 2048 * 2;
constexpr size_t WS_WT_MLIN = WS_WT_DN + (size_t)2048 * 5632 * 2;
constexpr size_t WS_WT_MLOUT = WS_WT_MLIN + (size_t)8192 * 2048 * 2;
constexpr size_t WS_WT_IF = WS_WT_MLOUT + (size_t)2048 * 4096 * 2;
constexpr size_t WS_WT_MGU = WS_WT_IF + (size_t)32 * 12288 * 2;
constexpr size_t WS_WT_MD = WS_WT_MGU + (size_t)8 * 14336 * 2048;
constexpr size_t WS_ARENA = WS_WT_MD + (size_t)8 * 2048 * 7168;
constexpr size_t A_QK = WS_ARENA;
constexpr size_t A_QKN = A_QK + (size_t)MTOK * 4096 * 2;
constexpr size_t A_VT = A_QKN + (size_t)MTOK * 4096 * 2;
constexpr size_t A_ATT = A_VT + (size_t)2048 * MTOK * 2;
constexpr size_t A_ACT = A_ATT + (size_t)MTOK * DM * 2;
constexpr size_t A_L0_END = A_ACT + (size_t)MTOK * FFN * 2;
constexpr size_t A_XZ = WS_ARENA;
constexpr size_t A_XC = A_XZ + (size_t)MTOK * 8192 * 2;
constexpr size_t A_Q = A_XC + (size_t)MTOK * 4096 * 2;
constexpr size_t A_K = A_Q + (size_t)MTOK * 4096 * 2;
constexpr size_t A_V = A_K + (size_t)MTOK * 4096 * 2;
constexpr size_t A_HF = A_V + (size_t)MTOK * 4096 * 2;
constexpr size_t A_HB = A_HF + (size_t)MTOK * 4096 * 2;
constexpr size_t A_MO = A_HB + (size_t)MTOK * 4096 * 2;
constexpr size_t A_L1_END = A_MO + (size_t)MTOK * 4096 * 2;
constexpr size_t A_HS = WS_ARENA;
constexpr size_t A_ACTM = A_HS + (size_t)8 * 8192 * DM;
constexpr size_t A_YS = A_ACTM + (size_t)MPAD * EDIM;
constexpr size_t A_L2_END = A_YS + (size_t)MPAD * DM * 4;
constexpr size_t cmax(size_t a, size_t b) { return a > b ? a : b; }
constexpr size_t WS_END = cmax(cmax(A_L0_END, A_L1_END), A_L2_END);

constexpr int CW_BAR = 0;
constexpr int CW_ECNT = 4096;
constexpr int CW_DBG = 8192;

typedef __bf16 bf16x2_t __attribute__((ext_vector_type(2)));
DI unsigned cvt_pk_bf16(float lo, float hi) { const f32x2 v = {lo, hi}; return __builtin_bit_cast(unsigned, __builtin_convertvector(v, bf16x2_t)); }
DI float clamp448(float x) { return __builtin_fminf(__builtin_fmaxf(x, -448.f), 448.f); }
DI unsigned pk4_fp8(float a, float b, float c, float d) {
    int p = 0; p = __builtin_amdgcn_cvt_pk_fp8_f32(clamp448(a), clamp448(b), p, false); p = __builtin_amdgcn_cvt_pk_fp8_f32(clamp448(c), clamp448(d), p, true); return (unsigned)p; }
DI float bf_lo(unsigned u) { return __uint_as_float(u << 16); }
DI float bf_hi(unsigned u) { return __uint_as_float(u & 0xffff0000u); }
DI float bf2f(bf16_t b) { return __uint_as_float(((unsigned)b) << 16); }
DI bf16_t f2bf(float f) { return (bf16_t)(cvt_pk_bf16(f, 0.f) & 0xffffu); }
DI float wave_sum(float v) {
#pragma unroll
    for (int o = 1; o < 64; o <<= 1) v += __shfl_xor(v, o);
    return v;
}
DI float wave_max(float v) {
#pragma unroll
    for (int o = 1; o < 64; o <<= 1) v = fmaxf(v, __shfl_xor(v, o));
    return v;
}
DI float silu_f(float x) { return x * __builtin_amdgcn_rcpf(1.f + __expf(-x)); }
DI float sigmoid_f(float x) { return __builtin_amdgcn_rcpf(1.f + __expf(-x)); }
#define LDS_WAIT() asm volatile("s_waitcnt lgkmcnt(0)" ::: "memory")
#define VM_WAIT() asm volatile("s_waitcnt vmcnt(0)" ::: "memory")

#define XB_TMO      128
#define XB_XCNT(j)  (256  + 64 * (j))
#define XB_XSUB(j)  (1280 + 64 * (j))
#define XB_XGEN(j)  (2304 + 64 * (j))
#define XB_TOP      3328
#define XB_TOPGEN   3392
#define XCD_BAR_WORDS 3456
#define XB_SPIN_CAP (1u << 22)

__device__ __forceinline__ unsigned xb_ld(unsigned* p)              { return __hip_atomic_load(p, __ATOMIC_RELAXED, __HIP_MEMORY_SCOPE_AGENT); }
__device__ __forceinline__ unsigned xb_add(unsigned* p, unsigned v) { return __hip_atomic_fetch_add(p, v, __ATOMIC_RELAXED, __HIP_MEMORY_SCOPE_AGENT); }
__device__ __forceinline__ unsigned xb_xcc_id() { return (unsigned)__builtin_amdgcn_s_getreg((3 << 11) | 20) & 0xFu; }
#define XB_SPIN(cond, bar) do { unsigned _sp = 0; while (cond) { __builtin_amdgcn_s_sleep(1); \
    if ((++_sp & 255u) == 0u) { if (xb_ld(&(bar)[XB_TMO])) break; if (_sp > XB_SPIN_CAP) { atomicAdd(&(bar)[XB_TMO], 1u); break; } } } } while (0)

struct XcdBarrier { unsigned* bar; unsigned x; volatile LAS unsigned* st; };

__device__ __forceinline__ XcdBarrier xcd_barrier_post(unsigned* bar, volatile LAS unsigned* st) {
    XcdBarrier b; b.bar = bar; b.x = xb_xcc_id(); b.st = st;
    if (threadIdx.x == 0) (void)xb_add(&bar[XB_XCNT(b.x)], 1u);
    return b;
}
__device__ __forceinline__ void xcd_barrier_complete(unsigned* bar, unsigned x, unsigned& nloc, unsigned& nx) {
    const unsigned G = gridDim.x * gridDim.y * gridDim.z;
    unsigned sum, cnt, mine, sp = 0u;
    for (;;) {
        sum = 0u; cnt = 0u; mine = 0u;
#pragma unroll
        for (unsigned j = 0; j < 16; ++j) { const unsigned c = xb_ld(&bar[XB_XCNT(j)]); sum += c; cnt += (c > 0u) ? 1u : 0u; mine = (j == x) ? c : mine; }
        if (sum == G) break;
        __builtin_amdgcn_s_sleep(1);
        if ((++sp & 255u) == 0u) { if (xb_ld(&bar[XB_TMO])) break; if (sp > XB_SPIN_CAP) { atomicAdd(&bar[XB_TMO], 1u); break; } }
    }
    nloc = mine > 0u ? mine : 1u; nx = cnt > 0u ? cnt : 1u;
}
__device__ __forceinline__ void xcd_barrier(const XcdBarrier& b) {
    asm volatile("s_waitcnt vmcnt(0)" ::: "memory");
    __syncthreads();
    if (threadIdx.x == 0) {
        unsigned* bar = b.bar;
        __builtin_amdgcn_s_waitcnt(0);
        unsigned nloc = b.st[0], nx = b.st[1];
        if (nloc == 0u) { xcd_barrier_complete(bar, b.x, nloc, nx); b.st[0] = nloc; b.st[1] = nx; }
        const unsigned old = xb_add(&bar[XB_XSUB(b.x)], 1u);
        const unsigned gen = old / nloc;
        if (old + 1u == (gen + 1u) * nloc) {
            __builtin_amdgcn_fence(__ATOMIC_RELEASE, "agent");
            asm volatile("s_waitcnt vmcnt(0)" ::: "memory");
            const unsigned og = xb_add(&bar[XB_TOP], 1u);
            const unsigned tg = og / nx;
            if (og + 1u == (tg + 1u) * nx) xb_add(&bar[XB_TOPGEN], 1u);
            else XB_SPIN(xb_ld(&bar[XB_TOPGEN]) == tg, bar);
            __builtin_amdgcn_fence(__ATOMIC_ACQUIRE, "agent");
            xb_add(&bar[XB_XGEN(b.x)], 1u);
            asm volatile("s_waitcnt vmcnt(0)" ::: "memory");
        } else {
            XB_SPIN(xb_ld(&bar[XB_XGEN(b.x)]) == gen, bar);
            __builtin_amdgcn_fence(__ATOMIC_ACQUIRE, "agent");
            asm volatile("s_waitcnt vmcnt(0)" ::: "memory");
        }
    }
    __syncthreads();
}

namespace pg8 {
constexpr int BM = 256, BK = 64, HALF = 128, HTB = HALF * BK * 2, STAGE_BYTES = 8 * HTB, NXCD = 8, WGM = 8;
__host__ __device__ __forceinline__ int lds_byte(int r, int c) { const int st = (r >> 4) * 2 + (c >> 5), rr = r & 15, cc = c & 31, ob = rr * 64 + cc * 2; return st * 1024 + (ob ^ (((ob >> 9) & 1) << 5)); }
__host__ __device__ __forceinline__ void stage_rc(int b, int& R, int& C) { const int st = b / 1024, sb = b % 1024, swz = sb ^ (((sb >> 9) & 1) << 5); R = (st >> 1) * 16 + swz / 64; C = (st & 1) * 32 + (swz % 64) / 2; }
__host__ __device__ __forceinline__ int perm32(int rho) { const int n = rho >> 4, i = rho & 15; return 8 * (i >> 2) + 4 * n + (i & 3); }

struct Unit { int pm, pn; size_t boff; size_t aoff; int slice; };
struct Gemm { const void* A; const void* Bt; int M, N, K; int ntk; };

struct StaticOrder {
    int nM, nN, nwg, G, c;
    __device__ void init(int M, int N, int G_, int c_) { nM = M / BM; nN = N / BM; nwg = nM * nN; G = G_; c = c_; }
    __device__ bool next(int i, Unit& u) const {
        const long L = (long)i * G + c; if (L >= nwg) return false;
        int wgid = (int)L; { const int q = nwg / NXCD, r = nwg % NXCD, xcd = wgid % NXCD, off = wgid / NXCD; wgid = (xcd < r ? xcd * (q + 1) : r * (q + 1) + (xcd - r) * q) + off; }
        const int nig = WGM * nN, gid = wgid / nig, fm = gid * WGM, gsz = (nM - fm) < WGM ? (nM - fm) : WGM;
        u.pm = fm + ((wgid % nig) % gsz); u.pn = (wgid % nig) / gsz; u.boff = 0; u.aoff = 0; u.slice = 0; return true;
    }
};
struct TileMap {
    int toff[9];
    __device__ __forceinline__ void lookup(int pm, int& e, int& k) const {
        e = (pm >= toff[1]) + (pm >= toff[2]) + (pm >= toff[3]) + (pm >= toff[4]) + (pm >= toff[5]) + (pm >= toff[6]) + (pm >= toff[7]);
        int t0 = 0;
#pragma unroll
        for (int q = 1; q < 8; ++q) t0 = (e == q) ? toff[q] : t0;
        k = pm - t0;
    }
};
constexpr int ECAP = 8192;
struct MoeOrder {
    int nM, nN, nwg, G, c; TileMap tm; size_t estride; size_t arowb;
    __device__ void init(int nM_, int N, int G_, int c_, const TileMap& tm_, size_t es, size_t arowb_) { nM = nM_; nN = N / BM; nwg = nM * nN; G = G_; c = c_; tm = tm_; estride = es; arowb = arowb_; }
    __device__ bool next(int i, Unit& u) const {
        const long L = (long)i * G + c; if (L >= nwg) return false;
        int wgid = (int)L; { const int q = nwg / NXCD, r = nwg % NXCD, xcd = wgid % NXCD, off = wgid / NXCD; wgid = (xcd < r ? xcd * (q + 1) : r * (q + 1) + (xcd - r) * q) + off; }
        const int nig = WGM * nN, gid = wgid / nig, fm = gid * WGM, gsz = (nM - fm) < WGM ? (nM - fm) : WGM;
        u.pm = fm + ((wgid % nig) % gsz); u.pn = (wgid % nig) / gsz; int e, k; tm.lookup(u.pm, e, k); u.boff = (size_t)e * estride;
        u.aoff = (size_t)((long)(e * ECAP + 256 * k - 256 * u.pm) * (long)arowb); u.slice = 0; return true;
    }
};

struct MoeRowOrder {
    int nwg, G, c; TileMap tm; size_t estride;
    __device__ void init(int nMf, int G_, int c_, const TileMap& tm_, size_t es) { nwg = nMf * 8; G = G_; c = c_; tm = tm_; estride = es; }
    __device__ bool next(int i, Unit& u) const {
        const long L = (long)i * G + c; if (L >= nwg) return false;
        u.pm = (int)(L >> 3); u.pn = (int)(L & 7); int e, k; tm.lookup(u.pm, e, k); u.boff = (size_t)e * estride; u.aoff = 0; u.slice = 0; return true;
    }
};
struct MoeSplitOrder {
    int pm0, nq, S, c; size_t kslice; TileMap tm; size_t estride;
    __device__ void init(int pm0_, int nT, int S_, size_t ks, int c_, const TileMap& tm_, size_t es) { pm0 = pm0_; S = S_; nq = nT * 8 * S_; kslice = ks; c = c_; tm = tm_; estride = es; }
    __device__ bool next(int i, Unit& u) const {
        if (i != 0 || c >= nq) return false;
        const int un = c / S; u.slice = c - un * S; u.pm = pm0 + (un >> 3); u.pn = un & 7; u.aoff = (size_t)u.slice * kslice; int e, k; tm.lookup(u.pm, e, k); u.boff = (size_t)e * estride + u.aoff; return true;
    }
};
struct EpiBf16 {
    static constexpr bool PERM = true, XBAR = false;
    bf16_t* O; int ldc;
    __device__ __forceinline__ void operator()(const f32x4 (&acc)[2][2][4][2], const Unit& u, int wr, int wc, int fr, int fq) const {
        const int row0 = u.pm * BM + wr * 64 + fr, col0 = u.pn * BM + wc * 32 + 8 * fq;
#pragma unroll
        for (int ai = 0; ai < 2; ++ai)
#pragma unroll
            for (int m = 0; m < 4; ++m) { bf16_t* rowp = O + (size_t)(row0 + ai * HALF + m * 16) * ldc + col0;
#pragma unroll
                for (int bj = 0; bj < 2; ++bj) { const f32x4 v0 = acc[ai][bj][m][0], v1 = acc[ai][bj][m][1];
                    u32x4 w; w.x = cvt_pk_bf16(v0[0], v0[1]); w.y = cvt_pk_bf16(v0[2], v0[3]); w.z = cvt_pk_bf16(v1[0], v1[1]); w.w = cvt_pk_bf16(v1[2], v1[3]);
                    *(u32x4*)(rowp + bj * HALF) = w; } }
    }
};
struct EpiQKNorm {
    static constexpr bool PERM = true, XBAR = true;
    bf16_t* O; int ldc; const float* qg; const float* kg; float sc;
    __device__ __forceinline__ void pre(const f32x4 (&acc)[2][2][4][2], int wr, int wc, int fr, int fq, LAS float* P) const {
#pragma unroll
        for (int ai = 0; ai < 2; ++ai)
#pragma unroll
            for (int m = 0; m < 4; ++m)
#pragma unroll
                for (int bj = 0; bj < 2; ++bj) { const f32x4 a = acc[ai][bj][m][0], b = acc[ai][bj][m][1];
                    float ss = (a[0] * a[0] + a[1] * a[1]) + (a[2] * a[2] + a[3] * a[3]) + (b[0] * b[0] + b[1] * b[1]) + (b[2] * b[2] + b[3] * b[3]);
                    ss += __shfl_xor(ss, 16); ss += __shfl_xor(ss, 32);
                    if (fq == 0) P[((ai * HALF + wr * 64 + m * 16 + fr) * 2 + bj) * 4 + wc] = ss * sc * sc; }
    }
    __device__ __forceinline__ void post(const f32x4 (&acc)[2][2][4][2], const Unit& u, int wr, int wc, int fr, int fq, const LAS float* P) const {
        const int row0 = u.pm * BM + wr * 64 + fr, col0 = u.pn * BM + wc * 32 + 8 * fq;
        f32x4 g0[2], g1[2]; float hs[2];
#pragma unroll
        for (int bj = 0; bj < 2; ++bj) { const int head = 2 * u.pn + bj; const float* gp = (head < 16 ? qg : kg) + wc * 32 + 8 * fq; g0[bj] = *(const f32x4*)gp; g1[bj] = *(const f32x4*)(gp + 4); hs[bj] = head < 16 ? 0.08838834764831845f : 1.0f; }
#pragma unroll
        for (int ai = 0; ai < 2; ++ai)
#pragma unroll
            for (int m = 0; m < 4; ++m) { bf16_t* rowp = O + (size_t)(row0 + ai * HALF + m * 16) * ldc + col0;
#pragma unroll
                for (int bj = 0; bj < 2; ++bj) { const f32x4 ps = *(const LAS f32x4*)(P + ((ai * HALF + wr * 64 + m * 16 + fr) * 2 + bj) * 4);
                    const float rstd = hs[bj] / sqrtf(((ps[0] + ps[1]) + (ps[2] + ps[3])) * (1.f / 128.f) + 1e-6f);
                    const f32x4 v0 = acc[ai][bj][m][0] * g0[bj] * (rstd * sc), v1 = acc[ai][bj][m][1] * g1[bj] * (rstd * sc);
                    u32x4 w; w.x = cvt_pk_bf16(v0[0], v0[1]); w.y = cvt_pk_bf16(v0[2], v0[3]); w.z = cvt_pk_bf16(v1[0], v1[1]); w.w = cvt_pk_bf16(v1[2], v1[3]);
                    *(u32x4*)(rowp + bj * HALF) = w; } }
    }
};
struct EpiBf16S {
    static constexpr bool PERM = true, XBAR = false;
    bf16_t* O; int ldc; float sc; size_t sstride;
    __device__ __forceinline__ void operator()(const f32x4 (&acc)[2][2][4][2], const Unit& u, int wr, int wc, int fr, int fq) const {
        const int row0 = u.pm * BM + wr * 64 + fr, col0 = u.pn * BM + wc * 32 + 8 * fq;
        bf16_t* Os = O + (size_t)u.slice * sstride;
#pragma unroll
        for (int ai = 0; ai < 2; ++ai)
#pragma unroll
            for (int m = 0; m < 4; ++m) { bf16_t* rowp = Os + (size_t)(row0 + ai * HALF + m * 16) * ldc + col0;
#pragma unroll
                for (int bj = 0; bj < 2; ++bj) { const f32x4 v0 = acc[ai][bj][m][0] * sc, v1 = acc[ai][bj][m][1] * sc;
                    u32x4 w; w.x = cvt_pk_bf16(v0[0], v0[1]); w.y = cvt_pk_bf16(v0[2], v0[3]); w.z = cvt_pk_bf16(v1[0], v1[1]); w.w = cvt_pk_bf16(v1[2], v1[3]);
                    *(u32x4*)(rowp + bj * HALF) = w; } }
    }
};
struct EpiSwiGLU {
    static constexpr bool PERM = true, XBAR = false;
    bf16_t* O; int ldc;
    __device__ __forceinline__ void operator()(const f32x4 (&acc)[2][2][4][2], const Unit& u, int wr, int wc, int fr, int fq) const {
        const int row0 = u.pm * BM + wr * 64 + fr, col0 = u.pn * HALF + wc * 32 + 8 * fq;
#pragma unroll
        for (int ai = 0; ai < 2; ++ai)
#pragma unroll
            for (int m = 0; m < 4; ++m) { bf16_t* rowp = O + (size_t)(row0 + ai * HALF + m * 16) * ldc + col0;
                float o[8];
#pragma unroll
                for (int n = 0; n < 2; ++n)
#pragma unroll
                    for (int j = 0; j < 4; ++j) { const float g = acc[ai][0][m][n][j], up = acc[ai][1][m][n][j]; o[n * 4 + j] = g * __builtin_amdgcn_rcpf(1.f + __expf(-g)) * up; }
                u32x4 w; w.x = cvt_pk_bf16(o[0], o[1]); w.y = cvt_pk_bf16(o[2], o[3]); w.z = cvt_pk_bf16(o[4], o[5]); w.w = cvt_pk_bf16(o[6], o[7]);
                *(u32x4*)rowp = w; }
    }
};
struct EpiSwiGLU8 {
    static constexpr bool PERM = true, XBAR = false;
    unsigned char* O; int ldc; float isc, osc;
    __device__ __forceinline__ void operator()(const f32x4 (&acc)[2][2][4][2], const Unit& u, int wr, int wc, int fr, int fq) const {
        const int row0 = u.pm * BM + wr * 64 + fr, col0 = u.pn * HALF + wc * 32 + 8 * fq;
#pragma unroll
        for (int ai = 0; ai < 2; ++ai)
#pragma unroll
            for (int m = 0; m < 4; ++m) { unsigned char* rowp = O + (size_t)(row0 + ai * HALF + m * 16) * ldc + col0;
                float o[8];
#pragma unroll
                for (int n = 0; n < 2; ++n)
#pragma unroll
                    for (int j = 0; j < 4; ++j) { const float g = acc[ai][0][m][n][j] * isc, up = acc[ai][1][m][n][j] * isc; o[n * 4 + j] = g * __builtin_amdgcn_rcpf(1.f + __expf(-g)) * up * osc; }
                u32x2 w; w.x = pk4_fp8(o[0], o[1], o[2], o[3]); w.y = pk4_fp8(o[4], o[5], o[6], o[7]);
                *(u32x2*)rowp = w; }
    }
};
struct EpiResGate {
    static constexpr bool PERM = false, XBAR = false;
    const float* base; float* out; int ldc; const float* gate; int gstride;
    __device__ __forceinline__ void operator()(const f32x4 (&acc)[2][2][4][2], const Unit& u, int wr, int wc, int fr, int fq) const {
        const int row0 = u.pm * BM + wr * 64 + fr, col0 = u.pn * BM + wc * 32 + 4 * fq;
        const float* gp = gate + (size_t)((u.pm * BM) >> 11) * gstride + col0;
        f32x4 gv[2][2];
#pragma unroll
        for (int bj = 0; bj < 2; ++bj)
#pragma unroll
            for (int n = 0; n < 2; ++n) gv[bj][n] = *(const f32x4*)(gp + bj * HALF + n * 16);
#pragma unroll
        for (int ai = 0; ai < 2; ++ai)
#pragma unroll
            for (int m = 0; m < 4; ++m) { const size_t off = (size_t)(row0 + ai * HALF + m * 16) * ldc + col0;
#pragma unroll
                for (int bj = 0; bj < 2; ++bj)
#pragma unroll
                    for (int n = 0; n < 2; ++n) { const f32x4 bs = *(const f32x4*)(base + off + bj * HALF + n * 16);
                        *(f32x4*)(out + off + bj * HALF + n * 16) = bs + gv[bj][n] * acc[ai][bj][m][n]; }
                asm volatile("" ::: "memory"); }
    }
};
template <bool BASE16>
struct EpiResGate16 {
    static constexpr bool PERM = true, XBAR = false;
    const void* base; bf16_t* out; int ldc; const float* gate; int gstride; float sc = 1.0f;
    __device__ __forceinline__ void operator()(const f32x4 (&acc)[2][2][4][2], const Unit& u, int wr, int wc, int fr, int fq) const {
        const int row0 = u.pm * BM + wr * 64 + fr, col0 = u.pn * BM + wc * 32 + 8 * fq;
        const float* gp = gate + (size_t)((u.pm * BM) >> 11) * gstride + col0;
        f32x4 gv[2][2];
#pragma unroll
        for (int bj = 0; bj < 2; ++bj)
#pragma unroll
            for (int n = 0; n < 2; ++n) gv[bj][n] = *(const f32x4*)(gp + bj * HALF + 4 * n) * sc;
#pragma unroll
        for (int ai = 0; ai < 2; ++ai)
#pragma unroll
            for (int m = 0; m < 4; ++m) { const size_t off = (size_t)(row0 + ai * HALF + m * 16) * ldc + col0;
#pragma unroll
                for (int bj = 0; bj < 2; ++bj) { f32x4 b0, b1;
                    if (BASE16) { const u32x4 r = *(const u32x4*)((const bf16_t*)base + off + bj * HALF);
                        b0 = (f32x4){__uint_as_float(r.x << 16), __uint_as_float(r.x & 0xffff0000u), __uint_as_float(r.y << 16), __uint_as_float(r.y & 0xffff0000u)};
                        b1 = (f32x4){__uint_as_float(r.z << 16), __uint_as_float(r.z & 0xffff0000u), __uint_as_float(r.w << 16), __uint_as_float(r.w & 0xffff0000u)}; }
                    else { b0 = *(const f32x4*)((const float*)base + off + bj * HALF); b1 = *(const f32x4*)((const float*)base + off + bj * HALF + 4); }
                    const f32x4 v0 = b0 + gv[bj][0] * acc[ai][bj][m][0], v1 = b1 + gv[bj][1] * acc[ai][bj][m][1];
                    u32x4 w; w.x = cvt_pk_bf16(v0[0], v0[1]); w.y = cvt_pk_bf16(v0[2], v0[3]); w.z = cvt_pk_bf16(v1[0], v1[1]); w.w = cvt_pk_bf16(v1[2], v1[3]);
                    *(u32x4*)(out + off + bj * HALF) = w; }
                asm volatile("" ::: "memory"); }
    }
};
struct EpiF32 {
    static constexpr bool PERM = false, XBAR = false;
    float* C; int ldc; float sc;
    __device__ __forceinline__ void operator()(const f32x4 (&acc)[2][2][4][2], const Unit& u, int wr, int wc, int fr, int fq) const {
        const int row0 = u.pm * BM + wr * 64 + fr, col0 = u.pn * BM + wc * 32 + 4 * fq;
#pragma unroll
        for (int ai = 0; ai < 2; ++ai)
#pragma unroll
            for (int m = 0; m < 4; ++m) { float* rowp = C + (size_t)(row0 + ai * HALF + m * 16) * ldc + col0;
#pragma unroll
                for (int bj = 0; bj < 2; ++bj)
#pragma unroll
                    for (int n = 0; n < 2; ++n) *(f32x4*)(rowp + bj * HALF + n * 16) = acc[ai][bj][m][n] * sc; }
    }
};

template <class Epi, class Sched, bool F8 = false, int HOT = 0, int SCH = GEMM_SCH>
__device__ __forceinline__ void gemm_phase(LAS unsigned char* lds, const Gemm g, const Sched& S, const Epi& E) {
    int tid = threadIdx.x; asm volatile("" : "+v"(tid));
    const int wid = __builtin_amdgcn_readfirstlane(tid >> 6), lane = tid & 63, wr = wid >> 2, wc = wid & 3, fr = lane & 15, fq = lane >> 4;
    const int rowb = F8 ? g.K : 2 * g.K, nt = g.ntk ? g.ntk : rowb / (BK * 2);
    unsigned voffA[2], voffB[2];
#pragma unroll
    for (int i = 0; i < 2; ++i) { int R, C; stage_rc(tid * 16 + i * 8192, R, C); const int Rb = Epi::PERM ? ((R & ~31) + perm32(R & 31)) : R;
        voffA[i] = (unsigned)(R * rowb + C * 2); voffB[i] = (unsigned)(Rb * rowb + C * 2); }
    const size_t kstep = (size_t)(BK * 2);
    const size_t hstep = (size_t)HALF * rowb;
    const size_t tstep = 2 * hstep;
    const unsigned ldsw = (unsigned)wid * 1024u;
    const int aoff = lds_byte(wr * 64 + fr, fq * 8), boff = lds_byte(wc * 32 + fr, fq * 8);
#define PG8_SA(b, h) (((b) * 2 + (h)) * HTB)
#define PG8_SB(b, h) ((4 + (b) * 2 + (h)) * HTB)
#define PG8_STAGE(bufoff, gbase, voff) do { _Pragma("unroll") for (int _i = 0; _i < 2; ++_i) \
        __builtin_amdgcn_global_load_lds((const unsigned*)((const char*)(gbase) + (voff)[_i]), (LAS unsigned*)(lds + (bufoff) + ldsw + _i * 8192), 16, 0, 0); } while (0)
#define PG8_LD8(base_) __builtin_shufflevector(*(const LAS i32x4*)(base_), *(const LAS i32x4*)((base_) + 1024), 0, 1, 2, 3, 4, 5, 6, 7)
#define PG8_LDA(dst, b, h) do { _Pragma("unroll") for (int m = 0; m < 4; ++m) { if constexpr (F8) dst##8[m] = PG8_LD8(lds + PG8_SA(b, h) + aoff + m * 2048); \
        else { _Pragma("unroll") for (int k = 0; k < 2; ++k) dst[m][k] = *(const LAS bf16x8*)(lds + PG8_SA(b, h) + aoff + m * 2048 + k * 1024); } } } while (0)
#define PG8_LDB(dst, b, h) do { _Pragma("unroll") for (int n = 0; n < 2; ++n) { if constexpr (F8) dst##8[n] = PG8_LD8(lds + PG8_SB(b, h) + boff + n * 2048); \
        else { _Pragma("unroll") for (int k = 0; k < 2; ++k) dst[n][k] = *(const LAS bf16x8*)(lds + PG8_SB(b, h) + boff + n * 2048 + k * 1024); } } } while (0)
#define PG8_MMA(ai, bj, At, Bt) do { __builtin_amdgcn_s_setprio(1); _Pragma("unroll") for (int m = 0; m < 4; ++m) _Pragma("unroll") for (int n = 0; n < 2; ++n) { \
        if constexpr (F8) { asm volatile("v_mfma_f32_16x16x128_f8f6f4 %0, %1, %2, %0" : "+v"(acc[ai][bj][m][n]) : "v"(Bt##8[n]), "v"(At##8[m])); } \
        else { _Pragma("unroll") for (int k = 0; k < 2; ++k) acc[ai][bj][m][n] = __builtin_amdgcn_mfma_f32_16x16x32_bf16(Bt[n][k], At[m][k], acc[ai][bj][m][n], 0, 0, 0); } } \
        __builtin_amdgcn_s_setprio(0); } while (0)
#define PG8_WAIT_V(n) asm volatile("s_waitcnt vmcnt(" #n ")" ::: "memory")
#define PG8_WAIT_L(n) asm volatile("s_waitcnt lgkmcnt(" #n ")" ::: "memory")
#define PG8_BAR __builtin_amdgcn_s_barrier()
#define PG8_SCHED __builtin_amdgcn_sched_barrier(0)
    Unit cur, nxt; int ui = 0;
    if (!S.next(0, cur)) return;
    f32x4 acc[2][2][4][2];
#pragma unroll
    for (int a = 0; a < 2; ++a)
#pragma unroll
        for (int b = 0; b < 2; ++b)
#pragma unroll
            for (int m = 0; m < 4; ++m)
#pragma unroll
                for (int n = 0; n < 2; ++n) acc[a][b][m][n] = (f32x4){0.f, 0.f, 0.f, 0.f};
    bf16x8 At[4][2], B0[2][2], B1[2][2]; i32x8 At8[4], B08[2], B18[2];
    const char* cA = (const char*)g.A + cur.aoff + (size_t)(HOT ? 0 : cur.pm) * tstep; const char* cB = (const char*)g.Bt + cur.boff + (size_t)(HOT ? 0 : cur.pn) * tstep;
    if constexpr (SCH == 1) {
        PG8_STAGE(PG8_SB(0, 0), cB, voffB); PG8_STAGE(PG8_SB(0, 1), cB + hstep, voffB); PG8_STAGE(PG8_SA(0, 0), cA, voffA); PG8_STAGE(PG8_SA(0, 1), cA + hstep, voffA);
        if (wr == 1) PG8_BAR;
        PG8_WAIT_V(2); PG8_BAR;
        PG8_STAGE(PG8_SB(1, 0), cB + kstep, voffB); PG8_STAGE(PG8_SB(1, 1), cB + hstep + kstep, voffB); PG8_STAGE(PG8_SA(1, 0), cA + kstep, voffA);
        PG8_WAIT_V(6); PG8_BAR;
    } else {
    PG8_STAGE(PG8_SB(0, 0), cB, voffB); PG8_STAGE(PG8_SA(0, 0), cA, voffA); PG8_STAGE(PG8_SB(0, 1), cB + hstep, voffB); PG8_STAGE(PG8_SA(0, 1), cA + hstep, voffA);
    if (wr == 1) PG8_BAR;
    PG8_WAIT_V(4); PG8_BAR;
    PG8_STAGE(PG8_SB(1, 0), cB + kstep, voffB); PG8_STAGE(PG8_SA(1, 0), cA + kstep, voffA); PG8_STAGE(PG8_SB(1, 1), cB + hstep + kstep, voffB);
    PG8_WAIT_V(6); PG8_BAR;
    }
    for (;;) {
        const bool has_next = S.next(ui + 1, nxt);
        const char* nA = has_next ? (const char*)g.A + nxt.aoff + (size_t)(HOT ? 0 : nxt.pm) * tstep : cA; const char* nB = has_next ? (const char*)g.Bt + nxt.boff + (size_t)(HOT ? 0 : nxt.pn) * tstep : cB;
        for (int t = 0; t < nt; t += 2) {
            const bool last = (t == nt - 2);
            const char* a1 = cA + (size_t)(t + 1) * kstep;
            const char* a2 = last ? nA : cA + (size_t)(t + 2) * kstep; const char* b2 = last ? nB : cB + (size_t)(t + 2) * kstep;
            const char* a3 = a2 + kstep; const char* b3 = b2 + kstep;
            if constexpr (SCH == 1) {
                PG8_LDB(B0, 0, 0); PG8_LDB(B1, 0, 1); PG8_SCHED; PG8_LDA(At, 0, 0); PG8_STAGE(PG8_SA(1, 1), a1 + hstep, voffA);
                PG8_WAIT_V(8); PG8_WAIT_L(0); PG8_BAR; PG8_MMA(0, 0, At, B0); PG8_MMA(0, 1, At, B1); PG8_BAR; PG8_SCHED;
                PG8_LDA(At, 0, 1); PG8_STAGE(PG8_SB(0, 0), b2, voffB); PG8_STAGE(PG8_SB(0, 1), b2 + hstep, voffB); PG8_STAGE(PG8_SA(0, 0), a2, voffA);
                PG8_WAIT_V(8); PG8_WAIT_L(0); PG8_BAR; PG8_MMA(1, 0, At, B0); PG8_MMA(1, 1, At, B1); PG8_BAR; PG8_SCHED;
                PG8_LDB(B0, 1, 0); PG8_LDB(B1, 1, 1); PG8_SCHED; PG8_LDA(At, 1, 0); PG8_STAGE(PG8_SA(0, 1), a2 + hstep, voffA);
                PG8_WAIT_V(8); PG8_WAIT_L(0); PG8_BAR; PG8_MMA(0, 0, At, B0); PG8_MMA(0, 1, At, B1); PG8_BAR; PG8_SCHED;
                PG8_LDA(At, 1, 1); PG8_STAGE(PG8_SB(1, 0), b3, voffB); PG8_STAGE(PG8_SB(1, 1), b3 + hstep, voffB); PG8_STAGE(PG8_SA(1, 0), a3, voffA);
                PG8_WAIT_V(8); PG8_WAIT_L(0); PG8_BAR; PG8_MMA(1, 0, At, B0); PG8_MMA(1, 1, At, B1); PG8_BAR; PG8_SCHED;
                continue;
            }
            PG8_LDB(B0, 0, 0); PG8_SCHED; PG8_LDA(At, 0, 0); PG8_STAGE(PG8_SA(1, 1), a1 + hstep, voffA);
            PG8_WAIT_L(8); PG8_BAR; PG8_WAIT_L(0); PG8_MMA(0, 0, At, B0); PG8_BAR; PG8_SCHED;
            PG8_LDB(B1, 0, 1); PG8_STAGE(PG8_SB(0, 0), b2, voffB);
            PG8_BAR; PG8_WAIT_L(0); PG8_MMA(0, 1, At, B1); PG8_BAR;
            PG8_LDA(At, 0, 1); PG8_STAGE(PG8_SA(0, 0), a2, voffA);
            PG8_BAR; PG8_WAIT_L(0); PG8_MMA(1, 0, At, B0); PG8_BAR; PG8_SCHED;
            PG8_STAGE(PG8_SB(0, 1), b2 + hstep, voffB);
            PG8_WAIT_V(6); PG8_BAR; PG8_MMA(1, 1, At, B1); PG8_BAR;
            PG8_LDB(B0, 1, 0); PG8_SCHED; PG8_LDA(At, 1, 0); PG8_STAGE(PG8_SA(0, 1), a2 + hstep, voffA);
            PG8_WAIT_L(8); PG8_BAR; PG8_WAIT_L(0); PG8_MMA(0, 0, At, B0); PG8_BAR; PG8_SCHED;
            PG8_LDB(B1, 1, 1); PG8_STAGE(PG8_SB(1, 0), b3, voffB);
            PG8_BAR; PG8_WAIT_L(0); PG8_MMA(0, 1, At, B1); PG8_BAR;
            PG8_LDA(At, 1, 1); PG8_STAGE(PG8_SA(1, 0), a3, voffA);
            PG8_BAR; PG8_WAIT_L(0); PG8_MMA(1, 0, At, B0); PG8_BAR; PG8_SCHED;
            PG8_STAGE(PG8_SB(1, 1), b3 + hstep, voffB);
            PG8_WAIT_V(6); PG8_BAR; PG8_MMA(1, 1, At, B1); PG8_BAR;
        }
        if constexpr (F8) asm volatile("s_nop 15\n\ts_nop 15" ::: "memory");
        if constexpr (Epi::XBAR) { LAS float* P_ = (LAS float*)(lds + STAGE_BYTES); E.pre(acc, wr, wc, fr, fq, P_); PG8_WAIT_L(0); PG8_BAR; asm volatile("" ::: "memory"); E.post(acc, cur, wr, wc, fr, fq, P_); }
        else E(acc, cur, wr, wc, fr, fq);
        if (!has_next) break;
#pragma unroll
        for (int a = 0; a < 2; ++a)
#pragma unroll
            for (int b = 0; b < 2; ++b)
#pragma unroll
                for (int m = 0; m < 4; ++m)
#pragma unroll
                    for (int n = 0; n < 2; ++n) acc[a][b][m][n] = (f32x4){0.f, 0.f, 0.f, 0.f};
        cur = nxt; cA = nA; cB = nB; ++ui;
    }
    PG8_WAIT_V(0);
    if (wr == 0) PG8_BAR;
    PG8_BAR;
#undef PG8_SA
#undef PG8_SB
#undef PG8_STAGE
#undef PG8_LDA
#undef PG8_LDB
#undef PG8_MMA
#undef PG8_WAIT_V
#undef PG8_WAIT_L
#undef PG8_BAR
#undef PG8_SCHED
}
}

DI void mod_phase(const float* c, const float* mod_w, const float* mod_b, float* mod, LAS unsigned char* lds, int G, int tid, int lane, int wave) {
    LAS f32x4* cact = (LAS f32x4*)lds;
    LAS float* red = (LAS float*)(lds + 32768);
    for (int k = tid; k < DM; k += NTHREADS) { f32x4 v; v.x = silu_f(c[k]); v.y = silu_f(c[DM + k]); v.z = silu_f(c[2 * DM + k]); v.w = silu_f(c[3 * DM + k]); cact[k] = v; }
    __syncthreads();
    for (int it = blockIdx.x; it < 256; it += G) {
        const int l = it >> 7, n0 = (it & 127) * 96;
        float a0[4] = {0.f, 0.f, 0.f, 0.f}, a1[4] = {0.f, 0.f, 0.f, 0.f};
        if (lane < 48) {
            const float* wp = mod_w + ((size_t)l * DM + wave * 256) * 12288 + n0 + 2 * lane;
#pragma unroll 8
            for (int k = 0; k < 256; ++k) { const f32x2 w = *(const f32x2*)(wp + (size_t)k * 12288); const f32x4 cv = cact[wave * 256 + k];
                a0[0] += cv.x * w.x; a1[0] += cv.x * w.y; a0[1] += cv.y * w.x; a1[1] += cv.y * w.y; a0[2] += cv.z * w.x; a1[2] += cv.z * w.y; a0[3] += cv.w * w.x; a1[3] += cv.w * w.y; }
#pragma unroll
            for (int b = 0; b < 4; ++b) { red[(wave * 4 + b) * 96 + 2 * lane] = a0[b]; red[(wave * 4 + b) * 96 + 2 * lane + 1] = a1[b]; }
        }
        __syncthreads();
        if (tid < 384) { const int b = tid / 96, col = tid % 96; float s = mod_b[l * 12288 + n0 + col];
#pragma unroll
            for (int w = 0; w < 8; ++w) s += red[(w * 4 + b) * 96 + col];
            mod[((size_t)l * 4 + b) * 12288 + n0 + col] = s; }
        __syncthreads();
    }
}

template <int MODE>
DI void cvt_item(const float* W, int K, int N, bf16_t* WT, LAS float* scr, int kb, int nb, int lane) {
    const int k0 = 64 * kb, n0 = 32 * nb;
    float v[32];
    const float* wp = W + (size_t)(k0 + (lane >> 5)) * N + n0 + (lane & 31);
#pragma unroll
    for (int i = 0; i < 32; ++i) v[i] = wp[(size_t)(2 * i) * N];
#pragma unroll
    for (int i = 0; i < 32; ++i) scr[(2 * i + (lane >> 5)) * 33 + (lane & 31)] = v[i];
    LDS_WAIT();
    const int c = lane & 7;
#pragma unroll
    for (int j = 0; j < 4; ++j) { const int n = (lane >> 3) + 8 * j; const LAS float* s = scr + (8 * c) * 33 + n;
        u32x4 o; o.x = cvt_pk_bf16(s[0 * 33], s[1 * 33]); o.y = cvt_pk_bf16(s[2 * 33], s[3 * 33]); o.z = cvt_pk_bf16(s[4 * 33], s[5 * 33]); o.w = cvt_pk_bf16(s[6 * 33], s[7 * 33]);
        const int ng = n0 + n; const int row = (MODE == 0) ? ng : ((ng >> 7) * 256 + (ng & 127) + (MODE == 2 ? 128 : 0));
        *(u32x4*)(WT + (size_t)row * K + k0 + 8 * c) = o; }
    LDS_WAIT();
}
template <int MODE>
DI void cvt_item8(const float* W, int K, int N, unsigned char* WT, LAS float* scr, int kb, int nb, int lane, float wsc) {
    const int k0 = 64 * kb, n0 = 32 * nb;
    float v[32];
    const float* wp = W + (size_t)(k0 + (lane >> 5)) * N + n0 + (lane & 31);
#pragma unroll
    for (int i = 0; i < 32; ++i) v[i] = wp[(size_t)(2 * i) * N];
#pragma unroll
    for (int i = 0; i < 32; ++i) scr[(2 * i + (lane >> 5)) * 33 + (lane & 31)] = v[i] * wsc;
    LDS_WAIT();
    const int c = lane & 3;
#pragma unroll
    for (int j = 0; j < 2; ++j) { const int n = (lane >> 2) + 16 * j; const LAS float* s = scr + (16 * c) * 33 + n;
        u32x4 o; o.x = pk4_fp8(s[0 * 33], s[1 * 33], s[2 * 33], s[3 * 33]); o.y = pk4_fp8(s[4 * 33], s[5 * 33], s[6 * 33], s[7 * 33]);
        o.z = pk4_fp8(s[8 * 33], s[9 * 33], s[10 * 33], s[11 * 33]); o.w = pk4_fp8(s[12 * 33], s[13 * 33], s[14 * 33], s[15 * 33]);
        const int ng = n0 + n; const int row = (MODE == 0) ? ng : ((ng >> 7) * 256 + (ng & 127) + (MODE == 2 ? 128 : 0));
        *(u32x4*)(WT + (size_t)row * K + k0 + 16 * c) = o; }
    LDS_WAIT();
}
template <int MODE>
DI void cvt_job8(const float* W, int K, int N, int nbatch, unsigned char* WT, size_t dst_bstride, LAS float* scr, int gw, int NGW, int lane, float wsc) {
    const int nnb = N / 32, per = (K / 64) * nnb, total = per * nbatch;
    for (int it = gw; it < total; it += NGW) {
        const int bt = it / per, r = it - bt * per, kb = r / nnb, nb = r - kb * nnb;
        cvt_item8<MODE>(W + (size_t)bt * K * N, K, N, WT + (size_t)bt * dst_bstride, scr, kb, nb, lane, wsc);
    }
}
template <int MODE>
DI void cvt_job(const float* W, int K, int N, int nbatch, bf16_t* WT, size_t dst_bstride, LAS float* scr, int gw, int NGW, int lane) {
    const int nnb = N / 32, per = (K / 64) * nnb, total = per * nbatch;
    for (int it = gw; it < total; it += NGW) {
        const int bt = it / per, r = it - bt * per, kb = r / nnb, nb = r - kb * nnb;
        cvt_item<MODE>(W + (size_t)bt * K * N, K, N, WT + (size_t)bt * dst_bstride, scr, kb, nb, lane);
    }
}

DI void cvtw_load(f32x4 (&v)[16], const float* wp, int N) {
#pragma unroll
    for (int i = 0; i < 16; ++i) v[i] = __builtin_nontemporal_load((const f32x4*)(wp + (size_t)(4 * i) * N));
}
template <int MODE, bool OUT8>
DI void cvtw_store(const f32x4 (&v)[16], int K, void* WTb, LAS float* scr, int k0, int n0, int lane, float wsc) {
    const int kr = lane >> 4, n4 = lane & 15;
#pragma unroll
    for (int i = 0; i < 16; ++i)
#pragma unroll
        for (int e = 0; e < 4; ++e) scr[(4 * n4 + e) * 65 + 4 * i + kr] = OUT8 ? v[i][e] * wsc : v[i][e];
    LDS_WAIT();
    if (OUT8) {
        unsigned char* WT = (unsigned char*)WTb; const int c = lane & 3;
#pragma unroll
        for (int j = 0; j < 4; ++j) { const int n = (lane >> 2) + 16 * j; const LAS float* s = scr + n * 65 + 16 * c;
            u32x4 o; o.x = pk4_fp8(s[0], s[1], s[2], s[3]); o.y = pk4_fp8(s[4], s[5], s[6], s[7]); o.z = pk4_fp8(s[8], s[9], s[10], s[11]); o.w = pk4_fp8(s[12], s[13], s[14], s[15]);
            const int ng = n0 + n; const int row = (MODE == 0) ? ng : ((ng >> 7) * 256 + (ng & 127) + (MODE == 2 ? 128 : 0));
            *(u32x4*)(WT + (size_t)row * K + k0 + 16 * c) = o; }
    } else {
        bf16_t* WT = (bf16_t*)WTb; const int c = lane & 7;
#pragma unroll
        for (int j = 0; j < 8; ++j) { const int n = (lane >> 3) + 8 * j; const LAS float* s = scr + n * 65 + 8 * c;
            u32x4 o; o.x = cvt_pk_bf16(s[0], s[1]); o.y = cvt_pk_bf16(s[2], s[3]); o.z = cvt_pk_bf16(s[4], s[5]); o.w = cvt_pk_bf16(s[6], s[7]);
            const int ng = n0 + n; const int row = (MODE == 0) ? ng : ((ng >> 7) * 256 + (ng & 127) + (MODE == 2 ? 128 : 0));
            *(u32x4*)(WT + (size_t)row * K + k0 + 8 * c) = o; }
    }
    LDS_WAIT();
}
DI void cvtw_pack8(const f32x4 (&v)[16], LAS float* scr, int lane, float wsc, u32x4 (&o)[4]) {
    const int kr = lane >> 4, n4 = lane & 15;
#pragma unroll
    for (int i = 0; i < 16; ++i)
#pragma unroll
        for (int e = 0; e < 4; ++e) scr[(4 * n4 + e) * 65 + 4 * i + kr] = v[i][e] * wsc;
    LDS_WAIT();
    const int c = lane & 3;
#pragma unroll
    for (int j = 0; j < 4; ++j) { const int n = (lane >> 2) + 16 * j; const LAS float* s = scr + n * 65 + 16 * c;
        o[j].x = pk4_fp8(s[0], s[1], s[2], s[3]); o[j].y = pk4_fp8(s[4], s[5], s[6], s[7]); o[j].z = pk4_fp8(s[8], s[9], s[10], s[11]); o[j].w = pk4_fp8(s[12], s[13], s[14], s[15]); }
    LDS_WAIT();
}
template <int MODE, bool OUT8>
DI void cvtw_job(const float* W, int K, int N, int nbatch, void* WT, size_t dst_bstride_bytes, LAS float* scr, int gw, int NGW, int lane, float wsc, int ld = 0, int off = 0) {
    const int nnb = N / 64, per = (K / 128) * nnb, total = per * nbatch;
    const int pitch = ld ? ld : N;
    const int first = (gw + NGW - (off % NGW)) % NGW;
    if (first >= total) return;
#define CVTW_SRC(it_) ({ const int bt_ = (it_) / per, r_ = (it_) - bt_ * per, kb_ = r_ / nnb, nb_ = r_ - kb_ * nnb; W + (size_t)bt_ * K * pitch + (size_t)(128 * kb_ + (lane >> 4)) * pitch + 64 * nb_ + 4 * (lane & 15); })
    for (int it = first; it < total; it += NGW) {
        const int bt = it / per, r = it - bt * per, kb = r / nnb, nb = r - kb * nnb, k0 = 128 * kb, n0 = 64 * nb;
        f32x4 v0[16], v1[16];
        { const float* wp = CVTW_SRC(it); cvtw_load(v0, wp, pitch); cvtw_load(v1, wp + (size_t)64 * pitch, pitch); }
        void* WTb = (unsigned char*)WT + (size_t)bt * dst_bstride_bytes;
        if (OUT8) {
            u32x4 o0[4], o1[4];
            cvtw_pack8(v0, scr, lane, wsc, o0);
            cvtw_pack8(v1, scr, lane, wsc, o1);
            unsigned char* WT8 = (unsigned char*)WTb; const int c = lane & 3;
#pragma unroll
            for (int j = 0; j < 4; ++j) { const int ng = n0 + (lane >> 2) + 16 * j; const int row = (MODE == 0) ? ng : ((ng >> 7) * 256 + (ng & 127) + (MODE == 2 ? 128 : 0));
                unsigned char* dp = WT8 + (size_t)row * K + k0 + 16 * c; *(u32x4*)dp = o0[j]; *(u32x4*)(dp + 64) = o1[j]; }
        } else {
            cvtw_store<MODE, OUT8>(v0, K, WTb, scr, k0, n0, lane, wsc);
            cvtw_store<MODE, OUT8>(v1, K, WTb, scr, k0 + 64, n0, lane, wsc);
        }
    }
#undef CVTW_SRC
}

constexpr float HSCALE = 8.f, WSCALE = 256.f, ASCALE = 8.f;
template <bool ROUTER, bool OUT8 = false, bool X16 = false>
DI void rms_mod_phase(const void* X, const float* g, const float* scale, const float* shift, bf16_t* out,
                      const float* router, int* tok_e, int* tok_pos, float* tok_w, unsigned* ecnt, unsigned char* HS2, int gw, int NGW, int lane, LAS float* rl = nullptr, int tid = 0) {
    if (ROUTER) {
        for (int c = tid; c < DM; c += NTHREADS) { const f32x4 r0 = ((const f32x4*)router)[2 * c], r1 = ((const f32x4*)router)[2 * c + 1];
            rl[c] = r0.x; rl[DM + c] = r0.y; rl[2 * DM + c] = r0.z; rl[3 * DM + c] = r0.w; rl[4 * DM + c] = r1.x; rl[5 * DM + c] = r1.y; rl[6 * DM + c] = r1.z; rl[7 * DM + c] = r1.w; }
        __syncthreads();
    }
    for (int row0 = 4 * gw; row0 < MTOK; row0 += 4 * NGW) {
        const int b = row0 >> 11;
        const f32x4* gp = (const f32x4*)g + lane; const f32x4* sc = (const f32x4*)(scale + (size_t)b * 12288) + lane; const f32x4* sh = (const f32x4*)(shift + (size_t)b * 12288) + lane;
        f32x4 gm[8], shv[8];
        if (!ROUTER) {
#pragma unroll
          for (int j = 0; j < 8; ++j) { gm[j] = gp[64 * j] * (sc[64 * j] + 1.0f); shv[j] = sh[64 * j]; } }
#pragma unroll 1
      for (int rr = 0; rr < 4; ++rr) { const int row = row0 + rr;
        f32x4 v[8]; float ss = 0.f;
        if (X16) { const u32x2* xr = (const u32x2*)((const bf16_t*)X + (size_t)row * DM) + lane; u32x2 raw[8];
#pragma unroll
            for (int j = 0; j < 8; ++j) raw[j] = xr[64 * j];
#pragma unroll
            for (int j = 0; j < 8; ++j) v[j] = (f32x4){bf_lo(raw[j].x), bf_hi(raw[j].x), bf_lo(raw[j].y), bf_hi(raw[j].y)}; }
        else { const f32x4* xr = (const f32x4*)((const float*)X + (size_t)row * DM) + lane;
#pragma unroll
            for (int j = 0; j < 8; ++j) v[j] = xr[64 * j]; }
#pragma unroll
        for (int j = 0; j < 8; ++j) ss += (v[j].x * v[j].x + v[j].y * v[j].y) + (v[j].z * v[j].z + v[j].w * v[j].w);
        const float rstd = 1.0f / sqrtf(wave_sum(ss) * (1.f / DM) + 1e-6f);
        u32x2* op = (u32x2*)(out + (size_t)row * DM) + lane;
        float lg[8] = {0.f, 0.f, 0.f, 0.f, 0.f, 0.f, 0.f, 0.f}; unsigned h8[8];
#pragma unroll
        for (int j = 0; j < 8; ++j) {
            const f32x4 h = ROUTER ? (v[j] * rstd) * (gp[64 * j] * (sc[64 * j] + 1.0f)) + sh[64 * j] : (v[j] * rstd) * gm[j] + shv[j];
            if (ROUTER) { h8[j] = pk4_fp8(h.x * HSCALE, h.y * HSCALE, h.z * HSCALE, h.w * HSCALE); }
            else { u32x2 w; w.x = cvt_pk_bf16(h.x, h.y); w.y = cvt_pk_bf16(h.z, h.w); op[64 * j] = w;
                   if (OUT8) ((unsigned*)(HS2 + (size_t)row * DM) + lane)[64 * j] = pk4_fp8(h.x * HSCALE, h.y * HSCALE, h.z * HSCALE, h.w * HSCALE); }
            if (ROUTER) {
#pragma unroll
                for (int e = 0; e < 8; ++e) { const f32x4 we = *(const LAS f32x4*)(rl + e * DM + 256 * j + 4 * lane); lg[e] += (h.x * we.x + h.y * we.y) + (h.z * we.z + h.w * we.w); }
                __builtin_amdgcn_sched_barrier(0); } }
        if (ROUTER) {
#pragma unroll
            for (int e = 0; e < 8; ++e) lg[e] = wave_sum(lg[e]);
            if (lane == 0) {
                int i0 = 0; float v0 = lg[0];
#pragma unroll
                for (int e = 1; e < 8; ++e) if (lg[e] > v0) { v0 = lg[e]; i0 = e; }
                int i1 = -1; float v1 = -3.0e38f;
#pragma unroll
                for (int e = 0; e < 8; ++e) if (e != i0 && lg[e] > v1) { v1 = lg[e]; i1 = e; }
                const float w1 = 1.f / (1.f + expf(v0 - v1)), w0 = 1.f - w1;
                const int p0 = (int)__hip_atomic_fetch_add(ecnt + 64 * i0, 1u, __ATOMIC_RELAXED, __HIP_MEMORY_SCOPE_AGENT);
                const int p1 = (int)__hip_atomic_fetch_add(ecnt + 64 * i1, 1u, __ATOMIC_RELAXED, __HIP_MEMORY_SCOPE_AGENT);
                tok_e[2 * row] = i0; tok_e[2 * row + 1] = i1; tok_pos[2 * row] = p0; tok_pos[2 * row + 1] = p1; tok_w[2 * row] = w0; tok_w[2 * row + 1] = w1;
                lg[0] = __int_as_float(i0 * pg8::ECAP + p0); lg[1] = __int_as_float(i1 * pg8::ECAP + p1);
            }
            const int ra = __builtin_amdgcn_readfirstlane(__float_as_int(lg[0])), rb = __builtin_amdgcn_readfirstlane(__float_as_int(lg[1]));
            unsigned* da = (unsigned*)(HS2 + (size_t)ra * DM) + lane; unsigned* db = (unsigned*)(HS2 + (size_t)rb * DM) + lane;
#pragma unroll
            for (int j = 0; j < 8; ++j) { da[64 * j] = h8[j]; db[64 * j] = h8[j]; }
        }
      }
    }
}

DI void qknorm_phase(const bf16_t* QK, bf16_t* QKN, const float* qg, const float* kg, int gw, int NGW, int lane) {
    const int l16 = lane & 15;
    for (int idx = gw * 4 + (lane >> 4); idx < MTOK * 32; idx += NGW * 4) {
        const int hr = idx & 31; const size_t off = (size_t)(idx >> 5) * 4096 + hr * 128 + 8 * l16;
        const u32x4 raw = *(const u32x4*)(QK + off);
        float x[8] = {bf_lo(raw.x), bf_hi(raw.x), bf_lo(raw.y), bf_hi(raw.y), bf_lo(raw.z), bf_hi(raw.z), bf_lo(raw.w), bf_hi(raw.w)};
        float ss = 0.f;
#pragma unroll
        for (int i = 0; i < 8; ++i) ss += x[i] * x[i];
        ss += __shfl_xor(ss, 1); ss += __shfl_xor(ss, 2); ss += __shfl_xor(ss, 4); ss += __shfl_xor(ss, 8);
        const float rstd = (1.0f / sqrtf(ss * (1.f / 128.f) + 1e-6f)) * (hr < 16 ? 0.08838834764831845f : 1.0f);
        const float* gp = (hr < 16 ? qg : kg) + 8 * l16;
        const f32x4 g0 = *(const f32x4*)gp, g1 = *(const f32x4*)(gp + 4);
        u32x4 o; o.x = cvt_pk_bf16(x[0] * rstd * g0.x, x[1] * rstd * g0.y); o.y = cvt_pk_bf16(x[2] * rstd * g0.z, x[3] * rstd * g0.w);
        o.z = cvt_pk_bf16(x[4] * rstd * g1.x, x[5] * rstd * g1.y); o.w = cvt_pk_bf16(x[6] * rstd * g1.z, x[7] * rstd * g1.w);
        *(u32x4*)(QKN + off) = o;
    }
}

constexpr int NA_TBL = 0, NA_BUF = 30720, NA_TILE = 18432;
DI void na_phase(const bf16_t* QKN, const bf16_t* VT, bf16_t* ATT, const float* rpb, LAS unsigned char* lds, int G, int vcu0, int tid, int lane, int wave) {
    LAS float* rpbL = (LAS float*)(lds + NA_TBL);
    for (int i = tid; i < 16 * 465; i += NTHREADS) rpbL[i] = rpb[i];
    const int c16 = lane & 15, g = lane >> 4, unit = wave >> 2, j = wave & 3;
    const int cb = (j == 0) ? 0 : (j == 1) ? 8 : (j == 2) ? 24 : 32;
    const int qc = 16 * j + c16, c0 = min(max(qc - 8, 0), 48);
    const int kcl = 8 * (c16 >> 2) + (c16 & 3);
    for (int p = vcu0; p < 1024; p += G) {
        const int rho = p & 15, hh = (p >> 4) & 15, b = p >> 8;
        const int rA = 2 * rho, r0A = min(max(rA - 4, 0), 24), r0B = min(max(rA + 1 - 4, 0), 24), delta = r0B - r0A, nrows = 8 + delta;
        const int r = rA + unit, r0 = unit ? r0B : r0A;
        const bool shiftB = (unit == 1) && (delta == 1);
        const size_t tq = (size_t)b * SEQ + r * 64 + qc;
        bf16x8 qf[4];
#pragma unroll
        for (int ks = 0; ks < 4; ++ks) qf[ks] = *(const bf16x8*)(QKN + tq * 4096 + hh * 128 + 32 * ks + 8 * g);
        f32x4 S[8][2];
        u32x4 st0, st1;
        const int kkey = tid >> 3, kch = tid & 7;
        const int vd = tid >> 2, vch = tid & 3;
        const bf16_t* kg = QKN + ((size_t)b * SEQ + (size_t)r0A * 64 + kkey) * 4096 + 2048 + hh * 128 + kch * 8;
        const bf16_t* vg = VT + (size_t)(hh * 128 + vd) * MTOK + (size_t)b * SEQ + (size_t)r0A * 64 + vch * 8;
#define NA_LDK(s_) do { st0 = *(const u32x4*)(kg + (size_t)(s_) * 64 * 4096); st1 = *(const u32x4*)(kg + (size_t)(s_) * 64 * 4096 + 64); } while (0)
#define NA_STK(s_) do { LAS unsigned char* t_ = lds + NA_BUF + ((s_) & 1) * NA_TILE + kkey * 272 + kch * 16; *(LAS u32x4*)t_ = st0; *(LAS u32x4*)(t_ + 128) = st1; } while (0)
#define NA_LDV(s_) do { st0 = *(const u32x4*)(vg + (s_) * 64); st1 = *(const u32x4*)(vg + (s_) * 64 + 32); } while (0)
#define NA_STV(s_) do { LAS unsigned char* t_ = lds + NA_BUF + ((s_) & 1) * NA_TILE + vd * 144 + vch * 16; *(LAS u32x4*)t_ = st0; *(LAS u32x4*)(t_ + 64) = st1; } while (0)
#define NA_QK(s_, i_) do { const LAS unsigned char* kb_ = lds + NA_BUF + ((s_) & 1) * NA_TILE + (cb + kcl) * 272 + 16 * g; \
            _Pragma("unroll") for (int hc = 0; hc < 2; ++hc) { f32x4 a = (f32x4){0.f, 0.f, 0.f, 0.f}; \
                _Pragma("unroll") for (int ks = 0; ks < 4; ++ks) a = __builtin_amdgcn_mfma_f32_16x16x32_bf16(*(const LAS bf16x8*)(kb_ + hc * 4 * 272 + 64 * ks), qf[ks], a, 0, 0, 0); S[i_][hc] = a; } } while (0)
#define NA_SROW(s_) do { if ((s_) < nrows) { NA_STK(s_); __syncthreads(); if ((s_) + 1 < nrows) NA_LDK((s_) + 1); \
            if (!shiftB) { if ((s_) < 8) NA_QK(s_, (s_) < 8 ? (s_) : 7); } else { if ((s_) >= 1) NA_QK(s_, (s_) >= 1 ? (s_) - 1 : 0); } } } while (0)
        __syncthreads();
        NA_LDK(0);
        NA_SROW(0); NA_SROW(1); NA_SROW(2); NA_SROW(3); NA_SROW(4); NA_SROW(5); NA_SROW(6); NA_SROW(7); NA_SROW(8);
        NA_LDV(0);
        float mx = -3.0e38f;
        const LAS float* bt = rpbL + hh * 465;
#pragma unroll
        for (int i = 0; i < 8; ++i)
#pragma unroll
            for (int hc = 0; hc < 2; ++hc)
#pragma unroll
                for (int e = 0; e < 4; ++e) {
                    const int kc = cb + 8 * g + 4 * hc + e; const bool valid = (kc >= c0) && (kc < c0 + 16);
                    const int dj = min(max(kc - qc + 15, 0), 30), di = r0 + i - r + 7;
                    const float sv = valid ? S[i][hc][e] + bt[di * 31 + dj] : -3.0e38f;
                    S[i][hc][e] = sv; mx = fmaxf(mx, sv);
                }
        mx = fmaxf(mx, __shfl_xor(mx, 16)); mx = fmaxf(mx, __shfl_xor(mx, 32));
        float sum = 0.f;
#pragma unroll
        for (int i = 0; i < 8; ++i)
#pragma unroll
            for (int hc = 0; hc < 2; ++hc)
#pragma unroll
                for (int e = 0; e < 4; ++e) { const float pv = (S[i][hc][e] > -1.0e38f) ? __expf(S[i][hc][e] - mx) : 0.f; S[i][hc][e] = pv; sum += pv; }
        sum += __shfl_xor(sum, 16); sum += __shfl_xor(sum, 32);
        const float inv = 1.0f / sum;
        f32x4 O[8];
#pragma unroll
        for (int dt = 0; dt < 8; ++dt) O[dt] = (f32x4){0.f, 0.f, 0.f, 0.f};
#define NA_PV(s_, i_) do { u32x4 pw; pw.x = cvt_pk_bf16(S[i_][0][0], S[i_][0][1]); pw.y = cvt_pk_bf16(S[i_][0][2], S[i_][0][3]); pw.z = cvt_pk_bf16(S[i_][1][0], S[i_][1][1]); pw.w = cvt_pk_bf16(S[i_][1][2], S[i_][1][3]); \
            const bf16x8 pf = __builtin_bit_cast(bf16x8, pw); const LAS unsigned char* vb_ = lds + NA_BUF + ((s_) & 1) * NA_TILE + c16 * 144 + (cb + 8 * g) * 2; \
            _Pragma("unroll") for (int dt = 0; dt < 8; ++dt) O[dt] = __builtin_amdgcn_mfma_f32_16x16x32_bf16(*(const LAS bf16x8*)(vb_ + dt * 16 * 144), pf, O[dt], 0, 0, 0); } while (0)
#define NA_VROW(s_) do { if ((s_) < nrows) { NA_STV(s_); __syncthreads(); if ((s_) + 1 < nrows) NA_LDV((s_) + 1); \
            if (!shiftB) { if ((s_) < 8) NA_PV(s_, (s_) < 8 ? (s_) : 7); } else { if ((s_) >= 1) NA_PV(s_, (s_) >= 1 ? (s_) - 1 : 0); } } } while (0)
        __syncthreads();
        NA_VROW(0); NA_VROW(1); NA_VROW(2); NA_VROW(3); NA_VROW(4); NA_VROW(5); NA_VROW(6); NA_VROW(7); NA_VROW(8);
#undef NA_LDK
#undef NA_STK
#undef NA_LDV
#undef NA_STV
#undef NA_QK
#undef NA_SROW
#undef NA_PV
#undef NA_VROW
#pragma unroll
        for (int dt = 0; dt < 8; ++dt) { u32x2 w; w.x = cvt_pk_bf16(O[dt][0] * inv, O[dt][1] * inv); w.y = cvt_pk_bf16(O[dt][2] * inv, O[dt][3] * inv);
            *(u32x2*)(ATT + tq * DM + hh * 128 + 16 * dt + 4 * g) = w; }
    }
}

constexpr int MLP_WIF = 36864, MLP_WROW = 3088;
DI void ml_pre_phase(const bf16_t* XZ, const float* conv_w, const float* conv_b, const float* wq, const float* wk, const float* wv, const bf16_t* WTif,
                     bf16_t* XC, bf16_t* Q, bf16_t* Kb, bf16_t* V, float* pre_part, LAS unsigned char* lds, int G, int tid, int lane, int wave) {
    LAS float* Lcw = (LAS float*)lds;
    LAS float* Lcb = Lcw + 2560;
    LAS float* Lwq = Lcb + 512;
    LAS float* Lwk = Lwq + 2048;
    LAS float* Lwv = Lwk + 2048;
    LAS unsigned char* Lwif = lds + MLP_WIF;
    const int g = lane >> 4, tk = lane & 15;
    for (int item = blockIdx.x; item < 256; item += G) {
        const int hd = item & 7, tr = item >> 3;
        __syncthreads();
        for (int i = tid; i < 2560; i += NTHREADS) Lcw[i] = conv_w[(i >> 9) * 4096 + hd * 512 + (i & 511)];
        Lcb[tid] = conv_b[hd * 512 + tid];
        for (int i = tid; i < 2048; i += NTHREADS) { Lwq[i] = wq[hd * 2048 + i]; Lwk[i] = wk[hd * 2048 + i]; Lwv[i] = wv[hd * 2048 + i]; }
        for (int i = tid; i < 32 * 3 * 64; i += NTHREADS) { const int n = i / 192, rem = i - n * 192, sec = rem >> 6, c16 = rem & 63;
            *(LAS u32x4*)(Lwif + n * MLP_WROW + sec * 1024 + c16 * 16) = *(const u32x4*)(WTif + (size_t)n * 12288 + sec * 4096 + hd * 512 + c16 * 8); }
        __syncthreads();
        for (int tt = wave; tt < 16; tt += 8) {
            const int tok = tr * 256 + tt * 16 + tk, tseq = tok & 2047;
            f32x4 accp[2]; accp[0] = (f32x4){0.f, 0.f, 0.f, 0.f}; accp[1] = (f32x4){0.f, 0.f, 0.f, 0.f};
            u32x4 xrA[5], xrB[5], hq, hk, hv, hc;
#define MLP_LOAD(xr_, step_) do { const int ch_ = hd * 512 + (step_) * 32 + 8 * g; \
                _Pragma("unroll") for (int jt = 0; jt < 5; ++jt) { const int dt = jt - 2; const bool ok = (unsigned)(tseq + dt) < (unsigned)SEQ; \
                    xr_[jt] = (u32x4){0u, 0u, 0u, 0u}; if (ok) xr_[jt] = *(const u32x4*)(XZ + (size_t)(tok + dt) * 8192 + ch_); } } while (0)
#define MLP_COMPUTE(xr_, step_, HOLD_) do { \
                const int cl = (step_) * 32 + 8 * g, ch = hd * 512 + cl; \
                float a[8], xm[8]; \
                { const f32x4 b0 = *(const LAS f32x4*)(Lcb + cl), b1 = *(const LAS f32x4*)(Lcb + cl + 4); \
                  a[0] = b0.x; a[1] = b0.y; a[2] = b0.z; a[3] = b0.w; a[4] = b1.x; a[5] = b1.y; a[6] = b1.z; a[7] = b1.w; } \
                _Pragma("unroll") for (int jt = 0; jt < 5; ++jt) { \
                    const u32x4 xr = xr_[jt]; \
                    const float xv[8] = {bf_lo(xr.x), bf_hi(xr.x), bf_lo(xr.y), bf_hi(xr.y), bf_lo(xr.z), bf_hi(xr.z), bf_lo(xr.w), bf_hi(xr.w)}; \
                    const f32x4 w0 = *(const LAS f32x4*)(Lcw + jt * 512 + cl), w1 = *(const LAS f32x4*)(Lcw + jt * 512 + cl + 4); \
                    a[0] += xv[0] * w0.x; a[1] += xv[1] * w0.y; a[2] += xv[2] * w0.z; a[3] += xv[3] * w0.w; a[4] += xv[4] * w1.x; a[5] += xv[5] * w1.y; a[6] += xv[6] * w1.z; a[7] += xv[7] * w1.w; \
                    if (jt == 2) { _Pragma("unroll") for (int i = 0; i < 8; ++i) xm[i] = xv[i]; } } \
                float xc[8], q[8], k[8], v[8]; \
                _Pragma("unroll") for (int i = 0; i < 8; ++i) xc[i] = silu_f(a[i]); \
                _Pragma("unroll") for (int blk = 0; blk < 2; ++blk) { const int wo = ((cl >> 2) + blk) * 16; \
                    _Pragma("unroll") for (int o = 0; o < 4; ++o) { float sq = 0.f, sk = 0.f, sv = 0.f; \
                        _Pragma("unroll") for (int i = 0; i < 4; ++i) { sq += xc[4 * blk + i] * Lwq[wo + i * 4 + o]; sk += xc[4 * blk + i] * Lwk[wo + i * 4 + o]; sv += xm[4 * blk + i] * Lwv[wo + i * 4 + o]; } \
                        q[4 * blk + o] = sq; k[4 * blk + o] = sk; v[4 * blk + o] = sv; } } \
                u32x4 qw, kw, vw, cw; \
                qw.x = cvt_pk_bf16(q[0], q[1]); qw.y = cvt_pk_bf16(q[2], q[3]); qw.z = cvt_pk_bf16(q[4], q[5]); qw.w = cvt_pk_bf16(q[6], q[7]); \
                kw.x = cvt_pk_bf16(k[0], k[1]); kw.y = cvt_pk_bf16(k[2], k[3]); kw.z = cvt_pk_bf16(k[4], k[5]); kw.w = cvt_pk_bf16(k[6], k[7]); \
                vw.x = cvt_pk_bf16(v[0], v[1]); vw.y = cvt_pk_bf16(v[2], v[3]); vw.z = cvt_pk_bf16(v[4], v[5]); vw.w = cvt_pk_bf16(v[6], v[7]); \
                cw.x = cvt_pk_bf16(xc[0], xc[1]); cw.y = cvt_pk_bf16(xc[2], xc[3]); cw.z = cvt_pk_bf16(xc[4], xc[5]); cw.w = cvt_pk_bf16(xc[6], xc[7]); \
                const size_t o4 = (size_t)tok * 4096 + ch; \
                if (HOLD_) { hq = qw; hk = kw; hv = vw; hc = cw; }     \
                else { *(u32x4*)(Q + o4 - 32) = hq; *(u32x4*)(Q + o4) = qw; *(u32x4*)(Kb + o4 - 32) = hk; *(u32x4*)(Kb + o4) = kw; *(u32x4*)(V + o4 - 32) = hv; *(u32x4*)(V + o4) = vw; *(u32x4*)(XC + o4 - 32) = hc; *(u32x4*)(XC + o4) = cw; } \
                const bf16x8 qf = __builtin_bit_cast(bf16x8, qw), kf = __builtin_bit_cast(bf16x8, kw), vf = __builtin_bit_cast(bf16x8, vw); \
                _Pragma("unroll") for (int nt = 0; nt < 2; ++nt) { const LAS unsigned char* wp = Lwif + (nt * 16 + tk) * MLP_WROW + cl * 2; \
                    accp[nt] = __builtin_amdgcn_mfma_f32_16x16x32_bf16(qf, *(const LAS bf16x8*)(wp), accp[nt], 0, 0, 0); \
                    accp[nt] = __builtin_amdgcn_mfma_f32_16x16x32_bf16(kf, *(const LAS bf16x8*)(wp + 1024), accp[nt], 0, 0, 0); \
                    accp[nt] = __builtin_amdgcn_mfma_f32_16x16x32_bf16(vf, *(const LAS bf16x8*)(wp + 2048), accp[nt], 0, 0, 0); } } while (0)
            MLP_LOAD(xrA, 0);
#pragma unroll 1
            for (int step = 0; step < 16; step += 2) {
                MLP_LOAD(xrB, step + 1);
                MLP_COMPUTE(xrA, step, true);
                { const int sn = (step + 2 < 16) ? step + 2 : 15; MLP_LOAD(xrA, sn); }
                MLP_COMPUTE(xrB, step + 1, false);
            }
#undef MLP_LOAD
#undef MLP_COMPUTE
#pragma unroll
            for (int nt = 0; nt < 2; ++nt)
#pragma unroll
                for (int e = 0; e < 4; ++e) pre_part[((size_t)hd * 32 + nt * 16 + tk) * MTOK + tr * 256 + tt * 16 + 4 * g + e] = accp[nt][e];
        }
    }
}

constexpr int ML_QS0 = 0, ML_KS0 = 16384, ML_QS1 = 32768, ML_KS1 = 49152, ML_VS0 = 65536, ML_VS1 = 81920, ML_WV = 98304, ML_SS = 114688, ML_SM = 123904;
constexpr int ML_XS = ML_QS1, ML_XN = ML_QS1;
constexpr int GB_U = 0, GB_MR = 64, GB_W = 128, GB_INT = 192, GB_BND = 256, GB_SC = 320;
constexpr int SM_DIN0 = 768, SM_DIN1 = 832, SM_NV = 896, SM_NVP = 1408, SM_DNQP = 3456, SM_GS = 3968, SM_CMX = 4000, SM_MC = 4032, SM_END = 4096;
static_assert(ML_SM + SM_END * 4 <= LDS_BYTES - 16, "mLSTM LDS");
constexpr float KSCALE = 0.04419417382415922f;

DI s16x4 tr_read(LAS unsigned char* p) { return __builtin_amdgcn_ds_read_tr16_b64_v4i16((LAS s16x4*)p); }
DI int dimg(int row, int ch) { return 2048 * (row >> 3) + 512 * (ch >> 2) + 64 * (row & 7) + 16 * ((ch & 3) ^ ((row >> 2) & 3)); }
DI bf16x8 frag_tr(LAS unsigned char* img, int k0, int c0, int lane) {
    const int h = lane >> 5, blk = (lane >> 4) & 1, q = (lane & 15) >> 2, p = lane & 3;
    const int row = k0 + 8 * h + q, ch = (c0 >> 3) + 2 * blk + (p >> 1), sub = 8 * (p & 1);
    const s16x4 lo = tr_read(img + dimg(row, ch) + sub), hi = tr_read(img + dimg(row + 4, ch) + sub);
    return __builtin_shufflevector(lo, hi, 0, 1, 2, 3, 4, 5, 6, 7);
}
#define MFMA32(a, b, c) __builtin_amdgcn_mfma_f32_32x32x16_bf16((a), (b), (c), 0, 0, 0)
DI void tr_batch4(bf16x8 (&f)[4], unsigned alo, unsigned ahi) {
    s16x4 l0, l1, l2, l3, h0, h1, h2, h3;
    asm volatile("ds_read_b64_tr_b16 %0, %8\n\tds_read_b64_tr_b16 %4, %9\n\tds_read_b64_tr_b16 %1, %8 offset:4096\n\tds_read_b64_tr_b16 %5, %9 offset:4096\n\t"
                 "ds_read_b64_tr_b16 %2, %8 offset:8192\n\tds_read_b64_tr_b16 %6, %9 offset:8192\n\tds_read_b64_tr_b16 %3, %8 offset:12288\n\tds_read_b64_tr_b16 %7, %9 offset:12288\n\t"
                 "s_waitcnt lgkmcnt(0)"
                 : "=&v"(l0), "=&v"(l1), "=&v"(l2), "=&v"(l3), "=&v"(h0), "=&v"(h1), "=&v"(h2), "=&v"(h3) : "v"(alo), "v"(ahi) : "memory");
    f[0] = __builtin_shufflevector(l0, h0, 0, 1, 2, 3, 4, 5, 6, 7); f[1] = __builtin_shufflevector(l1, h1, 0, 1, 2, 3, 4, 5, 6, 7);
    f[2] = __builtin_shufflevector(l2, h2, 0, 1, 2, 3, 4, 5, 6, 7); f[3] = __builtin_shufflevector(l3, h3, 0, 1, 2, 3, 4, 5, 6, 7);
}

DI void tr_issue4(s16x4& l0, s16x4& l1, s16x4& l2, s16x4& l3, s16x4& h0, s16x4& h1, s16x4& h2, s16x4& h3, unsigned alo, unsigned ahi) {
    asm volatile("ds_read_b64_tr_b16 %0, %8\n\tds_read_b64_tr_b16 %4, %9\n\tds_read_b64_tr_b16 %1, %8 offset:4096\n\tds_read_b64_tr_b16 %5, %9 offset:4096\n\t"
                 "ds_read_b64_tr_b16 %2, %8 offset:8192\n\tds_read_b64_tr_b16 %6, %9 offset:8192\n\tds_read_b64_tr_b16 %3, %8 offset:12288\n\tds_read_b64_tr_b16 %7, %9 offset:12288"
                 : "=&v"(l0), "=&v"(l1), "=&v"(l2), "=&v"(l3), "=&v"(h0), "=&v"(h1), "=&v"(h2), "=&v"(h3) : "v"(alo), "v"(ahi) : "memory");
}
DI void tr_wait8(s16x4& l0, s16x4& l1, s16x4& l2, s16x4& l3, s16x4& h0, s16x4& h1, s16x4& h2, s16x4& h3) {
    asm volatile("s_waitcnt lgkmcnt(0)" : "+v"(l0), "+v"(l1), "+v"(l2), "+v"(l3), "+v"(h0), "+v"(h1), "+v"(h2), "+v"(h3) :: "memory");
}
#define TR_CAT(f, l, h) do { f[0] = __builtin_shufflevector(l##0, h##0, 0, 1, 2, 3, 4, 5, 6, 7); f[1] = __builtin_shufflevector(l##1, h##1, 0, 1, 2, 3, 4, 5, 6, 7); \
        f[2] = __builtin_shufflevector(l##2, h##2, 0, 1, 2, 3, 4, 5, 6, 7); f[3] = __builtin_shufflevector(l##3, h##3, 0, 1, 2, 3, 4, 5, 6, 7); } while (0)

template <int I>
DI void ml_step(LAS unsigned char* lds, u32x4 (&Cp)[8][2], f32x16 (&num)[2], f32x16& Sacc, float& dnq, int tid, int lane, int wave, int gb) {
    asm volatile("" : "+v"(lane)); asm volatile("" : "+v"(tid));
    constexpr int QS = (I & 1) ? ML_QS1 : ML_QS0, KS = (I & 1) ? ML_KS1 : ML_KS0;
    const int r = lane & 31, h = lane >> 5, vt = wave & 3, dpar = wave >> 2;
    LAS float* SM = (LAS float*)(lds + ML_SM);
#define ML_SEC1 { const int wS = wave & 3, st = wS >> 1, tt1 = wS & 1, kh = wave >> 2; \
      if (!(st == 1 && tt1 == 0)) { \
        _Pragma("unroll") for (int ks = 0; ks < 4; ++ks) { const int kk = 4 * kh + ks; \
            const bf16x8 a = *(const LAS bf16x8*)(lds + KS + dimg(32 * st + r, 2 * kk + h)); \
            const bf16x8 b = *(const LAS bf16x8*)(lds + QS + dimg(32 * tt1 + r, 2 * kk + h)); \
            Sacc = MFMA32(a, b, Sacc); } } }
#define ML_SEC4 { _Pragma("unroll") for (int jj = 0; jj < 2; ++jj) { const int dl = dpar + 2 * jj; \
        _Pragma("unroll") for (int s2 = 0; s2 < 2; ++s2) { const bf16x8 a = __builtin_bit_cast(bf16x8, Cp[2 * I + jj][s2]); \
            _Pragma("unroll") for (int tt = 0; tt < 2; ++tt) { LAS unsigned char* qb = lds + QS + 8 * h; \
                const s16x4 lo = *(const LAS s16x4*)(qb + dimg(32 * tt + r, 4 * dl + 2 * s2)), hi = *(const LAS s16x4*)(qb + dimg(32 * tt + r, 4 * dl + 2 * s2 + 1)); \
                num[tt] = MFMA32(a, __builtin_shufflevector(lo, hi, 0, 1, 2, 3, 4, 5, 6, 7), num[tt]); } } } }
#define ML_UPD(jj_) { _Pragma("unroll") for (int s2 = 0; s2 < 2; ++s2) { const u32x4 o = Cp[2 * I + (jj_)][s2]; u32x4 n; \
            n.x = cvt_pk_bf16(bf_lo(o.x) * decay + U[8 * s2 + 0], bf_hi(o.x) * decay + U[8 * s2 + 1]); n.y = cvt_pk_bf16(bf_lo(o.y) * decay + U[8 * s2 + 2], bf_hi(o.y) * decay + U[8 * s2 + 3]); \
            n.z = cvt_pk_bf16(bf_lo(o.z) * decay + U[8 * s2 + 4], bf_hi(o.z) * decay + U[8 * s2 + 5]); n.w = cvt_pk_bf16(bf_lo(o.w) * decay + U[8 * s2 + 6], bf_hi(o.w) * decay + U[8 * s2 + 7]); \
            asm volatile("" : "+v"(n)); Cp[2 * I + (jj_)][s2] = n; } }
#define ML_SEC5 { const float decay = SM[gb + GB_SC + 0]; \
      const int blk = (lane >> 4) & 1, q = (lane & 15) >> 2, p = lane & 3, sub = 8 * (p & 1), rlo = 8 * h + q; \
      const unsigned ldsu = (unsigned)(size_t)lds; const int chB = 4 * vt + 2 * blk + (p >> 1), chA0 = 4 * dpar + 2 * blk + (p >> 1), chA1 = chA0 + 8; \
      s16x4 bl0, bl1, bl2, bl3, bh0, bh1, bh2, bh3, al0, al1, al2, al3, ah0, ah1, ah2, ah3, cl0, cl1, cl2, cl3, ch0, ch1, ch2, ch3; \
      tr_issue4(bl0, bl1, bl2, bl3, bh0, bh1, bh2, bh3, ldsu + ML_WV + dimg(rlo, chB) + sub, ldsu + ML_WV + dimg(rlo + 4, chB) + sub); \
      tr_issue4(al0, al1, al2, al3, ah0, ah1, ah2, ah3, ldsu + KS + dimg(rlo, chA0) + sub, ldsu + KS + dimg(rlo + 4, chA0) + sub); \
      tr_wait8(al0, al1, al2, al3, ah0, ah1, ah2, ah3); tr_wait8(bl0, bl1, bl2, bl3, bh0, bh1, bh2, bh3); \
      tr_issue4(cl0, cl1, cl2, cl3, ch0, ch1, ch2, ch3, ldsu + KS + dimg(rlo, chA1) + sub, ldsu + KS + dimg(rlo + 4, chA1) + sub); \
      bf16x8 Bf[4], Af[4]; TR_CAT(Bf, bl, bh); TR_CAT(Af, al, ah); \
      f32x16 U; \
      _Pragma("unroll") for (int e = 0; e < 16; ++e) U[e] = 0.f; \
      _Pragma("unroll") for (int ks = 0; ks < 4; ++ks) U = MFMA32(Af[ks], Bf[ks], U); \
      ML_UPD(0) \
      tr_wait8(cl0, cl1, cl2, cl3, ch0, ch1, ch2, ch3); TR_CAT(Af, cl, ch); \
      _Pragma("unroll") for (int e = 0; e < 16; ++e) U[e] = 0.f; \
      _Pragma("unroll") for (int ks = 0; ks < 4; ++ks) U = MFMA32(Af[ks], Bf[ks], U); \
      ML_UPD(1) }
#define ML_SECV { { const int t = tid & 63, dg = tid >> 6; \
      const u32x4 q0 = *(const LAS u32x4*)(lds + QS + dimg(t, 2 * dg)), q1 = *(const LAS u32x4*)(lds + QS + dimg(t, 2 * dg + 1)); \
      const LAS f32x4* nv = (const LAS f32x4*)(SM + SM_NV + 128 * I + 16 * dg); \
      const f32x4 n0 = nv[0], n1 = nv[1], n2 = nv[2], n3 = nv[3]; \
      dnq += bf_lo(q0.x) * n0.x + bf_hi(q0.x) * n0.y + bf_lo(q0.y) * n0.z + bf_hi(q0.y) * n0.w + bf_lo(q0.z) * n1.x + bf_hi(q0.z) * n1.y + bf_lo(q0.w) * n1.z + bf_hi(q0.w) * n1.w \
           + bf_lo(q1.x) * n2.x + bf_hi(q1.x) * n2.y + bf_lo(q1.y) * n2.z + bf_hi(q1.y) * n2.w + bf_lo(q1.z) * n3.x + bf_hi(q1.z) * n3.y + bf_lo(q1.w) * n3.z + bf_hi(q1.w) * n3.w; } \
    { const int dp = tid & 63, sg = tid >> 6; float a0 = 0.f, a1 = 0.f; \
      const f32x4 wA = *(const LAS f32x4*)(SM + gb + GB_W + 8 * sg), wB = *(const LAS f32x4*)(SM + gb + GB_W + 8 * sg + 4); const float ww[8] = {wA.x, wA.y, wA.z, wA.w, wB.x, wB.y, wB.z, wB.w}; \
      _Pragma("unroll") for (int s = 0; s < 8; ++s) { const unsigned kk2 = *(const LAS unsigned*)(lds + KS + dimg(8 * sg + s, dp >> 2) + 4 * (dp & 3)); a0 += ww[s] * bf_lo(kk2); a1 += ww[s] * bf_hi(kk2); } \
      ((LAS unsigned*)(SM + SM_NVP))[sg * 256 + 64 * I + dp] = cvt_pk_bf16(a0, a1); } }
    ML_SEC1 ML_SEC4 ML_SEC5 ML_SECV
#undef ML_SEC1
#undef ML_SEC4
#undef ML_UPD
#undef ML_SEC5
#undef ML_SECV
}

DI float lane_read(float v, int src_lane) { return __builtin_bit_cast(float, __builtin_amdgcn_ds_bpermute(src_lane << 2, __builtin_bit_cast(int, v))); }
DI void ml_scan(float li_, float lf_, float& u_, float& cm_, float& bs_, int lane) {
    bs_ = lf_;
#pragma unroll
    for (int o_ = 1; o_ < 64; o_ <<= 1) { const float t_ = lane_read(bs_, (lane - o_) & 63); if (lane >= o_) bs_ += t_; }
    u_ = li_ - bs_; cm_ = u_;
#pragma unroll
    for (int o_ = 1; o_ < 64; o_ <<= 1) { const float t_ = lane_read(cm_, (lane - o_) & 63); if (lane >= o_) cm_ = fmaxf(cm_, t_); }
}
DI void ml_gates(LAS float* SM, float u_, float cm_, float bs_, int gbn, float m_, float cmx_, int lane) {
    const float M_ = fmaxf(m_, cm_), Ml_ = fmaxf(m_, cmx_);
    SM[gbn + GB_U + lane] = u_; SM[gbn + GB_MR + lane] = M_; SM[gbn + GB_W + lane] = __expf(u_ - Ml_) * KSCALE; SM[gbn + GB_INT + lane] = __expf(m_ - M_); SM[gbn + GB_BND + lane] = __expf(-(bs_ + M_));
    if (lane == 0) SM[gbn + GB_SC + 0] = __expf(m_ - Ml_);
}

DI void ml_dma_piece(const bf16_t* colbase, int b, int dir, int tau0, LAS unsigned char* tile, int j, int lane) {
    const int pos = lane & 31, rin = pos >> 2, row = 8 * (j >> 1) + rin, ch = 4 * (2 * (j & 1) + (lane >> 5)) + ((pos & 3) ^ ((row >> 2) & 3));
    const int tau = tau0 + row; const size_t tok = (size_t)(b * SEQ + (dir ? SEQ - 1 - tau : tau));
    __builtin_amdgcn_global_load_lds((const unsigned*)(colbase + tok * 4096 + ch * 8), (LAS unsigned*)(tile + 1024 * j), 16, 0, 0);
}

DI void mlstm_phase(const bf16_t* Q, const bf16_t* Kb, const bf16_t* V, const float* pre_part, const float* b_if, float* GLF, bf16_t* HF, bf16_t* HB,
                    LAS unsigned char* lds, int G, int vcu0, int tid0, int lane0, int wave) {
    LAS float* SM = (LAS float*)(lds + ML_SM);
    const int vt = wave & 3, dpar = wave >> 2;
    for (int item = vcu0; item < 256; item += G) {
        const int vs = item & 3, stream = item >> 2, dir = stream & 1, hd = (stream >> 1) & 7, b = stream >> 4;
        bf16_t* H = dir ? HB : HF;
        float* glf = GLF + (size_t)item * 10240;
        const bf16_t* qcol = Q + hd * 512; const bf16_t* kcol = Kb + hd * 512; const bf16_t* vcol = V + hd * 512 + vs * 128;
        __syncthreads();
        int tidp = tid0, lanep = lane0; asm volatile("" : "+v"(tidp)); asm volatile("" : "+v"(lanep));
        for (int tau = tidp; tau < SEQ; tau += NTHREADS) {
            const int tok = b * SEQ + (dir ? SEQ - 1 - tau : tau);
            float li = b_if[dir * 16 + hd], lfr = b_if[dir * 16 + 8 + hd];
#pragma unroll
            for (int h8 = 0; h8 < 8; ++h8) { const float* pp = pre_part + ((size_t)h8 * 32 + dir * 16 + hd) * MTOK + tok; li += pp[0]; lfr += pp[(size_t)8 * MTOK]; }
            glf[tau] = li; glf[2048 + tau] = fminf(lfr, 0.f) - log1pf(__expf(-fabsf(lfr)));
        }
        SM[SM_NV + tidp] = 0.f;
        ml_dma_piece(qcol, b, dir, 0, lds + ML_QS0, 2 * wave, lanep); ml_dma_piece(qcol, b, dir, 0, lds + ML_QS0, 2 * wave + 1, lanep);
        ml_dma_piece(kcol, b, dir, 0, lds + ML_KS0, 2 * wave, lanep); ml_dma_piece(kcol, b, dir, 0, lds + ML_KS0, 2 * wave + 1, lanep);
        ml_dma_piece(vcol, b, dir, 0, lds + ML_VS0, 2 * wave, lanep); ml_dma_piece(vcol, b, dir, 0, lds + ML_VS0, 2 * wave + 1, lanep);
        asm volatile("s_waitcnt vmcnt(0)" ::: "memory");
        __syncthreads();
        float u0 = 0.f, cm0 = 0.f, bs0 = 0.f;
#pragma unroll 1
        for (int cc = wave; cc < 32; cc += 8) {
            const float lic = __hip_atomic_load(glf + 64 * cc + lanep, __ATOMIC_RELAXED, __HIP_MEMORY_SCOPE_AGENT), lfc = __hip_atomic_load(glf + 2048 + 64 * cc + lanep, __ATOMIC_RELAXED, __HIP_MEMORY_SCOPE_AGENT);
            float uu, cmm, bss; ml_scan(lic, lfc, uu, cmm, bss, lanep);
            glf[4096 + 64 * cc + lanep] = uu; glf[6144 + 64 * cc + lanep] = cmm; glf[8192 + 64 * cc + lanep] = bss;
            if (lanep == 63) { SM[SM_GS + cc] = bss; SM[SM_CMX + cc] = cmm; }
            if (cc == 0) { u0 = uu; cm0 = cmm; bs0 = bss; }
        }
        asm volatile("s_waitcnt vmcnt(0)" ::: "memory");
        __syncthreads();
        if (tidp == 0) { float m = 0.f;
#pragma unroll 1
            for (int cc = 0; cc < 32; ++cc) { SM[SM_MC + cc] = m; m = SM[SM_GS + cc] + fmaxf(m, SM[SM_CMX + cc]); } }
        __syncthreads();
        if (wave == 0) ml_gates(SM, u0, cm0, bs0, 0, 0.f, SM[SM_CMX + 0], lanep);
        __syncthreads();
#define ML_WRITE_WV(VS_, gbx_) do { const float w_ = SM[(gbx_) + GB_W + lrow]; \
        _Pragma("unroll") for (int hh_ = 0; hh_ < 2; ++hh_) { const int o_ = dimg(lrow, lcc + 8 * hh_); const u32x4 x_ = *(const LAS u32x4*)(lds + (VS_) + o_); u32x4 y_; \
            y_.x = cvt_pk_bf16(bf_lo(x_.x) * w_, bf_hi(x_.x) * w_); y_.y = cvt_pk_bf16(bf_lo(x_.y) * w_, bf_hi(x_.y) * w_); y_.z = cvt_pk_bf16(bf_lo(x_.z) * w_, bf_hi(x_.z) * w_); y_.w = cvt_pk_bf16(bf_lo(x_.w) * w_, bf_hi(x_.w) * w_); \
            *(LAS u32x4*)(lds + ML_WV + o_) = y_; } } while (0)
        { const int lrow = tidp >> 3, lcc = tidp & 7; ML_WRITE_WV(ML_VS0, 0); }
        u32x4 Cp[8][2];
#pragma unroll
        for (int j = 0; j < 8; ++j) { Cp[j][0] = (u32x4){0u, 0u, 0u, 0u}; Cp[j][1] = (u32x4){0u, 0u, 0u, 0u}; }
#pragma unroll 1
        for (int c = 0; c < 32; ++c) {
            int lane = lane0, tid = tid0; asm volatile("" : "+v"(lane)); asm volatile("" : "+v"(tid));
            const int r = lane & 31, h = lane >> 5, lrow = tid >> 3, lcc = tid & 7;
            const int gb = (c & 1) * 384, gbn = 384 - gb, cn = (c + 1 < 32) ? c + 1 : 31;
            const int VSc = (c & 1) ? ML_VS1 : ML_VS0, VSn = (c & 1) ? ML_VS0 : ML_VS1;
            f32x16 num[2], Sacc; float dnq = 0.f;
#pragma unroll
            for (int e = 0; e < 16; ++e) { num[0][e] = 0.f; num[1][e] = 0.f; Sacc[e] = 0.f; }
#define ML_DMA_QK(QS_, KS_, c_, i_) do { ml_dma_piece(qcol + 128 * (i_), b, dir, 64 * (c_), lds + (QS_), 2 * wave, lane); ml_dma_piece(qcol + 128 * (i_), b, dir, 64 * (c_), lds + (QS_), 2 * wave + 1, lane); \
                ml_dma_piece(kcol + 128 * (i_), b, dir, 64 * (c_), lds + (KS_), 2 * wave, lane); ml_dma_piece(kcol + 128 * (i_), b, dir, 64 * (c_), lds + (KS_), 2 * wave + 1, lane); } while (0)
            asm volatile("s_waitcnt vmcnt(0)" ::: "memory"); __syncthreads(); ML_DMA_QK(ML_QS1, ML_KS1, c, 1);  ml_step<0>(lds, Cp, num, Sacc, dnq, tid, lane, wave, gb);
            asm volatile("s_waitcnt vmcnt(0)" ::: "memory"); __syncthreads(); ML_DMA_QK(ML_QS0, ML_KS0, c, 2);  ml_step<1>(lds, Cp, num, Sacc, dnq, tid, lane, wave, gb);
            asm volatile("s_waitcnt vmcnt(0)" ::: "memory"); __syncthreads(); ML_DMA_QK(ML_QS1, ML_KS1, c, 3);  ml_step<2>(lds, Cp, num, Sacc, dnq, tid, lane, wave, gb);
            asm volatile("s_waitcnt vmcnt(0)" ::: "memory"); __syncthreads(); ML_DMA_QK(ML_QS0, ML_KS0, cn, 0);
            ml_dma_piece(vcol, b, dir, 64 * cn, lds + VSn, 2 * wave, lane); ml_dma_piece(vcol, b, dir, 64 * cn, lds + VSn, 2 * wave + 1, lane);
            ml_step<3>(lds, Cp, num, Sacc, dnq, tid, lane, wave, gb);
            asm volatile("s_waitcnt vmcnt(0)" ::: "memory");
            __syncthreads();
            float un = 0.f, cmn = 0.f, bsn = 0.f;
            if (wave == 0) { un = __hip_atomic_load(glf + 4096 + 64 * cn + lane, __ATOMIC_RELAXED, __HIP_MEMORY_SCOPE_AGENT); cmn = __hip_atomic_load(glf + 6144 + 64 * cn + lane, __ATOMIC_RELAXED, __HIP_MEMORY_SCOPE_AGENT);
                             bsn = __hip_atomic_load(glf + 8192 + 64 * cn + lane, __ATOMIC_RELAXED, __HIP_MEMORY_SCOPE_AGENT); }
            { LAS f32x4* xs = (LAS f32x4*)(lds + ML_XS) + (size_t)((wave & 3) * 4) * 64 + lane;
              if (wave >= 4) {
#pragma unroll
                for (int gq = 0; gq < 4; ++gq) xs[gq * 64] = (f32x4){Sacc[4 * gq], Sacc[4 * gq + 1], Sacc[4 * gq + 2], Sacc[4 * gq + 3]}; } }
            SM[SM_DNQP + (tid >> 6) * 64 + (tid & 63)] = dnq;
            __syncthreads();
            if (wave < 4) {
                const int st = wave >> 1, tt1 = wave & 1, t = 32 * tt1 + r;
                const LAS f32x4* xs = (const LAS f32x4*)(lds + ML_XS) + (size_t)(wave * 4) * 64 + lane;
                const float Mt = SM[gb + GB_MR + t]; float dsum = 0.f;
#pragma unroll
                for (int gq = 0; gq < 4; ++gq) {
                    const f32x4 px = xs[gq * 64]; const int s0 = 32 * st + 8 * gq + 4 * h; const f32x4 us = *(const LAS f32x4*)(SM + gb + GB_U + s0);
                    float vv[4];
#pragma unroll
                    for (int e = 0; e < 4; ++e) { const float raw = (Sacc[4 * gq + e] + px[e]) * KSCALE; vv[e] = (s0 + e <= t) ? raw * __expf(us[e] - Mt) : 0.f; dsum += vv[e]; }
                    u32x2 w; w.x = cvt_pk_bf16(vv[0], vv[1]); w.y = cvt_pk_bf16(vv[2], vv[3]);
                    *(LAS u32x2*)(lds + ML_SS + t * 144 + s0 * 2) = w;
                }
                dsum += __shfl_xor(dsum, 32);
                if (h == 0) SM[(st ? SM_DIN1 : SM_DIN0) + t] = dsum;
            }
#pragma unroll
            for (int tt = 0; tt < 2; ++tt) { const float it = SM[gb + GB_INT + 32 * tt + r]; num[tt] = num[tt] * it; }
            __syncthreads();
#pragma unroll
            for (int k2 = 0; k2 < 2; ++k2) { const int ks = 2 * dpar + k2;
                const bf16x8 a = frag_tr(lds + VSc, 16 * ks, 32 * vt, lane);
#pragma unroll
                for (int tt = 0; tt < 2; ++tt) { const bf16x8 bb = *(const LAS bf16x8*)(lds + ML_SS + (32 * tt + r) * 144 + (16 * ks + 8 * h) * 2); num[tt] = MFMA32(a, bb, num[tt]); } }
            __syncthreads();
            { LAS f32x4* xn = (LAS f32x4*)(lds + ML_XN) + (size_t)(vt * 8) * 64 + lane;
              if (dpar == 1) {
#pragma unroll
                for (int tt = 0; tt < 2; ++tt)
#pragma unroll
                    for (int gq = 0; gq < 4; ++gq) xn[(tt * 4 + gq) * 64] = (f32x4){num[tt][4 * gq], num[tt][4 * gq + 1], num[tt][4 * gq + 2], num[tt][4 * gq + 3]}; } }
            if (wave == 0) ml_gates(SM, un, cmn, bsn, gbn, SM[SM_MC + cn], SM[SM_CMX + cn], lane);
            __syncthreads();
            if (dpar == 0) {
                const LAS f32x4* xn = (const LAS f32x4*)(lds + ML_XN) + (size_t)(vt * 8) * 64 + lane;
#pragma unroll
                for (int tt = 0; tt < 2; ++tt) { const int t = 32 * tt + r; float nq = 0.f;
#pragma unroll
                    for (int gI = 0; gI < 8; ++gI) nq += SM[SM_DNQP + gI * 64 + t];
                    const float den = SM[SM_DIN0 + t] + SM[SM_DIN1 + t] + SM[gb + GB_INT + t] * nq;
                    const float inv = 1.0f / fmaxf(fabsf(den), SM[gb + GB_BND + t]);
                    const int tau = 64 * c + t; const size_t ob = (size_t)(b * SEQ + (dir ? SEQ - 1 - tau : tau)) * 4096 + hd * 512 + vs * 128 + 32 * vt + 4 * h;
#pragma unroll
                    for (int gq = 0; gq < 4; ++gq) { const f32x4 px = xn[(tt * 4 + gq) * 64];
                        u32x2 w; w.x = cvt_pk_bf16((num[tt][4 * gq] + px.x) * inv, (num[tt][4 * gq + 1] + px.y) * inv); w.y = cvt_pk_bf16((num[tt][4 * gq + 2] + px.z) * inv, (num[tt][4 * gq + 3] + px.w) * inv);
                        *(u32x2*)(H + ob + 8 * gq) = w; } }
            }
            ML_WRITE_WV(VSn, gbn);
            { const float decay = SM[gb + GB_SC + 0];
              float acc_ = 0.f; const LAS unsigned* np_ = (const LAS unsigned*)(SM + SM_NVP) + (tid >> 1);
#pragma unroll
              for (int sgx = 0; sgx < 8; ++sgx) { const unsigned pr_ = np_[sgx * 256]; acc_ += (tid & 1) ? bf_hi(pr_) : bf_lo(pr_); }
              SM[SM_NV + tid] = decay * SM[SM_NV + tid] + acc_; }
        }
#undef ML_DMA_QK
#undef ML_WRITE_WV
    }
}

DI void ml_combine_phase(const bf16_t* HF, const bf16_t* HB, const bf16_t* XC, const bf16_t* XZ, const float* norm_g, const float* skip, unsigned char* MO, int gw, int NGW, int lane) {
    const int hd = gw & 7, ch = hd * 512 + 8 * lane;
    const f32x4 g0 = *(const f32x4*)(norm_g + ch), g1 = *(const f32x4*)(norm_g + ch + 4), k0 = *(const f32x4*)(skip + ch), k1 = *(const f32x4*)(skip + ch + 4);
    const float gg[8] = {g0.x, g0.y, g0.z, g0.w, g1.x, g1.y, g1.z, g1.w}, sk[8] = {k0.x, k0.y, k0.z, k0.w, k1.x, k1.y, k1.z, k1.w};
    const int NI = MTOK * ML_HEADS;
#define MLC_LOAD(A_, B_, C_, Z_, idx_) do { const int ic_ = (idx_) < NI ? (idx_) : gw; const int tk_ = ic_ >> 3; const size_t o_ = (size_t)tk_ * 4096 + ch; \
        A_ = *(const u32x4*)(HF + o_); B_ = *(const u32x4*)(HB + o_); C_ = *(const u32x4*)(XC + o_); Z_ = *(const u32x4*)(XZ + (size_t)tk_ * 8192 + 4096 + ch); } while (0)
#define MLC_COMPUTE(a, bq, xcv, zv, idx_) do { const size_t o4 = (size_t)((idx_) >> 3) * 4096 + ch; \
        float ht[8] = {bf_lo(a.x) + bf_lo(bq.x), bf_hi(a.x) + bf_hi(bq.x), bf_lo(a.y) + bf_lo(bq.y), bf_hi(a.y) + bf_hi(bq.y), bf_lo(a.z) + bf_lo(bq.z), bf_hi(a.z) + bf_hi(bq.z), bf_lo(a.w) + bf_lo(bq.w), bf_hi(a.w) + bf_hi(bq.w)}; \
        const float xc[8] = {bf_lo(xcv.x), bf_hi(xcv.x), bf_lo(xcv.y), bf_hi(xcv.y), bf_lo(xcv.z), bf_hi(xcv.z), bf_lo(xcv.w), bf_hi(xcv.w)}; \
        const float z[8] = {bf_lo(zv.x), bf_hi(zv.x), bf_lo(zv.y), bf_hi(zv.y), bf_lo(zv.z), bf_hi(zv.z), bf_lo(zv.w), bf_hi(zv.w)}; \
        float s_ = 0.f; \
        _Pragma("unroll") for (int i = 0; i < 8; ++i) s_ += ht[i]; \
        const float mu = wave_sum(s_) * (1.f / 512.f); float q_ = 0.f; \
        _Pragma("unroll") for (int i = 0; i < 8; ++i) { ht[i] -= mu; q_ += ht[i] * ht[i]; } \
        const float rstd = 1.0f / sqrtf(wave_sum(q_) * (1.f / 512.f) + 1e-5f); \
        float o[8]; \
        _Pragma("unroll") for (int i = 0; i < 8; ++i) o[i] = (ht[i] * rstd * gg[i] + sk[i] * xc[i]) * sigmoid_f(z[i]); \
        u32x2 w; w.x = pk4_fp8(o[0] * HSCALE, o[1] * HSCALE, o[2] * HSCALE, o[3] * HSCALE); w.y = pk4_fp8(o[4] * HSCALE, o[5] * HSCALE, o[6] * HSCALE, o[7] * HSCALE);     \
        *(u32x2*)(MO + o4) = w; } while (0)
    u32x4 a0, b0, c0, z0, a1, b1, c1, z1, a2, b2, c2, z2;
    MLC_LOAD(a0, b0, c0, z0, gw); MLC_LOAD(a1, b1, c1, z1, gw + NGW);
    for (int idx = gw; idx < NI; idx += 3 * NGW) {
        MLC_LOAD(a2, b2, c2, z2, idx + 2 * NGW); MLC_COMPUTE(a0, b0, c0, z0, idx);
        if (idx + NGW >= NI) break;
        MLC_LOAD(a0, b0, c0, z0, idx + 3 * NGW); MLC_COMPUTE(a1, b1, c1, z1, idx + NGW);
        if (idx + 2 * NGW >= NI) break;
        MLC_LOAD(a1, b1, c1, z1, idx + 4 * NGW); MLC_COMPUTE(a2, b2, c2, z2, idx + 2 * NGW);
    }
#undef MLC_LOAD
#undef MLC_COMPUTE
}

DI void moe_offsets(const unsigned* ecnt, int (&cnt)[8], int (&off)[8], int& ntiles) {
    int acc = 0;
#pragma unroll
    for (int e = 0; e < 8; ++e) { cnt[e] = (int)ecnt[64 * e]; off[e] = acc * 256; acc += (cnt[e] + 255) >> 8; }
    ntiles = acc;
}
DI void moe_split_plan(int ntiles, int& nMf, int& nT, int& S) {
    nMf = (ntiles >> 5) << 5; nT = ntiles - nMf; S = 1;
    if (nT > 0) { S = (nT <= 4) ? 7 : (nT <= 8) ? 4 : (nT <= 16) ? 2 : 1; }
    if (S == 1) { nMf = ntiles; nT = 0; }
}
DI pg8::TileMap moe_tilemap(const int (&cnt)[8]) { pg8::TileMap tm; int acc = 0; tm.toff[0] = 0;
#pragma unroll
    for (int e = 0; e < 8; ++e) { acc += (cnt[e] + 255) >> 8; tm.toff[e + 1] = acc; }
    return tm; }
DI void moe_scatter_phase(const unsigned char* HA, unsigned char* HS, const int* tok_e, const int* tok_pos, int* slot_row, const unsigned* ecnt, int* tile_e, int gw, int NGW, int lane) {
    int cnt[8], off[8], ntiles; moe_offsets(ecnt, cnt, off, ntiles);
    if (gw == 0 && lane < 8) { const int e = lane; const int t0 = off[e] >> 8, nt = (cnt[e] + 255) >> 8; for (int t = 0; t < nt; ++t) tile_e[t0 + t] = e; }
    for (int id = gw; id < 2 * MTOK; id += NGW) {
        const int e = tok_e[id], pos = tok_pos[id]; int o = 0;
#pragma unroll
        for (int q = 0; q < 8; ++q) o = (e == q) ? off[q] : o;
        const int row = o + pos;
        if (lane == 0) slot_row[id] = row;
        const u32x4* src = (const u32x4*)(HA + (size_t)(id >> 1) * DM) + lane; u32x4* dst = (u32x4*)(HS + (size_t)row * DM) + lane;
#pragma unroll
        for (int j = 0; j < 2; ++j) dst[64 * j] = src[64 * j];
    }
#pragma unroll 1
    for (int e = 0; e < 8; ++e) { int c = 0, o = 0;
#pragma unroll
        for (int q = 0; q < 8; ++q) { c = (e == q) ? cnt[q] : c; o = (e == q) ? off[q] : o; }
        const int pend = ((c + 255) >> 8) << 8;
        for (int p = c + gw; p < pend; p += NGW) { u32x4* dst = (u32x4*)(HS + (size_t)(o + p) * DM) + lane;
#pragma unroll
            for (int j = 0; j < 2; ++j) dst[64 * j] = (u32x4){0u, 0u, 0u, 0u}; } }
}

DI f32x4 moe_yrow(const bf16_t* YS, const bf16_t* YSP, int r, int rsplit, int S, int nrs, int lane, int j) {
    if (r < rsplit) { const u32x2 a = ((const u32x2*)(YS + (size_t)r * DM) + lane)[64 * j]; return (f32x4){bf_lo(a.x), bf_hi(a.x), bf_lo(a.y), bf_hi(a.y)}; }
    f32x4 acc = (f32x4){0.f, 0.f, 0.f, 0.f};
    for (int s2 = 0; s2 < S; ++s2) { const u32x2 a = ((const u32x2*)(YSP + ((size_t)s2 * nrs + (r - rsplit)) * DM) + lane)[64 * j]; acc += (f32x4){bf_lo(a.x), bf_hi(a.x), bf_lo(a.y), bf_hi(a.y)}; }
    return acc;
}
DI void moe_combine_phase(const bf16_t* X3, const bf16_t* YS, const int* tok_e, const int* tok_pos, const float* tok_w, const float* gate, float* out, const unsigned* ecnt, int gw, int NGW, int lane) {
    int cnt[8], off[8], ntiles; moe_offsets(ecnt, cnt, off, ntiles);
    int nMf, nT, S; moe_split_plan(ntiles, nMf, nT, S); const int rsplit = nMf * 256; const bf16_t* YSP = YS + (size_t)MPAD * DM;
    for (int tok0 = 4 * gw; tok0 < MTOK; tok0 += 4 * NGW) {
      f32x4 gt[8];
      { const f32x4* gp = (const f32x4*)(gate + (size_t)(tok0 >> 11) * 12288) + lane;
#pragma unroll
        for (int j = 0; j < 8; ++j) gt[j] = gp[64 * j]; }
#pragma unroll 1
      for (int tq = 0; tq < 4; ++tq) { const int tok = tok0 + tq;
        const int e0 = tok_e[2 * tok], e1 = tok_e[2 * tok + 1]; int o0 = 0, o1 = 0;
#pragma unroll
        for (int q = 0; q < 8; ++q) { o0 = (e0 == q) ? off[q] : o0; o1 = (e1 == q) ? off[q] : o1; }
        const int r0 = o0 + tok_pos[2 * tok], r1 = o1 + tok_pos[2 * tok + 1]; const float w0 = tok_w[2 * tok], w1 = tok_w[2 * tok + 1];
        const u32x2* x = (const u32x2*)(X3 + (size_t)tok * DM) + lane;
        f32x4* o = (f32x4*)(out + (size_t)tok * DM) + lane;
#pragma unroll
        for (int j = 0; j < 8; ++j) { const f32x4 ya = moe_yrow(YS, YSP, r0, rsplit, S, nT * 256, lane, j), yb = moe_yrow(YS, YSP, r1, rsplit, S, nT * 256, lane, j);
            const u32x2 xr = x[64 * j]; o[64 * j] = (f32x4){bf_lo(xr.x), bf_hi(xr.x), bf_lo(xr.y), bf_hi(xr.y)} + gt[j] * (ya * w0 + yb * w1); }
      }
    }
}

struct Params { const float* in[29]; float* out; unsigned char* ws; int ph_lo, ph_hi; };
static_assert(sizeof(Params) == 31 * 8 + 8, "Params has padding");
constexpr int NPHASE = 20;

#if DBG
#include "dbg_checks.inc"
#endif

__global__ void __launch_bounds__(NTHREADS, 2) mega_fwd(Params p) {
    extern __shared__ __attribute__((aligned(16))) unsigned char lds_raw[];
    LAS unsigned char* lds = (LAS unsigned char*)lds_raw;
    const int tid = threadIdx.x, lane = tid & 63, wave = __builtin_amdgcn_readfirstlane(tid >> 6);
    const int G = gridDim.x, gw = blockIdx.x * NWAVES + wave, NGW = G * NWAVES;
    const int vcu = (G % 8 == 0) ? (int)(blockIdx.x % 8) * (G / 8) + (int)(blockIdx.x / 8) : (int)blockIdx.x;
    const int gwx = vcu * NWAVES + wave;
    unsigned char* ws = p.ws;
    unsigned* ctl = (unsigned*)(ws + WS_CTL);
    volatile LAS unsigned* xbw = (volatile LAS unsigned*)(lds + LDS_BYTES - 16);
    if (tid == 0) { xbw[0] = 0u; xbw[1] = 0u; xbw[2] = 0u; xbw[3] = 0u; }
    __syncthreads();
    XcdBarrier bar = xcd_barrier_post(ctl + CW_BAR, xbw);
    const int lo = p.ph_lo, hi = p.ph_hi;
#ifndef PH_MASK
#define PH_MASK 0xFFFFFFu
#endif
#define IN(k) (((PH_MASK >> (k)) & 1u) && lo <= (k) && (k) < hi)
#define SEAM(k) do { if (IN((k) + 1)) xcd_barrier(bar); } while (0)
#ifndef REP_MASK
#define REP_MASK 0u
#endif
#define PHASE(k, ...) if (IN(k)) { { __VA_ARGS__ } if ((REP_MASK >> (k)) & 1u) { __syncthreads(); { __VA_ARGS__ } } SEAM(k); }

    float* mod = (float*)(ws + WS_MOD);
    float* pre_part = (float*)(ws + WS_PRE);
    int* tok_e = (int*)(ws + WS_ROUTE); int* tok_pos = tok_e + 2 * MTOK; float* tok_w = (float*)(tok_pos + 2 * MTOK); int* slot_row = (int*)(tok_w + 2 * MTOK);
    unsigned* ecnt = ctl + CW_ECNT; int* tile_e = (int*)(ctl + 12288);
    bf16_t* HA = (bf16_t*)(ws + WS_HA); bf16_t* X1 = (bf16_t*)(ws + WS_X1); bf16_t* X2 = (bf16_t*)(ws + WS_X2);
    bf16_t* WT_IN = (bf16_t*)(ws + WS_WT_IN); bf16_t* WT_OUT = (bf16_t*)(ws + WS_WT_OUT); bf16_t* WT_GU = (bf16_t*)(ws + WS_WT_GU); bf16_t* WT_DN = (bf16_t*)(ws + WS_WT_DN);
    bf16_t* WT_MLIN = (bf16_t*)(ws + WS_WT_MLIN); bf16_t* WT_MLOUT = (bf16_t*)(ws + WS_WT_MLOUT); bf16_t* WT_IF = (bf16_t*)(ws + WS_WT_IF);
    unsigned char* WT_MGU = ws + WS_WT_MGU; unsigned char* WT_MD = ws + WS_WT_MD;
    bf16_t* QK = (bf16_t*)(ws + A_QK); bf16_t* QKN = (bf16_t*)(ws + A_QKN); bf16_t* VT = (bf16_t*)(ws + A_VT); bf16_t* ATT = (bf16_t*)(ws + A_ATT); bf16_t* ACT = (bf16_t*)(ws + A_ACT);
    bf16_t* XZ = (bf16_t*)(ws + A_XZ); bf16_t* XC = (bf16_t*)(ws + A_XC); bf16_t* Qm = (bf16_t*)(ws + A_Q); bf16_t* Km = (bf16_t*)(ws + A_K); bf16_t* Vm = (bf16_t*)(ws + A_V);
    bf16_t* HF = (bf16_t*)(ws + A_HF); bf16_t* HB = (bf16_t*)(ws + A_HB); bf16_t* MO = (bf16_t*)(ws + A_MO);
    unsigned char* HS = ws + A_HS; unsigned char* ACTM = ws + A_ACTM; float* YS = (float*)(ws + A_YS);
    const float* x_in = p.in[0];

    PHASE(0,
        mod_phase(p.in[1], p.in[2], p.in[3], mod, lds, G, tid, lane, wave);
        LAS float* scrw = (LAS float*)lds + wave * (64 * 65);
        cvtw_job<0, false>(p.in[6] + 4096, 2048, 2048, 1, WT_IN + (size_t)4096 * 2048, 0, scrw, gw, NGW, lane, 1.f, 6144, 0);
        cvtw_job<0, true>(p.in[6], 2048, 4096, 1, (unsigned char*)ACT + (size_t)32 * 1024 * 1024, 0, scrw, gw, NGW, lane, WSCALE, 6144, 512);
        cvtw_job<0, false>(p.in[10], 2048, 2048, 1, WT_OUT, 0, scrw, gw, NGW, lane, 1.f, 0, 1536);
        cvtw_job<1, false>(p.in[11], 2048, FFN, 1, WT_GU, 0, scrw, gw, NGW, lane, 1.f, 0, 2048);
        cvtw_job<2, false>(p.in[12], 2048, FFN, 1, WT_GU, 0, scrw, gw, NGW, lane, 1.f, 0, 3456);
        cvtw_job<0, false>(p.in[13], FFN, 2048, 1, WT_DN, 0, scrw, gw, NGW, lane, 1.f, 0, 4864);
        cvtw_job<0, false>(p.in[14], 2048, 4096, 1, WT_MLIN, 0, scrw, gw, NGW, lane, 1.f, 8192, 6272);
        cvtw_job<0, true>(p.in[14] + 4096, 2048, 4096, 1, (unsigned char*)WT_MLIN + (size_t)16 * 1024 * 1024, 0, scrw, gw, NGW, lane, WSCALE, 8192, 7296);
        cvtw_job<0, true>(p.in[24], 4096, 2048, 1, (unsigned char*)WT_MLOUT, 0, scrw, gw, NGW, lane, WSCALE, 0, 8320);
        cvt_job<0>(p.in[20], 12288, 32, 1, WT_IF, 0, scrw, gw, NGW, lane);
        cvtw_job<1, true>(p.in[26], 2048, EDIM, 8, WT_MGU, (size_t)14336 * 2048, scrw, gw, NGW, lane, WSCALE, 0, 9344);
        cvtw_job<2, true>(p.in[27], 2048, EDIM, 8, WT_MGU, (size_t)14336 * 2048, scrw, gw, NGW, lane, WSCALE, 0, 9344 + 14336);
        cvtw_job<0, true>(p.in[28], EDIM, 2048, 8, WT_MD, (size_t)2048 * EDIM, scrw, gw, NGW, lane, WSCALE, 0, 9344 + 2 * 14336); )
    PHASE(1,  rms_mod_phase<false, true>(x_in, p.in[4], mod + 1 * 2048, mod + 0 * 2048, HA, nullptr, nullptr, nullptr, nullptr, nullptr, (unsigned char*)ACT, gw, NGW, lane); )
    PHASE(2,
        { pg8::Gemm g{(const unsigned char*)ACT, (const unsigned char*)ACT + (size_t)32 * 1024 * 1024, MTOK, 4096, 2048, 0}; pg8::StaticOrder S; S.init(MTOK, 4096, G, (int)blockIdx.x); pg8::EpiQKNorm E{QKN, 4096, p.in[7], p.in[8], 1.0f / (HSCALE * WSCALE)}; pg8::gemm_phase<pg8::EpiQKNorm, pg8::StaticOrder, true>(lds, g, S, E); }
        { pg8::Gemm g{WT_IN + (size_t)4096 * 2048, HA, 2048, MTOK, 2048, 0}; pg8::StaticOrder S; S.init(2048, MTOK, G, (int)blockIdx.x); pg8::EpiBf16 E{VT, MTOK}; pg8::gemm_phase(lds, g, S, E); } )
    PHASE(4,  na_phase(QKN, VT, ATT, p.in[9], lds, G, vcu, tid, lane, wave); )
    PHASE(5,  pg8::Gemm g{ATT, WT_OUT, MTOK, 2048, 2048, 0}; pg8::StaticOrder S; S.init(MTOK, 2048, G, (int)blockIdx.x); pg8::EpiResGate16<false> E{x_in, X1, DM, mod + 2 * 2048, 12288}; pg8::gemm_phase(lds, g, S, E); )
    PHASE(6,  rms_mod_phase<false, false, true>(X1, p.in[5], mod + 4 * 2048, mod + 3 * 2048, HA, nullptr, nullptr, nullptr, nullptr, nullptr, nullptr, gw, NGW, lane); )
    PHASE(7,  pg8::Gemm g{HA, WT_GU, MTOK, 2 * FFN, 2048, 0}; pg8::StaticOrder S; S.init(MTOK, 2 * FFN, G, (int)blockIdx.x); pg8::EpiSwiGLU E{ACT, FFN}; pg8::gemm_phase(lds, g, S, E); )
    PHASE(8,  pg8::Gemm g{ACT, WT_DN, MTOK, 2048, FFN, 0}; pg8::StaticOrder S; S.init(MTOK, 2048, G, (int)blockIdx.x); pg8::EpiResGate16<true> E{X1, X2, DM, mod + 5 * 2048, 12288}; pg8::gemm_phase(lds, g, S, E); )
    PHASE(9,  rms_mod_phase<false, true, true>(X2, p.in[4] + DM, mod + 4 * 12288 + 1 * 2048, mod + 4 * 12288 + 0 * 2048, HA, nullptr, nullptr, nullptr, nullptr, nullptr, (unsigned char*)MO, gw, NGW, lane); )
    PHASE(10,
        { pg8::Gemm g{HA, WT_MLIN, MTOK, 4096, 2048, 0}; pg8::StaticOrder S; S.init(MTOK, 4096, G, (int)blockIdx.x); pg8::EpiBf16 E{XZ, 8192}; pg8::gemm_phase(lds, g, S, E); }
        { pg8::Gemm g{(const unsigned char*)MO, (const unsigned char*)WT_MLIN + (size_t)16 * 1024 * 1024, MTOK, 4096, 2048, 0}; pg8::StaticOrder S; S.init(MTOK, 4096, G, (int)blockIdx.x);
          pg8::EpiBf16S E{XZ + 4096, 8192, 1.0f / (HSCALE * WSCALE), 0}; pg8::gemm_phase<pg8::EpiBf16S, pg8::StaticOrder, true>(lds, g, S, E); } )
    PHASE(11,  ml_pre_phase(XZ, p.in[15], p.in[16], p.in[17], p.in[18], p.in[19], WT_IF, XC, Qm, Km, Vm, pre_part, lds, G, tid, lane, wave); )
    PHASE(12,  mlstm_phase(Qm, Km, Vm, pre_part, p.in[21], (float*)(ws + WS_GLF), HF, HB, lds, G, vcu, tid, lane, wave); )
    PHASE(13,  ml_combine_phase(HF, HB, XC, XZ, p.in[23], p.in[22], (unsigned char*)MO, gw, NGW, lane); )
    PHASE(14,  pg8::Gemm g{MO, WT_MLOUT, MTOK, 2048, 4096, 0}; pg8::StaticOrder S; S.init(MTOK, 2048, G, (int)blockIdx.x); pg8::EpiResGate16<true> E{X2, X1, DM, mod + 4 * 12288 + 2 * 2048, 12288, 1.0f / (HSCALE * WSCALE)}; pg8::gemm_phase<pg8::EpiResGate16<true>, pg8::StaticOrder, true>(lds, g, S, E); )
    PHASE(15,  rms_mod_phase<true, false, true>(X1, p.in[5] + DM, mod + 4 * 12288 + 4 * 2048, mod + 4 * 12288 + 3 * 2048, HA, p.in[25], tok_e, tok_pos, tok_w, ecnt, HS, gw, NGW, lane, (LAS float*)lds, tid); )
    PHASE(17,  int cnt[8], off[8], ntiles; moe_offsets(ecnt, cnt, off, ntiles);
        pg8::Gemm g{HS, WT_MGU, ntiles * 256, 2 * EDIM, 2048, 0}; pg8::MoeOrder S; S.init(ntiles, 2 * EDIM, G, (int)blockIdx.x, moe_tilemap(cnt), (size_t)14336 * 2048, (size_t)DM);
        pg8::EpiSwiGLU8 E{ACTM, EDIM, 1.0f / (HSCALE * WSCALE), ASCALE}; pg8::gemm_phase<pg8::EpiSwiGLU8, pg8::MoeOrder, true>(lds, g, S, E); )
    PHASE(18,  int cnt[8], off[8], ntiles; moe_offsets(ecnt, cnt, off, ntiles);
        pg8::Gemm g{ACTM, WT_MD, ntiles * 256, 2048, EDIM, 0};
        int nMf, nT, SS; moe_split_plan(ntiles, nMf, nT, SS); bf16_t* YSP = (bf16_t*)YS + (size_t)MPAD * DM;
        { pg8::MoeRowOrder S1; S1.init(nMf, G, (int)blockIdx.x, moe_tilemap(cnt), (size_t)2048 * EDIM); pg8::EpiBf16S E{(bf16_t*)YS, DM, 1.0f / (ASCALE * WSCALE), 0}; pg8::gemm_phase<pg8::EpiBf16S, pg8::MoeRowOrder, true>(lds, g, S1, E); }
        if (nT > 0) { pg8::Gemm g2 = g; g2.ntk = 56 / SS; pg8::MoeSplitOrder S2; S2.init(nMf, nT, SS, (size_t)(EDIM / SS), (int)blockIdx.x, moe_tilemap(cnt), (size_t)2048 * EDIM);
            pg8::EpiBf16S E2{YSP - (size_t)nMf * 256 * DM, DM, 1.0f / (ASCALE * WSCALE), (size_t)nT * 256 * DM}; pg8::gemm_phase<pg8::EpiBf16S, pg8::MoeSplitOrder, true>(lds, g2, S2, E2); } )
    PHASE(19,  moe_combine_phase(X1, (const bf16_t*)YS, tok_e, tok_pos, tok_w, mod + 4 * 12288 + 5 * 2048, p.out, ecnt, gw, NGW, lane); )
#undef IN
#undef SEAM
#undef PHASE
}

extern "C" void kernel_launch(void* const* d_in, const int* in_sizes, int n_in, void* d_out, int out_size, void* d_ws, size_t ws_size, hipStream_t stream) {
    static int grid = 0;
    if (grid == 0) {
        if (n_in != 29 || out_size != MTOK * DM || ws_size < WS_END) { fprintf(stderr, "kernel_launch: unexpected shapes (n_in %d out %d ws %zu need %zu)\n", n_in, out_size, ws_size, (size_t)WS_END); grid = -1; return; }
        int dev = 0, cus = 0, per_cu = 0;
        if (hipGetDevice(&dev) != hipSuccess || hipDeviceGetAttribute(&cus, hipDeviceAttributeMultiprocessorCount, dev) != hipSuccess) { grid = -1; return; }
        if (hipFuncSetAttribute((const void*)mega_fwd, hipFuncAttributeMaxDynamicSharedMemorySize, LDS_BYTES) != hipSuccess) { fprintf(stderr, "kernel_launch: hipFuncSetAttribute failed\n"); grid = -1; return; }
        if (hipOccupancyMaxActiveBlocksPerMultiprocessor(&per_cu, (const void*)mega_fwd, NTHREADS, LDS_BYTES) != hipSuccess || per_cu < 1) { fprintf(stderr, "kernel_launch: occupancy query says %d\n", per_cu); (void)hipGetLastError(); per_cu = 1; }
        grid = cus;
    }
    if (grid < 0) return;
    (void)hipMemsetAsync((char*)d_ws + WS_CTL, 0, CTL_BYTES, stream);
    Params p{};
    for (int i = 0; i < 29; ++i) p.in[i] = (const float*)d_in[i];
    p.out = (float*)d_out; p.ws = (unsigned char*)d_ws;
#if N_LAUNCH_SPLIT
    for (int k = 0; k < NPHASE; ++k) { p.ph_lo = k; p.ph_hi = k + 1; hipLaunchKernelGGL(mega_fwd, dim3(grid), dim3(NTHREADS), LDS_BYTES, stream, p); }
#else
    p.ph_lo = 0; p.ph_hi = NPHASE;
    hipLaunchKernelGGL(mega_fwd, dim3(grid), dim3(NTHREADS), LDS_BYTES, stream, p);
#endif
}
```
